# Optimizing an MI355X kernel written in HIP

```python
import math
import jax, jax.numpy as jnp
from jax import lax
import numpy as np

D_MODEL = 1024
BATCH = 8
SEQ = 4096
DEPTH = 1

DA_HEADS = 4
DA_HEAD_DIM = 64
DA_V_DIM = 2 * DA_HEAD_DIM
DA_WIDTH = DA_HEADS * DA_V_DIM
DA_QK_COLS = DA_HEADS * 2 * DA_HEAD_DIM
RW_HEADS = 8
RW_HEAD_DIM = 64
RW_WIDTH = RW_HEADS * RW_HEAD_DIM
DECAY_LORA = 64
AAA_LORA = 64
GATE_LORA = 128
MIX_WIDTH = DA_WIDTH + RW_WIDTH
DA_SIZES = (DA_QK_COLS, DA_QK_COLS, DA_WIDTH)
RW_SIZES = (RW_WIDTH, RW_WIDTH, RW_WIDTH, DECAY_LORA, AAA_LORA, GATE_LORA)
DA_COLS = DA_QK_COLS * 2 + DA_WIDTH
RW_COLS = RW_WIDTH * 3 + DECAY_LORA + AAA_LORA + GATE_LORA
IN_COLS = DA_COLS + RW_COLS
ROPE_THETA = 500000.0
ROPE_DIM = DA_HEAD_DIM // 4
Q_BLOCK = 128
N_EXPERTS = 32
TOP_K = 4
D_EXPERT = D_MODEL
SWIGLU_ALPHA = 1.702
SWIGLU_LIMIT = 7.0
NORM_EPS = 1e-6
SUBLN_EPS = 1e-5
LN_X_EPS = 64e-5
N_MOD = 6

kernel_name = 'hybrid_diffattn_rwkv7_moe'


def rms_norm(x, w, eps=NORM_EPS):
    xf = x.astype(jnp.float32)
    y = xf * lax.rsqrt(jnp.mean(xf * xf, axis=-1, keepdims=True) + eps)
    return (y * w.astype(jnp.float32)).astype(x.dtype)


def lambda_init_fn(layer):
    return 0.8 - 0.6 * math.exp(-0.3 * layer)


def split_cols(a, sizes):
    idx, s = [], 0
    for n in sizes[:-1]:
        s += n
        idx.append(s)
    return jnp.split(a, idx, axis=-1)


def partial_rope(x, cos, sin):
    half = ROPE_DIM // 2
    x1 = x[..., :half]
    x2 = x[..., half:ROPE_DIM]
    out = jnp.concatenate([x1 * cos - x2 * sin, x2 * cos + x1 * sin, x[..., ROPE_DIM:]], axis=-1)
    return out.astype(x.dtype)


def token_shift(p, mu):
    prev = jnp.pad(p, ((0, 0), (1, 0), (0, 0)))[:, :-1]
    return p + (prev - p) * mu


def diff_attention(q, k, v, cos, sin, lam_q1, lam_k1, lam_q2, lam_k2, subln_w, lambda_init):
    b, t = q.shape[0], q.shape[1]
    f32 = jnp.float32
    q = partial_rope(q.reshape(b, t, 2 * DA_HEADS, DA_HEAD_DIM), cos, sin) * (DA_HEAD_DIM ** -0.5)
    k = partial_rope(k.reshape(b, t, 2 * DA_HEADS, DA_HEAD_DIM), cos, sin)
    q = q.transpose(0, 2, 1, 3)
    k = k.transpose(0, 2, 1, 3)
    v = v.reshape(b, t, DA_HEADS, DA_V_DIM).transpose(0, 2, 1, 3)
    lam = (jnp.exp(jnp.sum(lam_q1.astype(f32) * lam_k1.astype(f32)))
           - jnp.exp(jnp.sum(lam_q2.astype(f32) * lam_k2.astype(f32))) + lambda_init)
    kpos = jnp.arange(t)

    def one_block(i):
        q_blk = lax.dynamic_slice_in_dim(q, i * Q_BLOCK, Q_BLOCK, axis=2)
        s = jnp.einsum('bhqd,bhkd->bhqk', q_blk, k).astype(f32)
        qpos = i * Q_BLOCK + jnp.arange(Q_BLOCK)
        s = jnp.where(qpos[:, None] >= kpos[None, :], s, -jnp.inf)
        p = jax.nn.softmax(s, axis=-1).reshape(b, DA_HEADS, 2, Q_BLOCK, t)
        attn = p[:, :, 0] - lam * p[:, :, 1]
        return jnp.einsum('bhqk,bhkd->bhqd', attn.astype(v.dtype), v)

    o = lax.map(one_block, jnp.arange(t // Q_BLOCK))
    o = o.transpose(1, 0, 3, 2, 4).reshape(b, t, DA_HEADS, DA_V_DIM)
    o = rms_norm(o, subln_w, SUBLN_EPS) * (1.0 - lambda_init)
    return o.reshape(b, t, DA_WIDTH)


def rwkv7_time_mix(r, k, v, w_lora, a_lora, g_lora, w0, w2, a0, a2, g2, k_k, k_a, r_k, ln_w, ln_b):
    b, t = r.shape[0], r.shape[1]
    f32 = jnp.float32
    log_w = -jax.nn.softplus(-(w0 + jnp.tanh(w_lora) @ w2).astype(f32)) - 0.5
    decay = jnp.exp(-jnp.exp(log_w))
    a = jax.nn.sigmoid((a0 + a_lora @ a2).astype(f32))
    g = jax.nn.sigmoid(g_lora) @ g2

    def heads(z):
        return z.astype(f32).reshape(b, t, RW_HEADS, RW_HEAD_DIM)

    kk = heads(k * k_k)
    kk = kk / jnp.maximum(jnp.linalg.norm(kk, axis=-1, keepdims=True), 1e-12)
    k_mod = k.astype(f32) * (1.0 + (a - 1.0) * k_a.astype(f32))
    r_h, k_h, v_h, w_h, a_h = heads(r), heads(k_mod), heads(v), heads(decay), heads(a)
    delta_a = -kk
    delta_b = kk * a_h

    def step(state, inp):
        r_t, w_t, k_t, v_t, da_t, db_t = inp
        sa = jnp.einsum('bhij,bhj->bhi', state, da_t)
        state = (state * w_t[:, :, None, :] + sa[..., None] * db_t[:, :, None, :]
                 + v_t[..., None] * k_t[:, :, None, :])
        return state, jnp.einsum('bhij,bhj->bhi', state, r_t)

    def tm(z):
        return z.transpose(1, 0, 2, 3)

    state0 = jnp.zeros((b, RW_HEADS, RW_HEAD_DIM, RW_HEAD_DIM), f32)
    _, y = lax.scan(step, state0, (tm(r_h), tm(w_h), tm(k_h), tm(v_h), tm(delta_a), tm(delta_b)))
    y = tm(y)
    mean = jnp.mean(y, axis=-1, keepdims=True)
    var = jnp.mean(jnp.square(y - mean), axis=-1, keepdims=True)
    y = ((y - mean) * lax.rsqrt(var + LN_X_EPS) * ln_w.astype(f32).reshape(RW_HEADS, RW_HEAD_DIM)
         + ln_b.astype(f32).reshape(RW_HEADS, RW_HEAD_DIM))
    y = y + jnp.sum(r_h * k_h * r_k.astype(f32), axis=-1, keepdims=True) * v_h
    return (y.reshape(b, t, RW_WIDTH) * g.astype(f32)).astype(r.dtype)


def clamped_swiglu(hid):
    x_glu = jnp.minimum(hid[..., ::2], SWIGLU_LIMIT)
    x_lin = jnp.clip(hid[..., 1::2], -SWIGLU_LIMIT, SWIGLU_LIMIT)
    return x_glu * jax.nn.sigmoid(SWIGLU_ALPHA * x_glu) * (x_lin + 1.0)


def moe_ffn(h, router_w, router_b, w1, b1, w2, b2):
    b, t, d = h.shape
    tok = h.reshape(b * t, d)
    logits = (tok @ router_w + router_b).astype(jnp.float32)
    top_vals, top_idx = lax.top_k(logits, TOP_K)
    top_w = jax.nn.softmax(top_vals, axis=-1)
    gates = jnp.sum(jax.nn.one_hot(top_idx, N_EXPERTS, dtype=jnp.float32) * top_w[..., None], axis=1)

    def expert(acc, xs):
        w1_e, b1_e, w2_e, b2_e, g_e = xs
        out = clamped_swiglu(tok @ w1_e + b1_e) @ w2_e + b2_e
        return acc + g_e[:, None] * out, None

    acc0 = jnp.zeros((b * t, d), jnp.float32)
    acc, _ = lax.scan(expert, acc0, (w1, b1, w2, b2, gates.T))
    return acc.reshape(b, t, d).astype(h.dtype)


def hybrid_layer(x, c, cos, sin, lambda_init, ada_w, ada_b, pre_mix_norm, post_mix_norm,
                 pre_ffn_norm, post_ffn_norm, w_in, w_out, da_lambda_q1, da_lambda_k1,
                 da_lambda_q2, da_lambda_k2, da_subln, rw_mu, rw_w0, rw_w2, rw_a0, rw_a2,
                 rw_g2, rw_k_k, rw_k_a, rw_r_k, rw_ln_w, rw_ln_b, router_w, router_b,
                 moe_w1, moe_b1, moe_w2, moe_b2):
    mod = jax.nn.silu(c) @ ada_w + ada_b
    sh1, sc1, gt1, sh2, sc2, gt2 = [m[:, None, :] for m in jnp.split(mod, N_MOD, axis=-1)]

    h = rms_norm(x, pre_mix_norm) * (1.0 + sc1) + sh1
    proj = h @ w_in
    da_part, rw_part = proj[..., :DA_COLS], proj[..., DA_COLS:]
    da_q, da_k, da_v = split_cols(da_part, DA_SIZES)
    rw_part = token_shift(rw_part, rw_mu)
    rw_r, rw_k, rw_v, rw_wl, rw_al, rw_gl = split_cols(rw_part, RW_SIZES)
    y_da = diff_attention(da_q, da_k, da_v, cos, sin, da_lambda_q1, da_lambda_k1,
                          da_lambda_q2, da_lambda_k2, da_subln, lambda_init)
    y_rw = rwkv7_time_mix(rw_r, rw_k, rw_v, rw_wl, rw_al, rw_gl, rw_w0, rw_w2, rw_a0, rw_a2,
                          rw_g2, rw_k_k, rw_k_a, rw_r_k, rw_ln_w, rw_ln_b)
    y = jnp.concatenate([y_da, y_rw], axis=-1) @ w_out
    x = x + gt1 * rms_norm(y, post_mix_norm)

    h = rms_norm(x, pre_ffn_norm) * (1.0 + sc2) + sh2
    y = moe_ffn(h, router_w, router_b, moe_w1, moe_b1, moe_w2, moe_b2)
    return x + gt2 * rms_norm(y, post_ffn_norm)


def setup_inputs(seed: int = 0) -> dict:
    key = jax.random.key(seed)
    ks = iter(jax.random.split(key, 40))
    f32 = jnp.float32
    L, D, E, F = DEPTH, D_MODEL, N_EXPERTS, D_EXPERT

    def nrm(shape, scale):
        return jax.random.normal(next(ks), shape, f32) * scale

    def gain(shape):
        return 1.0 + nrm(shape, 0.02)

    x = nrm((BATCH, SEQ, D), 1.0)
    c = nrm((BATCH, D), 1.0)
    offset = jax.random.randint(next(ks), (BATCH, 1), 0, 2048, jnp.int32)
    positions = offset + jnp.arange(SEQ, dtype=jnp.int32)[None, :]
    return {
        'x': x,
        'c': c,
        'positions': positions,
        'ada_w': nrm((L, D, N_MOD * D), 0.5 * D ** -0.5),
        'ada_b': nrm((L, N_MOD * D), 0.02),
        'pre_mix_norm': gain((L, D)),
        'post_mix_norm': gain((L, D)),
        'pre_ffn_norm': gain((L, D)),
        'post_ffn_norm': gain((L, D)),
        'w_in': nrm((L, D, IN_COLS), D ** -0.5),
        'w_out': nrm((L, MIX_WIDTH, D), MIX_WIDTH ** -0.5),
        'da_lambda_q1': nrm((L, DA_HEAD_DIM), 0.1),
        'da_lambda_k1': nrm((L, DA_HEAD_DIM), 0.1),
        'da_lambda_q2': nrm((L, DA_HEAD_DIM), 0.1),
        'da_lambda_k2': nrm((L, DA_HEAD_DIM), 0.1),
        'da_subln': gain((L, DA_V_DIM)),
        'rw_mu': jax.random.uniform(next(ks), (L, RW_COLS), f32),
        'rw_w0': -4.0 + 4.0 * jax.random.uniform(next(ks), (L, RW_WIDTH), f32),
        'rw_w2': nrm((L, DECAY_LORA, RW_WIDTH), 0.1 * DECAY_LORA ** -0.5),
        'rw_a0': nrm((L, RW_WIDTH), 0.1),
        'rw_a2': nrm((L, AAA_LORA, RW_WIDTH), 0.1 * AAA_LORA ** -0.5),
        'rw_g2': nrm((L, GATE_LORA, RW_WIDTH), GATE_LORA ** -0.5),
        'rw_k_k': 0.85 + nrm((L, RW_WIDTH), 0.02),
        'rw_k_a': gain((L, RW_WIDTH)),
        'rw_r_k': nrm((L, RW_HEADS, RW_HEAD_DIM), 0.1),
        'rw_ln_w': gain((L, RW_WIDTH)),
        'rw_ln_b': nrm((L, RW_WIDTH), 0.02),
        'router_w': nrm((L, D, E), D ** -0.5),
        'router_b': nrm((L, E), 0.01),
        'moe_w1': nrm((L, E, D, 2 * F), D ** -0.5),
        'moe_b1': nrm((L, E, 2 * F), 0.01),
        'moe_w2': nrm((L, E, F, D), F ** -0.5),
        'moe_b2': nrm((L, E, D), 0.01),
    }


def reference(x, c, positions, ada_w, ada_b, pre_mix_norm, post_mix_norm, pre_ffn_norm,
              post_ffn_norm, w_in, w_out, da_lambda_q1, da_lambda_k1, da_lambda_q2,
              da_lambda_k2, da_subln, rw_mu, rw_w0, rw_w2, rw_a0, rw_a2, rw_g2, rw_k_k,
              rw_k_a, rw_r_k, rw_ln_w, rw_ln_b, router_w, router_b, moe_w1, moe_b1,
              moe_w2, moe_b2):
    inv_freq = ROPE_THETA ** (-jnp.arange(0, ROPE_DIM, 2, dtype=jnp.float32) / ROPE_DIM)
    ang = positions.astype(jnp.float32)[..., None] * inv_freq
    cos = jnp.cos(ang)[:, :, None, :]
    sin = jnp.sin(ang)[:, :, None, :]
    for l in range(DEPTH):
        x = hybrid_layer(x, c, cos, sin, lambda_init_fn(l), ada_w[l], ada_b[l],
                         pre_mix_norm[l], post_mix_norm[l], pre_ffn_norm[l], post_ffn_norm[l],
                         w_in[l], w_out[l], da_lambda_q1[l], da_lambda_k1[l], da_lambda_q2[l],
                         da_lambda_k2[l], da_subln[l], rw_mu[l], rw_w0[l], rw_w2[l], rw_a0[l],
                         rw_a2[l], rw_g2[l], rw_k_k[l], rw_k_a[l], rw_r_k[l], rw_ln_w[l],
                         rw_ln_b[l], router_w[l], router_b[l], moe_w1[l], moe_b1[l],
                         moe_w2[l], moe_b2[l])
    return x
```

```cpp
#include <hip/hip_runtime.h>
#include <cstdio>
#include <cstdint>
__device__ __forceinline__ int lane_id_v() { int l; asm volatile("v_mbcnt_lo_u32_b32 %0, -1, 0\n\tv_mbcnt_hi_u32_b32 %0, -1, %0" : "=v"(l)); return l; }
namespace pg8 {
#define PG8_LAS __attribute__((address_space(3)))
typedef unsigned short bf16_t;
typedef short bf16x8 __attribute__((ext_vector_type(8)));
typedef float f32x4 __attribute__((ext_vector_type(4)));
typedef unsigned u32x4 __attribute__((ext_vector_type(4)));
constexpr int BM = 256, BK = 64, HALF = 128, HTB = HALF * BK * 2  , STAGE_BYTES = 8 * HTB, NXCD = 8, WGM = 8;

__host__ __device__ __forceinline__ int lds_byte(int r, int c) { const int st = (r >> 4) * 2 + (c >> 5), rr = r & 15, cc = c & 31, ob = rr * 64 + cc * 2; return st * 1024 + (ob ^ (((ob >> 9) & 1) << 5)); }
__host__ __device__ __forceinline__ void stage_rc(int b, int& R, int& C) { const int st = b / 1024, sb = b % 1024, swz = sb ^ (((sb >> 9) & 1) << 5); R = (st >> 1) * 16 + swz / 64; C = (st & 1) * 32 + (swz % 64) / 2; }
__host__ __device__ __forceinline__ int perm32(int rho) { const int n = rho >> 4, i = rho & 15; return 8 * (i >> 2) + 4 * n + (i & 3); }

struct Unit { int pm, pn, e; };
struct Gemm { const bf16_t* A; const bf16_t* Bt; int M, N, K; size_t bstride; const int* rowidx; };

struct StaticOrder {
    int nM, nN, nwg, G, c;
    __host__ __device__ void init(int M, int N, int G_, int c_) { nM = M / BM; nN = N / BM; nwg = nM * nN; G = G_; c = c_; }
    __host__ __device__ bool next(int i, Unit& u) const {
        const long L = (long)i * G + c; if (L >= nwg) return false;
        int wgid = (int)L; { const int q = nwg / NXCD, r = nwg % NXCD, xcd = wgid % NXCD, off = wgid / NXCD; wgid = (xcd < r ? xcd * (q + 1) : r * (q + 1) + (xcd - r) * q) + off; }
        const int nig = WGM * nN, gid = wgid / nig, fm = gid * WGM, gsz = (nM - fm) < WGM ? (nM - fm) : WGM;
        u.pm = fm + ((wgid % nig) % gsz); u.pn = (wgid % nig) / gsz; u.e = 0; return true;
    }
    __device__ __forceinline__ void a_ready(const Unit&) const {}
    __device__ __forceinline__ void done(const Unit&) const {}
};

__device__ __forceinline__ unsigned cvt_pk_bf16(float lo, float hi) { unsigned r; asm volatile("v_cvt_pk_bf16_f32 %0, %1, %2" : "=v"(r) : "v"(lo), "v"(hi)); return r; }
typedef float f32x2 __attribute__((ext_vector_type(2)));
typedef unsigned u32x2 __attribute__((ext_vector_type(2)));
__device__ __forceinline__ float sigmoidf_(float x) { return __builtin_amdgcn_rcpf(1.f + __expf(-x)); }

struct MoeOrder {
    int ntiles, nN, RG, G, c; const PG8_LAS int* tstart;
    __device__ __forceinline__ bool next(int i, Unit& u) const {
        const int L = i * G + c, grp = L >> 5, idx = L & 31; u.pn = idx / RG; u.pm = grp * RG + idx % RG; u.e = 0;
        if (u.pm >= ntiles) return false;
        int e = 0;
#pragma unroll
        for (int k = 16; k >= 1; k >>= 1) { if (tstart[e + k] <= u.pm) e += k; }
        u.e = e; return true;
    }
    __device__ __forceinline__ void a_ready(const Unit&) const {}
    __device__ __forceinline__ void done(const Unit&) const {}
};

#define PG8_PACK8(v0, v1) (u32x4){cvt_pk_bf16((v0)[0], (v0)[1]), cvt_pk_bf16((v0)[2], (v0)[3]), cvt_pk_bf16((v1)[0], (v1)[1]), cvt_pk_bf16((v1)[2], (v1)[3])}

struct EpiPlain {
    static constexpr bool PERM = true, AFTER_DRAIN = false;
    bf16_t* O; int ldc;
    __device__ __forceinline__ void operator()(const f32x4 (&acc)[2][2][4][2], const Unit& u, int wr, int wc, int fr, int fq) const {
        const int row0 = u.pm * BM + wr * 64 + fr, col0 = u.pn * BM + wc * 32 + 8 * fq;
#pragma unroll
        for (int ai = 0; ai < 2; ++ai)
#pragma unroll
            for (int m = 0; m < 4; ++m) { bf16_t* rowp = O + (size_t)(row0 + ai * HALF + m * 16) * ldc + col0;
#pragma unroll
                for (int bj = 0; bj < 2; ++bj) { const f32x4 v0 = acc[ai][bj][m][0], v1 = acc[ai][bj][m][1]; *(u32x4*)(rowp + bj * HALF) = PG8_PACK8(v0, v1); } }
    }
};

struct EpiProj {
    static constexpr bool PERM = true, AFTER_DRAIN = false;
    bf16_t *Q, *K, *V, *RW; const float* rope; float qscale;
    __device__ __forceinline__ void operator()(const f32x4 (&acc)[2][2][4][2], const Unit& u, int wr, int wc, int fr, int fq) const {
        const int row0 = u.pm * BM + wr * 64 + fr, cl = wc * 32 + 8 * fq, pn = u.pn;
        if (pn < 4) {
            bf16_t* base = (pn < 2) ? Q : K; const int colt = (pn & 1) * 256; const float sc = (pn < 2) ? qscale : 1.f;
            const bool rp = ((wc & 1) == 0) && (fq < 2);
#pragma unroll
            for (int ai = 0; ai < 2; ++ai)
#pragma unroll
                for (int m = 0; m < 4; ++m) { const int row = row0 + ai * HALF + m * 16;
                    f32x4 cs = (f32x4){1.f, 1.f, 1.f, 1.f}, sn = (f32x4){0.f, 0.f, 0.f, 0.f};
                    if (rp) { cs = *(const f32x4*)(rope + (size_t)row * 16 + 4 * fq); sn = *(const f32x4*)(rope + (size_t)row * 16 + 8 + 4 * fq); }
#pragma unroll
                    for (int bj = 0; bj < 2; ++bj) { f32x4 v0 = acc[ai][bj][m][0], v1 = acc[ai][bj][m][1];
                        { const float a0 = v0[0], b0 = v0[1], a1 = v0[2], b1 = v0[3], a2 = v1[0], b2 = v1[1], a3 = v1[2], b3 = v1[3];
                          v0[0] = a0 * cs[0] - b0 * sn[0]; v0[1] = b0 * cs[0] + a0 * sn[0]; v0[2] = a1 * cs[1] - b1 * sn[1]; v0[3] = b1 * cs[1] + a1 * sn[1];
                          v1[0] = a2 * cs[2] - b2 * sn[2]; v1[1] = b2 * cs[2] + a2 * sn[2]; v1[2] = a3 * cs[3] - b3 * sn[3]; v1[3] = b3 * cs[3] + a3 * sn[3]; }
                        v0 = v0 * sc; v1 = v1 * sc;
                        *(u32x4*)(base + (size_t)row * 512 + colt + bj * HALF + cl) = PG8_PACK8(v0, v1); } }
        } else {
            bf16_t* base; int ld, colt;
            if (pn < 6) { base = V; ld = 512; colt = (pn - 4) * 256; } else { base = RW; ld = 1792; colt = (pn - 6) * 256; }
#pragma unroll
            for (int ai = 0; ai < 2; ++ai)
#pragma unroll
                for (int m = 0; m < 4; ++m) { bf16_t* rowp = base + (size_t)(row0 + ai * HALF + m * 16) * ld + colt + cl;
#pragma unroll
                    for (int bj = 0; bj < 2; ++bj) { const f32x4 v0 = acc[ai][bj][m][0], v1 = acc[ai][bj][m][1]; *(u32x4*)(rowp + bj * HALF) = PG8_PACK8(v0, v1); } }
        }
    }
};

struct EpiLora {
    static constexpr bool PERM = true, AFTER_DRAIN = false;
    float* LW; size_t kstride; const float *w0, *a0;
    __device__ __forceinline__ void operator()(const f32x4 (&acc)[2][2][4][2], const Unit& u, int wr, int wc, int fr, int fq) const {
        const int row0 = u.pm * BM + wr * 64 + fr, kind = u.pn >> 1, col0 = (u.pn & 1) * 256 + wc * 32 + 8 * fq;
        float* dst = LW + (size_t)kind * kstride; const float* bias = (kind == 1) ? a0 : w0;
        f32x4 bv[2][2];
#pragma unroll
        for (int bj = 0; bj < 2; ++bj)
#pragma unroll
            for (int n = 0; n < 2; ++n) bv[bj][n] = (kind < 2) ? *(const f32x4*)(bias + col0 + bj * HALF + 4 * n) : (f32x4){0.f, 0.f, 0.f, 0.f};
#pragma unroll
        for (int ai = 0; ai < 2; ++ai)
#pragma unroll
            for (int m = 0; m < 4; ++m) { float* rowp = dst + (size_t)(row0 + ai * HALF + m * 16) * 512 + col0;
#pragma unroll
                for (int bj = 0; bj < 2; ++bj)
#pragma unroll
                    for (int n = 0; n < 2; ++n) { f32x4 v = acc[ai][bj][m][n] + bv[bj][n];
                        if (kind == 0) {
#pragma unroll
                            for (int q = 0; q < 4; ++q) { const float z = -v[q]; const float sp = fmaxf(z, 0.f) + __logf(1.f + __expf(-fabsf(z))); v[q] = -__expf(-sp - 0.5f); }
                        } else if (kind == 1) {
#pragma unroll
                            for (int q = 0; q < 4; ++q) v[q] = sigmoidf_(v[q]);
                        }
                        *(f32x4*)(rowp + bj * HALF + 4 * n) = v; } }
    }
};

struct EpiSwiglu {
    static constexpr bool PERM = true, AFTER_DRAIN = false;
    bf16_t* ACT; const float* b1;
    __device__ __forceinline__ void operator()(const f32x4 (&acc)[2][2][4][2], const Unit& u, int wr, int wc, int fr, int fq) const {
        const int row0 = u.pm * BM + wr * 64 + fr, col0 = u.pn * BM + wc * 32 + 8 * fq;
        f32x4 bv[2][2];
#pragma unroll
        for (int bj = 0; bj < 2; ++bj)
#pragma unroll
            for (int n = 0; n < 2; ++n) bv[bj][n] = *(const f32x4*)(b1 + (size_t)u.e * 2048 + col0 + bj * HALF + 4 * n);
#pragma unroll
        for (int ai = 0; ai < 2; ++ai)
#pragma unroll
            for (int m = 0; m < 4; ++m) { bf16_t* rowp = ACT + (size_t)(row0 + ai * HALF + m * 16) * 1024 + (col0 >> 1);
#pragma unroll
                for (int bj = 0; bj < 2; ++bj) { const f32x4 v0 = acc[ai][bj][m][0] + bv[bj][0], v1 = acc[ai][bj][m][1] + bv[bj][1];
                    float o[4];
#pragma unroll
                    for (int q = 0; q < 4; ++q) { const float glu = (q < 2) ? v0[2 * q] : v1[2 * q - 4], lin = (q < 2) ? v0[2 * q + 1] : v1[2 * q - 3];
                        const float gg = fminf(glu, 7.f), ll = fminf(fmaxf(lin, -7.f), 7.f); o[q] = gg * sigmoidf_(1.702f * gg) * (ll + 1.f); }
                    *(u32x2*)(rowp + bj * (HALF / 2)) = (u32x2){cvt_pk_bf16(o[0], o[1]), cvt_pk_bf16(o[2], o[3])}; } }
    }
};

struct EpiMoe2 {
    static constexpr bool PERM = true, AFTER_DRAIN = false;
    bf16_t* Y2; const float* b2; const float* gate;
    __device__ __forceinline__ void operator()(const f32x4 (&acc)[2][2][4][2], const Unit& u, int wr, int wc, int fr, int fq) const {
        const int row0 = u.pm * BM + wr * 64 + fr, col0 = u.pn * BM + wc * 32 + 8 * fq;
        f32x4 bv[2][2];
#pragma unroll
        for (int bj = 0; bj < 2; ++bj)
#pragma unroll
            for (int n = 0; n < 2; ++n) bv[bj][n] = *(const f32x4*)(b2 + (size_t)u.e * 1024 + col0 + bj * HALF + 4 * n);
#pragma unroll
        for (int ai = 0; ai < 2; ++ai)
#pragma unroll
            for (int m = 0; m < 4; ++m) { const int row = row0 + ai * HALF + m * 16; const float gt = gate[row]; bf16_t* rowp = Y2 + (size_t)row * 1024 + col0;
#pragma unroll
                for (int bj = 0; bj < 2; ++bj) { const f32x4 v0 = (acc[ai][bj][m][0] + bv[bj][0]) * gt, v1 = (acc[ai][bj][m][1] + bv[bj][1]) * gt;
                    *(u32x4*)(rowp + bj * HALF) = PG8_PACK8(v0, v1); } }
    }
};

template <class Epi, class Sched, bool ALIGN_EPI = false, bool SP2 = false, bool GATHER = false>
__device__ __forceinline__ void gemm_phase(PG8_LAS unsigned char* lds, const Gemm g, const Sched& S, const Epi& E, const int wid) {
    const int lane = lane_id_v(), tid = wid * 64 + lane, wr = wid >> 2, wc = wid & 3, fr = lane & 15, fq = lane >> 4;
    const int K = g.K, nt = K / BK;
    unsigned voffA[2], voffB[2], gC[2]; int gR[2];
#pragma unroll
    for (int i = 0; i < 2; ++i) { int R, C; stage_rc(tid * 16 + i * 8192, R, C); const int Rb = Epi::PERM ? ((R & ~31) + perm32(R & 31)) : R;
        voffA[i] = (unsigned)(R * K + C) * 2u; voffB[i] = (unsigned)(Rb * K + C) * 2u; gR[i] = R; gC[i] = (unsigned)C * 2u; }
    const size_t kstep = (size_t)(BK * 2);
    const size_t hstep = (size_t)HALF * K * 2;
    const size_t tstep = 2 * hstep;
    const unsigned ldsw = (unsigned)wid * 1024u;
    const int aoff = lds_byte(wr * 64 + fr, fq * 8), boff = lds_byte(wc * 32 + fr, fq * 8);
#define PG8_SA(b, h) (((b) * 2 + (h)) * HTB)
#define PG8_SB(b, h) ((4 + (b) * 2 + (h)) * HTB)
#define PG8_STAGE(bufoff, gbase, voff) do { _Pragma("unroll") for (int _i = 0; _i < 2; ++_i) \
        __builtin_amdgcn_global_load_lds((const unsigned*)((const char*)(gbase) + (voff)[_i]), (PG8_LAS unsigned*)(lds + (bufoff) + ldsw + _i * 8192), 16, 0, 0); } while (0)
#define PG8_STAGE_A(bufoff, ptr, h, nx) do { if constexpr (GATHER) { unsigned vo_[2]; vo_[0] = (nx) ? gn[h][0] : gc[h][0]; vo_[1] = (nx) ? gn[h][1] : gc[h][1]; PG8_STAGE(bufoff, ptr, vo_); } \
        else { PG8_STAGE(bufoff, (ptr) + (h) * hstep, voffA); } } while (0)
#define PG8_LDA(dst, b, h) do { _Pragma("unroll") for (int m = 0; m < 4; ++m) _Pragma("unroll") for (int k = 0; k < 2; ++k) dst[m][k] = *(const PG8_LAS bf16x8*)(lds + PG8_SA(b, h) + aoff + m * 2048 + k * 1024); } while (0)
#define PG8_LDB(dst, b, h) do { _Pragma("unroll") for (int n = 0; n < 2; ++n) _Pragma("unroll") for (int k = 0; k < 2; ++k) dst[n][k] = *(const PG8_LAS bf16x8*)(lds + PG8_SB(b, h) + boff + n * 2048 + k * 1024); } while (0)
#define PG8_MMA(ai, bj, At, Bt) do { __builtin_amdgcn_s_setprio(1); _Pragma("unroll") for (int m = 0; m < 4; ++m) _Pragma("unroll") for (int n = 0; n < 2; ++n) _Pragma("unroll") for (int k = 0; k < 2; ++k) \
        acc[ai][bj][m][n] = __builtin_amdgcn_mfma_f32_16x16x32_bf16(Bt[n][k], At[m][k], acc[ai][bj][m][n], 0, 0, 0); __builtin_amdgcn_s_setprio(0); } while (0)
#define PG8_WAIT_V(n) asm volatile("s_waitcnt vmcnt(" #n ")" ::: "memory")
#define PG8_WAIT_L(n) asm volatile("s_waitcnt lgkmcnt(" #n ")" ::: "memory")
#define PG8_BAR __builtin_amdgcn_s_barrier()
#define PG8_SCHED __builtin_amdgcn_sched_barrier(0)
    Unit cur, nxt; int ui = 0;
    if (!S.next(0, cur)) return;
    f32x4 acc[2][2][4][2];
#pragma unroll
    for (int a = 0; a < 2; ++a)
#pragma unroll
        for (int b = 0; b < 2; ++b)
#pragma unroll
            for (int m = 0; m < 4; ++m)
#pragma unroll
                for (int n = 0; n < 2; ++n) acc[a][b][m][n] = (f32x4){0.f, 0.f, 0.f, 0.f};
    bf16x8 At[4][2], B0[2][2], B1[2][2];
    const char* cA = GATHER ? (const char*)g.A : (const char*)g.A + (size_t)cur.pm * tstep; const char* cB = (const char*)g.Bt + (size_t)cur.e * g.bstride + (size_t)cur.pn * tstep;
    unsigned gc[2][2] = {{0u, 0u}, {0u, 0u}}, gn[2][2] = {{0u, 0u}, {0u, 0u}}, g2[2][2] = {{0u, 0u}, {0u, 0u}}; Unit nx2; bool has_nx2 = false;
    if constexpr (GATHER) {
        _Pragma("unroll") for (int h = 0; h < 2; ++h) _Pragma("unroll") for (int i = 0; i < 2; ++i) gc[h][i] = (unsigned)g.rowidx[cur.pm * BM + h * HALF + gR[i]] * (unsigned)(K * 2) + gC[i];
        const bool hn = S.next(1, nxt);
        _Pragma("unroll") for (int h = 0; h < 2; ++h) _Pragma("unroll") for (int i = 0; i < 2; ++i) gn[h][i] = hn ? (unsigned)g.rowidx[nxt.pm * BM + h * HALF + gR[i]] * (unsigned)(K * 2) + gC[i] : gc[h][i];
    }
    S.a_ready(cur);
    if constexpr (SP2) {
        PG8_STAGE(PG8_SB(0, 0), cB, voffB); PG8_STAGE(PG8_SB(0, 1), cB + hstep, voffB); PG8_STAGE_A(PG8_SA(0, 0), cA, 0, false); PG8_STAGE_A(PG8_SA(0, 1), cA, 1, false);
        if (wr == 1) PG8_BAR;
        PG8_WAIT_V(2); PG8_BAR;
        PG8_STAGE(PG8_SB(1, 0), cB + kstep, voffB); PG8_STAGE_A(PG8_SA(1, 0), cA + kstep, 0, false); PG8_STAGE(PG8_SB(1, 1), cB + hstep + kstep, voffB);
        PG8_WAIT_V(6); PG8_BAR;
    } else {
        PG8_STAGE(PG8_SB(0, 0), cB, voffB); PG8_STAGE_A(PG8_SA(0, 0), cA, 0, false); PG8_STAGE(PG8_SB(0, 1), cB + hstep, voffB); PG8_STAGE_A(PG8_SA(0, 1), cA, 1, false);
        if (wr == 1) PG8_BAR;
        PG8_WAIT_V(4); PG8_BAR;
        PG8_STAGE(PG8_SB(1, 0), cB + kstep, voffB); PG8_STAGE_A(PG8_SA(1, 0), cA + kstep, 0, false); PG8_STAGE(PG8_SB(1, 1), cB + hstep + kstep, voffB);
        PG8_WAIT_V(6); PG8_BAR;
    }
    for (;;) {
        const bool has_next = S.next(ui + 1, nxt);
        const char* nA = GATHER ? (const char*)g.A : (has_next ? (const char*)g.A + (size_t)nxt.pm * tstep : cA); const char* nB = has_next ? (const char*)g.Bt + (size_t)nxt.e * g.bstride + (size_t)nxt.pn * tstep : cB;
        for (int t = 0; t < nt; t += 2) {
            const bool last = (t == nt - 2);
            const char* a1 = cA + (size_t)(t + 1) * kstep;
            const char* a2 = last ? nA : cA + (size_t)(t + 2) * kstep; const char* b2 = last ? nB : cB + (size_t)(t + 2) * kstep;
            const char* a3 = a2 + kstep; const char* b3 = b2 + kstep;
            if (last && has_next) S.a_ready(nxt);
            if constexpr (SP2) {
            PG8_LDB(B0, 0, 0); PG8_LDB(B1, 0, 1); PG8_SCHED; PG8_LDA(At, 0, 0); PG8_STAGE_A(PG8_SA(1, 1), a1, 1, false);
            PG8_WAIT_V(8); PG8_WAIT_L(0); PG8_BAR; PG8_MMA(0, 0, At, B0); PG8_MMA(0, 1, At, B1); PG8_BAR; PG8_SCHED;
            PG8_LDA(At, 0, 1); PG8_STAGE(PG8_SB(0, 0), b2, voffB); PG8_STAGE(PG8_SB(0, 1), b2 + hstep, voffB); PG8_STAGE_A(PG8_SA(0, 0), a2, 0, last);
            PG8_WAIT_V(8); PG8_WAIT_L(0); PG8_BAR; PG8_MMA(1, 0, At, B0); PG8_MMA(1, 1, At, B1); PG8_BAR; PG8_SCHED;
            PG8_LDB(B0, 1, 0); PG8_LDB(B1, 1, 1); PG8_SCHED; PG8_LDA(At, 1, 0); PG8_STAGE_A(PG8_SA(0, 1), a2, 1, last);
            PG8_WAIT_V(8); PG8_WAIT_L(0); PG8_BAR; PG8_MMA(0, 0, At, B0); PG8_MMA(0, 1, At, B1); PG8_BAR; PG8_SCHED;
            PG8_LDA(At, 1, 1); PG8_STAGE(PG8_SB(1, 0), b3, voffB); PG8_STAGE(PG8_SB(1, 1), b3 + hstep, voffB); PG8_STAGE_A(PG8_SA(1, 0), a3, 0, last);
            PG8_WAIT_V(8); PG8_WAIT_L(0); PG8_BAR; PG8_MMA(1, 0, At, B0); PG8_MMA(1, 1, At, B1); PG8_BAR; PG8_SCHED;
            } else {
            PG8_LDB(B0, 0, 0); PG8_SCHED; PG8_LDA(At, 0, 0); PG8_STAGE_A(PG8_SA(1, 1), a1, 1, false);
            PG8_WAIT_L(8); PG8_BAR; PG8_WAIT_L(0); PG8_MMA(0, 0, At, B0); PG8_BAR; PG8_SCHED;
            PG8_LDB(B1, 0, 1); PG8_STAGE(PG8_SB(0, 0), b2, voffB);
            PG8_BAR; PG8_WAIT_L(0); PG8_MMA(0, 1, At, B1); PG8_BAR;
            PG8_LDA(At, 0, 1); PG8_STAGE_A(PG8_SA(0, 0), a2, 0, last);
            PG8_BAR; PG8_WAIT_L(0); PG8_MMA(1, 0, At, B0); PG8_BAR; PG8_SCHED;
            PG8_STAGE(PG8_SB(0, 1), b2 + hstep, voffB);
            PG8_WAIT_V(6); PG8_BAR; PG8_MMA(1, 1, At, B1); PG8_BAR;
            PG8_LDB(B0, 1, 0); PG8_SCHED; PG8_LDA(At, 1, 0); PG8_STAGE_A(PG8_SA(0, 1), a2, 1, last);
            PG8_WAIT_L(8); PG8_BAR; PG8_WAIT_L(0); PG8_MMA(0, 0, At, B0); PG8_BAR; PG8_SCHED;
            PG8_LDB(B1, 1, 1); PG8_STAGE(PG8_SB(1, 0), b3, voffB);
            PG8_BAR; PG8_WAIT_L(0); PG8_MMA(0, 1, At, B1); PG8_BAR;
            PG8_LDA(At, 1, 1); PG8_STAGE_A(PG8_SA(1, 0), a3, 0, last);
            PG8_BAR; PG8_WAIT_L(0); PG8_MMA(1, 0, At, B0); PG8_BAR; PG8_SCHED;
            PG8_STAGE(PG8_SB(1, 1), b3 + hstep, voffB);
            PG8_WAIT_V(6); PG8_BAR; PG8_MMA(1, 1, At, B1); PG8_BAR;
            }
        }
        if constexpr (GATHER) { has_nx2 = has_next && S.next(ui + 2, nx2);
            _Pragma("unroll") for (int h = 0; h < 2; ++h) _Pragma("unroll") for (int i = 0; i < 2; ++i) g2[h][i] = has_nx2 ? (unsigned)g.rowidx[nx2.pm * BM + h * HALF + gR[i]] * (unsigned)(K * 2) + gC[i] : gn[h][i]; }
        if constexpr (ALIGN_EPI) { if (wr == 0) PG8_BAR; }
        if constexpr (!Epi::AFTER_DRAIN) { E(acc, cur, wr, wc, fr, fq); S.done(cur); }
        if (!has_next) break;
#pragma unroll
        for (int a = 0; a < 2; ++a)
#pragma unroll
            for (int b = 0; b < 2; ++b)
#pragma unroll
                for (int m = 0; m < 4; ++m)
#pragma unroll
                    for (int n = 0; n < 2; ++n) acc[a][b][m][n] = (f32x4){0.f, 0.f, 0.f, 0.f};
        if constexpr (GATHER) { asm volatile("" : "+v"(g2[0][0]), "+v"(g2[0][1]), "+v"(g2[1][0]), "+v"(g2[1][1]));
            _Pragma("unroll") for (int h = 0; h < 2; ++h) _Pragma("unroll") for (int i = 0; i < 2; ++i) { gc[h][i] = gn[h][i]; gn[h][i] = g2[h][i]; } }
        cur = nxt; cA = nA; cB = nB; ++ui;
        if constexpr (ALIGN_EPI) { if (wr == 1) PG8_BAR; }
    }
    PG8_WAIT_V(0);
    if constexpr (!ALIGN_EPI) { if (wr == 0) PG8_BAR; }
    PG8_BAR;
    if constexpr (Epi::AFTER_DRAIN) { E.fused(acc, cur, wr, wc, fr, fq, lds, wid, lane); S.done(cur); }
#undef PG8_SA
#undef PG8_SB
#undef PG8_STAGE
#undef PG8_STAGE_A
#undef PG8_LDA
#undef PG8_LDB
#undef PG8_MMA
#undef PG8_WAIT_V
#undef PG8_WAIT_L
#undef PG8_BAR
#undef PG8_SCHED
}
}
#include <hip/hip_bf16.h>
#include <cmath>
namespace attn_body {
using bf16=__hip_bfloat16;
using bf16x8=__attribute__((ext_vector_type(8)))short;
using s16x4=__attribute__((ext_vector_type(4)))short;
using f32x16=__attribute__((ext_vector_type(16)))float;
using u32x4=__attribute__((ext_vector_type(4)))unsigned;
constexpr int BATCH=8,NHEAD=16,SEQ=4096,D=64;
constexpr int QP=512,KP=512,VP=512,OP=1024;
constexpr int NW=8,QBLK=32,QB=QBLK*NW,KVBLK=64,NQB=SEQ/QB;
constexpr int ATTN_UNIT_ROWS=QB;
__device__ __forceinline__ int crow(int r,int hi){return (r&3)+8*(r>>2)+4*hi;}
#define SBAR() __builtin_amdgcn_sched_barrier(0)
__device__ __forceinline__ void cmask(f32x16&p0,f32x16&p1,int jb,int qrel,int hi){
  const float NEG=-INFINITY; int kb=64*jb+4*hi;
  #pragma unroll
  for(int r=0;r<16;++r){int kv=kb+(r&3)+8*(r>>2); if(kv>qrel)p0[r]=NEG; if(kv+32>qrel)p1[r]=NEG;}
}

constexpr int NSLOT=3, SLOTB=8192;
constexpr int LDS_K=0, LDS_V=NSLOT*SLOTB, LDS_WS=2*NSLOT*SLOTB, LDS_OST=LDS_WS+NW*64*4, LDS_BYTES=LDS_OST+NW*4096;
constexpr float C2=0.125f*1.4426950408889634f;
__device__ __forceinline__ void glds16(const void*gsrc,unsigned lds_dst){unsigned keep;
  asm volatile("s_mov_b32 %0, m0\n\ts_mov_b32 m0, %2\n\ts_nop 0\n\tglobal_load_lds_dwordx4 %1, off\n\ts_mov_b32 m0, %0":"=&s"(keep):"v"(gsrc),"s"(lds_dst):"memory");}
__device__ __forceinline__ float max3f(float a,float b,float c){float r;asm("v_max3_f32 %0, %1, %2, %3":"=v"(r):"v"(a),"v"(b),"v"(c));return r;}
__device__ __forceinline__ float max2f(float a,float b){float r;asm("v_max_f32_e32 %0, %1, %2":"=v"(r):"v"(a),"v"(b));return r;}
__device__ __forceinline__ float fadd_s(float a,float b){float r;asm("v_add_f32_e32 %0, %1, %2":"=v"(r):"v"(a),"v"(b));return r;}
__device__ __forceinline__ float fsub_s(float a,float b){float r;asm("v_sub_f32_e32 %0, %1, %2":"=v"(r):"v"(a),"v"(b));return r;}
typedef float f32x2_t __attribute__((ext_vector_type(2))); typedef __bf16 bf16x2_t __attribute__((ext_vector_type(2)));
__device__ __forceinline__ unsigned cvtpk_s(float lo,float hi){f32x2_t v={lo,hi};bf16x2_t b=__builtin_convertvector(v,bf16x2_t);return __builtin_bit_cast(unsigned,b);}
#define WAIT_BAR(N) asm volatile("s_waitcnt vmcnt(" #N ") lgkmcnt(0)\n\ts_barrier":::"memory")

__device__ __forceinline__ void qkt(f32x16&p0,f32x16&p1,const char*Kslot,const bf16x8*qr,const f32x16&negm,int r32,int hi){
  const char*kb=Kslot+hi*1024+r32*16;
  #pragma unroll
  for(int d0=0;d0<4;++d0){
    const bf16x8 b0=*reinterpret_cast<const bf16x8*>(kb+d0*2048);
    const bf16x8 b1=*reinterpret_cast<const bf16x8*>(kb+d0*2048+512);
    if(d0==0){p0=__builtin_amdgcn_mfma_f32_32x32x16_bf16(b0,qr[0],negm,0,0,0);p1=__builtin_amdgcn_mfma_f32_32x32x16_bf16(b1,qr[0],negm,0,0,0);}
    else{p0=__builtin_amdgcn_mfma_f32_32x32x16_bf16(b0,qr[d0],p0,0,0,0);p1=__builtin_amdgcn_mfma_f32_32x32x16_bf16(b1,qr[d0],p1,0,0,0);}}
}
typedef __attribute__((address_space(3))) const char* lds_cptr;
typedef short v4i16_t __attribute__((ext_vector_type(4)));
__device__ __forceinline__ void kload8(bf16x8*kf,lds_cptr kp){
  kf[0]=*(const __attribute__((address_space(3))) bf16x8*)(kp);      kf[1]=*(const __attribute__((address_space(3))) bf16x8*)(kp+512);
  kf[2]=*(const __attribute__((address_space(3))) bf16x8*)(kp+2048); kf[3]=*(const __attribute__((address_space(3))) bf16x8*)(kp+2560);
  kf[4]=*(const __attribute__((address_space(3))) bf16x8*)(kp+4096); kf[5]=*(const __attribute__((address_space(3))) bf16x8*)(kp+4608);
  kf[6]=*(const __attribute__((address_space(3))) bf16x8*)(kp+6144); kf[7]=*(const __attribute__((address_space(3))) bf16x8*)(kp+6656);
}
__device__ __forceinline__ void kload2(bf16x8*kf,lds_cptr kp,int j){ kf[2*j]=*(const __attribute__((address_space(3))) bf16x8*)(kp+j*2048); kf[2*j+1]=*(const __attribute__((address_space(3))) bf16x8*)(kp+j*2048+512); }
__device__ __forceinline__ s16x4 vtr(lds_cptr p){ return __builtin_bit_cast(s16x4,__builtin_amdgcn_ds_read_tr16_b64_v4i16((__attribute__((address_space(3))) v4i16_t*)p)); }
__device__ __forceinline__ float rowmax(const f32x16&p0,const f32x16&p1){
  float a=max3f(p0[0],p0[1],p1[0]),b=max3f(p0[2],p0[3],p1[1]);a=max3f(a,p1[2],p1[3]);
  #pragma unroll
  for(int r=4;r<16;r+=4){a=max3f(a,p0[r],p0[r+1]);b=max3f(b,p0[r+2],p0[r+3]);a=max3f(a,p1[r],p1[r+1]);b=max3f(b,p1[r+2],p1[r+3]);}
  const float m=max2f(a,b);
  auto rr=__builtin_amdgcn_permlane32_swap(__float_as_uint(m),__float_as_uint(m),false,false);
  return max2f(__uint_as_float(rr[0]),__uint_as_float(rr[1]));
}
__device__ __forceinline__ void pv(f32x16*o,int vb,bf16x8 pa0,bf16x8 pa1,bf16x8 pa2,bf16x8 pa3){
  #pragma unroll
  for(int d0=0;d0<2;++d0){s16x4 lo[4],hi[4];
    #pragma unroll
    for(int ks=0;ks<4;++ks){
      asm volatile("ds_read_b64_tr_b16 %0,%1 offset:%c2":"=&v"(lo[ks]):"v"(vb),"i"(d0*4096+ks*1024):"memory");
      asm volatile("ds_read_b64_tr_b16 %0,%1 offset:%c2":"=&v"(hi[ks]):"v"(vb),"i"(d0*4096+ks*1024+512):"memory");}
    asm volatile("s_waitcnt lgkmcnt(0)":::"memory");SBAR();
    #define PK(k) (bf16x8){lo[k][0],lo[k][1],lo[k][2],lo[k][3],hi[k][0],hi[k][1],hi[k][2],hi[k][3]}
    o[d0]=__builtin_amdgcn_mfma_f32_32x32x16_bf16(pa0,PK(0),o[d0],0,0,0);
    o[d0]=__builtin_amdgcn_mfma_f32_32x32x16_bf16(pa1,PK(1),o[d0],0,0,0);
    o[d0]=__builtin_amdgcn_mfma_f32_32x32x16_bf16(pa2,PK(2),o[d0],0,0,0);
    o[d0]=__builtin_amdgcn_mfma_f32_32x32x16_bf16(pa3,PK(3),o[d0],0,0,0);
    #undef PK
  }
}

#ifndef ATTN_STORE16
#define ATTN_STORE16(p,v) (*(u32x4*)(p)=(v))
#endif
template<int THRL> __device__ __forceinline__ void attn_unit(int b,int h,int qb,const bf16*Q,const bf16*__restrict__ K,const bf16*__restrict__ V,bf16*O,char*shm,const int wid){
  const int qcol=(h>>1)*64, kcol=(h>>1)*64, vcol=(h>>2)*128+(h&1)*64, ocol=h*64;
  const int lane=lane_id_v(),r32=lane&31,hi=lane>>5;
  const long rowbase=(long)b*SEQ; const int q0=qb*QB;
  const bf16*Qw=Q+(rowbase+q0+wid*QBLK)*QP+qcol;
  const bf16*Kh=K+rowbase*KP+kcol,*Vh=V+rowbase*VP+vcol;
  const unsigned lds0=(unsigned)(uintptr_t)shm;
  float*wsf=(float*)(shm+LDS_WS)+wid*64;
  const bf16*ksrc=Kh+(long)lane*KP+wid*8;
  const bf16*vsrc=Vh+(long)(16*(wid&3)+(lane>>2))*VP+(wid>>2)*32+(lane&3)*8;
  const unsigned kdst=lds0+LDS_K+wid*1024, vdst=lds0+LDS_V+wid*1024;
  #define DMA_K(t,slot) glds16(ksrc+(long)(t)*KVBLK*KP,(unsigned)__builtin_amdgcn_readfirstlane(kdst+(slot)))
  #define DMA_V(t,slot) glds16(vsrc+(long)(t)*KVBLK*VP,(unsigned)__builtin_amdgcn_readfirstlane(vdst+(slot)))
  const int vb0=(int)(lds0+LDS_V)+((lane>>4)&1)*32+(lane&3)*8+(4*hi+((lane&15)>>2))*64;
  const char*Kbase=shm+LDS_K; bf16x8 kf[8];
  const lds_cptr shm3=(lds_cptr)shm; const lds_cptr kp0=shm3+LDS_K+hi*1024+r32*16; const lds_cptr vp0=shm3+LDS_V+((lane>>4)&1)*32+(lane&3)*8+(4*hi+((lane&15)>>2))*64;
  const int NT=(q0+QB)/KVBLK;
  DMA_K(0,0);DMA_V(0,0);DMA_K(1,SLOTB);
  bf16x8 qr[4];
  #pragma unroll
  for(int d0=0;d0<4;++d0)qr[d0]=*reinterpret_cast<const bf16x8*>(&Qw[(long)r32*QP+d0*16+hi*8]);
  float mhat=0.f,l_reg=0.f;f32x16 o[2];o[0]=f32x16{};o[1]=f32x16{};f32x16 negm=f32x16{};asm volatile("":"+v"(negm));
  const int qrel=wid*QBLK+r32;
  #define CMASK(P0,P1,t) do{int jb_=(t)-(NT-4); if(jb_>=0)cmask(P0,P1,jb_,qrel,hi);}while(0)
  bool resc=false;
  #define START(P0,P1) do{ const float rm=rowmax(P0,P1); resc=false; \
    { const float dl=rm; mhat=fadd_s(mhat,dl); \
      _Pragma("unroll") for(int r=0;r<16;++r){P0[r]=fsub_s(P0[r],dl);P1[r]=fsub_s(P1[r],dl);} \
      _Pragma("unroll") for(int r=0;r<16;++r)negm[r]=-mhat; asm volatile("":"+v"(negm)); } \
    _Pragma("unroll") for(int r=0;r<16;++r)P0[r]=__builtin_amdgcn_exp2f(P0[r]); }while(0)
  #define RESC() do{ if(resc){ asm volatile("s_waitcnt lgkmcnt(0)":::"memory"); \
      _Pragma("unroll") for(int d_=0;d_<2;++d_) _Pragma("unroll") for(int r=0;r<16;++r)o[d_][r]*=wsf[crow(r,hi)]; } }while(0)
  f32x16 pA0,pA1,pB0,pB1;
  int sl_prev=0,sl_cur=0,sl_next=SLOTB;
  #define ROT() do{sl_prev=sl_cur;sl_cur=sl_next;sl_next=(sl_next==(NSLOT-1)*SLOTB)?0:sl_next+SLOTB;}while(0)
  DMA_K(2,2*SLOTB);
  WAIT_BAR(3);
  qkt(pA0,pA1,Kbase,qr,negm,r32,hi);asm volatile("s_nop 15\n\ts_nop 7":"+v"(pA0),"+v"(pA1));CMASK(pA0,pA1,0);
  START(pA0,pA1);
  _Pragma("unroll") for(int r=0;r<16;++r)pA1[r]=__builtin_amdgcn_exp2f(pA1[r]);
  WAIT_BAR(0);
  DMA_K(3,0);DMA_V(1,SLOTB);
  ROT();
  kload8(kf,kp0+sl_cur);
  WAIT_BAR(2);
  s16x4 vlo[8],vhi[8]; u32x4 pw0,pw1,pw2,pw3;
  #define PKW(P,B) cvtpk_s(P[B],P[B+1])
  #define PAF(k) __builtin_bit_cast(bf16x8,pw##k)
  #define VFR(i) (bf16x8){vlo[i][0],vlo[i][1],vlo[i][2],vlo[i][3],vhi[i][0],vhi[i][1],vhi[i][2],vhi[i][3]}
  #define PIN(x) asm volatile("":"+v"(x))
  #define MX3(a,b,c) __builtin_fmaxf(__builtin_fmaxf((a),(b)),(c))
  #define GAPA(MF,A0,A1,A2,A3,W0,W1,PW) do{ MF; sacc+=A0; sacc+=A1; sacc+=A2; sacc+=A3; PIN(sacc); W0; W1; PIN(PW); SBAR(); }while(0)
  #define EX(v) __builtin_amdgcn_exp2f(v)
  #define GAPB(MF,X,B) do{ MF; X[B]=EX(X[B]); X[B+1]=EX(X[B+1]); X[B+2]=EX(X[B+2]); X[B+3]=EX(X[B+3]); PIN(X); SBAR(); }while(0)
  #define VRD(i) do{ vlo[i]=vtr(vp_+(((i)>>2)*4096+((i)&3)*1024)); vhi[i]=vtr(vp_+(((i)>>2)*4096+((i)&3)*1024+512)); }while(0)
  #define KRD(G,j) do{ if(G){ kload2(kf,kp0+sl_next,j); SBAR(); } }while(0)
  #define STEP(C0,C1,P0,P1,t,GK,GV,GL) do{ SBAR(); \
    const lds_cptr vp_=vp0+sl_prev; \
    VRD(0); SBAR(); float sacc=(P0[0]+P0[1]); \
    GAPA(C0=__builtin_amdgcn_mfma_f32_32x32x16_bf16(kf[0],qr[0],negm,0,0,0), P0[2],P0[3],P0[4],P0[5],     pw0[0]=PKW(P0,0), pw0[1]=PKW(P0,2), pw0); \
    VRD(4); SBAR(); GAPA(C1=__builtin_amdgcn_mfma_f32_32x32x16_bf16(kf[1],qr[0],negm,0,0,0), P0[6],P0[7],P0[8],P0[9],     pw0[2]=PKW(P0,4), pw0[3]=PKW(P0,6), pw0); \
    VRD(1); SBAR(); GAPA(C0=__builtin_amdgcn_mfma_f32_32x32x16_bf16(kf[2],qr[1],C0,0,0,0),   P0[10],P0[11],P0[12],P0[13], pw1[0]=PKW(P0,8), pw1[1]=PKW(P0,10), pw1); \
    VRD(5); SBAR(); GAPA(C1=__builtin_amdgcn_mfma_f32_32x32x16_bf16(kf[3],qr[1],C1,0,0,0),   P0[14],P0[15],P1[0],P1[1],   pw1[2]=PKW(P0,12),pw1[3]=PKW(P0,14), pw1); \
    VRD(2); SBAR(); GAPA(C0=__builtin_amdgcn_mfma_f32_32x32x16_bf16(kf[4],qr[2],C0,0,0,0),   P1[2],P1[3],P1[4],P1[5],     pw2[0]=PKW(P1,0), pw2[1]=PKW(P1,2), pw2); \
    VRD(6); SBAR(); GAPA(C1=__builtin_amdgcn_mfma_f32_32x32x16_bf16(kf[5],qr[2],C1,0,0,0),   P1[6],P1[7],P1[8],P1[9],     pw2[2]=PKW(P1,4), pw2[3]=PKW(P1,6), pw2); \
    VRD(3); SBAR(); GAPA(C0=__builtin_amdgcn_mfma_f32_32x32x16_bf16(kf[6],qr[3],C0,0,0,0),   P1[10],P1[11],P1[12],P1[13], pw3[0]=PKW(P1,8), pw3[1]=PKW(P1,10), pw3); \
    VRD(7); SBAR(); GAPA(C1=__builtin_amdgcn_mfma_f32_32x32x16_bf16(kf[7],qr[3],C1,0,0,0),   P1[14],P1[15],0.f,0.f,       pw3[2]=PKW(P1,12),pw3[3]=PKW(P1,14), pw3); \
    l_reg+=sacc; \
    if(GK){DMA_K((t)+3,sl_cur);} if(GV){DMA_V((t)+1,sl_next);} \
    CMASK(C0,C1,t); \
    { float a=MX3(C0[0],C0[1],C1[0]),b=MX3(C0[2],C0[3],C1[1]); a=MX3(a,C1[2],C1[3]); \
      _Pragma("unroll") for(int r=4;r<16;r+=4){a=MX3(a,C0[r],C0[r+1]);b=MX3(b,C0[r+2],C0[r+3]);a=MX3(a,C1[r],C1[r+1]);b=MX3(b,C1[r+2],C1[r+3]);} \
      float rm=__builtin_fmaxf(a,b); { auto rr=__builtin_amdgcn_permlane32_swap(__float_as_uint(rm),__float_as_uint(rm),false,false); rm=__builtin_fmaxf(__uint_as_float(rr[0]),__uint_as_float(rr[1])); } \
      resc=false; \
      if(__builtin_expect(__any(rm>(float)THRL),0)){ const float dl=__builtin_fmaxf(rm,0.f); mhat+=dl; \
        _Pragma("unroll") for(int r=0;r<16;++r){C0[r]-=dl;C1[r]-=dl;} \
        _Pragma("unroll") for(int r=0;r<16;++r)negm[r]=-mhat; asm volatile("":"+v"(negm)); \
        const float f=__builtin_amdgcn_exp2f(-dl); l_reg*=f; if(hi==0)wsf[r32]=f; resc=true; } } \
    SBAR(); \
    GAPB(o[0]=__builtin_amdgcn_mfma_f32_32x32x16_bf16(PAF(0),VFR(0),o[0],0,0,0), C0,0); \
    GAPB(o[1]=__builtin_amdgcn_mfma_f32_32x32x16_bf16(PAF(0),VFR(4),o[1],0,0,0), C0,4); \
    KRD(GL,0); GAPB(o[0]=__builtin_amdgcn_mfma_f32_32x32x16_bf16(PAF(1),VFR(1),o[0],0,0,0), C0,8); \
    KRD(GL,1); GAPB(o[1]=__builtin_amdgcn_mfma_f32_32x32x16_bf16(PAF(1),VFR(5),o[1],0,0,0), C0,12); \
    KRD(GL,2); GAPB(o[0]=__builtin_amdgcn_mfma_f32_32x32x16_bf16(PAF(2),VFR(2),o[0],0,0,0), C1,0); \
    KRD(GL,3); GAPB(o[1]=__builtin_amdgcn_mfma_f32_32x32x16_bf16(PAF(2),VFR(6),o[1],0,0,0), C1,4); \
    GAPB(o[0]=__builtin_amdgcn_mfma_f32_32x32x16_bf16(PAF(3),VFR(3),o[0],0,0,0), C1,8); \
    GAPB(o[1]=__builtin_amdgcn_mfma_f32_32x32x16_bf16(PAF(3),VFR(7),o[1],0,0,0), C1,12); \
    }while(0)
  int t=1;
  #undef CMASK
  #define CMASK(P0,P1,t) do{}while(0)
  for(;t+5<NT;t+=2){
    STEP(pB0,pB1,pA0,pA1,t,true,true,true);     WAIT_BAR(2); RESC(); ROT();
    STEP(pA0,pA1,pB0,pB1,t+1,true,true,true);   WAIT_BAR(2); RESC(); ROT();
  }
  #undef CMASK
  #define CMASK(P0,P1,t) do{int jb_=(t)-(NT-4); if(jb_>=0)cmask(P0,P1,jb_,qrel,hi);}while(0)
  #define ENDW(tt) do{ if((tt)+3<NT){WAIT_BAR(2);} else if((tt)+2<NT){WAIT_BAR(1);} else {WAIT_BAR(0);} }while(0)
  for(;t+1<NT;t+=2){
    STEP(pB0,pB1,pA0,pA1,t,(t+3<NT),(t+1<NT),(t+1<NT));       ENDW(t);   RESC(); ROT();
    STEP(pA0,pA1,pB0,pB1,t+1,(t+4<NT),(t+2<NT),(t+2<NT));     ENDW(t+1); RESC(); ROT();
  }
  STEP(pB0,pB1,pA0,pA1,NT-1,false,false,false); RESC();
  { float sacc=pB0[0]+pB0[1]; _Pragma("unroll") for(int r=2;r<16;++r)sacc+=pB0[r]; _Pragma("unroll") for(int r=0;r<16;++r)sacc+=pB1[r]; l_reg+=sacc;
    pw0=(u32x4){PKW(pB0,0),PKW(pB0,2),PKW(pB0,4),PKW(pB0,6)};pw1=(u32x4){PKW(pB0,8),PKW(pB0,10),PKW(pB0,12),PKW(pB0,14)};pw2=(u32x4){PKW(pB1,0),PKW(pB1,2),PKW(pB1,4),PKW(pB1,6)};pw3=(u32x4){PKW(pB1,8),PKW(pB1,10),PKW(pB1,12),PKW(pB1,14)};
    SBAR(); pv(o,vb0+sl_cur,PAF(0),PAF(1),PAF(2),PAF(3)); }
  #undef PKW
  #undef PAF
  #undef VFR
  #undef PIN
  #undef MX3
  #undef GAPA
  #undef GAPB
  #undef EX
  #undef VRD
  #undef KRD
  #undef STEP
  #undef ENDW
  {auto rr=__builtin_amdgcn_permlane32_swap(__float_as_uint(l_reg),__float_as_uint(l_reg),false,false);l_reg=__uint_as_float(rr[0])+__uint_as_float(rr[1]);}
  if(hi==0)wsf[32+r32]=l_reg;asm volatile("s_waitcnt lgkmcnt(0)":::"memory");
  float rli[16];
  #pragma unroll
  for(int r=0;r<16;++r)rli[r]=__builtin_amdgcn_rcpf(wsf[32+crow(r,hi)]);
  bf16*Ow=O+(rowbase+q0+wid*QBLK)*OP+ocol;
  { bf16*stg=(bf16*)(shm+LDS_OST)+wid*2048;
    #pragma unroll
    for(int r=0;r<16;++r){const int orow=crow(r,hi);
      #pragma unroll
      for(int d0=0;d0<2;++d0)stg[orow*64+d0*32+r32]=__float2bfloat16(o[d0][r]*rli[r]);}
    asm volatile("s_waitcnt lgkmcnt(0)":::"memory");
    #pragma unroll
    for(int i=0;i<4;++i){const int row=i*8+(lane>>3),ch=lane&7; const u32x4 v=*(const u32x4*)(stg+row*64+ch*8); ATTN_STORE16(Ow+(long)row*OP+ch*8,v);} }
  asm volatile("s_waitcnt lgkmcnt(0)\n\ts_barrier":::"memory");
  #undef DMA_K
  #undef DMA_V
  #undef CMASK
  #undef START
  #undef RESC
  #undef ROT
}
constexpr int ATTN_LDS_BYTES=LDS_BYTES;
struct AttnTensors { const bf16* Q; const bf16* K; const bf16* V; bf16* O; };
struct AttnUnit { int bh; int qb; };
struct QueueOrder {
  unsigned* ctr; volatile __attribute__((address_space(3))) unsigned* slot; int wid;
  __device__ __forceinline__ bool next(int,AttnUnit&u)const{
    if(wid==0&&lane_id_v()==0){ const unsigned n=__hip_atomic_fetch_add(ctr,1u,__ATOMIC_RELAXED,__HIP_MEMORY_SCOPE_AGENT); slot[0]=n; }
    asm volatile("s_waitcnt vmcnt(0) lgkmcnt(0)\n\ts_barrier":::"memory");
    const unsigned n=slot[0];
    asm volatile("s_waitcnt lgkmcnt(0)\n\ts_barrier":::"memory");
    if(n>=(unsigned)(BATCH*NHEAD*NQB))return false;
    u.qb=NQB-1-(int)(n/(BATCH*NHEAD)); u.bh=(int)(n%(BATCH*NHEAD)); return true; }
  __device__ __forceinline__ void a_ready(const AttnUnit&)const{}
  __device__ __forceinline__ void done(const AttnUnit&)const{}
};
template<class Sched,int THRL=8> __device__ __forceinline__ void attn_phase(char*lds,const AttnTensors&T,const Sched&S,const int wid){
  AttnUnit u;
  for(int i=0;S.next(i,u);++i){ S.a_ready(u); attn_unit<THRL>(u.bh/NHEAD,u.bh%NHEAD,u.qb,T.Q,T.K,T.V,T.O,lds,wid); S.done(u); }
}
#undef SBAR
#undef WAIT_BAR
}
constexpr int NWAVES = 8;
#ifndef MK_N_LAUNCHES
#define MK_N_LAUNCHES 1
#endif
constexpr int N_PHASES = 13;
constexpr int N_LAUNCHES = MK_N_LAUNCHES;
static_assert(N_LAUNCHES == 1 || N_LAUNCHES == N_PHASES, "MK_N_LAUNCHES is 1 or 13");

constexpr int BATCH = 8, T = 4096, D = 1024, M = BATCH * T;
constexpr int IN_COLS = 3328, RWC = 1792, NEXP = 32, TOPK = 4, NMOD = 6 * D;
constexpr int MAXROWS = M * TOPK + NEXP * 256;
constexpr int MOD_KS = 8;

constexpr size_t MiB = 1u << 20, KiB = 1u << 10;
constexpr size_t WS_CTL = 0, CTL_ZERO_BYTES = 1 * MiB;
constexpr size_t WS_MODP = 1 * MiB;
constexpr size_t WS_MOD = 2 * MiB + 512 * KiB;
constexpr size_t WS_ROPE = 3 * MiB;
constexpr size_t WS_WIN = 5 * MiB;
constexpr size_t WS_WOUT = 12 * MiB;
constexpr size_t WS_BLORA = 14 * MiB;
constexpr size_t WS_TOKE = 15 * MiB, WS_TOKG = 15 * MiB + 512 * KiB;
constexpr size_t WS_TOKROW = 16 * MiB, WS_ROWTOK = 16 * MiB + 512 * KiB, WS_ROWGATE = 17 * MiB + 256 * KiB, WS_BLKBASE = 18 * MiB;
constexpr size_t WS_W1 = 20 * MiB, WS_W2 = 148 * MiB;
constexpr size_t WS_H2 = 212 * MiB;
constexpr size_t WS_H = 276 * MiB, WS_Q = 340 * MiB, WS_K = 372 * MiB, WS_V = 404 * MiB, WS_RW = 436 * MiB;
constexpr size_t WS_O = 548 * MiB, WS_YCAT = 612 * MiB, WS_LACT = 676 * MiB;
constexpr size_t WS_LW = 692 * MiB, WS_AS = 756 * MiB, WS_G = 820 * MiB, WS_Y = 884 * MiB;
constexpr size_t WS_ACT = 276 * MiB, WS_Y2 = 548 * MiB, WS_END = 948 * MiB;
static_assert(WS_ROWTOK + (size_t)MAXROWS * 4 <= WS_ROWGATE && WS_ROWGATE + (size_t)MAXROWS * 4 <= WS_BLKBASE && WS_ACT + (size_t)MAXROWS * 2048 <= WS_Y2 && WS_Y2 + (size_t)MAXROWS * 2048 <= WS_Y, "d_ws map");
constexpr int CW_TMO = 0, CW_CODE = 1;
constexpr int CW_BAR = 4096;
constexpr int CW_ATTQ = 8192;
constexpr int CW_ECNT = 12288;
static_assert((CW_ECNT + 64 * NEXP) * 4 <= (int)CTL_ZERO_BYTES, "CTL words inside the memset region");

constexpr int RING_OFF = 0, RING_BYTES = 131072;
constexpr int LDSCTL_OFF = RING_BYTES, MISC_OFF = LDSCTL_OFF + 320;
constexpr int LDS_BYTES = 147456;
static_assert(MISC_OFF + 128 <= LDS_BYTES, "LDS map");
#define GAS __attribute__((address_space(1)))
#define LAS __attribute__((address_space(3)))
typedef unsigned short bf16;
typedef unsigned v4u __attribute__((ext_vector_type(4)));
typedef float f32x4 __attribute__((ext_vector_type(4)));
typedef short bf16x8 __attribute__((ext_vector_type(8)));
typedef GAS unsigned gu32;
typedef GAS unsigned long long gu64;
#define RLX_AGENT __ATOMIC_RELAXED, __HIP_MEMORY_SCOPE_AGENT
#define LDS_WAIT() asm volatile("s_waitcnt lgkmcnt(0)" ::: "memory")
#define VM_WAIT() asm volatile("s_waitcnt vmcnt(0)" ::: "memory")
__device__ __forceinline__ unsigned long long rt() { return __builtin_amdgcn_s_memrealtime(); }
__device__ __forceinline__ unsigned f2bf(float f) { unsigned u = __builtin_bit_cast(unsigned, f); return (u + 0x7fffu + ((u >> 16) & 1u)) >> 16; }
__device__ __forceinline__ unsigned pk2(float lo, float hi) { return f2bf(lo) | (f2bf(hi) << 16); }

#define XB_TMO      128
#define XB_XCNT(j)  (256  + 64 * (j))
#define XB_XSUB(j)  (1280 + 64 * (j))
#define XB_XGEN(j)  (2304 + 64 * (j))
#define XB_TOP      3328
#define XB_TOPGEN   3392
#define XCD_BAR_WORDS 3456
#define XB_SPIN_CAP (1u << 18)

__device__ __forceinline__ unsigned xb_ld(unsigned* p)              { return __hip_atomic_load(p, __ATOMIC_RELAXED, __HIP_MEMORY_SCOPE_AGENT); }
__device__ __forceinline__ unsigned xb_add(unsigned* p, unsigned v) { return __hip_atomic_fetch_add(p, v, __ATOMIC_RELAXED, __HIP_MEMORY_SCOPE_AGENT); }
__device__ __forceinline__ unsigned xb_xcc_id() { return (unsigned)__builtin_amdgcn_s_getreg((3 << 11) | 20) & 0xFu; }
#define XB_SPIN(cond, bar) do { unsigned _sp = 0; while (cond) { __builtin_amdgcn_s_sleep(1); \
    if ((++_sp & 255u) == 0u) { if (xb_ld(&(bar)[XB_TMO])) break; if (_sp > XB_SPIN_CAP) { atomicAdd(&(bar)[XB_TMO], 1u); break; } } } } while (0)

struct XcdBarrier {
    unsigned* bar; unsigned x; int wid;
    volatile LAS unsigned* st;
};

__device__ __forceinline__ XcdBarrier xcd_barrier_post(unsigned* bar, volatile LAS unsigned* st, int wid) {
    XcdBarrier b; b.bar = bar; b.x = xb_xcc_id(); b.st = st; b.wid = wid;
    if (threadIdx.x == 0) (void)xb_add(&bar[XB_XCNT(b.x)], 1u);
    return b;
}
__device__ __forceinline__ void xcd_barrier_complete(unsigned* bar, unsigned x, unsigned& nloc, unsigned& nx) {
    const unsigned G = gridDim.x * gridDim.y * gridDim.z;
    unsigned sum, cnt, mine, sp = 0u;
    for (;;) {
        sum = 0u; cnt = 0u; mine = 0u;
#pragma unroll
        for (unsigned j = 0; j < 16; ++j) { const unsigned c = xb_ld(&bar[XB_XCNT(j)]); sum += c; cnt += (c > 0u) ? 1u : 0u; mine = (j == x) ? c : mine; }
        if (sum == G) break;
        __builtin_amdgcn_s_sleep(1);
        if ((++sp & 255u) == 0u) { if (xb_ld(&bar[XB_TMO])) break; if (sp > XB_SPIN_CAP) { atomicAdd(&bar[XB_TMO], 1u); break; } }
    }
    nloc = mine > 0u ? mine : 1u; nx = cnt > 0u ? cnt : 1u;
}

__device__ __forceinline__ void xcd_barrier(const XcdBarrier& b) {
    asm volatile("s_waitcnt vmcnt(0)" ::: "memory");
    __syncthreads();
    if (b.wid == 0 && lane_id_v() == 0) {
        unsigned* bar = b.bar;
        __builtin_amdgcn_s_waitcnt(0);
        unsigned nloc = b.st[0], nx = b.st[1];
        if (nloc == 0u) { xcd_barrier_complete(bar, b.x, nloc, nx); b.st[0] = nloc; b.st[1] = nx; }
        const unsigned old = xb_add(&bar[XB_XSUB(b.x)], 1u);
        const unsigned gen = old / nloc;
        if (old + 1u == (gen + 1u) * nloc) {
            __builtin_amdgcn_fence(__ATOMIC_RELEASE, "agent");
            asm volatile("s_waitcnt vmcnt(0)" ::: "memory");
            const unsigned og = xb_add(&bar[XB_TOP], 1u);
            const unsigned tg = og / nx;
            if (og + 1u == (tg + 1u) * nx) xb_add(&bar[XB_TOPGEN], 1u);
            else XB_SPIN(xb_ld(&bar[XB_TOPGEN]) == tg, bar);
            __builtin_amdgcn_fence(__ATOMIC_ACQUIRE, "agent");
            xb_add(&bar[XB_XGEN(b.x)], 1u);
            asm volatile("s_waitcnt vmcnt(0)" ::: "memory");
        } else {
            XB_SPIN(xb_ld(&bar[XB_XGEN(b.x)]) == gen, bar);
            __builtin_amdgcn_fence(__ATOMIC_ACQUIRE, "agent");
            asm volatile("s_waitcnt vmcnt(0)" ::: "memory");
        }
    }
    __syncthreads();
}
typedef float f32x2 __attribute__((ext_vector_type(2)));
typedef unsigned u32x2 __attribute__((ext_vector_type(2)));
struct Frame {
    LAS unsigned char* lds;
    volatile LAS unsigned* MISC;
    gu32* ctl;
    int wave;
    int vcu, G;
    unsigned char* ws; float* out;
};
struct Args { const void* in[33]; float* out; unsigned char* ws; int ph_lo, ph_hi, li, pad; };

__device__ __forceinline__ float wave_sum(float v) {
#pragma unroll
    for (int o = 1; o < 64; o <<= 1) v += __shfl_xor(v, o);
    return v;
}
__device__ __forceinline__ float bf2f(unsigned short u) { return __uint_as_float((unsigned)u << 16); }
__device__ __forceinline__ float bflo(unsigned u) { return __uint_as_float(u << 16); }
__device__ __forceinline__ float bfhi(unsigned u) { return __uint_as_float(u & 0xffff0000u); }
typedef float f32x2_t __attribute__((ext_vector_type(2))); typedef __bf16 bf16x2_t __attribute__((ext_vector_type(2)));
__device__ __forceinline__ unsigned pkbf(float lo, float hi) { f32x2_t v = {lo, hi}; bf16x2_t b = __builtin_convertvector(v, bf16x2_t); return __builtin_bit_cast(unsigned, b); }
#define DPP_ADD(x, ctrl) ((x) + __builtin_bit_cast(float, __builtin_amdgcn_update_dpp(0, __builtin_bit_cast(int, (x)), (ctrl), 0xF, 0xF, true)))
__device__ __forceinline__ float allsum16(float x) {
    x = DPP_ADD(x, 0xB1); x = DPP_ADD(x, 0x4E); x = DPP_ADD(x, 0x124); x = DPP_ADD(x, 0x128); return x; }

template <bool PERMQ>
__device__ __forceinline__ void p0_transpose_item(const float* W, int K, int N, bf16* WT, LAS float* scr, int item, int lane) {
    const int nblk = N / 32, kb = item / nblk, nb = item % nblk, k0 = 64 * kb, n0 = 32 * nb;
#pragma unroll 8
    for (int i = 0; i < 32; ++i) { const int kk = 2 * i + (lane >> 5); scr[kk * 33 + (lane & 31)] = W[(size_t)(k0 + kk) * N + n0 + (lane & 31)]; }
    LDS_WAIT(); asm volatile("" ::: "memory");
    const int c = lane & 7;
#pragma unroll
    for (int j = 0; j < 4; ++j) { const int n = (lane >> 3) + 8 * j; const LAS float* s = scr + (8 * c) * 33 + n;
        v4u o; o.x = pkbf(s[0 * 33], s[1 * 33]); o.y = pkbf(s[2 * 33], s[3 * 33]); o.z = pkbf(s[4 * 33], s[5 * 33]); o.w = pkbf(s[6 * 33], s[7 * 33]);
        int nn = n0 + n;
        if (PERMQ && nn < 1024) { const int d = nn & 63; if (d < 16) nn = (nn & ~63) + ((d < 8) ? 2 * d : 2 * (d - 8) + 1); }
        *(GAS v4u*)(WT + (size_t)nn * K + k0 + 8 * c) = o; }
    LDS_WAIT(); asm volatile("" ::: "memory");
}
__device__ __forceinline__ void sincos_d(float af, float& s, float& c) {
    const double a = (double)af; const double n = __builtin_rint(a * 0.63661977236758134308);
    double r = __builtin_fma(-n, 1.57079632679489655800e+00, a); r = __builtin_fma(-n, 6.12323399573676603587e-17, r);
    const double r2 = r * r;
    double sp = 1.0 / 6227020800.0; sp = sp * r2 * -1.0 + 1.0 / 39916800.0; sp = -sp * r2 + 1.0 / 362880.0; sp = -sp * r2 + 1.0 / 5040.0; sp = -sp * r2 + 1.0 / 120.0; sp = -sp * r2 + 1.0 / 6.0; sp = r - r * r2 * sp;
    double cp = 1.0 / 87178291200.0; cp = -cp * r2 + 1.0 / 479001600.0; cp = -cp * r2 + 1.0 / 3628800.0; cp = -cp * r2 + 1.0 / 40320.0; cp = -cp * r2 + 1.0 / 720.0; cp = -cp * r2 + 1.0 / 24.0; cp = -cp * r2 + 0.5; cp = 1.0 - r2 * cp;
    const int q = ((int)n) & 3;
    const double sv = (q == 0) ? sp : (q == 1) ? cp : (q == 2) ? -sp : -cp, cv = (q == 0) ? cp : (q == 1) ? -sp : (q == 2) ? -cp : sp;
    s = (float)sv; c = (float)cv;
}
__device__ __forceinline__ void p0_prologue(Frame& F, const Args& A) {
    const int lane = lane_id_v(), tid = F.wave * 64 + lane; (void)tid;
    const int gw = F.vcu * NWAVES + F.wave, NGW = F.G * NWAVES, gt = F.vcu * 512 + tid, NGT = F.G * 512;
    LAS float* scr = (LAS float*)(F.lds + RING_OFF + F.wave * 12288);
    LAS float* sl = (LAS float*)(F.lds + RING_OFF + 98304);
    const float* c = (const float*)A.in[1];
    for (int i = tid; i < 8 * 1024; i += 512) { const float v = c[i]; sl[i] = v / (1.f + __expf(-v)); }
    __syncthreads();
    { const float* aw = (const float*)A.in[3]; float* modp = (float*)(F.ws + WS_MODP);
      for (int it = gw; it < 96 * MOD_KS; it += NGW) { const int cc = it % 96, ks = it / 96, col = cc * 64 + lane;
          float acc[8];
#pragma unroll
          for (int b = 0; b < 8; ++b) acc[b] = 0.f;
          for (int k = ks * 128; k < ks * 128 + 128; ++k) { const float w = aw[(size_t)k * NMOD + col];
#pragma unroll
              for (int b = 0; b < 8; ++b) acc[b] += sl[b * 1024 + k] * w; }
#pragma unroll
          for (int b = 0; b < 8; ++b) modp[(size_t)(ks * 8 + b) * NMOD + col] = acc[b]; } }
    { const int* pos = (const int*)A.in[2]; float* rope = (float*)(F.ws + WS_ROPE);
      for (int idx = gt; idx < M * 8; idx += NGT) { const int m = idx >> 3, i = idx & 7;
          const float invf = (i == 0) ? 1.0f : (i == 1) ? 0.1939227432012558f : (i == 2) ? 0.03760603070259094f : (i == 3) ? 0.007292664609849453f : (i == 4) ? 0.0014142135623842478f : (i == 5) ? 0.00027424818836152554f : (i == 6) ? 5.318296098266728e-05f : 1.0313386155758053e-05f;
          const float ang = (float)pos[m] * invf; float s, cc; sincos_d(ang, s, cc); rope[(size_t)m * 16 + i] = cc; rope[(size_t)m * 16 + 8 + i] = s; } }
    { const float* w2 = (const float*)A.in[18]; const float* a2 = (const float*)A.in[20]; const float* g2 = (const float*)A.in[21]; bf16* bl = (bf16*)(F.ws + WS_BLORA);
      for (int idx = gt; idx < 1536 * 256; idx += NGT) { const int n = idx >> 8, k = idx & 255, blk = n >> 9, nn = n & 511; float v = 0.f;
          if (blk == 0 && k < 64) v = w2[k * 512 + nn]; else if (blk == 1 && k >= 64 && k < 128) v = a2[(k - 64) * 512 + nn]; else if (blk == 2 && k >= 128) v = g2[(k - 128) * 512 + nn];
          bl[idx] = (bf16)(pkbf(v, 0.f) & 0xffffu); } }
    { constexpr int I_IN = (D / 64) * (IN_COLS / 32), I_OUT = (D / 64) * (D / 32), I_W1 = (D / 64) * (2048 / 32), I_W2 = (D / 64) * (D / 32);
      constexpr int NITEMS = I_IN + I_OUT + NEXP * I_W1 + NEXP * I_W2;
      const float* w_in = (const float*)A.in[9]; const float* w_out = (const float*)A.in[10]; const float* w1 = (const float*)A.in[29]; const float* w2m = (const float*)A.in[31];
      for (int it = gw; it < NITEMS; it += NGW) { int r = it;
          if (r < I_IN) { p0_transpose_item<true>(w_in, D, IN_COLS, (bf16*)(F.ws + WS_WIN), scr, r, lane); continue; } r -= I_IN;
          if (r < I_OUT) { p0_transpose_item<false>(w_out, D, D, (bf16*)(F.ws + WS_WOUT), scr, r, lane); continue; } r -= I_OUT;
          if (r < NEXP * I_W1) { const int e = r / I_W1; p0_transpose_item<false>(w1 + (size_t)e * D * 2048, D, 2048, (bf16*)(F.ws + WS_W1) + (size_t)e * 2048 * D, scr, r % I_W1, lane); continue; } r -= NEXP * I_W1;
          { const int e = r / I_W2; p0_transpose_item<false>(w2m + (size_t)e * D * D, D, D, (bf16*)(F.ws + WS_W2) + (size_t)e * D * D, scr, r % I_W2, lane); } } }
}

__device__ __forceinline__ void p1_premix(Frame& F, const Args& A) {
    const int lane = lane_id_v(), tid = F.wave * 64 + lane; (void)tid;
    const float* modp = (const float*)(F.ws + WS_MODP); const float* ada_b = (const float*)A.in[4]; float* mod = (float*)(F.ws + WS_MOD);
    LAS float* ms = (LAS float*)(F.lds + RING_OFF);
    for (int i = tid; i < 8 * 2048; i += 512) { const int b = i >> 11, col = i & 2047; float s = ada_b[col];
#pragma unroll
        for (int ks = 0; ks < MOD_KS; ++ks) s += modp[(size_t)(ks * 8 + b) * NMOD + col];
        ms[i] = s; }
    for (int i = F.vcu * 512 + tid; i < 8 * 4096; i += F.G * 512) { const int b = i >> 12, col = 2048 + (i & 4095); float s = ada_b[col];
#pragma unroll
        for (int ks = 0; ks < MOD_KS; ++ks) s += modp[(size_t)(ks * 8 + b) * NMOD + col];
        mod[(size_t)b * NMOD + col] = s; }
    __syncthreads();
    const float* x = (const float*)A.in[0]; const float* nw = (const float*)A.in[5]; bf16* H = (bf16*)(F.ws + WS_H);
    const int gw = F.vcu * NWAVES + F.wave, NGW = F.G * NWAVES;
    f32x4 w4[4];
#pragma unroll
    for (int j = 0; j < 4; ++j) w4[j] = *((const f32x4*)nw + lane + 64 * j);
    for (int m = gw; m < M; m += NGW) { const int b = m >> 12;
        const GAS f32x4* xr = (const GAS f32x4*)(x + (size_t)m * D) + lane; f32x4 v[4]; float s2 = 0.f;
#pragma unroll
        for (int j = 0; j < 4; ++j) { v[j] = xr[64 * j]; s2 += (v[j].x * v[j].x + v[j].y * v[j].y) + (v[j].z * v[j].z + v[j].w * v[j].w); }
        const float rs = 1.f / sqrtf(wave_sum(s2) * (1.f / D) + 1e-6f);
        GAS u32x2* o8 = (GAS u32x2*)(H + (size_t)m * D) + lane;
#pragma unroll
        for (int j = 0; j < 4; ++j) { const int col = 4 * lane + 256 * j; const f32x4 sh = *(const LAS f32x4*)(ms + b * 2048 + col), sc = *(const LAS f32x4*)(ms + b * 2048 + 1024 + col);
            const f32x4 y = v[j] * rs * w4[j] * (sc + 1.f) + sh; o8[64 * j] = (u32x2){pkbf(y.x, y.y), pkbf(y.z, y.w)}; } }
}

__device__ __forceinline__ void p3_lact(Frame& F, const Args& A) {
    const int lane = lane_id_v(), tid = F.wave * 64 + lane; (void)tid;
    const bf16* RW = (const bf16*)(F.ws + WS_RW); bf16* L = (bf16*)(F.ws + WS_LACT); const float* mu = (const float*)A.in[16] + 1536;
    const int gw = F.vcu * NWAVES + F.wave, NGW = F.G * NWAVES, c0 = 4 * lane;
    const f32x4 mu4 = *(const f32x4*)(mu + c0);
    for (int m = gw; m < M; m += NGW) { const int t = m & (T - 1);
        const u32x2 p = *(const GAS u32x2*)(RW + (size_t)m * RWC + 1536 + c0); u32x2 q = (u32x2){0u, 0u}; if (t > 0) q = *(const GAS u32x2*)(RW + (size_t)(m - 1) * RWC + 1536 + c0);
        f32x4 pv = (f32x4){bflo(p.x), bfhi(p.x), bflo(p.y), bfhi(p.y)}, qv = (f32x4){bflo(q.x), bfhi(q.x), bflo(q.y), bfhi(q.y)};
        f32x4 s = pv + (qv - pv) * mu4;
        if (c0 < 64) { s.x = tanhf(s.x); s.y = tanhf(s.y); s.z = tanhf(s.z); s.w = tanhf(s.w); }
        else if (c0 >= 128) { s.x = 1.f / (1.f + __expf(-s.x)); s.y = 1.f / (1.f + __expf(-s.y)); s.z = 1.f / (1.f + __expf(-s.z)); s.w = 1.f / (1.f + __expf(-s.w)); }
        *(GAS u32x2*)(L + (size_t)m * 256 + c0) = (u32x2){pkbf(s.x, s.y), pkbf(s.z, s.w)}; }
}

constexpr int TB = 32, NSTG = T / TB;
__device__ __forceinline__ void rwkv_scan(Frame& F, const Args& A, int bh) {
    const int b = bh >> 3, h = bh & 7, lane = lane_id_v(), tid = F.wave * 64 + lane;
    LAS float* buf = (LAS float*)(F.lds + RING_OFF);
    LAS float* ybuf = buf + 2 * 6 * TB * 64;
    LAS float* bon = ybuf + TB * 64;
    const bf16* RW = (const bf16*)(F.ws + WS_RW); const float* LW = (const float*)(F.ws + WS_LW); const float* AS = (const float*)(F.ws + WS_AS); const float* G = (const float*)(F.ws + WS_G);
    bf16* YC = (bf16*)(F.ws + WS_YCAT);
    const int tt = tid >> 4, cq = tid & 15, ch = 4 * cq, hc = h * 64 + ch;
    const float* mu = (const float*)A.in[16];
    const f32x4 mu_r = *(const f32x4*)(mu + hc), mu_k = *(const f32x4*)(mu + 512 + hc), mu_v = *(const f32x4*)(mu + 1024 + hc);
    const f32x4 kkc = *(const f32x4*)((const float*)A.in[22] + hc), kac = *(const f32x4*)((const float*)A.in[23] + hc), rkc = *(const f32x4*)((const float*)A.in[24] + hc);
    const f32x4 lnw = *(const f32x4*)((const float*)A.in[25] + hc), lnb = *(const f32x4*)((const float*)A.in[26] + hc);
    const int i0 = F.wave * 8 + (lane >> 4) * 2, j0 = (lane & 15) * 4;
    f32x4 S0 = (f32x4){0.f, 0.f, 0.f, 0.f}, S1 = (f32x4){0.f, 0.f, 0.f, 0.f};
    const size_t mb = (size_t)b * T;
    u32x2 pr, pk, pv, qr, qk, qv; f32x4 lw4, as4, g4;
#define RW_LOAD(s) do { const int t_ = (s) * TB + tt; const size_t m_ = mb + t_; const bf16* row_ = RW + m_ * RWC + hc; \
        pr = *(const GAS u32x2*)(row_); pk = *(const GAS u32x2*)(row_ + 512); pv = *(const GAS u32x2*)(row_ + 1024); \
        if (t_ > 0) { qr = *(const GAS u32x2*)(row_ - RWC); qk = *(const GAS u32x2*)(row_ - RWC + 512); qv = *(const GAS u32x2*)(row_ - RWC + 1024); } else { qr = (u32x2){0u, 0u}; qk = qr; qv = qr; } \
        lw4 = *(const GAS f32x4*)(LW + m_ * 512 + hc); as4 = *(const GAS f32x4*)(AS + m_ * 512 + hc); } while (0)
#define UNPK(p) ((f32x4){bflo((p).x), bfhi((p).x), bflo((p).y), bfhi((p).y)})
#define RW_PREP(s) do { LAS float* B_ = buf + ((s) & 1) * 6 * TB * 64 + tt * 64 + ch; \
        f32x4 r_ = UNPK(pr), k_ = UNPK(pk), v_ = UNPK(pv); { const f32x4 a_ = UNPK(qr), b_ = UNPK(qk), c_ = UNPK(qv); r_ = r_ + (a_ - r_) * mu_r; k_ = k_ + (b_ - k_) * mu_k; v_ = v_ + (c_ - v_) * mu_v; } \
        f32x4 w_; w_.x = __expf(lw4.x); w_.y = __expf(lw4.y); w_.z = __expf(lw4.z); w_.w = __expf(lw4.w); \
        f32x4 kk_ = k_ * kkc; float n2_ = (kk_.x * kk_.x + kk_.y * kk_.y) + (kk_.z * kk_.z + kk_.w * kk_.w); n2_ = allsum16(n2_); \
        kk_ = kk_ * (1.f / fmaxf(sqrtf(n2_), 1e-12f)); \
        const f32x4 km_ = k_ * ((as4 - 1.f) * kac + 1.f); \
        float bn_ = (r_.x * km_.x * rkc.x + r_.y * km_.y * rkc.y) + (r_.z * km_.z * rkc.z + r_.w * km_.w * rkc.w); bn_ = allsum16(bn_); \
        *(LAS f32x4*)(B_ + 0 * TB * 64) = r_; *(LAS f32x4*)(B_ + 1 * TB * 64) = w_; *(LAS f32x4*)(B_ + 2 * TB * 64) = km_; *(LAS f32x4*)(B_ + 3 * TB * 64) = v_; \
        *(LAS f32x4*)(B_ + 4 * TB * 64) = -kk_; *(LAS f32x4*)(B_ + 5 * TB * 64) = kk_ * as4; if (cq == 0) bon[((s) & 1) * TB + tt] = bn_; } while (0)
    RW_LOAD(0); RW_PREP(0);
    __syncthreads();
    for (int s = 0; s < NSTG; ++s) {
        if (s + 1 < NSTG) RW_LOAD(s + 1);
        g4 = *(const GAS f32x4*)(G + (mb + s * TB + tt) * 512 + hc);
        const LAS float* B = buf + (s & 1) * 6 * TB * 64;
#pragma unroll 2
        for (int q = 0; q < TB; ++q) {
            const f32x4 r4 = *(const LAS f32x4*)(B + (0 * TB + q) * 64 + j0), w4 = *(const LAS f32x4*)(B + (1 * TB + q) * 64 + j0), k4 = *(const LAS f32x4*)(B + (2 * TB + q) * 64 + j0);
            const f32x4 da4 = *(const LAS f32x4*)(B + (4 * TB + q) * 64 + j0), db4 = *(const LAS f32x4*)(B + (5 * TB + q) * 64 + j0);
            const f32x2 v2 = *(const LAS f32x2*)(B + (3 * TB + q) * 64 + i0);
            float sa0 = (S0.x * da4.x + S0.y * da4.y) + (S0.z * da4.z + S0.w * da4.w), sa1 = (S1.x * da4.x + S1.y * da4.y) + (S1.z * da4.z + S1.w * da4.w);
            sa0 = allsum16(sa0); sa1 = allsum16(sa1);
            S0 = S0 * w4 + (db4 * sa0 + k4 * v2.x); S1 = S1 * w4 + (db4 * sa1 + k4 * v2.y);
            float y0 = (S0.x * r4.x + S0.y * r4.y) + (S0.z * r4.z + S0.w * r4.w), y1 = (S1.x * r4.x + S1.y * r4.y) + (S1.z * r4.z + S1.w * r4.w);
            y0 = allsum16(y0); y1 = allsum16(y1);
            if ((lane & 15) == 0) *(LAS f32x2*)(ybuf + q * 64 + i0) = (f32x2){y0, y1};
        }
        __syncthreads();
        {
            const f32x4 y4 = *(const LAS f32x4*)(ybuf + tt * 64 + ch); const f32x4 v4 = *(const LAS f32x4*)(B + (3 * TB + tt) * 64 + ch); const float bn = bon[(s & 1) * TB + tt];
            const float mean = allsum16((y4.x + y4.y) + (y4.z + y4.w)) * (1.f / 64.f); const f32x4 d = y4 - mean;
            const float var = allsum16((d.x * d.x + d.y * d.y) + (d.z * d.z + d.w * d.w)) * (1.f / 64.f); const float rs = 1.f / sqrtf(var + 64e-5f);
            const f32x4 o = ((d * rs) * lnw + lnb + v4 * bn) * g4;
            *(GAS u32x2*)(YC + (mb + s * TB + tt) * 1024 + 512 + hc) = (u32x2){pkbf(o.x, o.y), pkbf(o.z, o.w)};
        }
        if (s + 1 < NSTG) RW_PREP(s + 1);
        __syncthreads();
    }
#undef RW_LOAD
#undef RW_PREP
#undef UNPK
}

__device__ __forceinline__ void p6_dacombine(Frame& F, const Args& A) {
    const int lane = lane_id_v(), tid = F.wave * 64 + lane; (void)tid;
    const float* q1 = (const float*)A.in[11]; const float* k1 = (const float*)A.in[12]; const float* q2 = (const float*)A.in[13]; const float* k2 = (const float*)A.in[14];
    const float lam = __expf(wave_sum(q1[lane] * k1[lane])) - __expf(wave_sum(q2[lane] * k2[lane])) + 0.2f;
    const bf16* O = (const bf16*)(F.ws + WS_O); bf16* YC = (bf16*)(F.ws + WS_YCAT);
    const int gw = F.vcu * NWAVES + F.wave, NGW = F.G * NWAVES, dh = lane >> 4, d0 = 8 * (lane & 15);
    const float* sw = (const float*)A.in[15] + d0; const f32x4 swa = *(const f32x4*)sw * 0.8f, swb = *(const f32x4*)(sw + 4) * 0.8f;
    for (int m = gw; m < M; m += NGW) {
        const v4u a = *(const GAS v4u*)(O + (size_t)m * 1024 + dh * 256 + d0), c = *(const GAS v4u*)(O + (size_t)m * 1024 + dh * 256 + 128 + d0);
        f32x4 y0 = (f32x4){bflo(a.x) - lam * bflo(c.x), bfhi(a.x) - lam * bfhi(c.x), bflo(a.y) - lam * bflo(c.y), bfhi(a.y) - lam * bfhi(c.y)};
        f32x4 y1 = (f32x4){bflo(a.z) - lam * bflo(c.z), bfhi(a.z) - lam * bfhi(c.z), bflo(a.w) - lam * bflo(c.w), bfhi(a.w) - lam * bfhi(c.w)};
        float s2 = (y0.x * y0.x + y0.y * y0.y) + (y0.z * y0.z + y0.w * y0.w) + (y1.x * y1.x + y1.y * y1.y) + (y1.z * y1.z + y1.w * y1.w);
        s2 = allsum16(s2); const float rs = 1.f / sqrtf(s2 * (1.f / 128.f) + 1e-5f);
        y0 = y0 * rs * swa; y1 = y1 * rs * swb;
        *(GAS v4u*)(YC + (size_t)m * 1024 + dh * 128 + d0) = (v4u){pkbf(y0.x, y0.y), pkbf(y0.z, y0.w), pkbf(y1.x, y1.y), pkbf(y1.z, y1.w)}; }
}

__device__ __forceinline__ void p8_postmix_router(Frame& F, const Args& A) {
    const int lane = lane_id_v(), tid = F.wave * 64 + lane; (void)tid;
    LAS float* rw = (LAS float*)(F.lds + RING_OFF);
    volatile LAS int* lcnt = (volatile LAS int*)(F.lds + LDSCTL_OFF);
    { const float* r = (const float*)A.in[27]; for (int i = tid; i < 1024 * 32; i += 512) { const int k = i >> 5, e = i & 31; rw[e * 1024 + k] = r[i]; } }
    if (tid < 32) lcnt[tid] = 0;
    __syncthreads();
    const float* x = (const float*)A.in[0]; const bf16* Y = (const bf16*)(F.ws + WS_Y); const float* mod = (const float*)(F.ws + WS_MOD);
    const float* pmn = (const float*)A.in[6]; const float* pfn = (const float*)A.in[7]; const float* rb = (const float*)A.in[28];
    bf16* H2 = (bf16*)(F.ws + WS_H2); int* tokE = (int*)(F.ws + WS_TOKE); float* tokG = (float*)(F.ws + WS_TOKG);
    const int rows_per = M / F.G, mbeg = F.vcu * rows_per;
    const float rbias = rb[lane & 31];
    for (int m = mbeg + F.wave; m < mbeg + rows_per; m += NWAVES) { const int b = m >> 12; const float* mb_ = mod + (size_t)b * NMOD;
        f32x4 xv[4]; float s2 = 0.f; f32x4 yv[4];
#pragma unroll
        for (int j = 0; j < 4; ++j) { const u32x2 p = *((const GAS u32x2*)(Y + (size_t)m * D) + lane + 64 * j); yv[j] = (f32x4){bflo(p.x), bfhi(p.x), bflo(p.y), bfhi(p.y)};
            s2 += (yv[j].x * yv[j].x + yv[j].y * yv[j].y) + (yv[j].z * yv[j].z + yv[j].w * yv[j].w); xv[j] = *((const GAS f32x4*)(x + (size_t)m * D) + lane + 64 * j); }
        const float rs = 1.f / sqrtf(wave_sum(s2) * (1.f / D) + 1e-6f); float t2 = 0.f;
#pragma unroll
        for (int j = 0; j < 4; ++j) { const int col = 4 * lane + 256 * j; const f32x4 w = *(const f32x4*)(pmn + col), g = *(const f32x4*)(mb_ + 2048 + col);
            xv[j] = xv[j] + g * (yv[j] * rs * w); *((GAS f32x4*)(F.out + (size_t)m * D) + lane + 64 * j) = xv[j];
            t2 += (xv[j].x * xv[j].x + xv[j].y * xv[j].y) + (xv[j].z * xv[j].z + xv[j].w * xv[j].w); }
        const float rs2 = 1.f / sqrtf(wave_sum(t2) * (1.f / D) + 1e-6f);
#pragma unroll
        for (int j = 0; j < 4; ++j) { const int col = 4 * lane + 256 * j; const f32x4 w = *(const f32x4*)(pfn + col), sh = *(const f32x4*)(mb_ + 3072 + col), sc = *(const f32x4*)(mb_ + 4096 + col);
            xv[j] = xv[j] * rs2 * w * (sc + 1.f) + sh; *((GAS u32x2*)(H2 + (size_t)m * D) + lane + 64 * j) = (u32x2){pkbf(xv[j].x, xv[j].y), pkbf(xv[j].z, xv[j].w)}; }
        float mine = 0.f;
#pragma unroll 4
        for (int e = 0; e < 32; ++e) { float a = 0.f;
#pragma unroll
            for (int j = 0; j < 4; ++j) { const f32x4 w = *(const LAS f32x4*)(rw + e * 1024 + 4 * lane + 256 * j); a += (xv[j].x * w.x + xv[j].y * w.y) + (xv[j].z * w.z + xv[j].w * w.w); }
            a = wave_sum(a); if ((lane & 31) == e) mine = a; }
        mine += rbias;
        float tv[4]; int ti[4];
#pragma unroll
        for (int k = 0; k < 4; ++k) { float bv = mine; int bi = lane & 31;
#pragma unroll
            for (int o = 1; o < 32; o <<= 1) { const float ov = __shfl_xor(bv, o); const int oi = __shfl_xor(bi, o); if (ov > bv || (ov == bv && oi < bi)) { bv = ov; bi = oi; } }
            tv[k] = bv; ti[k] = bi; if ((lane & 31) == bi) mine = -INFINITY; }
        float ew[4], es = 0.f;
#pragma unroll
        for (int k = 0; k < 4; ++k) { ew[k] = __expf(tv[k] - tv[0]); es += ew[k]; }
        if (lane < 4) { const int e = ti[lane == 0 ? 0 : lane == 1 ? 1 : lane == 2 ? 2 : 3]; const float g = (lane == 0 ? ew[0] : lane == 1 ? ew[1] : lane == 2 ? ew[2] : ew[3]) / es;
            const int pos = __hip_atomic_fetch_add((LAS int*)lcnt + e, 1, __ATOMIC_RELAXED, __HIP_MEMORY_SCOPE_WORKGROUP);
            tokE[(size_t)m * 4 + lane] = e | (pos << 8); tokG[(size_t)m * 4 + lane] = g; }
    }
    __syncthreads();
    if (tid < 32) { const int n = lcnt[tid]; int base = 0; if (n > 0) base = (int)__hip_atomic_fetch_add(F.ctl + CW_ECNT + 64 * tid, (unsigned)n, __ATOMIC_RELAXED, __HIP_MEMORY_SCOPE_AGENT);
        ((int*)(F.ws + WS_BLKBASE))[F.vcu * 32 + tid] = base; }
}

__device__ __forceinline__ void moe_tables(Frame& F) {
    const int lane = lane_id_v(), tid = F.wave * 64 + lane; (void)tid;
    volatile LAS int* ts = (volatile LAS int*)(F.lds + LDSCTL_OFF);
    if (tid < 32) ts[40 + tid] = (int)__hip_atomic_load(F.ctl + CW_ECNT + 64 * tid, __ATOMIC_RELAXED, __HIP_MEMORY_SCOPE_AGENT);
    __syncthreads();
    if (tid == 0) { int acc = 0; for (int e = 0; e < 32; ++e) { ts[e] = acc; acc += (ts[40 + e] + 255) >> 8; } ts[32] = acc; }
    __syncthreads();
}
__device__ __forceinline__ void p9_rows(Frame& F) {
    const int lane = lane_id_v(), tid = F.wave * 64 + lane; (void)tid;
    moe_tables(F);
    volatile LAS int* ts = (volatile LAS int*)(F.lds + LDSCTL_OFF);
    const int* tokE = (const int*)(F.ws + WS_TOKE); const float* tokG = (const float*)(F.ws + WS_TOKG); const int* blkbase = (const int*)(F.ws + WS_BLKBASE) + F.vcu * 32;
    int* tokrow = (int*)(F.ws + WS_TOKROW); int* rowtok = (int*)(F.ws + WS_ROWTOK); float* rowgate = (float*)(F.ws + WS_ROWGATE);
    const int rows_per = M / F.G, mbeg = F.vcu * rows_per;
    for (int i = tid; i < rows_per * 4; i += 512) { const int idx = mbeg * 4 + i; const int pe = tokE[idx], e = pe & 255, pos = pe >> 8; const int row = ts[e] * 256 + blkbase[e] + pos;
        tokrow[idx] = row; rowtok[row] = idx >> 2; rowgate[row] = tokG[idx]; }
    for (int e = F.vcu; e < 32; e += F.G) { const int n = ts[40 + e]; const int r0 = ts[e] * 256 + n, r1 = ts[e + 1] * 256;
        for (int r = r0 + tid; r < r1; r += 512) { rowtok[r] = 0; rowgate[r] = 0.f; } }
}

__device__ __forceinline__ void p12_final(Frame& F, const Args& A) {
    const int lane = lane_id_v(), tid = F.wave * 64 + lane; (void)tid;
    const bf16* Y2 = (const bf16*)(F.ws + WS_Y2); const int* tokrow = (const int*)(F.ws + WS_TOKROW); const float* mod = (const float*)(F.ws + WS_MOD); const float* pn = (const float*)A.in[8];
    const int gw = F.vcu * NWAVES + F.wave, NGW = F.G * NWAVES;
    for (int m = gw; m < M; m += NGW) { const int b = m >> 12; const float* mb_ = mod + (size_t)b * NMOD + 5120;
        int rows[4];
#pragma unroll
        for (int k = 0; k < 4; ++k) rows[k] = tokrow[(size_t)m * 4 + k];
        f32x4 a[4]; float s2 = 0.f;
#pragma unroll
        for (int j = 0; j < 4; ++j) { a[j] = (f32x4){0.f, 0.f, 0.f, 0.f};
#pragma unroll
            for (int k = 0; k < 4; ++k) { const u32x2 p = *((const GAS u32x2*)(Y2 + (size_t)rows[k] * D) + lane + 64 * j); a[j] = a[j] + (f32x4){bflo(p.x), bfhi(p.x), bflo(p.y), bfhi(p.y)}; }
            s2 += (a[j].x * a[j].x + a[j].y * a[j].y) + (a[j].z * a[j].z + a[j].w * a[j].w); }
        const float rs = 1.f / sqrtf(wave_sum(s2) * (1.f / D) + 1e-6f);
#pragma unroll
        for (int j = 0; j < 4; ++j) { const int col = 4 * lane + 256 * j; const f32x4 w = *(const f32x4*)(pn + col), g = *(const f32x4*)(mb_ + col);
            GAS f32x4* o = (GAS f32x4*)(F.out + (size_t)m * D) + lane + 64 * j; *o = *o + g * (a[j] * rs * w); } }
}
__global__ void __launch_bounds__(NWAVES * 64, 2) hybrid_fwd(Args args) {
    extern __shared__ __attribute__((aligned(16))) unsigned char lds[];
    Frame F;
    F.lds = (LAS unsigned char*)lds;
    F.MISC = (volatile LAS unsigned*)(F.lds + MISC_OFF);
    F.wave = __builtin_amdgcn_readfirstlane((int)threadIdx.x >> 6);
    F.G = gridDim.x; { const int bx = blockIdx.x; F.vcu = (F.G % 8 == 0) ? (bx % 8) * (F.G / 8) + bx / 8 : bx; }
    F.ws = args.ws; F.out = args.out;
    unsigned char* ws = args.ws;
    F.ctl = (gu32*)(ws + WS_CTL);
#define GRID_BAR(seam) do { if (N_LAUNCHES != 1) { if (F.wave == 0 && lane_id_v() == 0) __hip_atomic_store(F.ctl + CW_TMO, 0xBADBA0u | (unsigned)(seam), RLX_AGENT); } else { xcd_barrier(bar); } } while (0)
    for (int u = threadIdx.x; u < (LDS_BYTES - LDSCTL_OFF) / 4; u += NWAVES * 64) ((LAS unsigned*)(F.lds + LDSCTL_OFF))[u] = 0u;
    __syncthreads();
    XcdBarrier bar; bar.bar = (unsigned*)(F.ctl + CW_BAR); bar.x = 0; bar.st = nullptr; bar.wid = F.wave;
    if (N_LAUNCHES == 1) bar = xcd_barrier_post((unsigned*)(F.ctl + CW_BAR), F.MISC + 8, F.wave);
    const int lo = args.ph_lo, hi = args.ph_hi;
#define IN(k) (lo <= (k) && (k) < hi)
#define BOTH(k) (IN(k) && IN((k) + 1))
    bf16* const H = (bf16*)(ws + WS_H); bf16* const H2 = (bf16*)(ws + WS_H2);

    if (IN(0)) { p0_prologue(F, args); if (BOTH(0)) GRID_BAR(0); }
    if (IN(1)) { p1_premix(F, args); if (BOTH(1)) GRID_BAR(1); }
    if (IN(2)) {
        pg8::Gemm g{H, (const bf16*)(ws + WS_WIN), M, IN_COLS, D, 0, nullptr}; pg8::StaticOrder S; S.init(M, IN_COLS, F.G, (int)blockIdx.x);
        pg8::EpiProj E{(bf16*)(ws + WS_Q), (bf16*)(ws + WS_K), (bf16*)(ws + WS_V), (bf16*)(ws + WS_RW), (const float*)(ws + WS_ROPE), attn_body::C2};
        pg8::gemm_phase<pg8::EpiProj, pg8::StaticOrder, true, true, false>(F.lds + RING_OFF, g, S, E, F.wave);
        if (BOTH(2)) GRID_BAR(2);
    }
    if (IN(3)) { p3_lact(F, args); if (BOTH(3)) GRID_BAR(3); }
    if (IN(4)) {
        pg8::Gemm g{(const bf16*)(ws + WS_LACT), (const bf16*)(ws + WS_BLORA), M, 1536, 256, 0, nullptr}; pg8::StaticOrder S; S.init(M, 1536, F.G, (int)blockIdx.x);
        pg8::EpiLora E{(float*)(ws + WS_LW), (size_t)(WS_AS - WS_LW) / 4, (const float*)args.in[17], (const float*)args.in[19]}; static_assert(WS_G - WS_AS == WS_AS - WS_LW, "LW | AS | G equally spaced");
        pg8::gemm_phase<pg8::EpiLora, pg8::StaticOrder, true, true, false>(F.lds + RING_OFF, g, S, E, F.wave);
        if (BOTH(4)) GRID_BAR(4);
    }
    if (IN(5)) {
        for (int bh = blockIdx.x; bh < BATCH * 8; bh += F.G) rwkv_scan(F, args, bh);
        static_assert(attn_body::ATTN_LDS_BYTES <= RING_BYTES, "attention body geometry vs frame");
        const attn_body::AttnTensors AT{(const attn_body::bf16*)(ws + WS_Q), (const attn_body::bf16*)(ws + WS_K), (const attn_body::bf16*)(ws + WS_V), (attn_body::bf16*)(ws + WS_O)};
        const attn_body::QueueOrder S{(unsigned*)(F.ctl + CW_ATTQ), F.MISC + 12, F.wave};
        attn_body::attn_phase<attn_body::QueueOrder>((char*)lds + RING_OFF, AT, S, F.wave);
        if (BOTH(5)) GRID_BAR(5);
    }
    if (IN(6)) { p6_dacombine(F, args); if (BOTH(6)) GRID_BAR(6); }
    if (IN(7)) {
        pg8::Gemm g{(const bf16*)(ws + WS_YCAT), (const bf16*)(ws + WS_WOUT), M, D, D, 0, nullptr}; pg8::StaticOrder S; S.init(M, D, F.G, (int)blockIdx.x);
        pg8::EpiPlain E{(bf16*)(ws + WS_Y), D};
        pg8::gemm_phase<pg8::EpiPlain, pg8::StaticOrder, true, true, false>(F.lds + RING_OFF, g, S, E, F.wave);
        if (BOTH(7)) GRID_BAR(7);
    }
    if (IN(8)) { p8_postmix_router(F, args); if (BOTH(8)) GRID_BAR(8); }
    if (IN(9)) { p9_rows(F); if (BOTH(9)) GRID_BAR(9); }
    if (IN(10)) {
        moe_tables(F);
        const LAS int* ts = (const LAS int*)(F.lds + LDSCTL_OFF);
        pg8::Gemm g{H2, (const bf16*)(ws + WS_W1), MAXROWS, 2048, D, (size_t)2048 * D * 2, (const int*)(ws + WS_ROWTOK)};
        pg8::MoeOrder S{ts[32], 8, 4, F.G, F.vcu, ts};
        pg8::EpiSwiglu E{(bf16*)(ws + WS_ACT), (const float*)args.in[30]};
        pg8::gemm_phase<pg8::EpiSwiglu, pg8::MoeOrder, true, true, true>(F.lds + RING_OFF, g, S, E, F.wave);
        if (BOTH(10)) GRID_BAR(10);
    }
    if (IN(11)) {
        moe_tables(F);
        const LAS int* ts = (const LAS int*)(F.lds + LDSCTL_OFF);
        pg8::Gemm g{(const bf16*)(ws + WS_ACT), (const bf16*)(ws + WS_W2), MAXROWS, D, D, (size_t)D * D * 2, nullptr};
        pg8::MoeOrder S{ts[32], 4, 8, F.G, F.vcu, ts};
        pg8::EpiMoe2 E{(bf16*)(ws + WS_Y2), (const float*)args.in[32], (const float*)(ws + WS_ROWGATE)};
        pg8::gemm_phase<pg8::EpiMoe2, pg8::MoeOrder, true, true, false>(F.lds + RING_OFF, g, S, E, F.wave);
        if (BOTH(11)) GRID_BAR(11);
    }
    if (IN(12)) { p12_final(F, args); }
#undef IN
#undef BOTH
}

extern "C" void kernel_launch(void* const* d_in, const int* in_sizes, int n_in, void* d_out, int out_size, void* d_ws, size_t ws_size, hipStream_t stream) {
    static int grid = 0;
    if (grid == 0) {
        if (n_in != 33 || in_sizes[0] != M * D || out_size != M * D || ws_size < WS_END) { fprintf(stderr, "kernel_launch: built for 33 inputs, x and out of %d floats, >= %zu bytes of workspace; got n_in %d, in0 %d, out %d, ws %zu; nothing launched\n", M * D, (size_t)WS_END, n_in, n_in > 0 ? in_sizes[0] : -1, out_size, ws_size); grid = -1; return; }
        int dev = 0, cus = 0, per_cu = 0;
        if (hipGetDevice(&dev) != hipSuccess || hipDeviceGetAttribute(&cus, hipDeviceAttributeMultiprocessorCount, dev) != hipSuccess) { fprintf(stderr, "kernel_launch: hipGetDevice / hipDeviceGetAttribute failed; nothing launched\n"); grid = -1; return; }
        if (hipFuncSetAttribute((const void*)hybrid_fwd, hipFuncAttributeMaxDynamicSharedMemorySize, LDS_BYTES) != hipSuccess) { fprintf(stderr, "kernel_launch: hipFuncSetAttribute failed; nothing launched\n"); grid = -1; return; }
        if (hipOccupancyMaxActiveBlocksPerMultiprocessor(&per_cu, (const void*)hybrid_fwd, NWAVES * 64, LDS_BYTES) != hipSuccess || per_cu < 1)
            fprintf(stderr, "kernel_launch: note: the occupancy query reports %d workgroups per CU\n", per_cu);
        (void)hipGetLastError();
        grid = (cus >= 256) ? 256 : (cus / 32) * 32;
        if (grid != 256) fprintf(stderr, "kernel_launch: launching %d workgroups (built and checked for 256)\n", grid);
    }
    if (grid <= 0) return;
    if (hipMemsetAsync((char*)d_ws + WS_CTL, 0, CTL_ZERO_BYTES, stream) != hipSuccess) { fprintf(stderr, "kernel_launch: hipMemsetAsync of the control words failed; nothing launched\n"); return; }
    Args a{};
    for (int i = 0; i < 33; ++i) a.in[i] = d_in[i];
    a.out = (float*)d_out; a.ws = (unsigned char*)d_ws;
    for (int li = 0; li < N_LAUNCHES; ++li) {
        a.ph_lo = (N_LAUNCHES == 1) ? 0 : li; a.ph_hi = (N_LAUNCHES == 1) ? N_PHASES : li + 1; a.li = li; a.pad = 0;
        hipLaunchKernelGGL(hybrid_fwd, dim3(grid), dim3(NWAVES * 64), LDS_BYTES, stream, a);
        const hipError_t le = hipPeekAtLastError();
        if (le != hipSuccess) { fprintf(stderr, "kernel_launch: launch %d failed: %s\n", li, hipGetErrorName(le)); break; }
    }
}
```

```cpp
#include <hip/hip_runtime.h>
#include <cstdio>
#include <cstdint>
__device__ __forceinline__ int lane_id_v() { int l; asm volatile("v_mbcnt_lo_u32_b32 %0, -1, 0\n\tv_mbcnt_hi_u32_b32 %0, -1, %0" : "=v"(l)); return l; }
namespace pg8 {
#define PG8_LAS __attribute__((address_space(3)))
typedef unsigned short bf16_t;
typedef short bf16x8 __attribute__((ext_vector_type(8)));
typedef float f32x4 __attribute__((ext_vector_type(4)));
typedef unsigned u32x4 __attribute__((ext_vector_type(4)));
constexpr int BM = 256, BK = 64, HALF = 128, HTB = HALF * BK * 2  , STAGE_BYTES = 8 * HTB, NXCD = 8, WGM = 8;

__host__ __device__ __forceinline__ int lds_byte(int r, int c) { const int st = (r >> 4) * 2 + (c >> 5), rr = r & 15, cc = c & 31, ob = rr * 64 + cc * 2; return st * 1024 + (ob ^ (((ob >> 9) & 1) << 5)); }
__host__ __device__ __forceinline__ void stage_rc(int b, int& R, int& C) { const int st = b / 1024, sb = b % 1024, swz = sb ^ (((sb >> 9) & 1) << 5); R = (st >> 1) * 16 + swz / 64; C = (st & 1) * 32 + (swz % 64) / 2; }
__host__ __device__ __forceinline__ int perm32(int rho) { const int n = rho >> 4, i = rho & 15; return 8 * (i >> 2) + 4 * n + (i & 3); }

struct Unit { int pm, pn, e; };
struct Gemm { const bf16_t* A; const bf16_t* Bt; int M, N, K; size_t bstride; const int* rowidx; };

struct StaticOrder {
    int nM, nN, nwg, G, c;
    __host__ __device__ void init(int M, int N, int G_, int c_) { nM = M / BM; nN = N / BM; nwg = nM * nN; G = G_; c = c_; }
    __host__ __device__ bool next(int i, Unit& u) const {
        const long L = (long)i * G + c; if (L >= nwg) return false;
        int wgid = (int)L; { const int q = nwg / NXCD, r = nwg % NXCD, xcd = wgid % NXCD, off = wgid / NXCD; wgid = (xcd < r ? xcd * (q + 1) : r * (q + 1) + (xcd - r) * q) + off; }
        const int nig = WGM * nN, gid = wgid / nig, fm = gid * WGM, gsz = (nM - fm) < WGM ? (nM - fm) : WGM;
        u.pm = fm + ((wgid % nig) % gsz); u.pn = (wgid % nig) / gsz; u.e = 0; return true;
    }
    __device__ __forceinline__ void a_ready(const Unit&) const {}
    __device__ __forceinline__ void done(const Unit&) const {}
};

__device__ __forceinline__ unsigned cvt_pk_bf16(float lo, float hi) { unsigned r; asm volatile("v_cvt_pk_bf16_f32 %0, %1, %2" : "=v"(r) : "v"(lo), "v"(hi)); return r; }
typedef float f32x2 __attribute__((ext_vector_type(2)));
typedef unsigned u32x2 __attribute__((ext_vector_type(2)));
__device__ __forceinline__ float sigmoidf_(float x) { return __builtin_amdgcn_rcpf(1.f + __expf(-x)); }

struct MoeOrder {
    int ntiles, nN, RG, G, c; const PG8_LAS int* tstart;
    __device__ __forceinline__ bool next(int i, Unit& u) const {
        const int L = i * G + c, grp = L >> 5, idx = L & 31; u.pn = idx / RG; u.pm = grp * RG + idx % RG; u.e = 0;
        if (u.pm >= ntiles) return false;
        int e = 0;
#pragma unroll
        for (int k = 16; k >= 1; k >>= 1) { if (tstart[e + k] <= u.pm) e += k; }
        u.e = e; return true;
    }
    __device__ __forceinline__ void a_ready(const Unit&) const {}
    __device__ __forceinline__ void done(const Unit&) const {}
};

#define PG8_PACK8(v0, v1) (u32x4){cvt_pk_bf16((v0)[0], (v0)[1]), cvt_pk_bf16((v0)[2], (v0)[3]), cvt_pk_bf16((v1)[0], (v1)[1]), cvt_pk_bf16((v1)[2], (v1)[3])}

struct EpiPlain {
    static constexpr bool PERM = true, AFTER_DRAIN = false;
    bf16_t* O; int ldc;
    __device__ __forceinline__ void operator()(const f32x4 (&acc)[2][2][4][2], const Unit& u, int wr, int wc, int fr, int fq) const {
        const int row0 = u.pm * BM + wr * 64 + fr, col0 = u.pn * BM + wc * 32 + 8 * fq;
#pragma unroll
        for (int ai = 0; ai < 2; ++ai)
#pragma unroll
            for (int m = 0; m < 4; ++m) { bf16_t* rowp = O + (size_t)(row0 + ai * HALF + m * 16) * ldc + col0;
#pragma unroll
                for (int bj = 0; bj < 2; ++bj) { const f32x4 v0 = acc[ai][bj][m][0], v1 = acc[ai][bj][m][1]; *(u32x4*)(rowp + bj * HALF) = PG8_PACK8(v0, v1); } }
    }
};

struct EpiProj {
    static constexpr bool PERM = true, AFTER_DRAIN = false;
    bf16_t *Q, *K, *V, *RW; const float* rope; float qscale;
    __device__ __forceinline__ void operator()(const f32x4 (&acc)[2][2][4][2], const Unit& u, int wr, int wc, int fr, int fq) const {
        const int row0 = u.pm * BM + wr * 64 + fr, cl = wc * 32 + 8 * fq, pn = u.pn;
        if (pn < 4) {
            bf16_t* base = (pn < 2) ? Q : K; const int colt = (pn & 1) * 256; const float sc = (pn < 2) ? qscale : 1.f;
            const bool rp = ((wc & 1) == 0) && (fq < 2);
#pragma unroll
            for (int ai = 0; ai < 2; ++ai)
#pragma unroll
                for (int m = 0; m < 4; ++m) { const int row = row0 + ai * HALF + m * 16;
                    f32x4 cs = (f32x4){1.f, 1.f, 1.f, 1.f}, sn = (f32x4){0.f, 0.f, 0.f, 0.f};
                    if (rp) { cs = *(const f32x4*)(rope + (size_t)row * 16 + 4 * fq); sn = *(const f32x4*)(rope + (size_t)row * 16 + 8 + 4 * fq); }
#pragma unroll
                    for (int bj = 0; bj < 2; ++bj) { f32x4 v0 = acc[ai][bj][m][0], v1 = acc[ai][bj][m][1];
                        { const float a0 = v0[0], b0 = v0[1], a1 = v0[2], b1 = v0[3], a2 = v1[0], b2 = v1[1], a3 = v1[2], b3 = v1[3];
                          v0[0] = a0 * cs[0] - b0 * sn[0]; v0[1] = b0 * cs[0] + a0 * sn[0]; v0[2] = a1 * cs[1] - b1 * sn[1]; v0[3] = b1 * cs[1] + a1 * sn[1];
                          v1[0] = a2 * cs[2] - b2 * sn[2]; v1[1] = b2 * cs[2] + a2 * sn[2]; v1[2] = a3 * cs[3] - b3 * sn[3]; v1[3] = b3 * cs[3] + a3 * sn[3]; }
                        v0 = v0 * sc; v1 = v1 * sc;
                        *(u32x4*)(base + (size_t)row * 512 + colt + bj * HALF + cl) = PG8_PACK8(v0, v1); } }
        } else {
            bf16_t* base; int ld, colt;
            if (pn < 6) { base = V; ld = 512; colt = (pn - 4) * 256; } else { base = RW; ld = 1792; colt = (pn - 6) * 256; }
#pragma unroll
            for (int ai = 0; ai < 2; ++ai)
#pragma unroll
                for (int m = 0; m < 4; ++m) { bf16_t* rowp = base + (size_t)(row0 + ai * HALF + m * 16) * ld + colt + cl;
#pragma unroll
                    for (int bj = 0; bj < 2; ++bj) { const f32x4 v0 = acc[ai][bj][m][0], v1 = acc[ai][bj][m][1]; *(u32x4*)(rowp + bj * HALF) = PG8_PACK8(v0, v1); } }
        }
    }
};

struct EpiLora {
    static constexpr bool PERM = true, AFTER_DRAIN = false;
    float* LW; size_t kstride; const float *w0, *a0;
    __device__ __forceinline__ void operator()(const f32x4 (&acc)[2][2][4][2], const Unit& u, int wr, int wc, int fr, int fq) const {
        const int row0 = u.pm * BM + wr * 64 + fr, kind = u.pn >> 1, col0 = (u.pn & 1) * 256 + wc * 32 + 8 * fq;
        float* dst = LW + (size_t)kind * kstride; const float* bias = (kind == 1) ? a0 : w0;
        f32x4 bv[2][2];
#pragma unroll
        for (int bj = 0; bj < 2; ++bj)
#pragma unroll
            for (int n = 0; n < 2; ++n) bv[bj][n] = (kind < 2) ? *(const f32x4*)(bias + col0 + bj * HALF + 4 * n) : (f32x4){0.f, 0.f, 0.f, 0.f};
#pragma unroll
        for (int ai = 0; ai < 2; ++ai)
#pragma unroll
            for (int m = 0; m < 4; ++m) { float* rowp = dst + (size_t)(row0 + ai * HALF + m * 16) * 512 + col0;
#pragma unroll
                for (int bj = 0; bj < 2; ++bj)
#pragma unroll
                    for (int n = 0; n < 2; ++n) { f32x4 v = acc[ai][bj][m][n] + bv[bj][n];
                        if (kind == 0) {
#pragma unroll
                            for (int q = 0; q < 4; ++q) { const float z = -v[q]; const float sp = fmaxf(z, 0.f) + __logf(1.f + __expf(-fabsf(z))); v[q] = -__expf(-sp - 0.5f); }
                        } else if (kind == 1) {
#pragma unroll
                            for (int q = 0; q < 4; ++q) v[q] = sigmoidf_(v[q]);
                        }
                        *(f32x4*)(rowp + bj * HALF + 4 * n) = v; } }
    }
};

struct EpiSwiglu {
    static constexpr bool PERM = true, AFTER_DRAIN = false;
    bf16_t* ACT; const float* b1;
    __device__ __forceinline__ void operator()(const f32x4 (&acc)[2][2][4][2], const Unit& u, int wr, int wc, int fr, int fq) const {
        const int row0 = u.pm * BM + wr * 64 + fr, col0 = u.pn * BM + wc * 32 + 8 * fq;
        f32x4 bv[2][2];
#pragma unroll
        for (int bj = 0; bj < 2; ++bj)
#pragma unroll
            for (int n = 0; n < 2; ++n) bv[bj][n] = *(const f32x4*)(b1 + (size_t)u.e * 2048 + col0 + bj * HALF + 4 * n);
#pragma unroll
        for (int ai = 0; ai < 2; ++ai)
#pragma unroll
            for (int m = 0; m < 4; ++m) { bf16_t* rowp = ACT + (size_t)(row0 + ai * HALF + m * 16) * 1024 + (col0 >> 1);
#pragma unroll
                for (int bj = 0; bj < 2; ++bj) { const f32x4 v0 = acc[ai][bj][m][0] + bv[bj][0], v1 = acc[ai][bj][m][1] + bv[bj][1];
                    float o[4];
#pragma unroll
                    for (int q = 0; q < 4; ++q) { const float glu = (q < 2) ? v0[2 * q] : v1[2 * q - 4], lin = (q < 2) ? v0[2 * q + 1] : v1[2 * q - 3];
                        const float gg = fminf(glu, 7.f), ll = fminf(fmaxf(lin, -7.f), 7.f); o[q] = gg * sigmoidf_(1.702f * gg) * (ll + 1.f); }
                    *(u32x2*)(rowp + bj * (HALF / 2)) = (u32x2){cvt_pk_bf16(o[0], o[1]), cvt_pk_bf16(o[2], o[3])}; } }
    }
};

struct EpiMoe2 {
    static constexpr bool PERM = true, AFTER_DRAIN = false;
    bf16_t* Y2; const float* b2; const float* gate;
    __device__ __forceinline__ void operator()(const f32x4 (&acc)[2][2][4][2], const Unit& u, int wr, int wc, int fr, int fq) const {
        const int row0 = u.pm * BM + wr * 64 + fr, col0 = u.pn * BM + wc * 32 + 8 * fq;
        f32x4 bv[2][2];
#pragma unroll
        for (int bj = 0; bj < 2; ++bj)
#pragma unroll
            for (int n = 0; n < 2; ++n) bv[bj][n] = *(const f32x4*)(b2 + (size_t)u.e * 1024 + col0 + bj * HALF + 4 * n);
#pragma unroll
        for (int ai = 0; ai < 2; ++ai)
#pragma unroll
            for (int m = 0; m < 4; ++m) { const int row = row0 + ai * HALF + m * 16; const float gt = gate[row]; bf16_t* rowp = Y2 + (size_t)row * 1024 + col0;
#pragma unroll
                for (int bj = 0; bj < 2; ++bj) { const f32x4 v0 = (acc[ai][bj][m][0] + bv[bj][0]) * gt, v1 = (acc[ai][bj][m][1] + bv[bj][1]) * gt;
                    *(u32x4*)(rowp + bj * HALF) = PG8_PACK8(v0, v1); } }
    }
};

template <class Epi, class Sched, bool ALIGN_EPI = false, bool SP2 = false, bool GATHER = false>
__device__ __forceinline__ void gemm_phase(PG8_LAS unsigned char* lds, const Gemm g, const Sched& S, const Epi& E, const int wid) {
    const int lane = lane_id_v(), tid = wid * 64 + lane, wr = wid >> 2, wc = wid & 3, fr = lane & 15, fq = lane >> 4;
    const int K = g.K, nt = K / BK;
    unsigned voffA[2], voffB[2], gC[2]; int gR[2];
#pragma unroll
    for (int i = 0; i < 2; ++i) { int R, C; stage_rc(tid * 16 + i * 8192, R, C); const int Rb = Epi::PERM ? ((R & ~31) + perm32(R & 31)) : R;
        voffA[i] = (unsigned)(R * K + C) * 2u; voffB[i] = (unsigned)(Rb * K + C) * 2u; gR[i] = R; gC[i] = (unsigned)C * 2u; }
    const size_t kstep = (size_t)(BK * 2);
    const size_t hstep = (size_t)HALF * K * 2;
    const size_t tstep = 2 * hstep;
    const unsigned ldsw = (unsigned)wid * 1024u;
    const int aoff = lds_byte(wr * 64 + fr, fq * 8), boff = lds_byte(wc * 32 + fr, fq * 8);
#define PG8_SA(b, h) (((b) * 2 + (h)) * HTB)
#define PG8_SB(b, h) ((4 + (b) * 2 + (h)) * HTB)
#define PG8_STAGE(bufoff, gbase, voff) do { _Pragma("unroll") for (int _i = 0; _i < 2; ++_i) \
        __builtin_amdgcn_global_load_lds((const unsigned*)((const char*)(gbase) + (voff)[_i]), (PG8_LAS unsigned*)(lds + (bufoff) + ldsw + _i * 8192), 16, 0, 0); } while (0)
#define PG8_STAGE_A(bufoff, ptr, h, nx) do { if constexpr (GATHER) { unsigned vo_[2]; vo_[0] = (nx) ? gn[h][0] : gc[h][0]; vo_[1] = (nx) ? gn[h][1] : gc[h][1]; PG8_STAGE(bufoff, ptr, vo_); } \
        else { PG8_STAGE(bufoff, (ptr) + (h) * hstep, voffA); } } while (0)
#define PG8_LDA(dst, b, h) do { _Pragma("unroll") for (int m = 0; m < 4; ++m) _Pragma("unroll") for (int k = 0; k < 2; ++k) dst[m][k] = *(const PG8_LAS bf16x8*)(lds + PG8_SA(b, h) + aoff + m * 2048 + k * 1024); } while (0)
#define PG8_LDB(dst, b, h) do { _Pragma("unroll") for (int n = 0; n < 2; ++n) _Pragma("unroll") for (int k = 0; k < 2; ++k) dst[n][k] = *(const PG8_LAS bf16x8*)(lds + PG8_SB(b, h) + boff + n * 2048 + k * 1024); } while (0)
#define PG8_MMA(ai, bj, At, Bt) do { __builtin_amdgcn_s_setprio(1); _Pragma("unroll") for (int m = 0; m < 4; ++m) _Pragma("unroll") for (int n = 0; n < 2; ++n) _Pragma("unroll") for (int k = 0; k < 2; ++k) \
        acc[ai][bj][m][n] = __builtin_amdgcn_mfma_f32_16x16x32_bf16(Bt[n][k], At[m][k], acc[ai][bj][m][n], 0, 0, 0); __builtin_amdgcn_s_setprio(0); } while (0)
#define PG8_WAIT_V(n) asm volatile("s_waitcnt vmcnt(" #n ")" ::: "memory")
#define PG8_WAIT_L(n) asm volatile("s_waitcnt lgkmcnt(" #n ")" ::: "memory")
#define PG8_BAR __builtin_amdgcn_s_barrier()
#define PG8_SCHED __builtin_amdgcn_sched_barrier(0)
    Unit cur, nxt; int ui = 0;
    if (!S.next(0, cur)) return;
    f32x4 acc[2][2][4][2];
#pragma unroll
    for (int a = 0; a < 2; ++a)
#pragma unroll
        for (int b = 0; b < 2; ++b)
#pragma unroll
            for (int m = 0; m < 4; ++m)
#pragma unroll
                for (int n = 0; n < 2; ++n) acc[a][b][m][n] = (f32x4){0.f, 0.f, 0.f, 0.f};
    bf16x8 At[4][2], B0[2][2], B1[2][2];
    const char* cA = GATHER ? (const char*)g.A : (const char*)g.A + (size_t)cur.pm * tstep; const char* cB = (const char*)g.Bt + (size_t)cur.e * g.bstride + (size_t)cur.pn * tstep;
    unsigned gc[2][2] = {{0u, 0u}, {0u, 0u}}, gn[2][2] = {{0u, 0u}, {0u, 0u}}, g2[2][2] = {{0u, 0u}, {0u, 0u}}; Unit nx2; bool has_nx2 = false;
    if constexpr (GATHER) {
        _Pragma("unroll") for (int h = 0; h < 2; ++h) _Pragma("unroll") for (int i = 0; i < 2; ++i) gc[h][i] = (unsigned)g.rowidx[cur.pm * BM + h * HALF + gR[i]] * (unsigned)(K * 2) + gC[i];
        const bool hn = S.next(1, nxt);
        _Pragma("unroll") for (int h = 0; h < 2; ++h) _Pragma("unroll") for (int i = 0; i < 2; ++i) gn[h][i] = hn ? (unsigned)g.rowidx[nxt.pm * BM + h * HALF + gR[i]] * (unsigned)(K * 2) + gC[i] : gc[h][i];
    }
    S.a_ready(cur);
    if constexpr (SP2) {
        PG8_STAGE(PG8_SB(0, 0), cB, voffB); PG8_STAGE(PG8_SB(0, 1), cB + hstep, voffB); PG8_STAGE_A(PG8_SA(0, 0), cA, 0, false); PG8_STAGE_A(PG8_SA(0, 1), cA, 1, false);
        if (wr == 1) PG8_BAR;
        PG8_WAIT_V(2); PG8_BAR;
        PG8_STAGE(PG8_SB(1, 0), cB + kstep, voffB); PG8_STAGE_A(PG8_SA(1, 0), cA + kstep, 0, false); PG8_STAGE(PG8_SB(1, 1), cB + hstep + kstep, voffB);
        PG8_WAIT_V(6); PG8_BAR;
    } else {
        PG8_STAGE(PG8_SB(0, 0), cB, voffB); PG8_STAGE_A(PG8_SA(0, 0), cA, 0, false); PG8_STAGE(PG8_SB(0, 1), cB + hstep, voffB); PG8_STAGE_A(PG8_SA(0, 1), cA, 1, false);
        if (wr == 1) PG8_BAR;
        PG8_WAIT_V(4); PG8_BAR;
        PG8_STAGE(PG8_SB(1, 0), cB + kstep, voffB); PG8_STAGE_A(PG8_SA(1, 0), cA + kstep, 0, false); PG8_STAGE(PG8_SB(1, 1), cB + hstep + kstep, voffB);
        PG8_WAIT_V(6); PG8_BAR;
    }
    for (;;) {
        const bool has_next = S.next(ui + 1, nxt);
        const char* nA = GATHER ? (const char*)g.A : (has_next ? (const char*)g.A + (size_t)nxt.pm * tstep : cA); const char* nB = has_next ? (const char*)g.Bt + (size_t)nxt.e * g.bstride + (size_t)nxt.pn * tstep : cB;
        for (int t = 0; t < nt; t += 2) {
            const bool last = (t == nt - 2);
            const char* a1 = cA + (size_t)(t + 1) * kstep;
            const char* a2 = last ? nA : cA + (size_t)(t + 2) * kstep; const char* b2 = last ? nB : cB + (size_t)(t + 2) * kstep;
            const char* a3 = a2 + kstep; const char* b3 = b2 + kstep;
            if (last && has_next) S.a_ready(nxt);
            if constexpr (SP2) {
            PG8_LDB(B0, 0, 0); PG8_LDB(B1, 0, 1); PG8_SCHED; PG8_LDA(At, 0, 0); PG8_STAGE_A(PG8_SA(1, 1), a1, 1, false);
            PG8_WAIT_V(8); PG8_WAIT_L(0); PG8_BAR; PG8_MMA(0, 0, At, B0); PG8_MMA(0, 1, At, B1); PG8_BAR; PG8_SCHED;
            PG8_LDA(At, 0, 1); PG8_STAGE(PG8_SB(0, 0), b2, voffB); PG8_STAGE(PG8_SB(0, 1), b2 + hstep, voffB); PG8_STAGE_A(PG8_SA(0, 0), a2, 0, last);
            PG8_WAIT_V(8); PG8_WAIT_L(0); PG8_BAR; PG8_MMA(1, 0, At, B0); PG8_MMA(1, 1, At, B1); PG8_BAR; PG8_SCHED;
            PG8_LDB(B0, 1, 0); PG8_LDB(B1, 1, 1); PG8_SCHED; PG8_LDA(At, 1, 0); PG8_STAGE_A(PG8_SA(0, 1), a2, 1, last);
            PG8_WAIT_V(8); PG8_WAIT_L(0); PG8_BAR; PG8_MMA(0, 0, At, B0); PG8_MMA(0, 1, At, B1); PG8_BAR; PG8_SCHED;
            PG8_LDA(At, 1, 1); PG8_STAGE(PG8_SB(1, 0), b3, voffB); PG8_STAGE(PG8_SB(1, 1), b3 + hstep, voffB); PG8_STAGE_A(PG8_SA(1, 0), a3, 0, last);
            PG8_WAIT_V(8); PG8_WAIT_L(0); PG8_BAR; PG8_MMA(1, 0, At, B0); PG8_MMA(1, 1, At, B1); PG8_BAR; PG8_SCHED;
            } else {
            PG8_LDB(B0, 0, 0); PG8_SCHED; PG8_LDA(At, 0, 0); PG8_STAGE_A(PG8_SA(1, 1), a1, 1, false);
            PG8_WAIT_L(8); PG8_BAR; PG8_WAIT_L(0); PG8_MMA(0, 0, At, B0); PG8_BAR; PG8_SCHED;
            PG8_LDB(B1, 0, 1); PG8_STAGE(PG8_SB(0, 0), b2, voffB);
            PG8_BAR; PG8_WAIT_L(0); PG8_MMA(0, 1, At, B1); PG8_BAR;
            PG8_LDA(At, 0, 1); PG8_STAGE_A(PG8_SA(0, 0), a2, 0, last);
            PG8_BAR; PG8_WAIT_L(0); PG8_MMA(1, 0, At, B0); PG8_BAR; PG8_SCHED;
            PG8_STAGE(PG8_SB(0, 1), b2 + hstep, voffB);
            PG8_WAIT_V(6); PG8_BAR; PG8_MMA(1, 1, At, B1); PG8_BAR;
            PG8_LDB(B0, 1, 0); PG8_SCHED; PG8_LDA(At, 1, 0); PG8_STAGE_A(PG8_SA(0, 1), a2, 1, last);
            PG8_WAIT_L(8); PG8_BAR; PG8_WAIT_L(0); PG8_MMA(0, 0, At, B0); PG8_BAR; PG8_SCHED;
            PG8_LDB(B1, 1, 1); PG8_STAGE(PG8_SB(1, 0), b3, voffB);
            PG8_BAR; PG8_WAIT_L(0); PG8_MMA(0, 1, At, B1); PG8_BAR;
            PG8_LDA(At, 1, 1); PG8_STAGE_A(PG8_SA(1, 0), a3, 0, last);
            PG8_BAR; PG8_WAIT_L(0); PG8_MMA(1, 0, At, B0); PG8_BAR; PG8_SCHED;
            PG8_STAGE(PG8_SB(1, 1), b3 + hstep, voffB);
            PG8_WAIT_V(6); PG8_BAR; PG8_MMA(1, 1, At, B1); PG8_BAR;
            }
        }
        if constexpr (GATHER) { has_nx2 = has_next && S.next(ui + 2, nx2);
            _Pragma("unroll") for (int h = 0; h < 2; ++h) _Pragma("unroll") for (int i = 0; i < 2; ++i) g2[h][i] = has_nx2 ? (unsigned)g.rowidx[nx2.pm * BM + h * HALF + gR[i]] * (unsigned)(K * 2) + gC[i] : gn[h][i]; }
        if constexpr (ALIGN_EPI) { if (wr == 0) PG8_BAR; }
        if constexpr (!Epi::AFTER_DRAIN) { E(acc, cur, wr, wc, fr, fq); S.done(cur); }
        if (!has_next) break;
#pragma unroll
        for (int a = 0; a < 2; ++a)
#pragma unroll
            for (int b = 0; b < 2; ++b)
#pragma unroll
                for (int m = 0; m < 4; ++m)
#pragma unroll
                    for (int n = 0; n < 2; ++n) acc[a][b][m][n] = (f32x4){0.f, 0.f, 0.f, 0.f};
        if constexpr (GATHER) { asm volatile("" : "+v"(g2[0][0]), "+v"(g2[0][1]), "+v"(g2[1][0]), "+v"(g2[1][1]));
            _Pragma("unroll") for (int h = 0; h < 2; ++h) _Pragma("unroll") for (int i = 0; i < 2; ++i) { gc[h][i] = gn[h][i]; gn[h][i] = g2[h][i]; } }
        cur = nxt; cA = nA; cB = nB; ++ui;
        if constexpr (ALIGN_EPI) { if (wr == 1) PG8_BAR; }
    }
    PG8_WAIT_V(0);
    if constexpr (!ALIGN_EPI) { if (wr == 0) PG8_BAR; }
    PG8_BAR;
    if constexpr (Epi::AFTER_DRAIN) { E.fused(acc, cur, wr, wc, fr, fq, lds, wid, lane); S.done(cur); }
#undef PG8_SA
#undef PG8_SB
#undef PG8_STAGE
#undef PG8_STAGE_A
#undef PG8_LDA
#undef PG8_LDB
#undef PG8_MMA
#undef PG8_WAIT_V
#undef PG8_WAIT_L
#undef PG8_BAR
#undef PG8_SCHED
}
}
#include <hip/hip_bf16.h>
#include <cmath>
namespace attn_body {
using bf16=__hip_bfloat16;
using bf16x8=__attribute__((ext_vector_type(8)))short;
using s16x4=__attribute__((ext_vector_type(4)))short;
using f32x16=__attribute__((ext_vector_type(16)))float;
using u32x4=__attribute__((ext_vector_type(4)))unsigned;
constexpr int BATCH=8,NHEAD=16,SEQ=4096,D=64;
constexpr int QP=512,KP=512,VP=512,OP=1024;
constexpr int NW=8,QBLK=32,QB=QBLK*NW,KVBLK=64,NQB=SEQ/QB;
constexpr int ATTN_UNIT_ROWS=QB;
__device__ __forceinline__ int crow(int r,int hi){return (r&3)+8*(r>>2)+4*hi;}
#define SBAR() __builtin_amdgcn_sched_barrier(0)
__device__ __forceinline__ void cmask(f32x16&p0,f32x16&p1,int jb,int qrel,int hi){
  const float NEG=-INFINITY; int kb=64*jb+4*hi;
  #pragma unroll
  for(int r=0;r<16;++r){int kv=kb+(r&3)+8*(r>>2); if(kv>qrel)p0[r]=NEG; if(kv+32>qrel)p1[r]=NEG;}
}

constexpr int NSLOT=3, SLOTB=8192;
constexpr int LDS_K=0, LDS_V=NSLOT*SLOTB, LDS_WS=2*NSLOT*SLOTB, LDS_OST=LDS_WS+NW*64*4, LDS_BYTES=LDS_OST+NW*4096;
constexpr float C2=0.125f*1.4426950408889634f;
__device__ __forceinline__ void glds16(const void*gsrc,unsigned lds_dst){unsigned keep;
  asm volatile("s_mov_b32 %0, m0\n\ts_mov_b32 m0, %2\n\ts_nop 0\n\tglobal_load_lds_dwordx4 %1, off\n\ts_mov_b32 m0, %0":"=&s"(keep):"v"(gsrc),"s"(lds_dst):"memory");}
__device__ __forceinline__ float max3f(float a,float b,float c){float r;asm("v_max3_f32 %0, %1, %2, %3":"=v"(r):"v"(a),"v"(b),"v"(c));return r;}
__device__ __forceinline__ float max2f(float a,float b){float r;asm("v_max_f32_e32 %0, %1, %2":"=v"(r):"v"(a),"v"(b));return r;}
__device__ __forceinline__ float fadd_s(float a,float b){float r;asm("v_add_f32_e32 %0, %1, %2":"=v"(r):"v"(a),"v"(b));return r;}
__device__ __forceinline__ float fsub_s(float a,float b){float r;asm("v_sub_f32_e32 %0, %1, %2":"=v"(r):"v"(a),"v"(b));return r;}
typedef float f32x2_t __attribute__((ext_vector_type(2))); typedef __bf16 bf16x2_t __attribute__((ext_vector_type(2)));
__device__ __forceinline__ unsigned cvtpk_s(float lo,float hi){f32x2_t v={lo,hi};bf16x2_t b=__builtin_convertvector(v,bf16x2_t);return __builtin_bit_cast(unsigned,b);}
#define WAIT_BAR(N) asm volatile("s_waitcnt vmcnt(" #N ") lgkmcnt(0)\n\ts_barrier":::"memory")

__device__ __forceinline__ void qkt(f32x16&p0,f32x16&p1,const char*Kslot,const bf16x8*qr,const f32x16&negm,int r32,int hi){
  const char*kb=Kslot+hi*1024+r32*16;
  #pragma unroll
  for(int d0=0;d0<4;++d0){
    const bf16x8 b0=*reinterpret_cast<const bf16x8*>(kb+d0*2048);
    const bf16x8 b1=*reinterpret_cast<const bf16x8*>(kb+d0*2048+512);
    if(d0==0){p0=__builtin_amdgcn_mfma_f32_32x32x16_bf16(b0,qr[0],negm,0,0,0);p1=__builtin_amdgcn_mfma_f32_32x32x16_bf16(b1,qr[0],negm,0,0,0);}
    else{p0=__builtin_amdgcn_mfma_f32_32x32x16_bf16(b0,qr[d0],p0,0,0,0);p1=__builtin_amdgcn_mfma_f32_32x32x16_bf16(b1,qr[d0],p1,0,0,0);}}
}
typedef __attribute__((address_space(3))) const char* lds_cptr;
typedef short v4i16_t __attribute__((ext_vector_type(4)));
__device__ __forceinline__ void kload8(bf16x8*kf,lds_cptr kp){
  kf[0]=*(const __attribute__((address_space(3))) bf16x8*)(kp);      kf[1]=*(const __attribute__((address_space(3))) bf16x8*)(kp+512);
  kf[2]=*(const __attribute__((address_space(3))) bf16x8*)(kp+2048); kf[3]=*(const __attribute__((address_space(3))) bf16x8*)(kp+2560);
  kf[4]=*(const __attribute__((address_space(3))) bf16x8*)(kp+4096); kf[5]=*(const __attribute__((address_space(3))) bf16x8*)(kp+4608);
  kf[6]=*(const __attribute__((address_space(3))) bf16x8*)(kp+6144); kf[7]=*(const __attribute__((address_space(3))) bf16x8*)(kp+6656);
}
__device__ __forceinline__ void kload2(bf16x8*kf,lds_cptr kp,int j){ kf[2*j]=*(const __attribute__((address_space(3))) bf16x8*)(kp+j*2048); kf[2*j+1]=*(const __attribute__((address_space(3))) bf16x8*)(kp+j*2048+512); }
__device__ __forceinline__ s16x4 vtr(lds_cptr p){ return __builtin_bit_cast(s16x4,__builtin_amdgcn_ds_read_tr16_b64_v4i16((__attribute__((address_space(3))) v4i16_t*)p)); }
__device__ __forceinline__ float rowmax(const f32x16&p0,const f32x16&p1){
  float a=max3f(p0[0],p0[1],p1[0]),b=max3f(p0[2],p0[3],p1[1]);a=max3f(a,p1[2],p1[3]);
  #pragma unroll
  for(int r=4;r<16;r+=4){a=max3f(a,p0[r],p0[r+1]);b=max3f(b,p0[r+2],p0[r+3]);a=max3f(a,p1[r],p1[r+1]);b=max3f(b,p1[r+2],p1[r+3]);}
  const float m=max2f(a,b);
  auto rr=__builtin_amdgcn_permlane32_swap(__float_as_uint(m),__float_as_uint(m),false,false);
  return max2f(__uint_as_float(rr[0]),__uint_as_float(rr[1]));
}
__device__ __forceinline__ void pv(f32x16*o,int vb,bf16x8 pa0,bf16x8 pa1,bf16x8 pa2,bf16x8 pa3){
  #pragma unroll
  for(int d0=0;d0<2;++d0){s16x4 lo[4],hi[4];
    #pragma unroll
    for(int ks=0;ks<4;++ks){
      asm volatile("ds_read_b64_tr_b16 %0,%1 offset:%c2":"=&v"(lo[ks]):"v"(vb),"i"(d0*4096+ks*1024):"memory");
      asm volatile("ds_read_b64_tr_b16 %0,%1 offset:%c2":"=&v"(hi[ks]):"v"(vb),"i"(d0*4096+ks*1024+512):"memory");}
    asm volatile("s_waitcnt lgkmcnt(0)":::"memory");SBAR();
    #define PK(k) (bf16x8){lo[k][0],lo[k][1],lo[k][2],lo[k][3],hi[k][0],hi[k][1],hi[k][2],hi[k][3]}
    o[d0]=__builtin_amdgcn_mfma_f32_32x32x16_bf16(pa0,PK(0),o[d0],0,0,0);
    o[d0]=__builtin_amdgcn_mfma_f32_32x32x16_bf16(pa1,PK(1),o[d0],0,0,0);
    o[d0]=__builtin_amdgcn_mfma_f32_32x32x16_bf16(pa2,PK(2),o[d0],0,0,0);
    o[d0]=__builtin_amdgcn_mfma_f32_32x32x16_bf16(pa3,PK(3),o[d0],0,0,0);
    #undef PK
  }
}

#ifndef ATTN_STORE16
#define ATTN_STORE16(p,v) (*(u32x4*)(p)=(v))
#endif
template<int THRL> __device__ __forceinline__ void attn_unit(int b,int h,int qb,const bf16*Q,const bf16*__restrict__ K,const bf16*__restrict__ V,bf16*O,char*shm,const int wid){
  const int qcol=(h>>1)*64, kcol=(h>>1)*64, vcol=(h>>2)*128+(h&1)*64, ocol=h*64;
  const int lane=lane_id_v(),r32=lane&31,hi=lane>>5;
  const long rowbase=(long)b*SEQ; const int q0=qb*QB;
  const bf16*Qw=Q+(rowbase+q0+wid*QBLK)*QP+qcol;
  const bf16*Kh=K+rowbase*KP+kcol,*Vh=V+rowbase*VP+vcol;
  const unsigned lds0=(unsigned)(uintptr_t)shm;
  float*wsf=(float*)(shm+LDS_WS)+wid*64;
  const bf16*ksrc=Kh+(long)lane*KP+wid*8;
  const bf16*vsrc=Vh+(long)(16*(wid&3)+(lane>>2))*VP+(wid>>2)*32+(lane&3)*8;
  const unsigned kdst=lds0+LDS_K+wid*1024, vdst=lds0+LDS_V+wid*1024;
  #define DMA_K(t,slot) glds16(ksrc+(long)(t)*KVBLK*KP,(unsigned)__builtin_amdgcn_readfirstlane(kdst+(slot)))
  #define DMA_V(t,slot) glds16(vsrc+(long)(t)*KVBLK*VP,(unsigned)__builtin_amdgcn_readfirstlane(vdst+(slot)))
  const int vb0=(int)(lds0+LDS_V)+((lane>>4)&1)*32+(lane&3)*8+(4*hi+((lane&15)>>2))*64;
  const char*Kbase=shm+LDS_K; bf16x8 kf[8];
  const lds_cptr shm3=(lds_cptr)shm; const lds_cptr kp0=shm3+LDS_K+hi*1024+r32*16; const lds_cptr vp0=shm3+LDS_V+((lane>>4)&1)*32+(lane&3)*8+(4*hi+((lane&15)>>2))*64;
  const int NT=(q0+QB)/KVBLK;
  DMA_K(0,0);DMA_V(0,0);DMA_K(1,SLOTB);
  bf16x8 qr[4];
  #pragma unroll
  for(int d0=0;d0<4;++d0)qr[d0]=*reinterpret_cast<const bf16x8*>(&Qw[(long)r32*QP+d0*16+hi*8]);
  float mhat=0.f,l_reg=0.f;f32x16 o[2];o[0]=f32x16{};o[1]=f32x16{};f32x16 negm=f32x16{};asm volatile("":"+v"(negm));
  const int qrel=wid*QBLK+r32;
  #define CMASK(P0,P1,t) do{int jb_=(t)-(NT-4); if(jb_>=0)cmask(P0,P1,jb_,qrel,hi);}while(0)
  bool resc=false;
  #define START(P0,P1) do{ const float rm=rowmax(P0,P1); resc=false; \
    { const float dl=rm; mhat=fadd_s(mhat,dl); \
      _Pragma("unroll") for(int r=0;r<16;++r){P0[r]=fsub_s(P0[r],dl);P1[r]=fsub_s(P1[r],dl);} \
      _Pragma("unroll") for(int r=0;r<16;++r)negm[r]=-mhat; asm volatile("":"+v"(negm)); } \
    _Pragma("unroll") for(int r=0;r<16;++r)P0[r]=__builtin_amdgcn_exp2f(P0[r]); }while(0)
  #define RESC() do{ if(resc){ asm volatile("s_waitcnt lgkmcnt(0)":::"memory"); \
      _Pragma("unroll") for(int d_=0;d_<2;++d_) _Pragma("unroll") for(int r=0;r<16;++r)o[d_][r]*=wsf[crow(r,hi)]; } }while(0)
  f32x16 pA0,pA1,pB0,pB1;
  int sl_prev=0,sl_cur=0,sl_next=SLOTB;
  #define ROT() do{sl_prev=sl_cur;sl_cur=sl_next;sl_next=(sl_next==(NSLOT-1)*SLOTB)?0:sl_next+SLOTB;}while(0)
  DMA_K(2,2*SLOTB);
  WAIT_BAR(3);
  qkt(pA0,pA1,Kbase,qr,negm,r32,hi);asm volatile("s_nop 15\n\ts_nop 7":"+v"(pA0),"+v"(pA1));CMASK(pA0,pA1,0);
  START(pA0,pA1);
  _Pragma("unroll") for(int r=0;r<16;++r)pA1[r]=__builtin_amdgcn_exp2f(pA1[r]);
  WAIT_BAR(0);
  DMA_K(3,0);DMA_V(1,SLOTB);
  ROT();
  kload8(kf,kp0+sl_cur);
  WAIT_BAR(2);
  s16x4 vlo[8],vhi[8]; u32x4 pw0,pw1,pw2,pw3;
  #define PKW(P,B) cvtpk_s(P[B],P[B+1])
  #define PAF(k) __builtin_bit_cast(bf16x8,pw##k)
  #define VFR(i) (bf16x8){vlo[i][0],vlo[i][1],vlo[i][2],vlo[i][3],vhi[i][0],vhi[i][1],vhi[i][2],vhi[i][3]}
  #define PIN(x) asm volatile("":"+v"(x))
  #define MX3(a,b,c) __builtin_fmaxf(__builtin_fmaxf((a),(b)),(c))
  #define GAPA(MF,A0,A1,A2,A3,W0,W1,PW) do{ MF; sacc+=A0; sacc+=A1; sacc+=A2; sacc+=A3; PIN(sacc); W0; W1; PIN(PW); SBAR(); }while(0)
  #define EX(v) __builtin_amdgcn_exp2f(v)
  #define GAPB(MF,X,B) do{ MF; X[B]=EX(X[B]); X[B+1]=EX(X[B+1]); X[B+2]=EX(X[B+2]); X[B+3]=EX(X[B+3]); PIN(X); SBAR(); }while(0)
  #define VRD(i) do{ vlo[i]=vtr(vp_+(((i)>>2)*4096+((i)&3)*1024)); vhi[i]=vtr(vp_+(((i)>>2)*4096+((i)&3)*1024+512)); }while(0)
  #define KRD(G,j) do{ if(G){ kload2(kf,kp0+sl_next,j); SBAR(); } }while(0)
  #define STEP(C0,C1,P0,P1,t,GK,GV,GL) do{ SBAR(); \
    const lds_cptr vp_=vp0+sl_prev; \
    VRD(0); SBAR(); float sacc=(P0[0]+P0[1]); \
    GAPA(C0=__builtin_amdgcn_mfma_f32_32x32x16_bf16(kf[0],qr[0],negm,0,0,0), P0[2],P0[3],P0[4],P0[5],     pw0[0]=PKW(P0,0), pw0[1]=PKW(P0,2), pw0); \
    VRD(4); SBAR(); GAPA(C1=__builtin_amdgcn_mfma_f32_32x32x16_bf16(kf[1],qr[0],negm,0,0,0), P0[6],P0[7],P0[8],P0[9],     pw0[2]=PKW(P0,4), pw0[3]=PKW(P0,6), pw0); \
    VRD(1); SBAR(); GAPA(C0=__builtin_amdgcn_mfma_f32_32x32x16_bf16(kf[2],qr[1],C0,0,0,0),   P0[10],P0[11],P0[12],P0[13], pw1[0]=PKW(P0,8), pw1[1]=PKW(P0,10), pw1); \
    VRD(5); SBAR(); GAPA(C1=__builtin_amdgcn_mfma_f32_32x32x16_bf16(kf[3],qr[1],C1,0,0,0),   P0[14],P0[15],P1[0],P1[1],   pw1[2]=PKW(P0,12),pw1[3]=PKW(P0,14), pw1); \
    VRD(2); SBAR(); GAPA(C0=__builtin_amdgcn_mfma_f32_32x32x16_bf16(kf[4],qr[2],C0,0,0,0),   P1[2],P1[3],P1[4],P1[5],     pw2[0]=PKW(P1,0), pw2[1]=PKW(P1,2), pw2); \
    VRD(6); SBAR(); GAPA(C1=__builtin_amdgcn_mfma_f32_32x32x16_bf16(kf[5],qr[2],C1,0,0,0),   P1[6],P1[7],P1[8],P1[9],     pw2[2]=PKW(P1,4), pw2[3]=PKW(P1,6), pw2); \
    VRD(3); SBAR(); GAPA(C0=__builtin_amdgcn_mfma_f32_32x32x16_bf16(kf[6],qr[3],C0,0,0,0),   P1[10],P1[11],P1[12],P1[13], pw3[0]=PKW(P1,8), pw3[1]=PKW(P1,10), pw3); \
    VRD(7); SBAR(); GAPA(C1=__builtin_amdgcn_mfma_f32_32x32x16_bf16(kf[7],qr[3],C1,0,0,0),   P1[14],P1[15],0.f,0.f,       pw3[2]=PKW(P1,12),pw3[3]=PKW(P1,14), pw3); \
    l_reg+=sacc; \
    if(GK){DMA_K((t)+3,sl_cur);} if(GV){DMA_V((t)+1,sl_next);} \
    CMASK(C0,C1,t); \
    { float a=MX3(C0[0],C0[1],C1[0]),b=MX3(C0[2],C0[3],C1[1]); a=MX3(a,C1[2],C1[3]); \
      _Pragma("unroll") for(int r=4;r<16;r+=4){a=MX3(a,C0[r],C0[r+1]);b=MX3(b,C0[r+2],C0[r+3]);a=MX3(a,C1[r],C1[r+1]);b=MX3(b,C1[r+2],C1[r+3]);} \
      float rm=__builtin_fmaxf(a,b); { auto rr=__builtin_amdgcn_permlane32_swap(__float_as_uint(rm),__float_as_uint(rm),false,false); rm=__builtin_fmaxf(__uint_as_float(rr[0]),__uint_as_float(rr[1])); } \
      resc=false; \
      if(__builtin_expect(__any(rm>(float)THRL),0)){ const float dl=__builtin_fmaxf(rm,0.f); mhat+=dl; \
        _Pragma("unroll") for(int r=0;r<16;++r){C0[r]-=dl;C1[r]-=dl;} \
        _Pragma("unroll") for(int r=0;r<16;++r)negm[r]=-mhat; asm volatile("":"+v"(negm)); \
        const float f=__builtin_amdgcn_exp2f(-dl); l_reg*=f; if(hi==0)wsf[r32]=f; resc=true; } } \
    SBAR(); \
    GAPB(o[0]=__builtin_amdgcn_mfma_f32_32x32x16_bf16(PAF(0),VFR(0),o[0],0,0,0), C0,0); \
    GAPB(o[1]=__builtin_amdgcn_mfma_f32_32x32x16_bf16(PAF(0),VFR(4),o[1],0,0,0), C0,4); \
    KRD(GL,0); GAPB(o[0]=__builtin_amdgcn_mfma_f32_32x32x16_bf16(PAF(1),VFR(1),o[0],0,0,0), C0,8); \
    KRD(GL,1); GAPB(o[1]=__builtin_amdgcn_mfma_f32_32x32x16_bf16(PAF(1),VFR(5),o[1],0,0,0), C0,12); \
    KRD(GL,2); GAPB(o[0]=__builtin_amdgcn_mfma_f32_32x32x16_bf16(PAF(2),VFR(2),o[0],0,0,0), C1,0); \
    KRD(GL,3); GAPB(o[1]=__builtin_amdgcn_mfma_f32_32x32x16_bf16(PAF(2),VFR(6),o[1],0,0,0), C1,4); \
    GAPB(o[0]=__builtin_amdgcn_mfma_f32_32x32x16_bf16(PAF(3),VFR(3),o[0],0,0,0), C1,8); \
    GAPB(o[1]=__builtin_amdgcn_mfma_f32_32x32x16_bf16(PAF(3),VFR(7),o[1],0,0,0), C1,12); \
    }while(0)
  int t=1;
  #undef CMASK
  #define CMASK(P0,P1,t) do{}while(0)
  for(;t+5<NT;t+=2){
    STEP(pB0,pB1,pA0,pA1,t,true,true,true);     WAIT_BAR(2); RESC(); ROT();
    STEP(pA0,pA1,pB0,pB1,t+1,true,true,true);   WAIT_BAR(2); RESC(); ROT();
  }
  #undef CMASK
  #define CMASK(P0,P1,t) do{int jb_=(t)-(NT-4); if(jb_>=0)cmask(P0,P1,jb_,qrel,hi);}while(0)
  #define ENDW(tt) do{ if((tt)+3<NT){WAIT_BAR(2);} else if((tt)+2<NT){WAIT_BAR(1);} else {WAIT_BAR(0);} }while(0)
  for(;t+1<NT;t+=2){
    STEP(pB0,pB1,pA0,pA1,t,(t+3<NT),(t+1<NT),(t+1<NT));       ENDW(t);   RESC(); ROT();
    STEP(pA0,pA1,pB0,pB1,t+1,(t+4<NT),(t+2<NT),(t+2<NT));     ENDW(t+1); RESC(); ROT();
  }
  STEP(pB0,pB1,pA0,pA1,NT-1,false,false,false); RESC();
  { float sacc=pB0[0]+pB0[1]; _Pragma("unroll") for(int r=2;r<16;++r)sacc+=pB0[r]; _Pragma("unroll") for(int r=0;r<16;++r)sacc+=pB1[r]; l_reg+=sacc;
    pw0=(u32x4){PKW(pB0,0),PKW(pB0,2),PKW(pB0,4),PKW(pB0,6)};pw1=(u32x4){PKW(pB0,8),PKW(pB0,10),PKW(pB0,12),PKW(pB0,14)};pw2=(u32x4){PKW(pB1,0),PKW(pB1,2),PKW(pB1,4),PKW(pB1,6)};pw3=(u32x4){PKW(pB1,8),PKW(pB1,10),PKW(pB1,12),PKW(pB1,14)};
    SBAR(); pv(o,vb0+sl_cur,PAF(0),PAF(1),PAF(2),PAF(3)); }
  #undef PKW
  #undef PAF
  #undef VFR
  #undef PIN
  #undef MX3
  #undef GAPA
  #undef GAPB
  #undef EX
  #undef VRD
  #undef KRD
  #undef STEP
  #undef ENDW
  {auto rr=__builtin_amdgcn_permlane32_swap(__float_as_uint(l_reg),__float_as_uint(l_reg),false,false);l_reg=__uint_as_float(rr[0])+__uint_as_float(rr[1]);}
  if(hi==0)wsf[32+r32]=l_reg;asm volatile("s_waitcnt lgkmcnt(0)":::"memory");
  float rli[16];
  #pragma unroll
  for(int r=0;r<16;++r)rli[r]=__builtin_amdgcn_rcpf(wsf[32+crow(r,hi)]);
  bf16*Ow=O+(rowbase+q0+wid*QBLK)*OP+ocol;
  { bf16*stg=(bf16*)(shm+LDS_OST)+wid*2048;
    #pragma unroll
    for(int r=0;r<16;++r){const int orow=crow(r,hi);
      #pragma unroll
      for(int d0=0;d0<2;++d0)stg[orow*64+d0*32+r32]=__float2bfloat16(o[d0][r]*rli[r]);}
    asm volatile("s_waitcnt lgkmcnt(0)":::"memory");
    #pragma unroll
    for(int i=0;i<4;++i){const int row=i*8+(lane>>3),ch=lane&7; const u32x4 v=*(const u32x4*)(stg+row*64+ch*8); ATTN_STORE16(Ow+(long)row*OP+ch*8,v);} }
  asm volatile("s_waitcnt lgkmcnt(0)\n\ts_barrier":::"memory");
  #undef DMA_K
  #undef DMA_V
  #undef CMASK
  #undef START
  #undef RESC
  #undef ROT
}
constexpr int ATTN_LDS_BYTES=LDS_BYTES;
struct AttnTensors { const bf16* Q; const bf16* K; const bf16* V; bf16* O; };
struct AttnUnit { int bh; int qb; };
struct QueueOrder {
  unsigned* ctr; volatile __attribute__((address_space(3))) unsigned* slot; int wid;
  __device__ __forceinline__ bool next(int,AttnUnit&u)const{
    if(wid==0&&lane_id_v()==0){ const unsigned n=__hip_atomic_fetch_add(ctr,1u,__ATOMIC_RELAXED,__HIP_MEMORY_SCOPE_AGENT); slot[0]=n; }
    asm volatile("s_waitcnt vmcnt(0) lgkmcnt(0)\n\ts_barrier":::"memory");
    const unsigned n=slot[0];
    asm volatile("s_waitcnt lgkmcnt(0)\n\ts_barrier":::"memory");
    if(n>=(unsigned)(BATCH*NHEAD*NQB))return false;
    u.qb=NQB-1-(int)(n/(BATCH*NHEAD)); u.bh=(int)(n%(BATCH*NHEAD)); return true; }
  __device__ __forceinline__ void a_ready(const AttnUnit&)const{}
  __device__ __forceinline__ void done(const AttnUnit&)const{}
};
template<class Sched,int THRL=8> __device__ __forceinline__ void attn_phase(char*lds,const AttnTensors&T,const Sched&S,const int wid){
  AttnUnit u;
  for(int i=0;S.next(i,u);++i){ S.a_ready(u); attn_unit<THRL>(u.bh/NHEAD,u.bh%NHEAD,u.qb,T.Q,T.K,T.V,T.O,lds,wid); S.done(u); }
}
#undef SBAR
#undef WAIT_BAR
}
constexpr int NWAVES = 8;
#ifndef MK_N_LAUNCHES
#define MK_N_LAUNCHES 1
#endif
constexpr int N_PHASES = 14;
#ifndef PROBE_MASK
#define PROBE_MASK 0
#endif
constexpr int N_LAUNCHES = MK_N_LAUNCHES;
static_assert(N_LAUNCHES == 1 || N_LAUNCHES == N_PHASES, "MK_N_LAUNCHES is 1 or 14");

constexpr int BATCH = 8, T = 4096, D = 1024, M = BATCH * T;
constexpr int IN_COLS = 3328, RWC = 1792, NEXP = 32, TOPK = 4, NMOD = 6 * D;
constexpr int MAXROWS = M * TOPK + NEXP * 256;
constexpr int MOD_KS = 8;

constexpr size_t MiB = 1u << 20, KiB = 1u << 10;
constexpr size_t WS_CTL = 0, CTL_ZERO_BYTES = 1 * MiB;
constexpr size_t WS_MODP = 1 * MiB;
constexpr size_t WS_MOD = 2 * MiB + 512 * KiB;
constexpr size_t WS_ROPE = 3 * MiB;
constexpr size_t WS_WIN = 5 * MiB;
constexpr size_t WS_WOUT = 12 * MiB;
constexpr size_t WS_BLORA = 14 * MiB;
constexpr size_t WS_TOKE = 15 * MiB, WS_TOKG = 15 * MiB + 512 * KiB;
constexpr size_t WS_TOKROW = 16 * MiB, WS_ROWTOK = 16 * MiB + 512 * KiB, WS_ROWGATE = 17 * MiB + 256 * KiB, WS_BLKBASE = 18 * MiB;
constexpr size_t WS_W1 = 20 * MiB, WS_W2 = 148 * MiB;
constexpr size_t WS_H2 = 212 * MiB;
constexpr size_t WS_H = 276 * MiB, WS_Q = 340 * MiB, WS_K = 372 * MiB, WS_V = 404 * MiB, WS_RW = 436 * MiB;
constexpr size_t WS_O = 548 * MiB, WS_YCAT = 612 * MiB, WS_LACT = 676 * MiB;
constexpr size_t WS_LW = 692 * MiB, WS_AS = 756 * MiB, WS_G = 820 * MiB, WS_Y = 884 * MiB;
constexpr size_t WS_RIMG = 884 * MiB, WS_RBON = 1012 * MiB;
constexpr size_t WS_ACT = 276 * MiB, WS_Y2 = 548 * MiB, WS_END = 1013 * MiB;
static_assert(WS_ROWTOK + (size_t)MAXROWS * 4 <= WS_ROWGATE && WS_ROWGATE + (size_t)MAXROWS * 4 <= WS_BLKBASE && WS_ACT + (size_t)MAXROWS * 2048 <= WS_Y2 && WS_Y2 + (size_t)MAXROWS * 2048 <= WS_Y, "d_ws map");
constexpr int CW_TMO = 0, CW_CODE = 1;
constexpr int CW_BAR = 4096;
constexpr int CW_ATTQ = 8192;
constexpr int CW_ECNT = 12288;
static_assert((CW_ECNT + 2 * 64 * NEXP) * 4 <= (int)CTL_ZERO_BYTES, "CTL words inside the memset region");

constexpr int RING_OFF = 0, RING_BYTES = 131072;
constexpr int LDSCTL_OFF = RING_BYTES, MISC_OFF = LDSCTL_OFF + 320;
constexpr int LDS_BYTES = 147456;
static_assert(MISC_OFF + 128 <= LDS_BYTES, "LDS map");
#define GAS __attribute__((address_space(1)))
#define LAS __attribute__((address_space(3)))
typedef unsigned short bf16;
typedef unsigned v4u __attribute__((ext_vector_type(4)));
typedef float f32x4 __attribute__((ext_vector_type(4)));
typedef short bf16x8 __attribute__((ext_vector_type(8)));
typedef GAS unsigned gu32;
typedef GAS unsigned long long gu64;
#define RLX_AGENT __ATOMIC_RELAXED, __HIP_MEMORY_SCOPE_AGENT
#define LDS_WAIT() asm volatile("s_waitcnt lgkmcnt(0)" ::: "memory")
#define VM_WAIT() asm volatile("s_waitcnt vmcnt(0)" ::: "memory")
__device__ __forceinline__ unsigned long long rt() { return __builtin_amdgcn_s_memrealtime(); }
__device__ __forceinline__ unsigned f2bf(float f) { unsigned u = __builtin_bit_cast(unsigned, f); return (u + 0x7fffu + ((u >> 16) & 1u)) >> 16; }
__device__ __forceinline__ unsigned pk2(float lo, float hi) { return f2bf(lo) | (f2bf(hi) << 16); }

#define XB_TMO      128
#define XB_XCNT(j)  (256  + 64 * (j))
#define XB_XSUB(j)  (1280 + 64 * (j))
#define XB_XGEN(j)  (2304 + 64 * (j))
#define XB_TOP      3328
#define XB_TOPGEN   3392
#define XCD_BAR_WORDS 3456
#define XB_SPIN_CAP (1u << 18)

__device__ __forceinline__ unsigned xb_ld(unsigned* p)              { return __hip_atomic_load(p, __ATOMIC_RELAXED, __HIP_MEMORY_SCOPE_AGENT); }
__device__ __forceinline__ unsigned xb_add(unsigned* p, unsigned v) { return __hip_atomic_fetch_add(p, v, __ATOMIC_RELAXED, __HIP_MEMORY_SCOPE_AGENT); }
__device__ __forceinline__ unsigned xb_xcc_id() { return (unsigned)__builtin_amdgcn_s_getreg((3 << 11) | 20) & 0xFu; }
#define XB_SPIN(cond, bar) do { unsigned _sp = 0; while (cond) { __builtin_amdgcn_s_sleep(1); \
    if ((++_sp & 255u) == 0u) { if (xb_ld(&(bar)[XB_TMO])) break; if (_sp > XB_SPIN_CAP) { atomicAdd(&(bar)[XB_TMO], 1u); break; } } } } while (0)

struct XcdBarrier {
    unsigned* bar; unsigned x; int wid;
    volatile LAS unsigned* st;
};

__device__ __forceinline__ XcdBarrier xcd_barrier_post(unsigned* bar, volatile LAS unsigned* st, int wid) {
    XcdBarrier b; b.bar = bar; b.x = xb_xcc_id(); b.st = st; b.wid = wid;
    if (threadIdx.x == 0) (void)xb_add(&bar[XB_XCNT(b.x)], 1u);
    return b;
}
__device__ __forceinline__ void xcd_barrier_complete(unsigned* bar, unsigned x, unsigned& nloc, unsigned& nx) {
    const unsigned G = gridDim.x * gridDim.y * gridDim.z;
    unsigned sum, cnt, mine, sp = 0u;
    for (;;) {
        sum = 0u; cnt = 0u; mine = 0u;
#pragma unroll
        for (unsigned j = 0; j < 16; ++j) { const unsigned c = xb_ld(&bar[XB_XCNT(j)]); sum += c; cnt += (c > 0u) ? 1u : 0u; mine = (j == x) ? c : mine; }
        if (sum == G) break;
        __builtin_amdgcn_s_sleep(1);
        if ((++sp & 255u) == 0u) { if (xb_ld(&bar[XB_TMO])) break; if (sp > XB_SPIN_CAP) { atomicAdd(&bar[XB_TMO], 1u); break; } }
    }
    nloc = mine > 0u ? mine : 1u; nx = cnt > 0u ? cnt : 1u;
}

__device__ __forceinline__ void xcd_barrier(const XcdBarrier& b) {
    asm volatile("s_waitcnt vmcnt(0)" ::: "memory");
    __syncthreads();
    if (b.wid == 0 && lane_id_v() == 0) {
        unsigned* bar = b.bar;
        __builtin_amdgcn_s_waitcnt(0);
        unsigned nloc = b.st[0], nx = b.st[1];
        if (nloc == 0u) { xcd_barrier_complete(bar, b.x, nloc, nx); b.st[0] = nloc; b.st[1] = nx; }
        const unsigned old = xb_add(&bar[XB_XSUB(b.x)], 1u);
        const unsigned gen = old / nloc;
        if (old + 1u == (gen + 1u) * nloc) {
            __builtin_amdgcn_fence(__ATOMIC_RELEASE, "agent");
            asm volatile("s_waitcnt vmcnt(0)" ::: "memory");
            const unsigned og = xb_add(&bar[XB_TOP], 1u);
            const unsigned tg = og / nx;
            if (og + 1u == (tg + 1u) * nx) xb_add(&bar[XB_TOPGEN], 1u);
            else XB_SPIN(xb_ld(&bar[XB_TOPGEN]) == tg, bar);
            __builtin_amdgcn_fence(__ATOMIC_ACQUIRE, "agent");
            xb_add(&bar[XB_XGEN(b.x)], 1u);
            asm volatile("s_waitcnt vmcnt(0)" ::: "memory");
        } else {
            XB_SPIN(xb_ld(&bar[XB_XGEN(b.x)]) == gen, bar);
            __builtin_amdgcn_fence(__ATOMIC_ACQUIRE, "agent");
            asm volatile("s_waitcnt vmcnt(0)" ::: "memory");
        }
    }
    __syncthreads();
}
typedef float f32x2 __attribute__((ext_vector_type(2)));
typedef unsigned u32x2 __attribute__((ext_vector_type(2)));
struct Frame {
    LAS unsigned char* lds;
    volatile LAS unsigned* MISC;
    gu32* ctl;
    int wave;
    int vcu, G;
    unsigned char* ws; float* out;
};
struct Args { const void* in[33]; float* out; unsigned char* ws; int ph_lo, ph_hi, li, pad; };
struct InProxy { __device__ __forceinline__ const void* operator[](int k) const { unsigned long long v; const unsigned long long kp = (unsigned long long)__builtin_amdgcn_kernarg_segment_ptr();
    asm volatile("s_load_dwordx2 %0, %1, %2\n\ts_waitcnt lgkmcnt(0)" : "=s"(v) : "s"(kp), "s"(8 * k) : "memory"); return (const void*)v; } };
struct ArgsD { InProxy in; };

__device__ __forceinline__ float wave_sum(float v) {
#pragma unroll
    for (int o = 1; o < 64; o <<= 1) v += __shfl_xor(v, o);
    return v;
}
__device__ __forceinline__ float bf2f(unsigned short u) { return __uint_as_float((unsigned)u << 16); }
__device__ __forceinline__ float bflo(unsigned u) { return __uint_as_float(u << 16); }
__device__ __forceinline__ float bfhi(unsigned u) { return __uint_as_float(u & 0xffff0000u); }
typedef float f32x2_t __attribute__((ext_vector_type(2))); typedef __bf16 bf16x2_t __attribute__((ext_vector_type(2)));
__device__ __forceinline__ unsigned pkbf(float lo, float hi) { f32x2_t v = {lo, hi}; bf16x2_t b = __builtin_convertvector(v, bf16x2_t); return __builtin_bit_cast(unsigned, b); }
#define DPP_ADD(x, ctrl) ((x) + __builtin_bit_cast(float, __builtin_amdgcn_update_dpp(0, __builtin_bit_cast(int, (x)), (ctrl), 0xF, 0xF, true)))
__device__ __forceinline__ float allsum16(float x) {
    x = DPP_ADD(x, 0xB1); x = DPP_ADD(x, 0x4E); x = DPP_ADD(x, 0x124); x = DPP_ADD(x, 0x128); return x; }

struct P0Item { const float* src; bf16* dst; int N, K, n0; bool permq; };
__device__ __forceinline__ bool p0_decode(const Frame& F, int it, P0Item& d, const float* w_in, const float* w_out, const float* w1, const float* w2m) {
    constexpr int I_IN = (D / 64) * (IN_COLS / 32), I_OUT = (D / 64) * (D / 32), I_W1 = (D / 64) * (2048 / 32), I_W2 = (D / 64) * (D / 32);
    constexpr int NITEMS = I_IN + I_OUT + NEXP * I_W1 + NEXP * I_W2;
    if (it >= NITEMS) return false;
    const float* W; bf16* WT; int N, r = it; d.permq = false; d.K = D;
    if (r < I_IN) { W = w_in; WT = (bf16*)(F.ws + WS_WIN); N = IN_COLS; d.permq = true; }
    else { r -= I_IN; if (r < I_OUT) { W = w_out; WT = (bf16*)(F.ws + WS_WOUT); N = D; }
        else { r -= I_OUT; if (r < NEXP * I_W1) { const int e = r / I_W1; r -= e * I_W1; W = w1 + (size_t)e * D * 2048; WT = (bf16*)(F.ws + WS_W1) + (size_t)e * 2048 * D; N = 2048; }
            else { r -= NEXP * I_W1; const int e = r / I_W2; r -= e * I_W2; W = w2m + (size_t)e * D * D; WT = (bf16*)(F.ws + WS_W2) + (size_t)e * D * D; N = D; } } }
    const int nblk = N / 32, kb = r / nblk, nb = r - kb * nblk; d.N = N; d.n0 = 32 * nb; d.src = W + (size_t)(64 * kb) * N + d.n0; d.dst = WT + 64 * kb; return true;
}
__device__ __forceinline__ void p0_item_store(const P0Item& d, const float (&v)[32], LAS float* scr, int lane) {
#pragma unroll
    for (int i = 0; i < 32; ++i) scr[(2 * i + (lane >> 5)) * 33 + (lane & 31)] = v[i];
    LDS_WAIT(); asm volatile("" ::: "memory");
    const int c = lane & 7;
#pragma unroll
    for (int j = 0; j < 4; ++j) { const int n = (lane >> 3) + 8 * j; const LAS float* s = scr + (8 * c) * 33 + n;
        v4u o; o.x = pkbf(s[0 * 33], s[1 * 33]); o.y = pkbf(s[2 * 33], s[3 * 33]); o.z = pkbf(s[4 * 33], s[5 * 33]); o.w = pkbf(s[6 * 33], s[7 * 33]);
        int nn = d.n0 + n;
        if (d.permq && nn < 1024) { const int dd = nn & 63; if (dd < 16) nn = (nn & ~63) + ((dd < 8) ? 2 * dd : 2 * (dd - 8) + 1); }
        *(GAS v4u*)(d.dst + (size_t)nn * d.K + 8 * c) = o; }
    LDS_WAIT(); asm volatile("" ::: "memory");
}
__device__ __forceinline__ void sincos_d(float af, float& s, float& c) {
    const double a = (double)af; const double n = __builtin_rint(a * 0.63661977236758134308);
    double r = __builtin_fma(-n, 1.57079632679489655800e+00, a); r = __builtin_fma(-n, 6.12323399573676603587e-17, r);
    const double r2 = r * r;
    double sp = 1.0 / 6227020800.0; sp = sp * r2 * -1.0 + 1.0 / 39916800.0; sp = -sp * r2 + 1.0 / 362880.0; sp = -sp * r2 + 1.0 / 5040.0; sp = -sp * r2 + 1.0 / 120.0; sp = -sp * r2 + 1.0 / 6.0; sp = r - r * r2 * sp;
    double cp = 1.0 / 87178291200.0; cp = -cp * r2 + 1.0 / 479001600.0; cp = -cp * r2 + 1.0 / 3628800.0; cp = -cp * r2 + 1.0 / 40320.0; cp = -cp * r2 + 1.0 / 720.0; cp = -cp * r2 + 1.0 / 24.0; cp = -cp * r2 + 0.5; cp = 1.0 - r2 * cp;
    const int q = ((int)n) & 3;
    const double sv = (q == 0) ? sp : (q == 1) ? cp : (q == 2) ? -sp : -cp, cv = (q == 0) ? cp : (q == 1) ? -sp : (q == 2) ? -cp : sp;
    s = (float)sv; c = (float)cv;
}
__device__ __forceinline__ void p0_prologue(Frame& F, const ArgsD& A) {
    const int lane = lane_id_v(), tid = F.wave * 64 + lane; (void)tid;
    const int gw = F.vcu * NWAVES + F.wave, NGW = F.G * NWAVES, gt = F.vcu * 512 + tid, NGT = F.G * 512;
    LAS float* scr = (LAS float*)(F.lds + RING_OFF + F.wave * 12288);
    LAS float* sl = (LAS float*)(F.lds + RING_OFF + 98304);
    const float* c = (const float*)A.in[1];
    for (int i = tid; i < 8 * 1024; i += 512) { const float v = c[i]; sl[i] = v / (1.f + __expf(-v)); }
    __syncthreads();
    { const float* aw = (const float*)A.in[3]; float* modp = (float*)(F.ws + WS_MODP);
      for (int it = gw; it < 96 * MOD_KS; it += NGW) { const int cc = it % 96, ks = it / 96, col = cc * 64 + lane;
          float acc[8];
#pragma unroll
          for (int b = 0; b < 8; ++b) acc[b] = 0.f;
          for (int k = ks * 128; k < ks * 128 + 128; ++k) { const float w = aw[(size_t)k * NMOD + col];
#pragma unroll
              for (int b = 0; b < 8; ++b) acc[b] += sl[b * 1024 + k] * w; }
#pragma unroll
          for (int b = 0; b < 8; ++b) modp[(size_t)(ks * 8 + b) * NMOD + col] = acc[b]; } }
    { const int* pos = (const int*)A.in[2]; float* rope = (float*)(F.ws + WS_ROPE);
      for (int idx = gt; idx < M * 8; idx += NGT) { const int m = idx >> 3, i = idx & 7;
          const float invf = (i == 0) ? 1.0f : (i == 1) ? 0.1939227432012558f : (i == 2) ? 0.03760603070259094f : (i == 3) ? 0.007292664609849453f : (i == 4) ? 0.0014142135623842478f : (i == 5) ? 0.00027424818836152554f : (i == 6) ? 5.318296098266728e-05f : 1.0313386155758053e-05f;
          const float ang = (float)pos[m] * invf; float s, cc; sincos_d(ang, s, cc); rope[(size_t)m * 16 + i] = cc; rope[(size_t)m * 16 + 8 + i] = s; } }
    { const float* w2 = (const float*)A.in[18]; const float* a2 = (const float*)A.in[20]; const float* g2 = (const float*)A.in[21]; bf16* bl = (bf16*)(F.ws + WS_BLORA);
      for (int idx = gt; idx < 1536 * 256; idx += NGT) { const int n = idx >> 8, k = idx & 255, blk = n >> 9, nn = n & 511; float v = 0.f;
          if (blk == 0 && k < 64) v = w2[k * 512 + nn]; else if (blk == 1 && k >= 64 && k < 128) v = a2[(k - 64) * 512 + nn]; else if (blk == 2 && k >= 128) v = g2[(k - 128) * 512 + nn];
          bl[idx] = (bf16)(pkbf(v, 0.f) & 0xffffu); } }
    { const float* w_in = (const float*)A.in[9]; const float* w_out = (const float*)A.in[10]; const float* w1 = (const float*)A.in[29]; const float* w2m = (const float*)A.in[31];
      P0Item cur, nxt; float v[32], vn[32];
      bool have = p0_decode(F, gw, cur, w_in, w_out, w1, w2m);
      if (have) {
#pragma unroll
          for (int i = 0; i < 32; ++i) v[i] = cur.src[(size_t)(2 * i + (lane >> 5)) * cur.N + (lane & 31)]; }
      for (int it = gw; have; it += NGW) {
          const bool hn = p0_decode(F, it + NGW, nxt, w_in, w_out, w1, w2m);
          if (hn) {
#pragma unroll
              for (int i = 0; i < 32; ++i) vn[i] = nxt.src[(size_t)(2 * i + (lane >> 5)) * nxt.N + (lane & 31)]; }
          p0_item_store(cur, v, scr, lane);
          cur = nxt; have = hn;
#pragma unroll
          for (int i = 0; i < 32; ++i) v[i] = vn[i];
      } }
}

__device__ __forceinline__ void p1_premix(Frame& F, const ArgsD& A) {
    const int lane = lane_id_v(), tid = F.wave * 64 + lane; (void)tid;
    const float* modp = (const float*)(F.ws + WS_MODP); const float* ada_b = (const float*)A.in[4]; float* mod = (float*)(F.ws + WS_MOD);
    const int rows_per = M / F.G, mbeg = F.vcu * rows_per, b = mbeg >> 12;
    LAS float* ms = (LAS float*)(F.lds + RING_OFF);
    for (int col = tid; col < 2048; col += 512) { float s = ada_b[col];
#pragma unroll
        for (int ks = 0; ks < MOD_KS; ++ks) s += modp[(size_t)(ks * 8 + b) * NMOD + col];
        ms[col] = s; }
    for (int i = F.vcu * 512 + tid; i < 8 * 4096; i += F.G * 512) { const int bb = i >> 12, col = 2048 + (i & 4095); float s = ada_b[col];
#pragma unroll
        for (int ks = 0; ks < MOD_KS; ++ks) s += modp[(size_t)(ks * 8 + bb) * NMOD + col];
        mod[(size_t)bb * NMOD + col] = s; }
    __syncthreads();
    const float* x = (const float*)A.in[0]; const float* nw = (const float*)A.in[5]; bf16* H = (bf16*)(F.ws + WS_H);
    f32x4 wsc[4], sh[4];
#pragma unroll
    for (int j = 0; j < 4; ++j) { const int col = 4 * lane + 256 * j; wsc[j] = *((const f32x4*)nw + lane + 64 * j) * (*(const LAS f32x4*)(ms + 1024 + col) + 1.f); sh[j] = *(const LAS f32x4*)(ms + col); }
    const int nr = rows_per / NWAVES, m0 = mbeg + F.wave * nr;
    f32x4 pv[4];
#pragma unroll
    for (int j = 0; j < 4; ++j) pv[j] = *((const GAS f32x4*)(x + (size_t)m0 * D) + lane + 64 * j);
    for (int i = 0; i < nr; ++i) { const int m = m0 + i;
        f32x4 v[4]; float s2 = 0.f;
#pragma unroll
        for (int j = 0; j < 4; ++j) { v[j] = pv[j]; s2 += (v[j].x * v[j].x + v[j].y * v[j].y) + (v[j].z * v[j].z + v[j].w * v[j].w); }
        if (i + 1 < nr) {
#pragma unroll
            for (int j = 0; j < 4; ++j) pv[j] = *((const GAS f32x4*)(x + (size_t)(m + 1) * D) + lane + 64 * j); }
        const float rs = __builtin_amdgcn_rsqf(wave_sum(s2) * (1.f / D) + 1e-6f);
        GAS u32x2* o8 = (GAS u32x2*)(H + (size_t)m * D) + lane;
#pragma unroll
        for (int j = 0; j < 4; ++j) { const f32x4 y = v[j] * rs * wsc[j] + sh[j]; o8[64 * j] = (u32x2){pkbf(y.x, y.y), pkbf(y.z, y.w)}; } }
}

__device__ __forceinline__ void p3_lact(Frame& F, const ArgsD& A) {
    const int lane = lane_id_v(), tid = F.wave * 64 + lane; (void)tid;
    const bf16* RW = (const bf16*)(F.ws + WS_RW); bf16* L = (bf16*)(F.ws + WS_LACT); const float* mu = (const float*)A.in[16] + 1536;
    const int gw = F.vcu * NWAVES + F.wave, NGW = F.G * NWAVES, c0 = 4 * lane;
    const f32x4 mu4 = *(const f32x4*)(mu + c0);
    for (int m = gw; m < M; m += NGW) { const int t = m & (T - 1);
        const u32x2 p = *(const GAS u32x2*)(RW + (size_t)m * RWC + 1536 + c0); u32x2 q = (u32x2){0u, 0u}; if (t > 0) q = *(const GAS u32x2*)(RW + (size_t)(m - 1) * RWC + 1536 + c0);
        f32x4 pv = (f32x4){bflo(p.x), bfhi(p.x), bflo(p.y), bfhi(p.y)}, qv = (f32x4){bflo(q.x), bfhi(q.x), bflo(q.y), bfhi(q.y)};
        f32x4 s = pv + (qv - pv) * mu4;
        if (c0 < 64) { s.x = tanhf(s.x); s.y = tanhf(s.y); s.z = tanhf(s.z); s.w = tanhf(s.w); }
        else if (c0 >= 128) { s.x = 1.f / (1.f + __expf(-s.x)); s.y = 1.f / (1.f + __expf(-s.y)); s.z = 1.f / (1.f + __expf(-s.z)); s.w = 1.f / (1.f + __expf(-s.w)); }
        *(GAS u32x2*)(L + (size_t)m * 256 + c0) = (u32x2){pkbf(s.x, s.y), pkbf(s.z, s.w)}; }
}

namespace rwk {
typedef short bf16x8 __attribute__((ext_vector_type(8)));
constexpr int MB = 8192;
__device__ __forceinline__ int moff(int r, int c) { return r * 128 + ((((c >> 3) ^ (r >> 1)) & 7) << 4) + ((c & 7) << 1); }
__device__ __forceinline__ bf16x8 frag(const LAS unsigned char* buf, int row, int chunk) { return *(const LAS bf16x8*)(buf + row * 128 + (((chunk ^ (row >> 1)) & 7) << 4)); }
__device__ __forceinline__ void mm(f32x4& acc, const LAS unsigned char* A, int tm, const LAS unsigned char* B, int tn, int l) {
    const int ar = 16 * tm + (l & 15), br = 16 * tn + (l & 15), q = l >> 4;
#pragma unroll
    for (int ks = 0; ks < 2; ++ks) { const bf16x8 a = frag(A, ar, 4 * ks + q), b = frag(B, br, 4 * ks + q); acc = __builtin_amdgcn_mfma_f32_16x16x32_bf16(a, b, acc, 0, 0, 0); }
}
__device__ __forceinline__ void st_nm(LAS unsigned char* buf, int tm, int tn, int l, f32x4 v) {
    const int row = 16 * tn + (l & 15), c = 16 * tm + 4 * (l >> 4); *(LAS u32x2*)(buf + moff(row, c)) = (u32x2){pkbf(v[0], v[1]), pkbf(v[2], v[3])}; }
__device__ __forceinline__ void st_mn(LAS unsigned char* buf, int tm, int tn, int l, f32x4 v) {
    const int c = 16 * tn + (l & 15), r0 = 16 * tm + 4 * (l >> 4); const unsigned p0 = pkbf(v[0], v[1]), p1 = pkbf(v[2], v[3]);
    *(LAS unsigned short*)(buf + moff(r0 + 0, c)) = (unsigned short)(p0 & 0xffffu); *(LAS unsigned short*)(buf + moff(r0 + 1, c)) = (unsigned short)(p0 >> 16);
    *(LAS unsigned short*)(buf + moff(r0 + 2, c)) = (unsigned short)(p1 & 0xffffu); *(LAS unsigned short*)(buf + moff(r0 + 3, c)) = (unsigned short)(p1 >> 16); }
__device__ __forceinline__ f32x4 ld_nm(const LAS unsigned char* buf, int tm, int tn, int l) {
    const int row = 16 * tn + (l & 15), c = 16 * tm + 4 * (l >> 4); const u32x2 p = *(const LAS u32x2*)(buf + moff(row, c)); return (f32x4){bflo(p.x), bfhi(p.x), bflo(p.y), bfhi(p.y)}; }
__device__ __forceinline__ float wsum64(float x) {
    x = DPP_ADD(x, 0xB1); x = DPP_ADD(x, 0x4E); x = DPP_ADD(x, 0x124); x = DPP_ADD(x, 0x128);
    x += __shfl_xor(x, 16); x += __shfl_xor(x, 32); return x; }
__device__ __forceinline__ float sum8(float x) { x = DPP_ADD(x, 0xB1); x = DPP_ADD(x, 0x4E); x = DPP_ADD(x, 0x141); return x; }
}

__device__ __forceinline__ void rwkv_pre(Frame& F, const ArgsD& A, const int bh, const int c_lo, const int c_hi) {
    using namespace rwk;
    const int b = bh >> 3, h = bh & 7, lane0 = lane_id_v(), w0 = F.wave;
    LAS unsigned char* L = F.lds + RING_OFF;
    LAS unsigned char* bA = L + 0 * MB; LAS unsigned char* bR = L + 1 * MB; LAS unsigned char* bB = L + 2 * MB; LAS unsigned char* bK = L + 3 * MB;
    LAS unsigned char* bBH = L + 4 * MB; LAS unsigned char* bKH = L + 5 * MB; LAS unsigned char* bVT = L + 6 * MB;
    LAS unsigned char* bAT = L + 7 * MB;
    LAS unsigned char* bAak = L + 9 * MB; LAS unsigned char* bArb = L + 10 * MB; LAS unsigned char* bArk = L + 11 * MB;
    LAS unsigned char* bQ0 = L + 12 * MB; LAS unsigned char* bQT0 = L + 13 * MB;
    LAS unsigned char* bT = L + 14 * MB;
    LAS unsigned char* bTF = L + 15 * MB;
    LAS float* part = (LAS float*)(F.lds + MISC_OFF + 128);
    LAS float* bon = part + 512;
    const bf16* RW = (const bf16*)(F.ws + WS_RW); const float* LW = (const float*)(F.ws + WS_LW); const float* AS = (const float*)(F.ws + WS_AS);
    unsigned char* IMG = F.ws + WS_RIMG; float* BON = (float*)(F.ws + WS_RBON);
    const size_t mb = (size_t)b * T;
    const float* mu = (const float*)A.in[16];
    float mu_r, mu_k, mu_v, kkc, kac, rkc;
    { const int hj = h * 64 + lane0; mu_r = mu[hj]; mu_k = mu[512 + hj]; mu_v = mu[1024 + hj]; kkc = ((const float*)A.in[22])[hj]; kac = ((const float*)A.in[23])[hj]; rkc = ((const float*)A.in[24])[hj]; }
    unsigned short pr[9], pk_[9], pv[9]; float plw[8], pas[8];
#define RWC_LOAD(c) do { const int w = w0, hj = h * 64 + lane0; const size_t m0_ = mb + (size_t)(c) * 64 + 8 * w; \
        _Pragma("unroll") for (int i_ = 0; i_ < 9; ++i_) { const bool ok_ = (i_ > 0) || ((c) > 0) || (w > 0); const bf16* row_ = RW + (m0_ + i_ - 1) * RWC + hj; \
            pr[i_] = ok_ ? row_[0] : (unsigned short)0; pk_[i_] = ok_ ? row_[512] : (unsigned short)0; pv[i_] = ok_ ? row_[1024] : (unsigned short)0; } \
        _Pragma("unroll") for (int i_ = 0; i_ < 8; ++i_) { plw[i_] = LW[(m0_ + i_) * 512 + hj]; pas[i_] = AS[(m0_ + i_) * 512 + hj]; } } while (0)
    RWC_LOAD(c_lo);
    for (int c = c_lo; c < c_hi; ++c) {
        int w = w0, lane = lane0; asm volatile("" : "+s"(w), "+v"(lane));
        const int tn_ = w & 3, tm0_ = 2 * (w >> 2);
        { float run = 0.f;
#pragma unroll
          for (int i = 0; i < 8; ++i) run += plw[i];
          part[w * 64 + lane] = run; }
        __syncthreads();
        float off = 0.f, ctot = 0.f;
#pragma unroll
        for (int o = 0; o < 8; ++o) { const float p = part[o * 64 + lane]; ctot += p; if (o < w) off += p; }
        {   unsigned bh_[4], kh_[4], vt_[4], at_[4]; float cm = off; float* bon_g = BON + ((size_t)bh * 64 + c) * 64;
#pragma unroll
            for (int i = 0; i < 8; ++i) { const int t = 8 * w + i;
                const float p0 = bf2f(pr[i + 1]), p1 = bf2f(pk_[i + 1]), p2 = bf2f(pv[i + 1]);
                const float rv = p0 + (bf2f(pr[i]) - p0) * mu_r, kv = p1 + (bf2f(pk_[i]) - p1) * mu_k, vv = p2 + (bf2f(pv[i]) - p2) * mu_v, asg = pas[i];
                const float ce = cm; cm += plw[i];
                float kkv = kv * kkc; const float n2 = wsum64(kkv * kkv); kkv = kkv * __builtin_amdgcn_rsqf(fmaxf(n2, 1e-24f));
                const float km = kv * (1.f + (asg - 1.f) * kac); const float bn = wsum64(rv * km * rkc); if (lane == 0) bon_g[t] = bn;
                const float av = -kkv, bv = kkv * asg;
                const float e_ce = __expf(ce), e_cm = __expf(cm), e_ncm = __expf(-cm), e_rem = __expf(ctot - cm);
                const unsigned ha = pkbf(av * e_ce, 0.f) & 0xffffu; *(LAS unsigned short*)(bA + moff(t, lane)) = (unsigned short)ha; *(LAS unsigned short*)(bR + moff(t, lane)) = (unsigned short)(pkbf(rv * e_cm, 0.f) & 0xffffu);
                *(LAS unsigned short*)(bB + moff(t, lane)) = (unsigned short)(pkbf(bv * e_ncm, 0.f) & 0xffffu); *(LAS unsigned short*)(bK + moff(t, lane)) = (unsigned short)(pkbf(km * e_ncm, 0.f) & 0xffffu);
                const unsigned hb = pkbf(bv * e_rem, 0.f) & 0xffffu, hk = pkbf(km * e_rem, 0.f) & 0xffffu, hv = pkbf(vv, 0.f) & 0xffffu;
                if (i & 1) { bh_[i >> 1] |= hb << 16; kh_[i >> 1] |= hk << 16; vt_[i >> 1] |= hv << 16; at_[i >> 1] |= ha << 16; } else { bh_[i >> 1] = hb; kh_[i >> 1] = hk; vt_[i >> 1] = hv; at_[i >> 1] = ha; } }
            *(LAS v4u*)(bBH + moff(lane, 8 * w)) = (v4u){bh_[0], bh_[1], bh_[2], bh_[3]};
            *(LAS v4u*)(bKH + moff(lane, 8 * w)) = (v4u){kh_[0], kh_[1], kh_[2], kh_[3]};
            *(LAS v4u*)(bVT + moff(lane, 8 * w)) = (v4u){vt_[0], vt_[1], vt_[2], vt_[3]};
            *(LAS v4u*)(bAT + moff(lane, 8 * w)) = (v4u){at_[0], at_[1], at_[2], at_[3]};
        }
        const float dec0 = __expf(ctot);
        if (c + 1 < c_hi) RWC_LOAD(c + 1);
        __syncthreads();
        {   const int p = w >> 1; const LAS unsigned char* Am = (p < 2) ? bA : bR; const LAS unsigned char* Bm = (p == 0 || p == 2) ? bB : bK;
#pragma unroll
            for (int x = 0; x < 2; ++x) { const int tm = 2 * (w & 1) + x;
#pragma unroll
                for (int tn = 0; tn < 4; ++tn) { f32x4 acc = (f32x4){0.f, 0.f, 0.f, 0.f}; mm(acc, Am, tm, Bm, tn, lane);
                    const int n = 16 * tn + (lane & 15), m0 = 16 * tm + 4 * (lane >> 4);
#pragma unroll
                    for (int r = 0; r < 4; ++r) { const bool keep = (p < 2) ? (n < m0 + r) : (n <= m0 + r); if (!keep) acc[r] = 0.f; }
                    if (p == 0) { st_mn(bQ0, tm, tn, lane, acc); st_nm(bQT0, tm, tn, lane, acc);
#pragma unroll
                        for (int r = 0; r < 4; ++r) if (n == m0 + r) acc[r] += 1.f;
                        st_nm(bT, tm, tn, lane, acc); }
                    else st_mn((p == 1) ? bAak : (p == 2) ? bArb : bArk, tm, tn, lane, acc); } }
        }
        __syncthreads();
#pragma unroll
        for (int x = 0; x < 2; ++x) { const int tm = tm0_ + x; f32x4 acc = (f32x4){0.f, 0.f, 0.f, 0.f}; mm(acc, bQ0, tm, bQT0, tn_, lane); st_mn(bB, tm, tn_, lane, acc); st_nm(bK, tm, tn_, lane, acc); }
        __syncthreads();
#pragma unroll
        for (int s = 2; s <= 5; ++s) {
            const LAS unsigned char* Qc = (s & 1) ? bQ0 : bB; const LAS unsigned char* QTc = (s & 1) ? bQT0 : bK;
            LAS unsigned char* Qn = (s & 1) ? bB : bQ0; LAS unsigned char* QTn = (s & 1) ? bK : bQT0;
            const int tn = w & 3;
            if (w >= 4) { f32x4 acc[4];
#pragma unroll
                for (int tm = 0; tm < 4; ++tm) acc[tm] = ld_nm(bT, tm, tn, lane);
#pragma unroll
                for (int tm = 0; tm < 4; ++tm) mm(acc[tm], Qc, tm, bT, tn, lane);
#pragma unroll
                for (int tm = 0; tm < 4; ++tm) st_nm(bT, tm, tn, lane, acc[tm]);
            } else {
#pragma unroll
                for (int tm = 0; tm < 4; ++tm) { f32x4 acc = (f32x4){0.f, 0.f, 0.f, 0.f}; mm(acc, Qc, tm, QTc, tn, lane); st_mn(Qn, tm, tn, lane, acc); st_nm(QTn, tm, tn, lane, acc); }
            }
            __syncthreads();
        }
        {
#pragma unroll
            for (int x = 0; x < 2; ++x) { const int tm = tm0_ + x; f32x4 acc = ld_nm(bT, tm, tn_, lane); mm(acc, bB, tm, bT, tn_, lane); st_mn(bTF, tm, tn_, lane, acc); }
        }
        LAS unsigned char* bX = bB; LAS unsigned char* bW = bK; LAS unsigned char* bU = bQ0;
        __syncthreads();
#pragma unroll
        for (int x = 0; x < 2; ++x) { const int tm = tm0_ + x;
            { f32x4 acc = (f32x4){0.f, 0.f, 0.f, 0.f}; mm(acc, bAak, tm, bVT, tn_, lane); st_nm(bX, tm, tn_, lane, acc); }
            { f32x4 acc = (f32x4){0.f, 0.f, 0.f, 0.f}; mm(acc, bTF, tm, bAT, tn_, lane); st_nm(bW, tm, tn_, lane, acc); } }
        __syncthreads();
#pragma unroll
        for (int x = 0; x < 2; ++x) { const int tm = tm0_ + x; f32x4 acc = (f32x4){0.f, 0.f, 0.f, 0.f}; mm(acc, bTF, tm, bX, tn_, lane); st_nm(bU, tm, tn_, lane, acc); }
        __syncthreads();
        {   unsigned char* img = IMG + ((size_t)bh * 64 + c) * (4 * MB);
            const int n_ = 16 * tn_ + (lane & 15); const float decn = __shfl(dec0, n_);
#pragma unroll
            for (int x = 0; x < 2; ++x) { const int tm = tm0_ + x; const int m0 = 16 * tm + 4 * (lane >> 4); const int go = moff(n_, m0);
                { f32x4 acc = (f32x4){0.f, 0.f, 0.f, 0.f}; mm(acc, bW, tm, bBH, tn_, lane);
#pragma unroll
                  for (int r = 0; r < 4; ++r) if (m0 + r == n_) acc[r] += decn;
                  *(GAS u32x2*)(img + 0 * MB + go) = (u32x2){pkbf(acc[0], acc[1]), pkbf(acc[2], acc[3])}; }
                { f32x4 acc = (f32x4){0.f, 0.f, 0.f, 0.f}; mm(acc, bBH, tm, bU, tn_, lane); mm(acc, bKH, tm, bVT, tn_, lane);
                  *(GAS u32x2*)(img + 1 * MB + go) = (u32x2){pkbf(acc[0], acc[1]), pkbf(acc[2], acc[3])}; }
                { f32x4 acc = ld_nm(bR, tm, tn_, lane); mm(acc, bW, tm, bArb, tn_, lane);
                  *(GAS u32x2*)(img + 2 * MB + go) = (u32x2){pkbf(acc[0], acc[1]), pkbf(acc[2], acc[3])}; }
                { f32x4 acc = (f32x4){0.f, 0.f, 0.f, 0.f}; mm(acc, bArb, tm, bU, tn_, lane); mm(acc, bArk, tm, bVT, tn_, lane);
                  *(GAS u32x2*)(img + 3 * MB + go) = (u32x2){pkbf(acc[0], acc[1]), pkbf(acc[2], acc[3])}; } }
        }
        __syncthreads();
    }
#undef RWC_LOAD
}

__device__ __forceinline__ void rwkv_seq(Frame& F, const ArgsD& A, const int bh) {
    using namespace rwk;
    const int b = bh >> 3, h = bh & 7, lane0 = lane_id_v(), w0 = F.wave;
    LAS unsigned char* L = F.lds + RING_OFF;
    LAS unsigned char* bS0 = L + 8 * MB;
    LAS float* ybuf = (LAS float*)(L + 10 * MB);
    const bf16* RW = (const bf16*)(F.ws + WS_RW); const float* G = (const float*)(F.ws + WS_G); bf16* YC = (bf16*)(F.ws + WS_YCAT);
    const unsigned char* IMG = F.ws + WS_RIMG + (size_t)bh * 64 * (4 * MB); const float* BON = (const float*)(F.ws + WS_RBON) + (size_t)bh * 64 * 64;
    const float* mu = (const float*)A.in[16]; const float* lnw_g = (const float*)A.in[25]; const float* lnb_g = (const float*)A.in[26];
    const size_t mb = (size_t)b * T;
    const int tid0 = w0 * 64 + lane0, lt0 = tid0 >> 3, hlc0 = h * 64 + (tid0 & 7) * 8;
    for (int i = tid0; i < MB / 16; i += 512) ((LAS v4u*)bS0)[i] = (v4u){0u, 0u, 0u, 0u};
    v4u pf[4][4], lvp[4], lvq[4]; f32x4 lga[4], lgb[4]; float lbn[4];
#define RWS_LOAD(u, c) do { _Pragma("unroll") for (int k_ = 0; k_ < 4; ++k_) pf[u][k_] = *(const GAS v4u*)(IMG + (size_t)(c) * (4 * MB) + k_ * MB + tid0 * 16); \
        const size_t ml_ = mb + (size_t)(c) * 64 + lt0; lvp[u] = *(const GAS v4u*)(RW + ml_ * RWC + 1024 + hlc0); lvq[u] = *(const GAS v4u*)(RW + (ml_ - (((c) > 0 || lt0 > 0) ? 1 : 0)) * RWC + 1024 + hlc0); \
        lga[u] = *(const GAS f32x4*)(G + ml_ * 512 + hlc0); lgb[u] = *(const GAS f32x4*)(G + ml_ * 512 + hlc0 + 4); lbn[u] = BON[(c) * 64 + lt0]; } while (0)
#pragma unroll
    for (int u = 0; u < 4; ++u) RWS_LOAD(u, u);
    int scur = 0;
    for (int c4 = 0; c4 < T / 64; c4 += 4) {
#pragma unroll
      for (int u = 0; u < 4; ++u) { const int c = c4 + u;
        int w = w0, lane = lane0; asm volatile("" : "+s"(w), "+v"(lane));
        const int tid = w * 64 + lane, tn_ = w & 3, tm0_ = 2 * (w >> 2), lt = tid >> 3, lc = (tid & 7) * 8, hlc = h * 64 + lc;
        LAS unsigned char* set = L + (c & 1) * (4 * MB);
#pragma unroll
        for (int k = 0; k < 4; ++k) *(LAS v4u*)(set + k * MB + tid * 16) = pf[u][k];
        const v4u lv_p = lvp[u], lv_q = (c > 0 || lt > 0) ? lvq[u] : (v4u){0u, 0u, 0u, 0u}; const f32x4 lg0 = lga[u], lg1 = lgb[u]; const float bn = lbn[u];
        __syncthreads();
        if (c + 4 < T / 64) RWS_LOAD(u, c + 4);
        const LAS unsigned char* Sc = bS0 + scur * MB; LAS unsigned char* Sn = bS0 + (scur ^ 1) * MB;
#pragma unroll
        for (int x = 0; x < 2; ++x) { const int tm = tm0_ + x;
            { f32x4 acc = ld_nm(set + 1 * MB, tm, tn_, lane); mm(acc, set + 0 * MB, tm, Sc, tn_, lane); st_nm(Sn, tm, tn_, lane, acc); }
            { f32x4 acc = ld_nm(set + 3 * MB, tm, tn_, lane); mm(acc, set + 2 * MB, tm, Sc, tn_, lane);
              const int i = 16 * tn_ + (lane & 15), t0 = 16 * tm + 4 * (lane >> 4);
#pragma unroll
              for (int r = 0; r < 4; ++r) ybuf[(t0 + r) * 64 + i] = acc[r]; } }
        scur ^= 1;
        __syncthreads();
        {   const f32x4 y0 = *(const LAS f32x4*)(ybuf + lt * 64 + lc), y1 = *(const LAS f32x4*)(ybuf + lt * 64 + lc + 4);
            const float mean = sum8((y0.x + y0.y) + (y0.z + y0.w) + (y1.x + y1.y) + (y1.z + y1.w)) * (1.f / 64.f); const f32x4 d0 = y0 - mean, d1 = y1 - mean;
            const float var = sum8((d0.x * d0.x + d0.y * d0.y) + (d0.z * d0.z + d0.w * d0.w) + (d1.x * d1.x + d1.y * d1.y) + (d1.z * d1.z + d1.w * d1.w)) * (1.f / 64.f); const float rs = __builtin_amdgcn_rsqf(var + 64e-5f);
            const float* lnw_p = lnw_g + hlc; const float* lnb_p = lnb_g + hlc; const float* muv_p = mu + 1024 + hlc;
            const f32x4 lw0 = *(const f32x4*)lnw_p, lw1 = *(const f32x4*)(lnw_p + 4), lb0 = *(const f32x4*)lnb_p, lb1 = *(const f32x4*)(lnb_p + 4), mv0 = *(const f32x4*)muv_p, mv1 = *(const f32x4*)(muv_p + 4);
            f32x4 va = (f32x4){bflo(lv_p.x), bfhi(lv_p.x), bflo(lv_p.y), bfhi(lv_p.y)}, vb = (f32x4){bflo(lv_p.z), bfhi(lv_p.z), bflo(lv_p.w), bfhi(lv_p.w)};
            { const f32x4 qa = (f32x4){bflo(lv_q.x), bfhi(lv_q.x), bflo(lv_q.y), bfhi(lv_q.y)}, qb = (f32x4){bflo(lv_q.z), bfhi(lv_q.z), bflo(lv_q.w), bfhi(lv_q.w)}; va = va + (qa - va) * mv0; vb = vb + (qb - vb) * mv1; }
            const f32x4 o0 = ((d0 * rs) * lw0 + lb0 + va * bn) * lg0, o1 = ((d1 * rs) * lw1 + lb1 + vb * bn) * lg1;
            *(GAS v4u*)(YC + (mb + (size_t)c * 64 + lt) * 1024 + 512 + hlc) = (v4u){pkbf(o0.x, o0.y), pkbf(o0.z, o0.w), pkbf(o1.x, o1.y), pkbf(o1.z, o1.w)};
        }
      }
    }
#undef RWS_LOAD
}

__device__ __forceinline__ void p6_dacombine(Frame& F, const ArgsD& A) {
    const int lane = lane_id_v(), tid = F.wave * 64 + lane; (void)tid;
    const float* q1 = (const float*)A.in[11]; const float* k1 = (const float*)A.in[12]; const float* q2 = (const float*)A.in[13]; const float* k2 = (const float*)A.in[14];
    const float lam = __expf(wave_sum(q1[lane] * k1[lane])) - __expf(wave_sum(q2[lane] * k2[lane])) + 0.2f;
    const bf16* O = (const bf16*)(F.ws + WS_O); bf16* YC = (bf16*)(F.ws + WS_YCAT);
    const int gw = F.vcu * NWAVES + F.wave, NGW = F.G * NWAVES, dh = lane >> 4, d0 = 8 * (lane & 15);
    const float* sw = (const float*)A.in[15] + d0; const f32x4 swa = *(const f32x4*)sw * 0.8f, swb = *(const f32x4*)(sw + 4) * 0.8f;
    for (int m = gw; m < M; m += NGW) {
        const v4u a = *(const GAS v4u*)(O + (size_t)m * 1024 + dh * 256 + d0), c = *(const GAS v4u*)(O + (size_t)m * 1024 + dh * 256 + 128 + d0);
        f32x4 y0 = (f32x4){bflo(a.x) - lam * bflo(c.x), bfhi(a.x) - lam * bfhi(c.x), bflo(a.y) - lam * bflo(c.y), bfhi(a.y) - lam * bfhi(c.y)};
        f32x4 y1 = (f32x4){bflo(a.z) - lam * bflo(c.z), bfhi(a.z) - lam * bfhi(c.z), bflo(a.w) - lam * bflo(c.w), bfhi(a.w) - lam * bfhi(c.w)};
        float s2 = (y0.x * y0.x + y0.y * y0.y) + (y0.z * y0.z + y0.w * y0.w) + (y1.x * y1.x + y1.y * y1.y) + (y1.z * y1.z + y1.w * y1.w);
        s2 = allsum16(s2); const float rs = 1.f / sqrtf(s2 * (1.f / 128.f) + 1e-5f);
        y0 = y0 * rs * swa; y1 = y1 * rs * swb;
        *(GAS v4u*)(YC + (size_t)m * 1024 + dh * 128 + d0) = (v4u){pkbf(y0.x, y0.y), pkbf(y0.z, y0.w), pkbf(y1.x, y1.y), pkbf(y1.z, y1.w)}; }
}

#define P9_SWAP32(a, b) do { const auto r_ = __builtin_amdgcn_permlane32_swap(__float_as_uint(a), __float_as_uint(b), false, false); (a) = __uint_as_float(r_[0]) + __uint_as_float(r_[1]); } while (0)
#define P9_SWAP16(a, b) do { const auto r_ = __builtin_amdgcn_permlane16_swap(__float_as_uint(a), __float_as_uint(b), false, false); (a) = __uint_as_float(r_[0]) + __uint_as_float(r_[1]); } while (0)
#define P9_DPPF(x, ctrl) __builtin_bit_cast(float, __builtin_amdgcn_update_dpp(0, __builtin_bit_cast(int, (x)), (ctrl), 0xF, 0xF, true))
#define P9_DPPU(x, ctrl) ((unsigned)__builtin_amdgcn_update_dpp(0, (int)(x), (ctrl), 0xF, 0xF, true))
__device__ __forceinline__ float p9_reduce32(float (&a)[32], const int lane) {
#pragma unroll
    for (int e = 0; e < 16; ++e) P9_SWAP32(a[e], a[e + 16]);
#pragma unroll
    for (int e = 0; e < 8; ++e) P9_SWAP16(a[e], a[e + 8]);
    const bool b3 = (lane & 8) != 0, b2 = (lane & 4) != 0, b0 = (lane & 1) != 0;
#pragma unroll
    for (int e = 0; e < 4; ++e) { const float keep = b3 ? a[e + 4] : a[e], send = b3 ? a[e] : a[e + 4]; a[e] = keep + P9_DPPF(send, 0x128); }
#pragma unroll
    for (int e = 0; e < 2; ++e) { const float keep = b2 ? a[e + 2] : a[e], send = b2 ? a[e] : a[e + 2]; a[e] = keep + P9_DPPF(send, 0x141); }
    { const float keep = b0 ? a[1] : a[0], send = b0 ? a[0] : a[1]; a[0] = keep + P9_DPPF(send, 0xB1); }
    return a[0] + P9_DPPF(a[0], 0x4E);
}
__device__ __forceinline__ unsigned p9_wmax(unsigned v) {
    v = max(v, P9_DPPU(v, 0xB1)); v = max(v, P9_DPPU(v, 0x4E)); v = max(v, P9_DPPU(v, 0x124)); v = max(v, P9_DPPU(v, 0x128));
    const unsigned s0 = __builtin_amdgcn_readlane(v, 0), s1 = __builtin_amdgcn_readlane(v, 16), s2 = __builtin_amdgcn_readlane(v, 32), s3 = __builtin_amdgcn_readlane(v, 48);
    return max(max(s0, s1), max(s2, s3)); }
__device__ __forceinline__ void p8_postmix_router(Frame& F, const ArgsD& A, const int cset) {
    const int lane = lane_id_v(), tid = F.wave * 64 + lane; (void)tid;
    LAS float* rw = (LAS float*)(F.lds + RING_OFF);
    volatile LAS int* lcnt = (volatile LAS int*)(F.lds + LDSCTL_OFF);
    { const float* r = (const float*)A.in[27]; for (int i = tid; i < 1024 * 32; i += 512) { const int k = i >> 5, e = i & 31; rw[e * 1024 + k] = r[i]; } }
    if (tid < 32) lcnt[tid] = 0;
    __syncthreads();
    const float* x = (const float*)A.in[0]; const bf16* Y = (const bf16*)(F.ws + WS_Y); const float* mod = (const float*)(F.ws + WS_MOD);
    const float* pmn = (const float*)A.in[6]; const float* pfn = (const float*)A.in[7]; const float* rb = (const float*)A.in[28];
    bf16* H2 = (bf16*)(F.ws + WS_H2); int* tokE = (int*)(F.ws + WS_TOKE); float* tokG = (float*)(F.ws + WS_TOKG);
    const int rows_per = M / F.G, mbeg = F.vcu * rows_per, b = mbeg >> 12; const float* mb_ = mod + (size_t)b * NMOD;
    f32x4 a1[4], a2[4], sh[4];
#pragma unroll
    for (int j = 0; j < 4; ++j) { const int col = 4 * lane + 256 * j; a1[j] = *(const f32x4*)(pmn + col) * *(const f32x4*)(mb_ + 2048 + col); a2[j] = *(const f32x4*)(pfn + col) * (*(const f32x4*)(mb_ + 4096 + col) + 1.f); sh[j] = *(const f32x4*)(mb_ + 3072 + col); }
    const int myexp = 8 * (lane >> 4) + 4 * ((lane >> 3) & 1) + 2 * ((lane >> 2) & 1) + (lane & 1); const float rbias = rb[myexp];
    const int nr = rows_per / NWAVES, m0 = mbeg + F.wave * nr;
    u32x2 yp[2][4]; f32x4 xp[2][4];
#define P9_LOAD(m_) do { _Pragma("unroll") for (int t_ = 0; t_ < 2; ++t_) _Pragma("unroll") for (int j_ = 0; j_ < 4; ++j_) { \
        yp[t_][j_] = *((const GAS u32x2*)(Y + (size_t)((m_) + t_) * D) + lane + 64 * j_); xp[t_][j_] = *((const GAS f32x4*)(x + (size_t)((m_) + t_) * D) + lane + 64 * j_); } } while (0)
    P9_LOAD(m0);
    for (int i = 0; i < nr; i += 2) { const int m = m0 + i;
        f32x4 xv[2][4];
#pragma unroll
        for (int t = 0; t < 2; ++t) { f32x4 yv[4]; float s2 = 0.f;
#pragma unroll
            for (int j = 0; j < 4; ++j) { const u32x2 p = yp[t][j]; yv[j] = (f32x4){bflo(p.x), bfhi(p.x), bflo(p.y), bfhi(p.y)}; s2 += (yv[j].x * yv[j].x + yv[j].y * yv[j].y) + (yv[j].z * yv[j].z + yv[j].w * yv[j].w); }
            const float rs = __builtin_amdgcn_rsqf(wave_sum(s2) * (1.f / D) + 1e-6f); float t2 = 0.f;
#pragma unroll
            for (int j = 0; j < 4; ++j) { xv[t][j] = xp[t][j] + a1[j] * (yv[j] * rs); *((GAS f32x4*)(F.out + (size_t)(m + t) * D) + lane + 64 * j) = xv[t][j];
                t2 += (xv[t][j].x * xv[t][j].x + xv[t][j].y * xv[t][j].y) + (xv[t][j].z * xv[t][j].z + xv[t][j].w * xv[t][j].w); }
            const float rs2 = __builtin_amdgcn_rsqf(wave_sum(t2) * (1.f / D) + 1e-6f);
#pragma unroll
            for (int j = 0; j < 4; ++j) { xv[t][j] = xv[t][j] * rs2 * a2[j] + sh[j]; *((GAS u32x2*)(H2 + (size_t)(m + t) * D) + lane + 64 * j) = (u32x2){pkbf(xv[t][j].x, xv[t][j].y), pkbf(xv[t][j].z, xv[t][j].w)}; } }
        if (i + 2 < nr) P9_LOAD(m + 2);
        float ac0[32], ac1[32];
#pragma unroll
        for (int e = 0; e < 32; ++e) { float s0 = 0.f, s1 = 0.f;
#pragma unroll
            for (int j = 0; j < 4; ++j) { const f32x4 w = *(const LAS f32x4*)(rw + e * 1024 + 4 * lane + 256 * j);
                s0 += (xv[0][j].x * w.x + xv[0][j].y * w.y) + (xv[0][j].z * w.z + xv[0][j].w * w.w); s1 += (xv[1][j].x * w.x + xv[1][j].y * w.y) + (xv[1][j].z * w.z + xv[1][j].w * w.w); }
            ac0[e] = s0; ac1[e] = s1; }
        const float lg[2] = {p9_reduce32(ac0, lane) + rbias, p9_reduce32(ac1, lane) + rbias};
#pragma unroll
        for (int t = 0; t < 2; ++t) { const unsigned u = __float_as_uint(lg[t]); unsigned key = (((u >> 31) ? ~u : (u | 0x80000000u)) & ~31u) | (unsigned)(31 - myexp);
            float tv[4]; int ti[4];
#pragma unroll
            for (int k = 0; k < 4; ++k) { const unsigned mx = p9_wmax(key); ti[k] = 31 - (int)(mx & 31u); const unsigned kv = mx & ~31u; tv[k] = __uint_as_float((kv >> 31) ? (kv & 0x7fffffffu) : ~kv); if (key == mx) key = 0u; }
            float ew[4], es = 0.f;
#pragma unroll
            for (int k = 0; k < 4; ++k) { ew[k] = __expf(tv[k] - tv[0]); es += ew[k]; }
            if (lane < 4) { const int e = (lane == 0) ? ti[0] : (lane == 1) ? ti[1] : (lane == 2) ? ti[2] : ti[3]; const float g = ((lane == 0) ? ew[0] : (lane == 1) ? ew[1] : (lane == 2) ? ew[2] : ew[3]) / es;
                const int pos = __hip_atomic_fetch_add((LAS int*)lcnt + e, 1, __ATOMIC_RELAXED, __HIP_MEMORY_SCOPE_WORKGROUP);
                tokE[(size_t)(m + t) * 4 + lane] = e | (pos << 8); tokG[(size_t)(m + t) * 4 + lane] = g; } }
    }
#undef P9_LOAD
    __syncthreads();
    if (tid < 32) { const int n = lcnt[tid]; int base = 0; if (n > 0) base = (int)__hip_atomic_fetch_add(F.ctl + CW_ECNT + cset * 64 * NEXP + 64 * tid, (unsigned)n, __ATOMIC_RELAXED, __HIP_MEMORY_SCOPE_AGENT);
        ((int*)(F.ws + WS_BLKBASE))[F.vcu * 32 + tid] = base; }
}

__device__ __forceinline__ void moe_tables(Frame& F) {
    const int lane = lane_id_v(), tid = F.wave * 64 + lane; (void)tid;
    volatile LAS int* ts = (volatile LAS int*)(F.lds + LDSCTL_OFF);
    if (tid < 32) ts[40 + tid] = (int)__hip_atomic_load(F.ctl + CW_ECNT + 64 * tid, __ATOMIC_RELAXED, __HIP_MEMORY_SCOPE_AGENT);
    __syncthreads();
    if (tid == 0) { int acc = 0; for (int e = 0; e < 32; ++e) { ts[e] = acc; acc += (ts[40 + e] + 255) >> 8; } ts[32] = acc; }
    __syncthreads();
}
__device__ __forceinline__ void p9_rows(Frame& F) {
    const int lane = lane_id_v(), tid = F.wave * 64 + lane; (void)tid;
    moe_tables(F);
    volatile LAS int* ts = (volatile LAS int*)(F.lds + LDSCTL_OFF);
    const int* tokE = (const int*)(F.ws + WS_TOKE); const float* tokG = (const float*)(F.ws + WS_TOKG); const int* blkbase = (const int*)(F.ws + WS_BLKBASE) + F.vcu * 32;
    int* tokrow = (int*)(F.ws + WS_TOKROW); int* rowtok = (int*)(F.ws + WS_ROWTOK); float* rowgate = (float*)(F.ws + WS_ROWGATE);
    const int rows_per = M / F.G, mbeg = F.vcu * rows_per;
    for (int i = tid; i < rows_per * 4; i += 512) { const int idx = mbeg * 4 + i; const int pe = tokE[idx], e = pe & 255, pos = pe >> 8; const int row = ts[e] * 256 + blkbase[e] + pos;
        tokrow[idx] = row; rowtok[row] = idx >> 2; rowgate[row] = tokG[idx]; }
    for (int e = F.vcu; e < 32; e += F.G) { const int n = ts[40 + e]; const int r0 = ts[e] * 256 + n, r1 = ts[e + 1] * 256;
        for (int r = r0 + tid; r < r1; r += 512) { rowtok[r] = 0; rowgate[r] = 0.f; } }
}

__device__ __forceinline__ void p12_final(Frame& F, const ArgsD& A, float* dst) {
    const int lane = lane_id_v(), tid = F.wave * 64 + lane; (void)tid;
    const bf16* Y2 = (const bf16*)(F.ws + WS_Y2); const int* tokrow = (const int*)(F.ws + WS_TOKROW); const float* mod = (const float*)(F.ws + WS_MOD); const float* pn = (const float*)A.in[8];
    const int rows_per = M / F.G, mbeg = F.vcu * rows_per, b = mbeg >> 12, nr = rows_per / NWAVES, m0 = mbeg + F.wave * nr;
    const float* mb_ = mod + (size_t)b * NMOD + 5120;
    f32x4 gw[4];
#pragma unroll
    for (int j = 0; j < 4; ++j) { const int col = 4 * lane + 256 * j; gw[j] = *(const f32x4*)(pn + col) * *(const f32x4*)(mb_ + col); }
    const int myrow = tokrow[(size_t)m0 * 4 + (lane < nr * 4 ? lane : 0)];
    u32x2 yp[4][4]; f32x4 xp[4];
#define P13_LOAD(i_) do { _Pragma("unroll") for (int k_ = 0; k_ < 4; ++k_) { const int row_ = __builtin_amdgcn_readlane(myrow, 4 * (i_) + k_); \
        _Pragma("unroll") for (int j_ = 0; j_ < 4; ++j_) yp[k_][j_] = *((const GAS u32x2*)(Y2 + (size_t)row_ * D) + lane + 64 * j_); } \
        _Pragma("unroll") for (int j_ = 0; j_ < 4; ++j_) xp[j_] = *((const GAS f32x4*)(F.out + (size_t)(m0 + (i_)) * D) + lane + 64 * j_); } while (0)
    P13_LOAD(0);
#pragma unroll 1
    for (int i = 0; i < nr; ++i) { const int m = m0 + i;
        f32x4 a[4], xv[4]; float s2 = 0.f;
#pragma unroll
        for (int j = 0; j < 4; ++j) { a[j] = (f32x4){0.f, 0.f, 0.f, 0.f};
#pragma unroll
            for (int k = 0; k < 4; ++k) { const u32x2 p = yp[k][j]; a[j] = a[j] + (f32x4){bflo(p.x), bfhi(p.x), bflo(p.y), bfhi(p.y)}; }
            s2 += (a[j].x * a[j].x + a[j].y * a[j].y) + (a[j].z * a[j].z + a[j].w * a[j].w); xv[j] = xp[j]; }
        if (i + 1 < nr) { const int in_ = __builtin_amdgcn_readfirstlane(i + 1);
#pragma unroll
            for (int k_ = 0; k_ < 4; ++k_) { const int row_ = __shfl(myrow, 4 * in_ + k_);
#pragma unroll
                for (int j_ = 0; j_ < 4; ++j_) yp[k_][j_] = *((const GAS u32x2*)(Y2 + (size_t)row_ * D) + lane + 64 * j_); }
#pragma unroll
            for (int j_ = 0; j_ < 4; ++j_) xp[j_] = *((const GAS f32x4*)(F.out + (size_t)(m + 1) * D) + lane + 64 * j_); }
        const float rs = __builtin_amdgcn_rsqf(wave_sum(s2) * (1.f / D) + 1e-6f);
#pragma unroll
        for (int j = 0; j < 4; ++j) *((GAS f32x4*)(dst + (size_t)m * D) + lane + 64 * j) = xv[j] + gw[j] * (a[j] * rs); }
#undef P13_LOAD
}
__global__ void __launch_bounds__(NWAVES * 64, 2) hybrid_fwd(Args kargs) {
    const ArgsD args{};
    extern __shared__ __attribute__((aligned(16))) unsigned char lds[];
    Frame F;
    F.lds = (LAS unsigned char*)lds;
    F.MISC = (volatile LAS unsigned*)(F.lds + MISC_OFF);
    F.wave = __builtin_amdgcn_readfirstlane((int)threadIdx.x >> 6);
    F.G = gridDim.x; { const int bx = blockIdx.x; F.vcu = (F.G % 8 == 0) ? (bx % 8) * (F.G / 8) + bx / 8 : bx; }
    F.ws = kargs.ws; F.out = kargs.out;
    unsigned char* ws = kargs.ws;
    F.ctl = (gu32*)(ws + WS_CTL);
#define GRID_BAR(seam) do { if (N_LAUNCHES != 1) { if (F.wave == 0 && lane_id_v() == 0) __hip_atomic_store(F.ctl + CW_TMO, 0xBADBA0u | (unsigned)(seam), RLX_AGENT); } else { xcd_barrier(bar); } } while (0)
    for (int u = threadIdx.x; u < (LDS_BYTES - LDSCTL_OFF) / 4; u += NWAVES * 64) ((LAS unsigned*)(F.lds + LDSCTL_OFF))[u] = 0u;
    __syncthreads();
    XcdBarrier bar; bar.bar = (unsigned*)(F.ctl + CW_BAR); bar.x = 0; bar.st = nullptr; bar.wid = F.wave;
    if (N_LAUNCHES == 1) bar = xcd_barrier_post((unsigned*)(F.ctl + CW_BAR), F.MISC + 8, F.wave);
    const int lo = kargs.ph_lo, hi = kargs.ph_hi;
#define IN(k) (lo <= (k) && (k) < hi)
#define PREP(k) (((PROBE_MASK) >> (k)) & 1)
#define BOTH(k) (IN(k) && IN((k) + 1))
    bf16* const H = (bf16*)(ws + WS_H); bf16* const H2 = (bf16*)(ws + WS_H2);

    if (IN(0)) { _Pragma("unroll 1") for (int r_ = 0; r_ <= PREP(0); ++r_) { p0_prologue(F, args); } if (BOTH(0)) GRID_BAR(0); }
    if (IN(1)) { _Pragma("unroll 1") for (int r_ = 0; r_ <= PREP(1); ++r_) { p1_premix(F, args); } if (BOTH(1)) GRID_BAR(1); }
    if (IN(2)) {
        pg8::Gemm g{H, (const bf16*)(ws + WS_WIN), M, IN_COLS, D, 0, nullptr}; pg8::StaticOrder S; S.init(M, IN_COLS, F.G, (int)blockIdx.x);
        pg8::EpiProj E{(bf16*)(ws + WS_Q), (bf16*)(ws + WS_K), (bf16*)(ws + WS_V), (bf16*)(ws + WS_RW), (const float*)(ws + WS_ROPE), attn_body::C2};
        if (PREP(2)) { pg8::gemm_phase<pg8::EpiProj, pg8::StaticOrder, true, true, false>(F.lds + RING_OFF, g, S, E, F.wave); GRID_BAR(102); }
        pg8::gemm_phase<pg8::EpiProj, pg8::StaticOrder, true, true, false>(F.lds + RING_OFF, g, S, E, F.wave);
        if (BOTH(2)) GRID_BAR(2);
    }
    if (IN(3)) { _Pragma("unroll 1") for (int r_ = 0; r_ <= PREP(3); ++r_) { p3_lact(F, args); } if (BOTH(3)) GRID_BAR(3); }
    if (IN(4)) {
        pg8::Gemm g{(const bf16*)(ws + WS_LACT), (const bf16*)(ws + WS_BLORA), M, 1536, 256, 0, nullptr}; pg8::StaticOrder S; S.init(M, 1536, F.G, (int)blockIdx.x);
        pg8::EpiLora E{(float*)(ws + WS_LW), (size_t)(WS_AS - WS_LW) / 4, (const float*)args.in[17], (const float*)args.in[19]}; static_assert(WS_G - WS_AS == WS_AS - WS_LW, "LW | AS | G equally spaced");
        if (PREP(4)) { pg8::gemm_phase<pg8::EpiLora, pg8::StaticOrder, true, true, false>(F.lds + RING_OFF, g, S, E, F.wave); GRID_BAR(104); }
        pg8::gemm_phase<pg8::EpiLora, pg8::StaticOrder, true, true, false>(F.lds + RING_OFF, g, S, E, F.wave);
        if (BOTH(4)) GRID_BAR(4);
    }
    if (IN(5)) {
        _Pragma("unroll 1") for (int r_ = 0; r_ <= PREP(5); ++r_)
            for (int u = F.vcu; u < BATCH * 8 * 4; u += F.G) rwkv_pre(F, args, u >> 2, (u & 3) * 16, (u & 3) * 16 + 16);
        if (BOTH(5)) GRID_BAR(5);
    }
    if (IN(6)) {
        _Pragma("unroll 1") for (int r_ = 0; r_ <= PREP(14); ++r_)
            for (int bh = blockIdx.x; bh < BATCH * 8; bh += F.G) rwkv_seq(F, args, bh);
        static_assert(attn_body::ATTN_LDS_BYTES <= RING_BYTES, "attention body geometry vs frame");
        const attn_body::AttnTensors AT{(const attn_body::bf16*)(ws + WS_Q), (const attn_body::bf16*)(ws + WS_K), (const attn_body::bf16*)(ws + WS_V), (attn_body::bf16*)(ws + WS_O)};
        if (PREP(15)) { const attn_body::QueueOrder S0{(unsigned*)(F.ctl + CW_ATTQ + 64), F.MISC + 12, F.wave}; attn_body::attn_phase<attn_body::QueueOrder>((char*)lds + RING_OFF, AT, S0, F.wave); GRID_BAR(106); }
        const attn_body::QueueOrder S{(unsigned*)(F.ctl + CW_ATTQ), F.MISC + 12, F.wave};
        attn_body::attn_phase<attn_body::QueueOrder>((char*)lds + RING_OFF, AT, S, F.wave);
        if (BOTH(6)) GRID_BAR(6);
    }
    if (IN(7)) { _Pragma("unroll 1") for (int r_ = 0; r_ <= PREP(7); ++r_) { p6_dacombine(F, args); } if (BOTH(7)) GRID_BAR(7); }
    if (IN(8)) {
        pg8::Gemm g{(const bf16*)(ws + WS_YCAT), (const bf16*)(ws + WS_WOUT), M, D, D, 0, nullptr}; pg8::StaticOrder S; S.init(M, D, F.G, (int)blockIdx.x);
        pg8::EpiPlain E{(bf16*)(ws + WS_Y), D};
        if (PREP(8)) { pg8::gemm_phase<pg8::EpiPlain, pg8::StaticOrder, true, true, false>(F.lds + RING_OFF, g, S, E, F.wave); GRID_BAR(108); }
        pg8::gemm_phase<pg8::EpiPlain, pg8::StaticOrder, true, true, false>(F.lds + RING_OFF, g, S, E, F.wave);
        if (BOTH(8)) GRID_BAR(8);
    }
    if (IN(9)) { _Pragma("unroll 1") for (int r_ = PREP(9); r_ >= 0; --r_) { p8_postmix_router(F, args, r_); } if (BOTH(9)) GRID_BAR(9); }
    if (IN(10)) { _Pragma("unroll 1") for (int r_ = 0; r_ <= PREP(10); ++r_) { p9_rows(F); } if (BOTH(10)) GRID_BAR(10); }
    if (IN(11)) {
        moe_tables(F);
        const LAS int* ts = (const LAS int*)(F.lds + LDSCTL_OFF);
        pg8::Gemm g{H2, (const bf16*)(ws + WS_W1), MAXROWS, 2048, D, (size_t)2048 * D * 2, (const int*)(ws + WS_ROWTOK)};
        pg8::MoeOrder S{ts[32], 8, 4, F.G, F.vcu, ts};
        pg8::EpiSwiglu E{(bf16*)(ws + WS_ACT), (const float*)args.in[30]};
        if (PREP(11)) { pg8::gemm_phase<pg8::EpiSwiglu, pg8::MoeOrder, true, true, true>(F.lds + RING_OFF, g, S, E, F.wave); GRID_BAR(111); }
        pg8::gemm_phase<pg8::EpiSwiglu, pg8::MoeOrder, true, true, true>(F.lds + RING_OFF, g, S, E, F.wave);
        if (BOTH(11)) GRID_BAR(11);
    }
    if (IN(12)) {
        moe_tables(F);
        const LAS int* ts = (const LAS int*)(F.lds + LDSCTL_OFF);
        pg8::Gemm g{(const bf16*)(ws + WS_ACT), (const bf16*)(ws + WS_W2), MAXROWS, D, D, (size_t)D * D * 2, nullptr};
        pg8::MoeOrder S{ts[32], 4, 8, F.G, F.vcu, ts};
        pg8::EpiMoe2 E{(bf16*)(ws + WS_Y2), (const float*)args.in[32], (const float*)(ws + WS_ROWGATE)};
        if (PREP(12)) { pg8::gemm_phase<pg8::EpiMoe2, pg8::MoeOrder, true, true, false>(F.lds + RING_OFF, g, S, E, F.wave); GRID_BAR(112); }
        pg8::gemm_phase<pg8::EpiMoe2, pg8::MoeOrder, true, true, false>(F.lds + RING_OFF, g, S, E, F.wave);
        if (BOTH(12)) GRID_BAR(12);
    }
    if (IN(13)) { _Pragma("unroll 1") for (int r_ = PREP(13); r_ >= 0; --r_) { p12_final(F, args, r_ ? (float*)(ws + WS_G) : F.out); } }
#undef IN
#undef PREP
#undef BOTH
}

extern "C" void kernel_launch(void* const* d_in, const int* in_sizes, int n_in, void* d_out, int out_size, void* d_ws, size_t ws_size, hipStream_t stream) {
    static int grid = 0;
    if (grid == 0) {
        if (n_in != 33 || in_sizes[0] != M * D || out_size != M * D || ws_size < WS_END) { fprintf(stderr, "kernel_launch: built for 33 inputs, x and out of %d floats, >= %zu bytes of workspace; got n_in %d, in0 %d, out %d, ws %zu; nothing launched\n", M * D, (size_t)WS_END, n_in, n_in > 0 ? in_sizes[0] : -1, out_size, ws_size); grid = -1; return; }
        int dev = 0, cus = 0, per_cu = 0;
        if (hipGetDevice(&dev) != hipSuccess || hipDeviceGetAttribute(&cus, hipDeviceAttributeMultiprocessorCount, dev) != hipSuccess) { fprintf(stderr, "kernel_launch: hipGetDevice / hipDeviceGetAttribute failed; nothing launched\n"); grid = -1; return; }
        if (hipFuncSetAttribute((const void*)hybrid_fwd, hipFuncAttributeMaxDynamicSharedMemorySize, LDS_BYTES) != hipSuccess) { fprintf(stderr, "kernel_launch: hipFuncSetAttribute failed; nothing launched\n"); grid = -1; return; }
        if (hipOccupancyMaxActiveBlocksPerMultiprocessor(&per_cu, (const void*)hybrid_fwd, NWAVES * 64, LDS_BYTES) != hipSuccess || per_cu < 1)
            fprintf(stderr, "kernel_launch: note: the occupancy query reports %d workgroups per CU\n", per_cu);
        (void)hipGetLastError();
        grid = (cus >= 256) ? 256 : (cus / 32) * 32;
        if (grid != 256) fprintf(stderr, "kernel_launch: launching %d workgroups (built and checked for 256)\n", grid);
    }
    if (grid <= 0) return;
    if (hipMemsetAsync((char*)d_ws + WS_CTL, 0, CTL_ZERO_BYTES, stream) != hipSuccess) { fprintf(stderr, "kernel_launch: hipMemsetAsync of the control words failed; nothing launched\n"); return; }
    Args a{};
    for (int i = 0; i < 33; ++i) a.in[i] = d_in[i];
    a.out = (float*)d_out; a.ws = (unsigned char*)d_ws;
    for (int li = 0; li < N_LAUNCHES; ++li) {
        a.ph_lo = (N_LAUNCHES == 1) ? 0 : li; a.ph_hi = (N_LAUNCHES == 1) ? N_PHASES : li + 1; a.li = li; a.pad = 0;
        hipLaunchKernelGGL(hybrid_fwd, dim3(grid), dim3(NWAVES * 64), LDS_BYTES, stream, a);
        const hipError_t le = hipPeekAtLastError();
        if (le != hipSuccess) { fprintf(stderr, "kernel_launch: launch %d failed: %s\n", li, hipGetErrorName(le)); break; }
    }
}
```

```cpp
#include <hip/hip_runtime.h>
#include <cstdio>
#include <cstdint>
__device__ __forceinline__ int lane_id_v() { int l; asm volatile("v_mbcnt_lo_u32_b32 %0, -1, 0\n\tv_mbcnt_hi_u32_b32 %0, -1, %0" : "=v"(l)); return l; }
namespace pg8 {
#define PG8_LAS __attribute__((address_space(3)))
typedef unsigned short bf16_t;
typedef short bf16x8 __attribute__((ext_vector_type(8)));
typedef float f32x4 __attribute__((ext_vector_type(4)));
typedef unsigned u32x4 __attribute__((ext_vector_type(4)));
typedef int v4i_t __attribute__((ext_vector_type(4)));
typedef int v8i_t __attribute__((ext_vector_type(8)));
typedef v8i_t v8i_a16 __attribute__((aligned(16)));
union frag2_t { bf16x8 pc[2]; v8i_t w; };
constexpr int BM = 256, BK = 64, HALF = 128, HTB = HALF * BK * 2  , STAGE_BYTES = 8 * HTB, NXCD = 8, WGM = 8;

__host__ __device__ __forceinline__ int lds_byte(int r, int c) { const int st = (r >> 4) * 2 + (c >> 5), rr = r & 15, cc = c & 31, ob = rr * 64 + cc * 2; return st * 1024 + (ob ^ (((ob >> 9) & 1) << 5)); }
__host__ __device__ __forceinline__ void stage_rc(int b, int& R, int& C) { const int st = b / 1024, sb = b % 1024, swz = sb ^ (((sb >> 9) & 1) << 5); R = (st >> 1) * 16 + swz / 64; C = (st & 1) * 32 + (swz % 64) / 2; }
__host__ __device__ __forceinline__ int perm32(int rho) { const int n = rho >> 4, i = rho & 15; return 8 * (i >> 2) + 4 * n + (i & 3); }

struct Unit { int pm, pn, e; };
struct Gemm { const bf16_t* A; const bf16_t* Bt; int M, N, K; size_t bstride; const int* rowidx; const void* base; };

struct StaticOrder {
    int nM, nN, nwg, G, c;
    __host__ __device__ void init(int M, int N, int G_, int c_) { nM = M / BM; nN = N / BM; nwg = nM * nN; G = G_; c = c_; }
    __host__ __device__ bool next(int i, Unit& u) const {
        const long L = (long)i * G + c; if (L >= nwg) return false;
        int wgid = (int)L; { const int q = nwg / NXCD, r = nwg % NXCD, xcd = wgid % NXCD, off = wgid / NXCD; wgid = (xcd < r ? xcd * (q + 1) : r * (q + 1) + (xcd - r) * q) + off; }
        const int nig = WGM * nN, gid = wgid / nig, fm = gid * WGM, gsz = (nM - fm) < WGM ? (nM - fm) : WGM;
        u.pm = fm + ((wgid % nig) % gsz); u.pn = (wgid % nig) / gsz; u.e = 0; return true;
    }
    __device__ __forceinline__ void a_ready(const Unit&) const {}
    __device__ __forceinline__ void done(const Unit&) const {}
};

__device__ __forceinline__ unsigned cvt_pk_bf16(float lo, float hi) { unsigned r; asm volatile("v_cvt_pk_bf16_f32 %0, %1, %2" : "=v"(r) : "v"(lo), "v"(hi)); return r; }
typedef float f32x2 __attribute__((ext_vector_type(2)));
typedef unsigned u32x2 __attribute__((ext_vector_type(2)));
__device__ __forceinline__ float sigmoidf_(float x) { return __builtin_amdgcn_rcpf(1.f + __expf(-x)); }

struct MoeOrder {
    int ntiles, nN, RG, G, c; const PG8_LAS int* tstart;
    __device__ __forceinline__ bool next(int i, Unit& u) const {
        const int L = i * G + c, grp = L >> 5, idx = L & 31; u.pn = idx / RG; u.pm = grp * RG + idx % RG; u.e = 0;
        if (u.pm >= ntiles) return false;
        int e = 0;
#pragma unroll
        for (int k = 16; k >= 1; k >>= 1) { if (tstart[e + k] <= u.pm) e += k; }
        u.e = __builtin_amdgcn_readfirstlane(e); return true;
    }
    __device__ __forceinline__ void a_ready(const Unit&) const {}
    __device__ __forceinline__ void done(const Unit&) const {}
};

#define PG8_PACK8(v0, v1) (u32x4){cvt_pk_bf16((v0)[0], (v0)[1]), cvt_pk_bf16((v0)[2], (v0)[3]), cvt_pk_bf16((v1)[0], (v1)[1]), cvt_pk_bf16((v1)[2], (v1)[3])}

struct EpiPlain {
    static constexpr bool PERM = true, AFTER_DRAIN = false;
    bf16_t* O; int ldc;
    __device__ __forceinline__ void operator()(const f32x4 (&acc)[2][2][4][2], const Unit& u, int wr, int wc, int fr, int fq) const {
        const int row0 = u.pm * BM + wr * 64 + fr, col0 = u.pn * BM + wc * 32 + 8 * fq;
#pragma unroll
        for (int ai = 0; ai < 2; ++ai)
#pragma unroll
            for (int m = 0; m < 4; ++m) { bf16_t* rowp = O + (size_t)(row0 + ai * HALF + m * 16) * ldc + col0;
#pragma unroll
                for (int bj = 0; bj < 2; ++bj) { const f32x4 v0 = acc[ai][bj][m][0], v1 = acc[ai][bj][m][1]; *(u32x4*)(rowp + bj * HALF) = PG8_PACK8(v0, v1); } }
    }
};

struct EpiProj {
    static constexpr bool PERM = true, AFTER_DRAIN = false;
    bf16_t *Q, *K, *V, *RW; const float* rope; float qscale;
    __device__ __forceinline__ void operator()(const f32x4 (&acc)[2][2][4][2], const Unit& u, int wr, int wc, int fr, int fq) const {
        const int row0 = u.pm * BM + wr * 64 + fr, cl = wc * 32 + 8 * fq, pn = u.pn;
        if (pn < 4) {
            bf16_t* base = (pn < 2) ? Q : K; const int colt = (pn & 1) * 256; const float sc = (pn < 2) ? qscale : 1.f;
            const bool rp = ((wc & 1) == 0) && (fq < 2);
#pragma unroll
            for (int ai = 0; ai < 2; ++ai)
#pragma unroll
                for (int m = 0; m < 4; ++m) { const int row = row0 + ai * HALF + m * 16;
                    f32x4 cs = (f32x4){1.f, 1.f, 1.f, 1.f}, sn = (f32x4){0.f, 0.f, 0.f, 0.f};
                    if (rp) { cs = *(const f32x4*)(rope + (size_t)row * 16 + 4 * fq); sn = *(const f32x4*)(rope + (size_t)row * 16 + 8 + 4 * fq); }
#pragma unroll
                    for (int bj = 0; bj < 2; ++bj) { f32x4 v0 = acc[ai][bj][m][0], v1 = acc[ai][bj][m][1];
                        { const float a0 = v0[0], b0 = v0[1], a1 = v0[2], b1 = v0[3], a2 = v1[0], b2 = v1[1], a3 = v1[2], b3 = v1[3];
                          v0[0] = a0 * cs[0] - b0 * sn[0]; v0[1] = b0 * cs[0] + a0 * sn[0]; v0[2] = a1 * cs[1] - b1 * sn[1]; v0[3] = b1 * cs[1] + a1 * sn[1];
                          v1[0] = a2 * cs[2] - b2 * sn[2]; v1[1] = b2 * cs[2] + a2 * sn[2]; v1[2] = a3 * cs[3] - b3 * sn[3]; v1[3] = b3 * cs[3] + a3 * sn[3]; }
                        v0 = v0 * sc; v1 = v1 * sc;
                        *(u32x4*)(base + (size_t)row * 512 + colt + bj * HALF + cl) = PG8_PACK8(v0, v1); } }
        } else {
            bf16_t* base; int ld, colt;
            if (pn < 6) { base = V; ld = 512; colt = (pn - 4) * 256; } else { base = RW; ld = 1792; colt = (pn - 6) * 256; }
#pragma unroll
            for (int ai = 0; ai < 2; ++ai)
#pragma unroll
                for (int m = 0; m < 4; ++m) { bf16_t* rowp = base + (size_t)(row0 + ai * HALF + m * 16) * ld + colt + cl;
#pragma unroll
                    for (int bj = 0; bj < 2; ++bj) { const f32x4 v0 = acc[ai][bj][m][0], v1 = acc[ai][bj][m][1]; *(u32x4*)(rowp + bj * HALF) = PG8_PACK8(v0, v1); } }
        }
    }
};

struct EpiLora {
    static constexpr bool PERM = true, AFTER_DRAIN = false;
    float* LW; size_t kstride; const float *w0, *a0;
    __device__ __forceinline__ void operator()(const f32x4 (&acc)[2][2][4][2], const Unit& u, int wr, int wc, int fr, int fq) const {
        const int row0 = u.pm * BM + wr * 64 + fr, kind = u.pn >> 1, col0 = (u.pn & 1) * 256 + wc * 32 + 8 * fq;
        float* dst = LW + (size_t)kind * kstride; const float* bias = (kind == 1) ? a0 : w0;
        f32x4 bv[2][2];
#pragma unroll
        for (int bj = 0; bj < 2; ++bj)
#pragma unroll
            for (int n = 0; n < 2; ++n) bv[bj][n] = (kind < 2) ? *(const f32x4*)(bias + col0 + bj * HALF + 4 * n) : (f32x4){0.f, 0.f, 0.f, 0.f};
#pragma unroll
        for (int ai = 0; ai < 2; ++ai)
#pragma unroll
            for (int m = 0; m < 4; ++m) { float* rowp = dst + (size_t)(row0 + ai * HALF + m * 16) * 512 + col0;
#pragma unroll
                for (int bj = 0; bj < 2; ++bj)
#pragma unroll
                    for (int n = 0; n < 2; ++n) { f32x4 v = acc[ai][bj][m][n] + bv[bj][n];
                        if (kind == 0) {
#pragma unroll
                            for (int q = 0; q < 4; ++q) { const float z = -v[q]; const float sp = fmaxf(z, 0.f) + __logf(1.f + __expf(-fabsf(z))); v[q] = -__expf(-sp - 0.5f); }
                        } else if (kind == 1) {
#pragma unroll
                            for (int q = 0; q < 4; ++q) v[q] = sigmoidf_(v[q]);
                        }
                        *(f32x4*)(rowp + bj * HALF + 4 * n) = v; } }
    }
};

__device__ __forceinline__ unsigned pk4_fp8(float a, float b, float c_, float d) { int r = __builtin_amdgcn_cvt_pk_fp8_f32(a, b, 0, false); r = __builtin_amdgcn_cvt_pk_fp8_f32(c_, d, r, true); return (unsigned)r; }
constexpr float W8_SCALE = 32.f, W8_INV = 1.f / 32.f;
struct EpiSwiglu {
    static constexpr bool PERM = true, AFTER_DRAIN = false;
    unsigned char* ACT; const float* b1;
    __device__ __forceinline__ void operator()(const f32x4 (&acc)[2][2][4][2], const Unit& u, int wr, int wc, int fr, int fq) const {
        const int row0 = u.pm * BM + wr * 64 + fr, col0 = u.pn * BM + wc * 32 + 8 * fq;
        f32x4 bv[2][2];
#pragma unroll
        for (int bj = 0; bj < 2; ++bj)
#pragma unroll
            for (int n = 0; n < 2; ++n) bv[bj][n] = *(const f32x4*)(b1 + (size_t)u.e * 2048 + col0 + bj * HALF + 4 * n);
#pragma unroll
        for (int ai = 0; ai < 2; ++ai)
#pragma unroll
            for (int m = 0; m < 4; ++m) { unsigned char* rowp = ACT + (size_t)(row0 + ai * HALF + m * 16) * 1024 + (col0 >> 1);
#pragma unroll
                for (int bj = 0; bj < 2; ++bj) { const f32x4 v0 = acc[ai][bj][m][0] * W8_INV + bv[bj][0], v1 = acc[ai][bj][m][1] * W8_INV + bv[bj][1];
                    float o[4];
#pragma unroll
                    for (int q = 0; q < 4; ++q) { const float glu = (q < 2) ? v0[2 * q] : v1[2 * q - 4], lin = (q < 2) ? v0[2 * q + 1] : v1[2 * q - 3];
                        const float gg = fminf(glu, 7.f), ll = fminf(fmaxf(lin, -7.f), 7.f); o[q] = gg * sigmoidf_(1.702f * gg) * (ll + 1.f); }
                    *(unsigned*)(rowp + bj * (HALF / 2)) = pk4_fp8(o[0], o[1], o[2], o[3]); } }
    }
};

struct EpiMoe2 {
    static constexpr bool PERM = true, AFTER_DRAIN = false;
    bf16_t* Y2; const float* b2; const float* gate;
    __device__ __forceinline__ void operator()(const f32x4 (&acc)[2][2][4][2], const Unit& u, int wr, int wc, int fr, int fq) const {
        const int row0 = u.pm * BM + wr * 64 + fr, col0 = u.pn * BM + wc * 32 + 8 * fq;
        f32x4 bv[2][2];
#pragma unroll
        for (int bj = 0; bj < 2; ++bj)
#pragma unroll
            for (int n = 0; n < 2; ++n) bv[bj][n] = *(const f32x4*)(b2 + (size_t)u.e * 1024 + col0 + bj * HALF + 4 * n);
#pragma unroll
        for (int ai = 0; ai < 2; ++ai)
#pragma unroll
            for (int m = 0; m < 4; ++m) { const int row = row0 + ai * HALF + m * 16; const float gt = gate[row]; bf16_t* rowp = Y2 + (size_t)row * 1024 + col0;
#pragma unroll
                for (int bj = 0; bj < 2; ++bj) { const f32x4 v0 = (acc[ai][bj][m][0] * W8_INV + bv[bj][0]) * gt, v1 = (acc[ai][bj][m][1] * W8_INV + bv[bj][1]) * gt;
                    *(u32x4*)(rowp + bj * HALF) = PG8_PACK8(v0, v1); } }
    }
};

template <class Epi, class Sched, bool ALIGN_EPI = false, bool SP2 = false, bool GATHER = false, bool FP8 = false>
__device__ __forceinline__ void gemm_phase(PG8_LAS unsigned char* lds, const Gemm g, const Sched& S, const Epi& E, const int wid) {
    const int lane = lane_id_v(), tid = wid * 64 + lane, wr = wid >> 2, wc = wid & 3, fr = lane & 15, fq = lane >> 4;
    const int K = g.K, nt = K / BK;
    const __amdgpu_buffer_rsrc_t rsrc = __builtin_amdgcn_make_buffer_rsrc((void*)g.base, 0, 0x7fffffff, 0x00020000);
    unsigned voffA[2], voffB[2];
#pragma unroll
    for (int i = 0; i < 2; ++i) { int R, C; stage_rc(tid * 16 + i * 8192, R, C); const int Rb = Epi::PERM ? ((R & ~31) + perm32(R & 31)) : R;
        voffA[i] = (unsigned)(R * K + C) * 2u; voffB[i] = (unsigned)(Rb * K + C) * 2u; }
    const size_t kstep = (size_t)(BK * 2);
    const size_t hstep = (size_t)HALF * K * 2;
    const size_t tstep = 2 * hstep;
    const unsigned ldsw = (unsigned)wid * 1024u;
    const int aoff = FP8 ? lds_byte(wr * 64 + fr, fq * 16) : lds_byte(wr * 64 + fr, fq * 8), boff = FP8 ? lds_byte(wc * 32 + fr, fq * 16) : lds_byte(wc * 32 + fr, fq * 8);
#define PG8_SA(b, h) (((b) * 2 + (h)) * HTB)
#define PG8_SB(b, h) ((4 + (b) * 2 + (h)) * HTB)
#define PG8_STAGE(bufoff, gbase, voff) do { const unsigned so_ = (unsigned)((const char*)(gbase) - (const char*)g.base); _Pragma("unroll") for (int _i = 0; _i < 2; ++_i) \
        __builtin_amdgcn_raw_ptr_buffer_load_lds(rsrc, (PG8_LAS unsigned*)(lds + (bufoff) + ldsw + _i * 8192), 16, (voff)[_i], so_, 0, 0); } while (0)
#define PG8_STAGE_A(bufoff, ptr, h, nx) do { if constexpr (GATHER) { unsigned vo_[2]; vo_[0] = (nx) ? gn[h][0] : gc[h][0]; vo_[1] = (nx) ? gn[h][1] : gc[h][1]; PG8_STAGE(bufoff, ptr, vo_); } \
        else { PG8_STAGE(bufoff, (ptr) + (h) * hstep, voffA); } } while (0)
#define PG8_LDA(dst, b, h) do { _Pragma("unroll") for (int m = 0; m < 4; ++m) _Pragma("unroll") for (int k = 0; k < 2; ++k) dst[m].pc[k] = *(const PG8_LAS bf16x8*)(lds + PG8_SA(b, h) + aoff + m * 2048 + k * (FP8 ? 16 : 1024)); } while (0)
#define PG8_LDB(dst, b, h) do { _Pragma("unroll") for (int n = 0; n < 2; ++n) _Pragma("unroll") for (int k = 0; k < 2; ++k) dst[n].pc[k] = *(const PG8_LAS bf16x8*)(lds + PG8_SB(b, h) + boff + n * 2048 + k * (FP8 ? 16 : 1024)); } while (0)
#define PG8_MMA(ai, bj, At, Bt) do { __builtin_amdgcn_s_setprio(1); _Pragma("unroll") for (int m = 0; m < 4; ++m) _Pragma("unroll") for (int n = 0; n < 2; ++n) { \
        if constexpr (FP8) { acc[ai][bj][m][n] = __builtin_amdgcn_mfma_scale_f32_16x16x128_f8f6f4(Bt[n].w, At[m].w, acc[ai][bj][m][n], 0, 0, 0, 0, 0, 0); } \
        else { _Pragma("unroll") for (int k = 0; k < 2; ++k) acc[ai][bj][m][n] = __builtin_amdgcn_mfma_f32_16x16x32_bf16(Bt[n].pc[k], At[m].pc[k], acc[ai][bj][m][n], 0, 0, 0); } } \
        __builtin_amdgcn_s_setprio(0); } while (0)
#define PG8_WAIT_V(n) asm volatile("s_waitcnt vmcnt(" #n ")" ::: "memory")
#define PG8_WAIT_L(n) asm volatile("s_waitcnt lgkmcnt(" #n ")" ::: "memory")
#define PG8_BAR __builtin_amdgcn_s_barrier()
#define PG8_SCHED __builtin_amdgcn_sched_barrier(0)
    Unit cur, nxt; int ui = 0;
    if (!S.next(0, cur)) return;
    f32x4 acc[2][2][4][2];
#pragma unroll
    for (int a = 0; a < 2; ++a)
#pragma unroll
        for (int b = 0; b < 2; ++b)
#pragma unroll
            for (int m = 0; m < 4; ++m)
#pragma unroll
                for (int n = 0; n < 2; ++n) acc[a][b][m][n] = (f32x4){0.f, 0.f, 0.f, 0.f};
    frag2_t At[4], B0[2], B1[2];
    const char* cA = GATHER ? (const char*)g.A : (const char*)g.A + (size_t)cur.pm * tstep; const char* cB = (const char*)g.Bt + (size_t)cur.e * g.bstride + (size_t)cur.pn * tstep;
    unsigned gc[2][2] = {{0u, 0u}, {0u, 0u}}, gn[2][2] = {{0u, 0u}, {0u, 0u}}; Unit nx2; bool has_nx2 = false;
#define PG8_GOFF(dst, pm_, ok_, alt_) do { const int t_ = lane_id_v() + wid * 64; _Pragma("unroll") for (int i_ = 0; i_ < 2; ++i_) { int R_, C_; stage_rc(t_ * 16 + i_ * 8192, R_, C_); \
        _Pragma("unroll") for (int h_ = 0; h_ < 2; ++h_) dst[h_][i_] = (ok_) ? (unsigned)g.rowidx[(pm_) * BM + h_ * HALF + R_] * (unsigned)(K * 2) + (unsigned)C_ * 2u : alt_[h_][i_]; } } while (0)
    if constexpr (GATHER) {
        PG8_GOFF(gc, cur.pm, true, gc);
        const bool hn = S.next(1, nxt);
        PG8_GOFF(gn, nxt.pm, hn, gc);
    }
    S.a_ready(cur);
    if constexpr (SP2) {
        PG8_STAGE(PG8_SB(0, 0), cB, voffB); PG8_STAGE(PG8_SB(0, 1), cB + hstep, voffB); PG8_STAGE_A(PG8_SA(0, 0), cA, 0, false); PG8_STAGE_A(PG8_SA(0, 1), cA, 1, false);
        if (wr == 1) PG8_BAR;
        PG8_WAIT_V(2); PG8_BAR;
        PG8_STAGE(PG8_SB(1, 0), cB + kstep, voffB); PG8_STAGE_A(PG8_SA(1, 0), cA + kstep, 0, false); PG8_STAGE(PG8_SB(1, 1), cB + hstep + kstep, voffB);
        PG8_WAIT_V(6); PG8_BAR;
    } else {
        PG8_STAGE(PG8_SB(0, 0), cB, voffB); PG8_STAGE_A(PG8_SA(0, 0), cA, 0, false); PG8_STAGE(PG8_SB(0, 1), cB + hstep, voffB); PG8_STAGE_A(PG8_SA(0, 1), cA, 1, false);
        if (wr == 1) PG8_BAR;
        PG8_WAIT_V(4); PG8_BAR;
        PG8_STAGE(PG8_SB(1, 0), cB + kstep, voffB); PG8_STAGE_A(PG8_SA(1, 0), cA + kstep, 0, false); PG8_STAGE(PG8_SB(1, 1), cB + hstep + kstep, voffB);
        PG8_WAIT_V(6); PG8_BAR;
    }
    for (;;) {
        const bool has_next = S.next(ui + 1, nxt);
        const char* nA = GATHER ? (const char*)g.A : (has_next ? (const char*)g.A + (size_t)nxt.pm * tstep : cA); const char* nB = has_next ? (const char*)g.Bt + (size_t)nxt.e * g.bstride + (size_t)nxt.pn * tstep : cB;
        for (int t = 0; t < nt; t += 2) {
            const bool last = (t == nt - 2);
            asm volatile("" : "+v"(voffA[0]), "+v"(voffA[1]), "+v"(voffB[0]), "+v"(voffB[1]));
            if constexpr (GATHER) asm volatile("" : "+v"(gc[0][0]), "+v"(gc[0][1]), "+v"(gc[1][0]), "+v"(gc[1][1]), "+v"(gn[0][0]), "+v"(gn[0][1]), "+v"(gn[1][0]), "+v"(gn[1][1]));
            const char* a1 = cA + (size_t)(t + 1) * kstep;
            const char* a2 = last ? nA : cA + (size_t)(t + 2) * kstep; const char* b2 = last ? nB : cB + (size_t)(t + 2) * kstep;
            const char* a3 = a2 + kstep; const char* b3 = b2 + kstep;
            if (last && has_next) S.a_ready(nxt);
            if constexpr (SP2) {
            PG8_LDB(B0, 0, 0); PG8_LDB(B1, 0, 1); PG8_SCHED; PG8_LDA(At, 0, 0); PG8_STAGE_A(PG8_SA(1, 1), a1, 1, false);
            PG8_WAIT_V(8); PG8_WAIT_L(0); PG8_BAR; PG8_MMA(0, 0, At, B0); PG8_MMA(0, 1, At, B1); PG8_BAR; PG8_SCHED;
            PG8_LDA(At, 0, 1); PG8_STAGE(PG8_SB(0, 0), b2, voffB); PG8_STAGE(PG8_SB(0, 1), b2 + hstep, voffB); PG8_STAGE_A(PG8_SA(0, 0), a2, 0, last);
            PG8_WAIT_V(8); PG8_WAIT_L(0); PG8_BAR; PG8_MMA(1, 0, At, B0); PG8_MMA(1, 1, At, B1); PG8_BAR; PG8_SCHED;
            PG8_LDB(B0, 1, 0); PG8_LDB(B1, 1, 1); PG8_SCHED; PG8_LDA(At, 1, 0); PG8_STAGE_A(PG8_SA(0, 1), a2, 1, last);
            PG8_WAIT_V(8); PG8_WAIT_L(0); PG8_BAR; PG8_MMA(0, 0, At, B0); PG8_MMA(0, 1, At, B1); PG8_BAR; PG8_SCHED;
            PG8_LDA(At, 1, 1); PG8_STAGE(PG8_SB(1, 0), b3, voffB); PG8_STAGE(PG8_SB(1, 1), b3 + hstep, voffB); PG8_STAGE_A(PG8_SA(1, 0), a3, 0, last);
            PG8_WAIT_V(8); PG8_WAIT_L(0); PG8_BAR; PG8_MMA(1, 0, At, B0); PG8_MMA(1, 1, At, B1); PG8_BAR; PG8_SCHED;
            } else {
            PG8_LDB(B0, 0, 0); PG8_SCHED; PG8_LDA(At, 0, 0); PG8_STAGE_A(PG8_SA(1, 1), a1, 1, false);
            PG8_WAIT_L(8); PG8_BAR; PG8_WAIT_L(0); PG8_MMA(0, 0, At, B0); PG8_BAR; PG8_SCHED;
            PG8_LDB(B1, 0, 1); PG8_STAGE(PG8_SB(0, 0), b2, voffB);
            PG8_BAR; PG8_WAIT_L(0); PG8_MMA(0, 1, At, B1); PG8_BAR;
            PG8_LDA(At, 0, 1); PG8_STAGE_A(PG8_SA(0, 0), a2, 0, last);
            PG8_BAR; PG8_WAIT_L(0); PG8_MMA(1, 0, At, B0); PG8_BAR; PG8_SCHED;
            PG8_STAGE(PG8_SB(0, 1), b2 + hstep, voffB);
            PG8_WAIT_V(6); PG8_BAR; PG8_MMA(1, 1, At, B1); PG8_BAR;
            PG8_LDB(B0, 1, 0); PG8_SCHED; PG8_LDA(At, 1, 0); PG8_STAGE_A(PG8_SA(0, 1), a2, 1, last);
            PG8_WAIT_L(8); PG8_BAR; PG8_WAIT_L(0); PG8_MMA(0, 0, At, B0); PG8_BAR; PG8_SCHED;
            PG8_LDB(B1, 1, 1); PG8_STAGE(PG8_SB(1, 0), b3, voffB);
            PG8_BAR; PG8_WAIT_L(0); PG8_MMA(0, 1, At, B1); PG8_BAR;
            PG8_LDA(At, 1, 1); PG8_STAGE_A(PG8_SA(1, 0), a3, 0, last);
            PG8_BAR; PG8_WAIT_L(0); PG8_MMA(1, 0, At, B0); PG8_BAR; PG8_SCHED;
            PG8_STAGE(PG8_SB(1, 1), b3 + hstep, voffB);
            PG8_WAIT_V(6); PG8_BAR; PG8_MMA(1, 1, At, B1); PG8_BAR;
            }
        }
        if constexpr (GATHER) { has_nx2 = has_next && S.next(ui + 2, nx2);
            _Pragma("unroll") for (int h = 0; h < 2; ++h) _Pragma("unroll") for (int i = 0; i < 2; ++i) gc[h][i] = gn[h][i];
            PG8_GOFF(gn, nx2.pm, has_nx2, gc); }
        if constexpr (ALIGN_EPI) { if (wr == 0) PG8_BAR; }
        if constexpr (!Epi::AFTER_DRAIN) { const int l_ = lane_id_v(); const int fr_ = l_ & 15, fq_ = l_ >> 4;
            E(acc, cur, wr, wc, fr_, fq_); S.done(cur); }
        if (!has_next) break;
#pragma unroll
        for (int a = 0; a < 2; ++a)
#pragma unroll
            for (int b = 0; b < 2; ++b)
#pragma unroll
                for (int m = 0; m < 4; ++m)
#pragma unroll
                    for (int n = 0; n < 2; ++n) acc[a][b][m][n] = (f32x4){0.f, 0.f, 0.f, 0.f};
        if constexpr (GATHER) { asm volatile("" : "+v"(gn[0][0]), "+v"(gn[0][1]), "+v"(gn[1][0]), "+v"(gn[1][1])); }
        cur = nxt; cA = nA; cB = nB; ++ui;
        if constexpr (ALIGN_EPI) { if (wr == 1) PG8_BAR; }
    }
    PG8_WAIT_V(0);
    if constexpr (!ALIGN_EPI) { if (wr == 0) PG8_BAR; }
    PG8_BAR;
    if constexpr (Epi::AFTER_DRAIN) { E.fused(acc, cur, wr, wc, fr, fq, lds, wid, lane); S.done(cur); }
#undef PG8_SA
#undef PG8_SB
#undef PG8_STAGE
#undef PG8_STAGE_A
#undef PG8_GOFF
#undef PG8_LDA
#undef PG8_LDB
#undef PG8_MMA
#undef PG8_WAIT_V
#undef PG8_WAIT_L
#undef PG8_BAR
#undef PG8_SCHED
}
}
#include <hip/hip_bf16.h>
#include <cmath>
namespace attn_body {
using bf16=__hip_bfloat16;
using bf16x8=__attribute__((ext_vector_type(8)))short;
using s16x4=__attribute__((ext_vector_type(4)))short;
using f32x16=__attribute__((ext_vector_type(16)))float;
using u32x4=__attribute__((ext_vector_type(4)))unsigned;
constexpr int BATCH=8,NHEAD=16,SEQ=4096,D=64;
constexpr int QP=512,KP=512,VP=512,OP=1024;
constexpr int NW=8,QBLK=32,QB=QBLK*NW,KVBLK=64,NQB=SEQ/QB;
constexpr int ATTN_UNIT_ROWS=QB;
__device__ __forceinline__ int crow(int r,int hi){return (r&3)+8*(r>>2)+4*hi;}
#define SBAR() __builtin_amdgcn_sched_barrier(0)
__device__ __forceinline__ void cmask(f32x16&p0,f32x16&p1,int jb,int qrel,int hi){
  const float NEG=-INFINITY; int kb=64*jb+4*hi;
  #pragma unroll
  for(int r=0;r<16;++r){int kv=kb+(r&3)+8*(r>>2); if(kv>qrel)p0[r]=NEG; if(kv+32>qrel)p1[r]=NEG;}
}

constexpr int NSLOT=3, SLOTB=8192;
constexpr int LDS_K=0, LDS_V=NSLOT*SLOTB, LDS_WS=2*NSLOT*SLOTB, LDS_OST=LDS_WS+NW*64*4, LDS_BYTES=LDS_OST+NW*4096;
constexpr float C2=0.125f*1.4426950408889634f;
__device__ __forceinline__ void glds16(const void*gsrc,unsigned lds_dst){unsigned keep;
  asm volatile("s_mov_b32 %0, m0\n\ts_mov_b32 m0, %2\n\ts_nop 0\n\tglobal_load_lds_dwordx4 %1, off\n\ts_mov_b32 m0, %0":"=&s"(keep):"v"(gsrc),"s"(lds_dst):"memory");}
__device__ __forceinline__ float max3f(float a,float b,float c){float r;asm("v_max3_f32 %0, %1, %2, %3":"=v"(r):"v"(a),"v"(b),"v"(c));return r;}
__device__ __forceinline__ float max2f(float a,float b){float r;asm("v_max_f32_e32 %0, %1, %2":"=v"(r):"v"(a),"v"(b));return r;}
__device__ __forceinline__ float fadd_s(float a,float b){float r;asm("v_add_f32_e32 %0, %1, %2":"=v"(r):"v"(a),"v"(b));return r;}
__device__ __forceinline__ float fsub_s(float a,float b){float r;asm("v_sub_f32_e32 %0, %1, %2":"=v"(r):"v"(a),"v"(b));return r;}
typedef float f32x2_t __attribute__((ext_vector_type(2))); typedef __bf16 bf16x2_t __attribute__((ext_vector_type(2)));
__device__ __forceinline__ unsigned cvtpk_s(float lo,float hi){f32x2_t v={lo,hi};bf16x2_t b=__builtin_convertvector(v,bf16x2_t);return __builtin_bit_cast(unsigned,b);}
#define WAIT_BAR(N) asm volatile("s_waitcnt vmcnt(" #N ") lgkmcnt(0)\n\ts_barrier":::"memory")

__device__ __forceinline__ void qkt(f32x16&p0,f32x16&p1,const char*Kslot,const bf16x8*qr,const f32x16&negm,int r32,int hi){
  const char*kb=Kslot+hi*1024+r32*16;
  #pragma unroll
  for(int d0=0;d0<4;++d0){
    const bf16x8 b0=*reinterpret_cast<const bf16x8*>(kb+d0*2048);
    const bf16x8 b1=*reinterpret_cast<const bf16x8*>(kb+d0*2048+512);
    if(d0==0){p0=__builtin_amdgcn_mfma_f32_32x32x16_bf16(b0,qr[0],negm,0,0,0);p1=__builtin_amdgcn_mfma_f32_32x32x16_bf16(b1,qr[0],negm,0,0,0);}
    else{p0=__builtin_amdgcn_mfma_f32_32x32x16_bf16(b0,qr[d0],p0,0,0,0);p1=__builtin_amdgcn_mfma_f32_32x32x16_bf16(b1,qr[d0],p1,0,0,0);}}
}
typedef __attribute__((address_space(3))) const char* lds_cptr;
typedef short v4i16_t __attribute__((ext_vector_type(4)));
__device__ __forceinline__ void kload8(bf16x8*kf,lds_cptr kp){
  kf[0]=*(const __attribute__((address_space(3))) bf16x8*)(kp);      kf[1]=*(const __attribute__((address_space(3))) bf16x8*)(kp+512);
  kf[2]=*(const __attribute__((address_space(3))) bf16x8*)(kp+2048); kf[3]=*(const __attribute__((address_space(3))) bf16x8*)(kp+2560);
  kf[4]=*(const __attribute__((address_space(3))) bf16x8*)(kp+4096); kf[5]=*(const __attribute__((address_space(3))) bf16x8*)(kp+4608);
  kf[6]=*(const __attribute__((address_space(3))) bf16x8*)(kp+6144); kf[7]=*(const __attribute__((address_space(3))) bf16x8*)(kp+6656);
}
__device__ __forceinline__ void kload2(bf16x8*kf,lds_cptr kp,int j){ kf[2*j]=*(const __attribute__((address_space(3))) bf16x8*)(kp+j*2048); kf[2*j+1]=*(const __attribute__((address_space(3))) bf16x8*)(kp+j*2048+512); }
__device__ __forceinline__ s16x4 vtr(lds_cptr p){ return __builtin_bit_cast(s16x4,__builtin_amdgcn_ds_read_tr16_b64_v4i16((__attribute__((address_space(3))) v4i16_t*)p)); }
__device__ __forceinline__ float rowmax(const f32x16&p0,const f32x16&p1){
  float a=max3f(p0[0],p0[1],p1[0]),b=max3f(p0[2],p0[3],p1[1]);a=max3f(a,p1[2],p1[3]);
  #pragma unroll
  for(int r=4;r<16;r+=4){a=max3f(a,p0[r],p0[r+1]);b=max3f(b,p0[r+2],p0[r+3]);a=max3f(a,p1[r],p1[r+1]);b=max3f(b,p1[r+2],p1[r+3]);}
  const float m=max2f(a,b);
  auto rr=__builtin_amdgcn_permlane32_swap(__float_as_uint(m),__float_as_uint(m),false,false);
  return max2f(__uint_as_float(rr[0]),__uint_as_float(rr[1]));
}
__device__ __forceinline__ void pv(f32x16*o,int vb,bf16x8 pa0,bf16x8 pa1,bf16x8 pa2,bf16x8 pa3){
  #pragma unroll
  for(int d0=0;d0<2;++d0){s16x4 lo[4],hi[4];
    #pragma unroll
    for(int ks=0;ks<4;++ks){
      asm volatile("ds_read_b64_tr_b16 %0,%1 offset:%c2":"=&v"(lo[ks]):"v"(vb),"i"(d0*4096+ks*1024):"memory");
      asm volatile("ds_read_b64_tr_b16 %0,%1 offset:%c2":"=&v"(hi[ks]):"v"(vb),"i"(d0*4096+ks*1024+512):"memory");}
    asm volatile("s_waitcnt lgkmcnt(0)":::"memory");SBAR();
    #define PK(k) (bf16x8){lo[k][0],lo[k][1],lo[k][2],lo[k][3],hi[k][0],hi[k][1],hi[k][2],hi[k][3]}
    o[d0]=__builtin_amdgcn_mfma_f32_32x32x16_bf16(pa0,PK(0),o[d0],0,0,0);
    o[d0]=__builtin_amdgcn_mfma_f32_32x32x16_bf16(pa1,PK(1),o[d0],0,0,0);
    o[d0]=__builtin_amdgcn_mfma_f32_32x32x16_bf16(pa2,PK(2),o[d0],0,0,0);
    o[d0]=__builtin_amdgcn_mfma_f32_32x32x16_bf16(pa3,PK(3),o[d0],0,0,0);
    #undef PK
  }
}

#ifndef ATTN_STORE16
#define ATTN_STORE16(p,v) (*(u32x4*)(p)=(v))
#endif
template<int THRL> __device__ __forceinline__ void attn_unit(int b,int h,int qb,const bf16*Q,const bf16*__restrict__ K,const bf16*__restrict__ V,bf16*O,char*shm,const int wid){
  const int qcol=(h>>1)*64, kcol=(h>>1)*64, vcol=(h>>2)*128+(h&1)*64, ocol=h*64;
  const int lane=lane_id_v(),r32=lane&31,hi=lane>>5;
  const long rowbase=(long)b*SEQ; const int q0=qb*QB;
  const bf16*Qw=Q+(rowbase+q0+wid*QBLK)*QP+qcol;
  const bf16*Kh=K+rowbase*KP+kcol,*Vh=V+rowbase*VP+vcol;
  const unsigned lds0=(unsigned)(uintptr_t)shm;
  float*wsf=(float*)(shm+LDS_WS)+wid*64;
  const bf16*ksrc=Kh+(long)lane*KP+wid*8;
  const bf16*vsrc=Vh+(long)(16*(wid&3)+(lane>>2))*VP+(wid>>2)*32+(lane&3)*8;
  const unsigned kdst=lds0+LDS_K+wid*1024, vdst=lds0+LDS_V+wid*1024;
  #define DMA_K(t,slot) glds16(ksrc+(long)(t)*KVBLK*KP,(unsigned)__builtin_amdgcn_readfirstlane(kdst+(slot)))
  #define DMA_V(t,slot) glds16(vsrc+(long)(t)*KVBLK*VP,(unsigned)__builtin_amdgcn_readfirstlane(vdst+(slot)))
  const int vb0=(int)(lds0+LDS_V)+((lane>>4)&1)*32+(lane&3)*8+(4*hi+((lane&15)>>2))*64;
  const char*Kbase=shm+LDS_K; bf16x8 kf[8];
  const lds_cptr shm3=(lds_cptr)shm; const lds_cptr kp0=shm3+LDS_K+hi*1024+r32*16; const lds_cptr vp0=shm3+LDS_V+((lane>>4)&1)*32+(lane&3)*8+(4*hi+((lane&15)>>2))*64;
  const int NT=(q0+QB)/KVBLK;
  DMA_K(0,0);DMA_V(0,0);DMA_K(1,SLOTB);
  bf16x8 qr[4];
  #pragma unroll
  for(int d0=0;d0<4;++d0)qr[d0]=*reinterpret_cast<const bf16x8*>(&Qw[(long)r32*QP+d0*16+hi*8]);
  float mhat=0.f,l_reg=0.f;f32x16 o[2];o[0]=f32x16{};o[1]=f32x16{};f32x16 negm=f32x16{};asm volatile("":"+v"(negm));
  const int qrel=wid*QBLK+r32;
  #define CMASK(P0,P1,t) do{int jb_=(t)-(NT-4); if(jb_>=0)cmask(P0,P1,jb_,qrel,hi);}while(0)
  bool resc=false;
  #define START(P0,P1) do{ const float rm=rowmax(P0,P1); resc=false; \
    { const float dl=rm; mhat=fadd_s(mhat,dl); \
      _Pragma("unroll") for(int r=0;r<16;++r){P0[r]=fsub_s(P0[r],dl);P1[r]=fsub_s(P1[r],dl);} \
      _Pragma("unroll") for(int r=0;r<16;++r)negm[r]=-mhat; asm volatile("":"+v"(negm)); } \
    _Pragma("unroll") for(int r=0;r<16;++r)P0[r]=__builtin_amdgcn_exp2f(P0[r]); }while(0)
  #define RESC() do{ if(resc){ asm volatile("s_waitcnt lgkmcnt(0)":::"memory"); \
      _Pragma("unroll") for(int d_=0;d_<2;++d_) _Pragma("unroll") for(int r=0;r<16;++r)o[d_][r]*=wsf[crow(r,hi)]; } }while(0)
  f32x16 pA0,pA1,pB0,pB1;
  int sl_prev=0,sl_cur=0,sl_next=SLOTB;
  #define ROT() do{sl_prev=sl_cur;sl_cur=sl_next;sl_next=(sl_next==(NSLOT-1)*SLOTB)?0:sl_next+SLOTB;}while(0)
  DMA_K(2,2*SLOTB);
  WAIT_BAR(3);
  qkt(pA0,pA1,Kbase,qr,negm,r32,hi);asm volatile("s_nop 15\n\ts_nop 7":"+v"(pA0),"+v"(pA1));CMASK(pA0,pA1,0);
  START(pA0,pA1);
  _Pragma("unroll") for(int r=0;r<16;++r)pA1[r]=__builtin_amdgcn_exp2f(pA1[r]);
  WAIT_BAR(0);
  DMA_K(3,0);DMA_V(1,SLOTB);
  ROT();
  kload8(kf,kp0+sl_cur);
  WAIT_BAR(2);
  s16x4 vlo[8],vhi[8]; u32x4 pw0,pw1,pw2,pw3;
  #define PKW(P,B) cvtpk_s(P[B],P[B+1])
  #define PAF(k) __builtin_bit_cast(bf16x8,pw##k)
  #define VFR(i) (bf16x8){vlo[i][0],vlo[i][1],vlo[i][2],vlo[i][3],vhi[i][0],vhi[i][1],vhi[i][2],vhi[i][3]}
  #define PIN(x) asm volatile("":"+v"(x))
  #define MX3(a,b,c) __builtin_fmaxf(__builtin_fmaxf((a),(b)),(c))
  #define GAPA(MF,A0,A1,A2,A3,W0,W1,PW) do{ MF; sacc+=A0; sacc+=A1; sacc+=A2; sacc+=A3; PIN(sacc); W0; W1; PIN(PW); SBAR(); }while(0)
  #define EX(v) __builtin_amdgcn_exp2f(v)
  #define GAPB(MF,X,B) do{ MF; X[B]=EX(X[B]); X[B+1]=EX(X[B+1]); X[B+2]=EX(X[B+2]); X[B+3]=EX(X[B+3]); PIN(X); SBAR(); }while(0)
  #define VRD(i) do{ vlo[i]=vtr(vp_+(((i)>>2)*4096+((i)&3)*1024)); vhi[i]=vtr(vp_+(((i)>>2)*4096+((i)&3)*1024+512)); }while(0)
  #define KRD(G,j) do{ if(G){ kload2(kf,kp0+sl_next,j); SBAR(); } }while(0)
  #define STEP(C0,C1,P0,P1,t,GK,GV,GL) do{ SBAR(); \
    const lds_cptr vp_=vp0+sl_prev; \
    VRD(0); SBAR(); float sacc=(P0[0]+P0[1]); \
    GAPA(C0=__builtin_amdgcn_mfma_f32_32x32x16_bf16(kf[0],qr[0],negm,0,0,0), P0[2],P0[3],P0[4],P0[5],     pw0[0]=PKW(P0,0), pw0[1]=PKW(P0,2), pw0); \
    VRD(4); SBAR(); GAPA(C1=__builtin_amdgcn_mfma_f32_32x32x16_bf16(kf[1],qr[0],negm,0,0,0), P0[6],P0[7],P0[8],P0[9],     pw0[2]=PKW(P0,4), pw0[3]=PKW(P0,6), pw0); \
    VRD(1); SBAR(); GAPA(C0=__builtin_amdgcn_mfma_f32_32x32x16_bf16(kf[2],qr[1],C0,0,0,0),   P0[10],P0[11],P0[12],P0[13], pw1[0]=PKW(P0,8), pw1[1]=PKW(P0,10), pw1); \
    VRD(5); SBAR(); GAPA(C1=__builtin_amdgcn_mfma_f32_32x32x16_bf16(kf[3],qr[1],C1,0,0,0),   P0[14],P0[15],P1[0],P1[1],   pw1[2]=PKW(P0,12),pw1[3]=PKW(P0,14), pw1); \
    VRD(2); SBAR(); GAPA(C0=__builtin_amdgcn_mfma_f32_32x32x16_bf16(kf[4],qr[2],C0,0,0,0),   P1[2],P1[3],P1[4],P1[5],     pw2[0]=PKW(P1,0), pw2[1]=PKW(P1,2), pw2); \
    VRD(6); SBAR(); GAPA(C1=__builtin_amdgcn_mfma_f32_32x32x16_bf16(kf[5],qr[2],C1,0,0,0),   P1[6],P1[7],P1[8],P1[9],     pw2[2]=PKW(P1,4), pw2[3]=PKW(P1,6), pw2); \
    VRD(3); SBAR(); GAPA(C0=__builtin_amdgcn_mfma_f32_32x32x16_bf16(kf[6],qr[3],C0,0,0,0),   P1[10],P1[11],P1[12],P1[13], pw3[0]=PKW(P1,8), pw3[1]=PKW(P1,10), pw3); \
    VRD(7); SBAR(); GAPA(C1=__builtin_amdgcn_mfma_f32_32x32x16_bf16(kf[7],qr[3],C1,0,0,0),   P1[14],P1[15],0.f,0.f,       pw3[2]=PKW(P1,12),pw3[3]=PKW(P1,14), pw3); \
    l_reg+=sacc; \
    if(GK){DMA_K((t)+3,sl_cur);} if(GV){DMA_V((t)+1,sl_next);} \
    CMASK(C0,C1,t); \
    { float a=MX3(C0[0],C0[1],C1[0]),b=MX3(C0[2],C0[3],C1[1]); a=MX3(a,C1[2],C1[3]); \
      _Pragma("unroll") for(int r=4;r<16;r+=4){a=MX3(a,C0[r],C0[r+1]);b=MX3(b,C0[r+2],C0[r+3]);a=MX3(a,C1[r],C1[r+1]);b=MX3(b,C1[r+2],C1[r+3]);} \
      float rm=__builtin_fmaxf(a,b); { auto rr=__builtin_amdgcn_permlane32_swap(__float_as_uint(rm),__float_as_uint(rm),false,false); rm=__builtin_fmaxf(__uint_as_float(rr[0]),__uint_as_float(rr[1])); } \
      resc=false; \
      if(__builtin_expect(__any(rm>(float)THRL),0)){ const float dl=__builtin_fmaxf(rm,0.f); mhat+=dl; \
        _Pragma("unroll") for(int r=0;r<16;++r){C0[r]-=dl;C1[r]-=dl;} \
        _Pragma("unroll") for(int r=0;r<16;++r)negm[r]=-mhat; asm volatile("":"+v"(negm)); \
        const float f=__builtin_amdgcn_exp2f(-dl); l_reg*=f; if(hi==0)wsf[r32]=f; resc=true; } } \
    SBAR(); \
    GAPB(o[0]=__builtin_amdgcn_mfma_f32_32x32x16_bf16(PAF(0),VFR(0),o[0],0,0,0), C0,0); \
    GAPB(o[1]=__builtin_amdgcn_mfma_f32_32x32x16_bf16(PAF(0),VFR(4),o[1],0,0,0), C0,4); \
    KRD(GL,0); GAPB(o[0]=__builtin_amdgcn_mfma_f32_32x32x16_bf16(PAF(1),VFR(1),o[0],0,0,0), C0,8); \
    KRD(GL,1); GAPB(o[1]=__builtin_amdgcn_mfma_f32_32x32x16_bf16(PAF(1),VFR(5),o[1],0,0,0), C0,12); \
    KRD(GL,2); GAPB(o[0]=__builtin_amdgcn_mfma_f32_32x32x16_bf16(PAF(2),VFR(2),o[0],0,0,0), C1,0); \
    KRD(GL,3); GAPB(o[1]=__builtin_amdgcn_mfma_f32_32x32x16_bf16(PAF(2),VFR(6),o[1],0,0,0), C1,4); \
    GAPB(o[0]=__builtin_amdgcn_mfma_f32_32x32x16_bf16(PAF(3),VFR(3),o[0],0,0,0), C1,8); \
    GAPB(o[1]=__builtin_amdgcn_mfma_f32_32x32x16_bf16(PAF(3),VFR(7),o[1],0,0,0), C1,12); \
    }while(0)
  int t=1;
  #undef CMASK
  #define CMASK(P0,P1,t) do{}while(0)
  for(;t+5<NT;t+=2){
    STEP(pB0,pB1,pA0,pA1,t,true,true,true);     WAIT_BAR(2); RESC(); ROT();
    STEP(pA0,pA1,pB0,pB1,t+1,true,true,true);   WAIT_BAR(2); RESC(); ROT();
  }
  #undef CMASK
  #define CMASK(P0,P1,t) do{int jb_=(t)-(NT-4); if(jb_>=0)cmask(P0,P1,jb_,qrel,hi);}while(0)
  #define ENDW(tt) do{ if((tt)+3<NT){WAIT_BAR(2);} else if((tt)+2<NT){WAIT_BAR(1);} else {WAIT_BAR(0);} }while(0)
  for(;t+1<NT;t+=2){
    STEP(pB0,pB1,pA0,pA1,t,(t+3<NT),(t+1<NT),(t+1<NT));       ENDW(t);   RESC(); ROT();
    STEP(pA0,pA1,pB0,pB1,t+1,(t+4<NT),(t+2<NT),(t+2<NT));     ENDW(t+1); RESC(); ROT();
  }
  STEP(pB0,pB1,pA0,pA1,NT-1,false,false,false); RESC();
  { float sacc=pB0[0]+pB0[1]; _Pragma("unroll") for(int r=2;r<16;++r)sacc+=pB0[r]; _Pragma("unroll") for(int r=0;r<16;++r)sacc+=pB1[r]; l_reg+=sacc;
    pw0=(u32x4){PKW(pB0,0),PKW(pB0,2),PKW(pB0,4),PKW(pB0,6)};pw1=(u32x4){PKW(pB0,8),PKW(pB0,10),PKW(pB0,12),PKW(pB0,14)};pw2=(u32x4){PKW(pB1,0),PKW(pB1,2),PKW(pB1,4),PKW(pB1,6)};pw3=(u32x4){PKW(pB1,8),PKW(pB1,10),PKW(pB1,12),PKW(pB1,14)};
    SBAR(); pv(o,vb0+sl_cur,PAF(0),PAF(1),PAF(2),PAF(3)); }
  #undef PKW
  #undef PAF
  #undef VFR
  #undef PIN
  #undef MX3
  #undef GAPA
  #undef GAPB
  #undef EX
  #undef VRD
  #undef KRD
  #undef STEP
  #undef ENDW
  {auto rr=__builtin_amdgcn_permlane32_swap(__float_as_uint(l_reg),__float_as_uint(l_reg),false,false);l_reg=__uint_as_float(rr[0])+__uint_as_float(rr[1]);}
  if(hi==0)wsf[32+r32]=l_reg;asm volatile("s_waitcnt lgkmcnt(0)":::"memory");
  float rli[16];
  #pragma unroll
  for(int r=0;r<16;++r)rli[r]=__builtin_amdgcn_rcpf(wsf[32+crow(r,hi)]);
  bf16*Ow=O+(rowbase+q0+wid*QBLK)*OP+ocol;
  { bf16*stg=(bf16*)(shm+LDS_OST)+wid*2048;
    #pragma unroll
    for(int r=0;r<16;++r){const int orow=crow(r,hi);
      #pragma unroll
      for(int d0=0;d0<2;++d0)stg[orow*64+d0*32+r32]=__float2bfloat16(o[d0][r]*rli[r]);}
    asm volatile("s_waitcnt lgkmcnt(0)":::"memory");
    #pragma unroll
    for(int i=0;i<4;++i){const int row=i*8+(lane>>3),ch=lane&7; const u32x4 v=*(const u32x4*)(stg+row*64+ch*8); ATTN_STORE16(Ow+(long)row*OP+ch*8,v);} }
  asm volatile("s_waitcnt lgkmcnt(0)\n\ts_barrier":::"memory");
  #undef DMA_K
  #undef DMA_V
  #undef CMASK
  #undef START
  #undef RESC
  #undef ROT
}
constexpr int ATTN_LDS_BYTES=LDS_BYTES;
struct AttnTensors { const bf16* Q; const bf16* K; const bf16* V; bf16* O; };
struct AttnUnit { int bh; int qb; };
struct QueueOrder {
  unsigned* ctr; volatile __attribute__((address_space(3))) unsigned* slot; int wid;
  __device__ __forceinline__ bool next(int,AttnUnit&u)const{
    if(wid==0&&lane_id_v()==0){ const unsigned n=__hip_atomic_fetch_add(ctr,1u,__ATOMIC_RELAXED,__HIP_MEMORY_SCOPE_AGENT); slot[0]=n; }
    asm volatile("s_waitcnt vmcnt(0) lgkmcnt(0)\n\ts_barrier":::"memory");
    const unsigned n=slot[0];
    asm volatile("s_waitcnt lgkmcnt(0)\n\ts_barrier":::"memory");
    if(n>=(unsigned)(BATCH*NHEAD*NQB))return false;
    u.qb=NQB-1-(int)(n/(BATCH*NHEAD)); u.bh=(int)(n%(BATCH*NHEAD)); return true; }
  __device__ __forceinline__ void a_ready(const AttnUnit&)const{}
  __device__ __forceinline__ void done(const AttnUnit&)const{}
};
template<class Sched,int THRL=8> __device__ __forceinline__ void attn_phase(char*lds,const AttnTensors&T,const Sched&S,const int wid){
  AttnUnit u;
  for(int i=0;S.next(i,u);++i){ S.a_ready(u); attn_unit<THRL>(u.bh/NHEAD,u.bh%NHEAD,u.qb,T.Q,T.K,T.V,T.O,lds,wid); S.done(u); }
}
#undef SBAR
#undef WAIT_BAR
}
constexpr int NWAVES = 8;
#ifndef MK_N_LAUNCHES
#define MK_N_LAUNCHES 1
#endif
constexpr int N_PHASES = 14;
#ifndef PROBE_MASK
#define PROBE_MASK 0
#endif
constexpr int N_LAUNCHES = MK_N_LAUNCHES;
static_assert(N_LAUNCHES == 1 || N_LAUNCHES == N_PHASES, "MK_N_LAUNCHES is 1 or 14");

constexpr int BATCH = 8, T = 4096, D = 1024, M = BATCH * T;
constexpr int IN_COLS = 3328, RWC = 1792, NEXP = 32, TOPK = 4, NMOD = 6 * D;
constexpr int MAXROWS = M * TOPK + NEXP * 256;
constexpr int MOD_KS = 8;

constexpr size_t MiB = 1u << 20, KiB = 1u << 10;
constexpr size_t WS_CTL = 0, CTL_ZERO_BYTES = 1 * MiB;
constexpr size_t WS_MODP = 1 * MiB;
constexpr size_t WS_MOD = 2 * MiB + 512 * KiB;
constexpr size_t WS_ROPE = 3 * MiB;
constexpr size_t WS_WIN = 5 * MiB;
constexpr size_t WS_WOUT = 12 * MiB;
constexpr size_t WS_BLORA = 14 * MiB;
constexpr size_t WS_TOKE = 15 * MiB, WS_TOKG = 15 * MiB + 512 * KiB;
constexpr size_t WS_TOKROW = 16 * MiB, WS_ROWTOK = 16 * MiB + 512 * KiB, WS_ROWGATE = 17 * MiB + 256 * KiB, WS_BLKBASE = 18 * MiB;
constexpr size_t WS_W1 = 20 * MiB, WS_W2 = 148 * MiB;
constexpr size_t WS_H2 = 212 * MiB;
constexpr size_t WS_H = 276 * MiB, WS_Q = 340 * MiB, WS_K = 372 * MiB, WS_V = 404 * MiB, WS_RW = 436 * MiB;
constexpr size_t WS_O = 548 * MiB, WS_YCAT = 612 * MiB, WS_LACT = 676 * MiB;
constexpr size_t WS_LW = 692 * MiB, WS_AS = 756 * MiB, WS_G = 820 * MiB, WS_Y = 884 * MiB;
constexpr size_t WS_RIMG = 884 * MiB, WS_RBON = 1012 * MiB;
constexpr size_t WS_ACT = 276 * MiB, WS_Y2 = 548 * MiB, WS_END = 1013 * MiB;
static_assert(WS_ROWTOK + (size_t)MAXROWS * 4 <= WS_ROWGATE && WS_ROWGATE + (size_t)MAXROWS * 4 <= WS_BLKBASE && WS_ACT + (size_t)MAXROWS * 2048 <= WS_Y2 && WS_Y2 + (size_t)MAXROWS * 2048 <= WS_Y, "d_ws map");
constexpr int CW_TMO = 0, CW_CODE = 1;
constexpr int CW_BAR = 4096;
constexpr int CW_ATTQ = 8192;
constexpr int CW_ECNT = 12288;
static_assert((CW_ECNT + 2 * 64 * NEXP) * 4 <= (int)CTL_ZERO_BYTES, "CTL words inside the memset region");

constexpr int RING_OFF = 0, RING_BYTES = 131072;
constexpr int LDSCTL_OFF = RING_BYTES, MISC_OFF = LDSCTL_OFF + 320;
constexpr int LDS_BYTES = 147456;
static_assert(MISC_OFF + 128 <= LDS_BYTES, "LDS map");
#define GAS __attribute__((address_space(1)))
#define LAS __attribute__((address_space(3)))
typedef unsigned short bf16;
typedef unsigned v4u __attribute__((ext_vector_type(4)));
typedef float f32x4 __attribute__((ext_vector_type(4)));
typedef short bf16x8 __attribute__((ext_vector_type(8)));
typedef GAS unsigned gu32;
typedef GAS unsigned long long gu64;
#define RLX_AGENT __ATOMIC_RELAXED, __HIP_MEMORY_SCOPE_AGENT
#define LDS_WAIT() asm volatile("s_waitcnt lgkmcnt(0)" ::: "memory")
#define VM_WAIT() asm volatile("s_waitcnt vmcnt(0)" ::: "memory")
__device__ __forceinline__ unsigned long long rt() { return __builtin_amdgcn_s_memrealtime(); }
__device__ __forceinline__ unsigned f2bf(float f) { unsigned u = __builtin_bit_cast(unsigned, f); return (u + 0x7fffu + ((u >> 16) & 1u)) >> 16; }
__device__ __forceinline__ unsigned pk2(float lo, float hi) { return f2bf(lo) | (f2bf(hi) << 16); }

#define XB_TMO      128
#define XB_XCNT(j)  (256  + 64 * (j))
#define XB_XSUB(j)  (1280 + 64 * (j))
#define XB_XGEN(j)  (2304 + 64 * (j))
#define XB_TOP      3328
#define XB_TOPGEN   3392
#define XCD_BAR_WORDS 3456
#define XB_SPIN_CAP (1u << 18)

__device__ __forceinline__ unsigned xb_ld(unsigned* p)              { return __hip_atomic_load(p, __ATOMIC_RELAXED, __HIP_MEMORY_SCOPE_AGENT); }
__device__ __forceinline__ unsigned xb_add(unsigned* p, unsigned v) { return __hip_atomic_fetch_add(p, v, __ATOMIC_RELAXED, __HIP_MEMORY_SCOPE_AGENT); }
__device__ __forceinline__ unsigned xb_xcc_id() { return (unsigned)__builtin_amdgcn_s_getreg((3 << 11) | 20) & 0xFu; }
#define XB_SPIN(cond, bar) do { unsigned _sp = 0; while (cond) { __builtin_amdgcn_s_sleep(1); \
    if ((++_sp & 255u) == 0u) { if (xb_ld(&(bar)[XB_TMO])) break; if (_sp > XB_SPIN_CAP) { atomicAdd(&(bar)[XB_TMO], 1u); break; } } } } while (0)

struct XcdBarrier {
    unsigned* bar; unsigned x; int wid;
    volatile LAS unsigned* st;
};

__device__ __forceinline__ XcdBarrier xcd_barrier_post(unsigned* bar, volatile LAS unsigned* st, int wid) {
    XcdBarrier b; b.bar = bar; b.x = xb_xcc_id(); b.st = st; b.wid = wid;
    if (threadIdx.x == 0) (void)xb_add(&bar[XB_XCNT(b.x)], 1u);
    return b;
}
__device__ __forceinline__ void xcd_barrier_complete(unsigned* bar, unsigned x, unsigned& nloc, unsigned& nx) {
    const unsigned G = gridDim.x * gridDim.y * gridDim.z;
    unsigned sum, cnt, mine, sp = 0u;
    for (;;) {
        sum = 0u; cnt = 0u; mine = 0u;
#pragma unroll
        for (unsigned j = 0; j < 16; ++j) { const unsigned c = xb_ld(&bar[XB_XCNT(j)]); sum += c; cnt += (c > 0u) ? 1u : 0u; mine = (j == x) ? c : mine; }
        if (sum == G) break;
        __builtin_amdgcn_s_sleep(1);
        if ((++sp & 255u) == 0u) { if (xb_ld(&bar[XB_TMO])) break; if (sp > XB_SPIN_CAP) { atomicAdd(&bar[XB_TMO], 1u); break; } }
    }
    nloc = mine > 0u ? mine : 1u; nx = cnt > 0u ? cnt : 1u;
}

__device__ __forceinline__ void xcd_barrier(const XcdBarrier& b) {
    asm volatile("s_waitcnt vmcnt(0)" ::: "memory");
    __syncthreads();
    if (b.wid == 0 && lane_id_v() == 0) {
        unsigned* bar = b.bar;
        __builtin_amdgcn_s_waitcnt(0);
        unsigned nloc = b.st[0], nx = b.st[1];
        if (nloc == 0u) { xcd_barrier_complete(bar, b.x, nloc, nx); b.st[0] = nloc; b.st[1] = nx; }
        const unsigned old = xb_add(&bar[XB_XSUB(b.x)], 1u);
        const unsigned gen = old / nloc;
        if (old + 1u == (gen + 1u) * nloc) {
            __builtin_amdgcn_fence(__ATOMIC_RELEASE, "agent");
            asm volatile("s_waitcnt vmcnt(0)" ::: "memory");
            const unsigned og = xb_add(&bar[XB_TOP], 1u);
            const unsigned tg = og / nx;
            if (og + 1u == (tg + 1u) * nx) xb_add(&bar[XB_TOPGEN], 1u);
            else XB_SPIN(xb_ld(&bar[XB_TOPGEN]) == tg, bar);
            __builtin_amdgcn_fence(__ATOMIC_ACQUIRE, "agent");
            xb_add(&bar[XB_XGEN(b.x)], 1u);
            asm volatile("s_waitcnt vmcnt(0)" ::: "memory");
        } else {
            XB_SPIN(xb_ld(&bar[XB_XGEN(b.x)]) == gen, bar);
            __builtin_amdgcn_fence(__ATOMIC_ACQUIRE, "agent");
            asm volatile("s_waitcnt vmcnt(0)" ::: "memory");
        }
    }
    __syncthreads();
}
typedef float f32x2 __attribute__((ext_vector_type(2)));
typedef unsigned u32x2 __attribute__((ext_vector_type(2)));
struct Frame {
    LAS unsigned char* lds;
    volatile LAS unsigned* MISC;
    gu32* ctl;
    int wave;
    int vcu, G;
    unsigned char* ws; float* out;
};
struct Args { const void* in[33]; float* out; unsigned char* ws; int ph_lo, ph_hi, li, pad; };
struct InProxy { __device__ __forceinline__ const void* operator[](int k) const { unsigned long long v; const unsigned long long kp = (unsigned long long)__builtin_amdgcn_kernarg_segment_ptr();
    asm volatile("s_load_dwordx2 %0, %1, %2\n\ts_waitcnt lgkmcnt(0)" : "=s"(v) : "s"(kp), "s"(8 * k) : "memory"); return (const void*)(const GAS unsigned char*)v; } };
struct ArgsD { InProxy in; };

__device__ __forceinline__ float wave_sum(float v) {
#pragma unroll
    for (int o = 1; o < 64; o <<= 1) v += __shfl_xor(v, o);
    return v;
}
__device__ __forceinline__ float bf2f(unsigned short u) { return __uint_as_float((unsigned)u << 16); }
__device__ __forceinline__ float bflo(unsigned u) { return __uint_as_float(u << 16); }
__device__ __forceinline__ float bfhi(unsigned u) { return __uint_as_float(u & 0xffff0000u); }
typedef float f32x2_t __attribute__((ext_vector_type(2))); typedef __bf16 bf16x2_t __attribute__((ext_vector_type(2)));
__device__ __forceinline__ unsigned pkbf(float lo, float hi) { f32x2_t v = {lo, hi}; bf16x2_t b = __builtin_convertvector(v, bf16x2_t); return __builtin_bit_cast(unsigned, b); }
#define DPP_ADD(x, ctrl) ((x) + __builtin_bit_cast(float, __builtin_amdgcn_update_dpp(0, __builtin_bit_cast(int, (x)), (ctrl), 0xF, 0xF, true)))
__device__ __forceinline__ float allsum16(float x) {
    x = DPP_ADD(x, 0xB1); x = DPP_ADD(x, 0x4E); x = DPP_ADD(x, 0x124); x = DPP_ADD(x, 0x128); return x; }

struct P0Item { const float* src; bf16* dst; int N, K, n0; bool permq, fp8; };
__device__ __forceinline__ bool p0_decode(const Frame& F, int it, P0Item& d, const float* w_in, const float* w_out, const float* w1, const float* w2m) {
    constexpr int I_IN = (D / 64) * (IN_COLS / 32), I_OUT = (D / 64) * (D / 32), I_W1 = (D / 64) * (2048 / 32), I_W2 = (D / 64) * (D / 32);
    constexpr int NITEMS = I_IN + I_OUT + NEXP * I_W1 + NEXP * I_W2;
    if (it >= NITEMS) return false;
    const float* W; bf16* WT; int N, r = it; d.permq = false; d.fp8 = false; d.K = D;
    if (r < I_IN) { W = w_in; WT = (bf16*)(F.ws + WS_WIN); N = IN_COLS; d.permq = true; }
    else { r -= I_IN; if (r < I_OUT) { W = w_out; WT = (bf16*)(F.ws + WS_WOUT); N = D; }
        else { r -= I_OUT; if (r < NEXP * I_W1) { const int e = r / I_W1; r -= e * I_W1; W = w1 + (size_t)e * D * 2048; WT = (bf16*)(F.ws + WS_W1 + (size_t)e * 2048 * D); N = 2048; d.fp8 = true; }
            else { r -= NEXP * I_W1; const int e = r / I_W2; r -= e * I_W2; W = w2m + (size_t)e * D * D; WT = (bf16*)(F.ws + WS_W2 + (size_t)e * D * D); N = D; d.fp8 = true; } } }
    const int nblk = N / 32, kb = r / nblk, nb = r - kb * nblk; d.N = N; d.n0 = 32 * nb; d.src = W + (size_t)(64 * kb) * N + d.n0; d.dst = d.fp8 ? (bf16*)((unsigned char*)WT + 64 * kb) : WT + 64 * kb; return true;
}
__device__ __forceinline__ void p0_item_store(const P0Item& d, const float (&v)[32], LAS float* scr, int lane) {
#pragma unroll
    for (int i = 0; i < 32; ++i) scr[(2 * i + (lane >> 5)) * 33 + (lane & 31)] = v[i];
    LDS_WAIT(); asm volatile("" ::: "memory");
    const int c = lane & 7;
#pragma unroll
    for (int j = 0; j < 4; ++j) { const int n = (lane >> 3) + 8 * j; const LAS float* s = scr + (8 * c) * 33 + n;
        int nn = d.n0 + n;
        if (d.fp8) { const u32x2 o8 = (u32x2){pg8::pk4_fp8(s[0 * 33] * pg8::W8_SCALE, s[1 * 33] * pg8::W8_SCALE, s[2 * 33] * pg8::W8_SCALE, s[3 * 33] * pg8::W8_SCALE), pg8::pk4_fp8(s[4 * 33] * pg8::W8_SCALE, s[5 * 33] * pg8::W8_SCALE, s[6 * 33] * pg8::W8_SCALE, s[7 * 33] * pg8::W8_SCALE)};
            *(GAS u32x2*)((unsigned char*)d.dst + (size_t)nn * d.K + 8 * c) = o8; }
        else { v4u o; o.x = pkbf(s[0 * 33], s[1 * 33]); o.y = pkbf(s[2 * 33], s[3 * 33]); o.z = pkbf(s[4 * 33], s[5 * 33]); o.w = pkbf(s[6 * 33], s[7 * 33]);
            if (d.permq && nn < 1024) { const int dd = nn & 63; if (dd < 16) nn = (nn & ~63) + ((dd < 8) ? 2 * dd : 2 * (dd - 8) + 1); }
            *(GAS v4u*)(d.dst + (size_t)nn * d.K + 8 * c) = o; } }
    LDS_WAIT(); asm volatile("" ::: "memory");
}
__device__ __forceinline__ void sincos_d(float af, float& s, float& c) {
    const double a = (double)af; const double n = __builtin_rint(a * 0.63661977236758134308);
    double r = __builtin_fma(-n, 1.57079632679489655800e+00, a); r = __builtin_fma(-n, 6.12323399573676603587e-17, r);
    const double r2 = r * r;
    double sp = 1.0 / 6227020800.0; sp = sp * r2 * -1.0 + 1.0 / 39916800.0; sp = -sp * r2 + 1.0 / 362880.0; sp = -sp * r2 + 1.0 / 5040.0; sp = -sp * r2 + 1.0 / 120.0; sp = -sp * r2 + 1.0 / 6.0; sp = r - r * r2 * sp;
    double cp = 1.0 / 87178291200.0; cp = -cp * r2 + 1.0 / 479001600.0; cp = -cp * r2 + 1.0 / 3628800.0; cp = -cp * r2 + 1.0 / 40320.0; cp = -cp * r2 + 1.0 / 720.0; cp = -cp * r2 + 1.0 / 24.0; cp = -cp * r2 + 0.5; cp = 1.0 - r2 * cp;
    const int q = ((int)n) & 3;
    const double sv = (q == 0) ? sp : (q == 1) ? cp : (q == 2) ? -sp : -cp, cv = (q == 0) ? cp : (q == 1) ? -sp : (q == 2) ? -cp : sp;
    s = (float)sv; c = (float)cv;
}
__device__ __forceinline__ void p0_prologue(Frame& F, const ArgsD& A) {
    const int lane = lane_id_v(), tid = F.wave * 64 + lane; (void)tid;
    const int gw = F.vcu * NWAVES + F.wave, NGW = F.G * NWAVES, gt = F.vcu * 512 + tid, NGT = F.G * 512;
    LAS float* scr = (LAS float*)(F.lds + RING_OFF + F.wave * 12288);
    LAS float* sl = (LAS float*)(F.lds + RING_OFF + 98304);
    const float* c = (const float*)A.in[1];
    for (int i = tid; i < 8 * 1024; i += 512) { const float v = c[i]; sl[i] = v / (1.f + __expf(-v)); }
    __syncthreads();
    { const float* aw = (const float*)A.in[3]; float* modp = (float*)(F.ws + WS_MODP);
      for (int it = gw; it < 96 * MOD_KS; it += NGW) { const int cc = it % 96, ks = it / 96, col = cc * 64 + lane;
          float acc[8];
#pragma unroll
          for (int b = 0; b < 8; ++b) acc[b] = 0.f;
          for (int k = ks * 128; k < ks * 128 + 128; ++k) { const float w = aw[(size_t)k * NMOD + col];
#pragma unroll
              for (int b = 0; b < 8; ++b) acc[b] += sl[b * 1024 + k] * w; }
#pragma unroll
          for (int b = 0; b < 8; ++b) modp[(size_t)(ks * 8 + b) * NMOD + col] = acc[b]; } }
    { const int* pos = (const int*)A.in[2]; float* rope = (float*)(F.ws + WS_ROPE);
      for (int idx = gt; idx < M * 8; idx += NGT) { const int m = idx >> 3, i = idx & 7;
          const float invf = (i == 0) ? 1.0f : (i == 1) ? 0.1939227432012558f : (i == 2) ? 0.03760603070259094f : (i == 3) ? 0.007292664609849453f : (i == 4) ? 0.0014142135623842478f : (i == 5) ? 0.00027424818836152554f : (i == 6) ? 5.318296098266728e-05f : 1.0313386155758053e-05f;
          const float ang = (float)pos[m] * invf; float s, cc; sincos_d(ang, s, cc); rope[(size_t)m * 16 + i] = cc; rope[(size_t)m * 16 + 8 + i] = s; } }
    { const float* w2 = (const float*)A.in[18]; const float* a2 = (const float*)A.in[20]; const float* g2 = (const float*)A.in[21]; bf16* bl = (bf16*)(F.ws + WS_BLORA);
      for (int idx = gt; idx < 1536 * 256; idx += NGT) { const int n = idx >> 8, k = idx & 255, blk = n >> 9, nn = n & 511; float v = 0.f;
          if (blk == 0 && k < 64) v = w2[k * 512 + nn]; else if (blk == 1 && k >= 64 && k < 128) v = a2[(k - 64) * 512 + nn]; else if (blk == 2 && k >= 128) v = g2[(k - 128) * 512 + nn];
          bl[idx] = (bf16)(pkbf(v, 0.f) & 0xffffu); } }
    { const float* w_in = (const float*)A.in[9]; const float* w_out = (const float*)A.in[10]; const float* w1 = (const float*)A.in[29]; const float* w2m = (const float*)A.in[31];
      P0Item cur, nxt; float v[32], vn[32];
      bool have = p0_decode(F, gw, cur, w_in, w_out, w1, w2m);
      if (have) {
#pragma unroll
          for (int i = 0; i < 32; ++i) v[i] = cur.src[(size_t)(2 * i + (lane >> 5)) * cur.N + (lane & 31)]; }
      for (int it = gw; have; it += NGW) {
          const bool hn = p0_decode(F, it + NGW, nxt, w_in, w_out, w1, w2m);
          if (hn) {
#pragma unroll
              for (int i = 0; i < 32; ++i) vn[i] = nxt.src[(size_t)(2 * i + (lane >> 5)) * nxt.N + (lane & 31)]; }
          p0_item_store(cur, v, scr, lane);
          cur = nxt; have = hn;
#pragma unroll
          for (int i = 0; i < 32; ++i) v[i] = vn[i];
      } }
}

__device__ __forceinline__ void p1_premix(Frame& F, const ArgsD& A) {
    const int lane = lane_id_v(), tid = F.wave * 64 + lane; (void)tid;
    const float* modp = (const float*)(F.ws + WS_MODP); const float* ada_b = (const float*)A.in[4]; float* mod = (float*)(F.ws + WS_MOD);
    const int rows_per = M / F.G, mbeg = F.vcu * rows_per, b = mbeg >> 12;
    LAS float* ms = (LAS float*)(F.lds + RING_OFF);
    for (int col = tid; col < 2048; col += 512) { float s = ada_b[col];
#pragma unroll
        for (int ks = 0; ks < MOD_KS; ++ks) s += modp[(size_t)(ks * 8 + b) * NMOD + col];
        ms[col] = s; }
    for (int i = F.vcu * 512 + tid; i < 8 * 4096; i += F.G * 512) { const int bb = i >> 12, col = 2048 + (i & 4095); float s = ada_b[col];
#pragma unroll
        for (int ks = 0; ks < MOD_KS; ++ks) s += modp[(size_t)(ks * 8 + bb) * NMOD + col];
        mod[(size_t)bb * NMOD + col] = s; }
    __syncthreads();
    const float* x = (const float*)A.in[0]; const float* nw = (const float*)A.in[5]; bf16* H = (bf16*)(F.ws + WS_H);
    f32x4 wsc[4], sh[4];
#pragma unroll
    for (int j = 0; j < 4; ++j) { const int col = 4 * lane + 256 * j; wsc[j] = *((const f32x4*)nw + lane + 64 * j) * (*(const LAS f32x4*)(ms + 1024 + col) + 1.f); sh[j] = *(const LAS f32x4*)(ms + col); }
    const int nr = rows_per / NWAVES, m0 = mbeg + F.wave * nr;
    f32x4 pv[4];
#pragma unroll
    for (int j = 0; j < 4; ++j) pv[j] = *((const GAS f32x4*)(x + (size_t)m0 * D) + lane + 64 * j);
    for (int i = 0; i < nr; ++i) { const int m = m0 + i;
        f32x4 v[4]; float s2 = 0.f;
#pragma unroll
        for (int j = 0; j < 4; ++j) { v[j] = pv[j]; s2 += (v[j].x * v[j].x + v[j].y * v[j].y) + (v[j].z * v[j].z + v[j].w * v[j].w); }
        if (i + 1 < nr) {
#pragma unroll
            for (int j = 0; j < 4; ++j) pv[j] = *((const GAS f32x4*)(x + (size_t)(m + 1) * D) + lane + 64 * j); }
        const float rs = __builtin_amdgcn_rsqf(wave_sum(s2) * (1.f / D) + 1e-6f);
        GAS u32x2* o8 = (GAS u32x2*)(H + (size_t)m * D) + lane;
#pragma unroll
        for (int j = 0; j < 4; ++j) { const f32x4 y = v[j] * rs * wsc[j] + sh[j]; o8[64 * j] = (u32x2){pkbf(y.x, y.y), pkbf(y.z, y.w)}; } }
}

__device__ __forceinline__ void p3_lact(Frame& F, const ArgsD& A) {
    const int lane = lane_id_v(), tid = F.wave * 64 + lane; (void)tid;
    const bf16* RW = (const bf16*)(F.ws + WS_RW); bf16* L = (bf16*)(F.ws + WS_LACT); const float* mu = (const float*)A.in[16] + 1536;
    const int gw = F.vcu * NWAVES + F.wave, NGW = F.G * NWAVES, c0 = 4 * lane;
    const f32x4 mu4 = *(const f32x4*)(mu + c0);
    for (int m = gw; m < M; m += NGW) { const int t = m & (T - 1);
        const u32x2 p = *(const GAS u32x2*)(RW + (size_t)m * RWC + 1536 + c0); u32x2 q = (u32x2){0u, 0u}; if (t > 0) q = *(const GAS u32x2*)(RW + (size_t)(m - 1) * RWC + 1536 + c0);
        f32x4 pv = (f32x4){bflo(p.x), bfhi(p.x), bflo(p.y), bfhi(p.y)}, qv = (f32x4){bflo(q.x), bfhi(q.x), bflo(q.y), bfhi(q.y)};
        f32x4 s = pv + (qv - pv) * mu4;
        if (c0 < 64) { s.x = tanhf(s.x); s.y = tanhf(s.y); s.z = tanhf(s.z); s.w = tanhf(s.w); }
        else if (c0 >= 128) { s.x = 1.f / (1.f + __expf(-s.x)); s.y = 1.f / (1.f + __expf(-s.y)); s.z = 1.f / (1.f + __expf(-s.z)); s.w = 1.f / (1.f + __expf(-s.w)); }
        *(GAS u32x2*)(L + (size_t)m * 256 + c0) = (u32x2){pkbf(s.x, s.y), pkbf(s.z, s.w)}; }
}

namespace rwk {
typedef short bf16x8 __attribute__((ext_vector_type(8)));
constexpr int MB = 8192;
__device__ __forceinline__ int moff(int r, int c) { return r * 128 + ((((c >> 3) ^ (r >> 1)) & 7) << 4) + ((c & 7) << 1); }
__device__ __forceinline__ bf16x8 frag(const LAS unsigned char* buf, int row, int chunk) { return *(const LAS bf16x8*)(buf + row * 128 + (((chunk ^ (row >> 1)) & 7) << 4)); }
__device__ __forceinline__ void mm(f32x4& acc, const LAS unsigned char* A, int tm, const LAS unsigned char* B, int tn, int l) {
    const int ar = 16 * tm + (l & 15), br = 16 * tn + (l & 15), q = l >> 4;
#pragma unroll
    for (int ks = 0; ks < 2; ++ks) { const bf16x8 a = frag(A, ar, 4 * ks + q), b = frag(B, br, 4 * ks + q); acc = __builtin_amdgcn_mfma_f32_16x16x32_bf16(a, b, acc, 0, 0, 0); }
}
__device__ __forceinline__ void st_nm(LAS unsigned char* buf, int tm, int tn, int l, f32x4 v) {
    const int row = 16 * tn + (l & 15), c = 16 * tm + 4 * (l >> 4); *(LAS u32x2*)(buf + moff(row, c)) = (u32x2){pkbf(v[0], v[1]), pkbf(v[2], v[3])}; }
__device__ __forceinline__ void st_mn(LAS unsigned char* buf, int tm, int tn, int l, f32x4 v) {
    const int c = 16 * tn + (l & 15), r0 = 16 * tm + 4 * (l >> 4); const unsigned p0 = pkbf(v[0], v[1]), p1 = pkbf(v[2], v[3]);
    *(LAS unsigned short*)(buf + moff(r0 + 0, c)) = (unsigned short)(p0 & 0xffffu); *(LAS unsigned short*)(buf + moff(r0 + 1, c)) = (unsigned short)(p0 >> 16);
    *(LAS unsigned short*)(buf + moff(r0 + 2, c)) = (unsigned short)(p1 & 0xffffu); *(LAS unsigned short*)(buf + moff(r0 + 3, c)) = (unsigned short)(p1 >> 16); }
__device__ __forceinline__ f32x4 ld_nm(const LAS unsigned char* buf, int tm, int tn, int l) {
    const int row = 16 * tn + (l & 15), c = 16 * tm + 4 * (l >> 4); const u32x2 p = *(const LAS u32x2*)(buf + moff(row, c)); return (f32x4){bflo(p.x), bfhi(p.x), bflo(p.y), bfhi(p.y)}; }
__device__ __forceinline__ float wsum64(float x) {
    x = DPP_ADD(x, 0xB1); x = DPP_ADD(x, 0x4E); x = DPP_ADD(x, 0x124); x = DPP_ADD(x, 0x128);
    x += __shfl_xor(x, 16); x += __shfl_xor(x, 32); return x; }
__device__ __forceinline__ float sum8(float x) { x = DPP_ADD(x, 0xB1); x = DPP_ADD(x, 0x4E); x = DPP_ADD(x, 0x141); return x; }
}

__device__ __forceinline__ void rwkv_pre(Frame& F, const ArgsD& A, const int bh, const int c_lo, const int c_hi) {
    using namespace rwk;
    const int b = bh >> 3, h = bh & 7, lane0 = lane_id_v(), w0 = F.wave;
    LAS unsigned char* L = F.lds + RING_OFF;
    LAS unsigned char* bA = L + 0 * MB; LAS unsigned char* bR = L + 1 * MB; LAS unsigned char* bB = L + 2 * MB; LAS unsigned char* bK = L + 3 * MB;
    LAS unsigned char* bBH = L + 4 * MB; LAS unsigned char* bKH = L + 5 * MB; LAS unsigned char* bVT = L + 6 * MB;
    LAS unsigned char* bAT = L + 7 * MB;
    LAS unsigned char* bAak = L + 9 * MB; LAS unsigned char* bArb = L + 10 * MB; LAS unsigned char* bArk = L + 11 * MB;
    LAS unsigned char* bQ0 = L + 12 * MB; LAS unsigned char* bQT0 = L + 13 * MB;
    LAS unsigned char* bT = L + 14 * MB;
    LAS unsigned char* bTF = L + 15 * MB;
    LAS float* part = (LAS float*)(F.lds + MISC_OFF + 128);
    LAS float* bon = part + 512;
    const bf16* RW = (const bf16*)(F.ws + WS_RW); const float* LW = (const float*)(F.ws + WS_LW); const float* AS = (const float*)(F.ws + WS_AS);
    unsigned char* IMG = F.ws + WS_RIMG; float* BON = (float*)(F.ws + WS_RBON);
    const size_t mb = (size_t)b * T;
    const float* mu = (const float*)A.in[16];
    float mu_r, mu_k, mu_v, kkc, kac, rkc;
    { const int hj = h * 64 + lane0; mu_r = mu[hj]; mu_k = mu[512 + hj]; mu_v = mu[1024 + hj]; kkc = ((const float*)A.in[22])[hj]; kac = ((const float*)A.in[23])[hj]; rkc = ((const float*)A.in[24])[hj]; }
    unsigned short pr[9], pk_[9], pv[9]; float plw[8], pas[8];
#define RWC_LOAD(c) do { const int w = w0, hj = h * 64 + lane0; const size_t m0_ = mb + (size_t)(c) * 64 + 8 * w; \
        _Pragma("unroll") for (int i_ = 0; i_ < 9; ++i_) { const bool ok_ = (i_ > 0) || ((c) > 0) || (w > 0); const bf16* row_ = RW + (m0_ + i_ - 1) * RWC + hj; \
            pr[i_] = ok_ ? row_[0] : (unsigned short)0; pk_[i_] = ok_ ? row_[512] : (unsigned short)0; pv[i_] = ok_ ? row_[1024] : (unsigned short)0; } \
        _Pragma("unroll") for (int i_ = 0; i_ < 8; ++i_) { plw[i_] = LW[(m0_ + i_) * 512 + hj]; pas[i_] = AS[(m0_ + i_) * 512 + hj]; } } while (0)
    RWC_LOAD(c_lo);
    for (int c = c_lo; c < c_hi; ++c) {
        int w = w0, lane = lane0; asm volatile("" : "+s"(w), "+v"(lane));
        const int tn_ = w & 3, tm0_ = 2 * (w >> 2);
        { float run = 0.f;
#pragma unroll
          for (int i = 0; i < 8; ++i) run += plw[i];
          part[w * 64 + lane] = run; }
        __syncthreads();
        float off = 0.f, ctot = 0.f;
#pragma unroll
        for (int o = 0; o < 8; ++o) { const float p = part[o * 64 + lane]; ctot += p; if (o < w) off += p; }
        {   unsigned bh_[4], kh_[4], vt_[4], at_[4]; float cm = off; float* bon_g = BON + ((size_t)bh * 64 + c) * 64;
#pragma unroll
            for (int i = 0; i < 8; ++i) { const int t = 8 * w + i;
                const float p0 = bf2f(pr[i + 1]), p1 = bf2f(pk_[i + 1]), p2 = bf2f(pv[i + 1]);
                const float rv = p0 + (bf2f(pr[i]) - p0) * mu_r, kv = p1 + (bf2f(pk_[i]) - p1) * mu_k, vv = p2 + (bf2f(pv[i]) - p2) * mu_v, asg = pas[i];
                const float ce = cm; cm += plw[i];
                float kkv = kv * kkc; const float n2 = wsum64(kkv * kkv); kkv = kkv * __builtin_amdgcn_rsqf(fmaxf(n2, 1e-24f));
                const float km = kv * (1.f + (asg - 1.f) * kac); const float bn = wsum64(rv * km * rkc); if (lane == 0) bon_g[t] = bn;
                const float av = -kkv, bv = kkv * asg;
                const float e_ce = __expf(ce), e_cm = __expf(cm), e_ncm = __expf(-cm), e_rem = __expf(ctot - cm);
                const unsigned ha = pkbf(av * e_ce, 0.f) & 0xffffu; *(LAS unsigned short*)(bA + moff(t, lane)) = (unsigned short)ha; *(LAS unsigned short*)(bR + moff(t, lane)) = (unsigned short)(pkbf(rv * e_cm, 0.f) & 0xffffu);
                *(LAS unsigned short*)(bB + moff(t, lane)) = (unsigned short)(pkbf(bv * e_ncm, 0.f) & 0xffffu); *(LAS unsigned short*)(bK + moff(t, lane)) = (unsigned short)(pkbf(km * e_ncm, 0.f) & 0xffffu);
                const unsigned hb = pkbf(bv * e_rem, 0.f) & 0xffffu, hk = pkbf(km * e_rem, 0.f) & 0xffffu, hv = pkbf(vv, 0.f) & 0xffffu;
                if (i & 1) { bh_[i >> 1] |= hb << 16; kh_[i >> 1] |= hk << 16; vt_[i >> 1] |= hv << 16; at_[i >> 1] |= ha << 16; } else { bh_[i >> 1] = hb; kh_[i >> 1] = hk; vt_[i >> 1] = hv; at_[i >> 1] = ha; } }
            *(LAS v4u*)(bBH + moff(lane, 8 * w)) = (v4u){bh_[0], bh_[1], bh_[2], bh_[3]};
            *(LAS v4u*)(bKH + moff(lane, 8 * w)) = (v4u){kh_[0], kh_[1], kh_[2], kh_[3]};
            *(LAS v4u*)(bVT + moff(lane, 8 * w)) = (v4u){vt_[0], vt_[1], vt_[2], vt_[3]};
            *(LAS v4u*)(bAT + moff(lane, 8 * w)) = (v4u){at_[0], at_[1], at_[2], at_[3]};
        }
        const float dec0 = __expf(ctot);
        if (c + 1 < c_hi) RWC_LOAD(c + 1);
        __syncthreads();
        {   const int p = w >> 1; const LAS unsigned char* Am = (p < 2) ? bA : bR; const LAS unsigned char* Bm = (p == 0 || p == 2) ? bB : bK;
#pragma unroll
            for (int x = 0; x < 2; ++x) { const int tm = 2 * (w & 1) + x;
#pragma unroll
                for (int tn = 0; tn < 4; ++tn) { f32x4 acc = (f32x4){0.f, 0.f, 0.f, 0.f}; mm(acc, Am, tm, Bm, tn, lane);
                    const int n = 16 * tn + (lane & 15), m0 = 16 * tm + 4 * (lane >> 4);
#pragma unroll
                    for (int r = 0; r < 4; ++r) { const bool keep = (p < 2) ? (n < m0 + r) : (n <= m0 + r); if (!keep) acc[r] = 0.f; }
                    if (p == 0) { st_mn(bQ0, tm, tn, lane, acc); st_nm(bQT0, tm, tn, lane, acc);
#pragma unroll
                        for (int r = 0; r < 4; ++r) if (n == m0 + r) acc[r] += 1.f;
                        st_nm(bT, tm, tn, lane, acc); }
                    else st_mn((p == 1) ? bAak : (p == 2) ? bArb : bArk, tm, tn, lane, acc); } }
        }
        __syncthreads();
#pragma unroll
        for (int x = 0; x < 2; ++x) { const int tm = tm0_ + x; f32x4 acc = (f32x4){0.f, 0.f, 0.f, 0.f}; mm(acc, bQ0, tm, bQT0, tn_, lane); st_mn(bB, tm, tn_, lane, acc); st_nm(bK, tm, tn_, lane, acc); }
        __syncthreads();
#pragma unroll
        for (int s = 2; s <= 5; ++s) {
            const LAS unsigned char* Qc = (s & 1) ? bQ0 : bB; const LAS unsigned char* QTc = (s & 1) ? bQT0 : bK;
            LAS unsigned char* Qn = (s & 1) ? bB : bQ0; LAS unsigned char* QTn = (s & 1) ? bK : bQT0;
            const int tn = w & 3;
            if (w >= 4) { f32x4 acc[4];
#pragma unroll
                for (int tm = 0; tm < 4; ++tm) acc[tm] = ld_nm(bT, tm, tn, lane);
#pragma unroll
                for (int tm = 0; tm < 4; ++tm) mm(acc[tm], Qc, tm, bT, tn, lane);
#pragma unroll
                for (int tm = 0; tm < 4; ++tm) st_nm(bT, tm, tn, lane, acc[tm]);
            } else {
#pragma unroll
                for (int tm = 0; tm < 4; ++tm) { f32x4 acc = (f32x4){0.f, 0.f, 0.f, 0.f}; mm(acc, Qc, tm, QTc, tn, lane); st_mn(Qn, tm, tn, lane, acc); st_nm(QTn, tm, tn, lane, acc); }
            }
            __syncthreads();
        }
        {
#pragma unroll
            for (int x = 0; x < 2; ++x) { const int tm = tm0_ + x; f32x4 acc = ld_nm(bT, tm, tn_, lane); mm(acc, bB, tm, bT, tn_, lane); st_mn(bTF, tm, tn_, lane, acc); }
        }
        LAS unsigned char* bX = bB; LAS unsigned char* bW = bK; LAS unsigned char* bU = bQ0;
        __syncthreads();
#pragma unroll
        for (int x = 0; x < 2; ++x) { const int tm = tm0_ + x;
            { f32x4 acc = (f32x4){0.f, 0.f, 0.f, 0.f}; mm(acc, bAak, tm, bVT, tn_, lane); st_nm(bX, tm, tn_, lane, acc); }
            { f32x4 acc = (f32x4){0.f, 0.f, 0.f, 0.f}; mm(acc, bTF, tm, bAT, tn_, lane); st_nm(bW, tm, tn_, lane, acc); } }
        __syncthreads();
#pragma unroll
        for (int x = 0; x < 2; ++x) { const int tm = tm0_ + x; f32x4 acc = (f32x4){0.f, 0.f, 0.f, 0.f}; mm(acc, bTF, tm, bX, tn_, lane); st_nm(bU, tm, tn_, lane, acc); }
        __syncthreads();
        {   unsigned char* img = IMG + ((size_t)bh * 64 + c) * (4 * MB);
            const int n_ = 16 * tn_ + (lane & 15); const float decn = __shfl(dec0, n_);
#pragma unroll
            for (int x = 0; x < 2; ++x) { const int tm = tm0_ + x; const int m0 = 16 * tm + 4 * (lane >> 4); const int go = moff(n_, m0);
                { f32x4 acc = (f32x4){0.f, 0.f, 0.f, 0.f}; mm(acc, bW, tm, bBH, tn_, lane);
#pragma unroll
                  for (int r = 0; r < 4; ++r) if (m0 + r == n_) acc[r] += decn;
                  *(GAS u32x2*)(img + 0 * MB + go) = (u32x2){pkbf(acc[0], acc[1]), pkbf(acc[2], acc[3])}; }
                { f32x4 acc = (f32x4){0.f, 0.f, 0.f, 0.f}; mm(acc, bBH, tm, bU, tn_, lane); mm(acc, bKH, tm, bVT, tn_, lane);
                  *(GAS u32x2*)(img + 1 * MB + go) = (u32x2){pkbf(acc[0], acc[1]), pkbf(acc[2], acc[3])}; }
                { f32x4 acc = ld_nm(bR, tm, tn_, lane); mm(acc, bW, tm, bArb, tn_, lane);
                  *(GAS u32x2*)(img + 2 * MB + go) = (u32x2){pkbf(acc[0], acc[1]), pkbf(acc[2], acc[3])}; }
                { f32x4 acc = (f32x4){0.f, 0.f, 0.f, 0.f}; mm(acc, bArb, tm, bU, tn_, lane); mm(acc, bArk, tm, bVT, tn_, lane);
                  *(GAS u32x2*)(img + 3 * MB + go) = (u32x2){pkbf(acc[0], acc[1]), pkbf(acc[2], acc[3])}; } }
        }
        __syncthreads();
    }
#undef RWC_LOAD
}

__device__ __forceinline__ void rwkv_seq(Frame& F, const ArgsD& A, const int bh) {
    using namespace rwk;
    const int b = bh >> 3, h = bh & 7, lane0 = lane_id_v(), w0 = F.wave;
    LAS unsigned char* L = F.lds + RING_OFF;
    LAS unsigned char* bS0 = L + 8 * MB;
    LAS float* ybuf = (LAS float*)(L + 10 * MB);
    const bf16* RW = (const bf16*)(F.ws + WS_RW); const float* G = (const float*)(F.ws + WS_G); bf16* YC = (bf16*)(F.ws + WS_YCAT);
    const unsigned char* IMG = F.ws + WS_RIMG + (size_t)bh * 64 * (4 * MB); const float* BON = (const float*)(F.ws + WS_RBON) + (size_t)bh * 64 * 64;
    const float* mu = (const float*)A.in[16]; const float* lnw_g = (const float*)A.in[25]; const float* lnb_g = (const float*)A.in[26];
    const size_t mb = (size_t)b * T;
    const int tid0 = w0 * 64 + lane0, lt0 = tid0 >> 3, hlc0 = h * 64 + (tid0 & 7) * 8;
    for (int i = tid0; i < MB / 16; i += 512) ((LAS v4u*)bS0)[i] = (v4u){0u, 0u, 0u, 0u};
    v4u pf[4][4], lvp[4], lvq[4]; f32x4 lga[4], lgb[4]; float lbn[4];
#define RWS_LOAD(u, c) do { _Pragma("unroll") for (int k_ = 0; k_ < 4; ++k_) pf[u][k_] = *(const GAS v4u*)(IMG + (size_t)(c) * (4 * MB) + k_ * MB + tid0 * 16); \
        const size_t ml_ = mb + (size_t)(c) * 64 + lt0; lvp[u] = *(const GAS v4u*)(RW + ml_ * RWC + 1024 + hlc0); lvq[u] = *(const GAS v4u*)(RW + (ml_ - (((c) > 0 || lt0 > 0) ? 1 : 0)) * RWC + 1024 + hlc0); \
        lga[u] = *(const GAS f32x4*)(G + ml_ * 512 + hlc0); lgb[u] = *(const GAS f32x4*)(G + ml_ * 512 + hlc0 + 4); lbn[u] = BON[(c) * 64 + lt0]; } while (0)
#pragma unroll
    for (int u = 0; u < 4; ++u) RWS_LOAD(u, u);
    int scur = 0;
    for (int c4 = 0; c4 < T / 64; c4 += 4) {
#pragma unroll
      for (int u = 0; u < 4; ++u) { const int c = c4 + u;
        int w = w0, lane = lane0; asm volatile("" : "+s"(w), "+v"(lane));
        const int tid = w * 64 + lane, tn_ = w & 3, tm0_ = 2 * (w >> 2), lt = tid >> 3, lc = (tid & 7) * 8, hlc = h * 64 + lc;
        LAS unsigned char* set = L + (c & 1) * (4 * MB);
#pragma unroll
        for (int k = 0; k < 4; ++k) *(LAS v4u*)(set + k * MB + tid * 16) = pf[u][k];
        const v4u lv_p = lvp[u], lv_q = (c > 0 || lt > 0) ? lvq[u] : (v4u){0u, 0u, 0u, 0u}; const f32x4 lg0 = lga[u], lg1 = lgb[u]; const float bn = lbn[u];
        __syncthreads();
        if (c + 4 < T / 64) RWS_LOAD(u, c + 4);
        const LAS unsigned char* Sc = bS0 + scur * MB; LAS unsigned char* Sn = bS0 + (scur ^ 1) * MB;
#pragma unroll
        for (int x = 0; x < 2; ++x) { const int tm = tm0_ + x;
            { f32x4 acc = ld_nm(set + 1 * MB, tm, tn_, lane); mm(acc, set + 0 * MB, tm, Sc, tn_, lane); st_nm(Sn, tm, tn_, lane, acc); }
            { f32x4 acc = ld_nm(set + 3 * MB, tm, tn_, lane); mm(acc, set + 2 * MB, tm, Sc, tn_, lane);
              const int i = 16 * tn_ + (lane & 15), t0 = 16 * tm + 4 * (lane >> 4);
#pragma unroll
              for (int r = 0; r < 4; ++r) ybuf[(t0 + r) * 64 + i] = acc[r]; } }
        scur ^= 1;
        __syncthreads();
        {   const f32x4 y0 = *(const LAS f32x4*)(ybuf + lt * 64 + lc), y1 = *(const LAS f32x4*)(ybuf + lt * 64 + lc + 4);
            const float mean = sum8((y0.x + y0.y) + (y0.z + y0.w) + (y1.x + y1.y) + (y1.z + y1.w)) * (1.f / 64.f); const f32x4 d0 = y0 - mean, d1 = y1 - mean;
            const float var = sum8((d0.x * d0.x + d0.y * d0.y) + (d0.z * d0.z + d0.w * d0.w) + (d1.x * d1.x + d1.y * d1.y) + (d1.z * d1.z + d1.w * d1.w)) * (1.f / 64.f); const float rs = __builtin_amdgcn_rsqf(var + 64e-5f);
            const float* lnw_p = lnw_g + hlc; const float* lnb_p = lnb_g + hlc; const float* muv_p = mu + 1024 + hlc;
            const f32x4 lw0 = *(const f32x4*)lnw_p, lw1 = *(const f32x4*)(lnw_p + 4), lb0 = *(const f32x4*)lnb_p, lb1 = *(const f32x4*)(lnb_p + 4), mv0 = *(const f32x4*)muv_p, mv1 = *(const f32x4*)(muv_p + 4);
            f32x4 va = (f32x4){bflo(lv_p.x), bfhi(lv_p.x), bflo(lv_p.y), bfhi(lv_p.y)}, vb = (f32x4){bflo(lv_p.z), bfhi(lv_p.z), bflo(lv_p.w), bfhi(lv_p.w)};
            { const f32x4 qa = (f32x4){bflo(lv_q.x), bfhi(lv_q.x), bflo(lv_q.y), bfhi(lv_q.y)}, qb = (f32x4){bflo(lv_q.z), bfhi(lv_q.z), bflo(lv_q.w), bfhi(lv_q.w)}; va = va + (qa - va) * mv0; vb = vb + (qb - vb) * mv1; }
            const f32x4 o0 = ((d0 * rs) * lw0 + lb0 + va * bn) * lg0, o1 = ((d1 * rs) * lw1 + lb1 + vb * bn) * lg1;
            *(GAS v4u*)(YC + (mb + (size_t)c * 64 + lt) * 1024 + 512 + hlc) = (v4u){pkbf(o0.x, o0.y), pkbf(o0.z, o0.w), pkbf(o1.x, o1.y), pkbf(o1.z, o1.w)};
        }
      }
    }
#undef RWS_LOAD
}

__device__ __forceinline__ void p6_dacombine(Frame& F, const ArgsD& A) {
    const int lane = lane_id_v(), tid = F.wave * 64 + lane; (void)tid;
    const float* q1 = (const float*)A.in[11]; const float* k1 = (const float*)A.in[12]; const float* q2 = (const float*)A.in[13]; const float* k2 = (const float*)A.in[14];
    const float lam = __expf(wave_sum(q1[lane] * k1[lane])) - __expf(wave_sum(q2[lane] * k2[lane])) + 0.2f;
    const bf16* O = (const bf16*)(F.ws + WS_O); bf16* YC = (bf16*)(F.ws + WS_YCAT);
    const int gw = F.vcu * NWAVES + F.wave, NGW = F.G * NWAVES, dh = lane >> 4, d0 = 8 * (lane & 15);
    const float* sw = (const float*)A.in[15] + d0; const f32x4 swa = *(const f32x4*)sw * 0.8f, swb = *(const f32x4*)(sw + 4) * 0.8f;
    for (int m = gw; m < M; m += NGW) {
        const v4u a = *(const GAS v4u*)(O + (size_t)m * 1024 + dh * 256 + d0), c = *(const GAS v4u*)(O + (size_t)m * 1024 + dh * 256 + 128 + d0);
        f32x4 y0 = (f32x4){bflo(a.x) - lam * bflo(c.x), bfhi(a.x) - lam * bfhi(c.x), bflo(a.y) - lam * bflo(c.y), bfhi(a.y) - lam * bfhi(c.y)};
        f32x4 y1 = (f32x4){bflo(a.z) - lam * bflo(c.z), bfhi(a.z) - lam * bfhi(c.z), bflo(a.w) - lam * bflo(c.w), bfhi(a.w) - lam * bfhi(c.w)};
        float s2 = (y0.x * y0.x + y0.y * y0.y) + (y0.z * y0.z + y0.w * y0.w) + (y1.x * y1.x + y1.y * y1.y) + (y1.z * y1.z + y1.w * y1.w);
        s2 = allsum16(s2); const float rs = 1.f / sqrtf(s2 * (1.f / 128.f) + 1e-5f);
        y0 = y0 * rs * swa; y1 = y1 * rs * swb;
        *(GAS v4u*)(YC + (size_t)m * 1024 + dh * 128 + d0) = (v4u){pkbf(y0.x, y0.y), pkbf(y0.z, y0.w), pkbf(y1.x, y1.y), pkbf(y1.z, y1.w)}; }
}

#define P9_SWAP32(a, b) do { const auto r_ = __builtin_amdgcn_permlane32_swap(__float_as_uint(a), __float_as_uint(b), false, false); (a) = __uint_as_float(r_[0]) + __uint_as_float(r_[1]); } while (0)
#define P9_SWAP16(a, b) do { const auto r_ = __builtin_amdgcn_permlane16_swap(__float_as_uint(a), __float_as_uint(b), false, false); (a) = __uint_as_float(r_[0]) + __uint_as_float(r_[1]); } while (0)
#define P9_DPPF(x, ctrl) __builtin_bit_cast(float, __builtin_amdgcn_update_dpp(0, __builtin_bit_cast(int, (x)), (ctrl), 0xF, 0xF, true))
#define P9_DPPU(x, ctrl) ((unsigned)__builtin_amdgcn_update_dpp(0, (int)(x), (ctrl), 0xF, 0xF, true))
__device__ __forceinline__ float p9_reduce32(float (&a)[32], const int lane) {
#pragma unroll
    for (int e = 0; e < 16; ++e) P9_SWAP32(a[e], a[e + 16]);
#pragma unroll
    for (int e = 0; e < 8; ++e) P9_SWAP16(a[e], a[e + 8]);
    const bool b3 = (lane & 8) != 0, b2 = (lane & 4) != 0, b0 = (lane & 1) != 0;
#pragma unroll
    for (int e = 0; e < 4; ++e) { const float keep = b3 ? a[e + 4] : a[e], send = b3 ? a[e] : a[e + 4]; a[e] = keep + P9_DPPF(send, 0x128); }
#pragma unroll
    for (int e = 0; e < 2; ++e) { const float keep = b2 ? a[e + 2] : a[e], send = b2 ? a[e] : a[e + 2]; a[e] = keep + P9_DPPF(send, 0x141); }
    { const float keep = b0 ? a[1] : a[0], send = b0 ? a[0] : a[1]; a[0] = keep + P9_DPPF(send, 0xB1); }
    return a[0] + P9_DPPF(a[0], 0x4E);
}
__device__ __forceinline__ unsigned p9_wmax(unsigned v) {
    v = max(v, P9_DPPU(v, 0xB1)); v = max(v, P9_DPPU(v, 0x4E)); v = max(v, P9_DPPU(v, 0x124)); v = max(v, P9_DPPU(v, 0x128));
    const unsigned s0 = __builtin_amdgcn_readlane(v, 0), s1 = __builtin_amdgcn_readlane(v, 16), s2 = __builtin_amdgcn_readlane(v, 32), s3 = __builtin_amdgcn_readlane(v, 48);
    return max(max(s0, s1), max(s2, s3)); }
__device__ __forceinline__ void p8_postmix_router(Frame& F, const ArgsD& A, const int cset) {
    const int lane = lane_id_v(), tid = F.wave * 64 + lane; (void)tid;
    LAS float* rw = (LAS float*)(F.lds + RING_OFF);
    volatile LAS int* lcnt = (volatile LAS int*)(F.lds + LDSCTL_OFF);
    { const float* r = (const float*)A.in[27]; for (int i = tid; i < 1024 * 32; i += 512) { const int k = i >> 5, e = i & 31; rw[e * 1024 + k] = r[i]; } }
    if (tid < 32) lcnt[tid] = 0;
    __syncthreads();
    const float* x = (const float*)A.in[0]; const bf16* Y = (const bf16*)(F.ws + WS_Y); const float* mod = (const float*)(F.ws + WS_MOD);
    const float* pmn = (const float*)A.in[6]; const float* pfn = (const float*)A.in[7]; const float* rb = (const float*)A.in[28];
    unsigned char* H2 = F.ws + WS_H2; int* tokE = (int*)(F.ws + WS_TOKE); float* tokG = (float*)(F.ws + WS_TOKG);
    const int rows_per = M / F.G, mbeg = F.vcu * rows_per, b = mbeg >> 12; const float* mb_ = mod + (size_t)b * NMOD;
    f32x4 a1[4], a2[4], sh[4];
#pragma unroll
    for (int j = 0; j < 4; ++j) { const int col = 4 * lane + 256 * j; a1[j] = *(const f32x4*)(pmn + col) * *(const f32x4*)(mb_ + 2048 + col); a2[j] = *(const f32x4*)(pfn + col) * (*(const f32x4*)(mb_ + 4096 + col) + 1.f); sh[j] = *(const f32x4*)(mb_ + 3072 + col); }
    const int myexp = 8 * (lane >> 4) + 4 * ((lane >> 3) & 1) + 2 * ((lane >> 2) & 1) + (lane & 1); const float rbias = rb[myexp];
    const int nr = rows_per / NWAVES, m0 = mbeg + F.wave * nr;
    u32x2 yp[2][4]; f32x4 xp[2][4];
#define P9_LOAD(m_) do { _Pragma("unroll") for (int t_ = 0; t_ < 2; ++t_) _Pragma("unroll") for (int j_ = 0; j_ < 4; ++j_) { \
        yp[t_][j_] = *((const GAS u32x2*)(Y + (size_t)((m_) + t_) * D) + lane + 64 * j_); xp[t_][j_] = *((const GAS f32x4*)(x + (size_t)((m_) + t_) * D) + lane + 64 * j_); } } while (0)
    P9_LOAD(m0);
    for (int i = 0; i < nr; i += 2) { const int m = m0 + i;
        f32x4 xv[2][4];
#pragma unroll
        for (int t = 0; t < 2; ++t) { f32x4 yv[4]; float s2 = 0.f;
#pragma unroll
            for (int j = 0; j < 4; ++j) { const u32x2 p = yp[t][j]; yv[j] = (f32x4){bflo(p.x), bfhi(p.x), bflo(p.y), bfhi(p.y)}; s2 += (yv[j].x * yv[j].x + yv[j].y * yv[j].y) + (yv[j].z * yv[j].z + yv[j].w * yv[j].w); }
            const float rs = __builtin_amdgcn_rsqf(wave_sum(s2) * (1.f / D) + 1e-6f); float t2 = 0.f;
#pragma unroll
            for (int j = 0; j < 4; ++j) { xv[t][j] = xp[t][j] + a1[j] * (yv[j] * rs); *((GAS f32x4*)(F.out + (size_t)(m + t) * D) + lane + 64 * j) = xv[t][j];
                t2 += (xv[t][j].x * xv[t][j].x + xv[t][j].y * xv[t][j].y) + (xv[t][j].z * xv[t][j].z + xv[t][j].w * xv[t][j].w); }
            const float rs2 = __builtin_amdgcn_rsqf(wave_sum(t2) * (1.f / D) + 1e-6f);
#pragma unroll
            for (int j = 0; j < 4; ++j) { xv[t][j] = xv[t][j] * rs2 * a2[j] + sh[j]; *((GAS unsigned*)(H2 + (size_t)(m + t) * D) + lane + 64 * j) = pg8::pk4_fp8(xv[t][j].x, xv[t][j].y, xv[t][j].z, xv[t][j].w); } }
        if (i + 2 < nr) P9_LOAD(m + 2);
        float ac0[32], ac1[32];
#pragma unroll
        for (int e = 0; e < 32; ++e) { float s0 = 0.f, s1 = 0.f;
#pragma unroll
            for (int j = 0; j < 4; ++j) { const f32x4 w = *(const LAS f32x4*)(rw + e * 1024 + 4 * lane + 256 * j);
                s0 += (xv[0][j].x * w.x + xv[0][j].y * w.y) + (xv[0][j].z * w.z + xv[0][j].w * w.w); s1 += (xv[1][j].x * w.x + xv[1][j].y * w.y) + (xv[1][j].z * w.z + xv[1][j].w * w.w); }
            ac0[e] = s0; ac1[e] = s1; }
        const float lg[2] = {p9_reduce32(ac0, lane) + rbias, p9_reduce32(ac1, lane) + rbias};
#pragma unroll
        for (int t = 0; t < 2; ++t) { const unsigned u = __float_as_uint(lg[t]); unsigned key = (((u >> 31) ? ~u : (u | 0x80000000u)) & ~31u) | (unsigned)(31 - myexp);
            float tv[4]; int ti[4];
#pragma unroll
            for (int k = 0; k < 4; ++k) { const unsigned mx = p9_wmax(key); ti[k] = 31 - (int)(mx & 31u); const unsigned kv = mx & ~31u; tv[k] = __uint_as_float((kv >> 31) ? (kv & 0x7fffffffu) : ~kv); if (key == mx) key = 0u; }
            float ew[4], es = 0.f;
#pragma unroll
            for (int k = 0; k < 4; ++k) { ew[k] = __expf(tv[k] - tv[0]); es += ew[k]; }
            if (lane < 4) { const int e = (lane == 0) ? ti[0] : (lane == 1) ? ti[1] : (lane == 2) ? ti[2] : ti[3]; const float g = ((lane == 0) ? ew[0] : (lane == 1) ? ew[1] : (lane == 2) ? ew[2] : ew[3]) / es;
                const int pos = __hip_atomic_fetch_add((LAS int*)lcnt + e, 1, __ATOMIC_RELAXED, __HIP_MEMORY_SCOPE_WORKGROUP);
                tokE[(size_t)(m + t) * 4 + lane] = e | (pos << 8); tokG[(size_t)(m + t) * 4 + lane] = g; } }
    }
#undef P9_LOAD
    __syncthreads();
    if (tid < 32) { const int n = lcnt[tid]; int base = 0; if (n > 0) base = (int)__hip_atomic_fetch_add(F.ctl + CW_ECNT + cset * 64 * NEXP + 64 * tid, (unsigned)n, __ATOMIC_RELAXED, __HIP_MEMORY_SCOPE_AGENT);
        ((int*)(F.ws + WS_BLKBASE))[F.vcu * 32 + tid] = base; }
}

__device__ __forceinline__ void moe_tables(Frame& F) {
    const int lane = lane_id_v(), tid = F.wave * 64 + lane; (void)tid;
    volatile LAS int* ts = (volatile LAS int*)(F.lds + LDSCTL_OFF);
    if (tid < 32) ts[40 + tid] = (int)__hip_atomic_load(F.ctl + CW_ECNT + 64 * tid, __ATOMIC_RELAXED, __HIP_MEMORY_SCOPE_AGENT);
    __syncthreads();
    if (tid == 0) { int acc = 0; for (int e = 0; e < 32; ++e) { ts[e] = acc; acc += (ts[40 + e] + 255) >> 8; } ts[32] = acc; }
    __syncthreads();
}
__device__ __forceinline__ void p9_rows(Frame& F) {
    const int lane = lane_id_v(), tid = F.wave * 64 + lane; (void)tid;
    moe_tables(F);
    volatile LAS int* ts = (volatile LAS int*)(F.lds + LDSCTL_OFF);
    const int* tokE = (const int*)(F.ws + WS_TOKE); const float* tokG = (const float*)(F.ws + WS_TOKG); const int* blkbase = (const int*)(F.ws + WS_BLKBASE) + F.vcu * 32;
    int* tokrow = (int*)(F.ws + WS_TOKROW); int* rowtok = (int*)(F.ws + WS_ROWTOK); float* rowgate = (float*)(F.ws + WS_ROWGATE);
    const int rows_per = M / F.G, mbeg = F.vcu * rows_per;
    for (int i = tid; i < rows_per * 4; i += 512) { const int idx = mbeg * 4 + i; const int pe = tokE[idx], e = pe & 255, pos = pe >> 8; const int row = ts[e] * 256 + blkbase[e] + pos;
        tokrow[idx] = row; rowtok[row] = idx >> 2; rowgate[row] = tokG[idx]; }
    for (int e = F.vcu; e < 32; e += F.G) { const int n = ts[40 + e]; const int r0 = ts[e] * 256 + n, r1 = ts[e + 1] * 256;
        for (int r = r0 + tid; r < r1; r += 512) { rowtok[r] = 0; rowgate[r] = 0.f; } }
}

__device__ __forceinline__ void p12_final(Frame& F, const ArgsD& A, float* dst) {
    const int lane = lane_id_v(), tid = F.wave * 64 + lane; (void)tid;
    const bf16* Y2 = (const bf16*)(F.ws + WS_Y2); const int* tokrow = (const int*)(F.ws + WS_TOKROW); const float* mod = (const float*)(F.ws + WS_MOD); const float* pn = (const float*)A.in[8];
    const int rows_per = M / F.G, mbeg = F.vcu * rows_per, b = mbeg >> 12, nr = rows_per / NWAVES, m0 = mbeg + F.wave * nr;
    const float* mb_ = mod + (size_t)b * NMOD + 5120;
    f32x4 gw[4];
#pragma unroll
    for (int j = 0; j < 4; ++j) { const int col = 4 * lane + 256 * j; gw[j] = *(const f32x4*)(pn + col) * *(const f32x4*)(mb_ + col); }
    const int myrow = tokrow[(size_t)m0 * 4 + (lane < nr * 4 ? lane : 0)];
    u32x2 yp[4][4]; f32x4 xp[4];
#define P13_LOAD(i_) do { _Pragma("unroll") for (int k_ = 0; k_ < 4; ++k_) { const int row_ = __builtin_amdgcn_readlane(myrow, 4 * (i_) + k_); \
        _Pragma("unroll") for (int j_ = 0; j_ < 4; ++j_) yp[k_][j_] = *((const GAS u32x2*)(Y2 + (size_t)row_ * D) + lane + 64 * j_); } \
        _Pragma("unroll") for (int j_ = 0; j_ < 4; ++j_) xp[j_] = *((const GAS f32x4*)(F.out + (size_t)(m0 + (i_)) * D) + lane + 64 * j_); } while (0)
    P13_LOAD(0);
#pragma unroll 1
    for (int i = 0; i < nr; ++i) { const int m = m0 + i;
        f32x4 a[4], xv[4]; float s2 = 0.f;
#pragma unroll
        for (int j = 0; j < 4; ++j) { a[j] = (f32x4){0.f, 0.f, 0.f, 0.f};
#pragma unroll
            for (int k = 0; k < 4; ++k) { const u32x2 p = yp[k][j]; a[j] = a[j] + (f32x4){bflo(p.x), bfhi(p.x), bflo(p.y), bfhi(p.y)}; }
            s2 += (a[j].x * a[j].x + a[j].y * a[j].y) + (a[j].z * a[j].z + a[j].w * a[j].w); xv[j] = xp[j]; }
        if (i + 1 < nr) { const int in_ = __builtin_amdgcn_readfirstlane(i + 1);
#pragma unroll
            for (int k_ = 0; k_ < 4; ++k_) { const int row_ = __shfl(myrow, 4 * in_ + k_);
#pragma unroll
                for (int j_ = 0; j_ < 4; ++j_) yp[k_][j_] = *((const GAS u32x2*)(Y2 + (size_t)row_ * D) + lane + 64 * j_); }
#pragma unroll
            for (int j_ = 0; j_ < 4; ++j_) xp[j_] = *((const GAS f32x4*)(F.out + (size_t)(m + 1) * D) + lane + 64 * j_); }
        const float rs = __builtin_amdgcn_rsqf(wave_sum(s2) * (1.f / D) + 1e-6f);
#pragma unroll
        for (int j = 0; j < 4; ++j) *((GAS f32x4*)(dst + (size_t)m * D) + lane + 64 * j) = xv[j] + gw[j] * (a[j] * rs); }
#undef P13_LOAD
}
__global__ void __launch_bounds__(NWAVES * 64, 2) hybrid_fwd(Args kargs) {
    const ArgsD args{};
    extern __shared__ __attribute__((aligned(16))) unsigned char lds[];
    Frame F;
    F.lds = (LAS unsigned char*)lds;
    F.MISC = (volatile LAS unsigned*)(F.lds + MISC_OFF);
    F.wave = __builtin_amdgcn_readfirstlane((int)threadIdx.x >> 6);
    F.G = gridDim.x; { const int bx = blockIdx.x; F.vcu = (F.G % 8 == 0) ? (bx % 8) * (F.G / 8) + bx / 8 : bx; }
    F.ws = kargs.ws; F.out = kargs.out;
    unsigned char* ws = kargs.ws;
    F.ctl = (gu32*)(ws + WS_CTL);
#define GRID_BAR(seam) do { if (N_LAUNCHES != 1) { if (F.wave == 0 && lane_id_v() == 0) __hip_atomic_store(F.ctl + CW_TMO, 0xBADBA0u | (unsigned)(seam), RLX_AGENT); } else { xcd_barrier(bar); } } while (0)
    for (int u = threadIdx.x; u < (LDS_BYTES - LDSCTL_OFF) / 4; u += NWAVES * 64) ((LAS unsigned*)(F.lds + LDSCTL_OFF))[u] = 0u;
    __syncthreads();
    XcdBarrier bar; bar.bar = (unsigned*)(F.ctl + CW_BAR); bar.x = 0; bar.st = nullptr; bar.wid = F.wave;
    if (N_LAUNCHES == 1) bar = xcd_barrier_post((unsigned*)(F.ctl + CW_BAR), F.MISC + 8, F.wave);
    const int lo = kargs.ph_lo, hi = kargs.ph_hi;
#define IN(k) (lo <= (k) && (k) < hi)
#define PREP(k) (((PROBE_MASK) >> (k)) & 1)
#define BOTH(k) (IN(k) && IN((k) + 1))
    bf16* const H = (bf16*)(ws + WS_H); bf16* const H2 = (bf16*)(ws + WS_H2);

    if (IN(0)) { _Pragma("unroll 1") for (int r_ = 0; r_ <= PREP(0); ++r_) { p0_prologue(F, args); } if (BOTH(0)) GRID_BAR(0); }
    if (IN(1)) { _Pragma("unroll 1") for (int r_ = 0; r_ <= PREP(1); ++r_) { p1_premix(F, args); } if (BOTH(1)) GRID_BAR(1); }
    if (IN(2)) {
        pg8::Gemm g{H, (const bf16*)(ws + WS_WIN), M, IN_COLS, D, 0, nullptr, ws}; pg8::StaticOrder S; S.init(M, IN_COLS, F.G, (int)blockIdx.x);
        pg8::EpiProj E{(bf16*)(ws + WS_Q), (bf16*)(ws + WS_K), (bf16*)(ws + WS_V), (bf16*)(ws + WS_RW), (const float*)(ws + WS_ROPE), attn_body::C2};
        if (PREP(2)) { pg8::gemm_phase<pg8::EpiProj, pg8::StaticOrder, true, true, false>(F.lds + RING_OFF, g, S, E, F.wave); GRID_BAR(102); }
        pg8::gemm_phase<pg8::EpiProj, pg8::StaticOrder, true, true, false>(F.lds + RING_OFF, g, S, E, F.wave);
        if (BOTH(2)) GRID_BAR(2);
    }
    if (IN(3)) { _Pragma("unroll 1") for (int r_ = 0; r_ <= PREP(3); ++r_) { p3_lact(F, args); } if (BOTH(3)) GRID_BAR(3); }
    if (IN(4)) {
        pg8::Gemm g{(const bf16*)(ws + WS_LACT), (const bf16*)(ws + WS_BLORA), M, 1536, 256, 0, nullptr, ws}; pg8::StaticOrder S; S.init(M, 1536, F.G, (int)blockIdx.x);
        pg8::EpiLora E{(float*)(ws + WS_LW), (size_t)(WS_AS - WS_LW) / 4, (const float*)args.in[17], (const float*)args.in[19]}; static_assert(WS_G - WS_AS == WS_AS - WS_LW, "LW | AS | G equally spaced");
        if (PREP(4)) { pg8::gemm_phase<pg8::EpiLora, pg8::StaticOrder, true, true, false>(F.lds + RING_OFF, g, S, E, F.wave); GRID_BAR(104); }
        pg8::gemm_phase<pg8::EpiLora, pg8::StaticOrder, true, true, false>(F.lds + RING_OFF, g, S, E, F.wave);
        if (BOTH(4)) GRID_BAR(4);
    }
    if (IN(5)) {
        _Pragma("unroll 1") for (int r_ = 0; r_ <= PREP(5); ++r_)
            for (int u = F.vcu; u < BATCH * 8 * 4; u += F.G) rwkv_pre(F, args, u >> 2, (u & 3) * 16, (u & 3) * 16 + 16);
        if (BOTH(5)) GRID_BAR(5);
    }
    if (IN(6)) {
        _Pragma("unroll 1") for (int r_ = 0; r_ <= PREP(14); ++r_)
            for (int bh = blockIdx.x; bh < BATCH * 8; bh += F.G) rwkv_seq(F, args, bh);
        static_assert(attn_body::ATTN_LDS_BYTES <= RING_BYTES, "attention body geometry vs frame");
        const attn_body::AttnTensors AT{(const attn_body::bf16*)(ws + WS_Q), (const attn_body::bf16*)(ws + WS_K), (const attn_body::bf16*)(ws + WS_V), (attn_body::bf16*)(ws + WS_O)};
        if (PREP(15)) { const attn_body::QueueOrder S0{(unsigned*)(F.ctl + CW_ATTQ + 64), F.MISC + 12, F.wave}; attn_body::attn_phase<attn_body::QueueOrder>((char*)lds + RING_OFF, AT, S0, F.wave); GRID_BAR(106); }
        const attn_body::QueueOrder S{(unsigned*)(F.ctl + CW_ATTQ), F.MISC + 12, F.wave};
        attn_body::attn_phase<attn_body::QueueOrder>((char*)lds + RING_OFF, AT, S, F.wave);
        if (BOTH(6)) GRID_BAR(6);
    }
    if (IN(7)) { _Pragma("unroll 1") for (int r_ = 0; r_ <= PREP(7); ++r_) { p6_dacombine(F, args); } if (BOTH(7)) GRID_BAR(7); }
    if (IN(8)) {
        pg8::Gemm g{(const bf16*)(ws + WS_YCAT), (const bf16*)(ws + WS_WOUT), M, D, D, 0, nullptr, ws}; pg8::StaticOrder S; S.init(M, D, F.G, (int)blockIdx.x);
        pg8::EpiPlain E{(bf16*)(ws + WS_Y), D};
        if (PREP(8)) { pg8::gemm_phase<pg8::EpiPlain, pg8::StaticOrder, true, true, false>(F.lds + RING_OFF, g, S, E, F.wave); GRID_BAR(108); }
        pg8::gemm_phase<pg8::EpiPlain, pg8::StaticOrder, true, true, false>(F.lds + RING_OFF, g, S, E, F.wave);
        if (BOTH(8)) GRID_BAR(8);
    }
    if (IN(9)) { _Pragma("unroll 1") for (int r_ = PREP(9); r_ >= 0; --r_) { p8_postmix_router(F, args, r_); } if (BOTH(9)) GRID_BAR(9); }
    if (IN(10)) { _Pragma("unroll 1") for (int r_ = 0; r_ <= PREP(10); ++r_) { p9_rows(F); } if (BOTH(10)) GRID_BAR(10); }
    if (IN(11)) {
        moe_tables(F);
        const LAS int* ts = (const LAS int*)(F.lds + LDSCTL_OFF);
        pg8::Gemm g{H2, (const bf16*)(ws + WS_W1), MAXROWS, 2048, D / 2, (size_t)2048 * D, (const int*)(ws + WS_ROWTOK), ws};
        pg8::MoeOrder S{__builtin_amdgcn_readfirstlane(ts[32]), 8, 4, F.G, F.vcu, ts};
        pg8::EpiSwiglu E{ws + WS_ACT, (const float*)args.in[30]};
        if (PREP(11)) { pg8::gemm_phase<pg8::EpiSwiglu, pg8::MoeOrder, true, true, true, true>(F.lds + RING_OFF, g, S, E, F.wave); GRID_BAR(111); }
        pg8::gemm_phase<pg8::EpiSwiglu, pg8::MoeOrder, true, true, true, true>(F.lds + RING_OFF, g, S, E, F.wave);
        if (BOTH(11)) GRID_BAR(11);
    }
    if (IN(12)) {
        moe_tables(F);
        const LAS int* ts = (const LAS int*)(F.lds + LDSCTL_OFF);
        pg8::Gemm g{(const bf16*)(ws + WS_ACT), (const bf16*)(ws + WS_W2), MAXROWS, D, D / 2, (size_t)D * D, nullptr, ws};
        pg8::MoeOrder S{__builtin_amdgcn_readfirstlane(ts[32]), 4, 8, F.G, F.vcu, ts};
        pg8::EpiMoe2 E{(bf16*)(ws + WS_Y2), (const float*)args.in[32], (const float*)(ws + WS_ROWGATE)};
        if (PREP(12)) { pg8::gemm_phase<pg8::EpiMoe2, pg8::MoeOrder, true, true, false, true>(F.lds + RING_OFF, g, S, E, F.wave); GRID_BAR(112); }
        pg8::gemm_phase<pg8::EpiMoe2, pg8::MoeOrder, true, true, false, true>(F.lds + RING_OFF, g, S, E, F.wave);
        if (BOTH(12)) GRID_BAR(12);
    }
    if (IN(13)) { _Pragma("unroll 1") for (int r_ = PREP(13); r_ >= 0; --r_) { p12_final(F, args, r_ ? (float*)(ws + WS_G) : F.out); } }
#undef IN
#undef PREP
#undef BOTH
}

extern "C" void kernel_launch(void* const* d_in, const int* in_sizes, int n_in, void* d_out, int out_size, void* d_ws, size_t ws_size, hipStream_t stream) {
    static int grid = 0;
    if (grid == 0) {
        if (n_in != 33 || in_sizes[0] != M * D || out_size != M * D || ws_size < WS_END) { fprintf(stderr, "kernel_launch: built for 33 inputs, x and out of %d floats, >= %zu bytes of workspace; got n_in %d, in0 %d, out %d, ws %zu; nothing launched\n", M * D, (size_t)WS_END, n_in, n_in > 0 ? in_sizes[0] : -1, out_size, ws_size); grid = -1; return; }
        int dev = 0, cus = 0, per_cu = 0;
        if (hipGetDevice(&dev) != hipSuccess || hipDeviceGetAttribute(&cus, hipDeviceAttributeMultiprocessorCount, dev) != hipSuccess) { fprintf(stderr, "kernel_launch: hipGetDevice / hipDeviceGetAttribute failed; nothing launched\n"); grid = -1; return; }
        if (hipFuncSetAttribute((const void*)hybrid_fwd, hipFuncAttributeMaxDynamicSharedMemorySize, LDS_BYTES) != hipSuccess) { fprintf(stderr, "kernel_launch: hipFuncSetAttribute failed; nothing launched\n"); grid = -1; return; }
        if (hipOccupancyMaxActiveBlocksPerMultiprocessor(&per_cu, (const void*)hybrid_fwd, NWAVES * 64, LDS_BYTES) != hipSuccess || per_cu < 1)
            fprintf(stderr, "kernel_launch: note: the occupancy query reports %d workgroups per CU\n", per_cu);
        (void)hipGetLastError();
        grid = (cus >= 256) ? 256 : (cus / 32) * 32;
        if (grid != 256) fprintf(stderr, "kernel_launch: launching %d workgroups (built and checked for 256)\n", grid);
    }
    if (grid <= 0) return;
    if (hipMemsetAsync((char*)d_ws + WS_CTL, 0, CTL_ZERO_BYTES, stream) != hipSuccess) { fprintf(stderr, "kernel_launch: hipMemsetAsync of the control words failed; nothing launched\n"); return; }
    Args a{};
    for (int i = 0; i < 33; ++i) a.in[i] = d_in[i];
    a.out = (float*)d_out; a.ws = (unsigned char*)d_ws;
    for (int li = 0; li < N_LAUNCHES; ++li) {
        a.ph_lo = (N_LAUNCHES == 1) ? 0 : li; a.ph_hi = (N_LAUNCHES == 1) ? N_PHASES : li + 1; a.li = li; a.pad = 0;
        hipLaunchKernelGGL(hybrid_fwd, dim3(grid), dim3(NWAVES * 64), LDS_BYTES, stream, a);
        const hipError_t le = hipPeekAtLastError();
        if (le != hipSuccess) { fprintf(stderr, "kernel_launch: launch %d failed: %s\n", li, hipGetErrorName(le)); break; }
    }
}
```

```cpp
#include <hip/hip_runtime.h>
#include <cstdio>
#include <cstdint>
__device__ __forceinline__ int lane_id_v() { int l; asm volatile("v_mbcnt_lo_u32_b32 %0, -1, 0\n\tv_mbcnt_hi_u32_b32 %0, -1, %0" : "=v"(l)); return l; }
namespace pg8 {
#define PG8_LAS __attribute__((address_space(3)))
typedef unsigned short bf16_t;
typedef short bf16x8 __attribute__((ext_vector_type(8)));
typedef float f32x4 __attribute__((ext_vector_type(4)));
typedef unsigned u32x4 __attribute__((ext_vector_type(4)));
typedef int v4i_t __attribute__((ext_vector_type(4)));
typedef int v8i_t __attribute__((ext_vector_type(8)));
typedef v8i_t v8i_a16 __attribute__((aligned(16)));
union frag2_t { bf16x8 pc[2]; v8i_t w; };
constexpr int BM = 256, BK = 64, HALF = 128, HTB = HALF * BK * 2  , STAGE_BYTES = 8 * HTB, NXCD = 8, WGM = 8;

__host__ __device__ __forceinline__ int lds_byte(int r, int c) { const int st = (r >> 4) * 2 + (c >> 5), rr = r & 15, cc = c & 31, ob = rr * 64 + cc * 2; return st * 1024 + (ob ^ (((ob >> 9) & 1) << 5)); }
__host__ __device__ __forceinline__ void stage_rc(int b, int& R, int& C) { const int st = b / 1024, sb = b % 1024, swz = sb ^ (((sb >> 9) & 1) << 5); R = (st >> 1) * 16 + swz / 64; C = (st & 1) * 32 + (swz % 64) / 2; }
__host__ __device__ __forceinline__ int perm32(int rho) { const int n = rho >> 4, i = rho & 15; return 8 * (i >> 2) + 4 * n + (i & 3); }

struct Unit { int pm, pn, e; };
struct Gemm { const bf16_t* A; const bf16_t* Bt; int M, N, K; size_t bstride; const int* rowidx; const void* base; };

struct StaticOrder {
    int nM, nN, nwg, G, c;
    __host__ __device__ void init(int M, int N, int G_, int c_) { nM = M / BM; nN = N / BM; nwg = nM * nN; G = G_; c = c_; }
    __host__ __device__ bool next(int i, Unit& u) const {
        const long L = (long)i * G + c; if (L >= nwg) return false;
        int wgid = (int)L; { const int q = nwg / NXCD, r = nwg % NXCD, xcd = wgid % NXCD, off = wgid / NXCD; wgid = (xcd < r ? xcd * (q + 1) : r * (q + 1) + (xcd - r) * q) + off; }
        const int nig = WGM * nN, gid = wgid / nig, fm = gid * WGM, gsz = (nM - fm) < WGM ? (nM - fm) : WGM;
        u.pm = fm + ((wgid % nig) % gsz); u.pn = (wgid % nig) / gsz; u.e = 0; return true;
    }
    __device__ __forceinline__ void a_ready(const Unit&) const {}
    __device__ __forceinline__ void done(const Unit&) const {}
};

__device__ __forceinline__ unsigned cvt_pk_bf16(float lo, float hi) { unsigned r; asm volatile("v_cvt_pk_bf16_f32 %0, %1, %2" : "=v"(r) : "v"(lo), "v"(hi)); return r; }
typedef float f32x2 __attribute__((ext_vector_type(2)));
typedef unsigned u32x2 __attribute__((ext_vector_type(2)));
__device__ __forceinline__ float sigmoidf_(float x) { return __builtin_amdgcn_rcpf(1.f + __expf(-x)); }

struct MoeOrder {
    int ntiles, nN, RG, G, c; const PG8_LAS int* tstart;
    __device__ __forceinline__ bool next(int i, Unit& u) const {
        const int L = i * G + c, grp = L >> 5, idx = L & 31; u.pn = idx / RG; u.pm = grp * RG + idx % RG; u.e = 0;
        if (u.pm >= ntiles) return false;
        int e = 0;
#pragma unroll
        for (int k = 16; k >= 1; k >>= 1) { if (tstart[e + k] <= u.pm) e += k; }
        u.e = __builtin_amdgcn_readfirstlane(e); return true;
    }
    __device__ __forceinline__ void a_ready(const Unit&) const {}
    __device__ __forceinline__ void done(const Unit&) const {}
};

#define PG8_PACK8(v0, v1) (u32x4){cvt_pk_bf16((v0)[0], (v0)[1]), cvt_pk_bf16((v0)[2], (v0)[3]), cvt_pk_bf16((v1)[0], (v1)[1]), cvt_pk_bf16((v1)[2], (v1)[3])}

struct EpiPlain {
    static constexpr bool PERM = true, AFTER_DRAIN = false;
    bf16_t* O; int ldc;
    __device__ __forceinline__ void operator()(const f32x4 (&acc)[2][2][4][2], const Unit& u, int wr, int wc, int fr, int fq) const {
        const int row0 = u.pm * BM + wr * 64 + fr, col0 = u.pn * BM + wc * 32 + 8 * fq;
#pragma unroll
        for (int ai = 0; ai < 2; ++ai)
#pragma unroll
            for (int m = 0; m < 4; ++m) { bf16_t* rowp = O + (size_t)(row0 + ai * HALF + m * 16) * ldc + col0;
#pragma unroll
                for (int bj = 0; bj < 2; ++bj) { const f32x4 v0 = acc[ai][bj][m][0], v1 = acc[ai][bj][m][1]; *(u32x4*)(rowp + bj * HALF) = PG8_PACK8(v0, v1); } }
    }
};

struct EpiProj {
    static constexpr bool PERM = true, AFTER_DRAIN = false;
    bf16_t *Q, *K, *V, *RW; const float* rope; float qscale;
    __device__ __forceinline__ void operator()(const f32x4 (&acc)[2][2][4][2], const Unit& u, int wr, int wc, int fr, int fq) const {
        const int row0 = u.pm * BM + wr * 64 + fr, cl = wc * 32 + 8 * fq, pn = u.pn;
        if (pn < 4) {
            bf16_t* base = (pn < 2) ? Q : K; const int colt = (pn & 1) * 256; const float sc = (pn < 2) ? qscale : 1.f;
            const bool rp = ((wc & 1) == 0) && (fq < 2);
#pragma unroll
            for (int ai = 0; ai < 2; ++ai)
#pragma unroll
                for (int m = 0; m < 4; ++m) { const int row = row0 + ai * HALF + m * 16;
                    f32x4 cs = (f32x4){1.f, 1.f, 1.f, 1.f}, sn = (f32x4){0.f, 0.f, 0.f, 0.f};
                    if (rp) { cs = *(const f32x4*)(rope + (size_t)row * 16 + 4 * fq); sn = *(const f32x4*)(rope + (size_t)row * 16 + 8 + 4 * fq); }
#pragma unroll
                    for (int bj = 0; bj < 2; ++bj) { f32x4 v0 = acc[ai][bj][m][0], v1 = acc[ai][bj][m][1];
                        { const float a0 = v0[0], b0 = v0[1], a1 = v0[2], b1 = v0[3], a2 = v1[0], b2 = v1[1], a3 = v1[2], b3 = v1[3];
                          v0[0] = a0 * cs[0] - b0 * sn[0]; v0[1] = b0 * cs[0] + a0 * sn[0]; v0[2] = a1 * cs[1] - b1 * sn[1]; v0[3] = b1 * cs[1] + a1 * sn[1];
                          v1[0] = a2 * cs[2] - b2 * sn[2]; v1[1] = b2 * cs[2] + a2 * sn[2]; v1[2] = a3 * cs[3] - b3 * sn[3]; v1[3] = b3 * cs[3] + a3 * sn[3]; }
                        v0 = v0 * sc; v1 = v1 * sc;
                        *(u32x4*)(base + (size_t)row * 512 + colt + bj * HALF + cl) = PG8_PACK8(v0, v1); } }
        } else {
            bf16_t* base; int ld, colt;
            if (pn < 6) { base = V; ld = 512; colt = (pn - 4) * 256; } else { base = RW; ld = 1792; colt = (pn - 6) * 256; }
#pragma unroll
            for (int ai = 0; ai < 2; ++ai)
#pragma unroll
                for (int m = 0; m < 4; ++m) { bf16_t* rowp = base + (size_t)(row0 + ai * HALF + m * 16) * ld + colt + cl;
#pragma unroll
                    for (int bj = 0; bj < 2; ++bj) { const f32x4 v0 = acc[ai][bj][m][0], v1 = acc[ai][bj][m][1]; *(u32x4*)(rowp + bj * HALF) = PG8_PACK8(v0, v1); } }
        }
    }
};

struct EpiLora {
    static constexpr bool PERM = true, AFTER_DRAIN = false;
    bf16_t* LW; size_t kstride; const float *w0, *a0;
    __device__ __forceinline__ void operator()(const f32x4 (&acc)[2][2][4][2], const Unit& u, int wr, int wc, int fr, int fq) const {
        const int row0 = u.pm * BM + wr * 64 + fr, kind = u.pn >> 1, col0 = (u.pn & 1) * 256 + wc * 32 + 8 * fq;
        bf16_t* dst = LW + (size_t)kind * kstride; const float* bias = (kind == 1) ? a0 : w0;
        f32x4 bv[2][2];
#pragma unroll
        for (int bj = 0; bj < 2; ++bj)
#pragma unroll
            for (int n = 0; n < 2; ++n) bv[bj][n] = (kind < 2) ? *(const f32x4*)(bias + col0 + bj * HALF + 4 * n) : (f32x4){0.f, 0.f, 0.f, 0.f};
#pragma unroll
        for (int ai = 0; ai < 2; ++ai)
#pragma unroll
            for (int m = 0; m < 4; ++m) { bf16_t* rowp = dst + (size_t)(row0 + ai * HALF + m * 16) * 512 + col0;
#pragma unroll
                for (int bj = 0; bj < 2; ++bj) { f32x4 vv[2];
#pragma unroll
                    for (int n = 0; n < 2; ++n) { f32x4 v = acc[ai][bj][m][n] + bv[bj][n];
                        if (kind == 0) {
#pragma unroll
                            for (int q = 0; q < 4; ++q) { const float z = -v[q]; const float sp = fmaxf(z, 0.f) + __logf(1.f + __expf(-fabsf(z))); v[q] = -__expf(-sp - 0.5f); }
                        } else if (kind == 1) {
#pragma unroll
                            for (int q = 0; q < 4; ++q) v[q] = sigmoidf_(v[q]);
                        }
                        vv[n] = v; }
                    *(u32x4*)(rowp + bj * HALF) = PG8_PACK8(vv[0], vv[1]); } }
    }
};

__device__ __forceinline__ unsigned pk4_fp8(float a, float b, float c_, float d) { int r = __builtin_amdgcn_cvt_pk_fp8_f32(a, b, 0, false); r = __builtin_amdgcn_cvt_pk_fp8_f32(c_, d, r, true); return (unsigned)r; }
constexpr float W8_SCALE = 32.f, W8_INV = 1.f / 32.f;
struct EpiSwiglu {
    static constexpr bool PERM = true, AFTER_DRAIN = false;
    unsigned char* ACT; const float* b1;
    __device__ __forceinline__ void operator()(const f32x4 (&acc)[2][2][4][2], const Unit& u, int wr, int wc, int fr, int fq) const {
        const int row0 = u.pm * BM + wr * 64 + fr, col0 = u.pn * BM + wc * 32 + 8 * fq;
        f32x4 bv[2][2];
#pragma unroll
        for (int bj = 0; bj < 2; ++bj)
#pragma unroll
            for (int n = 0; n < 2; ++n) bv[bj][n] = *(const f32x4*)(b1 + (size_t)u.e * 2048 + col0 + bj * HALF + 4 * n);
#pragma unroll
        for (int ai = 0; ai < 2; ++ai)
#pragma unroll
            for (int m = 0; m < 4; ++m) { unsigned char* rowp = ACT + (size_t)(row0 + ai * HALF + m * 16) * 1024 + (col0 >> 1);
#pragma unroll
                for (int bj = 0; bj < 2; ++bj) { const f32x4 v0 = acc[ai][bj][m][0] * W8_INV + bv[bj][0], v1 = acc[ai][bj][m][1] * W8_INV + bv[bj][1];
                    float o[4];
#pragma unroll
                    for (int q = 0; q < 4; ++q) { const float glu = (q < 2) ? v0[2 * q] : v1[2 * q - 4], lin = (q < 2) ? v0[2 * q + 1] : v1[2 * q - 3];
                        const float gg = fminf(glu, 7.f), ll = fminf(fmaxf(lin, -7.f), 7.f); o[q] = gg * sigmoidf_(1.702f * gg) * (ll + 1.f); }
                    *(unsigned*)(rowp + bj * (HALF / 2)) = pk4_fp8(o[0], o[1], o[2], o[3]); } }
    }
};

struct EpiMoe2 {
    static constexpr bool PERM = true, AFTER_DRAIN = false;
    bf16_t* Y2; const float* b2; const float* gate;
    __device__ __forceinline__ void operator()(const f32x4 (&acc)[2][2][4][2], const Unit& u, int wr, int wc, int fr, int fq) const {
        const int row0 = u.pm * BM + wr * 64 + fr, col0 = u.pn * BM + wc * 32 + 8 * fq;
        f32x4 bv[2][2];
#pragma unroll
        for (int bj = 0; bj < 2; ++bj)
#pragma unroll
            for (int n = 0; n < 2; ++n) bv[bj][n] = *(const f32x4*)(b2 + (size_t)u.e * 1024 + col0 + bj * HALF + 4 * n);
#pragma unroll
        for (int ai = 0; ai < 2; ++ai)
#pragma unroll
            for (int m = 0; m < 4; ++m) { const int row = row0 + ai * HALF + m * 16; const float gt = gate[row]; bf16_t* rowp = Y2 + (size_t)row * 1024 + col0;
#pragma unroll
                for (int bj = 0; bj < 2; ++bj) { const f32x4 v0 = (acc[ai][bj][m][0] * W8_INV + bv[bj][0]) * gt, v1 = (acc[ai][bj][m][1] * W8_INV + bv[bj][1]) * gt;
                    *(u32x4*)(rowp + bj * HALF) = PG8_PACK8(v0, v1); } }
    }
};

template <class Epi, class Sched, bool ALIGN_EPI = false, bool SP2 = false, bool GATHER = false, bool FP8 = false>
__device__ __forceinline__ void gemm_phase(PG8_LAS unsigned char* lds, const Gemm g, const Sched& S, const Epi& E, const int wid) {
    const int lane = lane_id_v(), tid = wid * 64 + lane, wr = wid >> 2, wc = wid & 3, fr = lane & 15, fq = lane >> 4;
    const int K = g.K, nt = K / BK;
    const __amdgpu_buffer_rsrc_t rsrc = __builtin_amdgcn_make_buffer_rsrc((void*)g.base, 0, 0x7fffffff, 0x00020000);
    unsigned voffA[2], voffB[2];
#pragma unroll
    for (int i = 0; i < 2; ++i) { int R, C; stage_rc(tid * 16 + i * 8192, R, C); const int Rb = Epi::PERM ? ((R & ~31) + perm32(R & 31)) : R;
        voffA[i] = (unsigned)(R * K + C) * 2u; voffB[i] = (unsigned)(Rb * K + C) * 2u; }
    const size_t kstep = (size_t)(BK * 2);
    const size_t hstep = (size_t)HALF * K * 2;
    const size_t tstep = 2 * hstep;
    const unsigned ldsw = (unsigned)wid * 1024u;
    const int aoff = FP8 ? lds_byte(wr * 64 + fr, fq * 16) : lds_byte(wr * 64 + fr, fq * 8), boff = FP8 ? lds_byte(wc * 32 + fr, fq * 16) : lds_byte(wc * 32 + fr, fq * 8);
#define PG8_SA(b, h) (((b) * 2 + (h)) * HTB)
#define PG8_SB(b, h) ((4 + (b) * 2 + (h)) * HTB)
#define PG8_STAGE(bufoff, gbase, voff) do { const unsigned so_ = (unsigned)((const char*)(gbase) - (const char*)g.base); _Pragma("unroll") for (int _i = 0; _i < 2; ++_i) \
        __builtin_amdgcn_raw_ptr_buffer_load_lds(rsrc, (PG8_LAS unsigned*)(lds + (bufoff) + ldsw + _i * 8192), 16, (voff)[_i], so_, 0, 0); } while (0)
#define PG8_STAGE_A(bufoff, ptr, h, nx) do { if constexpr (GATHER) { unsigned vo_[2]; vo_[0] = (nx) ? gn[h][0] : gc[h][0]; vo_[1] = (nx) ? gn[h][1] : gc[h][1]; PG8_STAGE(bufoff, ptr, vo_); } \
        else { PG8_STAGE(bufoff, (ptr) + (h) * hstep, voffA); } } while (0)
#define PG8_LDA(dst, b, h) do { _Pragma("unroll") for (int m = 0; m < 4; ++m) _Pragma("unroll") for (int k = 0; k < 2; ++k) dst[m].pc[k] = *(const PG8_LAS bf16x8*)(lds + PG8_SA(b, h) + aoff + m * 2048 + k * (FP8 ? 16 : 1024)); } while (0)
#define PG8_LDB(dst, b, h) do { _Pragma("unroll") for (int n = 0; n < 2; ++n) _Pragma("unroll") for (int k = 0; k < 2; ++k) dst[n].pc[k] = *(const PG8_LAS bf16x8*)(lds + PG8_SB(b, h) + boff + n * 2048 + k * (FP8 ? 16 : 1024)); } while (0)
#define PG8_MMA(ai, bj, At, Bt) do { __builtin_amdgcn_s_setprio(1); _Pragma("unroll") for (int m = 0; m < 4; ++m) _Pragma("unroll") for (int n = 0; n < 2; ++n) { \
        if constexpr (FP8) { acc[ai][bj][m][n] = __builtin_amdgcn_mfma_scale_f32_16x16x128_f8f6f4(Bt[n].w, At[m].w, acc[ai][bj][m][n], 0, 0, 0, 0, 0, 0); } \
        else { _Pragma("unroll") for (int k = 0; k < 2; ++k) acc[ai][bj][m][n] = __builtin_amdgcn_mfma_f32_16x16x32_bf16(Bt[n].pc[k], At[m].pc[k], acc[ai][bj][m][n], 0, 0, 0); } } \
        __builtin_amdgcn_s_setprio(0); } while (0)
#define PG8_WAIT_V(n) asm volatile("s_waitcnt vmcnt(" #n ")" ::: "memory")
#define PG8_WAIT_L(n) asm volatile("s_waitcnt lgkmcnt(" #n ")" ::: "memory")
#define PG8_BAR __builtin_amdgcn_s_barrier()
#define PG8_SCHED __builtin_amdgcn_sched_barrier(0)
    Unit cur, nxt; int ui = 0;
    if (!S.next(0, cur)) return;
    f32x4 acc[2][2][4][2];
#pragma unroll
    for (int a = 0; a < 2; ++a)
#pragma unroll
        for (int b = 0; b < 2; ++b)
#pragma unroll
            for (int m = 0; m < 4; ++m)
#pragma unroll
                for (int n = 0; n < 2; ++n) acc[a][b][m][n] = (f32x4){0.f, 0.f, 0.f, 0.f};
    frag2_t At[4], B0[2], B1[2];
    const char* cA = GATHER ? (const char*)g.A : (const char*)g.A + (size_t)cur.pm * tstep; const char* cB = (const char*)g.Bt + (size_t)cur.e * g.bstride + (size_t)cur.pn * tstep;
    unsigned gc[2][2] = {{0u, 0u}, {0u, 0u}}, gn[2][2] = {{0u, 0u}, {0u, 0u}}; Unit nx2; bool has_nx2 = false;
#define PG8_GOFF(dst, pm_, ok_, alt_) do { const int t_ = lane_id_v() + wid * 64; _Pragma("unroll") for (int i_ = 0; i_ < 2; ++i_) { int R_, C_; stage_rc(t_ * 16 + i_ * 8192, R_, C_); \
        _Pragma("unroll") for (int h_ = 0; h_ < 2; ++h_) dst[h_][i_] = (ok_) ? (unsigned)g.rowidx[(pm_) * BM + h_ * HALF + R_] * (unsigned)(K * 2) + (unsigned)C_ * 2u : alt_[h_][i_]; } } while (0)
    if constexpr (GATHER) {
        PG8_GOFF(gc, cur.pm, true, gc);
        const bool hn = S.next(1, nxt);
        PG8_GOFF(gn, nxt.pm, hn, gc);
    }
    S.a_ready(cur);
    if constexpr (SP2) {
        PG8_STAGE(PG8_SB(0, 0), cB, voffB); PG8_STAGE(PG8_SB(0, 1), cB + hstep, voffB); PG8_STAGE_A(PG8_SA(0, 0), cA, 0, false); PG8_STAGE_A(PG8_SA(0, 1), cA, 1, false);
        if (wr == 1) PG8_BAR;
        PG8_WAIT_V(2); PG8_BAR;
        PG8_STAGE(PG8_SB(1, 0), cB + kstep, voffB); PG8_STAGE_A(PG8_SA(1, 0), cA + kstep, 0, false); PG8_STAGE(PG8_SB(1, 1), cB + hstep + kstep, voffB);
        PG8_WAIT_V(6); PG8_BAR;
    } else {
        PG8_STAGE(PG8_SB(0, 0), cB, voffB); PG8_STAGE_A(PG8_SA(0, 0), cA, 0, false); PG8_STAGE(PG8_SB(0, 1), cB + hstep, voffB); PG8_STAGE_A(PG8_SA(0, 1), cA, 1, false);
        if (wr == 1) PG8_BAR;
        PG8_WAIT_V(4); PG8_BAR;
        PG8_STAGE(PG8_SB(1, 0), cB + kstep, voffB); PG8_STAGE_A(PG8_SA(1, 0), cA + kstep, 0, false); PG8_STAGE(PG8_SB(1, 1), cB + hstep + kstep, voffB);
        PG8_WAIT_V(6); PG8_BAR;
    }
    for (;;) {
        const bool has_next = S.next(ui + 1, nxt);
        const char* nA = GATHER ? (const char*)g.A : (has_next ? (const char*)g.A + (size_t)nxt.pm * tstep : cA); const char* nB = has_next ? (const char*)g.Bt + (size_t)nxt.e * g.bstride + (size_t)nxt.pn * tstep : cB;
        for (int t = 0; t < nt; t += 2) {
            const bool last = (t == nt - 2);
            asm volatile("" : "+v"(voffA[0]), "+v"(voffA[1]), "+v"(voffB[0]), "+v"(voffB[1]));
            if constexpr (GATHER) asm volatile("" : "+v"(gc[0][0]), "+v"(gc[0][1]), "+v"(gc[1][0]), "+v"(gc[1][1]), "+v"(gn[0][0]), "+v"(gn[0][1]), "+v"(gn[1][0]), "+v"(gn[1][1]));
            const char* a1 = cA + (size_t)(t + 1) * kstep;
            const char* a2 = last ? nA : cA + (size_t)(t + 2) * kstep; const char* b2 = last ? nB : cB + (size_t)(t + 2) * kstep;
            const char* a3 = a2 + kstep; const char* b3 = b2 + kstep;
            if (last && has_next) S.a_ready(nxt);
            if constexpr (SP2) {
            PG8_LDB(B0, 0, 0); PG8_LDB(B1, 0, 1); PG8_SCHED; PG8_LDA(At, 0, 0); PG8_STAGE_A(PG8_SA(1, 1), a1, 1, false);
            PG8_WAIT_V(8); PG8_WAIT_L(0); PG8_BAR; PG8_MMA(0, 0, At, B0); PG8_MMA(0, 1, At, B1); PG8_BAR; PG8_SCHED;
            PG8_LDA(At, 0, 1); PG8_STAGE(PG8_SB(0, 0), b2, voffB); PG8_STAGE(PG8_SB(0, 1), b2 + hstep, voffB); PG8_STAGE_A(PG8_SA(0, 0), a2, 0, last);
            PG8_WAIT_V(8); PG8_WAIT_L(0); PG8_BAR; PG8_MMA(1, 0, At, B0); PG8_MMA(1, 1, At, B1); PG8_BAR; PG8_SCHED;
            PG8_LDB(B0, 1, 0); PG8_LDB(B1, 1, 1); PG8_SCHED; PG8_LDA(At, 1, 0); PG8_STAGE_A(PG8_SA(0, 1), a2, 1, last);
            PG8_WAIT_V(8); PG8_WAIT_L(0); PG8_BAR; PG8_MMA(0, 0, At, B0); PG8_MMA(0, 1, At, B1); PG8_BAR; PG8_SCHED;
            PG8_LDA(At, 1, 1); PG8_STAGE(PG8_SB(1, 0), b3, voffB); PG8_STAGE(PG8_SB(1, 1), b3 + hstep, voffB); PG8_STAGE_A(PG8_SA(1, 0), a3, 0, last);
            PG8_WAIT_V(8); PG8_WAIT_L(0); PG8_BAR; PG8_MMA(1, 0, At, B0); PG8_MMA(1, 1, At, B1); PG8_BAR; PG8_SCHED;
            } else {
            PG8_LDB(B0, 0, 0); PG8_SCHED; PG8_LDA(At, 0, 0); PG8_STAGE_A(PG8_SA(1, 1), a1, 1, false);
            PG8_WAIT_L(8); PG8_BAR; PG8_WAIT_L(0); PG8_MMA(0, 0, At, B0); PG8_BAR; PG8_SCHED;
            PG8_LDB(B1, 0, 1); PG8_STAGE(PG8_SB(0, 0), b2, voffB);
            PG8_BAR; PG8_WAIT_L(0); PG8_MMA(0, 1, At, B1); PG8_BAR;
            PG8_LDA(At, 0, 1); PG8_STAGE_A(PG8_SA(0, 0), a2, 0, last);
            PG8_BAR; PG8_WAIT_L(0); PG8_MMA(1, 0, At, B0); PG8_BAR; PG8_SCHED;
            PG8_STAGE(PG8_SB(0, 1), b2 + hstep, voffB);
            PG8_WAIT_V(6); PG8_BAR; PG8_MMA(1, 1, At, B1); PG8_BAR;
            PG8_LDB(B0, 1, 0); PG8_SCHED; PG8_LDA(At, 1, 0); PG8_STAGE_A(PG8_SA(0, 1), a2, 1, last);
            PG8_WAIT_L(8); PG8_BAR; PG8_WAIT_L(0); PG8_MMA(0, 0, At, B0); PG8_BAR; PG8_SCHED;
            PG8_LDB(B1, 1, 1); PG8_STAGE(PG8_SB(1, 0), b3, voffB);
            PG8_BAR; PG8_WAIT_L(0); PG8_MMA(0, 1, At, B1); PG8_BAR;
            PG8_LDA(At, 1, 1); PG8_STAGE_A(PG8_SA(1, 0), a3, 0, last);
            PG8_BAR; PG8_WAIT_L(0); PG8_MMA(1, 0, At, B0); PG8_BAR; PG8_SCHED;
            PG8_STAGE(PG8_SB(1, 1), b3 + hstep, voffB);
            PG8_WAIT_V(6); PG8_BAR; PG8_MMA(1, 1, At, B1); PG8_BAR;
            }
        }
        if constexpr (GATHER) { has_nx2 = has_next && S.next(ui + 2, nx2);
            _Pragma("unroll") for (int h = 0; h < 2; ++h) _Pragma("unroll") for (int i = 0; i < 2; ++i) gc[h][i] = gn[h][i];
            PG8_GOFF(gn, nx2.pm, has_nx2, gc); }
        if constexpr (ALIGN_EPI) { if (wr == 0) PG8_BAR; }
        if constexpr (!Epi::AFTER_DRAIN) { const int l_ = lane_id_v(); const int fr_ = l_ & 15, fq_ = l_ >> 4;
            E(acc, cur, wr, wc, fr_, fq_); S.done(cur); }
        if (!has_next) break;
#pragma unroll
        for (int a = 0; a < 2; ++a)
#pragma unroll
            for (int b = 0; b < 2; ++b)
#pragma unroll
                for (int m = 0; m < 4; ++m)
#pragma unroll
                    for (int n = 0; n < 2; ++n) acc[a][b][m][n] = (f32x4){0.f, 0.f, 0.f, 0.f};
        if constexpr (GATHER) { asm volatile("" : "+v"(gn[0][0]), "+v"(gn[0][1]), "+v"(gn[1][0]), "+v"(gn[1][1])); }
        cur = nxt; cA = nA; cB = nB; ++ui;
        if constexpr (ALIGN_EPI) { if (wr == 1) PG8_BAR; }
    }
    PG8_WAIT_V(0);
    if constexpr (!ALIGN_EPI) { if (wr == 0) PG8_BAR; }
    PG8_BAR;
    if constexpr (Epi::AFTER_DRAIN) { E.fused(acc, cur, wr, wc, fr, fq, lds, wid, lane); S.done(cur); }
#undef PG8_SA
#undef PG8_SB
#undef PG8_STAGE
#undef PG8_STAGE_A
#undef PG8_GOFF
#undef PG8_LDA
#undef PG8_LDB
#undef PG8_MMA
#undef PG8_WAIT_V
#undef PG8_WAIT_L
#undef PG8_BAR
#undef PG8_SCHED
}
}
#include <hip/hip_bf16.h>
#include <cmath>
namespace attn_body {
using bf16=__hip_bfloat16;
using bf16x8=__attribute__((ext_vector_type(8)))short;
using s16x4=__attribute__((ext_vector_type(4)))short;
using f32x16=__attribute__((ext_vector_type(16)))float;
using u32x4=__attribute__((ext_vector_type(4)))unsigned;
constexpr int BATCH=8,NHEAD=16,SEQ=4096,D=64;
constexpr int QP=512,KP=512,VP=512,OP=1024;
constexpr int NW=8,QBLK=32,QB=QBLK*NW,KVBLK=64,NQB=SEQ/QB;
constexpr int ATTN_UNIT_ROWS=QB;
__device__ __forceinline__ int crow(int r,int hi){return (r&3)+8*(r>>2)+4*hi;}
#define SBAR() __builtin_amdgcn_sched_barrier(0)
__device__ __forceinline__ void cmask(f32x16&p0,f32x16&p1,int jb,int qrel,int hi){
  const float NEG=-INFINITY; int kb=64*jb+4*hi;
  #pragma unroll
  for(int r=0;r<16;++r){int kv=kb+(r&3)+8*(r>>2); if(kv>qrel)p0[r]=NEG; if(kv+32>qrel)p1[r]=NEG;}
}

constexpr int NSLOT=3, SLOTB=8192;
constexpr int LDS_K=0, LDS_V=NSLOT*SLOTB, LDS_WS=2*NSLOT*SLOTB, LDS_OST=LDS_WS+NW*64*4, LDS_BYTES=LDS_OST+NW*4096;
constexpr float C2=0.125f*1.4426950408889634f;
__device__ __forceinline__ void glds16(const void*gsrc,unsigned lds_dst){unsigned keep;
  asm volatile("s_mov_b32 %0, m0\n\ts_mov_b32 m0, %2\n\ts_nop 0\n\tglobal_load_lds_dwordx4 %1, off\n\ts_mov_b32 m0, %0":"=&s"(keep):"v"(gsrc),"s"(lds_dst):"memory");}
__device__ __forceinline__ float max3f(float a,float b,float c){float r;asm("v_max3_f32 %0, %1, %2, %3":"=v"(r):"v"(a),"v"(b),"v"(c));return r;}
__device__ __forceinline__ float max2f(float a,float b){float r;asm("v_max_f32_e32 %0, %1, %2":"=v"(r):"v"(a),"v"(b));return r;}
__device__ __forceinline__ float fadd_s(float a,float b){float r;asm("v_add_f32_e32 %0, %1, %2":"=v"(r):"v"(a),"v"(b));return r;}
__device__ __forceinline__ float fsub_s(float a,float b){float r;asm("v_sub_f32_e32 %0, %1, %2":"=v"(r):"v"(a),"v"(b));return r;}
typedef float f32x2_t __attribute__((ext_vector_type(2))); typedef __bf16 bf16x2_t __attribute__((ext_vector_type(2)));
__device__ __forceinline__ unsigned cvtpk_s(float lo,float hi){f32x2_t v={lo,hi};bf16x2_t b=__builtin_convertvector(v,bf16x2_t);return __builtin_bit_cast(unsigned,b);}
#define WAIT_BAR(N) asm volatile("s_waitcnt vmcnt(" #N ") lgkmcnt(0)\n\ts_barrier":::"memory")

__device__ __forceinline__ void qkt(f32x16&p0,f32x16&p1,const char*Kslot,const bf16x8*qr,const f32x16&negm,int r32,int hi){
  const char*kb=Kslot+hi*1024+r32*16;
  #pragma unroll
  for(int d0=0;d0<4;++d0){
    const bf16x8 b0=*reinterpret_cast<const bf16x8*>(kb+d0*2048);
    const bf16x8 b1=*reinterpret_cast<const bf16x8*>(kb+d0*2048+512);
    if(d0==0){p0=__builtin_amdgcn_mfma_f32_32x32x16_bf16(b0,qr[0],negm,0,0,0);p1=__builtin_amdgcn_mfma_f32_32x32x16_bf16(b1,qr[0],negm,0,0,0);}
    else{p0=__builtin_amdgcn_mfma_f32_32x32x16_bf16(b0,qr[d0],p0,0,0,0);p1=__builtin_amdgcn_mfma_f32_32x32x16_bf16(b1,qr[d0],p1,0,0,0);}}
}
typedef __attribute__((address_space(3))) const char* lds_cptr;
typedef short v4i16_t __attribute__((ext_vector_type(4)));
__device__ __forceinline__ void kload8(bf16x8*kf,lds_cptr kp){
  kf[0]=*(const __attribute__((address_space(3))) bf16x8*)(kp);      kf[1]=*(const __attribute__((address_space(3))) bf16x8*)(kp+512);
  kf[2]=*(const __attribute__((address_space(3))) bf16x8*)(kp+2048); kf[3]=*(const __attribute__((address_space(3))) bf16x8*)(kp+2560);
  kf[4]=*(const __attribute__((address_space(3))) bf16x8*)(kp+4096); kf[5]=*(const __attribute__((address_space(3))) bf16x8*)(kp+4608);
  kf[6]=*(const __attribute__((address_space(3))) bf16x8*)(kp+6144); kf[7]=*(const __attribute__((address_space(3))) bf16x8*)(kp+6656);
}
__device__ __forceinline__ void kload2(bf16x8*kf,lds_cptr kp,int j){ kf[2*j]=*(const __attribute__((address_space(3))) bf16x8*)(kp+j*2048); kf[2*j+1]=*(const __attribute__((address_space(3))) bf16x8*)(kp+j*2048+512); }
__device__ __forceinline__ s16x4 vtr(lds_cptr p){ return __builtin_bit_cast(s16x4,__builtin_amdgcn_ds_read_tr16_b64_v4i16((__attribute__((address_space(3))) v4i16_t*)p)); }
__device__ __forceinline__ float rowmax(const f32x16&p0,const f32x16&p1){
  float a=max3f(p0[0],p0[1],p1[0]),b=max3f(p0[2],p0[3],p1[1]);a=max3f(a,p1[2],p1[3]);
  #pragma unroll
  for(int r=4;r<16;r+=4){a=max3f(a,p0[r],p0[r+1]);b=max3f(b,p0[r+2],p0[r+3]);a=max3f(a,p1[r],p1[r+1]);b=max3f(b,p1[r+2],p1[r+3]);}
  const float m=max2f(a,b);
  auto rr=__builtin_amdgcn_permlane32_swap(__float_as_uint(m),__float_as_uint(m),false,false);
  return max2f(__uint_as_float(rr[0]),__uint_as_float(rr[1]));
}
__device__ __forceinline__ void pv(f32x16*o,int vb,bf16x8 pa0,bf16x8 pa1,bf16x8 pa2,bf16x8 pa3){
  #pragma unroll
  for(int d0=0;d0<2;++d0){s16x4 lo[4],hi[4];
    #pragma unroll
    for(int ks=0;ks<4;++ks){
      asm volatile("ds_read_b64_tr_b16 %0,%1 offset:%c2":"=&v"(lo[ks]):"v"(vb),"i"(d0*4096+ks*1024):"memory");
      asm volatile("ds_read_b64_tr_b16 %0,%1 offset:%c2":"=&v"(hi[ks]):"v"(vb),"i"(d0*4096+ks*1024+512):"memory");}
    asm volatile("s_waitcnt lgkmcnt(0)":::"memory");SBAR();
    #define PK(k) (bf16x8){lo[k][0],lo[k][1],lo[k][2],lo[k][3],hi[k][0],hi[k][1],hi[k][2],hi[k][3]}
    o[d0]=__builtin_amdgcn_mfma_f32_32x32x16_bf16(pa0,PK(0),o[d0],0,0,0);
    o[d0]=__builtin_amdgcn_mfma_f32_32x32x16_bf16(pa1,PK(1),o[d0],0,0,0);
    o[d0]=__builtin_amdgcn_mfma_f32_32x32x16_bf16(pa2,PK(2),o[d0],0,0,0);
    o[d0]=__builtin_amdgcn_mfma_f32_32x32x16_bf16(pa3,PK(3),o[d0],0,0,0);
    #undef PK
  }
}

#ifndef ATTN_STORE16
#define ATTN_STORE16(p,v) (*(u32x4*)(p)=(v))
#endif
template<int THRL> __device__ __forceinline__ void attn_unit(int b,int h,int qb,const bf16*Q,const bf16*__restrict__ K,const bf16*__restrict__ V,bf16*O,char*shm,const int wid){
  const int qcol=(h>>1)*64, kcol=(h>>1)*64, vcol=(h>>2)*128+(h&1)*64, ocol=h*64;
  const int lane=lane_id_v(),r32=lane&31,hi=lane>>5;
  const long rowbase=(long)b*SEQ; const int q0=qb*QB;
  const bf16*Qw=Q+(rowbase+q0+wid*QBLK)*QP+qcol;
  const bf16*Kh=K+rowbase*KP+kcol,*Vh=V+rowbase*VP+vcol;
  const unsigned lds0=(unsigned)(uintptr_t)shm;
  float*wsf=(float*)(shm+LDS_WS)+wid*64;
  const bf16*ksrc=Kh+(long)lane*KP+wid*8;
  const bf16*vsrc=Vh+(long)(16*(wid&3)+(lane>>2))*VP+(wid>>2)*32+(lane&3)*8;
  const unsigned kdst=lds0+LDS_K+wid*1024, vdst=lds0+LDS_V+wid*1024;
  #define DMA_K(t,slot) glds16(ksrc+(long)(t)*KVBLK*KP,(unsigned)__builtin_amdgcn_readfirstlane(kdst+(slot)))
  #define DMA_V(t,slot) glds16(vsrc+(long)(t)*KVBLK*VP,(unsigned)__builtin_amdgcn_readfirstlane(vdst+(slot)))
  const int vb0=(int)(lds0+LDS_V)+((lane>>4)&1)*32+(lane&3)*8+(4*hi+((lane&15)>>2))*64;
  const char*Kbase=shm+LDS_K; bf16x8 kf[8];
  const lds_cptr shm3=(lds_cptr)shm; const lds_cptr kp0=shm3+LDS_K+hi*1024+r32*16; const lds_cptr vp0=shm3+LDS_V+((lane>>4)&1)*32+(lane&3)*8+(4*hi+((lane&15)>>2))*64;
  const int NT=(q0+QB)/KVBLK;
  DMA_K(0,0);DMA_V(0,0);DMA_K(1,SLOTB);
  bf16x8 qr[4];
  #pragma unroll
  for(int d0=0;d0<4;++d0)qr[d0]=*reinterpret_cast<const bf16x8*>(&Qw[(long)r32*QP+d0*16+hi*8]);
  float mhat=0.f,l_reg=0.f;f32x16 o[2];o[0]=f32x16{};o[1]=f32x16{};f32x16 negm=f32x16{};asm volatile("":"+v"(negm));
  const int qrel=wid*QBLK+r32;
  #define CMASK(P0,P1,t) do{int jb_=(t)-(NT-4); if(jb_>=0)cmask(P0,P1,jb_,qrel,hi);}while(0)
  bool resc=false;
  #define START(P0,P1) do{ const float rm=rowmax(P0,P1); resc=false; \
    { const float dl=rm; mhat=fadd_s(mhat,dl); \
      _Pragma("unroll") for(int r=0;r<16;++r){P0[r]=fsub_s(P0[r],dl);P1[r]=fsub_s(P1[r],dl);} \
      _Pragma("unroll") for(int r=0;r<16;++r)negm[r]=-mhat; asm volatile("":"+v"(negm)); } \
    _Pragma("unroll") for(int r=0;r<16;++r)P0[r]=__builtin_amdgcn_exp2f(P0[r]); }while(0)
  #define RESC() do{ if(resc){ asm volatile("s_waitcnt lgkmcnt(0)":::"memory"); \
      _Pragma("unroll") for(int d_=0;d_<2;++d_) _Pragma("unroll") for(int r=0;r<16;++r)o[d_][r]*=wsf[crow(r,hi)]; } }while(0)
  f32x16 pA0,pA1,pB0,pB1;
  int sl_prev=0,sl_cur=0,sl_next=SLOTB;
  #define ROT() do{sl_prev=sl_cur;sl_cur=sl_next;sl_next=(sl_next==(NSLOT-1)*SLOTB)?0:sl_next+SLOTB;}while(0)
  DMA_K(2,2*SLOTB);
  WAIT_BAR(3);
  qkt(pA0,pA1,Kbase,qr,negm,r32,hi);asm volatile("s_nop 15\n\ts_nop 7":"+v"(pA0),"+v"(pA1));CMASK(pA0,pA1,0);
  START(pA0,pA1);
  _Pragma("unroll") for(int r=0;r<16;++r)pA1[r]=__builtin_amdgcn_exp2f(pA1[r]);
  WAIT_BAR(0);
  DMA_K(3,0);DMA_V(1,SLOTB);
  ROT();
  kload8(kf,kp0+sl_cur);
  WAIT_BAR(2);
  s16x4 vlo[8],vhi[8]; u32x4 pw0,pw1,pw2,pw3;
  #define PKW(P,B) cvtpk_s(P[B],P[B+1])
  #define PAF(k) __builtin_bit_cast(bf16x8,pw##k)
  #define VFR(i) (bf16x8){vlo[i][0],vlo[i][1],vlo[i][2],vlo[i][3],vhi[i][0],vhi[i][1],vhi[i][2],vhi[i][3]}
  #define PIN(x) asm volatile("":"+v"(x))
  #define MX3(a,b,c) __builtin_fmaxf(__builtin_fmaxf((a),(b)),(c))
  #define GAPA(MF,A0,A1,A2,A3,W0,W1,PW) do{ MF; sacc+=A0; sacc+=A1; sacc+=A2; sacc+=A3; PIN(sacc); W0; W1; PIN(PW); SBAR(); }while(0)
  #define EX(v) __builtin_amdgcn_exp2f(v)
  #define GAPB(MF,X,B) do{ MF; X[B]=EX(X[B]); X[B+1]=EX(X[B+1]); X[B+2]=EX(X[B+2]); X[B+3]=EX(X[B+3]); PIN(X); SBAR(); }while(0)
  #define VRD(i) do{ vlo[i]=vtr(vp_+(((i)>>2)*4096+((i)&3)*1024)); vhi[i]=vtr(vp_+(((i)>>2)*4096+((i)&3)*1024+512)); }while(0)
  #define KRD(G,j) do{ if(G){ kload2(kf,kp0+sl_next,j); SBAR(); } }while(0)
  #define STEP(C0,C1,P0,P1,t,GK,GV,GL) do{ SBAR(); \
    const lds_cptr vp_=vp0+sl_prev; \
    VRD(0); SBAR(); float sacc=(P0[0]+P0[1]); \
    GAPA(C0=__builtin_amdgcn_mfma_f32_32x32x16_bf16(kf[0],qr[0],negm,0,0,0), P0[2],P0[3],P0[4],P0[5],     pw0[0]=PKW(P0,0), pw0[1]=PKW(P0,2), pw0); \
    VRD(4); SBAR(); GAPA(C1=__builtin_amdgcn_mfma_f32_32x32x16_bf16(kf[1],qr[0],negm,0,0,0), P0[6],P0[7],P0[8],P0[9],     pw0[2]=PKW(P0,4), pw0[3]=PKW(P0,6), pw0); \
    VRD(1); SBAR(); GAPA(C0=__builtin_amdgcn_mfma_f32_32x32x16_bf16(kf[2],qr[1],C0,0,0,0),   P0[10],P0[11],P0[12],P0[13], pw1[0]=PKW(P0,8), pw1[1]=PKW(P0,10), pw1); \
    VRD(5); SBAR(); GAPA(C1=__builtin_amdgcn_mfma_f32_32x32x16_bf16(kf[3],qr[1],C1,0,0,0),   P0[14],P0[15],P1[0],P1[1],   pw1[2]=PKW(P0,12),pw1[3]=PKW(P0,14), pw1); \
    VRD(2); SBAR(); GAPA(C0=__builtin_amdgcn_mfma_f32_32x32x16_bf16(kf[4],qr[2],C0,0,0,0),   P1[2],P1[3],P1[4],P1[5],     pw2[0]=PKW(P1,0), pw2[1]=PKW(P1,2), pw2); \
    VRD(6); SBAR(); GAPA(C1=__builtin_amdgcn_mfma_f32_32x32x16_bf16(kf[5],qr[2],C1,0,0,0),   P1[6],P1[7],P1[8],P1[9],     pw2[2]=PKW(P1,4), pw2[3]=PKW(P1,6), pw2); \
    VRD(3); SBAR(); GAPA(C0=__builtin_amdgcn_mfma_f32_32x32x16_bf16(kf[6],qr[3],C0,0,0,0),   P1[10],P1[11],P1[12],P1[13], pw3[0]=PKW(P1,8), pw3[1]=PKW(P1,10), pw3); \
    VRD(7); SBAR(); GAPA(C1=__builtin_amdgcn_mfma_f32_32x32x16_bf16(kf[7],qr[3],C1,0,0,0),   P1[14],P1[15],0.f,0.f,       pw3[2]=PKW(P1,12),pw3[3]=PKW(P1,14), pw3); \
    l_reg+=sacc; \
    if(GK){DMA_K((t)+3,sl_cur);} if(GV){DMA_V((t)+1,sl_next);} \
    CMASK(C0,C1,t); \
    { float a=MX3(C0[0],C0[1],C1[0]),b=MX3(C0[2],C0[3],C1[1]); a=MX3(a,C1[2],C1[3]); \
      _Pragma("unroll") for(int r=4;r<16;r+=4){a=MX3(a,C0[r],C0[r+1]);b=MX3(b,C0[r+2],C0[r+3]);a=MX3(a,C1[r],C1[r+1]);b=MX3(b,C1[r+2],C1[r+3]);} \
      float rm=__builtin_fmaxf(a,b); { auto rr=__builtin_amdgcn_permlane32_swap(__float_as_uint(rm),__float_as_uint(rm),false,false); rm=__builtin_fmaxf(__uint_as_float(rr[0]),__uint_as_float(rr[1])); } \
      resc=false; \
      if(__builtin_expect(__any(rm>(float)THRL),0)){ const float dl=__builtin_fmaxf(rm,0.f); mhat+=dl; \
        _Pragma("unroll") for(int r=0;r<16;++r){C0[r]-=dl;C1[r]-=dl;} \
        _Pragma("unroll") for(int r=0;r<16;++r)negm[r]=-mhat; asm volatile("":"+v"(negm)); \
        const float f=__builtin_amdgcn_exp2f(-dl); l_reg*=f; if(hi==0)wsf[r32]=f; resc=true; } } \
    SBAR(); \
    GAPB(o[0]=__builtin_amdgcn_mfma_f32_32x32x16_bf16(PAF(0),VFR(0),o[0],0,0,0), C0,0); \
    GAPB(o[1]=__builtin_amdgcn_mfma_f32_32x32x16_bf16(PAF(0),VFR(4),o[1],0,0,0), C0,4); \
    KRD(GL,0); GAPB(o[0]=__builtin_amdgcn_mfma_f32_32x32x16_bf16(PAF(1),VFR(1),o[0],0,0,0), C0,8); \
    KRD(GL,1); GAPB(o[1]=__builtin_amdgcn_mfma_f32_32x32x16_bf16(PAF(1),VFR(5),o[1],0,0,0), C0,12); \
    KRD(GL,2); GAPB(o[0]=__builtin_amdgcn_mfma_f32_32x32x16_bf16(PAF(2),VFR(2),o[0],0,0,0), C1,0); \
    KRD(GL,3); GAPB(o[1]=__builtin_amdgcn_mfma_f32_32x32x16_bf16(PAF(2),VFR(6),o[1],0,0,0), C1,4); \
    GAPB(o[0]=__builtin_amdgcn_mfma_f32_32x32x16_bf16(PAF(3),VFR(3),o[0],0,0,0), C1,8); \
    GAPB(o[1]=__builtin_amdgcn_mfma_f32_32x32x16_bf16(PAF(3),VFR(7),o[1],0,0,0), C1,12); \
    }while(0)
  int t=1;
  #undef CMASK
  #define CMASK(P0,P1,t) do{}while(0)
  for(;t+5<NT;t+=2){
    STEP(pB0,pB1,pA0,pA1,t,true,true,true);     WAIT_BAR(2); RESC(); ROT();
    STEP(pA0,pA1,pB0,pB1,t+1,true,true,true);   WAIT_BAR(2); RESC(); ROT();
  }
  #undef CMASK
  #define CMASK(P0,P1,t) do{int jb_=(t)-(NT-4); if(jb_>=0)cmask(P0,P1,jb_,qrel,hi);}while(0)
  #define ENDW(tt) do{ if((tt)+3<NT){WAIT_BAR(2);} else if((tt)+2<NT){WAIT_BAR(1);} else {WAIT_BAR(0);} }while(0)
  for(;t+1<NT;t+=2){
    STEP(pB0,pB1,pA0,pA1,t,(t+3<NT),(t+1<NT),(t+1<NT));       ENDW(t);   RESC(); ROT();
    STEP(pA0,pA1,pB0,pB1,t+1,(t+4<NT),(t+2<NT),(t+2<NT));     ENDW(t+1); RESC(); ROT();
  }
  STEP(pB0,pB1,pA0,pA1,NT-1,false,false,false); RESC();
  { float sacc=pB0[0]+pB0[1]; _Pragma("unroll") for(int r=2;r<16;++r)sacc+=pB0[r]; _Pragma("unroll") for(int r=0;r<16;++r)sacc+=pB1[r]; l_reg+=sacc;
    pw0=(u32x4){PKW(pB0,0),PKW(pB0,2),PKW(pB0,4),PKW(pB0,6)};pw1=(u32x4){PKW(pB0,8),PKW(pB0,10),PKW(pB0,12),PKW(pB0,14)};pw2=(u32x4){PKW(pB1,0),PKW(pB1,2),PKW(pB1,4),PKW(pB1,6)};pw3=(u32x4){PKW(pB1,8),PKW(pB1,10),PKW(pB1,12),PKW(pB1,14)};
    SBAR(); pv(o,vb0+sl_cur,PAF(0),PAF(1),PAF(2),PAF(3)); }
  #undef PKW
  #undef PAF
  #undef VFR
  #undef PIN
  #undef MX3
  #undef GAPA
  #undef GAPB
  #undef EX
  #undef VRD
  #undef KRD
  #undef STEP
  #undef ENDW
  {auto rr=__builtin_amdgcn_permlane32_swap(__float_as_uint(l_reg),__float_as_uint(l_reg),false,false);l_reg=__uint_as_float(rr[0])+__uint_as_float(rr[1]);}
  if(hi==0)wsf[32+r32]=l_reg;asm volatile("s_waitcnt lgkmcnt(0)":::"memory");
  float rli[16];
  #pragma unroll
  for(int r=0;r<16;++r)rli[r]=__builtin_amdgcn_rcpf(wsf[32+crow(r,hi)]);
  bf16*Ow=O+(rowbase+q0+wid*QBLK)*OP+ocol;
  { bf16*stg=(bf16*)(shm+LDS_OST)+wid*2048;
    #pragma unroll
    for(int r=0;r<16;++r){const int orow=crow(r,hi);
      #pragma unroll
      for(int d0=0;d0<2;++d0)stg[orow*64+d0*32+r32]=__float2bfloat16(o[d0][r]*rli[r]);}
    asm volatile("s_waitcnt lgkmcnt(0)":::"memory");
    #pragma unroll
    for(int i=0;i<4;++i){const int row=i*8+(lane>>3),ch=lane&7; const u32x4 v=*(const u32x4*)(stg+row*64+ch*8); ATTN_STORE16(Ow+(long)row*OP+ch*8,v);} }
  asm volatile("s_waitcnt lgkmcnt(0)\n\ts_barrier":::"memory");
  #undef DMA_K
  #undef DMA_V
  #undef CMASK
  #undef START
  #undef RESC
  #undef ROT
}
constexpr int ATTN_LDS_BYTES=LDS_BYTES;
struct AttnTensors { const bf16* Q; const bf16* K; const bf16* V; bf16* O; };
struct AttnUnit { int bh; int qb; };
struct QueueOrder {
  unsigned* ctr; volatile __attribute__((address_space(3))) unsigned* slot; int wid;
  __device__ __forceinline__ bool next(int,AttnUnit&u)const{
    if(wid==0&&lane_id_v()==0){ const unsigned n=__hip_atomic_fetch_add(ctr,1u,__ATOMIC_RELAXED,__HIP_MEMORY_SCOPE_AGENT); slot[0]=n; }
    asm volatile("s_waitcnt vmcnt(0) lgkmcnt(0)\n\ts_barrier":::"memory");
    const unsigned n=slot[0];
    asm volatile("s_waitcnt lgkmcnt(0)\n\ts_barrier":::"memory");
    if(n>=(unsigned)(BATCH*NHEAD*NQB))return false;
    u.qb=NQB-1-(int)(n/(BATCH*NHEAD)); u.bh=(int)(n%(BATCH*NHEAD)); return true; }
  __device__ __forceinline__ void a_ready(const AttnUnit&)const{}
  __device__ __forceinline__ void done(const AttnUnit&)const{}
};
template<class Sched,int THRL=8> __device__ __forceinline__ void attn_phase(char*lds,const AttnTensors&T,const Sched&S,const int wid){
  AttnUnit u;
  for(int i=0;S.next(i,u);++i){ S.a_ready(u); attn_unit<THRL>(u.bh/NHEAD,u.bh%NHEAD,u.qb,T.Q,T.K,T.V,T.O,lds,wid); S.done(u); }
}
#undef SBAR
#undef WAIT_BAR
}
constexpr int NWAVES = 8;
#ifndef MK_N_LAUNCHES
#define MK_N_LAUNCHES 1
#endif
constexpr int N_PHASES = 14;
#ifndef PROBE_MASK
#define PROBE_MASK 0
#endif
constexpr int N_LAUNCHES = MK_N_LAUNCHES;
static_assert(N_LAUNCHES == 1 || N_LAUNCHES == N_PHASES, "MK_N_LAUNCHES is 1 or 14");

constexpr int BATCH = 8, T = 4096, D = 1024, M = BATCH * T;
constexpr int IN_COLS = 3328, RWC = 1792, NEXP = 32, TOPK = 4, NMOD = 6 * D;
constexpr int MAXROWS = M * TOPK + NEXP * 256;
constexpr int MOD_KS = 8;

constexpr size_t MiB = 1u << 20, KiB = 1u << 10;
constexpr size_t WS_CTL = 0, CTL_ZERO_BYTES = 1 * MiB;
constexpr size_t WS_MODP = 1 * MiB;
constexpr size_t WS_MOD = 2 * MiB + 512 * KiB;
constexpr size_t WS_ROPE = 3 * MiB;
constexpr size_t WS_WIN = 5 * MiB;
constexpr size_t WS_WOUT = 12 * MiB;
constexpr size_t WS_BLORA = 14 * MiB;
constexpr size_t WS_TOKE = 15 * MiB, WS_TOKG = 15 * MiB + 512 * KiB;
constexpr size_t WS_TOKROW = 16 * MiB, WS_ROWTOK = 16 * MiB + 512 * KiB, WS_ROWGATE = 17 * MiB + 256 * KiB, WS_BLKBASE = 18 * MiB;
constexpr size_t WS_W1 = 20 * MiB, WS_W2 = 148 * MiB;
constexpr size_t WS_H2 = 212 * MiB;
constexpr size_t WS_H = 276 * MiB, WS_Q = 340 * MiB, WS_K = 372 * MiB, WS_V = 404 * MiB, WS_RW = 436 * MiB;
constexpr size_t WS_O = 548 * MiB, WS_YCAT = 612 * MiB, WS_LACT = 676 * MiB;
constexpr size_t WS_LW = 692 * MiB, WS_AS = 756 * MiB, WS_G = 820 * MiB, WS_Y = 884 * MiB;
constexpr size_t WS_RIMG = 884 * MiB, WS_RBON = 1012 * MiB;
constexpr size_t WS_ACT = 276 * MiB, WS_Y2 = 548 * MiB, WS_END = 1013 * MiB;
static_assert(WS_ROWTOK + (size_t)MAXROWS * 4 <= WS_ROWGATE && WS_ROWGATE + (size_t)MAXROWS * 4 <= WS_BLKBASE && WS_ACT + (size_t)MAXROWS * 2048 <= WS_Y2 && WS_Y2 + (size_t)MAXROWS * 2048 <= WS_Y, "d_ws map");
constexpr int CW_TMO = 0, CW_CODE = 1;
constexpr int CW_BAR = 4096;
constexpr int CW_ATTQ = 8192;
constexpr int CW_ECNT = 12288;
static_assert((CW_ECNT + 2 * 64 * NEXP) * 4 <= (int)CTL_ZERO_BYTES, "CTL words inside the memset region");

constexpr int RING_OFF = 0, RING_BYTES = 131072;
constexpr int LDSCTL_OFF = RING_BYTES, MISC_OFF = LDSCTL_OFF + 320;
constexpr int LDS_BYTES = 147456;
static_assert(MISC_OFF + 128 <= LDS_BYTES, "LDS map");
#define GAS __attribute__((address_space(1)))
#define LAS __attribute__((address_space(3)))
typedef unsigned short bf16;
typedef unsigned v4u __attribute__((ext_vector_type(4)));
typedef float f32x4 __attribute__((ext_vector_type(4)));
typedef short bf16x8 __attribute__((ext_vector_type(8)));
typedef GAS unsigned gu32;
typedef GAS unsigned long long gu64;
#define RLX_AGENT __ATOMIC_RELAXED, __HIP_MEMORY_SCOPE_AGENT
#define LDS_WAIT() asm volatile("s_waitcnt lgkmcnt(0)" ::: "memory")
#define VM_WAIT() asm volatile("s_waitcnt vmcnt(0)" ::: "memory")
__device__ __forceinline__ unsigned long long rt() { return __builtin_amdgcn_s_memrealtime(); }
__device__ __forceinline__ unsigned f2bf(float f) { unsigned u = __builtin_bit_cast(unsigned, f); return (u + 0x7fffu + ((u >> 16) & 1u)) >> 16; }
__device__ __forceinline__ unsigned pk2(float lo, float hi) { return f2bf(lo) | (f2bf(hi) << 16); }

#define XB_TMO      128
#define XB_XCNT(j)  (256  + 64 * (j))
#define XB_XSUB(j)  (1280 + 64 * (j))
#define XB_XGEN(j)  (2304 + 64 * (j))
#define XB_TOP      3328
#define XB_TOPGEN   3392
#define XCD_BAR_WORDS 3456
#define XB_SPIN_CAP (1u << 18)

__device__ __forceinline__ unsigned xb_ld(unsigned* p)              { return __hip_atomic_load(p, __ATOMIC_RELAXED, __HIP_MEMORY_SCOPE_AGENT); }
__device__ __forceinline__ unsigned xb_add(unsigned* p, unsigned v) { return __hip_atomic_fetch_add(p, v, __ATOMIC_RELAXED, __HIP_MEMORY_SCOPE_AGENT); }
__device__ __forceinline__ unsigned xb_xcc_id() { return (unsigned)__builtin_amdgcn_s_getreg((3 << 11) | 20) & 0xFu; }
#define XB_SPIN(cond, bar) do { unsigned _sp = 0; while (cond) { __builtin_amdgcn_s_sleep(1); \
    if ((++_sp & 255u) == 0u) { if (xb_ld(&(bar)[XB_TMO])) break; if (_sp > XB_SPIN_CAP) { atomicAdd(&(bar)[XB_TMO], 1u); break; } } } } while (0)

struct XcdBarrier {
    unsigned* bar; unsigned x; int wid;
    volatile LAS unsigned* st;
};

__device__ __forceinline__ XcdBarrier xcd_barrier_post(unsigned* bar, volatile LAS unsigned* st, int wid) {
    XcdBarrier b; b.bar = bar; b.x = xb_xcc_id(); b.st = st; b.wid = wid;
    if (threadIdx.x == 0) (void)xb_add(&bar[XB_XCNT(b.x)], 1u);
    return b;
}
__device__ __forceinline__ void xcd_barrier_complete(unsigned* bar, unsigned x, unsigned& nloc, unsigned& nx) {
    const unsigned G = gridDim.x * gridDim.y * gridDim.z;
    unsigned sum, cnt, mine, sp = 0u;
    for (;;) {
        sum = 0u; cnt = 0u; mine = 0u;
#pragma unroll
        for (unsigned j = 0; j < 16; ++j) { const unsigned c = xb_ld(&bar[XB_XCNT(j)]); sum += c; cnt += (c > 0u) ? 1u : 0u; mine = (j == x) ? c : mine; }
        if (sum == G) break;
        __builtin_amdgcn_s_sleep(1);
        if ((++sp & 255u) == 0u) { if (xb_ld(&bar[XB_TMO])) break; if (sp > XB_SPIN_CAP) { atomicAdd(&bar[XB_TMO], 1u); break; } }
    }
    nloc = mine > 0u ? mine : 1u; nx = cnt > 0u ? cnt : 1u;
}

__device__ __forceinline__ void xcd_barrier(const XcdBarrier& b) {
    asm volatile("s_waitcnt vmcnt(0)" ::: "memory");
    __syncthreads();
    if (b.wid == 0 && lane_id_v() == 0) {
        unsigned* bar = b.bar;
        __builtin_amdgcn_s_waitcnt(0);
        unsigned nloc = b.st[0], nx = b.st[1];
        if (nloc == 0u) { xcd_barrier_complete(bar, b.x, nloc, nx); b.st[0] = nloc; b.st[1] = nx; }
        const unsigned old = xb_add(&bar[XB_XSUB(b.x)], 1u);
        const unsigned gen = old / nloc;
        if (old + 1u == (gen + 1u) * nloc) {
            __builtin_amdgcn_fence(__ATOMIC_RELEASE, "agent");
            asm volatile("s_waitcnt vmcnt(0)" ::: "memory");
            const unsigned og = xb_add(&bar[XB_TOP], 1u);
            const unsigned tg = og / nx;
            if (og + 1u == (tg + 1u) * nx) xb_add(&bar[XB_TOPGEN], 1u);
            else XB_SPIN(xb_ld(&bar[XB_TOPGEN]) == tg, bar);
            __builtin_amdgcn_fence(__ATOMIC_ACQUIRE, "agent");
            xb_add(&bar[XB_XGEN(b.x)], 1u);
            asm volatile("s_waitcnt vmcnt(0)" ::: "memory");
        } else {
            XB_SPIN(xb_ld(&bar[XB_XGEN(b.x)]) == gen, bar);
            __builtin_amdgcn_fence(__ATOMIC_ACQUIRE, "agent");
            asm volatile("s_waitcnt vmcnt(0)" ::: "memory");
        }
    }
    __syncthreads();
}
typedef float f32x2 __attribute__((ext_vector_type(2)));
typedef unsigned u32x2 __attribute__((ext_vector_type(2)));
struct Frame {
    LAS unsigned char* lds;
    volatile LAS unsigned* MISC;
    gu32* ctl;
    int wave;
    int vcu, G;
    unsigned char* ws; float* out;
};
struct Args { const void* in[33]; float* out; unsigned char* ws; int ph_lo, ph_hi, li, pad; };
struct InProxy { __device__ __forceinline__ const void* operator[](int k) const { unsigned long long v; const unsigned long long kp = (unsigned long long)__builtin_amdgcn_kernarg_segment_ptr();
    asm volatile("s_load_dwordx2 %0, %1, %2\n\ts_waitcnt lgkmcnt(0)" : "=s"(v) : "s"(kp), "s"(8 * k) : "memory"); return (const void*)(const GAS unsigned char*)v; } };
struct ArgsD { InProxy in; };

__device__ __forceinline__ float wave_sum(float v) {
#pragma unroll
    for (int o = 1; o < 64; o <<= 1) v += __shfl_xor(v, o);
    return v;
}
__device__ __forceinline__ float bf2f(unsigned short u) { return __uint_as_float((unsigned)u << 16); }
__device__ __forceinline__ float bflo(unsigned u) { return __uint_as_float(u << 16); }
__device__ __forceinline__ float bfhi(unsigned u) { return __uint_as_float(u & 0xffff0000u); }
typedef float f32x2_t __attribute__((ext_vector_type(2))); typedef __bf16 bf16x2_t __attribute__((ext_vector_type(2)));
__device__ __forceinline__ unsigned pkbf(float lo, float hi) { f32x2_t v = {lo, hi}; bf16x2_t b = __builtin_convertvector(v, bf16x2_t); return __builtin_bit_cast(unsigned, b); }
#define DPP_ADD(x, ctrl) ((x) + __builtin_bit_cast(float, __builtin_amdgcn_update_dpp(0, __builtin_bit_cast(int, (x)), (ctrl), 0xF, 0xF, true)))
__device__ __forceinline__ float allsum16(float x) {
    x = DPP_ADD(x, 0xB1); x = DPP_ADD(x, 0x4E); x = DPP_ADD(x, 0x124); x = DPP_ADD(x, 0x128); return x; }

struct P0Item { const float* src; bf16* dst; int N, K, n0; bool permq, fp8; };
__device__ __forceinline__ bool p0_decode(const Frame& F, int it, P0Item& d, const float* w_in, const float* w_out, const float* w1, const float* w2m) {
    constexpr int I_IN = (D / 64) * (IN_COLS / 32), I_OUT = (D / 64) * (D / 32), I_W1 = (D / 64) * (2048 / 32), I_W2 = (D / 64) * (D / 32);
    constexpr int NITEMS = I_IN + I_OUT + NEXP * I_W1 + NEXP * I_W2;
    if (it >= NITEMS) return false;
    const float* W; bf16* WT; int N, r = it; d.permq = false; d.fp8 = false; d.K = D;
    if (r < I_IN) { W = w_in; WT = (bf16*)(F.ws + WS_WIN); N = IN_COLS; d.permq = true; }
    else { r -= I_IN; if (r < I_OUT) { W = w_out; WT = (bf16*)(F.ws + WS_WOUT); N = D; }
        else { r -= I_OUT; if (r < NEXP * I_W1) { const int e = r / I_W1; r -= e * I_W1; W = w1 + (size_t)e * D * 2048; WT = (bf16*)(F.ws + WS_W1 + (size_t)e * 2048 * D); N = 2048; d.fp8 = true; }
            else { r -= NEXP * I_W1; const int e = r / I_W2; r -= e * I_W2; W = w2m + (size_t)e * D * D; WT = (bf16*)(F.ws + WS_W2 + (size_t)e * D * D); N = D; d.fp8 = true; } } }
    const int nblk = N / 32, kb = r / nblk, nb = r - kb * nblk; d.N = N; d.n0 = 32 * nb; d.src = W + (size_t)(64 * kb) * N + d.n0; d.dst = d.fp8 ? (bf16*)((unsigned char*)WT + 64 * kb) : WT + 64 * kb; return true;
}
__device__ __forceinline__ void p0_item_store(const P0Item& d, const float (&v)[32], LAS float* scr, int lane) {
#pragma unroll
    for (int i = 0; i < 32; ++i) scr[(2 * i + (lane >> 5)) * 33 + (lane & 31)] = v[i];
    LDS_WAIT(); asm volatile("" ::: "memory");
    const int c = lane & 7;
#pragma unroll
    for (int j = 0; j < 4; ++j) { const int n = (lane >> 3) + 8 * j; const LAS float* s = scr + (8 * c) * 33 + n;
        int nn = d.n0 + n;
        if (d.fp8) { const u32x2 o8 = (u32x2){pg8::pk4_fp8(s[0 * 33] * pg8::W8_SCALE, s[1 * 33] * pg8::W8_SCALE, s[2 * 33] * pg8::W8_SCALE, s[3 * 33] * pg8::W8_SCALE), pg8::pk4_fp8(s[4 * 33] * pg8::W8_SCALE, s[5 * 33] * pg8::W8_SCALE, s[6 * 33] * pg8::W8_SCALE, s[7 * 33] * pg8::W8_SCALE)};
            *(GAS u32x2*)((unsigned char*)d.dst + (size_t)nn * d.K + 8 * c) = o8; }
        else { v4u o; o.x = pkbf(s[0 * 33], s[1 * 33]); o.y = pkbf(s[2 * 33], s[3 * 33]); o.z = pkbf(s[4 * 33], s[5 * 33]); o.w = pkbf(s[6 * 33], s[7 * 33]);
            if (d.permq && nn < 1024) { const int dd = nn & 63; if (dd < 16) nn = (nn & ~63) + ((dd < 8) ? 2 * dd : 2 * (dd - 8) + 1); }
            *(GAS v4u*)(d.dst + (size_t)nn * d.K + 8 * c) = o; } }
    LDS_WAIT(); asm volatile("" ::: "memory");
}
__device__ __forceinline__ void sincos_d(float af, float& s, float& c) {
    const double a = (double)af; const double n = __builtin_rint(a * 0.63661977236758134308);
    double r = __builtin_fma(-n, 1.57079632679489655800e+00, a); r = __builtin_fma(-n, 6.12323399573676603587e-17, r);
    const double r2 = r * r;
    double sp = 1.0 / 6227020800.0; sp = sp * r2 * -1.0 + 1.0 / 39916800.0; sp = -sp * r2 + 1.0 / 362880.0; sp = -sp * r2 + 1.0 / 5040.0; sp = -sp * r2 + 1.0 / 120.0; sp = -sp * r2 + 1.0 / 6.0; sp = r - r * r2 * sp;
    double cp = 1.0 / 87178291200.0; cp = -cp * r2 + 1.0 / 479001600.0; cp = -cp * r2 + 1.0 / 3628800.0; cp = -cp * r2 + 1.0 / 40320.0; cp = -cp * r2 + 1.0 / 720.0; cp = -cp * r2 + 1.0 / 24.0; cp = -cp * r2 + 0.5; cp = 1.0 - r2 * cp;
    const int q = ((int)n) & 3;
    const double sv = (q == 0) ? sp : (q == 1) ? cp : (q == 2) ? -sp : -cp, cv = (q == 0) ? cp : (q == 1) ? -sp : (q == 2) ? -cp : sp;
    s = (float)sv; c = (float)cv;
}
__device__ __forceinline__ void p0_prologue(Frame& F, const ArgsD& A) {
    const int lane = lane_id_v(), tid = F.wave * 64 + lane; (void)tid;
    const int gw = F.vcu * NWAVES + F.wave, NGW = F.G * NWAVES, gt = F.vcu * 512 + tid, NGT = F.G * 512;
    LAS float* scr = (LAS float*)(F.lds + RING_OFF + F.wave * 12288);
    LAS float* sl = (LAS float*)(F.lds + RING_OFF + 98304);
    const float* c = (const float*)A.in[1];
    for (int i = tid; i < 8 * 1024; i += 512) { const float v = c[i]; sl[i] = v / (1.f + __expf(-v)); }
    __syncthreads();
    { const float* aw = (const float*)A.in[3]; float* modp = (float*)(F.ws + WS_MODP);
      for (int it = gw; it < 96 * MOD_KS; it += NGW) { const int cc = it % 96, ks = it / 96, col = cc * 64 + lane;
          float acc[8];
#pragma unroll
          for (int b = 0; b < 8; ++b) acc[b] = 0.f;
          for (int k = ks * 128; k < ks * 128 + 128; ++k) { const float w = aw[(size_t)k * NMOD + col];
#pragma unroll
              for (int b = 0; b < 8; ++b) acc[b] += sl[b * 1024 + k] * w; }
#pragma unroll
          for (int b = 0; b < 8; ++b) modp[(size_t)(ks * 8 + b) * NMOD + col] = acc[b]; } }
    { const int* pos = (const int*)A.in[2]; float* rope = (float*)(F.ws + WS_ROPE);
      for (int idx = gt; idx < M * 8; idx += NGT) { const int m = idx >> 3, i = idx & 7;
          const float invf = (i == 0) ? 1.0f : (i == 1) ? 0.1939227432012558f : (i == 2) ? 0.03760603070259094f : (i == 3) ? 0.007292664609849453f : (i == 4) ? 0.0014142135623842478f : (i == 5) ? 0.00027424818836152554f : (i == 6) ? 5.318296098266728e-05f : 1.0313386155758053e-05f;
          const float ang = (float)pos[m] * invf; float s, cc; sincos_d(ang, s, cc); rope[(size_t)m * 16 + i] = cc; rope[(size_t)m * 16 + 8 + i] = s; } }
    { const float* w2 = (const float*)A.in[18]; const float* a2 = (const float*)A.in[20]; const float* g2 = (const float*)A.in[21]; bf16* bl = (bf16*)(F.ws + WS_BLORA);
      for (int idx = gt; idx < 1536 * 256; idx += NGT) { const int n = idx >> 8, k = idx & 255, blk = n >> 9, nn = n & 511; float v = 0.f;
          if (blk == 0 && k < 64) v = w2[k * 512 + nn]; else if (blk == 1 && k >= 64 && k < 128) v = a2[(k - 64) * 512 + nn]; else if (blk == 2 && k >= 128) v = g2[(k - 128) * 512 + nn];
          bl[idx] = (bf16)(pkbf(v, 0.f) & 0xffffu); } }
    { const float* w_in = (const float*)A.in[9]; const float* w_out = (const float*)A.in[10]; const float* w1 = (const float*)A.in[29]; const float* w2m = (const float*)A.in[31];
      P0Item cur, nxt; float v[32], vn[32];
      bool have = p0_decode(F, gw, cur, w_in, w_out, w1, w2m);
      if (have) {
#pragma unroll
          for (int i = 0; i < 32; ++i) v[i] = cur.src[(size_t)(2 * i + (lane >> 5)) * cur.N + (lane & 31)]; }
      for (int it = gw; have; it += NGW) {
          const bool hn = p0_decode(F, it + NGW, nxt, w_in, w_out, w1, w2m);
          if (hn) {
#pragma unroll
              for (int i = 0; i < 32; ++i) vn[i] = nxt.src[(size_t)(2 * i + (lane >> 5)) * nxt.N + (lane & 31)]; }
          p0_item_store(cur, v, scr, lane);
          cur = nxt; have = hn;
#pragma unroll
          for (int i = 0; i < 32; ++i) v[i] = vn[i];
      } }
}

__device__ __forceinline__ void p1_premix(Frame& F, const ArgsD& A) {
    const int lane = lane_id_v(), tid = F.wave * 64 + lane; (void)tid;
    const float* modp = (const float*)(F.ws + WS_MODP); const float* ada_b = (const float*)A.in[4]; float* mod = (float*)(F.ws + WS_MOD);
    const int rows_per = M / F.G, mbeg = F.vcu * rows_per, b = mbeg >> 12;
    LAS float* ms = (LAS float*)(F.lds + RING_OFF);
    for (int col = tid; col < 2048; col += 512) { float s = ada_b[col];
#pragma unroll
        for (int ks = 0; ks < MOD_KS; ++ks) s += modp[(size_t)(ks * 8 + b) * NMOD + col];
        ms[col] = s; }
    for (int i = F.vcu * 512 + tid; i < 8 * 4096; i += F.G * 512) { const int bb = i >> 12, col = 2048 + (i & 4095); float s = ada_b[col];
#pragma unroll
        for (int ks = 0; ks < MOD_KS; ++ks) s += modp[(size_t)(ks * 8 + bb) * NMOD + col];
        mod[(size_t)bb * NMOD + col] = s; }
    __syncthreads();
    const float* x = (const float*)A.in[0]; const float* nw = (const float*)A.in[5]; bf16* H = (bf16*)(F.ws + WS_H);
    f32x4 wsc[4], sh[4];
#pragma unroll
    for (int j = 0; j < 4; ++j) { const int col = 4 * lane + 256 * j; wsc[j] = *((const f32x4*)nw + lane + 64 * j) * (*(const LAS f32x4*)(ms + 1024 + col) + 1.f); sh[j] = *(const LAS f32x4*)(ms + col); }
    const int nr = rows_per / NWAVES, m0 = mbeg + F.wave * nr;
    f32x4 pv[4];
#pragma unroll
    for (int j = 0; j < 4; ++j) pv[j] = *((const GAS f32x4*)(x + (size_t)m0 * D) + lane + 64 * j);
    for (int i = 0; i < nr; ++i) { const int m = m0 + i;
        f32x4 v[4]; float s2 = 0.f;
#pragma unroll
        for (int j = 0; j < 4; ++j) { v[j] = pv[j]; s2 += (v[j].x * v[j].x + v[j].y * v[j].y) + (v[j].z * v[j].z + v[j].w * v[j].w); }
        if (i + 1 < nr) {
#pragma unroll
            for (int j = 0; j < 4; ++j) pv[j] = *((const GAS f32x4*)(x + (size_t)(m + 1) * D) + lane + 64 * j); }
        const float rs = __builtin_amdgcn_rsqf(wave_sum(s2) * (1.f / D) + 1e-6f);
        GAS u32x2* o8 = (GAS u32x2*)(H + (size_t)m * D) + lane;
#pragma unroll
        for (int j = 0; j < 4; ++j) { const f32x4 y = v[j] * rs * wsc[j] + sh[j]; o8[64 * j] = (u32x2){pkbf(y.x, y.y), pkbf(y.z, y.w)}; } }
}

__device__ __forceinline__ void p3_lact(Frame& F, const ArgsD& A) {
    const int lane = lane_id_v(), tid = F.wave * 64 + lane; (void)tid;
    const bf16* RW = (const bf16*)(F.ws + WS_RW); bf16* L = (bf16*)(F.ws + WS_LACT); const float* mu = (const float*)A.in[16] + 1536;
    const int gw = F.vcu * NWAVES + F.wave, NGW = F.G * NWAVES, c0 = 4 * lane;
    const f32x4 mu4 = *(const f32x4*)(mu + c0);
    for (int m = gw; m < M; m += NGW) { const int t = m & (T - 1);
        const u32x2 p = *(const GAS u32x2*)(RW + (size_t)m * RWC + 1536 + c0); u32x2 q = (u32x2){0u, 0u}; if (t > 0) q = *(const GAS u32x2*)(RW + (size_t)(m - 1) * RWC + 1536 + c0);
        f32x4 pv = (f32x4){bflo(p.x), bfhi(p.x), bflo(p.y), bfhi(p.y)}, qv = (f32x4){bflo(q.x), bfhi(q.x), bflo(q.y), bfhi(q.y)};
        f32x4 s = pv + (qv - pv) * mu4;
        if (c0 < 64) { s.x = tanhf(s.x); s.y = tanhf(s.y); s.z = tanhf(s.z); s.w = tanhf(s.w); }
        else if (c0 >= 128) { s.x = 1.f / (1.f + __expf(-s.x)); s.y = 1.f / (1.f + __expf(-s.y)); s.z = 1.f / (1.f + __expf(-s.z)); s.w = 1.f / (1.f + __expf(-s.w)); }
        *(GAS u32x2*)(L + (size_t)m * 256 + c0) = (u32x2){pkbf(s.x, s.y), pkbf(s.z, s.w)}; }
}

namespace rwk {
typedef short bf16x8 __attribute__((ext_vector_type(8)));
constexpr int MB = 8192;
__device__ __forceinline__ int moff(int r, int c) { return r * 128 + ((((c >> 3) ^ (r >> 1)) & 7) << 4) + ((c & 7) << 1); }
__device__ __forceinline__ bf16x8 frag(const LAS unsigned char* buf, int row, int chunk) { return *(const LAS bf16x8*)(buf + row * 128 + (((chunk ^ (row >> 1)) & 7) << 4)); }
__device__ __forceinline__ void mm(f32x4& acc, const LAS unsigned char* A, int tm, const LAS unsigned char* B, int tn, int l) {
    const int ar = 16 * tm + (l & 15), br = 16 * tn + (l & 15), q = l >> 4;
#pragma unroll
    for (int ks = 0; ks < 2; ++ks) { const bf16x8 a = frag(A, ar, 4 * ks + q), b = frag(B, br, 4 * ks + q); acc = __builtin_amdgcn_mfma_f32_16x16x32_bf16(a, b, acc, 0, 0, 0); }
}
__device__ __forceinline__ void st_nm(LAS unsigned char* buf, int tm, int tn, int l, f32x4 v) {
    const int row = 16 * tn + (l & 15), c = 16 * tm + 4 * (l >> 4); *(LAS u32x2*)(buf + moff(row, c)) = (u32x2){pkbf(v[0], v[1]), pkbf(v[2], v[3])}; }
__device__ __forceinline__ void st_mn(LAS unsigned char* buf, int tm, int tn, int l, f32x4 v) {
    const int c = 16 * tn + (l & 15), r0 = 16 * tm + 4 * (l >> 4); const unsigned p0 = pkbf(v[0], v[1]), p1 = pkbf(v[2], v[3]);
    *(LAS unsigned short*)(buf + moff(r0 + 0, c)) = (unsigned short)(p0 & 0xffffu); *(LAS unsigned short*)(buf + moff(r0 + 1, c)) = (unsigned short)(p0 >> 16);
    *(LAS unsigned short*)(buf + moff(r0 + 2, c)) = (unsigned short)(p1 & 0xffffu); *(LAS unsigned short*)(buf + moff(r0 + 3, c)) = (unsigned short)(p1 >> 16); }
__device__ __forceinline__ f32x4 ld_nm(const LAS unsigned char* buf, int tm, int tn, int l) {
    const int row = 16 * tn + (l & 15), c = 16 * tm + 4 * (l >> 4); const u32x2 p = *(const LAS u32x2*)(buf + moff(row, c)); return (f32x4){bflo(p.x), bfhi(p.x), bflo(p.y), bfhi(p.y)}; }
__device__ __forceinline__ float wsum64(float x) {
    x = DPP_ADD(x, 0xB1); x = DPP_ADD(x, 0x4E); x = DPP_ADD(x, 0x124); x = DPP_ADD(x, 0x128);
    x += __shfl_xor(x, 16); x += __shfl_xor(x, 32); return x; }
__device__ __forceinline__ float sum8(float x) { x = DPP_ADD(x, 0xB1); x = DPP_ADD(x, 0x4E); x = DPP_ADD(x, 0x141); return x; }
}

__device__ __forceinline__ void rwkv_pre(Frame& F, const ArgsD& A, const int bh, const int c_lo, const int c_hi) {
    using namespace rwk;
    const int b = bh >> 3, h = bh & 7, lane0 = lane_id_v(), w0 = F.wave;
    LAS unsigned char* L = F.lds + RING_OFF;
    LAS unsigned char* bA = L + 0 * MB; LAS unsigned char* bR = L + 1 * MB; LAS unsigned char* bB = L + 2 * MB; LAS unsigned char* bK = L + 3 * MB;
    LAS unsigned char* bBH = L + 4 * MB; LAS unsigned char* bKH = L + 5 * MB; LAS unsigned char* bVT = L + 6 * MB;
    LAS unsigned char* bAT = L + 7 * MB;
    LAS unsigned char* bAak = L + 9 * MB; LAS unsigned char* bArb = L + 10 * MB; LAS unsigned char* bArk = L + 11 * MB;
    LAS unsigned char* bQ0 = L + 12 * MB; LAS unsigned char* bQT0 = L + 13 * MB;
    LAS unsigned char* bT = L + 14 * MB;
    LAS unsigned char* bTF = L + 15 * MB;
    LAS float* part = (LAS float*)(F.lds + MISC_OFF + 128);
    LAS float* bon = part + 512;
    const bf16* RW = (const bf16*)(F.ws + WS_RW); const bf16* LW = (const bf16*)(F.ws + WS_LW); const bf16* AS = (const bf16*)(F.ws + WS_AS);
    unsigned char* IMG = F.ws + WS_RIMG; float* BON = (float*)(F.ws + WS_RBON);
    const size_t mb = (size_t)b * T;
    const float* mu = (const float*)A.in[16];
    float mu_r, mu_k, mu_v, kkc, kac, rkc;
    { const int hj = h * 64 + lane0; mu_r = mu[hj]; mu_k = mu[512 + hj]; mu_v = mu[1024 + hj]; kkc = ((const float*)A.in[22])[hj]; kac = ((const float*)A.in[23])[hj]; rkc = ((const float*)A.in[24])[hj]; }
    unsigned short pr[9], pk_[9], pv[9], plw[8], pas[8];
#define RWC_LOAD(c) do { const int w = w0, hj = h * 64 + lane0; const size_t m0_ = mb + (size_t)(c) * 64 + 8 * w; \
        _Pragma("unroll") for (int i_ = 0; i_ < 9; ++i_) { const bool ok_ = (i_ > 0) || ((c) > 0) || (w > 0); const bf16* row_ = RW + (m0_ + i_ - 1) * RWC + hj; \
            pr[i_] = ok_ ? row_[0] : (unsigned short)0; pk_[i_] = ok_ ? row_[512] : (unsigned short)0; pv[i_] = ok_ ? row_[1024] : (unsigned short)0; } \
        _Pragma("unroll") for (int i_ = 0; i_ < 8; ++i_) { plw[i_] = LW[(m0_ + i_) * 512 + hj]; pas[i_] = AS[(m0_ + i_) * 512 + hj]; } } while (0)
    RWC_LOAD(c_lo);
    for (int c = c_lo; c < c_hi; ++c) {
        int w = w0, lane = lane0; asm volatile("" : "+s"(w), "+v"(lane));
        const int tn_ = w & 3, tm0_ = 2 * (w >> 2);
        { float run = 0.f;
#pragma unroll
          for (int i = 0; i < 8; ++i) run += bf2f(plw[i]);
          part[w * 64 + lane] = run; }
        __syncthreads();
        float off = 0.f, ctot = 0.f;
#pragma unroll
        for (int o = 0; o < 8; ++o) { const float p = part[o * 64 + lane]; ctot += p; if (o < w) off += p; }
        {   unsigned bh_[4], kh_[4], vt_[4], at_[4]; float cm = off; float* bon_g = BON + ((size_t)bh * 64 + c) * 64;
#pragma unroll
            for (int i = 0; i < 8; ++i) { const int t = 8 * w + i;
                const float p0 = bf2f(pr[i + 1]), p1 = bf2f(pk_[i + 1]), p2 = bf2f(pv[i + 1]);
                const float rv = p0 + (bf2f(pr[i]) - p0) * mu_r, kv = p1 + (bf2f(pk_[i]) - p1) * mu_k, vv = p2 + (bf2f(pv[i]) - p2) * mu_v, asg = bf2f(pas[i]);
                const float ce = cm; cm += bf2f(plw[i]);
                float kkv = kv * kkc; const float n2 = wsum64(kkv * kkv); kkv = kkv * __builtin_amdgcn_rsqf(fmaxf(n2, 1e-24f));
                const float km = kv * (1.f + (asg - 1.f) * kac); const float bn = wsum64(rv * km * rkc); if (lane == 0) bon_g[t] = bn;
                const float av = -kkv, bv = kkv * asg;
                const float e_ce = __expf(ce), e_cm = __expf(cm), e_ncm = __expf(-cm), e_rem = __expf(ctot - cm);
                const unsigned ha = pkbf(av * e_ce, 0.f) & 0xffffu; *(LAS unsigned short*)(bA + moff(t, lane)) = (unsigned short)ha; *(LAS unsigned short*)(bR + moff(t, lane)) = (unsigned short)(pkbf(rv * e_cm, 0.f) & 0xffffu);
                *(LAS unsigned short*)(bB + moff(t, lane)) = (unsigned short)(pkbf(bv * e_ncm, 0.f) & 0xffffu); *(LAS unsigned short*)(bK + moff(t, lane)) = (unsigned short)(pkbf(km * e_ncm, 0.f) & 0xffffu);
                const unsigned hb = pkbf(bv * e_rem, 0.f) & 0xffffu, hk = pkbf(km * e_rem, 0.f) & 0xffffu, hv = pkbf(vv, 0.f) & 0xffffu;
                if (i & 1) { bh_[i >> 1] |= hb << 16; kh_[i >> 1] |= hk << 16; vt_[i >> 1] |= hv << 16; at_[i >> 1] |= ha << 16; } else { bh_[i >> 1] = hb; kh_[i >> 1] = hk; vt_[i >> 1] = hv; at_[i >> 1] = ha; } }
            *(LAS v4u*)(bBH + moff(lane, 8 * w)) = (v4u){bh_[0], bh_[1], bh_[2], bh_[3]};
            *(LAS v4u*)(bKH + moff(lane, 8 * w)) = (v4u){kh_[0], kh_[1], kh_[2], kh_[3]};
            *(LAS v4u*)(bVT + moff(lane, 8 * w)) = (v4u){vt_[0], vt_[1], vt_[2], vt_[3]};
            *(LAS v4u*)(bAT + moff(lane, 8 * w)) = (v4u){at_[0], at_[1], at_[2], at_[3]};
        }
        const float dec0 = __expf(ctot);
        if (c + 1 < c_hi) RWC_LOAD(c + 1);
        __syncthreads();
        {   const int p = w >> 1; const LAS unsigned char* Am = (p < 2) ? bA : bR; const LAS unsigned char* Bm = (p == 0 || p == 2) ? bB : bK;
#pragma unroll
            for (int x = 0; x < 2; ++x) { const int tm = 2 * (w & 1) + x;
#pragma unroll
                for (int tn = 0; tn < 4; ++tn) { f32x4 acc = (f32x4){0.f, 0.f, 0.f, 0.f}; mm(acc, Am, tm, Bm, tn, lane);
                    const int n = 16 * tn + (lane & 15), m0 = 16 * tm + 4 * (lane >> 4);
#pragma unroll
                    for (int r = 0; r < 4; ++r) { const bool keep = (p < 2) ? (n < m0 + r) : (n <= m0 + r); if (!keep) acc[r] = 0.f; }
                    if (p == 0) { st_mn(bQ0, tm, tn, lane, acc); st_nm(bQT0, tm, tn, lane, acc);
#pragma unroll
                        for (int r = 0; r < 4; ++r) if (n == m0 + r) acc[r] += 1.f;
                        st_nm(bT, tm, tn, lane, acc); }
                    else st_mn((p == 1) ? bAak : (p == 2) ? bArb : bArk, tm, tn, lane, acc); } }
        }
        __syncthreads();
#pragma unroll
        for (int x = 0; x < 2; ++x) { const int tm = tm0_ + x; f32x4 acc = (f32x4){0.f, 0.f, 0.f, 0.f}; mm(acc, bQ0, tm, bQT0, tn_, lane); st_mn(bB, tm, tn_, lane, acc); st_nm(bK, tm, tn_, lane, acc); }
        __syncthreads();
#pragma unroll
        for (int s = 2; s <= 5; ++s) {
            const LAS unsigned char* Qc = (s & 1) ? bQ0 : bB; const LAS unsigned char* QTc = (s & 1) ? bQT0 : bK;
            LAS unsigned char* Qn = (s & 1) ? bB : bQ0; LAS unsigned char* QTn = (s & 1) ? bK : bQT0;
            const int tn = w & 3;
            if (w >= 4) { f32x4 acc[4];
#pragma unroll
                for (int tm = 0; tm < 4; ++tm) acc[tm] = ld_nm(bT, tm, tn, lane);
#pragma unroll
                for (int tm = 0; tm < 4; ++tm) mm(acc[tm], Qc, tm, bT, tn, lane);
#pragma unroll
                for (int tm = 0; tm < 4; ++tm) st_nm(bT, tm, tn, lane, acc[tm]);
            } else {
#pragma unroll
                for (int tm = 0; tm < 4; ++tm) { f32x4 acc = (f32x4){0.f, 0.f, 0.f, 0.f}; mm(acc, Qc, tm, QTc, tn, lane); st_mn(Qn, tm, tn, lane, acc); st_nm(QTn, tm, tn, lane, acc); }
            }
            __syncthreads();
        }
        {
#pragma unroll
            for (int x = 0; x < 2; ++x) { const int tm = tm0_ + x; f32x4 acc = ld_nm(bT, tm, tn_, lane); mm(acc, bB, tm, bT, tn_, lane); st_mn(bTF, tm, tn_, lane, acc); }
        }
        LAS unsigned char* bX = bB; LAS unsigned char* bW = bK; LAS unsigned char* bU = bQ0;
        __syncthreads();
#pragma unroll
        for (int x = 0; x < 2; ++x) { const int tm = tm0_ + x;
            { f32x4 acc = (f32x4){0.f, 0.f, 0.f, 0.f}; mm(acc, bAak, tm, bVT, tn_, lane); st_nm(bX, tm, tn_, lane, acc); }
            { f32x4 acc = (f32x4){0.f, 0.f, 0.f, 0.f}; mm(acc, bTF, tm, bAT, tn_, lane); st_nm(bW, tm, tn_, lane, acc); } }
        __syncthreads();
#pragma unroll
        for (int x = 0; x < 2; ++x) { const int tm = tm0_ + x; f32x4 acc = (f32x4){0.f, 0.f, 0.f, 0.f}; mm(acc, bTF, tm, bX, tn_, lane); st_nm(bU, tm, tn_, lane, acc); }
        __syncthreads();
        {   unsigned char* img = IMG + ((size_t)bh * 64 + c) * (4 * MB);
            const int n_ = 16 * tn_ + (lane & 15); const float decn = __shfl(dec0, n_);
#pragma unroll
            for (int x = 0; x < 2; ++x) { const int tm = tm0_ + x; const int m0 = 16 * tm + 4 * (lane >> 4); const int go = moff(n_, m0);
                { f32x4 acc = (f32x4){0.f, 0.f, 0.f, 0.f}; mm(acc, bW, tm, bBH, tn_, lane);
#pragma unroll
                  for (int r = 0; r < 4; ++r) if (m0 + r == n_) acc[r] += decn;
                  *(GAS u32x2*)(img + 0 * MB + go) = (u32x2){pkbf(acc[0], acc[1]), pkbf(acc[2], acc[3])}; }
                { f32x4 acc = (f32x4){0.f, 0.f, 0.f, 0.f}; mm(acc, bBH, tm, bU, tn_, lane); mm(acc, bKH, tm, bVT, tn_, lane);
                  *(GAS u32x2*)(img + 1 * MB + go) = (u32x2){pkbf(acc[0], acc[1]), pkbf(acc[2], acc[3])}; }
                { f32x4 acc = ld_nm(bR, tm, tn_, lane); mm(acc, bW, tm, bArb, tn_, lane);
                  *(GAS u32x2*)(img + 2 * MB + go) = (u32x2){pkbf(acc[0], acc[1]), pkbf(acc[2], acc[3])}; }
                { f32x4 acc = (f32x4){0.f, 0.f, 0.f, 0.f}; mm(acc, bArb, tm, bU, tn_, lane); mm(acc, bArk, tm, bVT, tn_, lane);
                  *(GAS u32x2*)(img + 3 * MB + go) = (u32x2){pkbf(acc[0], acc[1]), pkbf(acc[2], acc[3])}; } }
        }
        __syncthreads();
    }
#undef RWC_LOAD
}

__device__ __forceinline__ void rwkv_seq(Frame& F, const ArgsD& A, const int bh) {
    using namespace rwk;
    const int b = bh >> 3, h = bh & 7, lane0 = lane_id_v(), w0 = F.wave;
    LAS unsigned char* L = F.lds + RING_OFF;
    LAS unsigned char* bS0 = L + 8 * MB;
    LAS float* ybuf = (LAS float*)(L + 10 * MB);
    const bf16* RW = (const bf16*)(F.ws + WS_RW); const bf16* G = (const bf16*)(F.ws + WS_G); bf16* YC = (bf16*)(F.ws + WS_YCAT);
    const unsigned char* IMG = F.ws + WS_RIMG + (size_t)bh * 64 * (4 * MB); const float* BON = (const float*)(F.ws + WS_RBON) + (size_t)bh * 64 * 64;
    const float* mu = (const float*)A.in[16]; const float* lnw_g = (const float*)A.in[25]; const float* lnb_g = (const float*)A.in[26];
    const size_t mb = (size_t)b * T;
    const int tid0 = w0 * 64 + lane0, lt0 = tid0 >> 3, hlc0 = h * 64 + (tid0 & 7) * 8;
    for (int i = tid0; i < MB / 16; i += 512) ((LAS v4u*)bS0)[i] = (v4u){0u, 0u, 0u, 0u};
    v4u pf[4][4], lvp[4], lvq[4], lgg[4]; float lbn[4];
#define RWS_LOAD(u, c) do { _Pragma("unroll") for (int k_ = 0; k_ < 4; ++k_) pf[u][k_] = *(const GAS v4u*)(IMG + (size_t)(c) * (4 * MB) + k_ * MB + tid0 * 16); \
        const size_t ml_ = mb + (size_t)(c) * 64 + lt0; lvp[u] = *(const GAS v4u*)(RW + ml_ * RWC + 1024 + hlc0); lvq[u] = *(const GAS v4u*)(RW + (ml_ - (((c) > 0 || lt0 > 0) ? 1 : 0)) * RWC + 1024 + hlc0); \
        lgg[u] = *(const GAS v4u*)(G + ml_ * 512 + hlc0); lbn[u] = BON[(c) * 64 + lt0]; } while (0)
#pragma unroll
    for (int u = 0; u < 4; ++u) RWS_LOAD(u, u);
    int scur = 0;
    for (int c4 = 0; c4 < T / 64; c4 += 4) {
#pragma unroll
      for (int u = 0; u < 4; ++u) { const int c = c4 + u;
        int w = w0, lane = lane0; asm volatile("" : "+s"(w), "+v"(lane));
        const int tid = w * 64 + lane, tn_ = w & 3, tm0_ = 2 * (w >> 2), lt = tid >> 3, lc = (tid & 7) * 8, hlc = h * 64 + lc;
        LAS unsigned char* set = L + (c & 1) * (4 * MB);
#pragma unroll
        for (int k = 0; k < 4; ++k) *(LAS v4u*)(set + k * MB + tid * 16) = pf[u][k];
        const v4u lv_p = lvp[u], lv_q = (c > 0 || lt > 0) ? lvq[u] : (v4u){0u, 0u, 0u, 0u}; const f32x4 lg0 = (f32x4){bflo(lgg[u].x), bfhi(lgg[u].x), bflo(lgg[u].y), bfhi(lgg[u].y)}, lg1 = (f32x4){bflo(lgg[u].z), bfhi(lgg[u].z), bflo(lgg[u].w), bfhi(lgg[u].w)}; const float bn = lbn[u];
        __syncthreads();
        if (c + 4 < T / 64) RWS_LOAD(u, c + 4);
        const LAS unsigned char* Sc = bS0 + scur * MB; LAS unsigned char* Sn = bS0 + (scur ^ 1) * MB;
#pragma unroll
        for (int x = 0; x < 2; ++x) { const int tm = tm0_ + x;
            { f32x4 acc = ld_nm(set + 1 * MB, tm, tn_, lane); mm(acc, set + 0 * MB, tm, Sc, tn_, lane); st_nm(Sn, tm, tn_, lane, acc); }
            { f32x4 acc = ld_nm(set + 3 * MB, tm, tn_, lane); mm(acc, set + 2 * MB, tm, Sc, tn_, lane);
              const int i = 16 * tn_ + (lane & 15), t0 = 16 * tm + 4 * (lane >> 4);
#pragma unroll
              for (int r = 0; r < 4; ++r) ybuf[(t0 + r) * 64 + i] = acc[r]; } }
        scur ^= 1;
        __syncthreads();
        {   const f32x4 y0 = *(const LAS f32x4*)(ybuf + lt * 64 + lc), y1 = *(const LAS f32x4*)(ybuf + lt * 64 + lc + 4);
            const float mean = sum8((y0.x + y0.y) + (y0.z + y0.w) + (y1.x + y1.y) + (y1.z + y1.w)) * (1.f / 64.f); const f32x4 d0 = y0 - mean, d1 = y1 - mean;
            const float var = sum8((d0.x * d0.x + d0.y * d0.y) + (d0.z * d0.z + d0.w * d0.w) + (d1.x * d1.x + d1.y * d1.y) + (d1.z * d1.z + d1.w * d1.w)) * (1.f / 64.f); const float rs = __builtin_amdgcn_rsqf(var + 64e-5f);
            const float* lnw_p = lnw_g + hlc; const float* lnb_p = lnb_g + hlc; const float* muv_p = mu + 1024 + hlc;
            const f32x4 lw0 = *(const f32x4*)lnw_p, lw1 = *(const f32x4*)(lnw_p + 4), lb0 = *(const f32x4*)lnb_p, lb1 = *(const f32x4*)(lnb_p + 4), mv0 = *(const f32x4*)muv_p, mv1 = *(const f32x4*)(muv_p + 4);
            f32x4 va = (f32x4){bflo(lv_p.x), bfhi(lv_p.x), bflo(lv_p.y), bfhi(lv_p.y)}, vb = (f32x4){bflo(lv_p.z), bfhi(lv_p.z), bflo(lv_p.w), bfhi(lv_p.w)};
            { const f32x4 qa = (f32x4){bflo(lv_q.x), bfhi(lv_q.x), bflo(lv_q.y), bfhi(lv_q.y)}, qb = (f32x4){bflo(lv_q.z), bfhi(lv_q.z), bflo(lv_q.w), bfhi(lv_q.w)}; va = va + (qa - va) * mv0; vb = vb + (qb - vb) * mv1; }
            const f32x4 o0 = ((d0 * rs) * lw0 + lb0 + va * bn) * lg0, o1 = ((d1 * rs) * lw1 + lb1 + vb * bn) * lg1;
            *(GAS v4u*)(YC + (mb + (size_t)c * 64 + lt) * 1024 + 512 + hlc) = (v4u){pkbf(o0.x, o0.y), pkbf(o0.z, o0.w), pkbf(o1.x, o1.y), pkbf(o1.z, o1.w)};
        }
      }
    }
#undef RWS_LOAD
}

__device__ __forceinline__ void p6_dacombine(Frame& F, const ArgsD& A) {
    const int lane = lane_id_v(), tid = F.wave * 64 + lane; (void)tid;
    const float* q1 = (const float*)A.in[11]; const float* k1 = (const float*)A.in[12]; const float* q2 = (const float*)A.in[13]; const float* k2 = (const float*)A.in[14];
    const float lam = __expf(wave_sum(q1[lane] * k1[lane])) - __expf(wave_sum(q2[lane] * k2[lane])) + 0.2f;
    const bf16* O = (const bf16*)(F.ws + WS_O); bf16* YC = (bf16*)(F.ws + WS_YCAT);
    const int gw = F.vcu * NWAVES + F.wave, NGW = F.G * NWAVES, dh = lane >> 4, d0 = 8 * (lane & 15);
    const float* sw = (const float*)A.in[15] + d0; const f32x4 swa = *(const f32x4*)sw * 0.8f, swb = *(const f32x4*)(sw + 4) * 0.8f;
    for (int m = gw; m < M; m += NGW) {
        const v4u a = *(const GAS v4u*)(O + (size_t)m * 1024 + dh * 256 + d0), c = *(const GAS v4u*)(O + (size_t)m * 1024 + dh * 256 + 128 + d0);
        f32x4 y0 = (f32x4){bflo(a.x) - lam * bflo(c.x), bfhi(a.x) - lam * bfhi(c.x), bflo(a.y) - lam * bflo(c.y), bfhi(a.y) - lam * bfhi(c.y)};
        f32x4 y1 = (f32x4){bflo(a.z) - lam * bflo(c.z), bfhi(a.z) - lam * bfhi(c.z), bflo(a.w) - lam * bflo(c.w), bfhi(a.w) - lam * bfhi(c.w)};
        float s2 = (y0.x * y0.x + y0.y * y0.y) + (y0.z * y0.z + y0.w * y0.w) + (y1.x * y1.x + y1.y * y1.y) + (y1.z * y1.z + y1.w * y1.w);
        s2 = allsum16(s2); const float rs = 1.f / sqrtf(s2 * (1.f / 128.f) + 1e-5f);
        y0 = y0 * rs * swa; y1 = y1 * rs * swb;
        *(GAS v4u*)(YC + (size_t)m * 1024 + dh * 128 + d0) = (v4u){pkbf(y0.x, y0.y), pkbf(y0.z, y0.w), pkbf(y1.x, y1.y), pkbf(y1.z, y1.w)}; }
}

#define P9_SWAP32(a, b) do { const auto r_ = __builtin_amdgcn_permlane32_swap(__float_as_uint(a), __float_as_uint(b), false, false); (a) = __uint_as_float(r_[0]) + __uint_as_float(r_[1]); } while (0)
#define P9_SWAP16(a, b) do { const auto r_ = __builtin_amdgcn_permlane16_swap(__float_as_uint(a), __float_as_uint(b), false, false); (a) = __uint_as_float(r_[0]) + __uint_as_float(r_[1]); } while (0)
#define P9_DPPF(x, ctrl) __builtin_bit_cast(float, __builtin_amdgcn_update_dpp(0, __builtin_bit_cast(int, (x)), (ctrl), 0xF, 0xF, true))
#define P9_DPPU(x, ctrl) ((unsigned)__builtin_amdgcn_update_dpp(0, (int)(x), (ctrl), 0xF, 0xF, true))
__device__ __forceinline__ float p9_reduce32(float (&a)[32], const int lane) {
#pragma unroll
    for (int e = 0; e < 16; ++e) P9_SWAP32(a[e], a[e + 16]);
#pragma unroll
    for (int e = 0; e < 8; ++e) P9_SWAP16(a[e], a[e + 8]);
    const bool b3 = (lane & 8) != 0, b2 = (lane & 4) != 0, b0 = (lane & 1) != 0;
#pragma unroll
    for (int e = 0; e < 4; ++e) { const float keep = b3 ? a[e + 4] : a[e], send = b3 ? a[e] : a[e + 4]; a[e] = keep + P9_DPPF(send, 0x128); }
#pragma unroll
    for (int e = 0; e < 2; ++e) { const float keep = b2 ? a[e + 2] : a[e], send = b2 ? a[e] : a[e + 2]; a[e] = keep + P9_DPPF(send, 0x141); }
    { const float keep = b0 ? a[1] : a[0], send = b0 ? a[0] : a[1]; a[0] = keep + P9_DPPF(send, 0xB1); }
    return a[0] + P9_DPPF(a[0], 0x4E);
}
__device__ __forceinline__ unsigned p9_wmax(unsigned v) {
    v = max(v, P9_DPPU(v, 0xB1)); v = max(v, P9_DPPU(v, 0x4E)); v = max(v, P9_DPPU(v, 0x124)); v = max(v, P9_DPPU(v, 0x128));
    const unsigned s0 = __builtin_amdgcn_readlane(v, 0), s1 = __builtin_amdgcn_readlane(v, 16), s2 = __builtin_amdgcn_readlane(v, 32), s3 = __builtin_amdgcn_readlane(v, 48);
    return max(max(s0, s1), max(s2, s3)); }
__device__ __forceinline__ void p8_postmix_router(Frame& F, const ArgsD& A, const int cset) {
    const int lane = lane_id_v(), tid = F.wave * 64 + lane; (void)tid;
    LAS float* rw = (LAS float*)(F.lds + RING_OFF);
    volatile LAS int* lcnt = (volatile LAS int*)(F.lds + LDSCTL_OFF);
    { const float* r = (const float*)A.in[27]; for (int i = tid; i < 1024 * 32; i += 512) { const int k = i >> 5, e = i & 31; rw[e * 1024 + k] = r[i]; } }
    if (tid < 32) lcnt[tid] = 0;
    __syncthreads();
    const float* x = (const float*)A.in[0]; const bf16* Y = (const bf16*)(F.ws + WS_Y); const float* mod = (const float*)(F.ws + WS_MOD);
    const float* pmn = (const float*)A.in[6]; const float* pfn = (const float*)A.in[7]; const float* rb = (const float*)A.in[28];
    unsigned char* H2 = F.ws + WS_H2; int* tokE = (int*)(F.ws + WS_TOKE); float* tokG = (float*)(F.ws + WS_TOKG);
    const int rows_per = M / F.G, mbeg = F.vcu * rows_per, b = mbeg >> 12; const float* mb_ = mod + (size_t)b * NMOD;
    f32x4 a1[4], a2[4], sh[4];
#pragma unroll
    for (int j = 0; j < 4; ++j) { const int col = 4 * lane + 256 * j; a1[j] = *(const f32x4*)(pmn + col) * *(const f32x4*)(mb_ + 2048 + col); a2[j] = *(const f32x4*)(pfn + col) * (*(const f32x4*)(mb_ + 4096 + col) + 1.f); sh[j] = *(const f32x4*)(mb_ + 3072 + col); }
    const int myexp = 8 * (lane >> 4) + 4 * ((lane >> 3) & 1) + 2 * ((lane >> 2) & 1) + (lane & 1); const float rbias = rb[myexp];
    const int nr = rows_per / NWAVES, m0 = mbeg + F.wave * nr;
    u32x2 yp[2][4]; f32x4 xp[2][4];
#define P9_LOAD(m_) do { _Pragma("unroll") for (int t_ = 0; t_ < 2; ++t_) _Pragma("unroll") for (int j_ = 0; j_ < 4; ++j_) { \
        yp[t_][j_] = *((const GAS u32x2*)(Y + (size_t)((m_) + t_) * D) + lane + 64 * j_); xp[t_][j_] = *((const GAS f32x4*)(x + (size_t)((m_) + t_) * D) + lane + 64 * j_); } } while (0)
    P9_LOAD(m0);
    for (int i = 0; i < nr; i += 2) { const int m = m0 + i;
        f32x4 xv[2][4];
#pragma unroll
        for (int t = 0; t < 2; ++t) { f32x4 yv[4]; float s2 = 0.f;
#pragma unroll
            for (int j = 0; j < 4; ++j) { const u32x2 p = yp[t][j]; yv[j] = (f32x4){bflo(p.x), bfhi(p.x), bflo(p.y), bfhi(p.y)}; s2 += (yv[j].x * yv[j].x + yv[j].y * yv[j].y) + (yv[j].z * yv[j].z + yv[j].w * yv[j].w); }
            const float rs = __builtin_amdgcn_rsqf(wave_sum(s2) * (1.f / D) + 1e-6f); float t2 = 0.f;
#pragma unroll
            for (int j = 0; j < 4; ++j) { xv[t][j] = xp[t][j] + a1[j] * (yv[j] * rs); *((GAS f32x4*)(F.out + (size_t)(m + t) * D) + lane + 64 * j) = xv[t][j];
                t2 += (xv[t][j].x * xv[t][j].x + xv[t][j].y * xv[t][j].y) + (xv[t][j].z * xv[t][j].z + xv[t][j].w * xv[t][j].w); }
            const float rs2 = __builtin_amdgcn_rsqf(wave_sum(t2) * (1.f / D) + 1e-6f);
#pragma unroll
            for (int j = 0; j < 4; ++j) { xv[t][j] = xv[t][j] * rs2 * a2[j] + sh[j]; *((GAS unsigned*)(H2 + (size_t)(m + t) * D) + lane + 64 * j) = pg8::pk4_fp8(xv[t][j].x, xv[t][j].y, xv[t][j].z, xv[t][j].w); } }
        if (i + 2 < nr) P9_LOAD(m + 2);
        float ac0[32], ac1[32];
#pragma unroll
        for (int e = 0; e < 32; ++e) { float s0 = 0.f, s1 = 0.f;
#pragma unroll
            for (int j = 0; j < 4; ++j) { const f32x4 w = *(const LAS f32x4*)(rw + e * 1024 + 4 * lane + 256 * j);
                s0 += (xv[0][j].x * w.x + xv[0][j].y * w.y) + (xv[0][j].z * w.z + xv[0][j].w * w.w); s1 += (xv[1][j].x * w.x + xv[1][j].y * w.y) + (xv[1][j].z * w.z + xv[1][j].w * w.w); }
            ac0[e] = s0; ac1[e] = s1; }
        const float lg[2] = {p9_reduce32(ac0, lane) + rbias, p9_reduce32(ac1, lane) + rbias};
#pragma unroll
        for (int t = 0; t < 2; ++t) { const unsigned u = __float_as_uint(lg[t]); unsigned key = (((u >> 31) ? ~u : (u | 0x80000000u)) & ~31u) | (unsigned)(31 - myexp);
            float tv[4]; int ti[4];
#pragma unroll
            for (int k = 0; k < 4; ++k) { const unsigned mx = p9_wmax(key); ti[k] = 31 - (int)(mx & 31u); const unsigned kv = mx & ~31u; tv[k] = __uint_as_float((kv >> 31) ? (kv & 0x7fffffffu) : ~kv); if (key == mx) key = 0u; }
            float ew[4], es = 0.f;
#pragma unroll
            for (int k = 0; k < 4; ++k) { ew[k] = __expf(tv[k] - tv[0]); es += ew[k]; }
            if (lane < 4) { const int e = (lane == 0) ? ti[0] : (lane == 1) ? ti[1] : (lane == 2) ? ti[2] : ti[3]; const float g = ((lane == 0) ? ew[0] : (lane == 1) ? ew[1] : (lane == 2) ? ew[2] : ew[3]) / es;
                const int pos = __hip_atomic_fetch_add((LAS int*)lcnt + e, 1, __ATOMIC_RELAXED, __HIP_MEMORY_SCOPE_WORKGROUP);
                tokE[(size_t)(m + t) * 4 + lane] = e | (pos << 8); tokG[(size_t)(m + t) * 4 + lane] = g; } }
    }
#undef P9_LOAD
    __syncthreads();
    if (tid < 32) { const int n = lcnt[tid]; int base = 0; if (n > 0) base = (int)__hip_atomic_fetch_add(F.ctl + CW_ECNT + cset * 64 * NEXP + 64 * tid, (unsigned)n, __ATOMIC_RELAXED, __HIP_MEMORY_SCOPE_AGENT);
        ((int*)(F.ws + WS_BLKBASE))[F.vcu * 32 + tid] = base; }
}

__device__ __forceinline__ void moe_tables(Frame& F) {
    const int lane = lane_id_v(), tid = F.wave * 64 + lane; (void)tid;
    volatile LAS int* ts = (volatile LAS int*)(F.lds + LDSCTL_OFF);
    if (tid < 32) ts[40 + tid] = (int)__hip_atomic_load(F.ctl + CW_ECNT + 64 * tid, __ATOMIC_RELAXED, __HIP_MEMORY_SCOPE_AGENT);
    __syncthreads();
    if (tid == 0) { int acc = 0; for (int e = 0; e < 32; ++e) { ts[e] = acc; acc += (ts[40 + e] + 255) >> 8; } ts[32] = acc; }
    __syncthreads();
}
__device__ __forceinline__ void p9_rows(Frame& F) {
    const int lane = lane_id_v(), tid = F.wave * 64 + lane; (void)tid;
    moe_tables(F);
    volatile LAS int* ts = (volatile LAS int*)(F.lds + LDSCTL_OFF);
    const int* tokE = (const int*)(F.ws + WS_TOKE); const float* tokG = (const float*)(F.ws + WS_TOKG); const int* blkbase = (const int*)(F.ws + WS_BLKBASE) + F.vcu * 32;
    int* tokrow = (int*)(F.ws + WS_TOKROW); int* rowtok = (int*)(F.ws + WS_ROWTOK); float* rowgate = (float*)(F.ws + WS_ROWGATE);
    const int rows_per = M / F.G, mbeg = F.vcu * rows_per;
    for (int i = tid; i < rows_per * 4; i += 512) { const int idx = mbeg * 4 + i; const int pe = tokE[idx], e = pe & 255, pos = pe >> 8; const int row = ts[e] * 256 + blkbase[e] + pos;
        tokrow[idx] = row; rowtok[row] = idx >> 2; rowgate[row] = tokG[idx]; }
    for (int e = F.vcu; e < 32; e += F.G) { const int n = ts[40 + e]; const int r0 = ts[e] * 256 + n, r1 = ts[e + 1] * 256;
        for (int r = r0 + tid; r < r1; r += 512) { rowtok[r] = 0; rowgate[r] = 0.f; } }
}

__device__ __forceinline__ void p12_final(Frame& F, const ArgsD& A, float* dst) {
    const int lane = lane_id_v(), tid = F.wave * 64 + lane; (void)tid;
    const bf16* Y2 = (const bf16*)(F.ws + WS_Y2); const int* tokrow = (const int*)(F.ws + WS_TOKROW); const float* mod = (const float*)(F.ws + WS_MOD); const float* pn = (const float*)A.in[8];
    const int rows_per = M / F.G, mbeg = F.vcu * rows_per, b = mbeg >> 12, nr = rows_per / NWAVES, m0 = mbeg + F.wave * nr;
    const float* mb_ = mod + (size_t)b * NMOD + 5120;
    f32x4 gw[4];
#pragma unroll
    for (int j = 0; j < 4; ++j) { const int col = 4 * lane + 256 * j; gw[j] = *(const f32x4*)(pn + col) * *(const f32x4*)(mb_ + col); }
    const int myrow = tokrow[(size_t)m0 * 4 + (lane < nr * 4 ? lane : 0)];
    u32x2 yp[4][4]; f32x4 xp[4];
#define P13_LOAD(i_) do { _Pragma("unroll") for (int k_ = 0; k_ < 4; ++k_) { const int row_ = __builtin_amdgcn_readlane(myrow, 4 * (i_) + k_); \
        _Pragma("unroll") for (int j_ = 0; j_ < 4; ++j_) yp[k_][j_] = *((const GAS u32x2*)(Y2 + (size_t)row_ * D) + lane + 64 * j_); } \
        _Pragma("unroll") for (int j_ = 0; j_ < 4; ++j_) xp[j_] = *((const GAS f32x4*)(F.out + (size_t)(m0 + (i_)) * D) + lane + 64 * j_); } while (0)
    P13_LOAD(0);
#pragma unroll 1
    for (int i = 0; i < nr; ++i) { const int m = m0 + i;
        f32x4 a[4], xv[4]; float s2 = 0.f;
#pragma unroll
        for (int j = 0; j < 4; ++j) { a[j] = (f32x4){0.f, 0.f, 0.f, 0.f};
#pragma unroll
            for (int k = 0; k < 4; ++k) { const u32x2 p = yp[k][j]; a[j] = a[j] + (f32x4){bflo(p.x), bfhi(p.x), bflo(p.y), bfhi(p.y)}; }
            s2 += (a[j].x * a[j].x + a[j].y * a[j].y) + (a[j].z * a[j].z + a[j].w * a[j].w); xv[j] = xp[j]; }
        if (i + 1 < nr) { const int in_ = __builtin_amdgcn_readfirstlane(i + 1);
#pragma unroll
            for (int k_ = 0; k_ < 4; ++k_) { const int row_ = __shfl(myrow, 4 * in_ + k_);
#pragma unroll
                for (int j_ = 0; j_ < 4; ++j_) yp[k_][j_] = *((const GAS u32x2*)(Y2 + (size_t)row_ * D) + lane + 64 * j_); }
#pragma unroll
            for (int j_ = 0; j_ < 4; ++j_) xp[j_] = *((const GAS f32x4*)(F.out + (size_t)(m + 1) * D) + lane + 64 * j_); }
        const float rs = __builtin_amdgcn_rsqf(wave_sum(s2) * (1.f / D) + 1e-6f);
#pragma unroll
        for (int j = 0; j < 4; ++j) *((GAS f32x4*)(dst + (size_t)m * D) + lane + 64 * j) = xv[j] + gw[j] * (a[j] * rs); }
#undef P13_LOAD
}
__global__ void __launch_bounds__(NWAVES * 64, 2) hybrid_fwd(Args kargs) {
    const ArgsD args{};
    extern __shared__ __attribute__((aligned(16))) unsigned char lds[];
    Frame F;
    F.lds = (LAS unsigned char*)lds;
    F.MISC = (volatile LAS unsigned*)(F.lds + MISC_OFF);
    F.wave = __builtin_amdgcn_readfirstlane((int)threadIdx.x >> 6);
    F.G = gridDim.x; { const int bx = blockIdx.x; F.vcu = (F.G % 8 == 0) ? (bx % 8) * (F.G / 8) + bx / 8 : bx; }
    F.ws = kargs.ws; F.out = kargs.out;
    unsigned char* ws = kargs.ws;
    F.ctl = (gu32*)(ws + WS_CTL);
#define GRID_BAR(seam) do { if (N_LAUNCHES != 1) { if (F.wave == 0 && lane_id_v() == 0) __hip_atomic_store(F.ctl + CW_TMO, 0xBADBA0u | (unsigned)(seam), RLX_AGENT); } else { xcd_barrier(bar); } } while (0)
    for (int u = threadIdx.x; u < (LDS_BYTES - LDSCTL_OFF) / 4; u += NWAVES * 64) ((LAS unsigned*)(F.lds + LDSCTL_OFF))[u] = 0u;
    __syncthreads();
    XcdBarrier bar; bar.bar = (unsigned*)(F.ctl + CW_BAR); bar.x = 0; bar.st = nullptr; bar.wid = F.wave;
    if (N_LAUNCHES == 1) bar = xcd_barrier_post((unsigned*)(F.ctl + CW_BAR), F.MISC + 8, F.wave);
    const int lo = kargs.ph_lo, hi = kargs.ph_hi;
#define IN(k) (lo <= (k) && (k) < hi)
#define PREP(k) (((PROBE_MASK) >> (k)) & 1)
#define BOTH(k) (IN(k) && IN((k) + 1))
    bf16* const H = (bf16*)(ws + WS_H); bf16* const H2 = (bf16*)(ws + WS_H2);

    if (IN(0)) { _Pragma("unroll 1") for (int r_ = 0; r_ <= PREP(0); ++r_) { p0_prologue(F, args); } if (BOTH(0)) GRID_BAR(0); }
    if (IN(1)) { _Pragma("unroll 1") for (int r_ = 0; r_ <= PREP(1); ++r_) { p1_premix(F, args); } if (BOTH(1)) GRID_BAR(1); }
    if (IN(2)) {
        pg8::Gemm g{H, (const bf16*)(ws + WS_WIN), M, IN_COLS, D, 0, nullptr, ws}; pg8::StaticOrder S; S.init(M, IN_COLS, F.G, (int)blockIdx.x);
        pg8::EpiProj E{(bf16*)(ws + WS_Q), (bf16*)(ws + WS_K), (bf16*)(ws + WS_V), (bf16*)(ws + WS_RW), (const float*)(ws + WS_ROPE), attn_body::C2};
        if (PREP(2)) { pg8::gemm_phase<pg8::EpiProj, pg8::StaticOrder, true, true, false>(F.lds + RING_OFF, g, S, E, F.wave); GRID_BAR(102); }
        pg8::gemm_phase<pg8::EpiProj, pg8::StaticOrder, true, true, false>(F.lds + RING_OFF, g, S, E, F.wave);
        if (BOTH(2)) GRID_BAR(2);
    }
    if (IN(3)) { _Pragma("unroll 1") for (int r_ = 0; r_ <= PREP(3); ++r_) { p3_lact(F, args); } if (BOTH(3)) GRID_BAR(3); }
    if (IN(4)) {
        pg8::Gemm g{(const bf16*)(ws + WS_LACT), (const bf16*)(ws + WS_BLORA), M, 1536, 256, 0, nullptr, ws}; pg8::StaticOrder S; S.init(M, 1536, F.G, (int)blockIdx.x);
        pg8::EpiLora E{(bf16*)(ws + WS_LW), (size_t)(WS_AS - WS_LW) / 2, (const float*)args.in[17], (const float*)args.in[19]}; static_assert(WS_G - WS_AS == WS_AS - WS_LW, "LW | AS | G equally spaced");
        if (PREP(4)) { pg8::gemm_phase<pg8::EpiLora, pg8::StaticOrder, true, true, false>(F.lds + RING_OFF, g, S, E, F.wave); GRID_BAR(104); }
        pg8::gemm_phase<pg8::EpiLora, pg8::StaticOrder, true, true, false>(F.lds + RING_OFF, g, S, E, F.wave);
        if (BOTH(4)) GRID_BAR(4);
    }
    if (IN(5)) {
        _Pragma("unroll 1") for (int r_ = 0; r_ <= PREP(5); ++r_)
            for (int u = F.vcu; u < BATCH * 8 * 4; u += F.G) rwkv_pre(F, args, u >> 2, (u & 3) * 16, (u & 3) * 16 + 16);
        if (BOTH(5)) GRID_BAR(5);
    }
    if (IN(6)) {
        _Pragma("unroll 1") for (int r_ = 0; r_ <= PREP(14); ++r_)
            for (int bh = blockIdx.x; bh < BATCH * 8; bh += F.G) rwkv_seq(F, args, bh);
        static_assert(attn_body::ATTN_LDS_BYTES <= RING_BYTES, "attention body geometry vs frame");
        const attn_body::AttnTensors AT{(const attn_body::bf16*)(ws + WS_Q), (const attn_body::bf16*)(ws + WS_K), (const attn_body::bf16*)(ws + WS_V), (attn_body::bf16*)(ws + WS_O)};
        if (PREP(15)) { const attn_body::QueueOrder S0{(unsigned*)(F.ctl + CW_ATTQ + 64), F.MISC + 12, F.wave}; attn_body::attn_phase<attn_body::QueueOrder>((char*)lds + RING_OFF, AT, S0, F.wave); GRID_BAR(106); }
        const attn_body::QueueOrder S{(unsigned*)(F.ctl + CW_ATTQ), F.MISC + 12, F.wave};
        attn_body::attn_phase<attn_body::QueueOrder>((char*)lds + RING_OFF, AT, S, F.wave);
        if (BOTH(6)) GRID_BAR(6);
    }
    if (IN(7)) { _Pragma("unroll 1") for (int r_ = 0; r_ <= PREP(7); ++r_) { p6_dacombine(F, args); } if (BOTH(7)) GRID_BAR(7); }
    if (IN(8)) {
        pg8::Gemm g{(const bf16*)(ws + WS_YCAT), (const bf16*)(ws + WS_WOUT), M, D, D, 0, nullptr, ws}; pg8::StaticOrder S; S.init(M, D, F.G, (int)blockIdx.x);
        pg8::EpiPlain E{(bf16*)(ws + WS_Y), D};
        if (PREP(8)) { pg8::gemm_phase<pg8::EpiPlain, pg8::StaticOrder, true, true, false>(F.lds + RING_OFF, g, S, E, F.wave); GRID_BAR(108); }
        pg8::gemm_phase<pg8::EpiPlain, pg8::StaticOrder, true, true, false>(F.lds + RING_OFF, g, S, E, F.wave);
        if (BOTH(8)) GRID_BAR(8);
    }
    if (IN(9)) { _Pragma("unroll 1") for (int r_ = PREP(9); r_ >= 0; --r_) { p8_postmix_router(F, args, r_); } if (BOTH(9)) GRID_BAR(9); }
    if (IN(10)) { _Pragma("unroll 1") for (int r_ = 0; r_ <= PREP(10); ++r_) { p9_rows(F); } if (BOTH(10)) GRID_BAR(10); }
    if (IN(11)) {
        moe_tables(F);
        const LAS int* ts = (const LAS int*)(F.lds + LDSCTL_OFF);
        pg8::Gemm g{H2, (const bf16*)(ws + WS_W1), MAXROWS, 2048, D / 2, (size_t)2048 * D, (const int*)(ws + WS_ROWTOK), ws};
        pg8::MoeOrder S{__builtin_amdgcn_readfirstlane(ts[32]), 8, 4, F.G, F.vcu, ts};
        pg8::EpiSwiglu E{ws + WS_ACT, (const float*)args.in[30]};
        if (PREP(11)) { pg8::gemm_phase<pg8::EpiSwiglu, pg8::MoeOrder, true, true, true, true>(F.lds + RING_OFF, g, S, E, F.wave); GRID_BAR(111); }
        pg8::gemm_phase<pg8::EpiSwiglu, pg8::MoeOrder, true, true, true, true>(F.lds + RING_OFF, g, S, E, F.wave);
        if (BOTH(11)) GRID_BAR(11);
    }
    if (IN(12)) {
        moe_tables(F);
        const LAS int* ts = (const LAS int*)(F.lds + LDSCTL_OFF);
        pg8::Gemm g{(const bf16*)(ws + WS_ACT), (const bf16*)(ws + WS_W2), MAXROWS, D, D / 2, (size_t)D * D, nullptr, ws};
        pg8::MoeOrder S{__builtin_amdgcn_readfirstlane(ts[32]), 4, 8, F.G, F.vcu, ts};
        pg8::EpiMoe2 E{(bf16*)(ws + WS_Y2), (const float*)args.in[32], (const float*)(ws + WS_ROWGATE)};
        if (PREP(12)) { pg8::gemm_phase<pg8::EpiMoe2, pg8::MoeOrder, true, true, false, true>(F.lds + RING_OFF, g, S, E, F.wave); GRID_BAR(112); }
        pg8::gemm_phase<pg8::EpiMoe2, pg8::MoeOrder, true, true, false, true>(F.lds + RING_OFF, g, S, E, F.wave);
        if (BOTH(12)) GRID_BAR(12);
    }
    if (IN(13)) { _Pragma("unroll 1") for (int r_ = PREP(13); r_ >= 0; --r_) { p12_final(F, args, r_ ? (float*)(ws + WS_G) : F.out); } }
#undef IN
#undef PREP
#undef BOTH
}

extern "C" void kernel_launch(void* const* d_in, const int* in_sizes, int n_in, void* d_out, int out_size, void* d_ws, size_t ws_size, hipStream_t stream) {
    static int grid = 0;
    if (grid == 0) {
        if (n_in != 33 || in_sizes[0] != M * D || out_size != M * D || ws_size < WS_END) { fprintf(stderr, "kernel_launch: built for 33 inputs, x and out of %d floats, >= %zu bytes of workspace; got n_in %d, in0 %d, out %d, ws %zu; nothing launched\n", M * D, (size_t)WS_END, n_in, n_in > 0 ? in_sizes[0] : -1, out_size, ws_size); grid = -1; return; }
        int dev = 0, cus = 0, per_cu = 0;
        if (hipGetDevice(&dev) != hipSuccess || hipDeviceGetAttribute(&cus, hipDeviceAttributeMultiprocessorCount, dev) != hipSuccess) { fprintf(stderr, "kernel_launch: hipGetDevice / hipDeviceGetAttribute failed; nothing launched\n"); grid = -1; return; }
        if (hipFuncSetAttribute((const void*)hybrid_fwd, hipFuncAttributeMaxDynamicSharedMemorySize, LDS_BYTES) != hipSuccess) { fprintf(stderr, "kernel_launch: hipFuncSetAttribute failed; nothing launched\n"); grid = -1; return; }
        if (hipOccupancyMaxActiveBlocksPerMultiprocessor(&per_cu, (const void*)hybrid_fwd, NWAVES * 64, LDS_BYTES) != hipSuccess || per_cu < 1)
            fprintf(stderr, "kernel_launch: note: the occupancy query reports %d workgroups per CU\n", per_cu);
        (void)hipGetLastError();
        grid = (cus >= 256) ? 256 : (cus / 32) * 32;
        if (grid != 256) fprintf(stderr, "kernel_launch: launching %d workgroups (built and checked for 256)\n", grid);
    }
    if (grid <= 0) return;
    if (hipMemsetAsync((char*)d_ws + WS_CTL, 0, CTL_ZERO_BYTES, stream) != hipSuccess) { fprintf(stderr, "kernel_launch: hipMemsetAsync of the control words failed; nothing launched\n"); return; }
    Args a{};
    for (int i = 0; i < 33; ++i) a.in[i] = d_in[i];
    a.out = (float*)d_out; a.ws = (unsigned char*)d_ws;
    for (int li = 0; li < N_LAUNCHES; ++li) {
        a.ph_lo = (N_LAUNCHES == 1) ? 0 : li; a.ph_hi = (N_LAUNCHES == 1) ? N_PHASES : li + 1; a.li = li; a.pad = 0;
        hipLaunchKernelGGL(hybrid_fwd, dim3(grid), dim3(NWAVES * 64), LDS_BYTES, stream, a);
        const hipError_t le = hipPeekAtLastError();
        if (le != hipSuccess) { fprintf(stderr, "kernel_launch: launch %d failed: %s\n", li, hipGetErrorName(le)); break; }
    }
}
```

```cpp
#include <hip/hip_runtime.h>
#include <cstdio>
#include <cstdint>
__device__ __forceinline__ int lane_id_v() { int l; asm volatile("v_mbcnt_lo_u32_b32 %0, -1, 0\n\tv_mbcnt_hi_u32_b32 %0, -1, %0" : "=v"(l)); return l; }
namespace pg8 {
#define PG8_LAS __attribute__((address_space(3)))
typedef unsigned short bf16_t;
typedef short bf16x8 __attribute__((ext_vector_type(8)));
typedef float f32x4 __attribute__((ext_vector_type(4)));
typedef unsigned u32x4 __attribute__((ext_vector_type(4)));
typedef int v4i_t __attribute__((ext_vector_type(4)));
typedef int v8i_t __attribute__((ext_vector_type(8)));
typedef v8i_t v8i_a16 __attribute__((aligned(16)));
union frag2_t { bf16x8 pc[2]; v8i_t w; };
constexpr int BM = 256, BK = 64, HALF = 128, HTB = HALF * BK * 2  , STAGE_BYTES = 8 * HTB, NXCD = 8, WGM = 8;

__host__ __device__ __forceinline__ int lds_byte(int r, int c) { const int st = (r >> 4) * 2 + (c >> 5), rr = r & 15, cc = c & 31, ob = rr * 64 + cc * 2; return st * 1024 + (ob ^ (((ob >> 9) & 1) << 5)); }
__host__ __device__ __forceinline__ void stage_rc(int b, int& R, int& C) { const int st = b / 1024, sb = b % 1024, swz = sb ^ (((sb >> 9) & 1) << 5); R = (st >> 1) * 16 + swz / 64; C = (st & 1) * 32 + (swz % 64) / 2; }
__host__ __device__ __forceinline__ int perm32(int rho) { const int n = rho >> 4, i = rho & 15; return 8 * (i >> 2) + 4 * n + (i & 3); }

struct Unit { int pm, pn, e; };
struct Gemm { const bf16_t* A; const bf16_t* Bt; int M, N, K; size_t bstride; const int* rowidx; const void* base; };

struct StaticOrder {
    int nM, nN, nwg, G, c;
    __host__ __device__ void init(int M, int N, int G_, int c_) { nM = M / BM; nN = N / BM; nwg = nM * nN; G = G_; c = c_; }
    __host__ __device__ bool next(int i, Unit& u) const {
        const long L = (long)i * G + c; if (L >= nwg) return false;
        int wgid = (int)L; { const int q = nwg / NXCD, r = nwg % NXCD, xcd = wgid % NXCD, off = wgid / NXCD; wgid = (xcd < r ? xcd * (q + 1) : r * (q + 1) + (xcd - r) * q) + off; }
        const int nig = WGM * nN, gid = wgid / nig, fm = gid * WGM, gsz = (nM - fm) < WGM ? (nM - fm) : WGM;
        u.pm = fm + ((wgid % nig) % gsz); u.pn = (wgid % nig) / gsz; u.e = 0; return true;
    }
    __device__ __forceinline__ void a_ready(const Unit&) const {}
    __device__ __forceinline__ void done(const Unit&) const {}
};

__device__ __forceinline__ unsigned cvt_pk_bf16(float lo, float hi) { unsigned r; asm volatile("v_cvt_pk_bf16_f32 %0, %1, %2" : "=v"(r) : "v"(lo), "v"(hi)); return r; }
typedef float f32x2 __attribute__((ext_vector_type(2)));
typedef unsigned u32x2 __attribute__((ext_vector_type(2)));
__device__ __forceinline__ float sigmoidf_(float x) { return __builtin_amdgcn_rcpf(1.f + __expf(-x)); }

struct MoeOrder {
    int ntiles, nN, RG, G, c; const PG8_LAS int* tstart;
    __device__ __forceinline__ bool next(int i, Unit& u) const {
        const int L = i * G + c, grp = L >> 5, idx = L & 31; u.pn = idx / RG; u.pm = grp * RG + idx % RG; u.e = 0;
        if (u.pm >= ntiles) return false;
        int e = 0;
#pragma unroll
        for (int k = 16; k >= 1; k >>= 1) { if (tstart[e + k] <= u.pm) e += k; }
        u.e = __builtin_amdgcn_readfirstlane(e); return true;
    }
    __device__ __forceinline__ void a_ready(const Unit&) const {}
    __device__ __forceinline__ void done(const Unit&) const {}
};

#define PG8_PACK8(v0, v1) (u32x4){cvt_pk_bf16((v0)[0], (v0)[1]), cvt_pk_bf16((v0)[2], (v0)[3]), cvt_pk_bf16((v1)[0], (v1)[1]), cvt_pk_bf16((v1)[2], (v1)[3])}

struct EpiPlain {
    static constexpr bool PERM = true, AFTER_DRAIN = false;
    bf16_t* O; int ldc;
    __device__ __forceinline__ void operator()(const f32x4 (&acc)[2][2][4][2], const Unit& u, int wr, int wc, int fr, int fq) const {
        const int row0 = u.pm * BM + wr * 64 + fr, col0 = u.pn * BM + wc * 32 + 8 * fq;
#pragma unroll
        for (int ai = 0; ai < 2; ++ai)
#pragma unroll
            for (int m = 0; m < 4; ++m) { bf16_t* rowp = O + (size_t)(row0 + ai * HALF + m * 16) * ldc + col0;
#pragma unroll
                for (int bj = 0; bj < 2; ++bj) { const f32x4 v0 = acc[ai][bj][m][0], v1 = acc[ai][bj][m][1]; *(u32x4*)(rowp + bj * HALF) = PG8_PACK8(v0, v1); } }
    }
};

struct EpiProj {
    static constexpr bool PERM = true, AFTER_DRAIN = false;
    bf16_t *Q, *K, *V, *RW; const float* rope; float qscale;
    __device__ __forceinline__ void operator()(const f32x4 (&acc)[2][2][4][2], const Unit& u, int wr, int wc, int fr, int fq) const {
        const int row0 = u.pm * BM + wr * 64 + fr, cl = wc * 32 + 8 * fq, pn = u.pn;
        if (pn < 4) {
            bf16_t* base = (pn < 2) ? Q : K; const int colt = (pn & 1) * 256; const float sc = (pn < 2) ? qscale : 1.f;
            const bool rp = ((wc & 1) == 0) && (fq < 2);
#pragma unroll
            for (int ai = 0; ai < 2; ++ai)
#pragma unroll
                for (int m = 0; m < 4; ++m) { const int row = row0 + ai * HALF + m * 16;
                    f32x4 cs = (f32x4){1.f, 1.f, 1.f, 1.f}, sn = (f32x4){0.f, 0.f, 0.f, 0.f};
                    if (rp) { cs = *(const f32x4*)(rope + (size_t)row * 16 + 4 * fq); sn = *(const f32x4*)(rope + (size_t)row * 16 + 8 + 4 * fq); }
#pragma unroll
                    for (int bj = 0; bj < 2; ++bj) { f32x4 v0 = acc[ai][bj][m][0], v1 = acc[ai][bj][m][1];
                        { const float a0 = v0[0], b0 = v0[1], a1 = v0[2], b1 = v0[3], a2 = v1[0], b2 = v1[1], a3 = v1[2], b3 = v1[3];
                          v0[0] = a0 * cs[0] - b0 * sn[0]; v0[1] = b0 * cs[0] + a0 * sn[0]; v0[2] = a1 * cs[1] - b1 * sn[1]; v0[3] = b1 * cs[1] + a1 * sn[1];
                          v1[0] = a2 * cs[2] - b2 * sn[2]; v1[1] = b2 * cs[2] + a2 * sn[2]; v1[2] = a3 * cs[3] - b3 * sn[3]; v1[3] = b3 * cs[3] + a3 * sn[3]; }
                        v0 = v0 * sc; v1 = v1 * sc;
                        *(u32x4*)(base + (size_t)row * 512 + colt + bj * HALF + cl) = PG8_PACK8(v0, v1); } }
        } else {
            bf16_t* base; int ld, colt;
            if (pn < 6) { base = V; ld = 512; colt = (pn - 4) * 256; } else { base = RW; ld = 1792; colt = (pn - 6) * 256; }
#pragma unroll
            for (int ai = 0; ai < 2; ++ai)
#pragma unroll
                for (int m = 0; m < 4; ++m) { bf16_t* rowp = base + (size_t)(row0 + ai * HALF + m * 16) * ld + colt + cl;
#pragma unroll
                    for (int bj = 0; bj < 2; ++bj) { const f32x4 v0 = acc[ai][bj][m][0], v1 = acc[ai][bj][m][1]; *(u32x4*)(rowp + bj * HALF) = PG8_PACK8(v0, v1); } }
        }
    }
};

struct EpiLora {
    static constexpr bool PERM = true, AFTER_DRAIN = false;
    bf16_t* LW; size_t kstride; const float *w0, *a0;
    __device__ __forceinline__ void operator()(const f32x4 (&acc)[2][2][4][2], const Unit& u, int wr, int wc, int fr, int fq) const {
        const int row0 = u.pm * BM + wr * 64 + fr, kind = u.pn >> 1, col0 = (u.pn & 1) * 256 + wc * 32 + 8 * fq;
        bf16_t* dst = LW + (size_t)kind * kstride; const float* bias = (kind == 1) ? a0 : w0;
        f32x4 bv[2][2];
#pragma unroll
        for (int bj = 0; bj < 2; ++bj)
#pragma unroll
            for (int n = 0; n < 2; ++n) bv[bj][n] = (kind < 2) ? *(const f32x4*)(bias + col0 + bj * HALF + 4 * n) : (f32x4){0.f, 0.f, 0.f, 0.f};
#pragma unroll
        for (int ai = 0; ai < 2; ++ai)
#pragma unroll
            for (int m = 0; m < 4; ++m) { bf16_t* rowp = dst + (size_t)(row0 + ai * HALF + m * 16) * 512 + col0;
#pragma unroll
                for (int bj = 0; bj < 2; ++bj) { f32x4 vv[2];
#pragma unroll
                    for (int n = 0; n < 2; ++n) { f32x4 v = acc[ai][bj][m][n] + bv[bj][n];
                        if (kind == 0) {
#pragma unroll
                            for (int q = 0; q < 4; ++q) { const float z = -v[q]; const float sp = fmaxf(z, 0.f) + __logf(1.f + __expf(-fabsf(z))); v[q] = -__expf(-sp - 0.5f); }
                        } else if (kind == 1) {
#pragma unroll
                            for (int q = 0; q < 4; ++q) v[q] = sigmoidf_(v[q]);
                        }
                        vv[n] = v; }
                    *(u32x4*)(rowp + bj * HALF) = PG8_PACK8(vv[0], vv[1]); } }
    }
};

__device__ __forceinline__ unsigned pk4_fp8(float a, float b, float c_, float d) { int r = __builtin_amdgcn_cvt_pk_fp8_f32(a, b, 0, false); r = __builtin_amdgcn_cvt_pk_fp8_f32(c_, d, r, true); return (unsigned)r; }
constexpr float W8_SCALE = 32.f, W8_INV = 1.f / 32.f;
struct EpiSwiglu {
    static constexpr bool PERM = true, AFTER_DRAIN = false;
    unsigned char* ACT; const float* b1;
    __device__ __forceinline__ void operator()(const f32x4 (&acc)[2][2][4][2], const Unit& u, int wr, int wc, int fr, int fq) const {
        const int row0 = u.pm * BM + wr * 64 + fr, col0 = u.pn * BM + wc * 32 + 8 * fq;
        f32x4 bv[2][2];
#pragma unroll
        for (int bj = 0; bj < 2; ++bj)
#pragma unroll
            for (int n = 0; n < 2; ++n) bv[bj][n] = *(const f32x4*)(b1 + (size_t)u.e * 2048 + col0 + bj * HALF + 4 * n);
#pragma unroll
        for (int ai = 0; ai < 2; ++ai)
#pragma unroll
            for (int m = 0; m < 4; ++m) { unsigned char* rowp = ACT + (size_t)(row0 + ai * HALF + m * 16) * 1024 + (col0 >> 1);
#pragma unroll
                for (int bj = 0; bj < 2; ++bj) { const f32x4 v0 = acc[ai][bj][m][0] * W8_INV + bv[bj][0], v1 = acc[ai][bj][m][1] * W8_INV + bv[bj][1];
                    float o[4];
#pragma unroll
                    for (int q = 0; q < 4; ++q) { const float glu = (q < 2) ? v0[2 * q] : v1[2 * q - 4], lin = (q < 2) ? v0[2 * q + 1] : v1[2 * q - 3];
                        const float gg = fminf(glu, 7.f), ll = fminf(fmaxf(lin, -7.f), 7.f); o[q] = gg * sigmoidf_(1.702f * gg) * (ll + 1.f); }
                    *(unsigned*)(rowp + bj * (HALF / 2)) = pk4_fp8(o[0], o[1], o[2], o[3]); } }
    }
};

constexpr float Y8_SCALE = 32.f, Y8_INV = 1.f / 32.f;
struct EpiMoe2 {
    static constexpr bool PERM = true, AFTER_DRAIN = false;
    unsigned char* Y2; const float* b2; const float* gate;
    __device__ __forceinline__ void operator()(const f32x4 (&acc)[2][2][4][2], const Unit& u, int wr, int wc, int fr, int fq) const {
        const int row0 = u.pm * BM + wr * 64 + fr, col0 = u.pn * BM + wc * 32 + 8 * fq;
#pragma unroll
        for (int bj = 0; bj < 2; ++bj) { const f32x4 b0 = *(const f32x4*)(b2 + (size_t)u.e * 1024 + col0 + bj * HALF), b1 = *(const f32x4*)(b2 + (size_t)u.e * 1024 + col0 + bj * HALF + 4);
#pragma unroll
            for (int ai = 0; ai < 2; ++ai)
#pragma unroll
                for (int m = 0; m < 4; ++m) { const int row = row0 + ai * HALF + m * 16; const float gt = gate[row] * Y8_SCALE;
                    const f32x4 v0 = (acc[ai][bj][m][0] * W8_INV + b0) * gt, v1 = (acc[ai][bj][m][1] * W8_INV + b1) * gt;
                    *(u32x2*)(Y2 + (size_t)row * 1024 + col0 + bj * HALF) = (u32x2){pk4_fp8(v0[0], v0[1], v0[2], v0[3]), pk4_fp8(v1[0], v1[1], v1[2], v1[3])}; } }
    }
};

template <class Epi, class Sched, bool ALIGN_EPI = false, bool SP2 = false, bool GATHER = false, bool FP8 = false>
__device__ __forceinline__ void gemm_phase(PG8_LAS unsigned char* lds, const Gemm g, const Sched& S, const Epi& E, const int wid) {
    const int lane = lane_id_v(), tid = wid * 64 + lane, wr = wid >> 2, wc = wid & 3, fr = lane & 15, fq = lane >> 4;
    const int K = g.K, nt = K / BK;
    const __amdgpu_buffer_rsrc_t rsrc = __builtin_amdgcn_make_buffer_rsrc((void*)g.base, 0, 0x7fffffff, 0x00020000);
    unsigned voffA[2], voffB[2];
#pragma unroll
    for (int i = 0; i < 2; ++i) { int R, C; stage_rc(tid * 16 + i * 8192, R, C); const int Rb = Epi::PERM ? ((R & ~31) + perm32(R & 31)) : R;
        voffA[i] = (unsigned)(R * K + C) * 2u; voffB[i] = (unsigned)(Rb * K + C) * 2u; }
    const size_t kstep = (size_t)(BK * 2);
    const size_t hstep = (size_t)HALF * K * 2;
    const size_t tstep = 2 * hstep;
    const unsigned ldsw = (unsigned)wid * 1024u;
    const int aoff = FP8 ? lds_byte(wr * 64 + fr, fq * 16) : lds_byte(wr * 64 + fr, fq * 8), boff = FP8 ? lds_byte(wc * 32 + fr, fq * 16) : lds_byte(wc * 32 + fr, fq * 8);
    const PG8_LAS unsigned char* ldsA; const PG8_LAS unsigned char* ldsB;
    { unsigned a_ = (unsigned)(size_t)(lds + aoff), b_ = (unsigned)(size_t)(lds + 4 * HTB + boff); asm volatile("" : "+v"(a_), "+v"(b_)); ldsA = (const PG8_LAS unsigned char*)(size_t)a_; ldsB = (const PG8_LAS unsigned char*)(size_t)b_; }
#define PG8_SA(b, h) (((b) * 2 + (h)) * HTB)
#define PG8_SB(b, h) ((4 + (b) * 2 + (h)) * HTB)
#define PG8_STAGE(bufoff, gbase, voff) do { const unsigned so_ = (unsigned)((const char*)(gbase) - (const char*)g.base); _Pragma("unroll") for (int _i = 0; _i < 2; ++_i) \
        __builtin_amdgcn_raw_ptr_buffer_load_lds(rsrc, (PG8_LAS unsigned*)(lds + (bufoff) + ldsw + _i * 8192), 16, (voff)[_i], so_, 0, 0); } while (0)
#define PG8_STAGE_A(bufoff, ptr, h, nx) do { if constexpr (GATHER) { unsigned vo_[2]; vo_[0] = (nx) ? gn[h][0] : gc[h][0]; vo_[1] = (nx) ? gn[h][1] : gc[h][1]; PG8_STAGE(bufoff, ptr, vo_); } \
        else { PG8_STAGE(bufoff, (ptr) + (h) * hstep, voffA); } } while (0)
#define PG8_LDA(dst, b, h) do { _Pragma("unroll") for (int m = 0; m < 4; ++m) _Pragma("unroll") for (int k = 0; k < 2; ++k) dst[m].pc[k] = *(const PG8_LAS bf16x8*)(ldsA + ((b) * 2 + (h)) * HTB + m * 2048 + k * (FP8 ? 16 : 1024)); } while (0)
#define PG8_LDB(dst, b, h) do { _Pragma("unroll") for (int n = 0; n < 2; ++n) _Pragma("unroll") for (int k = 0; k < 2; ++k) dst[n].pc[k] = *(const PG8_LAS bf16x8*)(ldsB + ((b) * 2 + (h)) * HTB + n * 2048 + k * (FP8 ? 16 : 1024)); } while (0)
#define PG8_MMA(ai, bj, At, Bt) do { __builtin_amdgcn_s_setprio(1); _Pragma("unroll") for (int m = 0; m < 4; ++m) _Pragma("unroll") for (int n = 0; n < 2; ++n) { \
        if constexpr (FP8) { acc[ai][bj][m][n] = __builtin_amdgcn_mfma_scale_f32_16x16x128_f8f6f4(Bt[n].w, At[m].w, acc[ai][bj][m][n], 0, 0, 0, 0, 0, 0); } \
        else { _Pragma("unroll") for (int k = 0; k < 2; ++k) acc[ai][bj][m][n] = __builtin_amdgcn_mfma_f32_16x16x32_bf16(Bt[n].pc[k], At[m].pc[k], acc[ai][bj][m][n], 0, 0, 0); } } \
        __builtin_amdgcn_s_setprio(0); } while (0)
#define PG8_WAIT_V(n) asm volatile("s_waitcnt vmcnt(" #n ")" ::: "memory")
#define PG8_WAIT_L(n) asm volatile("s_waitcnt lgkmcnt(" #n ")" ::: "memory")
#define PG8_BAR __builtin_amdgcn_s_barrier()
#define PG8_SCHED __builtin_amdgcn_sched_barrier(0)
    Unit cur, nxt; int ui = 0;
    if (!S.next(0, cur)) return;
    f32x4 acc[2][2][4][2];
#pragma unroll
    for (int a = 0; a < 2; ++a)
#pragma unroll
        for (int b = 0; b < 2; ++b)
#pragma unroll
            for (int m = 0; m < 4; ++m)
#pragma unroll
                for (int n = 0; n < 2; ++n) acc[a][b][m][n] = (f32x4){0.f, 0.f, 0.f, 0.f};
    frag2_t At[4], B0[2], B1[2];
    const char* cA = GATHER ? (const char*)g.A : (const char*)g.A + (size_t)cur.pm * tstep; const char* cB = (const char*)g.Bt + (size_t)cur.e * g.bstride + (size_t)cur.pn * tstep;
    unsigned gc[2][2] = {{0u, 0u}, {0u, 0u}}, gn[2][2] = {{0u, 0u}, {0u, 0u}}; Unit nx2; bool has_nx2 = false;
#define PG8_GOFF(dst, pm_, ok_, alt_) do { const int t_ = lane_id_v() + wid * 64; _Pragma("unroll") for (int i_ = 0; i_ < 2; ++i_) { int R_, C_; stage_rc(t_ * 16 + i_ * 8192, R_, C_); \
        _Pragma("unroll") for (int h_ = 0; h_ < 2; ++h_) dst[h_][i_] = (ok_) ? (unsigned)g.rowidx[(pm_) * BM + h_ * HALF + R_] * (unsigned)(K * 2) + (unsigned)C_ * 2u : alt_[h_][i_]; } } while (0)
    if constexpr (GATHER) {
        PG8_GOFF(gc, cur.pm, true, gc);
        const bool hn = S.next(1, nxt);
        PG8_GOFF(gn, nxt.pm, hn, gc);
    }
    S.a_ready(cur);
    if constexpr (SP2) {
        PG8_STAGE(PG8_SB(0, 0), cB, voffB); PG8_STAGE(PG8_SB(0, 1), cB + hstep, voffB); PG8_STAGE_A(PG8_SA(0, 0), cA, 0, false); PG8_STAGE_A(PG8_SA(0, 1), cA, 1, false);
        if (wr == 1) PG8_BAR;
        PG8_WAIT_V(2); PG8_BAR;
        PG8_STAGE(PG8_SB(1, 0), cB + kstep, voffB); PG8_STAGE_A(PG8_SA(1, 0), cA + kstep, 0, false); PG8_STAGE(PG8_SB(1, 1), cB + hstep + kstep, voffB);
        PG8_WAIT_V(6); PG8_BAR;
    } else {
        PG8_STAGE(PG8_SB(0, 0), cB, voffB); PG8_STAGE_A(PG8_SA(0, 0), cA, 0, false); PG8_STAGE(PG8_SB(0, 1), cB + hstep, voffB); PG8_STAGE_A(PG8_SA(0, 1), cA, 1, false);
        if (wr == 1) PG8_BAR;
        PG8_WAIT_V(4); PG8_BAR;
        PG8_STAGE(PG8_SB(1, 0), cB + kstep, voffB); PG8_STAGE_A(PG8_SA(1, 0), cA + kstep, 0, false); PG8_STAGE(PG8_SB(1, 1), cB + hstep + kstep, voffB);
        PG8_WAIT_V(6); PG8_BAR;
    }
    for (;;) {
        const bool has_next = S.next(ui + 1, nxt);
        const char* nA = GATHER ? (const char*)g.A : (has_next ? (const char*)g.A + (size_t)nxt.pm * tstep : cA); const char* nB = has_next ? (const char*)g.Bt + (size_t)nxt.e * g.bstride + (size_t)nxt.pn * tstep : cB;
        for (int t = 0; t < nt; t += 2) {
            const bool last = (t == nt - 2);
            asm volatile("" : "+v"(voffA[0]), "+v"(voffA[1]), "+v"(voffB[0]), "+v"(voffB[1]));
            if constexpr (GATHER) asm volatile("" : "+v"(gc[0][0]), "+v"(gc[0][1]), "+v"(gc[1][0]), "+v"(gc[1][1]), "+v"(gn[0][0]), "+v"(gn[0][1]), "+v"(gn[1][0]), "+v"(gn[1][1]));
            const char* a1 = cA + (size_t)(t + 1) * kstep;
            const char* a2 = last ? nA : cA + (size_t)(t + 2) * kstep; const char* b2 = last ? nB : cB + (size_t)(t + 2) * kstep;
            const char* a3 = a2 + kstep; const char* b3 = b2 + kstep;
            if (last && has_next) S.a_ready(nxt);
            if constexpr (SP2) {
            PG8_LDB(B0, 0, 0); PG8_LDB(B1, 0, 1); PG8_SCHED; PG8_LDA(At, 0, 0); PG8_STAGE_A(PG8_SA(1, 1), a1, 1, false);
            PG8_WAIT_V(8); PG8_WAIT_L(0); PG8_BAR; PG8_MMA(0, 0, At, B0); PG8_MMA(0, 1, At, B1); PG8_BAR; PG8_SCHED;
            PG8_LDA(At, 0, 1); PG8_STAGE(PG8_SB(0, 0), b2, voffB); PG8_STAGE(PG8_SB(0, 1), b2 + hstep, voffB); PG8_STAGE_A(PG8_SA(0, 0), a2, 0, last);
            PG8_WAIT_V(8); PG8_WAIT_L(0); PG8_BAR; PG8_MMA(1, 0, At, B0); PG8_MMA(1, 1, At, B1); PG8_BAR; PG8_SCHED;
            PG8_LDB(B0, 1, 0); PG8_LDB(B1, 1, 1); PG8_SCHED; PG8_LDA(At, 1, 0); PG8_STAGE_A(PG8_SA(0, 1), a2, 1, last);
            PG8_WAIT_V(8); PG8_WAIT_L(0); PG8_BAR; PG8_MMA(0, 0, At, B0); PG8_MMA(0, 1, At, B1); PG8_BAR; PG8_SCHED;
            PG8_LDA(At, 1, 1); PG8_STAGE(PG8_SB(1, 0), b3, voffB); PG8_STAGE(PG8_SB(1, 1), b3 + hstep, voffB); PG8_STAGE_A(PG8_SA(1, 0), a3, 0, last);
            PG8_WAIT_V(8); PG8_WAIT_L(0); PG8_BAR; PG8_MMA(1, 0, At, B0); PG8_MMA(1, 1, At, B1); PG8_BAR; PG8_SCHED;
            } else {
            PG8_LDB(B0, 0, 0); PG8_SCHED; PG8_LDA(At, 0, 0); PG8_STAGE_A(PG8_SA(1, 1), a1, 1, false);
            PG8_WAIT_L(8); PG8_BAR; PG8_WAIT_L(0); PG8_MMA(0, 0, At, B0); PG8_BAR; PG8_SCHED;
            PG8_LDB(B1, 0, 1); PG8_STAGE(PG8_SB(0, 0), b2, voffB);
            PG8_BAR; PG8_WAIT_L(0); PG8_MMA(0, 1, At, B1); PG8_BAR;
            PG8_LDA(At, 0, 1); PG8_STAGE_A(PG8_SA(0, 0), a2, 0, last);
            PG8_BAR; PG8_WAIT_L(0); PG8_MMA(1, 0, At, B0); PG8_BAR; PG8_SCHED;
            PG8_STAGE(PG8_SB(0, 1), b2 + hstep, voffB);
            PG8_WAIT_V(6); PG8_BAR; PG8_MMA(1, 1, At, B1); PG8_BAR;
            PG8_LDB(B0, 1, 0); PG8_SCHED; PG8_LDA(At, 1, 0); PG8_STAGE_A(PG8_SA(0, 1), a2, 1, last);
            PG8_WAIT_L(8); PG8_BAR; PG8_WAIT_L(0); PG8_MMA(0, 0, At, B0); PG8_BAR; PG8_SCHED;
            PG8_LDB(B1, 1, 1); PG8_STAGE(PG8_SB(1, 0), b3, voffB);
            PG8_BAR; PG8_WAIT_L(0); PG8_MMA(0, 1, At, B1); PG8_BAR;
            PG8_LDA(At, 1, 1); PG8_STAGE_A(PG8_SA(1, 0), a3, 0, last);
            PG8_BAR; PG8_WAIT_L(0); PG8_MMA(1, 0, At, B0); PG8_BAR; PG8_SCHED;
            PG8_STAGE(PG8_SB(1, 1), b3 + hstep, voffB);
            PG8_WAIT_V(6); PG8_BAR; PG8_MMA(1, 1, At, B1); PG8_BAR;
            }
        }
        if constexpr (GATHER) { has_nx2 = has_next && S.next(ui + 2, nx2);
            _Pragma("unroll") for (int h = 0; h < 2; ++h) _Pragma("unroll") for (int i = 0; i < 2; ++i) gc[h][i] = gn[h][i];
            PG8_GOFF(gn, nx2.pm, has_nx2, gc); }
        if constexpr (ALIGN_EPI) { if (wr == 0) PG8_BAR; }
        if constexpr (!Epi::AFTER_DRAIN) { const int l_ = lane_id_v(); const int fr_ = l_ & 15, fq_ = l_ >> 4;
            E(acc, cur, wr, wc, fr_, fq_); S.done(cur); }
        if (!has_next) break;
#pragma unroll
        for (int a = 0; a < 2; ++a)
#pragma unroll
            for (int b = 0; b < 2; ++b)
#pragma unroll
                for (int m = 0; m < 4; ++m)
#pragma unroll
                    for (int n = 0; n < 2; ++n) acc[a][b][m][n] = (f32x4){0.f, 0.f, 0.f, 0.f};
        if constexpr (GATHER) { asm volatile("" : "+v"(gn[0][0]), "+v"(gn[0][1]), "+v"(gn[1][0]), "+v"(gn[1][1])); }
        cur = nxt; cA = nA; cB = nB; ++ui;
        if constexpr (ALIGN_EPI) { if (wr == 1) PG8_BAR; }
    }
    PG8_WAIT_V(0);
    if constexpr (!ALIGN_EPI) { if (wr == 0) PG8_BAR; }
    PG8_BAR;
    if constexpr (Epi::AFTER_DRAIN) { E.fused(acc, cur, wr, wc, fr, fq, lds, wid, lane); S.done(cur); }
#undef PG8_SA
#undef PG8_SB
#undef PG8_STAGE
#undef PG8_STAGE_A
#undef PG8_GOFF
#undef PG8_LDA
#undef PG8_LDB
#undef PG8_MMA
#undef PG8_WAIT_V
#undef PG8_WAIT_L
#undef PG8_BAR
#undef PG8_SCHED
}
}
#include <hip/hip_bf16.h>
#include <cmath>
namespace attn_body {
using bf16=__hip_bfloat16;
using bf16x8=__attribute__((ext_vector_type(8)))short;
using s16x4=__attribute__((ext_vector_type(4)))short;
using f32x16=__attribute__((ext_vector_type(16)))float;
using u32x4=__attribute__((ext_vector_type(4)))unsigned;
constexpr int BATCH=8,NHEAD=16,SEQ=4096,D=64;
constexpr int QP=512,KP=512,VP=512,OP=1024;
constexpr int NW=8,QBLK=32,QB=QBLK*NW,KVBLK=64,NQB=SEQ/QB;
constexpr int ATTN_UNIT_ROWS=QB;
__device__ __forceinline__ int crow(int r,int hi){return (r&3)+8*(r>>2)+4*hi;}
#define SBAR() __builtin_amdgcn_sched_barrier(0)
__device__ __forceinline__ void cmask(f32x16&p0,f32x16&p1,int jb,int qrel,int hi){
  const float NEG=-INFINITY; int kb=64*jb+4*hi;
  #pragma unroll
  for(int r=0;r<16;++r){int kv=kb+(r&3)+8*(r>>2); if(kv>qrel)p0[r]=NEG; if(kv+32>qrel)p1[r]=NEG;}
}

constexpr int NSLOT=3, SLOTB=8192;
constexpr int LDS_K=0, LDS_V=NSLOT*SLOTB, LDS_WS=2*NSLOT*SLOTB, LDS_OST=LDS_WS+NW*64*4, LDS_BYTES=LDS_OST+NW*4096;
constexpr float C2=0.125f*1.4426950408889634f;
__device__ __forceinline__ void glds16(const void*gsrc,unsigned lds_dst){unsigned keep;
  asm volatile("s_mov_b32 %0, m0\n\ts_mov_b32 m0, %2\n\ts_nop 0\n\tglobal_load_lds_dwordx4 %1, off\n\ts_mov_b32 m0, %0":"=&s"(keep):"v"(gsrc),"s"(lds_dst):"memory");}
__device__ __forceinline__ float max3f(float a,float b,float c){float r;asm("v_max3_f32 %0, %1, %2, %3":"=v"(r):"v"(a),"v"(b),"v"(c));return r;}
__device__ __forceinline__ float max2f(float a,float b){float r;asm("v_max_f32_e32 %0, %1, %2":"=v"(r):"v"(a),"v"(b));return r;}
__device__ __forceinline__ float fadd_s(float a,float b){float r;asm("v_add_f32_e32 %0, %1, %2":"=v"(r):"v"(a),"v"(b));return r;}
__device__ __forceinline__ float fsub_s(float a,float b){float r;asm("v_sub_f32_e32 %0, %1, %2":"=v"(r):"v"(a),"v"(b));return r;}
typedef float f32x2_t __attribute__((ext_vector_type(2))); typedef __bf16 bf16x2_t __attribute__((ext_vector_type(2)));
__device__ __forceinline__ unsigned cvtpk_s(float lo,float hi){f32x2_t v={lo,hi};bf16x2_t b=__builtin_convertvector(v,bf16x2_t);return __builtin_bit_cast(unsigned,b);}
#define WAIT_BAR(N) asm volatile("s_waitcnt vmcnt(" #N ") lgkmcnt(0)\n\ts_barrier":::"memory")

__device__ __forceinline__ void qkt(f32x16&p0,f32x16&p1,const char*Kslot,const bf16x8*qr,const f32x16&negm,int r32,int hi){
  const char*kb=Kslot+hi*1024+r32*16;
  #pragma unroll
  for(int d0=0;d0<4;++d0){
    const bf16x8 b0=*reinterpret_cast<const bf16x8*>(kb+d0*2048);
    const bf16x8 b1=*reinterpret_cast<const bf16x8*>(kb+d0*2048+512);
    if(d0==0){p0=__builtin_amdgcn_mfma_f32_32x32x16_bf16(b0,qr[0],negm,0,0,0);p1=__builtin_amdgcn_mfma_f32_32x32x16_bf16(b1,qr[0],negm,0,0,0);}
    else{p0=__builtin_amdgcn_mfma_f32_32x32x16_bf16(b0,qr[d0],p0,0,0,0);p1=__builtin_amdgcn_mfma_f32_32x32x16_bf16(b1,qr[d0],p1,0,0,0);}}
}
typedef __attribute__((address_space(3))) const char* lds_cptr;
typedef short v4i16_t __attribute__((ext_vector_type(4)));
__device__ __forceinline__ void kload8(bf16x8*kf,lds_cptr kp){
  kf[0]=*(const __attribute__((address_space(3))) bf16x8*)(kp);      kf[1]=*(const __attribute__((address_space(3))) bf16x8*)(kp+512);
  kf[2]=*(const __attribute__((address_space(3))) bf16x8*)(kp+2048); kf[3]=*(const __attribute__((address_space(3))) bf16x8*)(kp+2560);
  kf[4]=*(const __attribute__((address_space(3))) bf16x8*)(kp+4096); kf[5]=*(const __attribute__((address_space(3))) bf16x8*)(kp+4608);
  kf[6]=*(const __attribute__((address_space(3))) bf16x8*)(kp+6144); kf[7]=*(const __attribute__((address_space(3))) bf16x8*)(kp+6656);
}
__device__ __forceinline__ void kload2(bf16x8*kf,lds_cptr kp,int j){ kf[2*j]=*(const __attribute__((address_space(3))) bf16x8*)(kp+j*2048); kf[2*j+1]=*(const __attribute__((address_space(3))) bf16x8*)(kp+j*2048+512); }
__device__ __forceinline__ s16x4 vtr(lds_cptr p){ return __builtin_bit_cast(s16x4,__builtin_amdgcn_ds_read_tr16_b64_v4i16((__attribute__((address_space(3))) v4i16_t*)p)); }
__device__ __forceinline__ float rowmax(const f32x16&p0,const f32x16&p1){
  float a=max3f(p0[0],p0[1],p1[0]),b=max3f(p0[2],p0[3],p1[1]);a=max3f(a,p1[2],p1[3]);
  #pragma unroll
  for(int r=4;r<16;r+=4){a=max3f(a,p0[r],p0[r+1]);b=max3f(b,p0[r+2],p0[r+3]);a=max3f(a,p1[r],p1[r+1]);b=max3f(b,p1[r+2],p1[r+3]);}
  const float m=max2f(a,b);
  auto rr=__builtin_amdgcn_permlane32_swap(__float_as_uint(m),__float_as_uint(m),false,false);
  return max2f(__uint_as_float(rr[0]),__uint_as_float(rr[1]));
}
__device__ __forceinline__ void pv(f32x16*o,int vb,bf16x8 pa0,bf16x8 pa1,bf16x8 pa2,bf16x8 pa3){
  #pragma unroll
  for(int d0=0;d0<2;++d0){s16x4 lo[4],hi[4];
    #pragma unroll
    for(int ks=0;ks<4;++ks){
      asm volatile("ds_read_b64_tr_b16 %0,%1 offset:%c2":"=&v"(lo[ks]):"v"(vb),"i"(d0*4096+ks*1024):"memory");
      asm volatile("ds_read_b64_tr_b16 %0,%1 offset:%c2":"=&v"(hi[ks]):"v"(vb),"i"(d0*4096+ks*1024+512):"memory");}
    asm volatile("s_waitcnt lgkmcnt(0)":::"memory");SBAR();
    #define PK(k) (bf16x8){lo[k][0],lo[k][1],lo[k][2],lo[k][3],hi[k][0],hi[k][1],hi[k][2],hi[k][3]}
    o[d0]=__builtin_amdgcn_mfma_f32_32x32x16_bf16(pa0,PK(0),o[d0],0,0,0);
    o[d0]=__builtin_amdgcn_mfma_f32_32x32x16_bf16(pa1,PK(1),o[d0],0,0,0);
    o[d0]=__builtin_amdgcn_mfma_f32_32x32x16_bf16(pa2,PK(2),o[d0],0,0,0);
    o[d0]=__builtin_amdgcn_mfma_f32_32x32x16_bf16(pa3,PK(3),o[d0],0,0,0);
    #undef PK
  }
}

#ifndef ATTN_STORE16
#define ATTN_STORE16(p,v) (*(u32x4*)(p)=(v))
#endif
template<int THRL> __device__ __forceinline__ void attn_unit(int b,int h,int qb,const bf16*Q,const bf16*__restrict__ K,const bf16*__restrict__ V,bf16*O,char*shm,const int wid){
  const int qcol=(h>>1)*64, kcol=(h>>1)*64, vcol=(h>>2)*128+(h&1)*64, ocol=h*64;
  const int lane=lane_id_v(),r32=lane&31,hi=lane>>5;
  const long rowbase=(long)b*SEQ; const int q0=qb*QB;
  const bf16*Qw=Q+(rowbase+q0+wid*QBLK)*QP+qcol;
  const bf16*Kh=K+rowbase*KP+kcol,*Vh=V+rowbase*VP+vcol;
  const unsigned lds0=(unsigned)(uintptr_t)shm;
  float*wsf=(float*)(shm+LDS_WS)+wid*64;
  const bf16*ksrc=Kh+(long)lane*KP+wid*8;
  const bf16*vsrc=Vh+(long)(16*(wid&3)+(lane>>2))*VP+(wid>>2)*32+(lane&3)*8;
  const unsigned kdst=lds0+LDS_K+wid*1024, vdst=lds0+LDS_V+wid*1024;
  #define DMA_K(t,slot) glds16(ksrc+(long)(t)*KVBLK*KP,(unsigned)__builtin_amdgcn_readfirstlane(kdst+(slot)))
  #define DMA_V(t,slot) glds16(vsrc+(long)(t)*KVBLK*VP,(unsigned)__builtin_amdgcn_readfirstlane(vdst+(slot)))
  const int vb0=(int)(lds0+LDS_V)+((lane>>4)&1)*32+(lane&3)*8+(4*hi+((lane&15)>>2))*64;
  const char*Kbase=shm+LDS_K; bf16x8 kf[8];
  const lds_cptr shm3=(lds_cptr)shm; const lds_cptr kp0=shm3+LDS_K+hi*1024+r32*16; const lds_cptr vp0=shm3+LDS_V+((lane>>4)&1)*32+(lane&3)*8+(4*hi+((lane&15)>>2))*64;
  const int NT=(q0+QB)/KVBLK;
  DMA_K(0,0);DMA_V(0,0);DMA_K(1,SLOTB);
  bf16x8 qr[4];
  #pragma unroll
  for(int d0=0;d0<4;++d0)qr[d0]=*reinterpret_cast<const bf16x8*>(&Qw[(long)r32*QP+d0*16+hi*8]);
  float mhat=0.f,l_reg=0.f;f32x16 o[2];o[0]=f32x16{};o[1]=f32x16{};f32x16 negm=f32x16{};asm volatile("":"+v"(negm));
  const int qrel=wid*QBLK+r32;
  #define CMASK(P0,P1,t) do{int jb_=(t)-(NT-4); if(jb_>=0)cmask(P0,P1,jb_,qrel,hi);}while(0)
  bool resc=false;
  #define START(P0,P1) do{ const float rm=rowmax(P0,P1); resc=false; \
    { const float dl=rm; mhat=fadd_s(mhat,dl); \
      _Pragma("unroll") for(int r=0;r<16;++r){P0[r]=fsub_s(P0[r],dl);P1[r]=fsub_s(P1[r],dl);} \
      _Pragma("unroll") for(int r=0;r<16;++r)negm[r]=-mhat; asm volatile("":"+v"(negm)); } \
    _Pragma("unroll") for(int r=0;r<16;++r)P0[r]=__builtin_amdgcn_exp2f(P0[r]); }while(0)
  #define RESC() do{ if(resc){ asm volatile("s_waitcnt lgkmcnt(0)":::"memory"); \
      _Pragma("unroll") for(int d_=0;d_<2;++d_) _Pragma("unroll") for(int r=0;r<16;++r)o[d_][r]*=wsf[crow(r,hi)]; } }while(0)
  f32x16 pA0,pA1,pB0,pB1;
  int sl_prev=0,sl_cur=0,sl_next=SLOTB;
  #define ROT() do{sl_prev=sl_cur;sl_cur=sl_next;sl_next=(sl_next==(NSLOT-1)*SLOTB)?0:sl_next+SLOTB;}while(0)
  DMA_K(2,2*SLOTB);
  WAIT_BAR(3);
  qkt(pA0,pA1,Kbase,qr,negm,r32,hi);asm volatile("s_nop 15\n\ts_nop 7":"+v"(pA0),"+v"(pA1));CMASK(pA0,pA1,0);
  START(pA0,pA1);
  _Pragma("unroll") for(int r=0;r<16;++r)pA1[r]=__builtin_amdgcn_exp2f(pA1[r]);
  WAIT_BAR(0);
  DMA_K(3,0);DMA_V(1,SLOTB);
  ROT();
  kload8(kf,kp0+sl_cur);
  WAIT_BAR(2);
  s16x4 vlo[8],vhi[8]; u32x4 pw0,pw1,pw2,pw3;
  #define PKW(P,B) cvtpk_s(P[B],P[B+1])
  #define PAF(k) __builtin_bit_cast(bf16x8,pw##k)
  #define VFR(i) (bf16x8){vlo[i][0],vlo[i][1],vlo[i][2],vlo[i][3],vhi[i][0],vhi[i][1],vhi[i][2],vhi[i][3]}
  #define PIN(x) asm volatile("":"+v"(x))
  #define MX3(a,b,c) __builtin_fmaxf(__builtin_fmaxf((a),(b)),(c))
  #define GAPA(MF,A0,A1,A2,A3,W0,W1,PW) do{ MF; sacc+=A0; sacc+=A1; sacc+=A2; sacc+=A3; PIN(sacc); W0; W1; PIN(PW); SBAR(); }while(0)
  #define EX(v) __builtin_amdgcn_exp2f(v)
  #define GAPB(MF,X,B) do{ MF; X[B]=EX(X[B]); X[B+1]=EX(X[B+1]); X[B+2]=EX(X[B+2]); X[B+3]=EX(X[B+3]); PIN(X); SBAR(); }while(0)
  #define VRD(i) do{ vlo[i]=vtr(vp_+(((i)>>2)*4096+((i)&3)*1024)); vhi[i]=vtr(vp_+(((i)>>2)*4096+((i)&3)*1024+512)); }while(0)
  #define KRD(G,j) do{ if(G){ kload2(kf,kp0+sl_next,j); SBAR(); } }while(0)
  #define STEP(C0,C1,P0,P1,t,GK,GV,GL) do{ SBAR(); \
    const lds_cptr vp_=vp0+sl_prev; \
    VRD(0); SBAR(); float sacc=(P0[0]+P0[1]); \
    GAPA(C0=__builtin_amdgcn_mfma_f32_32x32x16_bf16(kf[0],qr[0],negm,0,0,0), P0[2],P0[3],P0[4],P0[5],     pw0[0]=PKW(P0,0), pw0[1]=PKW(P0,2), pw0); \
    VRD(4); SBAR(); GAPA(C1=__builtin_amdgcn_mfma_f32_32x32x16_bf16(kf[1],qr[0],negm,0,0,0), P0[6],P0[7],P0[8],P0[9],     pw0[2]=PKW(P0,4), pw0[3]=PKW(P0,6), pw0); \
    VRD(1); SBAR(); GAPA(C0=__builtin_amdgcn_mfma_f32_32x32x16_bf16(kf[2],qr[1],C0,0,0,0),   P0[10],P0[11],P0[12],P0[13], pw1[0]=PKW(P0,8), pw1[1]=PKW(P0,10), pw1); \
    VRD(5); SBAR(); GAPA(C1=__builtin_amdgcn_mfma_f32_32x32x16_bf16(kf[3],qr[1],C1,0,0,0),   P0[14],P0[15],P1[0],P1[1],   pw1[2]=PKW(P0,12),pw1[3]=PKW(P0,14), pw1); \
    VRD(2); SBAR(); GAPA(C0=__builtin_amdgcn_mfma_f32_32x32x16_bf16(kf[4],qr[2],C0,0,0,0),   P1[2],P1[3],P1[4],P1[5],     pw2[0]=PKW(P1,0), pw2[1]=PKW(P1,2), pw2); \
    VRD(6); SBAR(); GAPA(C1=__builtin_amdgcn_mfma_f32_32x32x16_bf16(kf[5],qr[2],C1,0,0,0),   P1[6],P1[7],P1[8],P1[9],     pw2[2]=PKW(P1,4), pw2[3]=PKW(P1,6), pw2); \
    VRD(3); SBAR(); GAPA(C0=__builtin_amdgcn_mfma_f32_32x32x16_bf16(kf[6],qr[3],C0,0,0,0),   P1[10],P1[11],P1[12],P1[13], pw3[0]=PKW(P1,8), pw3[1]=PKW(P1,10), pw3); \
    VRD(7); SBAR(); GAPA(C1=__builtin_amdgcn_mfma_f32_32x32x16_bf16(kf[7],qr[3],C1,0,0,0),   P1[14],P1[15],0.f,0.f,       pw3[2]=PKW(P1,12),pw3[3]=PKW(P1,14), pw3); \
    l_reg+=sacc; \
    if(GK){DMA_K((t)+3,sl_cur);} if(GV){DMA_V((t)+1,sl_next);} \
    CMASK(C0,C1,t); \
    { float a=MX3(C0[0],C0[1],C1[0]),b=MX3(C0[2],C0[3],C1[1]); a=MX3(a,C1[2],C1[3]); \
      _Pragma("unroll") for(int r=4;r<16;r+=4){a=MX3(a,C0[r],C0[r+1]);b=MX3(b,C0[r+2],C0[r+3]);a=MX3(a,C1[r],C1[r+1]);b=MX3(b,C1[r+2],C1[r+3]);} \
      float rm=__builtin_fmaxf(a,b); { auto rr=__builtin_amdgcn_permlane32_swap(__float_as_uint(rm),__float_as_uint(rm),false,false); rm=__builtin_fmaxf(__uint_as_float(rr[0]),__uint_as_float(rr[1])); } \
      resc=false; \
      if(__builtin_expect(__any(rm>(float)THRL),0)){ const float dl=__builtin_fmaxf(rm,0.f); mhat+=dl; \
        _Pragma("unroll") for(int r=0;r<16;++r){C0[r]-=dl;C1[r]-=dl;} \
        _Pragma("unroll") for(int r=0;r<16;++r)negm[r]=-mhat; asm volatile("":"+v"(negm)); \
        const float f=__builtin_amdgcn_exp2f(-dl); l_reg*=f; if(hi==0)wsf[r32]=f; resc=true; } } \
    SBAR(); \
    GAPB(o[0]=__builtin_amdgcn_mfma_f32_32x32x16_bf16(PAF(0),VFR(0),o[0],0,0,0), C0,0); \
    GAPB(o[1]=__builtin_amdgcn_mfma_f32_32x32x16_bf16(PAF(0),VFR(4),o[1],0,0,0), C0,4); \
    KRD(GL,0); GAPB(o[0]=__builtin_amdgcn_mfma_f32_32x32x16_bf16(PAF(1),VFR(1),o[0],0,0,0), C0,8); \
    KRD(GL,1); GAPB(o[1]=__builtin_amdgcn_mfma_f32_32x32x16_bf16(PAF(1),VFR(5),o[1],0,0,0), C0,12); \
    KRD(GL,2); GAPB(o[0]=__builtin_amdgcn_mfma_f32_32x32x16_bf16(PAF(2),VFR(2),o[0],0,0,0), C1,0); \
    KRD(GL,3); GAPB(o[1]=__builtin_amdgcn_mfma_f32_32x32x16_bf16(PAF(2),VFR(6),o[1],0,0,0), C1,4); \
    GAPB(o[0]=__builtin_amdgcn_mfma_f32_32x32x16_bf16(PAF(3),VFR(3),o[0],0,0,0), C1,8); \
    GAPB(o[1]=__builtin_amdgcn_mfma_f32_32x32x16_bf16(PAF(3),VFR(7),o[1],0,0,0), C1,12); \
    }while(0)
  int t=1;
  #undef CMASK
  #define CMASK(P0,P1,t) do{}while(0)
  for(;t+5<NT;t+=2){
    STEP(pB0,pB1,pA0,pA1,t,true,true,true);     WAIT_BAR(2); RESC(); ROT();
    STEP(pA0,pA1,pB0,pB1,t+1,true,true,true);   WAIT_BAR(2); RESC(); ROT();
  }
  #undef CMASK
  #define CMASK(P0,P1,t) do{int jb_=(t)-(NT-4); if(jb_>=0)cmask(P0,P1,jb_,qrel,hi);}while(0)
  #define ENDW(tt) do{ if((tt)+3<NT){WAIT_BAR(2);} else if((tt)+2<NT){WAIT_BAR(1);} else {WAIT_BAR(0);} }while(0)
  for(;t+1<NT;t+=2){
    STEP(pB0,pB1,pA0,pA1,t,(t+3<NT),(t+1<NT),(t+1<NT));       ENDW(t);   RESC(); ROT();
    STEP(pA0,pA1,pB0,pB1,t+1,(t+4<NT),(t+2<NT),(t+2<NT));     ENDW(t+1); RESC(); ROT();
  }
  STEP(pB0,pB1,pA0,pA1,NT-1,false,false,false); RESC();
  { float sacc=pB0[0]+pB0[1]; _Pragma("unroll") for(int r=2;r<16;++r)sacc+=pB0[r]; _Pragma("unroll") for(int r=0;r<16;++r)sacc+=pB1[r]; l_reg+=sacc;
    pw0=(u32x4){PKW(pB0,0),PKW(pB0,2),PKW(pB0,4),PKW(pB0,6)};pw1=(u32x4){PKW(pB0,8),PKW(pB0,10),PKW(pB0,12),PKW(pB0,14)};pw2=(u32x4){PKW(pB1,0),PKW(pB1,2),PKW(pB1,4),PKW(pB1,6)};pw3=(u32x4){PKW(pB1,8),PKW(pB1,10),PKW(pB1,12),PKW(pB1,14)};
    SBAR(); pv(o,vb0+sl_cur,PAF(0),PAF(1),PAF(2),PAF(3)); }
  #undef PKW
  #undef PAF
  #undef VFR
  #undef PIN
  #undef MX3
  #undef GAPA
  #undef GAPB
  #undef EX
  #undef VRD
  #undef KRD
  #undef STEP
  #undef ENDW
  {auto rr=__builtin_amdgcn_permlane32_swap(__float_as_uint(l_reg),__float_as_uint(l_reg),false,false);l_reg=__uint_as_float(rr[0])+__uint_as_float(rr[1]);}
  if(hi==0)wsf[32+r32]=l_reg;asm volatile("s_waitcnt lgkmcnt(0)":::"memory");
  float rli[16];
  #pragma unroll
  for(int r=0;r<16;++r)rli[r]=__builtin_amdgcn_rcpf(wsf[32+crow(r,hi)]);
  bf16*Ow=O+(rowbase+q0+wid*QBLK)*OP+ocol;
  { bf16*stg=(bf16*)(shm+LDS_OST)+wid*2048;
    #pragma unroll
    for(int r=0;r<16;++r){const int orow=crow(r,hi);
      #pragma unroll
      for(int d0=0;d0<2;++d0)stg[orow*64+d0*32+r32]=__float2bfloat16(o[d0][r]*rli[r]);}
    asm volatile("s_waitcnt lgkmcnt(0)":::"memory");
    #pragma unroll
    for(int i=0;i<4;++i){const int row=i*8+(lane>>3),ch=lane&7; const u32x4 v=*(const u32x4*)(stg+row*64+ch*8); ATTN_STORE16(Ow+(long)row*OP+ch*8,v);} }
  asm volatile("s_waitcnt lgkmcnt(0)\n\ts_barrier":::"memory");
  #undef DMA_K
  #undef DMA_V
  #undef CMASK
  #undef START
  #undef RESC
  #undef ROT
}
constexpr int ATTN_LDS_BYTES=LDS_BYTES;
struct AttnTensors { const bf16* Q; const bf16* K; const bf16* V; bf16* O; };
struct AttnUnit { int bh; int qb; };
struct QueueOrder {
  unsigned* ctr; volatile __attribute__((address_space(3))) unsigned* slot; int wid;
  __device__ __forceinline__ bool next(int,AttnUnit&u)const{
    if(wid==0&&lane_id_v()==0){ const unsigned n=__hip_atomic_fetch_add(ctr,1u,__ATOMIC_RELAXED,__HIP_MEMORY_SCOPE_AGENT); slot[0]=n; }
    asm volatile("s_waitcnt vmcnt(0) lgkmcnt(0)\n\ts_barrier":::"memory");
    const unsigned n=slot[0];
    asm volatile("s_waitcnt lgkmcnt(0)\n\ts_barrier":::"memory");
    if(n>=(unsigned)(BATCH*NHEAD*NQB))return false;
    u.qb=NQB-1-(int)(n/(BATCH*NHEAD)); u.bh=(int)(n%(BATCH*NHEAD)); return true; }
  __device__ __forceinline__ void a_ready(const AttnUnit&)const{}
  __device__ __forceinline__ void done(const AttnUnit&)const{}
};
template<class Sched,int THRL=8> __device__ __forceinline__ void attn_phase(char*lds,const AttnTensors&T,const Sched&S,const int wid){
  AttnUnit u;
  for(int i=0;S.next(i,u);++i){ S.a_ready(u); attn_unit<THRL>(u.bh/NHEAD,u.bh%NHEAD,u.qb,T.Q,T.K,T.V,T.O,lds,wid); S.done(u); }
}
#undef SBAR
#undef WAIT_BAR
}
constexpr int NWAVES = 8;
#ifndef MK_N_LAUNCHES
#define MK_N_LAUNCHES 1
#endif
constexpr int N_PHASES = 14;
#ifndef PROBE_MASK
#define PROBE_MASK 0
#endif
constexpr int N_LAUNCHES = MK_N_LAUNCHES;
static_assert(N_LAUNCHES == 1 || N_LAUNCHES == N_PHASES, "MK_N_LAUNCHES is 1 or 14");

constexpr int BATCH = 8, T = 4096, D = 1024, M = BATCH * T;
constexpr int IN_COLS = 3328, RWC = 1792, NEXP = 32, TOPK = 4, NMOD = 6 * D;
constexpr int MAXROWS = M * TOPK + NEXP * 256;
constexpr int MOD_KS = 8;

constexpr size_t MiB = 1u << 20, KiB = 1u << 10;
constexpr size_t WS_CTL = 0, CTL_ZERO_BYTES = 1 * MiB;
constexpr size_t WS_MODP = 1 * MiB;
constexpr size_t WS_MOD = 2 * MiB + 512 * KiB;
constexpr size_t WS_ROPE = 3 * MiB;
constexpr size_t WS_WIN = 5 * MiB;
constexpr size_t WS_WOUT = 12 * MiB;
constexpr size_t WS_BLORA = 14 * MiB;
constexpr size_t WS_TOKE = 15 * MiB, WS_TOKG = 15 * MiB + 512 * KiB;
constexpr size_t WS_TOKROW = 16 * MiB, WS_ROWTOK = 16 * MiB + 512 * KiB, WS_ROWGATE = 17 * MiB + 256 * KiB, WS_BLKBASE = 18 * MiB;
constexpr size_t WS_W1 = 20 * MiB, WS_W2 = 148 * MiB;
constexpr size_t WS_H2 = 212 * MiB;
constexpr size_t WS_H = 276 * MiB, WS_Q = 340 * MiB, WS_K = 372 * MiB, WS_V = 404 * MiB, WS_RW = 436 * MiB;
constexpr size_t WS_O = 548 * MiB, WS_YCAT = 612 * MiB, WS_LACT = 676 * MiB;
constexpr size_t WS_LW = 692 * MiB, WS_AS = 756 * MiB, WS_G = 820 * MiB, WS_Y = 884 * MiB;
constexpr size_t WS_RIMG = 884 * MiB, WS_RBON = 1012 * MiB;
constexpr size_t WS_ACT = 276 * MiB, WS_Y2 = 548 * MiB, WS_END = 1013 * MiB;
static_assert(WS_ROWTOK + (size_t)MAXROWS * 4 <= WS_ROWGATE && WS_ROWGATE + (size_t)MAXROWS * 4 <= WS_BLKBASE && WS_ACT + (size_t)MAXROWS * 2048 <= WS_Y2 && WS_Y2 + (size_t)MAXROWS * 2048 <= WS_Y, "d_ws map");
constexpr int CW_TMO = 0, CW_CODE = 1;
constexpr int CW_BAR = 4096;
constexpr int CW_ATTQ = 8192;
constexpr int CW_ECNT = 12288;
static_assert((CW_ECNT + 2 * 64 * NEXP) * 4 <= (int)CTL_ZERO_BYTES, "CTL words inside the memset region");

constexpr int RING_OFF = 0, RING_BYTES = 131072;
constexpr int LDSCTL_OFF = RING_BYTES, MISC_OFF = LDSCTL_OFF + 320;
constexpr int LDS_BYTES = 147456;
static_assert(MISC_OFF + 128 <= LDS_BYTES, "LDS map");
#define GAS __attribute__((address_space(1)))
#define LAS __attribute__((address_space(3)))
typedef unsigned short bf16;
typedef unsigned v4u __attribute__((ext_vector_type(4)));
typedef float f32x4 __attribute__((ext_vector_type(4)));
typedef short bf16x8 __attribute__((ext_vector_type(8)));
typedef GAS unsigned gu32;
typedef GAS unsigned long long gu64;
#define RLX_AGENT __ATOMIC_RELAXED, __HIP_MEMORY_SCOPE_AGENT
#define LDS_WAIT() asm volatile("s_waitcnt lgkmcnt(0)" ::: "memory")
#define VM_WAIT() asm volatile("s_waitcnt vmcnt(0)" ::: "memory")
__device__ __forceinline__ unsigned long long rt() { return __builtin_amdgcn_s_memrealtime(); }
__device__ __forceinline__ unsigned f2bf(float f) { unsigned u = __builtin_bit_cast(unsigned, f); return (u + 0x7fffu + ((u >> 16) & 1u)) >> 16; }
__device__ __forceinline__ unsigned pk2(float lo, float hi) { return f2bf(lo) | (f2bf(hi) << 16); }

#define XB_TMO      128
#define XB_XCNT(j)  (256  + 64 * (j))
#define XB_XSUB(j)  (1280 + 64 * (j))
#define XB_XGEN(j)  (2304 + 64 * (j))
#define XB_TOP      3328
#define XB_TOPGEN   3392
#define XCD_BAR_WORDS 3456
#define XB_SPIN_CAP (1u << 18)

__device__ __forceinline__ unsigned xb_ld(unsigned* p)              { return __hip_atomic_load(p, __ATOMIC_RELAXED, __HIP_MEMORY_SCOPE_AGENT); }
__device__ __forceinline__ unsigned xb_add(unsigned* p, unsigned v) { return __hip_atomic_fetch_add(p, v, __ATOMIC_RELAXED, __HIP_MEMORY_SCOPE_AGENT); }
__device__ __forceinline__ unsigned xb_xcc_id() { return (unsigned)__builtin_amdgcn_s_getreg((3 << 11) | 20) & 0xFu; }
#define XB_SPIN(cond, bar) do { unsigned _sp = 0; while (cond) { __builtin_amdgcn_s_sleep(1); \
    if ((++_sp & 255u) == 0u) { if (xb_ld(&(bar)[XB_TMO])) break; if (_sp > XB_SPIN_CAP) { atomicAdd(&(bar)[XB_TMO], 1u); break; } } } } while (0)

struct XcdBarrier {
    unsigned* bar; unsigned x; int wid;
    volatile LAS unsigned* st;
};

__device__ __forceinline__ XcdBarrier xcd_barrier_post(unsigned* bar, volatile LAS unsigned* st, int wid) {
    XcdBarrier b; b.bar = bar; b.x = xb_xcc_id(); b.st = st; b.wid = wid;
    if (threadIdx.x == 0) (void)xb_add(&bar[XB_XCNT(b.x)], 1u);
    return b;
}
__device__ __forceinline__ void xcd_barrier_complete(unsigned* bar, unsigned x, unsigned& nloc, unsigned& nx) {
    const unsigned G = gridDim.x * gridDim.y * gridDim.z;
    unsigned sum, cnt, mine, sp = 0u;
    for (;;) {
        sum = 0u; cnt = 0u; mine = 0u;
#pragma unroll
        for (unsigned j = 0; j < 16; ++j) { const unsigned c = xb_ld(&bar[XB_XCNT(j)]); sum += c; cnt += (c > 0u) ? 1u : 0u; mine = (j == x) ? c : mine; }
        if (sum == G) break;
        __builtin_amdgcn_s_sleep(1);
        if ((++sp & 255u) == 0u) { if (xb_ld(&bar[XB_TMO])) break; if (sp > XB_SPIN_CAP) { atomicAdd(&bar[XB_TMO], 1u); break; } }
    }
    nloc = mine > 0u ? mine : 1u; nx = cnt > 0u ? cnt : 1u;
}

__device__ __forceinline__ void xcd_barrier(const XcdBarrier& b) {
    asm volatile("s_waitcnt vmcnt(0)" ::: "memory");
    __syncthreads();
    if (b.wid == 0 && lane_id_v() == 0) {
        unsigned* bar = b.bar;
        __builtin_amdgcn_s_waitcnt(0);
        unsigned nloc = b.st[0], nx = b.st[1];
        if (nloc == 0u) { xcd_barrier_complete(bar, b.x, nloc, nx); b.st[0] = nloc; b.st[1] = nx; }
        const unsigned old = xb_add(&bar[XB_XSUB(b.x)], 1u);
        const unsigned gen = old / nloc;
        if (old + 1u == (gen + 1u) * nloc) {
            __builtin_amdgcn_fence(__ATOMIC_RELEASE, "agent");
            asm volatile("s_waitcnt vmcnt(0)" ::: "memory");
            const unsigned og = xb_add(&bar[XB_TOP], 1u);
            const unsigned tg = og / nx;
            if (og + 1u == (tg + 1u) * nx) xb_add(&bar[XB_TOPGEN], 1u);
            else XB_SPIN(xb_ld(&bar[XB_TOPGEN]) == tg, bar);
            __builtin_amdgcn_fence(__ATOMIC_ACQUIRE, "agent");
            xb_add(&bar[XB_XGEN(b.x)], 1u);
            asm volatile("s_waitcnt vmcnt(0)" ::: "memory");
        } else {
            XB_SPIN(xb_ld(&bar[XB_XGEN(b.x)]) == gen, bar);
            __builtin_amdgcn_fence(__ATOMIC_ACQUIRE, "agent");
            asm volatile("s_waitcnt vmcnt(0)" ::: "memory");
        }
    }
    __syncthreads();
}
typedef float f32x2 __attribute__((ext_vector_type(2)));
typedef unsigned u32x2 __attribute__((ext_vector_type(2)));
struct Frame {
    LAS unsigned char* lds;
    volatile LAS unsigned* MISC;
    gu32* ctl;
    int wave;
    int vcu, G;
    unsigned char* ws; float* out;
};
struct Args { const void* in[33]; float* out; unsigned char* ws; int ph_lo, ph_hi, li, pad; };
struct InProxy { __device__ __forceinline__ const void* operator[](int k) const { unsigned long long v; const unsigned long long kp = (unsigned long long)__builtin_amdgcn_kernarg_segment_ptr();
    asm volatile("s_load_dwordx2 %0, %1, %2\n\ts_waitcnt lgkmcnt(0)" : "=s"(v) : "s"(kp), "s"(8 * k) : "memory"); return (const void*)(const GAS unsigned char*)v; } };
struct ArgsD { InProxy in; };

__device__ __forceinline__ float wave_sum(float v) {
#pragma unroll
    for (int o = 1; o < 64; o <<= 1) v += __shfl_xor(v, o);
    return v;
}
__device__ __forceinline__ float bf2f(unsigned short u) { return __uint_as_float((unsigned)u << 16); }
__device__ __forceinline__ float bflo(unsigned u) { return __uint_as_float(u << 16); }
__device__ __forceinline__ float bfhi(unsigned u) { return __uint_as_float(u & 0xffff0000u); }
typedef float f32x2_t __attribute__((ext_vector_type(2))); typedef __bf16 bf16x2_t __attribute__((ext_vector_type(2)));
__device__ __forceinline__ unsigned pkbf(float lo, float hi) { f32x2_t v = {lo, hi}; bf16x2_t b = __builtin_convertvector(v, bf16x2_t); return __builtin_bit_cast(unsigned, b); }
#define DPP_ADD(x, ctrl) ((x) + __builtin_bit_cast(float, __builtin_amdgcn_update_dpp(0, __builtin_bit_cast(int, (x)), (ctrl), 0xF, 0xF, true)))
__device__ __forceinline__ float allsum16(float x) {
    x = DPP_ADD(x, 0xB1); x = DPP_ADD(x, 0x4E); x = DPP_ADD(x, 0x124); x = DPP_ADD(x, 0x128); return x; }

struct P0Item { const float* src; bf16* dst; int N, K, n0; bool permq, fp8; };
__device__ __forceinline__ bool p0_decode(const Frame& F, int it, P0Item& d, const float* w_in, const float* w_out, const float* w1, const float* w2m) {
    constexpr int I_IN = (D / 64) * (IN_COLS / 32), I_OUT = (D / 64) * (D / 32), I_W1 = (D / 64) * (2048 / 32), I_W2 = (D / 64) * (D / 32);
    constexpr int NITEMS = I_IN + I_OUT + NEXP * I_W1 + NEXP * I_W2;
    if (it >= NITEMS) return false;
    const float* W; bf16* WT; int N, r = it; d.permq = false; d.fp8 = false; d.K = D;
    if (r < I_IN) { W = w_in; WT = (bf16*)(F.ws + WS_WIN); N = IN_COLS; d.permq = true; }
    else { r -= I_IN; if (r < I_OUT) { W = w_out; WT = (bf16*)(F.ws + WS_WOUT); N = D; }
        else { r -= I_OUT; if (r < NEXP * I_W1) { const int e = r / I_W1; r -= e * I_W1; W = w1 + (size_t)e * D * 2048; WT = (bf16*)(F.ws + WS_W1 + (size_t)e * 2048 * D); N = 2048; d.fp8 = true; }
            else { r -= NEXP * I_W1; const int e = r / I_W2; r -= e * I_W2; W = w2m + (size_t)e * D * D; WT = (bf16*)(F.ws + WS_W2 + (size_t)e * D * D); N = D; d.fp8 = true; } } }
    const int nblk = N / 32, kb = r / nblk, nb = r - kb * nblk; d.N = N; d.n0 = 32 * nb; d.src = W + (size_t)(64 * kb) * N + d.n0; d.dst = d.fp8 ? (bf16*)((unsigned char*)WT + 64 * kb) : WT + 64 * kb; return true;
}
__device__ __forceinline__ void p0_item_store(const P0Item& d, const float (&v)[32], LAS float* scr, int lane) {
#pragma unroll
    for (int i = 0; i < 32; ++i) scr[(2 * i + (lane >> 5)) * 33 + (lane & 31)] = v[i];
    LDS_WAIT(); asm volatile("" ::: "memory");
    const int c = lane & 7;
#pragma unroll
    for (int j = 0; j < 4; ++j) { const int n = (lane >> 3) + 8 * j; const LAS float* s = scr + (8 * c) * 33 + n;
        int nn = d.n0 + n;
        if (d.fp8) { const u32x2 o8 = (u32x2){pg8::pk4_fp8(s[0 * 33] * pg8::W8_SCALE, s[1 * 33] * pg8::W8_SCALE, s[2 * 33] * pg8::W8_SCALE, s[3 * 33] * pg8::W8_SCALE), pg8::pk4_fp8(s[4 * 33] * pg8::W8_SCALE, s[5 * 33] * pg8::W8_SCALE, s[6 * 33] * pg8::W8_SCALE, s[7 * 33] * pg8::W8_SCALE)};
            *(GAS u32x2*)((unsigned char*)d.dst + (size_t)nn * d.K + 8 * c) = o8; }
        else { v4u o; o.x = pkbf(s[0 * 33], s[1 * 33]); o.y = pkbf(s[2 * 33], s[3 * 33]); o.z = pkbf(s[4 * 33], s[5 * 33]); o.w = pkbf(s[6 * 33], s[7 * 33]);
            if (d.permq && nn < 1024) { const int dd = nn & 63; if (dd < 16) nn = (nn & ~63) + ((dd < 8) ? 2 * dd : 2 * (dd - 8) + 1); }
            *(GAS v4u*)(d.dst + (size_t)nn * d.K + 8 * c) = o; } }
    LDS_WAIT(); asm volatile("" ::: "memory");
}
__device__ __forceinline__ void sincos_d(float af, float& s, float& c) {
    const double a = (double)af; const double n = __builtin_rint(a * 0.63661977236758134308);
    double r = __builtin_fma(-n, 1.57079632679489655800e+00, a); r = __builtin_fma(-n, 6.12323399573676603587e-17, r);
    const double r2 = r * r;
    double sp = 1.0 / 6227020800.0; sp = sp * r2 * -1.0 + 1.0 / 39916800.0; sp = -sp * r2 + 1.0 / 362880.0; sp = -sp * r2 + 1.0 / 5040.0; sp = -sp * r2 + 1.0 / 120.0; sp = -sp * r2 + 1.0 / 6.0; sp = r - r * r2 * sp;
    double cp = 1.0 / 87178291200.0; cp = -cp * r2 + 1.0 / 479001600.0; cp = -cp * r2 + 1.0 / 3628800.0; cp = -cp * r2 + 1.0 / 40320.0; cp = -cp * r2 + 1.0 / 720.0; cp = -cp * r2 + 1.0 / 24.0; cp = -cp * r2 + 0.5; cp = 1.0 - r2 * cp;
    const int q = ((int)n) & 3;
    const double sv = (q == 0) ? sp : (q == 1) ? cp : (q == 2) ? -sp : -cp, cv = (q == 0) ? cp : (q == 1) ? -sp : (q == 2) ? -cp : sp;
    s = (float)sv; c = (float)cv;
}
__device__ __forceinline__ void p0_prologue(Frame& F, const ArgsD& A) {
    const int lane = lane_id_v(), tid = F.wave * 64 + lane; (void)tid;
    const int gw = F.vcu * NWAVES + F.wave, NGW = F.G * NWAVES, gt = F.vcu * 512 + tid, NGT = F.G * 512;
    LAS float* scr = (LAS float*)(F.lds + RING_OFF + F.wave * 12288);
    LAS float* sl = (LAS float*)(F.lds + RING_OFF + 98304);
    const float* c = (const float*)A.in[1];
    for (int i = tid; i < 8 * 1024; i += 512) { const float v = c[i]; sl[i] = v / (1.f + __expf(-v)); }
    __syncthreads();
    { const float* aw = (const float*)A.in[3]; float* modp = (float*)(F.ws + WS_MODP);
      for (int it = gw; it < 96 * MOD_KS; it += NGW) { const int cc = it % 96, ks = it / 96, col = cc * 64 + lane;
          float acc[8];
#pragma unroll
          for (int b = 0; b < 8; ++b) acc[b] = 0.f;
          for (int k = ks * 128; k < ks * 128 + 128; ++k) { const float w = aw[(size_t)k * NMOD + col];
#pragma unroll
              for (int b = 0; b < 8; ++b) acc[b] += sl[b * 1024 + k] * w; }
#pragma unroll
          for (int b = 0; b < 8; ++b) modp[(size_t)(ks * 8 + b) * NMOD + col] = acc[b]; } }
    { const int* pos = (const int*)A.in[2]; float* rope = (float*)(F.ws + WS_ROPE);
      for (int idx = gt; idx < M * 8; idx += NGT) { const int m = idx >> 3, i = idx & 7;
          const float invf = (i == 0) ? 1.0f : (i == 1) ? 0.1939227432012558f : (i == 2) ? 0.03760603070259094f : (i == 3) ? 0.007292664609849453f : (i == 4) ? 0.0014142135623842478f : (i == 5) ? 0.00027424818836152554f : (i == 6) ? 5.318296098266728e-05f : 1.0313386155758053e-05f;
          const float ang = (float)pos[m] * invf; float s, cc; sincos_d(ang, s, cc); rope[(size_t)m * 16 + i] = cc; rope[(size_t)m * 16 + 8 + i] = s; } }
    { const float* w2 = (const float*)A.in[18]; const float* a2 = (const float*)A.in[20]; const float* g2 = (const float*)A.in[21]; bf16* bl = (bf16*)(F.ws + WS_BLORA);
      for (int idx = gt; idx < 1536 * 256; idx += NGT) { const int n = idx >> 8, k = idx & 255, blk = n >> 9, nn = n & 511; float v = 0.f;
          if (blk == 0 && k < 64) v = w2[k * 512 + nn]; else if (blk == 1 && k >= 64 && k < 128) v = a2[(k - 64) * 512 + nn]; else if (blk == 2 && k >= 128) v = g2[(k - 128) * 512 + nn];
          bl[idx] = (bf16)(pkbf(v, 0.f) & 0xffffu); } }
    { const float* w_in = (const float*)A.in[9]; const float* w_out = (const float*)A.in[10]; const float* w1 = (const float*)A.in[29]; const float* w2m = (const float*)A.in[31];
      P0Item cur, nxt; float v[32], vn[32];
      bool have = p0_decode(F, gw, cur, w_in, w_out, w1, w2m);
      if (have) {
#pragma unroll
          for (int i = 0; i < 32; ++i) v[i] = cur.src[(size_t)(2 * i + (lane >> 5)) * cur.N + (lane & 31)]; }
      for (int it = gw; have; it += NGW) {
          const bool hn = p0_decode(F, it + NGW, nxt, w_in, w_out, w1, w2m);
          if (hn) {
#pragma unroll
              for (int i = 0; i < 32; ++i) vn[i] = nxt.src[(size_t)(2 * i + (lane >> 5)) * nxt.N + (lane & 31)]; }
          p0_item_store(cur, v, scr, lane);
          cur = nxt; have = hn;
#pragma unroll
          for (int i = 0; i < 32; ++i) v[i] = vn[i];
      } }
}

__device__ __forceinline__ void p1_premix(Frame& F, const ArgsD& A) {
    const int lane = lane_id_v(), tid = F.wave * 64 + lane; (void)tid;
    const float* modp = (const float*)(F.ws + WS_MODP); const float* ada_b = (const float*)A.in[4]; float* mod = (float*)(F.ws + WS_MOD);
    const int rows_per = M / F.G, mbeg = F.vcu * rows_per, b = mbeg >> 12;
    LAS float* ms = (LAS float*)(F.lds + RING_OFF);
    for (int col = tid; col < 2048; col += 512) { float s = ada_b[col];
#pragma unroll
        for (int ks = 0; ks < MOD_KS; ++ks) s += modp[(size_t)(ks * 8 + b) * NMOD + col];
        ms[col] = s; }
    for (int i = F.vcu * 512 + tid; i < 8 * 4096; i += F.G * 512) { const int bb = i >> 12, col = 2048 + (i & 4095); float s = ada_b[col];
#pragma unroll
        for (int ks = 0; ks < MOD_KS; ++ks) s += modp[(size_t)(ks * 8 + bb) * NMOD + col];
        mod[(size_t)bb * NMOD + col] = s; }
    __syncthreads();
    const float* x = (const float*)A.in[0]; const float* nw = (const float*)A.in[5]; bf16* H = (bf16*)(F.ws + WS_H);
    f32x4 wsc[4], sh[4];
#pragma unroll
    for (int j = 0; j < 4; ++j) { const int col = 4 * lane + 256 * j; wsc[j] = *((const f32x4*)nw + lane + 64 * j) * (*(const LAS f32x4*)(ms + 1024 + col) + 1.f); sh[j] = *(const LAS f32x4*)(ms + col); }
    const int nr = rows_per / NWAVES, m0 = mbeg + F.wave * nr;
    f32x4 pv[4];
#pragma unroll
    for (int j = 0; j < 4; ++j) pv[j] = *((const GAS f32x4*)(x + (size_t)m0 * D) + lane + 64 * j);
    for (int i = 0; i < nr; ++i) { const int m = m0 + i;
        f32x4 v[4]; float s2 = 0.f;
#pragma unroll
        for (int j = 0; j < 4; ++j) { v[j] = pv[j]; s2 += (v[j].x * v[j].x + v[j].y * v[j].y) + (v[j].z * v[j].z + v[j].w * v[j].w); }
        if (i + 1 < nr) {
#pragma unroll
            for (int j = 0; j < 4; ++j) pv[j] = *((const GAS f32x4*)(x + (size_t)(m + 1) * D) + lane + 64 * j); }
        const float rs = __builtin_amdgcn_rsqf(wave_sum(s2) * (1.f / D) + 1e-6f);
        GAS u32x2* o8 = (GAS u32x2*)(H + (size_t)m * D) + lane;
#pragma unroll
        for (int j = 0; j < 4; ++j) { const f32x4 y = v[j] * rs * wsc[j] + sh[j]; o8[64 * j] = (u32x2){pkbf(y.x, y.y), pkbf(y.z, y.w)}; } }
}

__device__ __forceinline__ void p3_lact(Frame& F, const ArgsD& A) {
    const int lane = lane_id_v(), tid = F.wave * 64 + lane; (void)tid;
    const bf16* RW = (const bf16*)(F.ws + WS_RW); bf16* L = (bf16*)(F.ws + WS_LACT); const float* mu = (const float*)A.in[16] + 1536;
    const int gw = F.vcu * NWAVES + F.wave, NGW = F.G * NWAVES, c0 = 4 * lane;
    const f32x4 mu4 = *(const f32x4*)(mu + c0);
    for (int m = gw; m < M; m += NGW) { const int t = m & (T - 1);
        const u32x2 p = *(const GAS u32x2*)(RW + (size_t)m * RWC + 1536 + c0); u32x2 q = (u32x2){0u, 0u}; if (t > 0) q = *(const GAS u32x2*)(RW + (size_t)(m - 1) * RWC + 1536 + c0);
        f32x4 pv = (f32x4){bflo(p.x), bfhi(p.x), bflo(p.y), bfhi(p.y)}, qv = (f32x4){bflo(q.x), bfhi(q.x), bflo(q.y), bfhi(q.y)};
        f32x4 s = pv + (qv - pv) * mu4;
        if (c0 < 64) { s.x = tanhf(s.x); s.y = tanhf(s.y); s.z = tanhf(s.z); s.w = tanhf(s.w); }
        else if (c0 >= 128) { s.x = 1.f / (1.f + __expf(-s.x)); s.y = 1.f / (1.f + __expf(-s.y)); s.z = 1.f / (1.f + __expf(-s.z)); s.w = 1.f / (1.f + __expf(-s.w)); }
        *(GAS u32x2*)(L + (size_t)m * 256 + c0) = (u32x2){pkbf(s.x, s.y), pkbf(s.z, s.w)}; }
}

namespace rwk {
typedef short bf16x8 __attribute__((ext_vector_type(8)));
constexpr int MB = 8192;
__device__ __forceinline__ int moff(int r, int c) { return r * 128 + ((((c >> 3) ^ (r >> 1)) & 7) << 4) + ((c & 7) << 1); }
__device__ __forceinline__ bf16x8 frag(const LAS unsigned char* buf, int row, int chunk) { return *(const LAS bf16x8*)(buf + row * 128 + (((chunk ^ (row >> 1)) & 7) << 4)); }
__device__ __forceinline__ void mm(f32x4& acc, const LAS unsigned char* A, int tm, const LAS unsigned char* B, int tn, int l) {
    const int ar = 16 * tm + (l & 15), br = 16 * tn + (l & 15), q = l >> 4;
#pragma unroll
    for (int ks = 0; ks < 2; ++ks) { const bf16x8 a = frag(A, ar, 4 * ks + q), b = frag(B, br, 4 * ks + q); acc = __builtin_amdgcn_mfma_f32_16x16x32_bf16(a, b, acc, 0, 0, 0); }
}
__device__ __forceinline__ void st_nm(LAS unsigned char* buf, int tm, int tn, int l, f32x4 v) {
    const int row = 16 * tn + (l & 15), c = 16 * tm + 4 * (l >> 4); *(LAS u32x2*)(buf + moff(row, c)) = (u32x2){pkbf(v[0], v[1]), pkbf(v[2], v[3])}; }
__device__ __forceinline__ void st_mn(LAS unsigned char* buf, int tm, int tn, int l, f32x4 v) {
    const int c = 16 * tn + (l & 15), r0 = 16 * tm + 4 * (l >> 4); const unsigned p0 = pkbf(v[0], v[1]), p1 = pkbf(v[2], v[3]);
    *(LAS unsigned short*)(buf + moff(r0 + 0, c)) = (unsigned short)(p0 & 0xffffu); *(LAS unsigned short*)(buf + moff(r0 + 1, c)) = (unsigned short)(p0 >> 16);
    *(LAS unsigned short*)(buf + moff(r0 + 2, c)) = (unsigned short)(p1 & 0xffffu); *(LAS unsigned short*)(buf + moff(r0 + 3, c)) = (unsigned short)(p1 >> 16); }
__device__ __forceinline__ f32x4 ld_nm(const LAS unsigned char* buf, int tm, int tn, int l) {
    const int row = 16 * tn + (l & 15), c = 16 * tm + 4 * (l >> 4); const u32x2 p = *(const LAS u32x2*)(buf + moff(row, c)); return (f32x4){bflo(p.x), bfhi(p.x), bflo(p.y), bfhi(p.y)}; }
__device__ __forceinline__ float wsum64(float x) {
    x = DPP_ADD(x, 0xB1); x = DPP_ADD(x, 0x4E); x = DPP_ADD(x, 0x124); x = DPP_ADD(x, 0x128);
    x += __shfl_xor(x, 16); x += __shfl_xor(x, 32); return x; }
__device__ __forceinline__ float sum8(float x) { x = DPP_ADD(x, 0xB1); x = DPP_ADD(x, 0x4E); x = DPP_ADD(x, 0x141); return x; }
}

__device__ __forceinline__ void rwkv_pre(Frame& F, const ArgsD& A, const int bh, const int c_lo, const int c_hi) {
    using namespace rwk;
    const int b = bh >> 3, h = bh & 7, lane0 = lane_id_v(), w0 = F.wave;
    LAS unsigned char* L = F.lds + RING_OFF;
    LAS unsigned char* bA = L + 0 * MB; LAS unsigned char* bR = L + 1 * MB; LAS unsigned char* bB = L + 2 * MB; LAS unsigned char* bK = L + 3 * MB;
    LAS unsigned char* bBH = L + 4 * MB; LAS unsigned char* bKH = L + 5 * MB; LAS unsigned char* bVT = L + 6 * MB;
    LAS unsigned char* bAT = L + 7 * MB;
    LAS unsigned char* bAak = L + 9 * MB; LAS unsigned char* bArb = L + 10 * MB; LAS unsigned char* bArk = L + 11 * MB;
    LAS unsigned char* bQ0 = L + 12 * MB; LAS unsigned char* bQT0 = L + 13 * MB;
    LAS unsigned char* bT = L + 14 * MB;
    LAS unsigned char* bTF = L + 15 * MB;
    LAS float* part = (LAS float*)(F.lds + MISC_OFF + 128);
    LAS float* bon = part + 512;
    const bf16* RW = (const bf16*)(F.ws + WS_RW); const bf16* LW = (const bf16*)(F.ws + WS_LW); const bf16* AS = (const bf16*)(F.ws + WS_AS);
    unsigned char* IMG = F.ws + WS_RIMG; float* BON = (float*)(F.ws + WS_RBON);
    const size_t mb = (size_t)b * T;
    const float* mu = (const float*)A.in[16];
    float mu_r, mu_k, mu_v, kkc, kac, rkc;
    { const int hj = h * 64 + lane0; mu_r = mu[hj]; mu_k = mu[512 + hj]; mu_v = mu[1024 + hj]; kkc = ((const float*)A.in[22])[hj]; kac = ((const float*)A.in[23])[hj]; rkc = ((const float*)A.in[24])[hj]; }
    unsigned short pr[9], pk_[9], pv[9], plw[8], pas[8];
#define RWC_LOAD(c) do { const int w = w0, hj = h * 64 + lane0; const size_t m0_ = mb + (size_t)(c) * 64 + 8 * w; \
        _Pragma("unroll") for (int i_ = 0; i_ < 9; ++i_) { const bool ok_ = (i_ > 0) || ((c) > 0) || (w > 0); const bf16* row_ = RW + (m0_ + i_ - 1) * RWC + hj; \
            pr[i_] = ok_ ? row_[0] : (unsigned short)0; pk_[i_] = ok_ ? row_[512] : (unsigned short)0; pv[i_] = ok_ ? row_[1024] : (unsigned short)0; } \
        _Pragma("unroll") for (int i_ = 0; i_ < 8; ++i_) { plw[i_] = LW[(m0_ + i_) * 512 + hj]; pas[i_] = AS[(m0_ + i_) * 512 + hj]; } } while (0)
    RWC_LOAD(c_lo);
    for (int c = c_lo; c < c_hi; ++c) {
        int w = w0, lane = lane0; asm volatile("" : "+s"(w), "+v"(lane));
        const int tn_ = w & 3, tm0_ = 2 * (w >> 2);
        { float run = 0.f;
#pragma unroll
          for (int i = 0; i < 8; ++i) run += bf2f(plw[i]);
          part[w * 64 + lane] = run; }
        __syncthreads();
        float off = 0.f, ctot = 0.f;
#pragma unroll
        for (int o = 0; o < 8; ++o) { const float p = part[o * 64 + lane]; ctot += p; if (o < w) off += p; }
        {   unsigned bh_[4], kh_[4], vt_[4], at_[4]; float cm = off; float* bon_g = BON + ((size_t)bh * 64 + c) * 64;
#pragma unroll
            for (int i = 0; i < 8; ++i) { const int t = 8 * w + i;
                const float p0 = bf2f(pr[i + 1]), p1 = bf2f(pk_[i + 1]), p2 = bf2f(pv[i + 1]);
                const float rv = p0 + (bf2f(pr[i]) - p0) * mu_r, kv = p1 + (bf2f(pk_[i]) - p1) * mu_k, vv = p2 + (bf2f(pv[i]) - p2) * mu_v, asg = bf2f(pas[i]);
                const float ce = cm; cm += bf2f(plw[i]);
                float kkv = kv * kkc; const float n2 = wsum64(kkv * kkv); kkv = kkv * __builtin_amdgcn_rsqf(fmaxf(n2, 1e-24f));
                const float km = kv * (1.f + (asg - 1.f) * kac); const float bn = wsum64(rv * km * rkc); if (lane == 0) bon_g[t] = bn;
                const float av = -kkv, bv = kkv * asg;
                const float e_ce = __expf(ce), e_cm = __expf(cm), e_ncm = __expf(-cm), e_rem = __expf(ctot - cm);
                const unsigned ha = pkbf(av * e_ce, 0.f) & 0xffffu; *(LAS unsigned short*)(bA + moff(t, lane)) = (unsigned short)ha; *(LAS unsigned short*)(bR + moff(t, lane)) = (unsigned short)(pkbf(rv * e_cm, 0.f) & 0xffffu);
                *(LAS unsigned short*)(bB + moff(t, lane)) = (unsigned short)(pkbf(bv * e_ncm, 0.f) & 0xffffu); *(LAS unsigned short*)(bK + moff(t, lane)) = (unsigned short)(pkbf(km * e_ncm, 0.f) & 0xffffu);
                const unsigned hb = pkbf(bv * e_rem, 0.f) & 0xffffu, hk = pkbf(km * e_rem, 0.f) & 0xffffu, hv = pkbf(vv, 0.f) & 0xffffu;
                if (i & 1) { bh_[i >> 1] |= hb << 16; kh_[i >> 1] |= hk << 16; vt_[i >> 1] |= hv << 16; at_[i >> 1] |= ha << 16; } else { bh_[i >> 1] = hb; kh_[i >> 1] = hk; vt_[i >> 1] = hv; at_[i >> 1] = ha; } }
            *(LAS v4u*)(bBH + moff(lane, 8 * w)) = (v4u){bh_[0], bh_[1], bh_[2], bh_[3]};
            *(LAS v4u*)(bKH + moff(lane, 8 * w)) = (v4u){kh_[0], kh_[1], kh_[2], kh_[3]};
            *(LAS v4u*)(bVT + moff(lane, 8 * w)) = (v4u){vt_[0], vt_[1], vt_[2], vt_[3]};
            *(LAS v4u*)(bAT + moff(lane, 8 * w)) = (v4u){at_[0], at_[1], at_[2], at_[3]};
        }
        const float dec0 = __expf(ctot);
        if (c + 1 < c_hi) RWC_LOAD(c + 1);
        __syncthreads();
        {   const int p = w >> 1; const LAS unsigned char* Am = (p < 2) ? bA : bR; const LAS unsigned char* Bm = (p == 0 || p == 2) ? bB : bK;
#pragma unroll
            for (int x = 0; x < 2; ++x) { const int tm = 2 * (w & 1) + x;
#pragma unroll
                for (int tn = 0; tn < 4; ++tn) { f32x4 acc = (f32x4){0.f, 0.f, 0.f, 0.f}; mm(acc, Am, tm, Bm, tn, lane);
                    const int n = 16 * tn + (lane & 15), m0 = 16 * tm + 4 * (lane >> 4);
#pragma unroll
                    for (int r = 0; r < 4; ++r) { const bool keep = (p < 2) ? (n < m0 + r) : (n <= m0 + r); if (!keep) acc[r] = 0.f; }
                    if (p == 0) { st_mn(bQ0, tm, tn, lane, acc); st_nm(bQT0, tm, tn, lane, acc);
#pragma unroll
                        for (int r = 0; r < 4; ++r) if (n == m0 + r) acc[r] += 1.f;
                        st_nm(bT, tm, tn, lane, acc); }
                    else st_mn((p == 1) ? bAak : (p == 2) ? bArb : bArk, tm, tn, lane, acc); } }
        }
        __syncthreads();
#pragma unroll
        for (int x = 0; x < 2; ++x) { const int tm = tm0_ + x; f32x4 acc = (f32x4){0.f, 0.f, 0.f, 0.f}; mm(acc, bQ0, tm, bQT0, tn_, lane); st_mn(bB, tm, tn_, lane, acc); st_nm(bK, tm, tn_, lane, acc); }
        __syncthreads();
#pragma unroll
        for (int s = 2; s <= 5; ++s) {
            const LAS unsigned char* Qc = (s & 1) ? bQ0 : bB; const LAS unsigned char* QTc = (s & 1) ? bQT0 : bK;
            LAS unsigned char* Qn = (s & 1) ? bB : bQ0; LAS unsigned char* QTn = (s & 1) ? bK : bQT0;
            const int tn = w & 3;
            if (w >= 4) { f32x4 acc[4];
#pragma unroll
                for (int tm = 0; tm < 4; ++tm) acc[tm] = ld_nm(bT, tm, tn, lane);
#pragma unroll
                for (int tm = 0; tm < 4; ++tm) mm(acc[tm], Qc, tm, bT, tn, lane);
#pragma unroll
                for (int tm = 0; tm < 4; ++tm) st_nm(bT, tm, tn, lane, acc[tm]);
            } else {
#pragma unroll
                for (int tm = 0; tm < 4; ++tm) { f32x4 acc = (f32x4){0.f, 0.f, 0.f, 0.f}; mm(acc, Qc, tm, QTc, tn, lane); st_mn(Qn, tm, tn, lane, acc); st_nm(QTn, tm, tn, lane, acc); }
            }
            __syncthreads();
        }
        {
#pragma unroll
            for (int x = 0; x < 2; ++x) { const int tm = tm0_ + x; f32x4 acc = ld_nm(bT, tm, tn_, lane); mm(acc, bB, tm, bT, tn_, lane); st_mn(bTF, tm, tn_, lane, acc); }
        }
        LAS unsigned char* bX = bB; LAS unsigned char* bW = bK; LAS unsigned char* bU = bQ0;
        __syncthreads();
#pragma unroll
        for (int x = 0; x < 2; ++x) { const int tm = tm0_ + x;
            { f32x4 acc = (f32x4){0.f, 0.f, 0.f, 0.f}; mm(acc, bAak, tm, bVT, tn_, lane); st_nm(bX, tm, tn_, lane, acc); }
            { f32x4 acc = (f32x4){0.f, 0.f, 0.f, 0.f}; mm(acc, bTF, tm, bAT, tn_, lane); st_nm(bW, tm, tn_, lane, acc); } }
        __syncthreads();
#pragma unroll
        for (int x = 0; x < 2; ++x) { const int tm = tm0_ + x; f32x4 acc = (f32x4){0.f, 0.f, 0.f, 0.f}; mm(acc, bTF, tm, bX, tn_, lane); st_nm(bU, tm, tn_, lane, acc); }
        __syncthreads();
        {   unsigned char* img = IMG + ((size_t)bh * 64 + c) * (4 * MB);
            const int n_ = 16 * tn_ + (lane & 15); const float decn = __shfl(dec0, n_);
#pragma unroll
            for (int x = 0; x < 2; ++x) { const int tm = tm0_ + x; const int m0 = 16 * tm + 4 * (lane >> 4); const int go = moff(n_, m0);
                { f32x4 acc = (f32x4){0.f, 0.f, 0.f, 0.f}; mm(acc, bW, tm, bBH, tn_, lane);
#pragma unroll
                  for (int r = 0; r < 4; ++r) if (m0 + r == n_) acc[r] += decn;
                  *(GAS u32x2*)(img + 0 * MB + go) = (u32x2){pkbf(acc[0], acc[1]), pkbf(acc[2], acc[3])}; }
                { f32x4 acc = (f32x4){0.f, 0.f, 0.f, 0.f}; mm(acc, bBH, tm, bU, tn_, lane); mm(acc, bKH, tm, bVT, tn_, lane);
                  *(GAS u32x2*)(img + 1 * MB + go) = (u32x2){pkbf(acc[0], acc[1]), pkbf(acc[2], acc[3])}; }
                { f32x4 acc = ld_nm(bR, tm, tn_, lane); mm(acc, bW, tm, bArb, tn_, lane);
                  *(GAS u32x2*)(img + 2 * MB + go) = (u32x2){pkbf(acc[0], acc[1]), pkbf(acc[2], acc[3])}; }
                { f32x4 acc = (f32x4){0.f, 0.f, 0.f, 0.f}; mm(acc, bArb, tm, bU, tn_, lane); mm(acc, bArk, tm, bVT, tn_, lane);
                  *(GAS u32x2*)(img + 3 * MB + go) = (u32x2){pkbf(acc[0], acc[1]), pkbf(acc[2], acc[3])}; } }
        }
        __syncthreads();
    }
#undef RWC_LOAD
}

__device__ __forceinline__ void rwkv_seq(Frame& F, const ArgsD& A, const int bh) {
    using namespace rwk;
    const int b = bh >> 3, h = bh & 7, lane0 = lane_id_v(), w0 = F.wave;
    LAS unsigned char* L = F.lds + RING_OFF;
    LAS unsigned char* bS0 = L + 8 * MB;
    LAS float* ybuf = (LAS float*)(L + 10 * MB);
    const bf16* RW = (const bf16*)(F.ws + WS_RW); const bf16* G = (const bf16*)(F.ws + WS_G); bf16* YC = (bf16*)(F.ws + WS_YCAT);
    const unsigned char* IMG = F.ws + WS_RIMG + (size_t)bh * 64 * (4 * MB); const float* BON = (const float*)(F.ws + WS_RBON) + (size_t)bh * 64 * 64;
    const float* mu = (const float*)A.in[16]; const float* lnw_g = (const float*)A.in[25]; const float* lnb_g = (const float*)A.in[26];
    const size_t mb = (size_t)b * T;
    const int tid0 = w0 * 64 + lane0, lt0 = tid0 >> 3, hlc0 = h * 64 + (tid0 & 7) * 8;
    for (int i = tid0; i < MB / 16; i += 512) ((LAS v4u*)bS0)[i] = (v4u){0u, 0u, 0u, 0u};
    v4u pf[4][4], lvp[4], lvq[4], lgg[4]; float lbn[4];
#define RWS_LOAD(u, c) do { _Pragma("unroll") for (int k_ = 0; k_ < 4; ++k_) pf[u][k_] = *(const GAS v4u*)(IMG + (size_t)(c) * (4 * MB) + k_ * MB + tid0 * 16); \
        const size_t ml_ = mb + (size_t)(c) * 64 + lt0; lvp[u] = *(const GAS v4u*)(RW + ml_ * RWC + 1024 + hlc0); lvq[u] = *(const GAS v4u*)(RW + (ml_ - (((c) > 0 || lt0 > 0) ? 1 : 0)) * RWC + 1024 + hlc0); \
        lgg[u] = *(const GAS v4u*)(G + ml_ * 512 + hlc0); lbn[u] = BON[(c) * 64 + lt0]; } while (0)
#pragma unroll
    for (int u = 0; u < 4; ++u) RWS_LOAD(u, u);
    int scur = 0;
    for (int c4 = 0; c4 < T / 64; c4 += 4) {
#pragma unroll
      for (int u = 0; u < 4; ++u) { const int c = c4 + u;
        int w = w0, lane = lane0; asm volatile("" : "+s"(w), "+v"(lane));
        const int tid = w * 64 + lane, tn_ = w & 3, tm0_ = 2 * (w >> 2), lt = tid >> 3, lc = (tid & 7) * 8, hlc = h * 64 + lc;
        LAS unsigned char* set = L + (c & 1) * (4 * MB);
#pragma unroll
        for (int k = 0; k < 4; ++k) *(LAS v4u*)(set + k * MB + tid * 16) = pf[u][k];
        const v4u lv_p = lvp[u], lv_q = (c > 0 || lt > 0) ? lvq[u] : (v4u){0u, 0u, 0u, 0u}; const f32x4 lg0 = (f32x4){bflo(lgg[u].x), bfhi(lgg[u].x), bflo(lgg[u].y), bfhi(lgg[u].y)}, lg1 = (f32x4){bflo(lgg[u].z), bfhi(lgg[u].z), bflo(lgg[u].w), bfhi(lgg[u].w)}; const float bn = lbn[u];
        __syncthreads();
        if (c + 4 < T / 64) RWS_LOAD(u, c + 4);
        const LAS unsigned char* Sc = bS0 + scur * MB; LAS unsigned char* Sn = bS0 + (scur ^ 1) * MB;
#pragma unroll
        for (int x = 0; x < 2; ++x) { const int tm = tm0_ + x;
            { f32x4 acc = ld_nm(set + 1 * MB, tm, tn_, lane); mm(acc, set + 0 * MB, tm, Sc, tn_, lane); st_nm(Sn, tm, tn_, lane, acc); }
            { f32x4 acc = ld_nm(set + 3 * MB, tm, tn_, lane); mm(acc, set + 2 * MB, tm, Sc, tn_, lane);
              const int i = 16 * tn_ + (lane & 15), t0 = 16 * tm + 4 * (lane >> 4);
#pragma unroll
              for (int r = 0; r < 4; ++r) ybuf[(t0 + r) * 64 + i] = acc[r]; } }
        scur ^= 1;
        __syncthreads();
        {   const f32x4 y0 = *(const LAS f32x4*)(ybuf + lt * 64 + lc), y1 = *(const LAS f32x4*)(ybuf + lt * 64 + lc + 4);
            const float mean = sum8((y0.x + y0.y) + (y0.z + y0.w) + (y1.x + y1.y) + (y1.z + y1.w)) * (1.f / 64.f); const f32x4 d0 = y0 - mean, d1 = y1 - mean;
            const float var = sum8((d0.x * d0.x + d0.y * d0.y) + (d0.z * d0.z + d0.w * d0.w) + (d1.x * d1.x + d1.y * d1.y) + (d1.z * d1.z + d1.w * d1.w)) * (1.f / 64.f); const float rs = __builtin_amdgcn_rsqf(var + 64e-5f);
            const float* lnw_p = lnw_g + hlc; const float* lnb_p = lnb_g + hlc; const float* muv_p = mu + 1024 + hlc;
            const f32x4 lw0 = *(const f32x4*)lnw_p, lw1 = *(const f32x4*)(lnw_p + 4), lb0 = *(const f32x4*)lnb_p, lb1 = *(const f32x4*)(lnb_p + 4), mv0 = *(const f32x4*)muv_p, mv1 = *(const f32x4*)(muv_p + 4);
            f32x4 va = (f32x4){bflo(lv_p.x), bfhi(lv_p.x), bflo(lv_p.y), bfhi(lv_p.y)}, vb = (f32x4){bflo(lv_p.z), bfhi(lv_p.z), bflo(lv_p.w), bfhi(lv_p.w)};
            { const f32x4 qa = (f32x4){bflo(lv_q.x), bfhi(lv_q.x), bflo(lv_q.y), bfhi(lv_q.y)}, qb = (f32x4){bflo(lv_q.z), bfhi(lv_q.z), bflo(lv_q.w), bfhi(lv_q.w)}; va = va + (qa - va) * mv0; vb = vb + (qb - vb) * mv1; }
            const f32x4 o0 = ((d0 * rs) * lw0 + lb0 + va * bn) * lg0, o1 = ((d1 * rs) * lw1 + lb1 + vb * bn) * lg1;
            *(GAS v4u*)(YC + (mb + (size_t)c * 64 + lt) * 1024 + 512 + hlc) = (v4u){pkbf(o0.x, o0.y), pkbf(o0.z, o0.w), pkbf(o1.x, o1.y), pkbf(o1.z, o1.w)};
        }
      }
    }
#undef RWS_LOAD
}

__device__ __forceinline__ void p6_dacombine(Frame& F, const ArgsD& A) {
    const int lane = lane_id_v(), tid = F.wave * 64 + lane; (void)tid;
    const float* q1 = (const float*)A.in[11]; const float* k1 = (const float*)A.in[12]; const float* q2 = (const float*)A.in[13]; const float* k2 = (const float*)A.in[14];
    const float lam = __expf(wave_sum(q1[lane] * k1[lane])) - __expf(wave_sum(q2[lane] * k2[lane])) + 0.2f;
    const bf16* O = (const bf16*)(F.ws + WS_O); bf16* YC = (bf16*)(F.ws + WS_YCAT);
    const int gw = F.vcu * NWAVES + F.wave, NGW = F.G * NWAVES, dh = lane >> 4, d0 = 8 * (lane & 15);
    const float* sw = (const float*)A.in[15] + d0; const f32x4 swa = *(const f32x4*)sw * 0.8f, swb = *(const f32x4*)(sw + 4) * 0.8f;
    for (int m = gw; m < M; m += NGW) {
        const v4u a = *(const GAS v4u*)(O + (size_t)m * 1024 + dh * 256 + d0), c = *(const GAS v4u*)(O + (size_t)m * 1024 + dh * 256 + 128 + d0);
        f32x4 y0 = (f32x4){bflo(a.x) - lam * bflo(c.x), bfhi(a.x) - lam * bfhi(c.x), bflo(a.y) - lam * bflo(c.y), bfhi(a.y) - lam * bfhi(c.y)};
        f32x4 y1 = (f32x4){bflo(a.z) - lam * bflo(c.z), bfhi(a.z) - lam * bfhi(c.z), bflo(a.w) - lam * bflo(c.w), bfhi(a.w) - lam * bfhi(c.w)};
        float s2 = (y0.x * y0.x + y0.y * y0.y) + (y0.z * y0.z + y0.w * y0.w) + (y1.x * y1.x + y1.y * y1.y) + (y1.z * y1.z + y1.w * y1.w);
        s2 = allsum16(s2); const float rs = 1.f / sqrtf(s2 * (1.f / 128.f) + 1e-5f);
        y0 = y0 * rs * swa; y1 = y1 * rs * swb;
        *(GAS v4u*)(YC + (size_t)m * 1024 + dh * 128 + d0) = (v4u){pkbf(y0.x, y0.y), pkbf(y0.z, y0.w), pkbf(y1.x, y1.y), pkbf(y1.z, y1.w)}; }
}

#define P9_SWAP32(a, b) do { const auto r_ = __builtin_amdgcn_permlane32_swap(__float_as_uint(a), __float_as_uint(b), false, false); (a) = __uint_as_float(r_[0]) + __uint_as_float(r_[1]); } while (0)
#define P9_SWAP16(a, b) do { const auto r_ = __builtin_amdgcn_permlane16_swap(__float_as_uint(a), __float_as_uint(b), false, false); (a) = __uint_as_float(r_[0]) + __uint_as_float(r_[1]); } while (0)
#define P9_DPPF(x, ctrl) __builtin_bit_cast(float, __builtin_amdgcn_update_dpp(0, __builtin_bit_cast(int, (x)), (ctrl), 0xF, 0xF, true))
#define P9_DPPU(x, ctrl) ((unsigned)__builtin_amdgcn_update_dpp(0, (int)(x), (ctrl), 0xF, 0xF, true))
__device__ __forceinline__ float p9_reduce32(float (&a)[32], const int lane) {
#pragma unroll
    for (int e = 0; e < 16; ++e) P9_SWAP32(a[e], a[e + 16]);
#pragma unroll
    for (int e = 0; e < 8; ++e) P9_SWAP16(a[e], a[e + 8]);
    const bool b3 = (lane & 8) != 0, b2 = (lane & 4) != 0, b0 = (lane & 1) != 0;
#pragma unroll
    for (int e = 0; e < 4; ++e) { const float keep = b3 ? a[e + 4] : a[e], send = b3 ? a[e] : a[e + 4]; a[e] = keep + P9_DPPF(send, 0x128); }
#pragma unroll
    for (int e = 0; e < 2; ++e) { const float keep = b2 ? a[e + 2] : a[e], send = b2 ? a[e] : a[e + 2]; a[e] = keep + P9_DPPF(send, 0x141); }
    { const float keep = b0 ? a[1] : a[0], send = b0 ? a[0] : a[1]; a[0] = keep + P9_DPPF(send, 0xB1); }
    return a[0] + P9_DPPF(a[0], 0x4E);
}
__device__ __forceinline__ unsigned p9_wmax(unsigned v) {
    v = max(v, P9_DPPU(v, 0xB1)); v = max(v, P9_DPPU(v, 0x4E)); v = max(v, P9_DPPU(v, 0x124)); v = max(v, P9_DPPU(v, 0x128));
    const unsigned s0 = __builtin_amdgcn_readlane(v, 0), s1 = __builtin_amdgcn_readlane(v, 16), s2 = __builtin_amdgcn_readlane(v, 32), s3 = __builtin_amdgcn_readlane(v, 48);
    return max(max(s0, s1), max(s2, s3)); }
__device__ __forceinline__ void p8_postmix_router(Frame& F, const ArgsD& A, const int cset) {
    const int lane = lane_id_v(), tid = F.wave * 64 + lane; (void)tid;
    LAS float* rw = (LAS float*)(F.lds + RING_OFF);
    volatile LAS int* lcnt = (volatile LAS int*)(F.lds + LDSCTL_OFF);
    { const float* r = (const float*)A.in[27]; for (int i = tid; i < 1024 * 32; i += 512) { const int k = i >> 5, e = i & 31; rw[e * 1024 + k] = r[i]; } }
    if (tid < 32) lcnt[tid] = 0;
    __syncthreads();
    const float* x = (const float*)A.in[0]; const bf16* Y = (const bf16*)(F.ws + WS_Y); const float* mod = (const float*)(F.ws + WS_MOD);
    const float* pmn = (const float*)A.in[6]; const float* pfn = (const float*)A.in[7]; const float* rb = (const float*)A.in[28];
    unsigned char* H2 = F.ws + WS_H2; int* tokE = (int*)(F.ws + WS_TOKE); float* tokG = (float*)(F.ws + WS_TOKG);
    const int rows_per = M / F.G, mbeg = F.vcu * rows_per, b = mbeg >> 12; const float* mb_ = mod + (size_t)b * NMOD;
    f32x4 a1[4], a2[4], sh[4];
#pragma unroll
    for (int j = 0; j < 4; ++j) { const int col = 4 * lane + 256 * j; a1[j] = *(const f32x4*)(pmn + col) * *(const f32x4*)(mb_ + 2048 + col); a2[j] = *(const f32x4*)(pfn + col) * (*(const f32x4*)(mb_ + 4096 + col) + 1.f); sh[j] = *(const f32x4*)(mb_ + 3072 + col); }
    const int myexp = 8 * (lane >> 4) + 4 * ((lane >> 3) & 1) + 2 * ((lane >> 2) & 1) + (lane & 1); const float rbias = rb[myexp];
    const int nr = rows_per / NWAVES, m0 = mbeg + F.wave * nr;
    u32x2 yp[2][4]; f32x4 xp[2][4];
#define P9_LOAD(m_) do { _Pragma("unroll") for (int t_ = 0; t_ < 2; ++t_) _Pragma("unroll") for (int j_ = 0; j_ < 4; ++j_) { \
        yp[t_][j_] = *((const GAS u32x2*)(Y + (size_t)((m_) + t_) * D) + lane + 64 * j_); xp[t_][j_] = *((const GAS f32x4*)(x + (size_t)((m_) + t_) * D) + lane + 64 * j_); } } while (0)
    P9_LOAD(m0);
    for (int i = 0; i < nr; i += 2) { const int m = m0 + i;
        f32x4 xv[2][4];
#pragma unroll
        for (int t = 0; t < 2; ++t) { f32x4 yv[4]; float s2 = 0.f;
#pragma unroll
            for (int j = 0; j < 4; ++j) { const u32x2 p = yp[t][j]; yv[j] = (f32x4){bflo(p.x), bfhi(p.x), bflo(p.y), bfhi(p.y)}; s2 += (yv[j].x * yv[j].x + yv[j].y * yv[j].y) + (yv[j].z * yv[j].z + yv[j].w * yv[j].w); }
            const float rs = __builtin_amdgcn_rsqf(wave_sum(s2) * (1.f / D) + 1e-6f); float t2 = 0.f;
#pragma unroll
            for (int j = 0; j < 4; ++j) { xv[t][j] = xp[t][j] + a1[j] * (yv[j] * rs); *((GAS f32x4*)(F.out + (size_t)(m + t) * D) + lane + 64 * j) = xv[t][j];
                t2 += (xv[t][j].x * xv[t][j].x + xv[t][j].y * xv[t][j].y) + (xv[t][j].z * xv[t][j].z + xv[t][j].w * xv[t][j].w); }
            const float rs2 = __builtin_amdgcn_rsqf(wave_sum(t2) * (1.f / D) + 1e-6f);
#pragma unroll
            for (int j = 0; j < 4; ++j) { xv[t][j] = xv[t][j] * rs2 * a2[j] + sh[j]; *((GAS unsigned*)(H2 + (size_t)(m + t) * D) + lane + 64 * j) = pg8::pk4_fp8(xv[t][j].x, xv[t][j].y, xv[t][j].z, xv[t][j].w); } }
        if (i + 2 < nr) P9_LOAD(m + 2);
        float ac0[32], ac1[32];
#pragma unroll
        for (int e = 0; e < 32; ++e) { float s0 = 0.f, s1 = 0.f;
#pragma unroll
            for (int j = 0; j < 4; ++j) { const f32x4 w = *(const LAS f32x4*)(rw + e * 1024 + 4 * lane + 256 * j);
                s0 += (xv[0][j].x * w.x + xv[0][j].y * w.y) + (xv[0][j].z * w.z + xv[0][j].w * w.w); s1 += (xv[1][j].x * w.x + xv[1][j].y * w.y) + (xv[1][j].z * w.z + xv[1][j].w * w.w); }
            ac0[e] = s0; ac1[e] = s1; }
        const float lg[2] = {p9_reduce32(ac0, lane) + rbias, p9_reduce32(ac1, lane) + rbias};
#pragma unroll
        for (int t = 0; t < 2; ++t) { const unsigned u = __float_as_uint(lg[t]); unsigned key = (((u >> 31) ? ~u : (u | 0x80000000u)) & ~31u) | (unsigned)(31 - myexp);
            float tv[4]; int ti[4];
#pragma unroll
            for (int k = 0; k < 4; ++k) { const unsigned mx = p9_wmax(key); ti[k] = 31 - (int)(mx & 31u); const unsigned kv = mx & ~31u; tv[k] = __uint_as_float((kv >> 31) ? (kv & 0x7fffffffu) : ~kv); if (key == mx) key = 0u; }
            float ew[4], es = 0.f;
#pragma unroll
            for (int k = 0; k < 4; ++k) { ew[k] = __expf(tv[k] - tv[0]); es += ew[k]; }
            if (lane < 4) { const int e = (lane == 0) ? ti[0] : (lane == 1) ? ti[1] : (lane == 2) ? ti[2] : ti[3]; const float g = ((lane == 0) ? ew[0] : (lane == 1) ? ew[1] : (lane == 2) ? ew[2] : ew[3]) / es;
                const int pos = __hip_atomic_fetch_add((LAS int*)lcnt + e, 1, __ATOMIC_RELAXED, __HIP_MEMORY_SCOPE_WORKGROUP);
                tokE[(size_t)(m + t) * 4 + lane] = e | (pos << 8); tokG[(size_t)(m + t) * 4 + lane] = g; } }
    }
#undef P9_LOAD
    __syncthreads();
    if (tid < 32) { const int n = lcnt[tid]; int base = 0; if (n > 0) base = (int)__hip_atomic_fetch_add(F.ctl + CW_ECNT + cset * 64 * NEXP + 64 * tid, (unsigned)n, __ATOMIC_RELAXED, __HIP_MEMORY_SCOPE_AGENT);
        ((int*)(F.ws + WS_BLKBASE))[F.vcu * 32 + tid] = base; }
}

__device__ __forceinline__ void moe_tables(Frame& F) {
    const int lane = lane_id_v(), tid = F.wave * 64 + lane; (void)tid;
    volatile LAS int* ts = (volatile LAS int*)(F.lds + LDSCTL_OFF);
    if (tid < 32) ts[40 + tid] = (int)__hip_atomic_load(F.ctl + CW_ECNT + 64 * tid, __ATOMIC_RELAXED, __HIP_MEMORY_SCOPE_AGENT);
    __syncthreads();
    if (tid == 0) { int acc = 0; for (int e = 0; e < 32; ++e) { ts[e] = acc; acc += (ts[40 + e] + 255) >> 8; } ts[32] = acc; }
    __syncthreads();
}
__device__ __forceinline__ void p9_rows(Frame& F) {
    const int lane = lane_id_v(), tid = F.wave * 64 + lane; (void)tid;
    moe_tables(F);
    volatile LAS int* ts = (volatile LAS int*)(F.lds + LDSCTL_OFF);
    const int* tokE = (const int*)(F.ws + WS_TOKE); const float* tokG = (const float*)(F.ws + WS_TOKG); const int* blkbase = (const int*)(F.ws + WS_BLKBASE) + F.vcu * 32;
    int* tokrow = (int*)(F.ws + WS_TOKROW); int* rowtok = (int*)(F.ws + WS_ROWTOK); float* rowgate = (float*)(F.ws + WS_ROWGATE);
    const int rows_per = M / F.G, mbeg = F.vcu * rows_per;
    for (int i = tid; i < rows_per * 4; i += 512) { const int idx = mbeg * 4 + i; const int pe = tokE[idx], e = pe & 255, pos = pe >> 8; const int row = ts[e] * 256 + blkbase[e] + pos;
        tokrow[idx] = row; rowtok[row] = idx >> 2; rowgate[row] = tokG[idx]; }
    for (int e = F.vcu; e < 32; e += F.G) { const int n = ts[40 + e]; const int r0 = ts[e] * 256 + n, r1 = ts[e + 1] * 256;
        for (int r = r0 + tid; r < r1; r += 512) { rowtok[r] = 0; rowgate[r] = 0.f; } }
}

__device__ __forceinline__ void p12_final(Frame& F, const ArgsD& A, float* dst) {
    const int lane = lane_id_v(), tid = F.wave * 64 + lane; (void)tid;
    const unsigned char* Y2 = F.ws + WS_Y2; const int* tokrow = (const int*)(F.ws + WS_TOKROW); const float* mod = (const float*)(F.ws + WS_MOD); const float* pn = (const float*)A.in[8];
    const int rows_per = M / F.G, mbeg = F.vcu * rows_per, b = mbeg >> 12, nr = rows_per / NWAVES, m0 = mbeg + F.wave * nr;
    const float* mb_ = mod + (size_t)b * NMOD + 5120;
    f32x4 gw[4];
#pragma unroll
    for (int j = 0; j < 4; ++j) { const int col = 4 * lane + 256 * j; gw[j] = *(const f32x4*)(pn + col) * *(const f32x4*)(mb_ + col); }
    const int myrow = tokrow[(size_t)m0 * 4 + (lane < nr * 4 ? lane : 0)];
    unsigned yp[4][4]; f32x4 xp[4];
#define P13_LOAD(i_) do { _Pragma("unroll") for (int k_ = 0; k_ < 4; ++k_) { const int row_ = __builtin_amdgcn_readlane(myrow, 4 * (i_) + k_); \
        _Pragma("unroll") for (int j_ = 0; j_ < 4; ++j_) yp[k_][j_] = *((const GAS unsigned*)(Y2 + (size_t)row_ * D) + lane + 64 * j_); } \
        _Pragma("unroll") for (int j_ = 0; j_ < 4; ++j_) xp[j_] = *((const GAS f32x4*)(F.out + (size_t)(m0 + (i_)) * D) + lane + 64 * j_); } while (0)
    P13_LOAD(0);
#pragma unroll 1
    for (int i = 0; i < nr; ++i) { const int m = m0 + i;
        f32x4 a[4], xv[4]; float s2 = 0.f;
#pragma unroll
        for (int j = 0; j < 4; ++j) { a[j] = (f32x4){0.f, 0.f, 0.f, 0.f};
#pragma unroll
            for (int k = 0; k < 4; ++k) { const unsigned p = yp[k][j]; const f32x2 lo = __builtin_amdgcn_cvt_pk_f32_fp8((int)p, false), hi = __builtin_amdgcn_cvt_pk_f32_fp8((int)p, true); a[j] = a[j] + (f32x4){lo.x, lo.y, hi.x, hi.y}; }
            a[j] = a[j] * pg8::Y8_INV;
            s2 += (a[j].x * a[j].x + a[j].y * a[j].y) + (a[j].z * a[j].z + a[j].w * a[j].w); xv[j] = xp[j]; }
        if (i + 1 < nr) { const int in_ = __builtin_amdgcn_readfirstlane(i + 1);
#pragma unroll
            for (int k_ = 0; k_ < 4; ++k_) { const int row_ = __shfl(myrow, 4 * in_ + k_);
#pragma unroll
                for (int j_ = 0; j_ < 4; ++j_) yp[k_][j_] = *((const GAS unsigned*)(Y2 + (size_t)row_ * D) + lane + 64 * j_); }
#pragma unroll
            for (int j_ = 0; j_ < 4; ++j_) xp[j_] = *((const GAS f32x4*)(F.out + (size_t)(m + 1) * D) + lane + 64 * j_); }
        const float rs = __builtin_amdgcn_rsqf(wave_sum(s2) * (1.f / D) + 1e-6f);
#pragma unroll
        for (int j = 0; j < 4; ++j) *((GAS f32x4*)(dst + (size_t)m * D) + lane + 64 * j) = xv[j] + gw[j] * (a[j] * rs); }
#undef P13_LOAD
}
__global__ void __launch_bounds__(NWAVES * 64, 2) hybrid_fwd(Args kargs) {
    const ArgsD args{};
    extern __shared__ __attribute__((aligned(16))) unsigned char lds[];
    Frame F;
    F.lds = (LAS unsigned char*)lds;
    F.MISC = (volatile LAS unsigned*)(F.lds + MISC_OFF);
    F.wave = __builtin_amdgcn_readfirstlane((int)threadIdx.x >> 6);
    F.G = gridDim.x; { const int bx = blockIdx.x; F.vcu = (F.G % 8 == 0) ? (bx % 8) * (F.G / 8) + bx / 8 : bx; }
    F.ws = kargs.ws; F.out = kargs.out;
    unsigned char* ws = kargs.ws;
    F.ctl = (gu32*)(ws + WS_CTL);
#define GRID_BAR(seam) do { if (N_LAUNCHES != 1) { if (F.wave == 0 && lane_id_v() == 0) __hip_atomic_store(F.ctl + CW_TMO, 0xBADBA0u | (unsigned)(seam), RLX_AGENT); } else { xcd_barrier(bar); } } while (0)
    for (int u = threadIdx.x; u < (LDS_BYTES - LDSCTL_OFF) / 4; u += NWAVES * 64) ((LAS unsigned*)(F.lds + LDSCTL_OFF))[u] = 0u;
    __syncthreads();
    XcdBarrier bar; bar.bar = (unsigned*)(F.ctl + CW_BAR); bar.x = 0; bar.st = nullptr; bar.wid = F.wave;
    if (N_LAUNCHES == 1) bar = xcd_barrier_post((unsigned*)(F.ctl + CW_BAR), F.MISC + 8, F.wave);
    const int lo = kargs.ph_lo, hi = kargs.ph_hi;
#define IN(k) (lo <= (k) && (k) < hi)
#define PREP(k) (((PROBE_MASK) >> (k)) & 1)
#define BOTH(k) (IN(k) && IN((k) + 1))
    bf16* const H = (bf16*)(ws + WS_H); bf16* const H2 = (bf16*)(ws + WS_H2);

    if (IN(0)) { _Pragma("unroll 1") for (int r_ = 0; r_ <= PREP(0); ++r_) { p0_prologue(F, args); } if (BOTH(0)) GRID_BAR(0); }
    if (IN(1)) { _Pragma("unroll 1") for (int r_ = 0; r_ <= PREP(1); ++r_) { p1_premix(F, args); } if (BOTH(1)) GRID_BAR(1); }
    if (IN(2)) {
        pg8::Gemm g{H, (const bf16*)(ws + WS_WIN), M, IN_COLS, D, 0, nullptr, ws}; pg8::StaticOrder S; S.init(M, IN_COLS, F.G, (int)blockIdx.x);
        pg8::EpiProj E{(bf16*)(ws + WS_Q), (bf16*)(ws + WS_K), (bf16*)(ws + WS_V), (bf16*)(ws + WS_RW), (const float*)(ws + WS_ROPE), attn_body::C2};
        if (PREP(2)) { pg8::gemm_phase<pg8::EpiProj, pg8::StaticOrder, true, true, false>(F.lds + RING_OFF, g, S, E, F.wave); GRID_BAR(102); }
        pg8::gemm_phase<pg8::EpiProj, pg8::StaticOrder, true, true, false>(F.lds + RING_OFF, g, S, E, F.wave);
        if (BOTH(2)) GRID_BAR(2);
    }
    if (IN(3)) { _Pragma("unroll 1") for (int r_ = 0; r_ <= PREP(3); ++r_) { p3_lact(F, args); } if (BOTH(3)) GRID_BAR(3); }
    if (IN(4)) {
        pg8::Gemm g{(const bf16*)(ws + WS_LACT), (const bf16*)(ws + WS_BLORA), M, 1536, 256, 0, nullptr, ws}; pg8::StaticOrder S; S.init(M, 1536, F.G, (int)blockIdx.x);
        pg8::EpiLora E{(bf16*)(ws + WS_LW), (size_t)(WS_AS - WS_LW) / 2, (const float*)args.in[17], (const float*)args.in[19]}; static_assert(WS_G - WS_AS == WS_AS - WS_LW, "LW | AS | G equally spaced");
        if (PREP(4)) { pg8::gemm_phase<pg8::EpiLora, pg8::StaticOrder, true, true, false>(F.lds + RING_OFF, g, S, E, F.wave); GRID_BAR(104); }
        pg8::gemm_phase<pg8::EpiLora, pg8::StaticOrder, true, true, false>(F.lds + RING_OFF, g, S, E, F.wave);
        if (BOTH(4)) GRID_BAR(4);
    }
    if (IN(5)) {
        _Pragma("unroll 1") for (int r_ = 0; r_ <= PREP(5); ++r_)
            for (int u = F.vcu; u < BATCH * 8 * 4; u += F.G) rwkv_pre(F, args, u >> 2, (u & 3) * 16, (u & 3) * 16 + 16);
        if (BOTH(5)) GRID_BAR(5);
    }
    if (IN(6)) {
        _Pragma("unroll 1") for (int r_ = 0; r_ <= PREP(14); ++r_)
            for (int bh = blockIdx.x; bh < BATCH * 8; bh += F.G) rwkv_seq(F, args, bh);
        static_assert(attn_body::ATTN_LDS_BYTES <= RING_BYTES, "attention body geometry vs frame");
        const attn_body::AttnTensors AT{(const attn_body::bf16*)(ws + WS_Q), (const attn_body::bf16*)(ws + WS_K), (const attn_body::bf16*)(ws + WS_V), (attn_body::bf16*)(ws + WS_O)};
        if (PREP(15)) { const attn_body::QueueOrder S0{(unsigned*)(F.ctl + CW_ATTQ + 64), F.MISC + 12, F.wave}; attn_body::attn_phase<attn_body::QueueOrder>((char*)lds + RING_OFF, AT, S0, F.wave); GRID_BAR(106); }
        const attn_body::QueueOrder S{(unsigned*)(F.ctl + CW_ATTQ), F.MISC + 12, F.wave};
        attn_body::attn_phase<attn_body::QueueOrder>((char*)lds + RING_OFF, AT, S, F.wave);
        if (BOTH(6)) GRID_BAR(6);
    }
    if (IN(7)) { _Pragma("unroll 1") for (int r_ = 0; r_ <= PREP(7); ++r_) { p6_dacombine(F, args); } if (BOTH(7)) GRID_BAR(7); }
    if (IN(8)) {
        pg8::Gemm g{(const bf16*)(ws + WS_YCAT), (const bf16*)(ws + WS_WOUT), M, D, D, 0, nullptr, ws}; pg8::StaticOrder S; S.init(M, D, F.G, (int)blockIdx.x);
        pg8::EpiPlain E{(bf16*)(ws + WS_Y), D};
        if (PREP(8)) { pg8::gemm_phase<pg8::EpiPlain, pg8::StaticOrder, true, true, false>(F.lds + RING_OFF, g, S, E, F.wave); GRID_BAR(108); }
        pg8::gemm_phase<pg8::EpiPlain, pg8::StaticOrder, true, true, false>(F.lds + RING_OFF, g, S, E, F.wave);
        if (BOTH(8)) GRID_BAR(8);
    }
    if (IN(9)) { _Pragma("unroll 1") for (int r_ = PREP(9); r_ >= 0; --r_) { p8_postmix_router(F, args, r_); } if (BOTH(9)) GRID_BAR(9); }
    if (IN(10)) { _Pragma("unroll 1") for (int r_ = 0; r_ <= PREP(10); ++r_) { p9_rows(F); } if (BOTH(10)) GRID_BAR(10); }
    if (IN(11)) {
        moe_tables(F);
        const LAS int* ts = (const LAS int*)(F.lds + LDSCTL_OFF);
        pg8::Gemm g{H2, (const bf16*)(ws + WS_W1), MAXROWS, 2048, D / 2, (size_t)2048 * D, (const int*)(ws + WS_ROWTOK), ws};
        pg8::MoeOrder S{__builtin_amdgcn_readfirstlane(ts[32]), 8, 4, F.G, F.vcu, ts};
        pg8::EpiSwiglu E{ws + WS_ACT, (const float*)args.in[30]};
        if (PREP(11)) { pg8::gemm_phase<pg8::EpiSwiglu, pg8::MoeOrder, true, true, true, true>(F.lds + RING_OFF, g, S, E, F.wave); GRID_BAR(111); }
        pg8::gemm_phase<pg8::EpiSwiglu, pg8::MoeOrder, true, true, true, true>(F.lds + RING_OFF, g, S, E, F.wave);
        if (BOTH(11)) GRID_BAR(11);
    }
    if (IN(12)) {
        moe_tables(F);
        const LAS int* ts = (const LAS int*)(F.lds + LDSCTL_OFF);
        pg8::Gemm g{(const bf16*)(ws + WS_ACT), (const bf16*)(ws + WS_W2), MAXROWS, D, D / 2, (size_t)D * D, nullptr, ws};
        pg8::MoeOrder S{__builtin_amdgcn_readfirstlane(ts[32]), 4, 8, F.G, F.vcu, ts};
        pg8::EpiMoe2 E{ws + WS_Y2, (const float*)args.in[32], (const float*)(ws + WS_ROWGATE)};
        if (PREP(12)) { pg8::gemm_phase<pg8::EpiMoe2, pg8::MoeOrder, true, true, false, true>(F.lds + RING_OFF, g, S, E, F.wave); GRID_BAR(112); }
        pg8::gemm_phase<pg8::EpiMoe2, pg8::MoeOrder, true, true, false, true>(F.lds + RING_OFF, g, S, E, F.wave);
        if (BOTH(12)) GRID_BAR(12);
    }
    if (IN(13)) { _Pragma("unroll 1") for (int r_ = PREP(13); r_ >= 0; --r_) { p12_final(F, args, r_ ? (float*)(ws + WS_G) : F.out); } }
#undef IN
#undef PREP
#undef BOTH
}

extern "C" void kernel_launch(void* const* d_in, const int* in_sizes, int n_in, void* d_out, int out_size, void* d_ws, size_t ws_size, hipStream_t stream) {
    static int grid = 0;
    if (grid == 0) {
        if (n_in != 33 || in_sizes[0] != M * D || out_size != M * D || ws_size < WS_END) { fprintf(stderr, "kernel_launch: built for 33 inputs, x and out of %d floats, >= %zu bytes of workspace; got n_in %d, in0 %d, out %d, ws %zu; nothing launched\n", M * D, (size_t)WS_END, n_in, n_in > 0 ? in_sizes[0] : -1, out_size, ws_size); grid = -1; return; }
        int dev = 0, cus = 0, per_cu = 0;
        if (hipGetDevice(&dev) != hipSuccess || hipDeviceGetAttribute(&cus, hipDeviceAttributeMultiprocessorCount, dev) != hipSuccess) { fprintf(stderr, "kernel_launch: hipGetDevice / hipDeviceGetAttribute failed; nothing launched\n"); grid = -1; return; }
        if (hipFuncSetAttribute((const void*)hybrid_fwd, hipFuncAttributeMaxDynamicSharedMemorySize, LDS_BYTES) != hipSuccess) { fprintf(stderr, "kernel_launch: hipFuncSetAttribute failed; nothing launched\n"); grid = -1; return; }
        if (hipOccupancyMaxActiveBlocksPerMultiprocessor(&per_cu, (const void*)hybrid_fwd, NWAVES * 64, LDS_BYTES) != hipSuccess || per_cu < 1)
            fprintf(stderr, "kernel_launch: note: the occupancy query reports %d workgroups per CU\n", per_cu);
        (void)hipGetLastError();
        grid = (cus >= 256) ? 256 : (cus / 32) * 32;
        if (grid != 256) fprintf(stderr, "kernel_launch: launching %d workgroups (built and checked for 256)\n", grid);
    }
    if (grid <= 0) return;
    if (hipMemsetAsync((char*)d_ws + WS_CTL, 0, CTL_ZERO_BYTES, stream) != hipSuccess) { fprintf(stderr, "kernel_launch: hipMemsetAsync of the control words failed; nothing launched\n"); return; }
    Args a{};
    for (int i = 0; i < 33; ++i) a.in[i] = d_in[i];
    a.out = (float*)d_out; a.ws = (unsigned char*)d_ws;
    for (int li = 0; li < N_LAUNCHES; ++li) {
        a.ph_lo = (N_LAUNCHES == 1) ? 0 : li; a.ph_hi = (N_LAUNCHES == 1) ? N_PHASES : li + 1; a.li = li; a.pad = 0;
        hipLaunchKernelGGL(hybrid_fwd, dim3(grid), dim3(NWAVES * 64), LDS_BYTES, stream, a);
        const hipError_t le = hipPeekAtLastError();
        if (le != hipSuccess) { fprintf(stderr, "kernel_launch: launch %d failed: %s\n", li, hipGetErrorName(le)); break; }
    }
}
```

```cpp
#include <hip/hip_runtime.h>
#include <cstdio>
#include <cstdint>
__device__ __forceinline__ int lane_id_v() { int l; asm volatile("v_mbcnt_lo_u32_b32 %0, -1, 0\n\tv_mbcnt_hi_u32_b32 %0, -1, %0" : "=v"(l)); return l; }
namespace pg8 {
#define PG8_LAS __attribute__((address_space(3)))
typedef unsigned short bf16_t;
typedef short bf16x8 __attribute__((ext_vector_type(8)));
typedef float f32x4 __attribute__((ext_vector_type(4)));
typedef unsigned u32x4 __attribute__((ext_vector_type(4)));
typedef int v4i_t __attribute__((ext_vector_type(4)));
typedef int v8i_t __attribute__((ext_vector_type(8)));
typedef v8i_t v8i_a16 __attribute__((aligned(16)));
union frag2_t { bf16x8 pc[2]; v8i_t w; };
constexpr int BM = 256, BK = 64, HALF = 128, HTB = HALF * BK * 2  , STAGE_BYTES = 8 * HTB, NXCD = 8, WGM = 8;

__host__ __device__ __forceinline__ int lds_byte(int r, int c) { const int st = (r >> 4) * 2 + (c >> 5), rr = r & 15, cc = c & 31, ob = rr * 64 + cc * 2; return st * 1024 + (ob ^ (((ob >> 9) & 1) << 5)); }
__host__ __device__ __forceinline__ void stage_rc(int b, int& R, int& C) { const int st = b / 1024, sb = b % 1024, swz = sb ^ (((sb >> 9) & 1) << 5); R = (st >> 1) * 16 + swz / 64; C = (st & 1) * 32 + (swz % 64) / 2; }
__host__ __device__ __forceinline__ int perm32(int rho) { const int n = rho >> 4, i = rho & 15; return 8 * (i >> 2) + 4 * n + (i & 3); }

struct Unit { int pm, pn, e; };
struct Gemm { const bf16_t* A; const bf16_t* Bt; int M, N, K; size_t bstride; const int* rowidx; const void* base; };

struct StaticOrder {
    int nM, nN, nwg, G, c;
    __host__ __device__ void init(int M, int N, int G_, int c_) { nM = M / BM; nN = N / BM; nwg = nM * nN; G = G_; c = c_; }
    __host__ __device__ bool next(int i, Unit& u) const {
        const long L = (long)i * G + c; if (L >= nwg) return false;
        int wgid = (int)L; { const int q = nwg / NXCD, r = nwg % NXCD, xcd = wgid % NXCD, off = wgid / NXCD; wgid = (xcd < r ? xcd * (q + 1) : r * (q + 1) + (xcd - r) * q) + off; }
        const int nig = WGM * nN, gid = wgid / nig, fm = gid * WGM, gsz = (nM - fm) < WGM ? (nM - fm) : WGM;
        u.pm = fm + ((wgid % nig) % gsz); u.pn = (wgid % nig) / gsz; u.e = 0; return true;
    }
    __device__ __forceinline__ void a_ready(const Unit&) const {}
    __device__ __forceinline__ void done(const Unit&) const {}
};

__device__ __forceinline__ unsigned cvt_pk_bf16(float lo, float hi) { unsigned r; asm volatile("v_cvt_pk_bf16_f32 %0, %1, %2" : "=v"(r) : "v"(lo), "v"(hi)); return r; }
typedef float f32x2 __attribute__((ext_vector_type(2)));
typedef unsigned u32x2 __attribute__((ext_vector_type(2)));
__device__ __forceinline__ float sigmoidf_(float x) { return __builtin_amdgcn_rcpf(1.f + __expf(-x)); }

struct MoeOrder {
    int ntiles, nN, RG, G, c; const PG8_LAS int* tstart;
    __device__ __forceinline__ bool next(int i, Unit& u) const {
        const int L = i * G + c, grp = L >> 5, idx = L & 31; u.pn = idx / RG; u.pm = grp * RG + idx % RG; u.e = 0;
        if (u.pm >= ntiles) return false;
        int e = 0;
#pragma unroll
        for (int k = 16; k >= 1; k >>= 1) { if (tstart[e + k] <= u.pm) e += k; }
        u.e = __builtin_amdgcn_readfirstlane(e); return true;
    }
    __device__ __forceinline__ void a_ready(const Unit&) const {}
    __device__ __forceinline__ void done(const Unit&) const {}
};

#define PG8_PACK8(v0, v1) (u32x4){cvt_pk_bf16((v0)[0], (v0)[1]), cvt_pk_bf16((v0)[2], (v0)[3]), cvt_pk_bf16((v1)[0], (v1)[1]), cvt_pk_bf16((v1)[2], (v1)[3])}

struct EpiPlain {
    static constexpr bool PERM = true, AFTER_DRAIN = false;
    bf16_t* O; int ldc;
    __device__ __forceinline__ void operator()(const f32x4 (&acc)[2][2][4][2], const Unit& u, int wr, int wc, int fr, int fq) const {
        const int row0 = u.pm * BM + wr * 64 + fr, col0 = u.pn * BM + wc * 32 + 8 * fq;
#pragma unroll
        for (int ai = 0; ai < 2; ++ai)
#pragma unroll
            for (int m = 0; m < 4; ++m) { bf16_t* rowp = O + (size_t)(row0 + ai * HALF + m * 16) * ldc + col0;
#pragma unroll
                for (int bj = 0; bj < 2; ++bj) { const f32x4 v0 = acc[ai][bj][m][0], v1 = acc[ai][bj][m][1]; *(u32x4*)(rowp + bj * HALF) = PG8_PACK8(v0, v1); } }
    }
};

struct EpiProj {
    static constexpr bool PERM = true, AFTER_DRAIN = false;
    bf16_t *Q, *K, *V, *RW; const float* rope; float qscale;
    __device__ __forceinline__ void operator()(const f32x4 (&acc)[2][2][4][2], const Unit& u, int wr, int wc, int fr, int fq) const {
        const int row0 = u.pm * BM + wr * 64 + fr, cl = wc * 32 + 8 * fq, pn = u.pn;
        if (pn < 4) {
            bf16_t* base = (pn < 2) ? Q : K; const int colt = (pn & 1) * 256; const float sc = (pn < 2) ? qscale : 1.f;
            const bool rp = ((wc & 1) == 0) && (fq < 2);
#pragma unroll
            for (int ai = 0; ai < 2; ++ai)
#pragma unroll
                for (int m = 0; m < 4; ++m) { const int row = row0 + ai * HALF + m * 16;
                    f32x4 cs = (f32x4){1.f, 1.f, 1.f, 1.f}, sn = (f32x4){0.f, 0.f, 0.f, 0.f};
                    if (rp) { cs = *(const f32x4*)(rope + (size_t)row * 16 + 4 * fq); sn = *(const f32x4*)(rope + (size_t)row * 16 + 8 + 4 * fq); }
#pragma unroll
                    for (int bj = 0; bj < 2; ++bj) { f32x4 v0 = acc[ai][bj][m][0], v1 = acc[ai][bj][m][1];
                        { const float a0 = v0[0], b0 = v0[1], a1 = v0[2], b1 = v0[3], a2 = v1[0], b2 = v1[1], a3 = v1[2], b3 = v1[3];
                          v0[0] = a0 * cs[0] - b0 * sn[0]; v0[1] = b0 * cs[0] + a0 * sn[0]; v0[2] = a1 * cs[1] - b1 * sn[1]; v0[3] = b1 * cs[1] + a1 * sn[1];
                          v1[0] = a2 * cs[2] - b2 * sn[2]; v1[1] = b2 * cs[2] + a2 * sn[2]; v1[2] = a3 * cs[3] - b3 * sn[3]; v1[3] = b3 * cs[3] + a3 * sn[3]; }
                        v0 = v0 * sc; v1 = v1 * sc;
                        *(u32x4*)(base + (size_t)row * 512 + colt + bj * HALF + cl) = PG8_PACK8(v0, v1); } }
        } else {
            bf16_t* base; int ld, colt;
            if (pn < 6) { base = V; ld = 512; colt = (pn - 4) * 256; } else { base = RW; ld = 1792; colt = (pn - 6) * 256; }
#pragma unroll
            for (int ai = 0; ai < 2; ++ai)
#pragma unroll
                for (int m = 0; m < 4; ++m) { bf16_t* rowp = base + (size_t)(row0 + ai * HALF + m * 16) * ld + colt + cl;
#pragma unroll
                    for (int bj = 0; bj < 2; ++bj) { const f32x4 v0 = acc[ai][bj][m][0], v1 = acc[ai][bj][m][1]; *(u32x4*)(rowp + bj * HALF) = PG8_PACK8(v0, v1); } }
        }
    }
};

struct EpiLora {
    static constexpr bool PERM = true, AFTER_DRAIN = false;
    bf16_t* LW; size_t kstride; const float *w0, *a0;
    __device__ __forceinline__ void operator()(const f32x4 (&acc)[2][2][4][2], const Unit& u, int wr, int wc, int fr, int fq) const {
        const int row0 = u.pm * BM + wr * 64 + fr, kind = u.pn >> 1, col0 = (u.pn & 1) * 256 + wc * 32 + 8 * fq;
        bf16_t* dst = LW + (size_t)kind * kstride; const float* bias = (kind == 1) ? a0 : w0;
        f32x4 bv[2][2];
#pragma unroll
        for (int bj = 0; bj < 2; ++bj)
#pragma unroll
            for (int n = 0; n < 2; ++n) bv[bj][n] = (kind < 2) ? *(const f32x4*)(bias + col0 + bj * HALF + 4 * n) : (f32x4){0.f, 0.f, 0.f, 0.f};
#pragma unroll
        for (int ai = 0; ai < 2; ++ai)
#pragma unroll
            for (int m = 0; m < 4; ++m) { bf16_t* rowp = dst + (size_t)(row0 + ai * HALF + m * 16) * 512 + col0;
#pragma unroll
                for (int bj = 0; bj < 2; ++bj) { f32x4 vv[2];
#pragma unroll
                    for (int n = 0; n < 2; ++n) { f32x4 v = acc[ai][bj][m][n] + bv[bj][n];
                        if (kind == 0) {
#pragma unroll
                            for (int q = 0; q < 4; ++q) v[q] = -0.60653066f * sigmoidf_(v[q]);
                        } else if (kind == 1) {
#pragma unroll
                            for (int q = 0; q < 4; ++q) v[q] = sigmoidf_(v[q]);
                        }
                        vv[n] = v; }
                    *(u32x4*)(rowp + bj * HALF) = PG8_PACK8(vv[0], vv[1]); } }
    }
};

__device__ __forceinline__ unsigned pk4_fp8(float a, float b, float c_, float d) { int r = __builtin_amdgcn_cvt_pk_fp8_f32(a, b, 0, false); r = __builtin_amdgcn_cvt_pk_fp8_f32(c_, d, r, true); return (unsigned)r; }
constexpr float W8_SCALE = 32.f, W8_INV = 1.f / 32.f;
struct EpiSwiglu {
    static constexpr bool PERM = true, AFTER_DRAIN = false;
    unsigned char* ACT; const float* b1;
    __device__ __forceinline__ void operator()(const f32x4 (&acc)[2][2][4][2], const Unit& u, int wr, int wc, int fr, int fq) const {
        const int row0 = u.pm * BM + wr * 64 + fr, col0 = u.pn * BM + wc * 32 + 8 * fq;
        f32x4 bv[2][2];
#pragma unroll
        for (int bj = 0; bj < 2; ++bj)
#pragma unroll
            for (int n = 0; n < 2; ++n) bv[bj][n] = *(const f32x4*)(b1 + (size_t)u.e * 2048 + col0 + bj * HALF + 4 * n);
#pragma unroll
        for (int ai = 0; ai < 2; ++ai)
#pragma unroll
            for (int m = 0; m < 4; ++m) { unsigned char* rowp = ACT + (size_t)(row0 + ai * HALF + m * 16) * 1024 + (col0 >> 1);
#pragma unroll
                for (int bj = 0; bj < 2; ++bj) { const f32x4 v0 = acc[ai][bj][m][0] * W8_INV + bv[bj][0], v1 = acc[ai][bj][m][1] * W8_INV + bv[bj][1];
                    float o[4];
#pragma unroll
                    for (int q = 0; q < 4; ++q) { const float glu = (q < 2) ? v0[2 * q] : v1[2 * q - 4], lin = (q < 2) ? v0[2 * q + 1] : v1[2 * q - 3];
                        const float gg = fminf(glu, 7.f), ll = fminf(fmaxf(lin, -7.f), 7.f); o[q] = gg * sigmoidf_(1.702f * gg) * (ll + 1.f); }
                    *(unsigned*)(rowp + bj * (HALF / 2)) = pk4_fp8(o[0], o[1], o[2], o[3]); } }
    }
};

constexpr float Y8_SCALE = 32.f, Y8_INV = 1.f / 32.f;
struct EpiMoe2 {
    static constexpr bool PERM = true, AFTER_DRAIN = false;
    unsigned char* Y2; const float* b2; const float* gate;
    __device__ __forceinline__ void operator()(const f32x4 (&acc)[2][2][4][2], const Unit& u, int wr, int wc, int fr, int fq) const {
        const int row0 = u.pm * BM + wr * 64 + fr, col0 = u.pn * BM + wc * 32 + 8 * fq;
#pragma unroll
        for (int bj = 0; bj < 2; ++bj) { const f32x4 b0 = *(const f32x4*)(b2 + (size_t)u.e * 1024 + col0 + bj * HALF), b1 = *(const f32x4*)(b2 + (size_t)u.e * 1024 + col0 + bj * HALF + 4);
#pragma unroll
            for (int ai = 0; ai < 2; ++ai)
#pragma unroll
                for (int m = 0; m < 4; ++m) { const int row = row0 + ai * HALF + m * 16; const float gt = gate[row] * Y8_SCALE;
                    const f32x4 v0 = (acc[ai][bj][m][0] * W8_INV + b0) * gt, v1 = (acc[ai][bj][m][1] * W8_INV + b1) * gt;
                    *(u32x2*)(Y2 + (size_t)row * 1024 + col0 + bj * HALF) = (u32x2){pk4_fp8(v0[0], v0[1], v0[2], v0[3]), pk4_fp8(v1[0], v1[1], v1[2], v1[3])}; } }
    }
};

template <class Epi, class Sched, bool ALIGN_EPI = false, bool SP2 = false, bool GATHER = false, bool FP8 = false>
__device__ __forceinline__ void gemm_phase(PG8_LAS unsigned char* lds, const Gemm g, const Sched& S, const Epi& E, const int wid) {
    const int lane = lane_id_v(), tid = wid * 64 + lane, wr = wid >> 2, wc = wid & 3, fr = lane & 15, fq = lane >> 4;
    const int K = g.K, nt = K / BK;
    const __amdgpu_buffer_rsrc_t rsrc = __builtin_amdgcn_make_buffer_rsrc((void*)g.base, 0, 0x7fffffff, 0x00020000);
    unsigned voffA[2], voffB[2];
#pragma unroll
    for (int i = 0; i < 2; ++i) { int R, C; stage_rc(tid * 16 + i * 8192, R, C); const int Rb = Epi::PERM ? ((R & ~31) + perm32(R & 31)) : R;
        voffA[i] = (unsigned)(R * K + C) * 2u; voffB[i] = (unsigned)(Rb * K + C) * 2u; }
    const size_t kstep = (size_t)(BK * 2);
    const size_t hstep = (size_t)HALF * K * 2;
    const size_t tstep = 2 * hstep;
    const unsigned ldsw = (unsigned)wid * 1024u;
    const int aoff = FP8 ? lds_byte(wr * 64 + fr, fq * 16) : lds_byte(wr * 64 + fr, fq * 8), boff = FP8 ? lds_byte(wc * 32 + fr, fq * 16) : lds_byte(wc * 32 + fr, fq * 8);
    const PG8_LAS unsigned char* ldsA; const PG8_LAS unsigned char* ldsB;
    { unsigned a_ = (unsigned)(size_t)(lds + aoff), b_ = (unsigned)(size_t)(lds + 4 * HTB + boff); asm volatile("" : "+v"(a_), "+v"(b_)); ldsA = (const PG8_LAS unsigned char*)(size_t)a_; ldsB = (const PG8_LAS unsigned char*)(size_t)b_; }
#define PG8_SA(b, h) (((b) * 2 + (h)) * HTB)
#define PG8_SB(b, h) ((4 + (b) * 2 + (h)) * HTB)
#define PG8_STAGE(bufoff, gbase, voff) do { const unsigned so_ = (unsigned)((const char*)(gbase) - (const char*)g.base); _Pragma("unroll") for (int _i = 0; _i < 2; ++_i) \
        __builtin_amdgcn_raw_ptr_buffer_load_lds(rsrc, (PG8_LAS unsigned*)(lds + (bufoff) + ldsw + _i * 8192), 16, (voff)[_i], so_, 0, 0); } while (0)
#define PG8_STAGE_A(bufoff, ptr, h, nx) do { if constexpr (GATHER) { unsigned vo_[2]; vo_[0] = (nx) ? gn[h][0] : gc[h][0]; vo_[1] = (nx) ? gn[h][1] : gc[h][1]; PG8_STAGE(bufoff, ptr, vo_); } \
        else { PG8_STAGE(bufoff, (ptr) + (h) * hstep, voffA); } } while (0)
#define PG8_LDA(dst, b, h) do { _Pragma("unroll") for (int m = 0; m < 4; ++m) _Pragma("unroll") for (int k = 0; k < 2; ++k) dst[m].pc[k] = *(const PG8_LAS bf16x8*)(ldsA + ((b) * 2 + (h)) * HTB + m * 2048 + k * (FP8 ? 16 : 1024)); } while (0)
#define PG8_LDB(dst, b, h) do { _Pragma("unroll") for (int n = 0; n < 2; ++n) _Pragma("unroll") for (int k = 0; k < 2; ++k) dst[n].pc[k] = *(const PG8_LAS bf16x8*)(ldsB + ((b) * 2 + (h)) * HTB + n * 2048 + k * (FP8 ? 16 : 1024)); } while (0)
#define PG8_MMA(ai, bj, At, Bt) do { __builtin_amdgcn_s_setprio(1); _Pragma("unroll") for (int m = 0; m < 4; ++m) _Pragma("unroll") for (int n = 0; n < 2; ++n) { \
        if constexpr (FP8) { acc[ai][bj][m][n] = __builtin_amdgcn_mfma_scale_f32_16x16x128_f8f6f4(Bt[n].w, At[m].w, acc[ai][bj][m][n], 0, 0, 0, 0, 0, 0); } \
        else { _Pragma("unroll") for (int k = 0; k < 2; ++k) acc[ai][bj][m][n] = __builtin_amdgcn_mfma_f32_16x16x32_bf16(Bt[n].pc[k], At[m].pc[k], acc[ai][bj][m][n], 0, 0, 0); } } \
        __builtin_amdgcn_s_setprio(0); } while (0)
#define PG8_WAIT_V(n) asm volatile("s_waitcnt vmcnt(" #n ")" ::: "memory")
#define PG8_WAIT_L(n) asm volatile("s_waitcnt lgkmcnt(" #n ")" ::: "memory")
#define PG8_BAR __builtin_amdgcn_s_barrier()
#define PG8_SCHED __builtin_amdgcn_sched_barrier(0)
    Unit cur, nxt; int ui = 0;
    if (!S.next(0, cur)) return;
    f32x4 acc[2][2][4][2];
#pragma unroll
    for (int a = 0; a < 2; ++a)
#pragma unroll
        for (int b = 0; b < 2; ++b)
#pragma unroll
            for (int m = 0; m < 4; ++m)
#pragma unroll
                for (int n = 0; n < 2; ++n) acc[a][b][m][n] = (f32x4){0.f, 0.f, 0.f, 0.f};
    frag2_t At[4], B0[2], B1[2];
    const char* cA = GATHER ? (const char*)g.A : (const char*)g.A + (size_t)cur.pm * tstep; const char* cB = (const char*)g.Bt + (size_t)cur.e * g.bstride + (size_t)cur.pn * tstep;
    unsigned gc[2][2] = {{0u, 0u}, {0u, 0u}}, gn[2][2] = {{0u, 0u}, {0u, 0u}}; Unit nx2; bool has_nx2 = false;
#define PG8_GOFF(dst, pm_, ok_, alt_) do { const int t_ = lane_id_v() + wid * 64; _Pragma("unroll") for (int i_ = 0; i_ < 2; ++i_) { int R_, C_; stage_rc(t_ * 16 + i_ * 8192, R_, C_); \
        _Pragma("unroll") for (int h_ = 0; h_ < 2; ++h_) dst[h_][i_] = (ok_) ? (unsigned)g.rowidx[(pm_) * BM + h_ * HALF + R_] * (unsigned)(K * 2) + (unsigned)C_ * 2u : alt_[h_][i_]; } } while (0)
    if constexpr (GATHER) {
        PG8_GOFF(gc, cur.pm, true, gc);
        const bool hn = S.next(1, nxt);
        PG8_GOFF(gn, nxt.pm, hn, gc);
    }
    S.a_ready(cur);
    if constexpr (SP2) {
        PG8_STAGE(PG8_SB(0, 0), cB, voffB); PG8_STAGE(PG8_SB(0, 1), cB + hstep, voffB); PG8_STAGE_A(PG8_SA(0, 0), cA, 0, false); PG8_STAGE_A(PG8_SA(0, 1), cA, 1, false);
        if (wr == 1) PG8_BAR;
        PG8_WAIT_V(2); PG8_BAR;
        PG8_STAGE(PG8_SB(1, 0), cB + kstep, voffB); PG8_STAGE_A(PG8_SA(1, 0), cA + kstep, 0, false); PG8_STAGE(PG8_SB(1, 1), cB + hstep + kstep, voffB);
        PG8_WAIT_V(6); PG8_BAR;
    } else {
        PG8_STAGE(PG8_SB(0, 0), cB, voffB); PG8_STAGE_A(PG8_SA(0, 0), cA, 0, false); PG8_STAGE(PG8_SB(0, 1), cB + hstep, voffB); PG8_STAGE_A(PG8_SA(0, 1), cA, 1, false);
        if (wr == 1) PG8_BAR;
        PG8_WAIT_V(4); PG8_BAR;
        PG8_STAGE(PG8_SB(1, 0), cB + kstep, voffB); PG8_STAGE_A(PG8_SA(1, 0), cA + kstep, 0, false); PG8_STAGE(PG8_SB(1, 1), cB + hstep + kstep, voffB);
        PG8_WAIT_V(6); PG8_BAR;
    }
    for (;;) {
        const bool has_next = S.next(ui + 1, nxt);
        const char* nA = GATHER ? (const char*)g.A : (has_next ? (const char*)g.A + (size_t)nxt.pm * tstep : cA); const char* nB = has_next ? (const char*)g.Bt + (size_t)nxt.e * g.bstride + (size_t)nxt.pn * tstep : cB;
        for (int t = 0; t < nt; t += 2) {
            const bool last = (t == nt - 2);
            asm volatile("" : "+v"(voffA[0]), "+v"(voffA[1]), "+v"(voffB[0]), "+v"(voffB[1]));
            if constexpr (GATHER) asm volatile("" : "+v"(gc[0][0]), "+v"(gc[0][1]), "+v"(gc[1][0]), "+v"(gc[1][1]), "+v"(gn[0][0]), "+v"(gn[0][1]), "+v"(gn[1][0]), "+v"(gn[1][1]));
            const char* a1 = cA + (size_t)(t + 1) * kstep;
            const char* a2 = last ? nA : cA + (size_t)(t + 2) * kstep; const char* b2 = last ? nB : cB + (size_t)(t + 2) * kstep;
            const char* a3 = a2 + kstep; const char* b3 = b2 + kstep;
            if (last && has_next) S.a_ready(nxt);
            if constexpr (SP2) {
            PG8_LDB(B0, 0, 0); PG8_LDB(B1, 0, 1); PG8_SCHED; PG8_LDA(At, 0, 0); PG8_STAGE_A(PG8_SA(1, 1), a1, 1, false);
            PG8_WAIT_V(8); PG8_WAIT_L(0); PG8_BAR; PG8_MMA(0, 0, At, B0); PG8_MMA(0, 1, At, B1); PG8_BAR; PG8_SCHED;
            PG8_LDA(At, 0, 1); PG8_STAGE(PG8_SB(0, 0), b2, voffB); PG8_STAGE(PG8_SB(0, 1), b2 + hstep, voffB); PG8_STAGE_A(PG8_SA(0, 0), a2, 0, last);
            PG8_WAIT_V(8); PG8_WAIT_L(0); PG8_BAR; PG8_MMA(1, 0, At, B0); PG8_MMA(1, 1, At, B1); PG8_BAR; PG8_SCHED;
            PG8_LDB(B0, 1, 0); PG8_LDB(B1, 1, 1); PG8_SCHED; PG8_LDA(At, 1, 0); PG8_STAGE_A(PG8_SA(0, 1), a2, 1, last);
            PG8_WAIT_V(8); PG8_WAIT_L(0); PG8_BAR; PG8_MMA(0, 0, At, B0); PG8_MMA(0, 1, At, B1); PG8_BAR; PG8_SCHED;
            PG8_LDA(At, 1, 1); PG8_STAGE(PG8_SB(1, 0), b3, voffB); PG8_STAGE(PG8_SB(1, 1), b3 + hstep, voffB); PG8_STAGE_A(PG8_SA(1, 0), a3, 0, last);
            PG8_WAIT_V(8); PG8_WAIT_L(0); PG8_BAR; PG8_MMA(1, 0, At, B0); PG8_MMA(1, 1, At, B1); PG8_BAR; PG8_SCHED;
            } else {
            PG8_LDB(B0, 0, 0); PG8_SCHED; PG8_LDA(At, 0, 0); PG8_STAGE_A(PG8_SA(1, 1), a1, 1, false);
            PG8_WAIT_L(8); PG8_BAR; PG8_WAIT_L(0); PG8_MMA(0, 0, At, B0); PG8_BAR; PG8_SCHED;
            PG8_LDB(B1, 0, 1); PG8_STAGE(PG8_SB(0, 0), b2, voffB);
            PG8_BAR; PG8_WAIT_L(0); PG8_MMA(0, 1, At, B1); PG8_BAR;
            PG8_LDA(At, 0, 1); PG8_STAGE_A(PG8_SA(0, 0), a2, 0, last);
            PG8_BAR; PG8_WAIT_L(0); PG8_MMA(1, 0, At, B0); PG8_BAR; PG8_SCHED;
            PG8_STAGE(PG8_SB(0, 1), b2 + hstep, voffB);
            PG8_WAIT_V(6); PG8_BAR; PG8_MMA(1, 1, At, B1); PG8_BAR;
            PG8_LDB(B0, 1, 0); PG8_SCHED; PG8_LDA(At, 1, 0); PG8_STAGE_A(PG8_SA(0, 1), a2, 1, last);
            PG8_WAIT_L(8); PG8_BAR; PG8_WAIT_L(0); PG8_MMA(0, 0, At, B0); PG8_BAR; PG8_SCHED;
            PG8_LDB(B1, 1, 1); PG8_STAGE(PG8_SB(1, 0), b3, voffB);
            PG8_BAR; PG8_WAIT_L(0); PG8_MMA(0, 1, At, B1); PG8_BAR;
            PG8_LDA(At, 1, 1); PG8_STAGE_A(PG8_SA(1, 0), a3, 0, last);
            PG8_BAR; PG8_WAIT_L(0); PG8_MMA(1, 0, At, B0); PG8_BAR; PG8_SCHED;
            PG8_STAGE(PG8_SB(1, 1), b3 + hstep, voffB);
            PG8_WAIT_V(6); PG8_BAR; PG8_MMA(1, 1, At, B1); PG8_BAR;
            }
        }
        if constexpr (GATHER) { has_nx2 = has_next && S.next(ui + 2, nx2);
            _Pragma("unroll") for (int h = 0; h < 2; ++h) _Pragma("unroll") for (int i = 0; i < 2; ++i) gc[h][i] = gn[h][i];
            PG8_GOFF(gn, nx2.pm, has_nx2, gc); }
        if constexpr (ALIGN_EPI) { if (wr == 0) PG8_BAR; }
        if constexpr (!Epi::AFTER_DRAIN) { const int l_ = lane_id_v(); const int fr_ = l_ & 15, fq_ = l_ >> 4;
            E(acc, cur, wr, wc, fr_, fq_); S.done(cur); }
        if (!has_next) break;
#pragma unroll
        for (int a = 0; a < 2; ++a)
#pragma unroll
            for (int b = 0; b < 2; ++b)
#pragma unroll
                for (int m = 0; m < 4; ++m)
#pragma unroll
                    for (int n = 0; n < 2; ++n) acc[a][b][m][n] = (f32x4){0.f, 0.f, 0.f, 0.f};
        if constexpr (GATHER) { asm volatile("" : "+v"(gn[0][0]), "+v"(gn[0][1]), "+v"(gn[1][0]), "+v"(gn[1][1])); }
        cur = nxt; cA = nA; cB = nB; ++ui;
        if constexpr (ALIGN_EPI) { if (wr == 1) PG8_BAR; }
    }
    PG8_WAIT_V(0);
    if constexpr (!ALIGN_EPI) { if (wr == 0) PG8_BAR; }
    PG8_BAR;
    if constexpr (Epi::AFTER_DRAIN) { E.fused(acc, cur, wr, wc, fr, fq, lds, wid, lane); S.done(cur); }
#undef PG8_SA
#undef PG8_SB
#undef PG8_STAGE
#undef PG8_STAGE_A
#undef PG8_GOFF
#undef PG8_LDA
#undef PG8_LDB
#undef PG8_MMA
#undef PG8_WAIT_V
#undef PG8_WAIT_L
#undef PG8_BAR
#undef PG8_SCHED
}
}
#include <hip/hip_bf16.h>
#include <cmath>
namespace attn_body {
using bf16=__hip_bfloat16;
using bf16x8=__attribute__((ext_vector_type(8)))short;
using s16x4=__attribute__((ext_vector_type(4)))short;
using f32x16=__attribute__((ext_vector_type(16)))float;
using u32x4=__attribute__((ext_vector_type(4)))unsigned;
constexpr int BATCH=8,NHEAD=16,SEQ=4096,D=64;
constexpr int QP=512,KP=512,VP=512,OP=1024;
constexpr int NW=8,QBLK=32,QB=QBLK*NW,KVBLK=64,NQB=SEQ/QB;
constexpr int ATTN_UNIT_ROWS=QB;
__device__ __forceinline__ int crow(int r,int hi){return (r&3)+8*(r>>2)+4*hi;}
#define SBAR() __builtin_amdgcn_sched_barrier(0)
__device__ __forceinline__ void cmask(f32x16&p0,f32x16&p1,int jb,int qrel,int hi){
  const float NEG=-INFINITY; int kb=64*jb+4*hi;
  #pragma unroll
  for(int r=0;r<16;++r){int kv=kb+(r&3)+8*(r>>2); if(kv>qrel)p0[r]=NEG; if(kv+32>qrel)p1[r]=NEG;}
}

constexpr int NSLOT=3, SLOTB=8192;
constexpr int LDS_K=0, LDS_V=NSLOT*SLOTB, LDS_WS=2*NSLOT*SLOTB, LDS_OST=LDS_WS+NW*64*4, LDS_BYTES=LDS_OST+NW*4096;
constexpr float C2=0.125f*1.4426950408889634f;
__device__ __forceinline__ void glds16(const void*gsrc,unsigned lds_dst){unsigned keep;
  asm volatile("s_mov_b32 %0, m0\n\ts_mov_b32 m0, %2\n\ts_nop 0\n\tglobal_load_lds_dwordx4 %1, off\n\ts_mov_b32 m0, %0":"=&s"(keep):"v"(gsrc),"s"(lds_dst):"memory");}
__device__ __forceinline__ float max3f(float a,float b,float c){float r;asm("v_max3_f32 %0, %1, %2, %3":"=v"(r):"v"(a),"v"(b),"v"(c));return r;}
__device__ __forceinline__ float max2f(float a,float b){float r;asm("v_max_f32_e32 %0, %1, %2":"=v"(r):"v"(a),"v"(b));return r;}
__device__ __forceinline__ float fadd_s(float a,float b){float r;asm("v_add_f32_e32 %0, %1, %2":"=v"(r):"v"(a),"v"(b));return r;}
__device__ __forceinline__ float fsub_s(float a,float b){float r;asm("v_sub_f32_e32 %0, %1, %2":"=v"(r):"v"(a),"v"(b));return r;}
typedef float f32x2_t __attribute__((ext_vector_type(2))); typedef __bf16 bf16x2_t __attribute__((ext_vector_type(2)));
__device__ __forceinline__ unsigned cvtpk_s(float lo,float hi){f32x2_t v={lo,hi};bf16x2_t b=__builtin_convertvector(v,bf16x2_t);return __builtin_bit_cast(unsigned,b);}
#define WAIT_BAR(N) asm volatile("s_waitcnt vmcnt(" #N ") lgkmcnt(0)\n\ts_barrier":::"memory")

__device__ __forceinline__ void qkt(f32x16&p0,f32x16&p1,const char*Kslot,const bf16x8*qr,const f32x16&negm,int r32,int hi){
  const char*kb=Kslot+hi*1024+r32*16;
  #pragma unroll
  for(int d0=0;d0<4;++d0){
    const bf16x8 b0=*reinterpret_cast<const bf16x8*>(kb+d0*2048);
    const bf16x8 b1=*reinterpret_cast<const bf16x8*>(kb+d0*2048+512);
    if(d0==0){p0=__builtin_amdgcn_mfma_f32_32x32x16_bf16(b0,qr[0],negm,0,0,0);p1=__builtin_amdgcn_mfma_f32_32x32x16_bf16(b1,qr[0],negm,0,0,0);}
    else{p0=__builtin_amdgcn_mfma_f32_32x32x16_bf16(b0,qr[d0],p0,0,0,0);p1=__builtin_amdgcn_mfma_f32_32x32x16_bf16(b1,qr[d0],p1,0,0,0);}}
}
typedef __attribute__((address_space(3))) const char* lds_cptr;
typedef short v4i16_t __attribute__((ext_vector_type(4)));
__device__ __forceinline__ void kload8(bf16x8*kf,lds_cptr kp){
  kf[0]=*(const __attribute__((address_space(3))) bf16x8*)(kp);      kf[1]=*(const __attribute__((address_space(3))) bf16x8*)(kp+512);
  kf[2]=*(const __attribute__((address_space(3))) bf16x8*)(kp+2048); kf[3]=*(const __attribute__((address_space(3))) bf16x8*)(kp+2560);
  kf[4]=*(const __attribute__((address_space(3))) bf16x8*)(kp+4096); kf[5]=*(const __attribute__((address_space(3))) bf16x8*)(kp+4608);
  kf[6]=*(const __attribute__((address_space(3))) bf16x8*)(kp+6144); kf[7]=*(const __attribute__((address_space(3))) bf16x8*)(kp+6656);
}
__device__ __forceinline__ void kload2(bf16x8*kf,lds_cptr kp,int j){ kf[2*j]=*(const __attribute__((address_space(3))) bf16x8*)(kp+j*2048); kf[2*j+1]=*(const __attribute__((address_space(3))) bf16x8*)(kp+j*2048+512); }
__device__ __forceinline__ s16x4 vtr(lds_cptr p){ return __builtin_bit_cast(s16x4,__builtin_amdgcn_ds_read_tr16_b64_v4i16((__attribute__((address_space(3))) v4i16_t*)p)); }
__device__ __forceinline__ float rowmax(const f32x16&p0,const f32x16&p1){
  float a=max3f(p0[0],p0[1],p1[0]),b=max3f(p0[2],p0[3],p1[1]);a=max3f(a,p1[2],p1[3]);
  #pragma unroll
  for(int r=4;r<16;r+=4){a=max3f(a,p0[r],p0[r+1]);b=max3f(b,p0[r+2],p0[r+3]);a=max3f(a,p1[r],p1[r+1]);b=max3f(b,p1[r+2],p1[r+3]);}
  const float m=max2f(a,b);
  auto rr=__builtin_amdgcn_permlane32_swap(__float_as_uint(m),__float_as_uint(m),false,false);
  return max2f(__uint_as_float(rr[0]),__uint_as_float(rr[1]));
}
__device__ __forceinline__ void pv(f32x16*o,int vb,bf16x8 pa0,bf16x8 pa1,bf16x8 pa2,bf16x8 pa3){
  #pragma unroll
  for(int d0=0;d0<2;++d0){s16x4 lo[4],hi[4];
    #pragma unroll
    for(int ks=0;ks<4;++ks){
      asm volatile("ds_read_b64_tr_b16 %0,%1 offset:%c2":"=&v"(lo[ks]):"v"(vb),"i"(d0*4096+ks*1024):"memory");
      asm volatile("ds_read_b64_tr_b16 %0,%1 offset:%c2":"=&v"(hi[ks]):"v"(vb),"i"(d0*4096+ks*1024+512):"memory");}
    asm volatile("s_waitcnt lgkmcnt(0)":::"memory");SBAR();
    #define PK(k) (bf16x8){lo[k][0],lo[k][1],lo[k][2],lo[k][3],hi[k][0],hi[k][1],hi[k][2],hi[k][3]}
    o[d0]=__builtin_amdgcn_mfma_f32_32x32x16_bf16(pa0,PK(0),o[d0],0,0,0);
    o[d0]=__builtin_amdgcn_mfma_f32_32x32x16_bf16(pa1,PK(1),o[d0],0,0,0);
    o[d0]=__builtin_amdgcn_mfma_f32_32x32x16_bf16(pa2,PK(2),o[d0],0,0,0);
    o[d0]=__builtin_amdgcn_mfma_f32_32x32x16_bf16(pa3,PK(3),o[d0],0,0,0);
    #undef PK
  }
}

#ifndef ATTN_STORE16
#define ATTN_STORE16(p,v) (*(u32x4*)(p)=(v))
#endif
template<int THRL> __device__ __forceinline__ void attn_unit(int b,int h,int qb,const bf16*Q,const bf16*__restrict__ K,const bf16*__restrict__ V,bf16*O,char*shm,const int wid){
  const int qcol=(h>>1)*64, kcol=(h>>1)*64, vcol=(h>>2)*128+(h&1)*64, ocol=h*64;
  const int lane=lane_id_v(),r32=lane&31,hi=lane>>5;
  const long rowbase=(long)b*SEQ; const int q0=qb*QB;
  const bf16*Qw=Q+(rowbase+q0+wid*QBLK)*QP+qcol;
  const bf16*Kh=K+rowbase*KP+kcol,*Vh=V+rowbase*VP+vcol;
  const unsigned lds0=(unsigned)(uintptr_t)shm;
  float*wsf=(float*)(shm+LDS_WS)+wid*64;
  const bf16*ksrc=Kh+(long)lane*KP+wid*8;
  const bf16*vsrc=Vh+(long)(16*(wid&3)+(lane>>2))*VP+(wid>>2)*32+(lane&3)*8;
  const unsigned kdst=lds0+LDS_K+wid*1024, vdst=lds0+LDS_V+wid*1024;
  #define DMA_K(t,slot) glds16(ksrc+(long)(t)*KVBLK*KP,(unsigned)__builtin_amdgcn_readfirstlane(kdst+(slot)))
  #define DMA_V(t,slot) glds16(vsrc+(long)(t)*KVBLK*VP,(unsigned)__builtin_amdgcn_readfirstlane(vdst+(slot)))
  const int vb0=(int)(lds0+LDS_V)+((lane>>4)&1)*32+(lane&3)*8+(4*hi+((lane&15)>>2))*64;
  const char*Kbase=shm+LDS_K; bf16x8 kf[8];
  const lds_cptr shm3=(lds_cptr)shm; const lds_cptr kp0=shm3+LDS_K+hi*1024+r32*16; const lds_cptr vp0=shm3+LDS_V+((lane>>4)&1)*32+(lane&3)*8+(4*hi+((lane&15)>>2))*64;
  const int NT=(q0+QB)/KVBLK;
  DMA_K(0,0);DMA_V(0,0);DMA_K(1,SLOTB);
  bf16x8 qr[4];
  #pragma unroll
  for(int d0=0;d0<4;++d0)qr[d0]=*reinterpret_cast<const bf16x8*>(&Qw[(long)r32*QP+d0*16+hi*8]);
  float mhat=0.f,l_reg=0.f;f32x16 o[2];o[0]=f32x16{};o[1]=f32x16{};f32x16 negm=f32x16{};asm volatile("":"+v"(negm));
  const int qrel=wid*QBLK+r32;
  #define CMASK(P0,P1,t) do{int jb_=(t)-(NT-4); if(jb_>=0)cmask(P0,P1,jb_,qrel,hi);}while(0)
  bool resc=false;
  #define START(P0,P1) do{ const float rm=rowmax(P0,P1); resc=false; \
    { const float dl=rm; mhat=fadd_s(mhat,dl); \
      _Pragma("unroll") for(int r=0;r<16;++r){P0[r]=fsub_s(P0[r],dl);P1[r]=fsub_s(P1[r],dl);} \
      _Pragma("unroll") for(int r=0;r<16;++r)negm[r]=-mhat; asm volatile("":"+v"(negm)); } \
    _Pragma("unroll") for(int r=0;r<16;++r)P0[r]=__builtin_amdgcn_exp2f(P0[r]); }while(0)
  #define RESC() do{ if(resc){ asm volatile("s_waitcnt lgkmcnt(0)":::"memory"); \
      _Pragma("unroll") for(int d_=0;d_<2;++d_) _Pragma("unroll") for(int r=0;r<16;++r)o[d_][r]*=wsf[crow(r,hi)]; } }while(0)
  f32x16 pA0,pA1,pB0,pB1;
  int sl_prev=0,sl_cur=0,sl_next=SLOTB;
  #define ROT() do{sl_prev=sl_cur;sl_cur=sl_next;sl_next=(sl_next==(NSLOT-1)*SLOTB)?0:sl_next+SLOTB;}while(0)
  DMA_K(2,2*SLOTB);
  WAIT_BAR(3);
  qkt(pA0,pA1,Kbase,qr,negm,r32,hi);asm volatile("s_nop 15\n\ts_nop 7":"+v"(pA0),"+v"(pA1));CMASK(pA0,pA1,0);
  START(pA0,pA1);
  _Pragma("unroll") for(int r=0;r<16;++r)pA1[r]=__builtin_amdgcn_exp2f(pA1[r]);
  WAIT_BAR(0);
  DMA_K(3,0);DMA_V(1,SLOTB);
  ROT();
  kload8(kf,kp0+sl_cur);
  WAIT_BAR(2);
  s16x4 vlo[8],vhi[8]; u32x4 pw0,pw1,pw2,pw3;
  #define PKW(P,B) cvtpk_s(P[B],P[B+1])
  #define PAF(k) __builtin_bit_cast(bf16x8,pw##k)
  #define VFR(i) (bf16x8){vlo[i][0],vlo[i][1],vlo[i][2],vlo[i][3],vhi[i][0],vhi[i][1],vhi[i][2],vhi[i][3]}
  #define PIN(x) asm volatile("":"+v"(x))
  #define MX3(a,b,c) __builtin_fmaxf(__builtin_fmaxf((a),(b)),(c))
  #define GAPA(MF,A0,A1,A2,A3,W0,W1,PW) do{ MF; sacc+=A0; sacc+=A1; sacc+=A2; sacc+=A3; PIN(sacc); W0; W1; PIN(PW); SBAR(); }while(0)
  #define EX(v) __builtin_amdgcn_exp2f(v)
  #define GAPB(MF,X,B) do{ MF; X[B]=EX(X[B]); X[B+1]=EX(X[B+1]); X[B+2]=EX(X[B+2]); X[B+3]=EX(X[B+3]); PIN(X); SBAR(); }while(0)
  #define VRD(i) do{ vlo[i]=vtr(vp_+(((i)>>2)*4096+((i)&3)*1024)); vhi[i]=vtr(vp_+(((i)>>2)*4096+((i)&3)*1024+512)); }while(0)
  #define KRD(G,j) do{ if(G){ kload2(kf,kp0+sl_next,j); SBAR(); } }while(0)
  #define STEP(C0,C1,P0,P1,t,GK,GV,GL) do{ SBAR(); \
    const lds_cptr vp_=vp0+sl_prev; \
    VRD(0); SBAR(); float sacc=(P0[0]+P0[1]); \
    GAPA(C0=__builtin_amdgcn_mfma_f32_32x32x16_bf16(kf[0],qr[0],negm,0,0,0), P0[2],P0[3],P0[4],P0[5],     pw0[0]=PKW(P0,0), pw0[1]=PKW(P0,2), pw0); \
    VRD(4); SBAR(); GAPA(C1=__builtin_amdgcn_mfma_f32_32x32x16_bf16(kf[1],qr[0],negm,0,0,0), P0[6],P0[7],P0[8],P0[9],     pw0[2]=PKW(P0,4), pw0[3]=PKW(P0,6), pw0); \
    VRD(1); SBAR(); GAPA(C0=__builtin_amdgcn_mfma_f32_32x32x16_bf16(kf[2],qr[1],C0,0,0,0),   P0[10],P0[11],P0[12],P0[13], pw1[0]=PKW(P0,8), pw1[1]=PKW(P0,10), pw1); \
    VRD(5); SBAR(); GAPA(C1=__builtin_amdgcn_mfma_f32_32x32x16_bf16(kf[3],qr[1],C1,0,0,0),   P0[14],P0[15],P1[0],P1[1],   pw1[2]=PKW(P0,12),pw1[3]=PKW(P0,14), pw1); \
    VRD(2); SBAR(); GAPA(C0=__builtin_amdgcn_mfma_f32_32x32x16_bf16(kf[4],qr[2],C0,0,0,0),   P1[2],P1[3],P1[4],P1[5],     pw2[0]=PKW(P1,0), pw2[1]=PKW(P1,2), pw2); \
    VRD(6); SBAR(); GAPA(C1=__builtin_amdgcn_mfma_f32_32x32x16_bf16(kf[5],qr[2],C1,0,0,0),   P1[6],P1[7],P1[8],P1[9],     pw2[2]=PKW(P1,4), pw2[3]=PKW(P1,6), pw2); \
    VRD(3); SBAR(); GAPA(C0=__builtin_amdgcn_mfma_f32_32x32x16_bf16(kf[6],qr[3],C0,0,0,0),   P1[10],P1[11],P1[12],P1[13], pw3[0]=PKW(P1,8), pw3[1]=PKW(P1,10), pw3); \
    VRD(7); SBAR(); GAPA(C1=__builtin_amdgcn_mfma_f32_32x32x16_bf16(kf[7],qr[3],C1,0,0,0),   P1[14],P1[15],0.f,0.f,       pw3[2]=PKW(P1,12),pw3[3]=PKW(P1,14), pw3); \
    l_reg+=sacc; \
    if(GK){DMA_K((t)+3,sl_cur);} if(GV){DMA_V((t)+1,sl_next);} \
    CMASK(C0,C1,t); \
    { float a=MX3(C0[0],C0[1],C1[0]),b=MX3(C0[2],C0[3],C1[1]); a=MX3(a,C1[2],C1[3]); \
      _Pragma("unroll") for(int r=4;r<16;r+=4){a=MX3(a,C0[r],C0[r+1]);b=MX3(b,C0[r+2],C0[r+3]);a=MX3(a,C1[r],C1[r+1]);b=MX3(b,C1[r+2],C1[r+3]);} \
      float rm=__builtin_fmaxf(a,b); { auto rr=__builtin_amdgcn_permlane32_swap(__float_as_uint(rm),__float_as_uint(rm),false,false); rm=__builtin_fmaxf(__uint_as_float(rr[0]),__uint_as_float(rr[1])); } \
      resc=false; \
      if(__builtin_expect(__any(rm>(float)THRL),0)){ const float dl=__builtin_fmaxf(rm,0.f); mhat+=dl; \
        _Pragma("unroll") for(int r=0;r<16;++r){C0[r]-=dl;C1[r]-=dl;} \
        _Pragma("unroll") for(int r=0;r<16;++r)negm[r]=-mhat; asm volatile("":"+v"(negm)); \
        const float f=__builtin_amdgcn_exp2f(-dl); l_reg*=f; if(hi==0)wsf[r32]=f; resc=true; } } \
    SBAR(); \
    GAPB(o[0]=__builtin_amdgcn_mfma_f32_32x32x16_bf16(PAF(0),VFR(0),o[0],0,0,0), C0,0); \
    GAPB(o[1]=__builtin_amdgcn_mfma_f32_32x32x16_bf16(PAF(0),VFR(4),o[1],0,0,0), C0,4); \
    KRD(GL,0); GAPB(o[0]=__builtin_amdgcn_mfma_f32_32x32x16_bf16(PAF(1),VFR(1),o[0],0,0,0), C0,8); \
    KRD(GL,1); GAPB(o[1]=__builtin_amdgcn_mfma_f32_32x32x16_bf16(PAF(1),VFR(5),o[1],0,0,0), C0,12); \
    KRD(GL,2); GAPB(o[0]=__builtin_amdgcn_mfma_f32_32x32x16_bf16(PAF(2),VFR(2),o[0],0,0,0), C1,0); \
    KRD(GL,3); GAPB(o[1]=__builtin_amdgcn_mfma_f32_32x32x16_bf16(PAF(2),VFR(6),o[1],0,0,0), C1,4); \
    GAPB(o[0]=__builtin_amdgcn_mfma_f32_32x32x16_bf16(PAF(3),VFR(3),o[0],0,0,0), C1,8); \
    GAPB(o[1]=__builtin_amdgcn_mfma_f32_32x32x16_bf16(PAF(3),VFR(7),o[1],0,0,0), C1,12); \
    }while(0)
  int t=1;
  #undef CMASK
  #define CMASK(P0,P1,t) do{}while(0)
  for(;t+5<NT;t+=2){
    STEP(pB0,pB1,pA0,pA1,t,true,true,true);     WAIT_BAR(2); RESC(); ROT();
    STEP(pA0,pA1,pB0,pB1,t+1,true,true,true);   WAIT_BAR(2); RESC(); ROT();
  }
  #undef CMASK
  #define CMASK(P0,P1,t) do{int jb_=(t)-(NT-4); if(jb_>=0)cmask(P0,P1,jb_,qrel,hi);}while(0)
  #define ENDW(tt) do{ if((tt)+3<NT){WAIT_BAR(2);} else if((tt)+2<NT){WAIT_BAR(1);} else {WAIT_BAR(0);} }while(0)
  for(;t+1<NT;t+=2){
    STEP(pB0,pB1,pA0,pA1,t,(t+3<NT),(t+1<NT),(t+1<NT));       ENDW(t);   RESC(); ROT();
    STEP(pA0,pA1,pB0,pB1,t+1,(t+4<NT),(t+2<NT),(t+2<NT));     ENDW(t+1); RESC(); ROT();
  }
  STEP(pB0,pB1,pA0,pA1,NT-1,false,false,false); RESC();
  { float sacc=pB0[0]+pB0[1]; _Pragma("unroll") for(int r=2;r<16;++r)sacc+=pB0[r]; _Pragma("unroll") for(int r=0;r<16;++r)sacc+=pB1[r]; l_reg+=sacc;
    pw0=(u32x4){PKW(pB0,0),PKW(pB0,2),PKW(pB0,4),PKW(pB0,6)};pw1=(u32x4){PKW(pB0,8),PKW(pB0,10),PKW(pB0,12),PKW(pB0,14)};pw2=(u32x4){PKW(pB1,0),PKW(pB1,2),PKW(pB1,4),PKW(pB1,6)};pw3=(u32x4){PKW(pB1,8),PKW(pB1,10),PKW(pB1,12),PKW(pB1,14)};
    SBAR(); pv(o,vb0+sl_cur,PAF(0),PAF(1),PAF(2),PAF(3)); }
  #undef PKW
  #undef PAF
  #undef VFR
  #undef PIN
  #undef MX3
  #undef GAPA
  #undef GAPB
  #undef EX
  #undef VRD
  #undef KRD
  #undef STEP
  #undef ENDW
  {auto rr=__builtin_amdgcn_permlane32_swap(__float_as_uint(l_reg),__float_as_uint(l_reg),false,false);l_reg=__uint_as_float(rr[0])+__uint_as_float(rr[1]);}
  if(hi==0)wsf[32+r32]=l_reg;asm volatile("s_waitcnt lgkmcnt(0)":::"memory");
  float rli[16];
  #pragma unroll
  for(int r=0;r<16;++r)rli[r]=__builtin_amdgcn_rcpf(wsf[32+crow(r,hi)]);
  bf16*Ow=O+(rowbase+q0+wid*QBLK)*OP+ocol;
  { bf16*stg=(bf16*)(shm+LDS_OST)+wid*2048;
    #pragma unroll
    for(int r=0;r<16;++r){const int orow=crow(r,hi);
      #pragma unroll
      for(int d0=0;d0<2;++d0)stg[orow*64+d0*32+r32]=__float2bfloat16(o[d0][r]*rli[r]);}
    asm volatile("s_waitcnt lgkmcnt(0)":::"memory");
    #pragma unroll
    for(int i=0;i<4;++i){const int row=i*8+(lane>>3),ch=lane&7; const u32x4 v=*(const u32x4*)(stg+row*64+ch*8); ATTN_STORE16(Ow+(long)row*OP+ch*8,v);} }
  asm volatile("s_waitcnt lgkmcnt(0)\n\ts_barrier":::"memory");
  #undef DMA_K
  #undef DMA_V
  #undef CMASK
  #undef START
  #undef RESC
  #undef ROT
}
constexpr int ATTN_LDS_BYTES=LDS_BYTES;
struct AttnTensors { const bf16* Q; const bf16* K; const bf16* V; bf16* O; };
struct AttnUnit { int bh; int qb; };
struct QueueOrder {
  unsigned* ctr; volatile __attribute__((address_space(3))) unsigned* slot; int wid;
  __device__ __forceinline__ unsigned claim()const{ unsigned n=0u; if(wid==0&&lane_id_v()==0) n=__hip_atomic_fetch_add(ctr,1u,__ATOMIC_RELAXED,__HIP_MEMORY_SCOPE_AGENT); return n; }
  __device__ __forceinline__ unsigned publish(unsigned n,int par)const{
    if(wid==0&&lane_id_v()==0) slot[par]=n;
    asm volatile("s_waitcnt lgkmcnt(0)\n\ts_barrier":::"memory");
    const unsigned r=slot[par]; asm volatile("s_waitcnt lgkmcnt(0)":::"memory"); return r; }
  __device__ __forceinline__ void a_ready(const AttnUnit&)const{}
  __device__ __forceinline__ void done(const AttnUnit&)const{}
};
template<class Sched,int THRL=8> __device__ __forceinline__ void attn_phase(char*lds,const AttnTensors&T,const Sched&S,const int wid){
  unsigned nxt=S.claim(); int par=0;
  for(;;){ const unsigned n=S.publish(nxt,par); par^=1; if(n>=(unsigned)(BATCH*NHEAD*NQB))break;
    nxt=S.claim();
    const int qb=NQB-1-(int)(n/(BATCH*NHEAD)), bh=(int)(n%(BATCH*NHEAD));
    attn_unit<THRL>(bh/NHEAD,bh%NHEAD,qb,T.Q,T.K,T.V,T.O,lds,wid); }
}
#undef SBAR
#undef WAIT_BAR
}
constexpr int NWAVES = 8;
#ifndef MK_N_LAUNCHES
#define MK_N_LAUNCHES 1
#endif
constexpr int N_PHASES = 14;
#ifndef PROBE_MASK
#define PROBE_MASK 0
#endif
constexpr int N_LAUNCHES = MK_N_LAUNCHES;
static_assert(N_LAUNCHES == 1 || N_LAUNCHES == N_PHASES, "MK_N_LAUNCHES is 1 or 14");

constexpr int BATCH = 8, T = 4096, D = 1024, M = BATCH * T;
constexpr int IN_COLS = 3328, RWC = 1792, NEXP = 32, TOPK = 4, NMOD = 6 * D;
constexpr int MAXROWS = M * TOPK + NEXP * 256;
constexpr int MOD_KS = 8;

constexpr size_t MiB = 1u << 20, KiB = 1u << 10;
constexpr size_t WS_CTL = 0, CTL_ZERO_BYTES = 1 * MiB;
constexpr size_t WS_MODP = 1 * MiB;
constexpr size_t WS_MOD = 2 * MiB + 512 * KiB;
constexpr size_t WS_ROPE = 3 * MiB;
constexpr size_t WS_WIN = 5 * MiB;
constexpr size_t WS_WOUT = 12 * MiB;
constexpr size_t WS_BLORA = 14 * MiB;
constexpr size_t WS_TOKE = 15 * MiB, WS_TOKG = 15 * MiB + 512 * KiB;
constexpr size_t WS_TOKROW = 16 * MiB, WS_ROWTOK = 16 * MiB + 512 * KiB, WS_ROWGATE = 17 * MiB + 256 * KiB, WS_BLKBASE = 18 * MiB;
constexpr size_t WS_W1 = 20 * MiB, WS_W2 = 148 * MiB;
constexpr size_t WS_H2 = 212 * MiB;
constexpr size_t WS_H = 276 * MiB, WS_Q = 340 * MiB, WS_K = 372 * MiB, WS_V = 404 * MiB, WS_RW = 436 * MiB;
constexpr size_t WS_O = 548 * MiB, WS_YCAT = 612 * MiB, WS_LACT = 676 * MiB;
constexpr size_t WS_LW = 692 * MiB, WS_AS = 756 * MiB, WS_G = 820 * MiB, WS_Y = 884 * MiB;
constexpr size_t WS_RIMG = 884 * MiB, WS_RBON = 1012 * MiB;
constexpr size_t WS_ACT = 276 * MiB, WS_Y2 = 548 * MiB, WS_END = 1013 * MiB;
static_assert(WS_ROWTOK + (size_t)MAXROWS * 4 <= WS_ROWGATE && WS_ROWGATE + (size_t)MAXROWS * 4 <= WS_BLKBASE && WS_ACT + (size_t)MAXROWS * 2048 <= WS_Y2 && WS_Y2 + (size_t)MAXROWS * 2048 <= WS_Y, "d_ws map");
constexpr int CW_TMO = 0, CW_CODE = 1;
constexpr int CW_BAR = 4096;
constexpr int CW_ATTQ = 8192;
constexpr int CW_ECNT = 12288;
static_assert((CW_ECNT + 2 * 64 * NEXP) * 4 <= (int)CTL_ZERO_BYTES, "CTL words inside the memset region");

constexpr int RING_OFF = 0, RING_BYTES = 131072;
constexpr int LDSCTL_OFF = RING_BYTES, MISC_OFF = LDSCTL_OFF + 320;
constexpr int LDS_BYTES = 147456;
static_assert(MISC_OFF + 128 <= LDS_BYTES, "LDS map");
#define GAS __attribute__((address_space(1)))
#define LAS __attribute__((address_space(3)))
typedef unsigned short bf16;
typedef unsigned v4u __attribute__((ext_vector_type(4)));
typedef float f32x4 __attribute__((ext_vector_type(4)));
typedef short bf16x8 __attribute__((ext_vector_type(8)));
typedef GAS unsigned gu32;
typedef GAS unsigned long long gu64;
#define RLX_AGENT __ATOMIC_RELAXED, __HIP_MEMORY_SCOPE_AGENT
#define LDS_WAIT() asm volatile("s_waitcnt lgkmcnt(0)" ::: "memory")
#define VM_WAIT() asm volatile("s_waitcnt vmcnt(0)" ::: "memory")
__device__ __forceinline__ unsigned long long rt() { return __builtin_amdgcn_s_memrealtime(); }
__device__ __forceinline__ unsigned f2bf(float f) { unsigned u = __builtin_bit_cast(unsigned, f); return (u + 0x7fffu + ((u >> 16) & 1u)) >> 16; }
__device__ __forceinline__ unsigned pk2(float lo, float hi) { return f2bf(lo) | (f2bf(hi) << 16); }

#define XB_TMO      128
#define XB_XCNT(j)  (256  + 64 * (j))
#define XB_XSUB(j)  (1280 + 64 * (j))
#define XB_XGEN(j)  (2304 + 64 * (j))
#define XB_TOP      3328
#define XB_TOPGEN   3392
#define XCD_BAR_WORDS 3456
#define XB_SPIN_CAP (1u << 18)

__device__ __forceinline__ unsigned xb_ld(unsigned* p)              { return __hip_atomic_load(p, __ATOMIC_RELAXED, __HIP_MEMORY_SCOPE_AGENT); }
__device__ __forceinline__ unsigned xb_add(unsigned* p, unsigned v) { return __hip_atomic_fetch_add(p, v, __ATOMIC_RELAXED, __HIP_MEMORY_SCOPE_AGENT); }
__device__ __forceinline__ unsigned xb_xcc_id() { return (unsigned)__builtin_amdgcn_s_getreg((3 << 11) | 20) & 0xFu; }
#define XB_SPIN(cond, bar) do { unsigned _sp = 0; while (cond) { __builtin_amdgcn_s_sleep(1); \
    if ((++_sp & 255u) == 0u) { if (xb_ld(&(bar)[XB_TMO])) break; if (_sp > XB_SPIN_CAP) { atomicAdd(&(bar)[XB_TMO], 1u); break; } } } } while (0)

struct XcdBarrier {
    unsigned* bar; unsigned x; int wid;
    volatile LAS unsigned* st;
};

__device__ __forceinline__ XcdBarrier xcd_barrier_post(unsigned* bar, volatile LAS unsigned* st, int wid) {
    XcdBarrier b; b.bar = bar; b.x = xb_xcc_id(); b.st = st; b.wid = wid;
    if (threadIdx.x == 0) (void)xb_add(&bar[XB_XCNT(b.x)], 1u);
    return b;
}
__device__ __forceinline__ void xcd_barrier_complete(unsigned* bar, unsigned x, unsigned& nloc, unsigned& nx) {
    const unsigned G = gridDim.x * gridDim.y * gridDim.z;
    unsigned sum, cnt, mine, sp = 0u;
    for (;;) {
        sum = 0u; cnt = 0u; mine = 0u;
#pragma unroll
        for (unsigned j = 0; j < 16; ++j) { const unsigned c = xb_ld(&bar[XB_XCNT(j)]); sum += c; cnt += (c > 0u) ? 1u : 0u; mine = (j == x) ? c : mine; }
        if (sum == G) break;
        __builtin_amdgcn_s_sleep(1);
        if ((++sp & 255u) == 0u) { if (xb_ld(&bar[XB_TMO])) break; if (sp > XB_SPIN_CAP) { atomicAdd(&bar[XB_TMO], 1u); break; } }
    }
    nloc = mine > 0u ? mine : 1u; nx = cnt > 0u ? cnt : 1u;
}

__device__ __forceinline__ void xcd_barrier(const XcdBarrier& b) {
    asm volatile("s_waitcnt vmcnt(0)" ::: "memory");
    __syncthreads();
    if (b.wid == 0 && lane_id_v() == 0) {
        unsigned* bar = b.bar;
        __builtin_amdgcn_s_waitcnt(0);
        unsigned nloc = b.st[0], nx = b.st[1];
        if (nloc == 0u) { xcd_barrier_complete(bar, b.x, nloc, nx); b.st[0] = nloc; b.st[1] = nx; }
        const unsigned old = xb_add(&bar[XB_XSUB(b.x)], 1u);
        const unsigned gen = old / nloc;
        if (old + 1u == (gen + 1u) * nloc) {
            __builtin_amdgcn_fence(__ATOMIC_RELEASE, "agent");
            asm volatile("s_waitcnt vmcnt(0)" ::: "memory");
            const unsigned og = xb_add(&bar[XB_TOP], 1u);
            const unsigned tg = og / nx;
            if (og + 1u == (tg + 1u) * nx) xb_add(&bar[XB_TOPGEN], 1u);
            else XB_SPIN(xb_ld(&bar[XB_TOPGEN]) == tg, bar);
            __builtin_amdgcn_fence(__ATOMIC_ACQUIRE, "agent");
            xb_add(&bar[XB_XGEN(b.x)], 1u);
            asm volatile("s_waitcnt vmcnt(0)" ::: "memory");
        } else {
            XB_SPIN(xb_ld(&bar[XB_XGEN(b.x)]) == gen, bar);
            __builtin_amdgcn_fence(__ATOMIC_ACQUIRE, "agent");
            asm volatile("s_waitcnt vmcnt(0)" ::: "memory");
        }
    }
    __syncthreads();
}
typedef float f32x2 __attribute__((ext_vector_type(2)));
typedef unsigned u32x2 __attribute__((ext_vector_type(2)));
struct Frame {
    LAS unsigned char* lds;
    volatile LAS unsigned* MISC;
    gu32* ctl;
    int wave;
    int vcu, G;
    unsigned char* ws; float* out;
};
struct Args { const void* in[33]; float* out; unsigned char* ws; int ph_lo, ph_hi, li, pad; };
struct InProxy { __device__ __forceinline__ const void* operator[](int k) const { unsigned long long v; const unsigned long long kp = (unsigned long long)__builtin_amdgcn_kernarg_segment_ptr();
    asm volatile("s_load_dwordx2 %0, %1, %2\n\ts_waitcnt lgkmcnt(0)" : "=s"(v) : "s"(kp), "s"(8 * k) : "memory"); return (const void*)(const GAS unsigned char*)v; } };
struct ArgsD { InProxy in; };

__device__ __forceinline__ float wave_sum(float v) {
#pragma unroll
    for (int o = 1; o < 64; o <<= 1) v += __shfl_xor(v, o);
    return v;
}
__device__ __forceinline__ float bf2f(unsigned short u) { return __uint_as_float((unsigned)u << 16); }
__device__ __forceinline__ float bflo(unsigned u) { return __uint_as_float(u << 16); }
__device__ __forceinline__ float bfhi(unsigned u) { return __uint_as_float(u & 0xffff0000u); }
typedef float f32x2_t __attribute__((ext_vector_type(2))); typedef __bf16 bf16x2_t __attribute__((ext_vector_type(2)));
__device__ __forceinline__ unsigned pkbf(float lo, float hi) { f32x2_t v = {lo, hi}; bf16x2_t b = __builtin_convertvector(v, bf16x2_t); return __builtin_bit_cast(unsigned, b); }
#define DPP_ADD(x, ctrl) ((x) + __builtin_bit_cast(float, __builtin_amdgcn_update_dpp(0, __builtin_bit_cast(int, (x)), (ctrl), 0xF, 0xF, true)))
__device__ __forceinline__ float allsum16(float x) {
    x = DPP_ADD(x, 0xB1); x = DPP_ADD(x, 0x4E); x = DPP_ADD(x, 0x124); x = DPP_ADD(x, 0x128); return x; }

struct P0Item { const float* src; bf16* dst; int N, K, n0; bool permq, fp8; };
__device__ __forceinline__ bool p0_decode(const Frame& F, int it, P0Item& d, const float* w_in, const float* w_out, const float* w1, const float* w2m) {
    constexpr int I_IN = (D / 64) * (IN_COLS / 32), I_OUT = (D / 64) * (D / 32), I_W1 = (D / 64) * (2048 / 32), I_W2 = (D / 64) * (D / 32);
    constexpr int NITEMS = I_IN + I_OUT + NEXP * I_W1 + NEXP * I_W2;
    if (it >= NITEMS) return false;
    const float* W; bf16* WT; int N, r = it; d.permq = false; d.fp8 = false; d.K = D;
    if (r < I_IN) { W = w_in; WT = (bf16*)(F.ws + WS_WIN); N = IN_COLS; d.permq = true; }
    else { r -= I_IN; if (r < I_OUT) { W = w_out; WT = (bf16*)(F.ws + WS_WOUT); N = D; }
        else { r -= I_OUT; if (r < NEXP * I_W1) { const int e = r / I_W1; r -= e * I_W1; W = w1 + (size_t)e * D * 2048; WT = (bf16*)(F.ws + WS_W1 + (size_t)e * 2048 * D); N = 2048; d.fp8 = true; }
            else { r -= NEXP * I_W1; const int e = r / I_W2; r -= e * I_W2; W = w2m + (size_t)e * D * D; WT = (bf16*)(F.ws + WS_W2 + (size_t)e * D * D); N = D; d.fp8 = true; } } }
    const int nblk = N / 32, kb = r / nblk, nb = r - kb * nblk; d.N = N; d.n0 = 32 * nb; d.src = W + (size_t)(64 * kb) * N + d.n0; d.dst = d.fp8 ? (bf16*)((unsigned char*)WT + 64 * kb) : WT + 64 * kb; return true;
}
__device__ __forceinline__ void p0_item_store(const P0Item& d, const float (&v)[32], LAS float* scr, int lane) {
#pragma unroll
    for (int i = 0; i < 32; ++i) scr[(2 * i + (lane >> 5)) * 33 + (lane & 31)] = v[i];
    LDS_WAIT(); asm volatile("" ::: "memory");
    const int c = lane & 7;
#pragma unroll
    for (int j = 0; j < 4; ++j) { const int n = (lane >> 3) + 8 * j; const LAS float* s = scr + (8 * c) * 33 + n;
        int nn = d.n0 + n;
        if (d.fp8) { const u32x2 o8 = (u32x2){pg8::pk4_fp8(s[0 * 33] * pg8::W8_SCALE, s[1 * 33] * pg8::W8_SCALE, s[2 * 33] * pg8::W8_SCALE, s[3 * 33] * pg8::W8_SCALE), pg8::pk4_fp8(s[4 * 33] * pg8::W8_SCALE, s[5 * 33] * pg8::W8_SCALE, s[6 * 33] * pg8::W8_SCALE, s[7 * 33] * pg8::W8_SCALE)};
            *(GAS u32x2*)((unsigned char*)d.dst + (size_t)nn * d.K + 8 * c) = o8; }
        else { v4u o; o.x = pkbf(s[0 * 33], s[1 * 33]); o.y = pkbf(s[2 * 33], s[3 * 33]); o.z = pkbf(s[4 * 33], s[5 * 33]); o.w = pkbf(s[6 * 33], s[7 * 33]);
            if (d.permq && nn < 1024) { const int dd = nn & 63; if (dd < 16) nn = (nn & ~63) + ((dd < 8) ? 2 * dd : 2 * (dd - 8) + 1); }
            *(GAS v4u*)(d.dst + (size_t)nn * d.K + 8 * c) = o; } }
    LDS_WAIT(); asm volatile("" ::: "memory");
}
__device__ __forceinline__ void sincos_d(float af, float& s, float& c) {
    const double a = (double)af; const double n = __builtin_rint(a * 0.63661977236758134308);
    double r = __builtin_fma(-n, 1.57079632679489655800e+00, a); r = __builtin_fma(-n, 6.12323399573676603587e-17, r);
    const double r2 = r * r;
    double sp = 1.0 / 6227020800.0; sp = sp * r2 * -1.0 + 1.0 / 39916800.0; sp = -sp * r2 + 1.0 / 362880.0; sp = -sp * r2 + 1.0 / 5040.0; sp = -sp * r2 + 1.0 / 120.0; sp = -sp * r2 + 1.0 / 6.0; sp = r - r * r2 * sp;
    double cp = 1.0 / 87178291200.0; cp = -cp * r2 + 1.0 / 479001600.0; cp = -cp * r2 + 1.0 / 3628800.0; cp = -cp * r2 + 1.0 / 40320.0; cp = -cp * r2 + 1.0 / 720.0; cp = -cp * r2 + 1.0 / 24.0; cp = -cp * r2 + 0.5; cp = 1.0 - r2 * cp;
    const int q = ((int)n) & 3;
    const double sv = (q == 0) ? sp : (q == 1) ? cp : (q == 2) ? -sp : -cp, cv = (q == 0) ? cp : (q == 1) ? -sp : (q == 2) ? -cp : sp;
    s = (float)sv; c = (float)cv;
}
__device__ __forceinline__ void p0_prologue(Frame& F, const ArgsD& A) {
    const int lane = lane_id_v(), tid = F.wave * 64 + lane; (void)tid;
    const int gw = F.vcu * NWAVES + F.wave, NGW = F.G * NWAVES, gt = F.vcu * 512 + tid, NGT = F.G * 512;
    LAS float* scr = (LAS float*)(F.lds + RING_OFF + F.wave * 12288);
    LAS float* sl = (LAS float*)(F.lds + RING_OFF + 98304);
    const float* c = (const float*)A.in[1];
    for (int i = tid; i < 8 * 1024; i += 512) { const float v = c[i]; sl[i] = v / (1.f + __expf(-v)); }
    __syncthreads();
    { const float* aw = (const float*)A.in[3]; float* modp = (float*)(F.ws + WS_MODP);
      for (int it = gw; it < 96 * MOD_KS; it += NGW) { const int cc = it % 96, ks = it / 96, col = cc * 64 + lane;
          float acc[8];
#pragma unroll
          for (int b = 0; b < 8; ++b) acc[b] = 0.f;
          for (int k = ks * 128; k < ks * 128 + 128; ++k) { const float w = aw[(size_t)k * NMOD + col];
#pragma unroll
              for (int b = 0; b < 8; ++b) acc[b] += sl[b * 1024 + k] * w; }
#pragma unroll
          for (int b = 0; b < 8; ++b) modp[(size_t)(ks * 8 + b) * NMOD + col] = acc[b]; } }
    { const int* pos = (const int*)A.in[2]; float* rope = (float*)(F.ws + WS_ROPE);
      for (int idx = gt; idx < M * 8; idx += NGT) { const int m = idx >> 3, i = idx & 7;
          const float invf = (i == 0) ? 1.0f : (i == 1) ? 0.1939227432012558f : (i == 2) ? 0.03760603070259094f : (i == 3) ? 0.007292664609849453f : (i == 4) ? 0.0014142135623842478f : (i == 5) ? 0.00027424818836152554f : (i == 6) ? 5.318296098266728e-05f : 1.0313386155758053e-05f;
          const float ang = (float)pos[m] * invf; float s, cc; sincos_d(ang, s, cc); rope[(size_t)m * 16 + i] = cc; rope[(size_t)m * 16 + 8 + i] = s; } }
    { const float* w2 = (const float*)A.in[18]; const float* a2 = (const float*)A.in[20]; const float* g2 = (const float*)A.in[21]; bf16* bl = (bf16*)(F.ws + WS_BLORA);
      for (int idx = gt; idx < 1536 * 256; idx += NGT) { const int n = idx >> 8, k = idx & 255, blk = n >> 9, nn = n & 511; float v = 0.f;
          if (blk == 0 && k < 64) v = w2[k * 512 + nn]; else if (blk == 1 && k >= 64 && k < 128) v = a2[(k - 64) * 512 + nn]; else if (blk == 2 && k >= 128) v = g2[(k - 128) * 512 + nn];
          bl[idx] = (bf16)(pkbf(v, 0.f) & 0xffffu); } }
    { const float* w_in = (const float*)A.in[9]; const float* w_out = (const float*)A.in[10]; const float* w1 = (const float*)A.in[29]; const float* w2m = (const float*)A.in[31];
      P0Item cur, nxt; float v[32], vn[32];
      bool have = p0_decode(F, gw, cur, w_in, w_out, w1, w2m);
      if (have) {
#pragma unroll
          for (int i = 0; i < 32; ++i) v[i] = cur.src[(size_t)(2 * i + (lane >> 5)) * cur.N + (lane & 31)]; }
      for (int it = gw; have; it += NGW) {
          const bool hn = p0_decode(F, it + NGW, nxt, w_in, w_out, w1, w2m);
          if (hn) {
#pragma unroll
              for (int i = 0; i < 32; ++i) vn[i] = nxt.src[(size_t)(2 * i + (lane >> 5)) * nxt.N + (lane & 31)]; }
          p0_item_store(cur, v, scr, lane);
          cur = nxt; have = hn;
#pragma unroll
          for (int i = 0; i < 32; ++i) v[i] = vn[i];
      } }
}

__device__ __forceinline__ void p1_premix(Frame& F, const ArgsD& A) {
    const int lane = lane_id_v(), tid = F.wave * 64 + lane; (void)tid;
    const float* modp = (const float*)(F.ws + WS_MODP); const float* ada_b = (const float*)A.in[4]; float* mod = (float*)(F.ws + WS_MOD);
    const int rows_per = M / F.G, mbeg = F.vcu * rows_per, b = mbeg >> 12;
    LAS float* ms = (LAS float*)(F.lds + RING_OFF);
    for (int col = tid; col < 2048; col += 512) { float s = ada_b[col];
#pragma unroll
        for (int ks = 0; ks < MOD_KS; ++ks) s += modp[(size_t)(ks * 8 + b) * NMOD + col];
        ms[col] = s; }
    for (int i = F.vcu * 512 + tid; i < 8 * 4096; i += F.G * 512) { const int bb = i >> 12, col = 2048 + (i & 4095); float s = ada_b[col];
#pragma unroll
        for (int ks = 0; ks < MOD_KS; ++ks) s += modp[(size_t)(ks * 8 + bb) * NMOD + col];
        mod[(size_t)bb * NMOD + col] = s; }
    __syncthreads();
    const float* x = (const float*)A.in[0]; const float* nw = (const float*)A.in[5]; bf16* H = (bf16*)(F.ws + WS_H);
    f32x4 wsc[4], sh[4];
#pragma unroll
    for (int j = 0; j < 4; ++j) { const int col = 4 * lane + 256 * j; wsc[j] = *((const f32x4*)nw + lane + 64 * j) * (*(const LAS f32x4*)(ms + 1024 + col) + 1.f); sh[j] = *(const LAS f32x4*)(ms + col); }
    const int nr = rows_per / NWAVES, m0 = mbeg + F.wave * nr;
    f32x4 pv[4];
#pragma unroll
    for (int j = 0; j < 4; ++j) pv[j] = *((const GAS f32x4*)(x + (size_t)m0 * D) + lane + 64 * j);
    for (int i = 0; i < nr; ++i) { const int m = m0 + i;
        f32x4 v[4]; float s2 = 0.f;
#pragma unroll
        for (int j = 0; j < 4; ++j) { v[j] = pv[j]; s2 += (v[j].x * v[j].x + v[j].y * v[j].y) + (v[j].z * v[j].z + v[j].w * v[j].w); }
        if (i + 1 < nr) {
#pragma unroll
            for (int j = 0; j < 4; ++j) pv[j] = *((const GAS f32x4*)(x + (size_t)(m + 1) * D) + lane + 64 * j); }
        const float rs = __builtin_amdgcn_rsqf(wave_sum(s2) * (1.f / D) + 1e-6f);
        GAS u32x2* o8 = (GAS u32x2*)(H + (size_t)m * D) + lane;
#pragma unroll
        for (int j = 0; j < 4; ++j) { const f32x4 y = v[j] * rs * wsc[j] + sh[j]; o8[64 * j] = (u32x2){pkbf(y.x, y.y), pkbf(y.z, y.w)}; } }
}

__device__ __forceinline__ void p3_lact(Frame& F, const ArgsD& A) {
    const int lane = lane_id_v(), tid = F.wave * 64 + lane; (void)tid;
    const bf16* RW = (const bf16*)(F.ws + WS_RW); bf16* L = (bf16*)(F.ws + WS_LACT); const float* mu = (const float*)A.in[16] + 1536;
    const int gw = F.vcu * NWAVES + F.wave, NGW = F.G * NWAVES, c0 = 4 * lane;
    const f32x4 mu4 = *(const f32x4*)(mu + c0);
    for (int m = gw; m < M; m += NGW) { const int t = m & (T - 1);
        const u32x2 p = *(const GAS u32x2*)(RW + (size_t)m * RWC + 1536 + c0); u32x2 q = (u32x2){0u, 0u}; if (t > 0) q = *(const GAS u32x2*)(RW + (size_t)(m - 1) * RWC + 1536 + c0);
        f32x4 pv = (f32x4){bflo(p.x), bfhi(p.x), bflo(p.y), bfhi(p.y)}, qv = (f32x4){bflo(q.x), bfhi(q.x), bflo(q.y), bfhi(q.y)};
        f32x4 s = pv + (qv - pv) * mu4;
        if (c0 < 64) { s.x = tanhf(s.x); s.y = tanhf(s.y); s.z = tanhf(s.z); s.w = tanhf(s.w); }
        else if (c0 >= 128) { s.x = 1.f / (1.f + __expf(-s.x)); s.y = 1.f / (1.f + __expf(-s.y)); s.z = 1.f / (1.f + __expf(-s.z)); s.w = 1.f / (1.f + __expf(-s.w)); }
        *(GAS u32x2*)(L + (size_t)m * 256 + c0) = (u32x2){pkbf(s.x, s.y), pkbf(s.z, s.w)}; }
}

namespace rwk {
typedef short bf16x8 __attribute__((ext_vector_type(8)));
constexpr int MB = 8192;
__device__ __forceinline__ int moff(int r, int c) { return r * 128 + ((((c >> 3) ^ (r >> 1)) & 7) << 4) + ((c & 7) << 1); }
__device__ __forceinline__ bf16x8 frag(const LAS unsigned char* buf, int row, int chunk) { return *(const LAS bf16x8*)(buf + row * 128 + (((chunk ^ (row >> 1)) & 7) << 4)); }
struct LaneOff { int f[2], sb, mb[2]; };
__device__ __forceinline__ LaneOff lane_off(int l) { LaneOff o; const int r16 = l & 15, q = l >> 4, key = (l >> 1) & 7;
    o.f[0] = r16 * 128 + (((q) ^ key) << 4); o.f[1] = r16 * 128 + (((4 + q) ^ key) << 4);
    o.sb = r16 * 128 + ((((q >> 1) ^ key) & 7) << 4) + (q & 1) * 8;
#pragma unroll
    for (int p = 0; p < 2; ++p) { const int keyr = (2 * q + p) & 7; o.mb[p] = (4 * q + 2 * p) * 128 + ((((r16 >> 3) ^ keyr) & 7) << 4) + (r16 & 7) * 2; }
    return o; }
__device__ __forceinline__ void mm(f32x4& acc, const LAS unsigned char* A, int tm, const LAS unsigned char* B, int tn, const LaneOff& o) {
#pragma unroll
    for (int ks = 0; ks < 2; ++ks) { const bf16x8 a = *(const LAS bf16x8*)(A + tm * 2048 + o.f[ks]), b = *(const LAS bf16x8*)(B + tn * 2048 + o.f[ks]); acc = __builtin_amdgcn_mfma_f32_16x16x32_bf16(a, b, acc, 0, 0, 0); }
}
__device__ __forceinline__ void st_nm(LAS unsigned char* buf, int tm, int tn, const LaneOff& o, f32x4 v) {
    *(LAS u32x2*)(buf + tn * 2048 + (o.sb ^ (tm << 5))) = (u32x2){pkbf(v[0], v[1]), pkbf(v[2], v[3])}; }
__device__ __forceinline__ void st_mn(LAS unsigned char* buf, int tm, int tn, const LaneOff& o, f32x4 v) {
    const unsigned p0 = pkbf(v[0], v[1]), p1 = pkbf(v[2], v[3]); LAS unsigned char* b0 = buf + tm * 2048 + (o.mb[0] ^ (tn << 5)); LAS unsigned char* b1 = buf + tm * 2048 + (o.mb[1] ^ (tn << 5));
    *(LAS unsigned short*)(b0) = (unsigned short)(p0 & 0xffffu); *(LAS unsigned short*)(b0 + 128) = (unsigned short)(p0 >> 16);
    *(LAS unsigned short*)(b1) = (unsigned short)(p1 & 0xffffu); *(LAS unsigned short*)(b1 + 128) = (unsigned short)(p1 >> 16); }
__device__ __forceinline__ f32x4 ld_nm(const LAS unsigned char* buf, int tm, int tn, const LaneOff& o) {
    const u32x2 p = *(const LAS u32x2*)(buf + tn * 2048 + (o.sb ^ (tm << 5))); return (f32x4){bflo(p.x), bfhi(p.x), bflo(p.y), bfhi(p.y)}; }
__device__ __forceinline__ float wsum64(float x) {
    x = DPP_ADD(x, 0xB1); x = DPP_ADD(x, 0x4E); x = DPP_ADD(x, 0x124); x = DPP_ADD(x, 0x128);
    x += __shfl_xor(x, 16); x += __shfl_xor(x, 32); return x; }
__device__ __forceinline__ float sum8(float x) { x = DPP_ADD(x, 0xB1); x = DPP_ADD(x, 0x4E); x = DPP_ADD(x, 0x141); return x; }
}

__device__ __forceinline__ void rwkv_pre(Frame& F, const ArgsD& A, const int bh, const int c_lo, const int c_hi) {
    using namespace rwk;
    const int b = bh >> 3, h = bh & 7, lane0 = lane_id_v(), w0 = F.wave;
    const LaneOff LO = lane_off(lane0);
    LAS unsigned char* L = F.lds + RING_OFF;
    LAS unsigned char* bA = L + 0 * MB; LAS unsigned char* bR = L + 1 * MB; LAS unsigned char* bB = L + 2 * MB; LAS unsigned char* bK = L + 3 * MB;
    LAS unsigned char* bBH = L + 4 * MB; LAS unsigned char* bKH = L + 5 * MB; LAS unsigned char* bVT = L + 6 * MB;
    LAS unsigned char* bAT = L + 7 * MB;
    LAS unsigned char* bAak = L + 9 * MB; LAS unsigned char* bArb = L + 10 * MB; LAS unsigned char* bArk = L + 11 * MB;
    LAS unsigned char* bQ0 = L + 12 * MB; LAS unsigned char* bQT0 = L + 13 * MB;
    LAS unsigned char* bT = L + 14 * MB;
    LAS unsigned char* bTF = L + 15 * MB;
    LAS float* part = (LAS float*)(F.lds + MISC_OFF + 128);
    LAS float* bon = part + 512;
    const bf16* RW = (const bf16*)(F.ws + WS_RW); const bf16* LW = (const bf16*)(F.ws + WS_LW); const bf16* AS = (const bf16*)(F.ws + WS_AS);
    unsigned char* IMG = F.ws + WS_RIMG; float* BON = (float*)(F.ws + WS_RBON);
    const size_t mb = (size_t)b * T;
    const float* mu = (const float*)A.in[16];
    float mu_r, mu_k, mu_v, kkc, kac, rkc;
    { const int hj = h * 64 + lane0; mu_r = mu[hj]; mu_k = mu[512 + hj]; mu_v = mu[1024 + hj]; kkc = ((const float*)A.in[22])[hj]; kac = ((const float*)A.in[23])[hj]; rkc = ((const float*)A.in[24])[hj]; }
    unsigned short pr[9], pk_[9], pv[9], plw[8], pas[8];
#define RWC_LOAD(c) do { const int w = w0, hj = h * 64 + lane0; const size_t m0_ = mb + (size_t)(c) * 64 + 8 * w; \
        _Pragma("unroll") for (int i_ = 0; i_ < 9; ++i_) { const bool ok_ = (i_ > 0) || ((c) > 0) || (w > 0); const bf16* row_ = RW + (m0_ + i_ - 1) * RWC + hj; \
            pr[i_] = ok_ ? row_[0] : (unsigned short)0; pk_[i_] = ok_ ? row_[512] : (unsigned short)0; pv[i_] = ok_ ? row_[1024] : (unsigned short)0; } \
        _Pragma("unroll") for (int i_ = 0; i_ < 8; ++i_) { plw[i_] = LW[(m0_ + i_) * 512 + hj]; pas[i_] = AS[(m0_ + i_) * 512 + hj]; } } while (0)
    RWC_LOAD(c_lo);
    for (int c = c_lo; c < c_hi; ++c) {
        int w = w0, lane = lane0; asm volatile("" : "+s"(w), "+v"(lane));
        const int tn_ = w & 3, tm0_ = 2 * (w >> 2);
        { float run = 0.f;
#pragma unroll
          for (int i = 0; i < 8; ++i) run += bf2f(plw[i]);
          part[w * 64 + lane] = run; }
        __syncthreads();
        float off = 0.f, ctot = 0.f;
#pragma unroll
        for (int o = 0; o < 8; ++o) { const float p = part[o * 64 + lane]; ctot += p; if (o < w) off += p; }
        {   unsigned bh_[4], kh_[4], vt_[4], at_[4]; float cm = off; float* bon_g = BON + ((size_t)bh * 64 + c) * 64;
#pragma unroll
            for (int i = 0; i < 8; ++i) { const int t = 8 * w + i;
                const float p0 = bf2f(pr[i + 1]), p1 = bf2f(pk_[i + 1]), p2 = bf2f(pv[i + 1]);
                const float rv = p0 + (bf2f(pr[i]) - p0) * mu_r, kv = p1 + (bf2f(pk_[i]) - p1) * mu_k, vv = p2 + (bf2f(pv[i]) - p2) * mu_v, asg = bf2f(pas[i]);
                const float ce = cm; cm += bf2f(plw[i]);
                float kkv = kv * kkc; const float n2 = wsum64(kkv * kkv); kkv = kkv * __builtin_amdgcn_rsqf(fmaxf(n2, 1e-24f));
                const float km = kv * (1.f + (asg - 1.f) * kac); const float bn = wsum64(rv * km * rkc); if (lane == 0) bon_g[t] = bn;
                const float av = -kkv, bv = kkv * asg;
                const float e_ce = __expf(ce), e_cm = __expf(cm), e_ncm = __expf(-cm), e_rem = __expf(ctot - cm);
                const unsigned ha = pkbf(av * e_ce, 0.f) & 0xffffu; *(LAS unsigned short*)(bA + moff(t, lane)) = (unsigned short)ha; *(LAS unsigned short*)(bR + moff(t, lane)) = (unsigned short)(pkbf(rv * e_cm, 0.f) & 0xffffu);
                *(LAS unsigned short*)(bB + moff(t, lane)) = (unsigned short)(pkbf(bv * e_ncm, 0.f) & 0xffffu); *(LAS unsigned short*)(bK + moff(t, lane)) = (unsigned short)(pkbf(km * e_ncm, 0.f) & 0xffffu);
                const unsigned hb = pkbf(bv * e_rem, 0.f) & 0xffffu, hk = pkbf(km * e_rem, 0.f) & 0xffffu, hv = pkbf(vv, 0.f) & 0xffffu;
                if (i & 1) { bh_[i >> 1] |= hb << 16; kh_[i >> 1] |= hk << 16; vt_[i >> 1] |= hv << 16; at_[i >> 1] |= ha << 16; } else { bh_[i >> 1] = hb; kh_[i >> 1] = hk; vt_[i >> 1] = hv; at_[i >> 1] = ha; } }
            *(LAS v4u*)(bBH + moff(lane, 8 * w)) = (v4u){bh_[0], bh_[1], bh_[2], bh_[3]};
            *(LAS v4u*)(bKH + moff(lane, 8 * w)) = (v4u){kh_[0], kh_[1], kh_[2], kh_[3]};
            *(LAS v4u*)(bVT + moff(lane, 8 * w)) = (v4u){vt_[0], vt_[1], vt_[2], vt_[3]};
            *(LAS v4u*)(bAT + moff(lane, 8 * w)) = (v4u){at_[0], at_[1], at_[2], at_[3]};
        }
        const float dec0 = __expf(ctot);
        if (c + 1 < c_hi) RWC_LOAD(c + 1);
        __syncthreads();
        {   const int p = w >> 1; const LAS unsigned char* Am = (p < 2) ? bA : bR; const LAS unsigned char* Bm = (p == 0 || p == 2) ? bB : bK;
#pragma unroll
            for (int x = 0; x < 2; ++x) { const int tm = 2 * (w & 1) + x;
#pragma unroll
                for (int tn = 0; tn < 4; ++tn) { f32x4 acc = (f32x4){0.f, 0.f, 0.f, 0.f}; mm(acc, Am, tm, Bm, tn, LO);
                    const int n = 16 * tn + (lane & 15), m0 = 16 * tm + 4 * (lane >> 4);
#pragma unroll
                    for (int r = 0; r < 4; ++r) { const bool keep = (p < 2) ? (n < m0 + r) : (n <= m0 + r); if (!keep) acc[r] = 0.f; }
                    if (p == 0) { st_mn(bQ0, tm, tn, LO, acc); st_nm(bQT0, tm, tn, LO, acc);
#pragma unroll
                        for (int r = 0; r < 4; ++r) if (n == m0 + r) acc[r] += 1.f;
                        st_nm(bT, tm, tn, LO, acc); }
                    else st_mn((p == 1) ? bAak : (p == 2) ? bArb : bArk, tm, tn, LO, acc); } }
        }
        __syncthreads();
#pragma unroll
        for (int x = 0; x < 2; ++x) { const int tm = tm0_ + x; f32x4 acc = (f32x4){0.f, 0.f, 0.f, 0.f}; mm(acc, bQ0, tm, bQT0, tn_, LO); st_mn(bB, tm, tn_, LO, acc); st_nm(bK, tm, tn_, LO, acc); }
        __syncthreads();
#pragma unroll
        for (int s = 2; s <= 5; ++s) {
            const LAS unsigned char* Qc = (s & 1) ? bQ0 : bB; const LAS unsigned char* QTc = (s & 1) ? bQT0 : bK;
            LAS unsigned char* Qn = (s & 1) ? bB : bQ0; LAS unsigned char* QTn = (s & 1) ? bK : bQT0;
            const int tn = w & 3;
            if (w >= 4) { f32x4 acc[4];
#pragma unroll
                for (int tm = 0; tm < 4; ++tm) acc[tm] = ld_nm(bT, tm, tn, LO);
#pragma unroll
                for (int tm = 0; tm < 4; ++tm) mm(acc[tm], Qc, tm, bT, tn, LO);
#pragma unroll
                for (int tm = 0; tm < 4; ++tm) st_nm(bT, tm, tn, LO, acc[tm]);
            } else {
#pragma unroll
                for (int tm = 0; tm < 4; ++tm) { f32x4 acc = (f32x4){0.f, 0.f, 0.f, 0.f}; mm(acc, Qc, tm, QTc, tn, LO); st_mn(Qn, tm, tn, LO, acc); st_nm(QTn, tm, tn, LO, acc); }
            }
            __syncthreads();
        }
        {
#pragma unroll
            for (int x = 0; x < 2; ++x) { const int tm = tm0_ + x; f32x4 acc = ld_nm(bT, tm, tn_, LO); mm(acc, bB, tm, bT, tn_, LO); st_mn(bTF, tm, tn_, LO, acc); }
        }
        LAS unsigned char* bX = bB; LAS unsigned char* bW = bK; LAS unsigned char* bU = bQ0;
        __syncthreads();
#pragma unroll
        for (int x = 0; x < 2; ++x) { const int tm = tm0_ + x;
            { f32x4 acc = (f32x4){0.f, 0.f, 0.f, 0.f}; mm(acc, bAak, tm, bVT, tn_, LO); st_nm(bX, tm, tn_, LO, acc); }
            { f32x4 acc = (f32x4){0.f, 0.f, 0.f, 0.f}; mm(acc, bTF, tm, bAT, tn_, LO); st_nm(bW, tm, tn_, LO, acc); } }
        __syncthreads();
#pragma unroll
        for (int x = 0; x < 2; ++x) { const int tm = tm0_ + x; f32x4 acc = (f32x4){0.f, 0.f, 0.f, 0.f}; mm(acc, bTF, tm, bX, tn_, LO); st_nm(bU, tm, tn_, LO, acc); }
        __syncthreads();
        {   unsigned char* img = IMG + ((size_t)bh * 64 + c) * (4 * MB);
            const int n_ = 16 * tn_ + (lane & 15); const float decn = __shfl(dec0, n_);
#pragma unroll
            for (int x = 0; x < 2; ++x) { const int tm = tm0_ + x; const int m0 = 16 * tm + 4 * (lane >> 4); const int go = moff(n_, m0);
                { f32x4 acc = (f32x4){0.f, 0.f, 0.f, 0.f}; mm(acc, bW, tm, bBH, tn_, LO);
#pragma unroll
                  for (int r = 0; r < 4; ++r) if (m0 + r == n_) acc[r] += decn;
                  *(GAS u32x2*)(img + 0 * MB + go) = (u32x2){pkbf(acc[0], acc[1]), pkbf(acc[2], acc[3])}; }
                { f32x4 acc = (f32x4){0.f, 0.f, 0.f, 0.f}; mm(acc, bBH, tm, bU, tn_, LO); mm(acc, bKH, tm, bVT, tn_, LO);
                  *(GAS u32x2*)(img + 1 * MB + go) = (u32x2){pkbf(acc[0], acc[1]), pkbf(acc[2], acc[3])}; }
                { f32x4 acc = ld_nm(bR, tm, tn_, LO); mm(acc, bW, tm, bArb, tn_, LO);
                  *(GAS u32x2*)(img + 2 * MB + go) = (u32x2){pkbf(acc[0], acc[1]), pkbf(acc[2], acc[3])}; }
                { f32x4 acc = (f32x4){0.f, 0.f, 0.f, 0.f}; mm(acc, bArb, tm, bU, tn_, LO); mm(acc, bArk, tm, bVT, tn_, LO);
                  *(GAS u32x2*)(img + 3 * MB + go) = (u32x2){pkbf(acc[0], acc[1]), pkbf(acc[2], acc[3])}; } }
        }
        __syncthreads();
    }
#undef RWC_LOAD
}

__device__ __forceinline__ void rwkv_seq(Frame& F, const ArgsD& A, const int bh) {
    using namespace rwk;
    const int b = bh >> 3, h = bh & 7, lane0 = lane_id_v(), w0 = F.wave;
    const LaneOff LO = lane_off(lane0);
    LAS unsigned char* L = F.lds + RING_OFF;
    LAS unsigned char* bS0 = L + 8 * MB;
    LAS float* ybuf = (LAS float*)(L + 10 * MB);
    const bf16* RW = (const bf16*)(F.ws + WS_RW); const bf16* G = (const bf16*)(F.ws + WS_G); bf16* YC = (bf16*)(F.ws + WS_YCAT);
    const unsigned char* IMG = F.ws + WS_RIMG + (size_t)bh * 64 * (4 * MB); const float* BON = (const float*)(F.ws + WS_RBON) + (size_t)bh * 64 * 64;
    const float* mu = (const float*)A.in[16]; const float* lnw_g = (const float*)A.in[25]; const float* lnb_g = (const float*)A.in[26];
    const size_t mb = (size_t)b * T;
    const int tid0 = w0 * 64 + lane0, lt0 = tid0 >> 3, hlc0 = h * 64 + (tid0 & 7) * 8;
    for (int i = tid0; i < MB / 16; i += 512) ((LAS v4u*)bS0)[i] = (v4u){0u, 0u, 0u, 0u};
    const f32x4 lw0 = *(const f32x4*)(lnw_g + hlc0), lw1 = *(const f32x4*)(lnw_g + hlc0 + 4), lb0 = *(const f32x4*)(lnb_g + hlc0), lb1 = *(const f32x4*)(lnb_g + hlc0 + 4), mv0 = *(const f32x4*)(mu + 1024 + hlc0), mv1 = *(const f32x4*)(mu + 1024 + hlc0 + 4);
    v4u pf[4][4], lvp[4], lvq[4], lgg[4]; float lbn[4];
#define RWS_LOAD(u, c) do { _Pragma("unroll") for (int k_ = 0; k_ < 4; ++k_) pf[u][k_] = *(const GAS v4u*)(IMG + (size_t)(c) * (4 * MB) + k_ * MB + tid0 * 16); \
        const size_t ml_ = mb + (size_t)(c) * 64 + lt0; lvp[u] = *(const GAS v4u*)(RW + ml_ * RWC + 1024 + hlc0); lvq[u] = *(const GAS v4u*)(RW + (ml_ - (((c) > 0 || lt0 > 0) ? 1 : 0)) * RWC + 1024 + hlc0); \
        lgg[u] = *(const GAS v4u*)(G + ml_ * 512 + hlc0); lbn[u] = BON[(c) * 64 + lt0]; } while (0)
#pragma unroll
    for (int u = 0; u < 4; ++u) RWS_LOAD(u, u);
    int scur = 0;
    for (int c4 = 0; c4 < T / 64; c4 += 4) {
#pragma unroll
      for (int u = 0; u < 4; ++u) { const int c = c4 + u;
        int w = w0, lane = lane0; asm volatile("" : "+s"(w), "+v"(lane));
        const int tid = w * 64 + lane, tn_ = w & 3, tm0_ = 2 * (w >> 2), lt = tid >> 3, lc = (tid & 7) * 8, hlc = h * 64 + lc;
        LAS unsigned char* set = L + (c & 1) * (4 * MB);
#pragma unroll
        for (int k = 0; k < 4; ++k) *(LAS v4u*)(set + k * MB + tid * 16) = pf[u][k];
        const v4u lv_p = lvp[u], lv_q = (c > 0 || lt > 0) ? lvq[u] : (v4u){0u, 0u, 0u, 0u}; const f32x4 lg0 = (f32x4){bflo(lgg[u].x), bfhi(lgg[u].x), bflo(lgg[u].y), bfhi(lgg[u].y)}, lg1 = (f32x4){bflo(lgg[u].z), bfhi(lgg[u].z), bflo(lgg[u].w), bfhi(lgg[u].w)}; const float bn = lbn[u];
        __syncthreads();
        if (c + 4 < T / 64) RWS_LOAD(u, c + 4);
        const LAS unsigned char* Sc = bS0 + scur * MB; LAS unsigned char* Sn = bS0 + (scur ^ 1) * MB;
#pragma unroll
        for (int x = 0; x < 2; ++x) { const int tm = tm0_ + x;
            { f32x4 acc = ld_nm(set + 1 * MB, tm, tn_, LO); mm(acc, set + 0 * MB, tm, Sc, tn_, LO); st_nm(Sn, tm, tn_, LO, acc); }
            { f32x4 acc = ld_nm(set + 3 * MB, tm, tn_, LO); mm(acc, set + 2 * MB, tm, Sc, tn_, LO);
              const int i = 16 * tn_ + (lane & 15), t0 = 16 * tm + 4 * (lane >> 4);
#pragma unroll
              for (int r = 0; r < 4; ++r) ybuf[(t0 + r) * 64 + i] = acc[r]; } }
        scur ^= 1;
        __syncthreads();
        {   const f32x4 y0 = *(const LAS f32x4*)(ybuf + lt * 64 + lc), y1 = *(const LAS f32x4*)(ybuf + lt * 64 + lc + 4);
            const float mean = sum8((y0.x + y0.y) + (y0.z + y0.w) + (y1.x + y1.y) + (y1.z + y1.w)) * (1.f / 64.f); const f32x4 d0 = y0 - mean, d1 = y1 - mean;
            const float var = sum8((d0.x * d0.x + d0.y * d0.y) + (d0.z * d0.z + d0.w * d0.w) + (d1.x * d1.x + d1.y * d1.y) + (d1.z * d1.z + d1.w * d1.w)) * (1.f / 64.f); const float rs = __builtin_amdgcn_rsqf(var + 64e-5f);
            f32x4 va = (f32x4){bflo(lv_p.x), bfhi(lv_p.x), bflo(lv_p.y), bfhi(lv_p.y)}, vb = (f32x4){bflo(lv_p.z), bfhi(lv_p.z), bflo(lv_p.w), bfhi(lv_p.w)};
            { const f32x4 qa = (f32x4){bflo(lv_q.x), bfhi(lv_q.x), bflo(lv_q.y), bfhi(lv_q.y)}, qb = (f32x4){bflo(lv_q.z), bfhi(lv_q.z), bflo(lv_q.w), bfhi(lv_q.w)}; va = va + (qa - va) * mv0; vb = vb + (qb - vb) * mv1; }
            const f32x4 o0 = ((d0 * rs) * lw0 + lb0 + va * bn) * lg0, o1 = ((d1 * rs) * lw1 + lb1 + vb * bn) * lg1;
            *(GAS v4u*)(YC + (mb + (size_t)c * 64 + lt) * 1024 + 512 + hlc) = (v4u){pkbf(o0.x, o0.y), pkbf(o0.z, o0.w), pkbf(o1.x, o1.y), pkbf(o1.z, o1.w)};
        }
      }
    }
#undef RWS_LOAD
}

__device__ __forceinline__ void p6_dacombine(Frame& F, const ArgsD& A) {
    const int lane = lane_id_v(), tid = F.wave * 64 + lane; (void)tid;
    const float* q1 = (const float*)A.in[11]; const float* k1 = (const float*)A.in[12]; const float* q2 = (const float*)A.in[13]; const float* k2 = (const float*)A.in[14];
    const float lam = __expf(wave_sum(q1[lane] * k1[lane])) - __expf(wave_sum(q2[lane] * k2[lane])) + 0.2f;
    const bf16* O = (const bf16*)(F.ws + WS_O); bf16* YC = (bf16*)(F.ws + WS_YCAT);
    const int gw = F.vcu * NWAVES + F.wave, NGW = F.G * NWAVES, dh = lane >> 4, d0 = 8 * (lane & 15);
    const float* sw = (const float*)A.in[15] + d0; const f32x4 swa = *(const f32x4*)sw * 0.8f, swb = *(const f32x4*)(sw + 4) * 0.8f;
    for (int m = gw; m < M; m += NGW) {
        const v4u a = *(const GAS v4u*)(O + (size_t)m * 1024 + dh * 256 + d0), c = *(const GAS v4u*)(O + (size_t)m * 1024 + dh * 256 + 128 + d0);
        f32x4 y0 = (f32x4){bflo(a.x) - lam * bflo(c.x), bfhi(a.x) - lam * bfhi(c.x), bflo(a.y) - lam * bflo(c.y), bfhi(a.y) - lam * bfhi(c.y)};
        f32x4 y1 = (f32x4){bflo(a.z) - lam * bflo(c.z), bfhi(a.z) - lam * bfhi(c.z), bflo(a.w) - lam * bflo(c.w), bfhi(a.w) - lam * bfhi(c.w)};
        float s2 = (y0.x * y0.x + y0.y * y0.y) + (y0.z * y0.z + y0.w * y0.w) + (y1.x * y1.x + y1.y * y1.y) + (y1.z * y1.z + y1.w * y1.w);
        s2 = allsum16(s2); const float rs = 1.f / sqrtf(s2 * (1.f / 128.f) + 1e-5f);
        y0 = y0 * rs * swa; y1 = y1 * rs * swb;
        *(GAS v4u*)(YC + (size_t)m * 1024 + dh * 128 + d0) = (v4u){pkbf(y0.x, y0.y), pkbf(y0.z, y0.w), pkbf(y1.x, y1.y), pkbf(y1.z, y1.w)}; }
}

#define P9_SWAP32(a, b) do { const auto r_ = __builtin_amdgcn_permlane32_swap(__float_as_uint(a), __float_as_uint(b), false, false); (a) = __uint_as_float(r_[0]) + __uint_as_float(r_[1]); } while (0)
#define P9_SWAP16(a, b) do { const auto r_ = __builtin_amdgcn_permlane16_swap(__float_as_uint(a), __float_as_uint(b), false, false); (a) = __uint_as_float(r_[0]) + __uint_as_float(r_[1]); } while (0)
#define P9_DPPF(x, ctrl) __builtin_bit_cast(float, __builtin_amdgcn_update_dpp(0, __builtin_bit_cast(int, (x)), (ctrl), 0xF, 0xF, true))
#define P9_DPPU(x, ctrl) ((unsigned)__builtin_amdgcn_update_dpp(0, (int)(x), (ctrl), 0xF, 0xF, true))
__device__ __forceinline__ float p9_reduce32(float (&a)[32], const int lane) {
#pragma unroll
    for (int e = 0; e < 16; ++e) P9_SWAP32(a[e], a[e + 16]);
#pragma unroll
    for (int e = 0; e < 8; ++e) P9_SWAP16(a[e], a[e + 8]);
    const bool b3 = (lane & 8) != 0, b2 = (lane & 4) != 0, b0 = (lane & 1) != 0;
#pragma unroll
    for (int e = 0; e < 4; ++e) { const float keep = b3 ? a[e + 4] : a[e], send = b3 ? a[e] : a[e + 4]; a[e] = keep + P9_DPPF(send, 0x128); }
#pragma unroll
    for (int e = 0; e < 2; ++e) { const float keep = b2 ? a[e + 2] : a[e], send = b2 ? a[e] : a[e + 2]; a[e] = keep + P9_DPPF(send, 0x141); }
    { const float keep = b0 ? a[1] : a[0], send = b0 ? a[0] : a[1]; a[0] = keep + P9_DPPF(send, 0xB1); }
    return a[0] + P9_DPPF(a[0], 0x4E);
}
__device__ __forceinline__ unsigned p9_wmax(unsigned v) {
    v = max(v, P9_DPPU(v, 0xB1)); v = max(v, P9_DPPU(v, 0x4E)); v = max(v, P9_DPPU(v, 0x124)); v = max(v, P9_DPPU(v, 0x128));
    const unsigned s0 = __builtin_amdgcn_readlane(v, 0), s1 = __builtin_amdgcn_readlane(v, 16), s2 = __builtin_amdgcn_readlane(v, 32), s3 = __builtin_amdgcn_readlane(v, 48);
    return max(max(s0, s1), max(s2, s3)); }
__device__ __forceinline__ void p8_postmix_router(Frame& F, const ArgsD& A, const int cset) {
    const int lane = lane_id_v(), tid = F.wave * 64 + lane; (void)tid;
    LAS float* rw = (LAS float*)(F.lds + RING_OFF);
    volatile LAS int* lcnt = (volatile LAS int*)(F.lds + LDSCTL_OFF);
    { const float* r = (const float*)A.in[27]; for (int i = tid; i < 1024 * 32; i += 512) { const int k = i >> 5, e = i & 31; rw[e * 1024 + k] = r[i]; } }
    if (tid < 32) lcnt[tid] = 0;
    __syncthreads();
    const float* x = (const float*)A.in[0]; const bf16* Y = (const bf16*)(F.ws + WS_Y); const float* mod = (const float*)(F.ws + WS_MOD);
    const float* pmn = (const float*)A.in[6]; const float* pfn = (const float*)A.in[7]; const float* rb = (const float*)A.in[28];
    unsigned char* H2 = F.ws + WS_H2; int* tokE = (int*)(F.ws + WS_TOKE); float* tokG = (float*)(F.ws + WS_TOKG);
    const int rows_per = M / F.G, mbeg = F.vcu * rows_per, b = mbeg >> 12; const float* mb_ = mod + (size_t)b * NMOD;
    f32x4 a1[4], a2[4], sh[4];
#pragma unroll
    for (int j = 0; j < 4; ++j) { const int col = 4 * lane + 256 * j; a1[j] = *(const f32x4*)(pmn + col) * *(const f32x4*)(mb_ + 2048 + col); a2[j] = *(const f32x4*)(pfn + col) * (*(const f32x4*)(mb_ + 4096 + col) + 1.f); sh[j] = *(const f32x4*)(mb_ + 3072 + col); }
    const int myexp = 8 * (lane >> 4) + 4 * ((lane >> 3) & 1) + 2 * ((lane >> 2) & 1) + (lane & 1); const float rbias = rb[myexp];
    const int nr = rows_per / NWAVES, m0 = mbeg + F.wave * nr;
    u32x2 yp[2][4]; f32x4 xp[2][4];
#define P9_LOAD(m_) do { _Pragma("unroll") for (int t_ = 0; t_ < 2; ++t_) _Pragma("unroll") for (int j_ = 0; j_ < 4; ++j_) { \
        yp[t_][j_] = *((const GAS u32x2*)(Y + (size_t)((m_) + t_) * D) + lane + 64 * j_); xp[t_][j_] = *((const GAS f32x4*)(x + (size_t)((m_) + t_) * D) + lane + 64 * j_); } } while (0)
    P9_LOAD(m0);
    for (int i = 0; i < nr; i += 2) { const int m = m0 + i;
        f32x4 xv[2][4];
#pragma unroll
        for (int t = 0; t < 2; ++t) { f32x4 yv[4]; float s2 = 0.f;
#pragma unroll
            for (int j = 0; j < 4; ++j) { const u32x2 p = yp[t][j]; yv[j] = (f32x4){bflo(p.x), bfhi(p.x), bflo(p.y), bfhi(p.y)}; s2 += (yv[j].x * yv[j].x + yv[j].y * yv[j].y) + (yv[j].z * yv[j].z + yv[j].w * yv[j].w); }
            const float rs = __builtin_amdgcn_rsqf(wave_sum(s2) * (1.f / D) + 1e-6f); float t2 = 0.f;
#pragma unroll
            for (int j = 0; j < 4; ++j) { xv[t][j] = xp[t][j] + a1[j] * (yv[j] * rs); *((GAS f32x4*)(F.out + (size_t)(m + t) * D) + lane + 64 * j) = xv[t][j];
                t2 += (xv[t][j].x * xv[t][j].x + xv[t][j].y * xv[t][j].y) + (xv[t][j].z * xv[t][j].z + xv[t][j].w * xv[t][j].w); }
            const float rs2 = __builtin_amdgcn_rsqf(wave_sum(t2) * (1.f / D) + 1e-6f);
#pragma unroll
            for (int j = 0; j < 4; ++j) { xv[t][j] = xv[t][j] * rs2 * a2[j] + sh[j]; *((GAS unsigned*)(H2 + (size_t)(m + t) * D) + lane + 64 * j) = pg8::pk4_fp8(xv[t][j].x, xv[t][j].y, xv[t][j].z, xv[t][j].w); } }
        if (i + 2 < nr) P9_LOAD(m + 2);
        float ac0[32], ac1[32];
#pragma unroll
        for (int e = 0; e < 32; ++e) { float s0 = 0.f, s1 = 0.f;
#pragma unroll
            for (int j = 0; j < 4; ++j) { const f32x4 w = *(const LAS f32x4*)(rw + e * 1024 + 4 * lane + 256 * j);
                s0 += (xv[0][j].x * w.x + xv[0][j].y * w.y) + (xv[0][j].z * w.z + xv[0][j].w * w.w); s1 += (xv[1][j].x * w.x + xv[1][j].y * w.y) + (xv[1][j].z * w.z + xv[1][j].w * w.w); }
            ac0[e] = s0; ac1[e] = s1; }
        const float lg[2] = {p9_reduce32(ac0, lane) + rbias, p9_reduce32(ac1, lane) + rbias};
#pragma unroll
        for (int t = 0; t < 2; ++t) { const unsigned u = __float_as_uint(lg[t]); unsigned key = (((u >> 31) ? ~u : (u | 0x80000000u)) & ~31u) | (unsigned)(31 - myexp);
            float tv[4]; int ti[4];
#pragma unroll
            for (int k = 0; k < 4; ++k) { const unsigned mx = p9_wmax(key); ti[k] = 31 - (int)(mx & 31u); const unsigned kv = mx & ~31u; tv[k] = __uint_as_float((kv >> 31) ? (kv & 0x7fffffffu) : ~kv); if (key == mx) key = 0u; }
            float ew[4], es = 0.f;
#pragma unroll
            for (int k = 0; k < 4; ++k) { ew[k] = __expf(tv[k] - tv[0]); es += ew[k]; }
            if (lane < 4) { const int e = (lane == 0) ? ti[0] : (lane == 1) ? ti[1] : (lane == 2) ? ti[2] : ti[3]; const float g = ((lane == 0) ? ew[0] : (lane == 1) ? ew[1] : (lane == 2) ? ew[2] : ew[3]) / es;
                const int pos = __hip_atomic_fetch_add((LAS int*)lcnt + e, 1, __ATOMIC_RELAXED, __HIP_MEMORY_SCOPE_WORKGROUP);
                tokE[(size_t)(m + t) * 4 + lane] = e | (pos << 8); tokG[(size_t)(m + t) * 4 + lane] = g; } }
    }
#undef P9_LOAD
    __syncthreads();
    if (tid < 32) { const int n = lcnt[tid]; int base = 0; if (n > 0) base = (int)__hip_atomic_fetch_add(F.ctl + CW_ECNT + cset * 64 * NEXP + 64 * tid, (unsigned)n, __ATOMIC_RELAXED, __HIP_MEMORY_SCOPE_AGENT);
        ((int*)(F.ws + WS_BLKBASE))[F.vcu * 32 + tid] = base; }
}

__device__ __forceinline__ void moe_tables(Frame& F) {
    const int lane = lane_id_v(), tid = F.wave * 64 + lane; (void)tid;
    volatile LAS int* ts = (volatile LAS int*)(F.lds + LDSCTL_OFF);
    if (tid < 32) ts[40 + tid] = (int)__hip_atomic_load(F.ctl + CW_ECNT + 64 * tid, __ATOMIC_RELAXED, __HIP_MEMORY_SCOPE_AGENT);
    __syncthreads();
    if (tid == 0) { int acc = 0; for (int e = 0; e < 32; ++e) { ts[e] = acc; acc += (ts[40 + e] + 255) >> 8; } ts[32] = acc; }
    __syncthreads();
}
__device__ __forceinline__ void p9_rows(Frame& F) {
    const int lane = lane_id_v(), tid = F.wave * 64 + lane; (void)tid;
    moe_tables(F);
    volatile LAS int* ts = (volatile LAS int*)(F.lds + LDSCTL_OFF);
    const int* tokE = (const int*)(F.ws + WS_TOKE); const float* tokG = (const float*)(F.ws + WS_TOKG); const int* blkbase = (const int*)(F.ws + WS_BLKBASE) + F.vcu * 32;
    int* tokrow = (int*)(F.ws + WS_TOKROW); int* rowtok = (int*)(F.ws + WS_ROWTOK); float* rowgate = (float*)(F.ws + WS_ROWGATE);
    const int rows_per = M / F.G, mbeg = F.vcu * rows_per;
    for (int i = tid; i < rows_per * 4; i += 512) { const int idx = mbeg * 4 + i; const int pe = tokE[idx], e = pe & 255, pos = pe >> 8; const int row = ts[e] * 256 + blkbase[e] + pos;
        tokrow[idx] = row; rowtok[row] = idx >> 2; rowgate[row] = tokG[idx]; }
    for (int e = F.vcu; e < 32; e += F.G) { const int n = ts[40 + e]; const int r0 = ts[e] * 256 + n, r1 = ts[e + 1] * 256;
        for (int r = r0 + tid; r < r1; r += 512) { rowtok[r] = 0; rowgate[r] = 0.f; } }
}

__device__ __forceinline__ void p12_final(Frame& F, const ArgsD& A, float* dst) {
    const int lane = lane_id_v(), tid = F.wave * 64 + lane; (void)tid;
    const unsigned char* Y2 = F.ws + WS_Y2; const int* tokrow = (const int*)(F.ws + WS_TOKROW); const float* mod = (const float*)(F.ws + WS_MOD); const float* pn = (const float*)A.in[8];
    const int rows_per = M / F.G, mbeg = F.vcu * rows_per, b = mbeg >> 12, nr = rows_per / NWAVES, m0 = mbeg + F.wave * nr;
    const float* mb_ = mod + (size_t)b * NMOD + 5120;
    f32x4 gw[4];
#pragma unroll
    for (int j = 0; j < 4; ++j) { const int col = 4 * lane + 256 * j; gw[j] = *(const f32x4*)(pn + col) * *(const f32x4*)(mb_ + col); }
    const int myrow = tokrow[(size_t)m0 * 4 + (lane < nr * 4 ? lane : 0)];
    unsigned yp[4][4]; f32x4 xp[4];
#define P13_LOAD(i_) do { _Pragma("unroll") for (int k_ = 0; k_ < 4; ++k_) { const int row_ = __builtin_amdgcn_readlane(myrow, 4 * (i_) + k_); \
        _Pragma("unroll") for (int j_ = 0; j_ < 4; ++j_) yp[k_][j_] = *((const GAS unsigned*)(Y2 + (size_t)row_ * D) + lane + 64 * j_); } \
        _Pragma("unroll") for (int j_ = 0; j_ < 4; ++j_) xp[j_] = *((const GAS f32x4*)(F.out + (size_t)(m0 + (i_)) * D) + lane + 64 * j_); } while (0)
    P13_LOAD(0);
#pragma unroll 1
    for (int i = 0; i < nr; ++i) { const int m = m0 + i;
        f32x4 a[4], xv[4]; float s2 = 0.f;
#pragma unroll
        for (int j = 0; j < 4; ++j) { a[j] = (f32x4){0.f, 0.f, 0.f, 0.f};
#pragma unroll
            for (int k = 0; k < 4; ++k) { const unsigned p = yp[k][j]; const f32x2 lo = __builtin_amdgcn_cvt_pk_f32_fp8((int)p, false), hi = __builtin_amdgcn_cvt_pk_f32_fp8((int)p, true); a[j] = a[j] + (f32x4){lo.x, lo.y, hi.x, hi.y}; }
            a[j] = a[j] * pg8::Y8_INV;
            s2 += (a[j].x * a[j].x + a[j].y * a[j].y) + (a[j].z * a[j].z + a[j].w * a[j].w); xv[j] = xp[j]; }
        if (i + 1 < nr) { const int in_ = __builtin_amdgcn_readfirstlane(i + 1);
#pragma unroll
            for (int k_ = 0; k_ < 4; ++k_) { const int row_ = __shfl(myrow, 4 * in_ + k_);
#pragma unroll
                for (int j_ = 0; j_ < 4; ++j_) yp[k_][j_] = *((const GAS unsigned*)(Y2 + (size_t)row_ * D) + lane + 64 * j_); }
#pragma unroll
            for (int j_ = 0; j_ < 4; ++j_) xp[j_] = *((const GAS f32x4*)(F.out + (size_t)(m + 1) * D) + lane + 64 * j_); }
        const float rs = __builtin_amdgcn_rsqf(wave_sum(s2) * (1.f / D) + 1e-6f);
#pragma unroll
        for (int j = 0; j < 4; ++j) *((GAS f32x4*)(dst + (size_t)m * D) + lane + 64 * j) = xv[j] + gw[j] * (a[j] * rs); }
#undef P13_LOAD
}
__global__ void __launch_bounds__(NWAVES * 64, 2) hybrid_fwd(Args kargs) {
    const ArgsD args{};
    extern __shared__ __attribute__((aligned(16))) unsigned char lds[];
    Frame F;
    F.lds = (LAS unsigned char*)lds;
    F.MISC = (volatile LAS unsigned*)(F.lds + MISC_OFF);
    F.wave = __builtin_amdgcn_readfirstlane((int)threadIdx.x >> 6);
    F.G = gridDim.x; { const int bx = blockIdx.x; F.vcu = (F.G % 8 == 0) ? (bx % 8) * (F.G / 8) + bx / 8 : bx; }
    F.ws = kargs.ws; F.out = kargs.out;
    unsigned char* ws = kargs.ws;
    F.ctl = (gu32*)(ws + WS_CTL);
#define GRID_BAR(seam) do { if (N_LAUNCHES != 1) { if (F.wave == 0 && lane_id_v() == 0) __hip_atomic_store(F.ctl + CW_TMO, 0xBADBA0u | (unsigned)(seam), RLX_AGENT); } else { xcd_barrier(bar); } } while (0)
    for (int u = threadIdx.x; u < (LDS_BYTES - LDSCTL_OFF) / 4; u += NWAVES * 64) ((LAS unsigned*)(F.lds + LDSCTL_OFF))[u] = 0u;
    __syncthreads();
    XcdBarrier bar; bar.bar = (unsigned*)(F.ctl + CW_BAR); bar.x = 0; bar.st = nullptr; bar.wid = F.wave;
    if (N_LAUNCHES == 1) bar = xcd_barrier_post((unsigned*)(F.ctl + CW_BAR), F.MISC + 8, F.wave);
    const int lo = kargs.ph_lo, hi = kargs.ph_hi;
#define IN(k) (lo <= (k) && (k) < hi)
#define PREP(k) (((PROBE_MASK) >> (k)) & 1)
#define BOTH(k) (IN(k) && IN((k) + 1))
    bf16* const H = (bf16*)(ws + WS_H); bf16* const H2 = (bf16*)(ws + WS_H2);

    if (IN(0)) { _Pragma("unroll 1") for (int r_ = 0; r_ <= PREP(0); ++r_) { p0_prologue(F, args); } if (BOTH(0)) GRID_BAR(0); }
    if (IN(1)) { _Pragma("unroll 1") for (int r_ = 0; r_ <= PREP(1); ++r_) { p1_premix(F, args); } if (BOTH(1)) GRID_BAR(1); }
    if (IN(2)) {
        pg8::Gemm g{H, (const bf16*)(ws + WS_WIN), M, IN_COLS, D, 0, nullptr, ws}; pg8::StaticOrder S; S.init(M, IN_COLS, F.G, (int)blockIdx.x);
        pg8::EpiProj E{(bf16*)(ws + WS_Q), (bf16*)(ws + WS_K), (bf16*)(ws + WS_V), (bf16*)(ws + WS_RW), (const float*)(ws + WS_ROPE), attn_body::C2};
        if (PREP(2)) { pg8::gemm_phase<pg8::EpiProj, pg8::StaticOrder, true, true, false>(F.lds + RING_OFF, g, S, E, F.wave); GRID_BAR(102); }
        pg8::gemm_phase<pg8::EpiProj, pg8::StaticOrder, true, true, false>(F.lds + RING_OFF, g, S, E, F.wave);
        if (BOTH(2)) GRID_BAR(2);
    }
    if (IN(3)) { _Pragma("unroll 1") for (int r_ = 0; r_ <= PREP(3); ++r_) { p3_lact(F, args); } if (BOTH(3)) GRID_BAR(3); }
    if (IN(4)) {
        pg8::Gemm g{(const bf16*)(ws + WS_LACT), (const bf16*)(ws + WS_BLORA), M, 1536, 256, 0, nullptr, ws}; pg8::StaticOrder S; S.init(M, 1536, F.G, (int)blockIdx.x);
        pg8::EpiLora E{(bf16*)(ws + WS_LW), (size_t)(WS_AS - WS_LW) / 2, (const float*)args.in[17], (const float*)args.in[19]}; static_assert(WS_G - WS_AS == WS_AS - WS_LW, "LW | AS | G equally spaced");
        if (PREP(4)) { pg8::gemm_phase<pg8::EpiLora, pg8::StaticOrder, true, true, false>(F.lds + RING_OFF, g, S, E, F.wave); GRID_BAR(104); }
        pg8::gemm_phase<pg8::EpiLora, pg8::StaticOrder, true, true, false>(F.lds + RING_OFF, g, S, E, F.wave);
        if (BOTH(4)) GRID_BAR(4);
    }
    if (IN(5)) {
        _Pragma("unroll 1") for (int r_ = 0; r_ <= PREP(5); ++r_)
            for (int u = F.vcu; u < BATCH * 8 * 4; u += F.G) rwkv_pre(F, args, u >> 2, (u & 3) * 16, (u & 3) * 16 + 16);
        if (BOTH(5)) GRID_BAR(5);
    }
    if (IN(6)) {
        _Pragma("unroll 1") for (int r_ = 0; r_ <= PREP(14); ++r_)
            for (int bh = blockIdx.x; bh < BATCH * 8; bh += F.G) rwkv_seq(F, args, bh);
        static_assert(attn_body::ATTN_LDS_BYTES <= RING_BYTES, "attention body geometry vs frame");
        const attn_body::AttnTensors AT{(const attn_body::bf16*)(ws + WS_Q), (const attn_body::bf16*)(ws + WS_K), (const attn_body::bf16*)(ws + WS_V), (attn_body::bf16*)(ws + WS_O)};
        if (PREP(15)) { const attn_body::QueueOrder S0{(unsigned*)(F.ctl + CW_ATTQ + 64), F.MISC + 12, F.wave}; attn_body::attn_phase<attn_body::QueueOrder>((char*)lds + RING_OFF, AT, S0, F.wave); GRID_BAR(106); }
        const attn_body::QueueOrder S{(unsigned*)(F.ctl + CW_ATTQ), F.MISC + 12, F.wave};
        attn_body::attn_phase<attn_body::QueueOrder>((char*)lds + RING_OFF, AT, S, F.wave);
        if (BOTH(6)) GRID_BAR(6);
    }
    if (IN(7)) { _Pragma("unroll 1") for (int r_ = 0; r_ <= PREP(7); ++r_) { p6_dacombine(F, args); } if (BOTH(7)) GRID_BAR(7); }
    if (IN(8)) {
        pg8::Gemm g{(const bf16*)(ws + WS_YCAT), (const bf16*)(ws + WS_WOUT), M, D, D, 0, nullptr, ws}; pg8::StaticOrder S; S.init(M, D, F.G, (int)blockIdx.x);
        pg8::EpiPlain E{(bf16*)(ws + WS_Y), D};
        if (PREP(8)) { pg8::gemm_phase<pg8::EpiPlain, pg8::StaticOrder, true, true, false>(F.lds + RING_OFF, g, S, E, F.wave); GRID_BAR(108); }
        pg8::gemm_phase<pg8::EpiPlain, pg8::StaticOrder, true, true, false>(F.lds + RING_OFF, g, S, E, F.wave);
        if (BOTH(8)) GRID_BAR(8);
    }
    if (IN(9)) { _Pragma("unroll 1") for (int r_ = PREP(9); r_ >= 0; --r_) { p8_postmix_router(F, args, r_); } if (BOTH(9)) GRID_BAR(9); }
    if (IN(10)) { _Pragma("unroll 1") for (int r_ = 0; r_ <= PREP(10); ++r_) { p9_rows(F); } if (BOTH(10)) GRID_BAR(10); }
    if (IN(11)) {
        moe_tables(F);
        const LAS int* ts = (const LAS int*)(F.lds + LDSCTL_OFF);
        pg8::Gemm g{H2, (const bf16*)(ws + WS_W1), MAXROWS, 2048, D / 2, (size_t)2048 * D, (const int*)(ws + WS_ROWTOK), ws};
        pg8::MoeOrder S{__builtin_amdgcn_readfirstlane(ts[32]), 8, 4, F.G, F.vcu, ts};
        pg8::EpiSwiglu E{ws + WS_ACT, (const float*)args.in[30]};
        if (PREP(11)) { pg8::gemm_phase<pg8::EpiSwiglu, pg8::MoeOrder, true, true, true, true>(F.lds + RING_OFF, g, S, E, F.wave); GRID_BAR(111); }
        pg8::gemm_phase<pg8::EpiSwiglu, pg8::MoeOrder, true, true, true, true>(F.lds + RING_OFF, g, S, E, F.wave);
        if (BOTH(11)) GRID_BAR(11);
    }
    if (IN(12)) {
        moe_tables(F);
        const LAS int* ts = (const LAS int*)(F.lds + LDSCTL_OFF);
        pg8::Gemm g{(const bf16*)(ws + WS_ACT), (const bf16*)(ws + WS_W2), MAXROWS, D, D / 2, (size_t)D * D, nullptr, ws};
        pg8::MoeOrder S{__builtin_amdgcn_readfirstlane(ts[32]), 4, 8, F.G, F.vcu, ts};
        pg8::EpiMoe2 E{ws + WS_Y2, (const float*)args.in[32], (const float*)(ws + WS_ROWGATE)};
        if (PREP(12)) { pg8::gemm_phase<pg8::EpiMoe2, pg8::MoeOrder, true, true, false, true>(F.lds + RING_OFF, g, S, E, F.wave); GRID_BAR(112); }
        pg8::gemm_phase<pg8::EpiMoe2, pg8::MoeOrder, true, true, false, true>(F.lds + RING_OFF, g, S, E, F.wave);
        if (BOTH(12)) GRID_BAR(12);
    }
    if (IN(13)) { _Pragma("unroll 1") for (int r_ = PREP(13); r_ >= 0; --r_) { p12_final(F, args, r_ ? (float*)(ws + WS_G) : F.out); } }
#undef IN
#undef PREP
#undef BOTH
}

extern "C" void kernel_launch(void* const* d_in, const int* in_sizes, int n_in, void* d_out, int out_size, void* d_ws, size_t ws_size, hipStream_t stream) {
    static int grid = 0;
    if (grid == 0) {
        if (n_in != 33 || in_sizes[0] != M * D || out_size != M * D || ws_size < WS_END) { fprintf(stderr, "kernel_launch: built for 33 inputs, x and out of %d floats, >= %zu bytes of workspace; got n_in %d, in0 %d, out %d, ws %zu; nothing launched\n", M * D, (size_t)WS_END, n_in, n_in > 0 ? in_sizes[0] : -1, out_size, ws_size); grid = -1; return; }
        int dev = 0, cus = 0, per_cu = 0;
        if (hipGetDevice(&dev) != hipSuccess || hipDeviceGetAttribute(&cus, hipDeviceAttributeMultiprocessorCount, dev) != hipSuccess) { fprintf(stderr, "kernel_launch: hipGetDevice / hipDeviceGetAttribute failed; nothing launched\n"); grid = -1; return; }
        if (hipFuncSetAttribute((const void*)hybrid_fwd, hipFuncAttributeMaxDynamicSharedMemorySize, LDS_BYTES) != hipSuccess) { fprintf(stderr, "kernel_launch: hipFuncSetAttribute failed; nothing launched\n"); grid = -1; return; }
        if (hipOccupancyMaxActiveBlocksPerMultiprocessor(&per_cu, (const void*)hybrid_fwd, NWAVES * 64, LDS_BYTES) != hipSuccess || per_cu < 1)
            fprintf(stderr, "kernel_launch: note: the occupancy query reports %d workgroups per CU\n", per_cu);
        (void)hipGetLastError();
        grid = (cus >= 256) ? 256 : (cus / 32) * 32;
        if (grid != 256) fprintf(stderr, "kernel_launch: launching %d workgroups (built and checked for 256)\n", grid);
    }
    if (grid <= 0) return;
    if (hipMemsetAsync((char*)d_ws + WS_CTL, 0, CTL_ZERO_BYTES, stream) != hipSuccess) { fprintf(stderr, "kernel_launch: hipMemsetAsync of the control words failed; nothing launched\n"); return; }
    Args a{};
    for (int i = 0; i < 33; ++i) a.in[i] = d_in[i];
    a.out = (float*)d_out; a.ws = (unsigned char*)d_ws;
    for (int li = 0; li < N_LAUNCHES; ++li) {
        a.ph_lo = (N_LAUNCHES == 1) ? 0 : li; a.ph_hi = (N_LAUNCHES == 1) ? N_PHASES : li + 1; a.li = li; a.pad = 0;
        hipLaunchKernelGGL(hybrid_fwd, dim3(grid), dim3(NWAVES * 64), LDS_BYTES, stream, a);
        const hipError_t le = hipPeekAtLastError();
        if (le != hipSuccess) { fprintf(stderr, "kernel_launch: launch %d failed: %s\n", li, hipGetErrorName(le)); break; }
    }
}
```

```cpp
#include <hip/hip_runtime.h>
#include <cstdio>
#include <cstdint>
__device__ __forceinline__ int lane_id_v() { int l; asm volatile("v_mbcnt_lo_u32_b32 %0, -1, 0\n\tv_mbcnt_hi_u32_b32 %0, -1, %0" : "=v"(l)); return l; }
namespace pg8 {
#define PG8_LAS __attribute__((address_space(3)))
typedef unsigned short bf16_t;
typedef short bf16x8 __attribute__((ext_vector_type(8)));
typedef float f32x4 __attribute__((ext_vector_type(4)));
typedef unsigned u32x4 __attribute__((ext_vector_type(4)));
typedef int v4i_t __attribute__((ext_vector_type(4)));
typedef int v8i_t __attribute__((ext_vector_type(8)));
typedef v8i_t v8i_a16 __attribute__((aligned(16)));
union frag2_t { bf16x8 pc[2]; v8i_t w; };
constexpr int BM = 256, BK = 64, HALF = 128, HTB = HALF * BK * 2  , STAGE_BYTES = 8 * HTB, NXCD = 8, WGM = 8;

__host__ __device__ __forceinline__ int lds_byte(int r, int c) { const int st = (r >> 4) * 2 + (c >> 5), rr = r & 15, cc = c & 31, ob = rr * 64 + cc * 2; return st * 1024 + (ob ^ (((ob >> 9) & 1) << 5)); }
__host__ __device__ __forceinline__ void stage_rc(int b, int& R, int& C) { const int st = b / 1024, sb = b % 1024, swz = sb ^ (((sb >> 9) & 1) << 5); R = (st >> 1) * 16 + swz / 64; C = (st & 1) * 32 + (swz % 64) / 2; }
__host__ __device__ __forceinline__ int perm32(int rho) { const int n = rho >> 4, i = rho & 15; return 8 * (i >> 2) + 4 * n + (i & 3); }

struct Unit { int pm, pn, e; };
struct Gemm { const bf16_t* A; const bf16_t* Bt; int M, N, K; size_t bstride; const int* rowidx; const void* base; };

struct StaticOrder {
    int nM, nN, nwg, G, c;
    __host__ __device__ void init(int M, int N, int G_, int c_) { nM = M / BM; nN = N / BM; nwg = nM * nN; G = G_; c = c_; }
    __host__ __device__ bool next(int i, Unit& u) const {
        const long L = (long)i * G + c; if (L >= nwg) return false;
        int wgid = (int)L; { const int q = nwg / NXCD, r = nwg % NXCD, xcd = wgid % NXCD, off = wgid / NXCD; wgid = (xcd < r ? xcd * (q + 1) : r * (q + 1) + (xcd - r) * q) + off; }
        const int nig = WGM * nN, gid = wgid / nig, fm = gid * WGM, gsz = (nM - fm) < WGM ? (nM - fm) : WGM;
        u.pm = fm + ((wgid % nig) % gsz); u.pn = (wgid % nig) / gsz; u.e = 0; return true;
    }
    __device__ __forceinline__ void a_ready(const Unit&) const {}
    __device__ __forceinline__ void done(const Unit&) const {}
};

__device__ __forceinline__ unsigned cvt_pk_bf16(float lo, float hi) { unsigned r; asm volatile("v_cvt_pk_bf16_f32 %0, %1, %2" : "=v"(r) : "v"(lo), "v"(hi)); return r; }
typedef float f32x2 __attribute__((ext_vector_type(2)));
typedef unsigned u32x2 __attribute__((ext_vector_type(2)));
__device__ __forceinline__ float sigmoidf_(float x) { return __builtin_amdgcn_rcpf(1.f + __expf(-x)); }

struct MoeOrder {
    int ntiles, nN, RG, G, c; const PG8_LAS int* tstart;
    __device__ __forceinline__ bool next(int i, Unit& u) const {
        const int L = i * G + c, grp = L >> 5, idx = L & 31; u.pn = idx / RG; u.pm = grp * RG + idx % RG; u.e = 0;
        if (u.pm >= ntiles) return false;
        int e = 0;
#pragma unroll
        for (int k = 16; k >= 1; k >>= 1) { if (tstart[e + k] <= u.pm) e += k; }
        u.e = __builtin_amdgcn_readfirstlane(e); return true;
    }
    __device__ __forceinline__ void a_ready(const Unit&) const {}
    __device__ __forceinline__ void done(const Unit&) const {}
};

#define PG8_PACK8(v0, v1) (u32x4){cvt_pk_bf16((v0)[0], (v0)[1]), cvt_pk_bf16((v0)[2], (v0)[3]), cvt_pk_bf16((v1)[0], (v1)[1]), cvt_pk_bf16((v1)[2], (v1)[3])}

struct EpiPlain {
    static constexpr bool PERM = true, AFTER_DRAIN = false;
    bf16_t* O; int ldc;
    __device__ __forceinline__ void operator()(const f32x4 (&acc)[2][2][4][2], const Unit& u, int wr, int wc, int fr, int fq) const {
        const int row0 = u.pm * BM + wr * 64 + fr, col0 = u.pn * BM + wc * 32 + 8 * fq;
#pragma unroll
        for (int ai = 0; ai < 2; ++ai)
#pragma unroll
            for (int m = 0; m < 4; ++m) { bf16_t* rowp = O + (size_t)(row0 + ai * HALF + m * 16) * ldc + col0;
#pragma unroll
                for (int bj = 0; bj < 2; ++bj) { const f32x4 v0 = acc[ai][bj][m][0], v1 = acc[ai][bj][m][1]; *(u32x4*)(rowp + bj * HALF) = PG8_PACK8(v0, v1); } }
    }
};

struct EpiProj {
    static constexpr bool PERM = true, AFTER_DRAIN = false;
    bf16_t *Q, *K, *V, *RW; const float* rope; float qscale;
    __device__ __forceinline__ void operator()(const f32x4 (&acc)[2][2][4][2], const Unit& u, int wr, int wc, int fr, int fq) const {
        const int row0 = u.pm * BM + wr * 64 + fr, cl = wc * 32 + 8 * fq, pn = u.pn;
        if (pn < 4) {
            bf16_t* base = (pn < 2) ? Q : K; const int colt = (pn & 1) * 256; const float sc = (pn < 2) ? qscale : 1.f;
            const bool rp = ((wc & 1) == 0) && (fq < 2);
#pragma unroll
            for (int ai = 0; ai < 2; ++ai)
#pragma unroll
                for (int m = 0; m < 4; ++m) { const int row = row0 + ai * HALF + m * 16;
                    f32x4 cs = (f32x4){1.f, 1.f, 1.f, 1.f}, sn = (f32x4){0.f, 0.f, 0.f, 0.f};
                    if (rp) { cs = *(const f32x4*)(rope + (size_t)row * 16 + 4 * fq); sn = *(const f32x4*)(rope + (size_t)row * 16 + 8 + 4 * fq); }
#pragma unroll
                    for (int bj = 0; bj < 2; ++bj) { f32x4 v0 = acc[ai][bj][m][0], v1 = acc[ai][bj][m][1];
                        { const float a0 = v0[0], b0 = v0[1], a1 = v0[2], b1 = v0[3], a2 = v1[0], b2 = v1[1], a3 = v1[2], b3 = v1[3];
                          v0[0] = a0 * cs[0] - b0 * sn[0]; v0[1] = b0 * cs[0] + a0 * sn[0]; v0[2] = a1 * cs[1] - b1 * sn[1]; v0[3] = b1 * cs[1] + a1 * sn[1];
                          v1[0] = a2 * cs[2] - b2 * sn[2]; v1[1] = b2 * cs[2] + a2 * sn[2]; v1[2] = a3 * cs[3] - b3 * sn[3]; v1[3] = b3 * cs[3] + a3 * sn[3]; }
                        v0 = v0 * sc; v1 = v1 * sc;
                        *(u32x4*)(base + (size_t)row * 512 + colt + bj * HALF + cl) = PG8_PACK8(v0, v1); } }
        } else {
            bf16_t* base; int ld, colt;
            if (pn < 6) { base = V; ld = 512; colt = (pn - 4) * 256; } else { base = RW; ld = 1792; colt = (pn - 6) * 256; }
#pragma unroll
            for (int ai = 0; ai < 2; ++ai)
#pragma unroll
                for (int m = 0; m < 4; ++m) { bf16_t* rowp = base + (size_t)(row0 + ai * HALF + m * 16) * ld + colt + cl;
#pragma unroll
                    for (int bj = 0; bj < 2; ++bj) { const f32x4 v0 = acc[ai][bj][m][0], v1 = acc[ai][bj][m][1]; *(u32x4*)(rowp + bj * HALF) = PG8_PACK8(v0, v1); } }
        }
    }
};

struct EpiLora {
    static constexpr bool PERM = true, AFTER_DRAIN = false;
    bf16_t* LW; size_t kstride; const float *w0, *a0;
    __device__ __forceinline__ void operator()(const f32x4 (&acc)[2][2][4][2], const Unit& u, int wr, int wc, int fr, int fq) const {
        const int row0 = u.pm * BM + wr * 64 + fr, kind = u.pn >> 1, col0 = (u.pn & 1) * 256 + wc * 32 + 8 * fq;
        bf16_t* dst = LW + (size_t)kind * kstride; const float* bias = (kind == 1) ? a0 : w0;
        f32x4 bv[2][2];
#pragma unroll
        for (int bj = 0; bj < 2; ++bj)
#pragma unroll
            for (int n = 0; n < 2; ++n) bv[bj][n] = (kind < 2) ? *(const f32x4*)(bias + col0 + bj * HALF + 4 * n) : (f32x4){0.f, 0.f, 0.f, 0.f};
#pragma unroll
        for (int ai = 0; ai < 2; ++ai)
#pragma unroll
            for (int m = 0; m < 4; ++m) { bf16_t* rowp = dst + (size_t)(row0 + ai * HALF + m * 16) * 512 + col0;
#pragma unroll
                for (int bj = 0; bj < 2; ++bj) { f32x4 vv[2];
#pragma unroll
                    for (int n = 0; n < 2; ++n) { f32x4 v = acc[ai][bj][m][n] + bv[bj][n];
                        if (kind == 0) {
#pragma unroll
                            for (int q = 0; q < 4; ++q) v[q] = -0.60653066f * sigmoidf_(v[q]);
                        } else if (kind == 1) {
#pragma unroll
                            for (int q = 0; q < 4; ++q) v[q] = sigmoidf_(v[q]);
                        }
                        vv[n] = v; }
                    *(u32x4*)(rowp + bj * HALF) = PG8_PACK8(vv[0], vv[1]); } }
    }
};

__device__ __forceinline__ unsigned pk4_fp8(float a, float b, float c_, float d) { int r = __builtin_amdgcn_cvt_pk_fp8_f32(a, b, 0, false); r = __builtin_amdgcn_cvt_pk_fp8_f32(c_, d, r, true); return (unsigned)r; }
constexpr float W8_SCALE = 32.f, W8_INV = 1.f / 32.f;
struct EpiSwiglu {
    static constexpr bool PERM = true, AFTER_DRAIN = false;
    unsigned char* ACT; const float* b1;
    __device__ __forceinline__ void operator()(const f32x4 (&acc)[2][2][4][2], const Unit& u, int wr, int wc, int fr, int fq) const {
        const int row0 = u.pm * BM + wr * 64 + fr, col0 = u.pn * BM + wc * 32 + 8 * fq;
        f32x4 bv[2][2];
#pragma unroll
        for (int bj = 0; bj < 2; ++bj)
#pragma unroll
            for (int n = 0; n < 2; ++n) bv[bj][n] = *(const f32x4*)(b1 + (size_t)u.e * 2048 + col0 + bj * HALF + 4 * n);
#pragma unroll
        for (int ai = 0; ai < 2; ++ai)
#pragma unroll
            for (int m = 0; m < 4; ++m) { unsigned char* rowp = ACT + (size_t)(row0 + ai * HALF + m * 16) * 1024 + (col0 >> 1);
#pragma unroll
                for (int bj = 0; bj < 2; ++bj) { const f32x4 v0 = acc[ai][bj][m][0] * W8_INV + bv[bj][0], v1 = acc[ai][bj][m][1] * W8_INV + bv[bj][1];
                    float o[4];
#pragma unroll
                    for (int q = 0; q < 4; ++q) { const float glu = (q < 2) ? v0[2 * q] : v1[2 * q - 4], lin = (q < 2) ? v0[2 * q + 1] : v1[2 * q - 3];
                        const float gg = fminf(glu, 7.f), ll = fminf(fmaxf(lin, -7.f), 7.f); o[q] = gg * sigmoidf_(1.702f * gg) * (ll + 1.f); }
                    *(unsigned*)(rowp + bj * (HALF / 2)) = pk4_fp8(o[0], o[1], o[2], o[3]); } }
    }
};

constexpr float Y8_SCALE = 32.f, Y8_INV = 1.f / 32.f;
struct EpiMoe2 {
    static constexpr bool PERM = true, AFTER_DRAIN = false;
    unsigned char* Y2; const float* b2; const float* gate;
    __device__ __forceinline__ void operator()(const f32x4 (&acc)[2][2][4][2], const Unit& u, int wr, int wc, int fr, int fq) const {
        const int row0 = u.pm * BM + wr * 64 + fr, col0 = u.pn * BM + wc * 32 + 8 * fq;
#pragma unroll
        for (int bj = 0; bj < 2; ++bj) { const f32x4 b0 = *(const f32x4*)(b2 + (size_t)u.e * 1024 + col0 + bj * HALF), b1 = *(const f32x4*)(b2 + (size_t)u.e * 1024 + col0 + bj * HALF + 4);
#pragma unroll
            for (int ai = 0; ai < 2; ++ai)
#pragma unroll
                for (int m = 0; m < 4; ++m) { const int row = row0 + ai * HALF + m * 16; const float gt = gate[row] * Y8_SCALE;
                    const f32x4 v0 = (acc[ai][bj][m][0] * W8_INV + b0) * gt, v1 = (acc[ai][bj][m][1] * W8_INV + b1) * gt;
                    *(u32x2*)(Y2 + (size_t)row * 1024 + col0 + bj * HALF) = (u32x2){pk4_fp8(v0[0], v0[1], v0[2], v0[3]), pk4_fp8(v1[0], v1[1], v1[2], v1[3])}; } }
    }
};

template <class Epi, class Sched, bool ALIGN_EPI = false, bool SP2 = false, bool GATHER = false, bool FP8 = false>
__device__ __forceinline__ void gemm_phase(PG8_LAS unsigned char* lds, const Gemm g, const Sched& S, const Epi& E, const int wid) {
    const int lane = lane_id_v(), tid = wid * 64 + lane, wr = wid >> 2, wc = wid & 3, fr = lane & 15, fq = lane >> 4;
    const int K = g.K, nt = K / BK;
    const __amdgpu_buffer_rsrc_t rsrc = __builtin_amdgcn_make_buffer_rsrc((void*)g.base, 0, 0x7fffffff, 0x00020000);
    unsigned voffA[2], voffB[2];
#pragma unroll
    for (int i = 0; i < 2; ++i) { int R, C; stage_rc(tid * 16 + i * 8192, R, C); const int Rb = Epi::PERM ? ((R & ~31) + perm32(R & 31)) : R;
        voffA[i] = (unsigned)(R * K + C) * 2u; voffB[i] = (unsigned)(Rb * K + C) * 2u; }
    const size_t kstep = (size_t)(BK * 2);
    const size_t hstep = (size_t)HALF * K * 2;
    const size_t tstep = 2 * hstep;
    const unsigned ldsw = (unsigned)wid * 1024u;
    const int aoff = FP8 ? lds_byte(wr * 64 + fr, fq * 16) : lds_byte(wr * 64 + fr, fq * 8), boff = FP8 ? lds_byte(wc * 32 + fr, fq * 16) : lds_byte(wc * 32 + fr, fq * 8);
    const PG8_LAS unsigned char* ldsA; const PG8_LAS unsigned char* ldsB;
    { unsigned a_ = (unsigned)(size_t)(lds + aoff), b_ = (unsigned)(size_t)(lds + 4 * HTB + boff); asm volatile("" : "+v"(a_), "+v"(b_)); ldsA = (const PG8_LAS unsigned char*)(size_t)a_; ldsB = (const PG8_LAS unsigned char*)(size_t)b_; }
#define PG8_SA(b, h) (((b) * 2 + (h)) * HTB)
#define PG8_SB(b, h) ((4 + (b) * 2 + (h)) * HTB)
#define PG8_STAGE(bufoff, gbase, voff) do { const unsigned so_ = (unsigned)((const char*)(gbase) - (const char*)g.base); _Pragma("unroll") for (int _i = 0; _i < 2; ++_i) \
        __builtin_amdgcn_raw_ptr_buffer_load_lds(rsrc, (PG8_LAS unsigned*)(lds + (bufoff) + ldsw + _i * 8192), 16, (voff)[_i], so_, 0, 0); } while (0)
#define PG8_STAGE_A(bufoff, ptr, h, nx) do { if constexpr (GATHER) { unsigned vo_[2]; vo_[0] = (nx) ? gn[h][0] : gc[h][0]; vo_[1] = (nx) ? gn[h][1] : gc[h][1]; PG8_STAGE(bufoff, ptr, vo_); } \
        else { PG8_STAGE(bufoff, (ptr) + (h) * hstep, voffA); } } while (0)
#define PG8_LDA(dst, b, h) do { _Pragma("unroll") for (int m = 0; m < 4; ++m) _Pragma("unroll") for (int k = 0; k < 2; ++k) dst[m].pc[k] = *(const PG8_LAS bf16x8*)(ldsA + ((b) * 2 + (h)) * HTB + m * 2048 + k * (FP8 ? 16 : 1024)); } while (0)
#define PG8_LDB(dst, b, h) do { _Pragma("unroll") for (int n = 0; n < 2; ++n) _Pragma("unroll") for (int k = 0; k < 2; ++k) dst[n].pc[k] = *(const PG8_LAS bf16x8*)(ldsB + ((b) * 2 + (h)) * HTB + n * 2048 + k * (FP8 ? 16 : 1024)); } while (0)
#define PG8_MMA(ai, bj, At, Bt) do { __builtin_amdgcn_s_setprio(1); _Pragma("unroll") for (int m = 0; m < 4; ++m) _Pragma("unroll") for (int n = 0; n < 2; ++n) { \
        if constexpr (FP8) { acc[ai][bj][m][n] = __builtin_amdgcn_mfma_scale_f32_16x16x128_f8f6f4(Bt[n].w, At[m].w, acc[ai][bj][m][n], 0, 0, 0, 0, 0, 0); } \
        else { _Pragma("unroll") for (int k = 0; k < 2; ++k) acc[ai][bj][m][n] = __builtin_amdgcn_mfma_f32_16x16x32_bf16(Bt[n].pc[k], At[m].pc[k], acc[ai][bj][m][n], 0, 0, 0); } } \
        __builtin_amdgcn_s_setprio(0); } while (0)
#define PG8_WAIT_V(n) asm volatile("s_waitcnt vmcnt(" #n ")" ::: "memory")
#define PG8_WAIT_L(n) asm volatile("s_waitcnt lgkmcnt(" #n ")" ::: "memory")
#define PG8_BAR __builtin_amdgcn_s_barrier()
#define PG8_SCHED __builtin_amdgcn_sched_barrier(0)
    Unit cur, nxt; int ui = 0;
    if (!S.next(0, cur)) return;
    f32x4 acc[2][2][4][2];
#pragma unroll
    for (int a = 0; a < 2; ++a)
#pragma unroll
        for (int b = 0; b < 2; ++b)
#pragma unroll
            for (int m = 0; m < 4; ++m)
#pragma unroll
                for (int n = 0; n < 2; ++n) acc[a][b][m][n] = (f32x4){0.f, 0.f, 0.f, 0.f};
    frag2_t At[4], B0[2], B1[2];
    const char* cA = GATHER ? (const char*)g.A : (const char*)g.A + (size_t)cur.pm * tstep; const char* cB = (const char*)g.Bt + (size_t)cur.e * g.bstride + (size_t)cur.pn * tstep;
    unsigned gc[2][2] = {{0u, 0u}, {0u, 0u}}, gn[2][2] = {{0u, 0u}, {0u, 0u}}; Unit nx2; bool has_nx2 = false;
#define PG8_GOFF(dst, pm_, ok_, alt_) do { const int t_ = lane_id_v() + wid * 64; _Pragma("unroll") for (int i_ = 0; i_ < 2; ++i_) { int R_, C_; stage_rc(t_ * 16 + i_ * 8192, R_, C_); \
        _Pragma("unroll") for (int h_ = 0; h_ < 2; ++h_) dst[h_][i_] = (ok_) ? (unsigned)g.rowidx[(pm_) * BM + h_ * HALF + R_] * (unsigned)(K * 2) + (unsigned)C_ * 2u : alt_[h_][i_]; } } while (0)
    if constexpr (GATHER) {
        PG8_GOFF(gc, cur.pm, true, gc);
        const bool hn = S.next(1, nxt);
        PG8_GOFF(gn, nxt.pm, hn, gc);
    }
    S.a_ready(cur);
    if constexpr (SP2) {
        PG8_STAGE(PG8_SB(0, 0), cB, voffB); PG8_STAGE(PG8_SB(0, 1), cB + hstep, voffB); PG8_STAGE_A(PG8_SA(0, 0), cA, 0, false); PG8_STAGE_A(PG8_SA(0, 1), cA, 1, false);
        if (wr == 1) PG8_BAR;
        PG8_WAIT_V(2); PG8_BAR;
        PG8_STAGE(PG8_SB(1, 0), cB + kstep, voffB); PG8_STAGE_A(PG8_SA(1, 0), cA + kstep, 0, false); PG8_STAGE(PG8_SB(1, 1), cB + hstep + kstep, voffB);
        PG8_WAIT_V(6); PG8_BAR;
    } else {
        PG8_STAGE(PG8_SB(0, 0), cB, voffB); PG8_STAGE_A(PG8_SA(0, 0), cA, 0, false); PG8_STAGE(PG8_SB(0, 1), cB + hstep, voffB); PG8_STAGE_A(PG8_SA(0, 1), cA, 1, false);
        if (wr == 1) PG8_BAR;
        PG8_WAIT_V(4); PG8_BAR;
        PG8_STAGE(PG8_SB(1, 0), cB + kstep, voffB); PG8_STAGE_A(PG8_SA(1, 0), cA + kstep, 0, false); PG8_STAGE(PG8_SB(1, 1), cB + hstep + kstep, voffB);
        PG8_WAIT_V(6); PG8_BAR;
    }
    for (;;) {
        const bool has_next = S.next(ui + 1, nxt);
        const char* nA = GATHER ? (const char*)g.A : (has_next ? (const char*)g.A + (size_t)nxt.pm * tstep : cA); const char* nB = has_next ? (const char*)g.Bt + (size_t)nxt.e * g.bstride + (size_t)nxt.pn * tstep : cB;
        for (int t = 0; t < nt; t += 2) {
            const bool last = (t == nt - 2);
            asm volatile("" : "+v"(voffA[0]), "+v"(voffA[1]), "+v"(voffB[0]), "+v"(voffB[1]));
            if constexpr (GATHER) asm volatile("" : "+v"(gc[0][0]), "+v"(gc[0][1]), "+v"(gc[1][0]), "+v"(gc[1][1]), "+v"(gn[0][0]), "+v"(gn[0][1]), "+v"(gn[1][0]), "+v"(gn[1][1]));
            const char* a1 = cA + (size_t)(t + 1) * kstep;
            const char* a2 = last ? nA : cA + (size_t)(t + 2) * kstep; const char* b2 = last ? nB : cB + (size_t)(t + 2) * kstep;
            const char* a3 = a2 + kstep; const char* b3 = b2 + kstep;
            if (last && has_next) S.a_ready(nxt);
            if constexpr (SP2) {
            PG8_LDB(B0, 0, 0); PG8_LDB(B1, 0, 1); PG8_SCHED; PG8_LDA(At, 0, 0); PG8_STAGE_A(PG8_SA(1, 1), a1, 1, false);
            PG8_WAIT_V(8); PG8_WAIT_L(0); PG8_BAR; PG8_MMA(0, 0, At, B0); PG8_MMA(0, 1, At, B1); PG8_BAR; PG8_SCHED;
            PG8_LDA(At, 0, 1); PG8_STAGE(PG8_SB(0, 0), b2, voffB); PG8_STAGE(PG8_SB(0, 1), b2 + hstep, voffB); PG8_STAGE_A(PG8_SA(0, 0), a2, 0, last);
            PG8_WAIT_V(8); PG8_WAIT_L(0); PG8_BAR; PG8_MMA(1, 0, At, B0); PG8_MMA(1, 1, At, B1); PG8_BAR; PG8_SCHED;
            PG8_LDB(B0, 1, 0); PG8_LDB(B1, 1, 1); PG8_SCHED; PG8_LDA(At, 1, 0); PG8_STAGE_A(PG8_SA(0, 1), a2, 1, last);
            PG8_WAIT_V(8); PG8_WAIT_L(0); PG8_BAR; PG8_MMA(0, 0, At, B0); PG8_MMA(0, 1, At, B1); PG8_BAR; PG8_SCHED;
            PG8_LDA(At, 1, 1); PG8_STAGE(PG8_SB(1, 0), b3, voffB); PG8_STAGE(PG8_SB(1, 1), b3 + hstep, voffB); PG8_STAGE_A(PG8_SA(1, 0), a3, 0, last);
            PG8_WAIT_V(8); PG8_WAIT_L(0); PG8_BAR; PG8_MMA(1, 0, At, B0); PG8_MMA(1, 1, At, B1); PG8_BAR; PG8_SCHED;
            } else {
            PG8_LDB(B0, 0, 0); PG8_SCHED; PG8_LDA(At, 0, 0); PG8_STAGE_A(PG8_SA(1, 1), a1, 1, false);
            PG8_WAIT_L(8); PG8_BAR; PG8_WAIT_L(0); PG8_MMA(0, 0, At, B0); PG8_BAR; PG8_SCHED;
            PG8_LDB(B1, 0, 1); PG8_STAGE(PG8_SB(0, 0), b2, voffB);
            PG8_BAR; PG8_WAIT_L(0); PG8_MMA(0, 1, At, B1); PG8_BAR;
            PG8_LDA(At, 0, 1); PG8_STAGE_A(PG8_SA(0, 0), a2, 0, last);
            PG8_BAR; PG8_WAIT_L(0); PG8_MMA(1, 0, At, B0); PG8_BAR; PG8_SCHED;
            PG8_STAGE(PG8_SB(0, 1), b2 + hstep, voffB);
            PG8_WAIT_V(6); PG8_BAR; PG8_MMA(1, 1, At, B1); PG8_BAR;
            PG8_LDB(B0, 1, 0); PG8_SCHED; PG8_LDA(At, 1, 0); PG8_STAGE_A(PG8_SA(0, 1), a2, 1, last);
            PG8_WAIT_L(8); PG8_BAR; PG8_WAIT_L(0); PG8_MMA(0, 0, At, B0); PG8_BAR; PG8_SCHED;
            PG8_LDB(B1, 1, 1); PG8_STAGE(PG8_SB(1, 0), b3, voffB);
            PG8_BAR; PG8_WAIT_L(0); PG8_MMA(0, 1, At, B1); PG8_BAR;
            PG8_LDA(At, 1, 1); PG8_STAGE_A(PG8_SA(1, 0), a3, 0, last);
            PG8_BAR; PG8_WAIT_L(0); PG8_MMA(1, 0, At, B0); PG8_BAR; PG8_SCHED;
            PG8_STAGE(PG8_SB(1, 1), b3 + hstep, voffB);
            PG8_WAIT_V(6); PG8_BAR; PG8_MMA(1, 1, At, B1); PG8_BAR;
            }
        }
        if constexpr (GATHER) { has_nx2 = has_next && S.next(ui + 2, nx2);
            _Pragma("unroll") for (int h = 0; h < 2; ++h) _Pragma("unroll") for (int i = 0; i < 2; ++i) gc[h][i] = gn[h][i];
            PG8_GOFF(gn, nx2.pm, has_nx2, gc); }
        if constexpr (ALIGN_EPI) { if (wr == 0) PG8_BAR; }
        if constexpr (!Epi::AFTER_DRAIN) { const int l_ = lane_id_v(); const int fr_ = l_ & 15, fq_ = l_ >> 4;
            E(acc, cur, wr, wc, fr_, fq_); S.done(cur); }
        if (!has_next) break;
#pragma unroll
        for (int a = 0; a < 2; ++a)
#pragma unroll
            for (int b = 0; b < 2; ++b)
#pragma unroll
                for (int m = 0; m < 4; ++m)
#pragma unroll
                    for (int n = 0; n < 2; ++n) acc[a][b][m][n] = (f32x4){0.f, 0.f, 0.f, 0.f};
        if constexpr (GATHER) { asm volatile("" : "+v"(gn[0][0]), "+v"(gn[0][1]), "+v"(gn[1][0]), "+v"(gn[1][1])); }
        cur = nxt; cA = nA; cB = nB; ++ui;
        if constexpr (ALIGN_EPI) { if (wr == 1) PG8_BAR; }
    }
    PG8_WAIT_V(0);
    if constexpr (!ALIGN_EPI) { if (wr == 0) PG8_BAR; }
    PG8_BAR;
    if constexpr (Epi::AFTER_DRAIN) { E.fused(acc, cur, wr, wc, fr, fq, lds, wid, lane); S.done(cur); }
#undef PG8_SA
#undef PG8_SB
#undef PG8_STAGE
#undef PG8_STAGE_A
#undef PG8_GOFF
#undef PG8_LDA
#undef PG8_LDB
#undef PG8_MMA
#undef PG8_WAIT_V
#undef PG8_WAIT_L
#undef PG8_BAR
#undef PG8_SCHED
}
}
#include <hip/hip_bf16.h>
#include <cmath>
namespace attn_body {
using bf16=__hip_bfloat16;
using bf16x8=__attribute__((ext_vector_type(8)))short;
using s16x4=__attribute__((ext_vector_type(4)))short;
using f32x16=__attribute__((ext_vector_type(16)))float;
using u32x4=__attribute__((ext_vector_type(4)))unsigned;
constexpr int BATCH=8,NHEAD=8,SEQ=4096,D=64;
constexpr int QP=512,KP=512,VP=512,OP=1024;
constexpr int NW=8,QBLK=32,QB=QBLK*NW,KVBLK=64,NQB=SEQ/QB;
constexpr int ATTN_UNIT_ROWS=QB;
__device__ __forceinline__ int crow(int r,int hi){return (r&3)+8*(r>>2)+4*hi;}
#define SBAR() __builtin_amdgcn_sched_barrier(0)
__device__ __forceinline__ void cmask(f32x16&p0,f32x16&p1,int jb,int qrel,int hi){
  const float NEG=-INFINITY; int kb=64*jb+4*hi;
  #pragma unroll
  for(int r=0;r<16;++r){int kv=kb+(r&3)+8*(r>>2); if(kv>qrel)p0[r]=NEG; if(kv+32>qrel)p1[r]=NEG;}
}

constexpr int NSLOT=3, SLOTB=8192;
constexpr int LDS_K=0, LDS_V=NSLOT*SLOTB, LDS_WS=3*NSLOT*SLOTB, LDS_Q=LDS_WS+NW*64*4, LDS_OST=LDS_Q, LDS_BYTES=LDS_Q+NW*4096;
constexpr float C2=0.125f*1.4426950408889634f;
__device__ __forceinline__ void glds16(const void*gsrc,unsigned lds_dst){unsigned keep;
  asm volatile("s_mov_b32 %0, m0\n\ts_mov_b32 m0, %2\n\ts_nop 0\n\tglobal_load_lds_dwordx4 %1, off\n\ts_mov_b32 m0, %0":"=&s"(keep):"v"(gsrc),"s"(lds_dst):"memory");}
__device__ __forceinline__ float max3f(float a,float b,float c){float r;asm("v_max3_f32 %0, %1, %2, %3":"=v"(r):"v"(a),"v"(b),"v"(c));return r;}
__device__ __forceinline__ float max2f(float a,float b){float r;asm("v_max_f32_e32 %0, %1, %2":"=v"(r):"v"(a),"v"(b));return r;}
__device__ __forceinline__ float fadd_s(float a,float b){float r;asm("v_add_f32_e32 %0, %1, %2":"=v"(r):"v"(a),"v"(b));return r;}
__device__ __forceinline__ float fsub_s(float a,float b){float r;asm("v_sub_f32_e32 %0, %1, %2":"=v"(r):"v"(a),"v"(b));return r;}
typedef float f32x2_t __attribute__((ext_vector_type(2))); typedef __bf16 bf16x2_t __attribute__((ext_vector_type(2)));
__device__ __forceinline__ unsigned cvtpk_s(float lo,float hi){f32x2_t v={lo,hi};bf16x2_t b=__builtin_convertvector(v,bf16x2_t);return __builtin_bit_cast(unsigned,b);}
#define WAIT_BAR(N) asm volatile("s_waitcnt vmcnt(" #N ") lgkmcnt(0)\n\ts_barrier":::"memory")

__device__ __forceinline__ void qkt(f32x16&p0,f32x16&p1,const char*Kslot,const __attribute__((address_space(3))) char*qf,int r32,int hi){
  const char*kb=Kslot+hi*1024+r32*16;
  #pragma unroll
  for(int d0=0;d0<4;++d0){
    const bf16x8 b0=*reinterpret_cast<const bf16x8*>(kb+d0*2048);
    const bf16x8 b1=*reinterpret_cast<const bf16x8*>(kb+d0*2048+512);
    const bf16x8 q_=*(const __attribute__((address_space(3))) bf16x8*)(qf+d0*1024);
    if(d0==0){p0=__builtin_amdgcn_mfma_f32_32x32x16_bf16(b0,q_,f32x16{},0,0,0);p1=__builtin_amdgcn_mfma_f32_32x32x16_bf16(b1,q_,f32x16{},0,0,0);}
    else{p0=__builtin_amdgcn_mfma_f32_32x32x16_bf16(b0,q_,p0,0,0,0);p1=__builtin_amdgcn_mfma_f32_32x32x16_bf16(b1,q_,p1,0,0,0);}}
}
typedef __attribute__((address_space(3))) const char* lds_cptr;
typedef short v4i16_t __attribute__((ext_vector_type(4)));
__device__ __forceinline__ void kload8(bf16x8*kf,lds_cptr kp){
  kf[0]=*(const __attribute__((address_space(3))) bf16x8*)(kp);      kf[1]=*(const __attribute__((address_space(3))) bf16x8*)(kp+512);
  kf[2]=*(const __attribute__((address_space(3))) bf16x8*)(kp+2048); kf[3]=*(const __attribute__((address_space(3))) bf16x8*)(kp+2560);
  kf[4]=*(const __attribute__((address_space(3))) bf16x8*)(kp+4096); kf[5]=*(const __attribute__((address_space(3))) bf16x8*)(kp+4608);
  kf[6]=*(const __attribute__((address_space(3))) bf16x8*)(kp+6144); kf[7]=*(const __attribute__((address_space(3))) bf16x8*)(kp+6656);
}
__device__ __forceinline__ void kload2(bf16x8*kf,lds_cptr kp,int j){ kf[2*j]=*(const __attribute__((address_space(3))) bf16x8*)(kp+j*2048); kf[2*j+1]=*(const __attribute__((address_space(3))) bf16x8*)(kp+j*2048+512); }
__device__ __forceinline__ s16x4 vtr(lds_cptr p){ return __builtin_bit_cast(s16x4,__builtin_amdgcn_ds_read_tr16_b64_v4i16((__attribute__((address_space(3))) v4i16_t*)p)); }
__device__ __forceinline__ float rowmax(const f32x16&p0,const f32x16&p1){
  float a=max3f(p0[0],p0[1],p1[0]),b=max3f(p0[2],p0[3],p1[1]);a=max3f(a,p1[2],p1[3]);
  #pragma unroll
  for(int r=4;r<16;r+=4){a=max3f(a,p0[r],p0[r+1]);b=max3f(b,p0[r+2],p0[r+3]);a=max3f(a,p1[r],p1[r+1]);b=max3f(b,p1[r+2],p1[r+3]);}
  const float m=max2f(a,b);
  auto rr=__builtin_amdgcn_permlane32_swap(__float_as_uint(m),__float_as_uint(m),false,false);
  return max2f(__uint_as_float(rr[0]),__uint_as_float(rr[1]));
}
__device__ __forceinline__ void pv(f32x16*o,int vb,bf16x8 pa0,bf16x8 pa1,bf16x8 pa2,bf16x8 pa3){
  #pragma unroll
  for(int d0=0;d0<2;++d0){s16x4 lo[4],hi[4];
    #pragma unroll
    for(int ks=0;ks<4;++ks){
      asm volatile("ds_read_b64_tr_b16 %0,%1 offset:%c2":"=&v"(lo[ks]):"v"(vb),"i"(d0*4096+ks*1024):"memory");
      asm volatile("ds_read_b64_tr_b16 %0,%1 offset:%c2":"=&v"(hi[ks]):"v"(vb),"i"(d0*4096+ks*1024+512):"memory");}
    asm volatile("s_waitcnt lgkmcnt(0)":::"memory");SBAR();
    #define PK(k) (bf16x8){lo[k][0],lo[k][1],lo[k][2],lo[k][3],hi[k][0],hi[k][1],hi[k][2],hi[k][3]}
    o[d0]=__builtin_amdgcn_mfma_f32_32x32x16_bf16(pa0,PK(0),o[d0],0,0,0);
    o[d0]=__builtin_amdgcn_mfma_f32_32x32x16_bf16(pa1,PK(1),o[d0],0,0,0);
    o[d0]=__builtin_amdgcn_mfma_f32_32x32x16_bf16(pa2,PK(2),o[d0],0,0,0);
    o[d0]=__builtin_amdgcn_mfma_f32_32x32x16_bf16(pa3,PK(3),o[d0],0,0,0);
    #undef PK
  }
}

#ifndef ATTN_STORE16
#define ATTN_STORE16(p,v) (*(u32x4*)(p)=(v))
#endif
template<int THRL> __device__ __forceinline__ void attn_unit(int b,int h,int qb,const bf16*Q,const bf16*__restrict__ K,const bf16*__restrict__ V,bf16*O,char*shm,const int wid){
  const int qcol=h*64, kcol=h*64, vcol=(h>>1)*128, ocol=h*128;
  const int lane=lane_id_v(),r32=lane&31,hi=lane>>5;
  const long rowbase=(long)b*SEQ; const int q0=qb*QB;
  const bf16*Qw=Q+(rowbase+q0+wid*QBLK)*QP+qcol;
  const bf16*Kh=K+rowbase*KP+kcol,*Vh=V+rowbase*VP+vcol;
  const unsigned lds0=(unsigned)(uintptr_t)shm;
  __attribute__((address_space(3))) float*const wsf=(__attribute__((address_space(3))) float*)((__attribute__((address_space(3))) char*)shm+LDS_WS)+wid*64;
  const int koff=lane*KP+wid*8, voff=(16*(wid&3)+(lane>>2))*VP+(wid>>2)*32+(lane&3)*8;
  const unsigned kdst=lds0+LDS_K+wid*1024, vdst=lds0+LDS_V+wid*1024;
  #define DMA_K(t,slot) glds16(Kh+(long)(t)*KVBLK*KP+koff,(unsigned)__builtin_amdgcn_readfirstlane(kdst+(slot)))
  #define DMA_V(t,slot) do{ glds16(Vh+(long)(t)*KVBLK*VP+voff,(unsigned)__builtin_amdgcn_readfirstlane(vdst+2*(slot))); glds16(Vh+(long)(t)*KVBLK*VP+64+voff,(unsigned)__builtin_amdgcn_readfirstlane(vdst+2*(slot)+8192)); }while(0)
  const char*Kbase=shm+LDS_K; bf16x8 kf[8];
  const lds_cptr shm3=(lds_cptr)shm; const lds_cptr kp0=shm3+LDS_K+hi*1024+r32*16; const lds_cptr vp0=shm3+LDS_V+((lane>>4)&1)*32+(lane&3)*8+(4*hi+((lane&15)>>2))*64;
  const int NT=(q0+QB)/KVBLK;
  DMA_K(0,0);DMA_V(0,0);DMA_K(1,SLOTB);
  __attribute__((address_space(3))) char*const qf=(__attribute__((address_space(3))) char*)shm+LDS_Q+wid*4096+lane*16;
  { bf16x8 qt[4];
    #pragma unroll
    for(int d0=0;d0<4;++d0)qt[d0]=*reinterpret_cast<const bf16x8*>(&Qw[(long)r32*QP+d0*16+hi*8]);
    #pragma unroll
    for(int d0=0;d0<4;++d0)*(__attribute__((address_space(3))) bf16x8*)(qf+d0*1024)=qt[d0]; }
  #define QF(d0) (*(const __attribute__((address_space(3))) bf16x8*)(qf+(d0)*1024))
  float mhat=0.f,l_reg=0.f;f32x16 o[4];o[0]=f32x16{};o[1]=f32x16{};o[2]=f32x16{};o[3]=f32x16{};
  #define CMASK(P0,P1,t) do{int jb_=(t)-(NT-4); if(jb_>=0){ const int l_=lane_id_v(); cmask(P0,P1,jb_,wid*QBLK+(l_&31),l_>>5); } }while(0)
  bool resc=false;
  #define START(P0,P1) do{ const float rm=rowmax(P0,P1); resc=false; \
    { const float dl=rm; mhat=fadd_s(mhat,dl); \
      _Pragma("unroll") for(int r=0;r<16;++r){P0[r]=fsub_s(P0[r],dl);P1[r]=fsub_s(P1[r],dl);} } \
    _Pragma("unroll") for(int r=0;r<16;++r)P0[r]=__builtin_amdgcn_exp2f(P0[r]); }while(0)
  #define RESC() do{ if(resc){ asm volatile("s_waitcnt lgkmcnt(0)":::"memory"); \
      _Pragma("unroll") for(int d_=0;d_<4;++d_) _Pragma("unroll") for(int r=0;r<16;++r)o[d_][r]*=wsf[crow(r,hi)]; } }while(0)
  f32x16 pA0,pA1,pB0,pB1;
  int sl_prev=0,sl_cur=0,sl_next=SLOTB;
  #define ROT() do{sl_prev=sl_cur;sl_cur=sl_next;sl_next=(sl_next==(NSLOT-1)*SLOTB)?0:sl_next+SLOTB;}while(0)
  DMA_K(2,2*SLOTB);
  WAIT_BAR(4);
  qkt(pA0,pA1,Kbase,qf,r32,hi);asm volatile("s_nop 15\n\ts_nop 7":"+v"(pA0),"+v"(pA1));CMASK(pA0,pA1,0);
  START(pA0,pA1);
  _Pragma("unroll") for(int r=0;r<16;++r)pA1[r]=__builtin_amdgcn_exp2f(pA1[r]);
  WAIT_BAR(0);
  DMA_K(3,0);DMA_V(1,SLOTB);
  ROT();
  kload8(kf,kp0+sl_cur);
  WAIT_BAR(3);
  s16x4 vlo[8],vhi[8]; u32x4 pw0,pw1,pw2,pw3;
  #define PKW(P,B) cvtpk_s(P[B],P[B+1])
  #define PAF(k) __builtin_bit_cast(bf16x8,pw##k)
  #define VFR(i) (bf16x8){vlo[i][0],vlo[i][1],vlo[i][2],vlo[i][3],vhi[i][0],vhi[i][1],vhi[i][2],vhi[i][3]}
  #define PIN(x) asm volatile("":"+v"(x))
  #define MX3(a,b,c) __builtin_fmaxf(__builtin_fmaxf((a),(b)),(c))
  #define GAPA(MF,A0,A1,A2,A3,W0,W1,PW) do{ MF; sacc+=A0; sacc+=A1; sacc+=A2; sacc+=A3; PIN(sacc); W0; W1; PIN(PW); SBAR(); }while(0)
  #define EX(v) __builtin_amdgcn_exp2f(v)
  #define GAPB(MF,X,B) do{ MF; X[B]=EX(X[B]); X[B+1]=EX(X[B+1]); X[B+2]=EX(X[B+2]); X[B+3]=EX(X[B+3]); PIN(X); SBAR(); }while(0)
  #define GAPB2(MF,X,B,RD) do{ MF; RD; X[B]=EX(X[B]); X[(B)+1]=EX(X[(B)+1]); PIN(X); SBAR(); }while(0)
  #define VRD2(i) do{ vlo[i]=vtr(vp_+8192+(((i)>>2)*4096+((i)&3)*1024)); vhi[i]=vtr(vp_+8192+(((i)>>2)*4096+((i)&3)*1024+512)); }while(0)
  #define VRD(i) do{ vlo[i]=vtr(vp_+(((i)>>2)*4096+((i)&3)*1024)); vhi[i]=vtr(vp_+(((i)>>2)*4096+((i)&3)*1024+512)); }while(0)
  #define KRD(G,j) do{ if(G){ kload2(kf,kp0+sl_next,j); SBAR(); } }while(0)
  #define STEP(C0,C1,P0,P1,t,GK,GV,GL) do{ SBAR(); \
    const lds_cptr vp_=vp0+2*sl_prev; \
    VRD(0); SBAR(); float sacc=(P0[0]+P0[1]); \
    bf16x8 q_=QF(0); \
    GAPA(C0=__builtin_amdgcn_mfma_f32_32x32x16_bf16(kf[0],q_,f32x16{},0,0,0), P0[2],P0[3],P0[4],P0[5],     pw0[0]=PKW(P0,0), pw0[1]=PKW(P0,2), pw0); \
    VRD(4); SBAR(); GAPA(C1=__builtin_amdgcn_mfma_f32_32x32x16_bf16(kf[1],q_,f32x16{},0,0,0), P0[6],P0[7],P0[8],P0[9],     pw0[2]=PKW(P0,4), pw0[3]=PKW(P0,6), pw0); \
    q_=QF(1); \
    VRD(1); SBAR(); GAPA(C0=__builtin_amdgcn_mfma_f32_32x32x16_bf16(kf[2],q_,C0,0,0,0),   P0[10],P0[11],P0[12],P0[13], pw1[0]=PKW(P0,8), pw1[1]=PKW(P0,10), pw1); \
    VRD(5); SBAR(); GAPA(C1=__builtin_amdgcn_mfma_f32_32x32x16_bf16(kf[3],q_,C1,0,0,0),   P0[14],P0[15],P1[0],P1[1],   pw1[2]=PKW(P0,12),pw1[3]=PKW(P0,14), pw1); \
    q_=QF(2); \
    VRD(2); SBAR(); GAPA(C0=__builtin_amdgcn_mfma_f32_32x32x16_bf16(kf[4],q_,C0,0,0,0),   P1[2],P1[3],P1[4],P1[5],     pw2[0]=PKW(P1,0), pw2[1]=PKW(P1,2), pw2); \
    VRD(6); SBAR(); GAPA(C1=__builtin_amdgcn_mfma_f32_32x32x16_bf16(kf[5],q_,C1,0,0,0),   P1[6],P1[7],P1[8],P1[9],     pw2[2]=PKW(P1,4), pw2[3]=PKW(P1,6), pw2); \
    q_=QF(3); \
    VRD(3); SBAR(); GAPA(C0=__builtin_amdgcn_mfma_f32_32x32x16_bf16(kf[6],q_,C0,0,0,0),   P1[10],P1[11],P1[12],P1[13], pw3[0]=PKW(P1,8), pw3[1]=PKW(P1,10), pw3); \
    VRD(7); SBAR(); GAPA(C1=__builtin_amdgcn_mfma_f32_32x32x16_bf16(kf[7],q_,C1,0,0,0),   P1[14],P1[15],0.f,0.f,       pw3[2]=PKW(P1,12),pw3[3]=PKW(P1,14), pw3); \
    l_reg+=sacc; \
    if(GK){DMA_K((t)+3,sl_cur);} if(GV){DMA_V((t)+1,sl_next);} \
    _Pragma("unroll") for(int r=0;r<16;++r){C0[r]-=mhat;C1[r]-=mhat;} \
    CMASK(C0,C1,t); \
    { float a=MX3(C0[0],C0[1],C1[0]),b=MX3(C0[2],C0[3],C1[1]); a=MX3(a,C1[2],C1[3]); \
      _Pragma("unroll") for(int r=4;r<16;r+=4){a=MX3(a,C0[r],C0[r+1]);b=MX3(b,C0[r+2],C0[r+3]);a=MX3(a,C1[r],C1[r+1]);b=MX3(b,C1[r+2],C1[r+3]);} \
      float rm=__builtin_fmaxf(a,b); { auto rr=__builtin_amdgcn_permlane32_swap(__float_as_uint(rm),__float_as_uint(rm),false,false); rm=__builtin_fmaxf(__uint_as_float(rr[0]),__uint_as_float(rr[1])); } \
      resc=false; \
      if(__builtin_expect(__any(rm>(float)THRL),0)){ const float dl=__builtin_fmaxf(rm,0.f); mhat+=dl; \
        _Pragma("unroll") for(int r=0;r<16;++r){C0[r]-=dl;C1[r]-=dl;} \
        const float f=__builtin_amdgcn_exp2f(-dl); l_reg*=f; if(hi==0)wsf[r32]=f; resc=true; } } \
    SBAR(); \
    GAPB2(o[0]=__builtin_amdgcn_mfma_f32_32x32x16_bf16(PAF(0),VFR(0),o[0],0,0,0), C0,0,  VRD2(0)); \
    GAPB2(o[1]=__builtin_amdgcn_mfma_f32_32x32x16_bf16(PAF(0),VFR(4),o[1],0,0,0), C0,2,  VRD2(4)); \
    KRD(GL,0); GAPB2(o[0]=__builtin_amdgcn_mfma_f32_32x32x16_bf16(PAF(1),VFR(1),o[0],0,0,0), C0,4,  VRD2(1)); \
    KRD(GL,1); GAPB2(o[1]=__builtin_amdgcn_mfma_f32_32x32x16_bf16(PAF(1),VFR(5),o[1],0,0,0), C0,6,  VRD2(5)); \
    KRD(GL,2); GAPB2(o[0]=__builtin_amdgcn_mfma_f32_32x32x16_bf16(PAF(2),VFR(2),o[0],0,0,0), C0,8,  VRD2(2)); \
    KRD(GL,3); GAPB2(o[1]=__builtin_amdgcn_mfma_f32_32x32x16_bf16(PAF(2),VFR(6),o[1],0,0,0), C0,10, VRD2(6)); \
    GAPB2(o[0]=__builtin_amdgcn_mfma_f32_32x32x16_bf16(PAF(3),VFR(3),o[0],0,0,0), C0,12, VRD2(3)); \
    GAPB2(o[1]=__builtin_amdgcn_mfma_f32_32x32x16_bf16(PAF(3),VFR(7),o[1],0,0,0), C0,14, VRD2(7)); \
      \
    GAPB2(o[2]=__builtin_amdgcn_mfma_f32_32x32x16_bf16(PAF(0),VFR(0),o[2],0,0,0), C1,0,  (void)0); \
    GAPB2(o[3]=__builtin_amdgcn_mfma_f32_32x32x16_bf16(PAF(0),VFR(4),o[3],0,0,0), C1,2,  (void)0); \
    GAPB2(o[2]=__builtin_amdgcn_mfma_f32_32x32x16_bf16(PAF(1),VFR(1),o[2],0,0,0), C1,4,  (void)0); \
    GAPB2(o[3]=__builtin_amdgcn_mfma_f32_32x32x16_bf16(PAF(1),VFR(5),o[3],0,0,0), C1,6,  (void)0); \
    GAPB2(o[2]=__builtin_amdgcn_mfma_f32_32x32x16_bf16(PAF(2),VFR(2),o[2],0,0,0), C1,8,  (void)0); \
    GAPB2(o[3]=__builtin_amdgcn_mfma_f32_32x32x16_bf16(PAF(2),VFR(6),o[3],0,0,0), C1,10, (void)0); \
    GAPB2(o[2]=__builtin_amdgcn_mfma_f32_32x32x16_bf16(PAF(3),VFR(3),o[2],0,0,0), C1,12, (void)0); \
    GAPB2(o[3]=__builtin_amdgcn_mfma_f32_32x32x16_bf16(PAF(3),VFR(7),o[3],0,0,0), C1,14, (void)0); \
    }while(0)
  int t=1;
  #undef CMASK
  #define CMASK(P0,P1,t) do{}while(0)
  for(;t+5<NT;t+=2){
    STEP(pB0,pB1,pA0,pA1,t,true,true,true);     WAIT_BAR(3); RESC(); ROT();
    STEP(pA0,pA1,pB0,pB1,t+1,true,true,true);   WAIT_BAR(3); RESC(); ROT();
  }
  #undef CMASK
  #define CMASK(P0,P1,t) do{int jb_=(t)-(NT-4); if(jb_>=0){ const int l_=lane_id_v(); cmask(P0,P1,jb_,wid*QBLK+(l_&31),l_>>5); } }while(0)
  #define ENDW(tt) do{ if((tt)+3<NT){WAIT_BAR(3);} else if((tt)+2<NT){WAIT_BAR(2);} else {WAIT_BAR(0);} }while(0)
  for(;t+1<NT;t+=2){
    STEP(pB0,pB1,pA0,pA1,t,(t+3<NT),(t+1<NT),(t+1<NT));       ENDW(t);   RESC(); ROT();
    STEP(pA0,pA1,pB0,pB1,t+1,(t+4<NT),(t+2<NT),(t+2<NT));     ENDW(t+1); RESC(); ROT();
  }
  STEP(pB0,pB1,pA0,pA1,NT-1,false,false,false); RESC();
  { float sacc=pB0[0]+pB0[1]; _Pragma("unroll") for(int r=2;r<16;++r)sacc+=pB0[r]; _Pragma("unroll") for(int r=0;r<16;++r)sacc+=pB1[r]; l_reg+=sacc;
    pw0=(u32x4){PKW(pB0,0),PKW(pB0,2),PKW(pB0,4),PKW(pB0,6)};pw1=(u32x4){PKW(pB0,8),PKW(pB0,10),PKW(pB0,12),PKW(pB0,14)};pw2=(u32x4){PKW(pB1,0),PKW(pB1,2),PKW(pB1,4),PKW(pB1,6)};pw3=(u32x4){PKW(pB1,8),PKW(pB1,10),PKW(pB1,12),PKW(pB1,14)};
    const int vb0=(int)(lds0+LDS_V)+((lane>>4)&1)*32+(lane&3)*8+(4*hi+((lane&15)>>2))*64;
    SBAR(); pv(o,vb0+2*sl_cur,PAF(0),PAF(1),PAF(2),PAF(3)); pv(o+2,vb0+2*sl_cur+8192,PAF(0),PAF(1),PAF(2),PAF(3)); }
  #undef PKW
  #undef PAF
  #undef VFR
  #undef PIN
  #undef MX3
  #undef GAPA
  #undef GAPB
  #undef GAPB2
  #undef VRD2
  #undef EX
  #undef VRD
  #undef KRD
  #undef STEP
  #undef ENDW
  {auto rr=__builtin_amdgcn_permlane32_swap(__float_as_uint(l_reg),__float_as_uint(l_reg),false,false);l_reg=__uint_as_float(rr[0])+__uint_as_float(rr[1]);}
  if(hi==0)wsf[32+r32]=l_reg;asm volatile("s_waitcnt lgkmcnt(0)":::"memory");
  float rli[16];
  #pragma unroll
  for(int r=0;r<16;++r)rli[r]=__builtin_amdgcn_rcpf(wsf[32+crow(r,hi)]);
  bf16*Ow=O+(rowbase+q0+wid*QBLK)*OP+ocol;
  { bf16*stg=(bf16*)(shm+LDS_OST)+wid*2048;
    #pragma unroll
    for(int hf=0;hf<2;++hf){
      #pragma unroll
      for(int r=0;r<16;++r){const int orow=crow(r,hi);
        #pragma unroll
        for(int d0=0;d0<2;++d0)stg[orow*64+d0*32+r32]=__float2bfloat16(o[2*hf+d0][r]*rli[r]);}
      asm volatile("s_waitcnt lgkmcnt(0)":::"memory");
      #pragma unroll
      for(int i=0;i<4;++i){const int row=i*8+(lane>>3),ch=lane&7; const u32x4 v=*(const u32x4*)(stg+row*64+ch*8); ATTN_STORE16(Ow+(long)row*OP+hf*64+ch*8,v);}
      asm volatile("s_waitcnt lgkmcnt(0)":::"memory"); } }
  asm volatile("s_waitcnt lgkmcnt(0)\n\ts_barrier":::"memory");
  #undef DMA_K
  #undef DMA_V
  #undef QF
  #undef CMASK
  #undef START
  #undef RESC
  #undef ROT
}
constexpr int ATTN_LDS_BYTES=LDS_BYTES;
struct AttnTensors { const bf16* Q; const bf16* K; const bf16* V; bf16* O; };
struct AttnUnit { int bh; int qb; };
struct QueueOrder {
  unsigned* ctr; volatile __attribute__((address_space(3))) unsigned* slot; int wid;
  __device__ __forceinline__ unsigned claim()const{ unsigned n=0u; if(wid==0&&lane_id_v()==0) n=__hip_atomic_fetch_add(ctr,1u,__ATOMIC_RELAXED,__HIP_MEMORY_SCOPE_AGENT); return n; }
  __device__ __forceinline__ unsigned publish(unsigned n,int par)const{
    if(wid==0&&lane_id_v()==0) slot[par]=n;
    asm volatile("s_waitcnt lgkmcnt(0)\n\ts_barrier":::"memory");
    const unsigned r=slot[par]; asm volatile("s_waitcnt lgkmcnt(0)":::"memory"); return r; }
  __device__ __forceinline__ void a_ready(const AttnUnit&)const{}
  __device__ __forceinline__ void done(const AttnUnit&)const{}
};
template<class Sched,int THRL=8> __device__ __forceinline__ void attn_phase(char*lds,const AttnTensors&T,const Sched&S,const int wid){
  unsigned nxt=S.claim(); int par=0;
  for(;;){ const unsigned n=S.publish(nxt,par); par^=1; if(n>=(unsigned)(BATCH*NHEAD*NQB))break;
    nxt=S.claim();
    const int qb=NQB-1-(int)(n/(BATCH*NHEAD)), bh=(int)(n%(BATCH*NHEAD));
    attn_unit<THRL>(bh/NHEAD,bh%NHEAD,qb,T.Q,T.K,T.V,T.O,lds,wid); }
}
#undef SBAR
#undef WAIT_BAR
}
constexpr int NWAVES = 8;
#ifndef MK_N_LAUNCHES
#define MK_N_LAUNCHES 1
#endif
constexpr int N_PHASES = 14;
#ifndef PROBE_MASK
#define PROBE_MASK 0
#endif
constexpr int N_LAUNCHES = MK_N_LAUNCHES;
static_assert(N_LAUNCHES == 1 || N_LAUNCHES == N_PHASES, "MK_N_LAUNCHES is 1 or 14");

constexpr int BATCH = 8, T = 4096, D = 1024, M = BATCH * T;
constexpr int IN_COLS = 3328, RWC = 1792, NEXP = 32, TOPK = 4, NMOD = 6 * D;
constexpr int MAXROWS = M * TOPK + NEXP * 256;
constexpr int MOD_KS = 8;

constexpr size_t MiB = 1u << 20, KiB = 1u << 10;
constexpr size_t WS_CTL = 0, CTL_ZERO_BYTES = 1 * MiB;
constexpr size_t WS_MODP = 1 * MiB;
constexpr size_t WS_MOD = 2 * MiB + 512 * KiB;
constexpr size_t WS_ROPE = 3 * MiB;
constexpr size_t WS_WIN = 5 * MiB;
constexpr size_t WS_WOUT = 12 * MiB;
constexpr size_t WS_BLORA = 14 * MiB;
constexpr size_t WS_TOKE = 15 * MiB, WS_TOKG = 15 * MiB + 512 * KiB;
constexpr size_t WS_TOKROW = 16 * MiB, WS_ROWTOK = 16 * MiB + 512 * KiB, WS_ROWGATE = 17 * MiB + 256 * KiB, WS_BLKBASE = 18 * MiB;
constexpr size_t WS_W1 = 20 * MiB, WS_W2 = 148 * MiB;
constexpr size_t WS_H2 = 212 * MiB;
constexpr size_t WS_H = 276 * MiB, WS_Q = 340 * MiB, WS_K = 372 * MiB, WS_V = 404 * MiB, WS_RW = 436 * MiB;
constexpr size_t WS_O = 548 * MiB, WS_YCAT = 612 * MiB, WS_LACT = 676 * MiB;
constexpr size_t WS_LW = 692 * MiB, WS_AS = 756 * MiB, WS_G = 820 * MiB, WS_Y = 884 * MiB;
constexpr size_t WS_RIMG = 884 * MiB, WS_RBON = 1012 * MiB;
constexpr size_t WS_ACT = 276 * MiB, WS_Y2 = 548 * MiB, WS_END = 1013 * MiB;
static_assert(WS_ROWTOK + (size_t)MAXROWS * 4 <= WS_ROWGATE && WS_ROWGATE + (size_t)MAXROWS * 4 <= WS_BLKBASE && WS_ACT + (size_t)MAXROWS * 2048 <= WS_Y2 && WS_Y2 + (size_t)MAXROWS * 2048 <= WS_Y, "d_ws map");
constexpr int CW_TMO = 0, CW_CODE = 1;
constexpr int CW_BAR = 4096;
constexpr int CW_ATTQ = 8192;
constexpr int CW_ECNT = 12288;
static_assert((CW_ECNT + 2 * 64 * NEXP) * 4 <= (int)CTL_ZERO_BYTES, "CTL words inside the memset region");

constexpr int RING_OFF = 0, RING_BYTES = 131072;
constexpr int LDSCTL_OFF = RING_BYTES, MISC_OFF = LDSCTL_OFF + 320;
constexpr int LDS_BYTES = 147456;
static_assert(MISC_OFF + 128 <= LDS_BYTES, "LDS map");
#define GAS __attribute__((address_space(1)))
#define LAS __attribute__((address_space(3)))
typedef unsigned short bf16;
typedef unsigned v4u __attribute__((ext_vector_type(4)));
typedef float f32x4 __attribute__((ext_vector_type(4)));
typedef short bf16x8 __attribute__((ext_vector_type(8)));
typedef GAS unsigned gu32;
typedef GAS unsigned long long gu64;
#define RLX_AGENT __ATOMIC_RELAXED, __HIP_MEMORY_SCOPE_AGENT
#define LDS_WAIT() asm volatile("s_waitcnt lgkmcnt(0)" ::: "memory")
#define VM_WAIT() asm volatile("s_waitcnt vmcnt(0)" ::: "memory")
__device__ __forceinline__ unsigned long long rt() { return __builtin_amdgcn_s_memrealtime(); }
__device__ __forceinline__ unsigned f2bf(float f) { unsigned u = __builtin_bit_cast(unsigned, f); return (u + 0x7fffu + ((u >> 16) & 1u)) >> 16; }
__device__ __forceinline__ unsigned pk2(float lo, float hi) { return f2bf(lo) | (f2bf(hi) << 16); }

#define XB_TMO      128
#define XB_XCNT(j)  (256  + 64 * (j))
#define XB_XSUB(j)  (1280 + 64 * (j))
#define XB_XGEN(j)  (2304 + 64 * (j))
#define XB_TOP      3328
#define XB_TOPGEN   3392
#define XCD_BAR_WORDS 3456
#define XB_SPIN_CAP (1u << 18)

__device__ __forceinline__ unsigned xb_ld(unsigned* p)              { return __hip_atomic_load(p, __ATOMIC_RELAXED, __HIP_MEMORY_SCOPE_AGENT); }
__device__ __forceinline__ unsigned xb_add(unsigned* p, unsigned v) { return __hip_atomic_fetch_add(p, v, __ATOMIC_RELAXED, __HIP_MEMORY_SCOPE_AGENT); }
__device__ __forceinline__ unsigned xb_xcc_id() { return (unsigned)__builtin_amdgcn_s_getreg((3 << 11) | 20) & 0xFu; }
#define XB_SPIN(cond, bar) do { unsigned _sp = 0; while (cond) { __builtin_amdgcn_s_sleep(1); \
    if ((++_sp & 255u) == 0u) { if (xb_ld(&(bar)[XB_TMO])) break; if (_sp > XB_SPIN_CAP) { atomicAdd(&(bar)[XB_TMO], 1u); break; } } } } while (0)

struct XcdBarrier {
    unsigned* bar; unsigned x; int wid;
    volatile LAS unsigned* st;
};

__device__ __forceinline__ XcdBarrier xcd_barrier_post(unsigned* bar, volatile LAS unsigned* st, int wid) {
    XcdBarrier b; b.bar = bar; b.x = xb_xcc_id(); b.st = st; b.wid = wid;
    if (threadIdx.x == 0) (void)xb_add(&bar[XB_XCNT(b.x)], 1u);
    return b;
}
__device__ __forceinline__ void xcd_barrier_complete(unsigned* bar, unsigned x, unsigned& nloc, unsigned& nx) {
    const unsigned G = gridDim.x * gridDim.y * gridDim.z;
    unsigned sum, cnt, mine, sp = 0u;
    for (;;) {
        sum = 0u; cnt = 0u; mine = 0u;
#pragma unroll
        for (unsigned j = 0; j < 16; ++j) { const unsigned c = xb_ld(&bar[XB_XCNT(j)]); sum += c; cnt += (c > 0u) ? 1u : 0u; mine = (j == x) ? c : mine; }
        if (sum == G) break;
        __builtin_amdgcn_s_sleep(1);
        if ((++sp & 255u) == 0u) { if (xb_ld(&bar[XB_TMO])) break; if (sp > XB_SPIN_CAP) { atomicAdd(&bar[XB_TMO], 1u); break; } }
    }
    nloc = mine > 0u ? mine : 1u; nx = cnt > 0u ? cnt : 1u;
}

__device__ __forceinline__ void xcd_barrier(const XcdBarrier& b) {
    asm volatile("s_waitcnt vmcnt(0)" ::: "memory");
    __syncthreads();
    if (b.wid == 0 && lane_id_v() == 0) {
        unsigned* bar = b.bar;
        __builtin_amdgcn_s_waitcnt(0);
        unsigned nloc = b.st[0], nx = b.st[1];
        if (nloc == 0u) { xcd_barrier_complete(bar, b.x, nloc, nx); b.st[0] = nloc; b.st[1] = nx; }
        const unsigned old = xb_add(&bar[XB_XSUB(b.x)], 1u);
        const unsigned gen = old / nloc;
        if (old + 1u == (gen + 1u) * nloc) {
            __builtin_amdgcn_fence(__ATOMIC_RELEASE, "agent");
            asm volatile("s_waitcnt vmcnt(0)" ::: "memory");
            const unsigned og = xb_add(&bar[XB_TOP], 1u);
            const unsigned tg = og / nx;
            if (og + 1u == (tg + 1u) * nx) xb_add(&bar[XB_TOPGEN], 1u);
            else XB_SPIN(xb_ld(&bar[XB_TOPGEN]) == tg, bar);
            __builtin_amdgcn_fence(__ATOMIC_ACQUIRE, "agent");
            xb_add(&bar[XB_XGEN(b.x)], 1u);
            asm volatile("s_waitcnt vmcnt(0)" ::: "memory");
        } else {
            XB_SPIN(xb_ld(&bar[XB_XGEN(b.x)]) == gen, bar);
            __builtin_amdgcn_fence(__ATOMIC_ACQUIRE, "agent");
            asm volatile("s_waitcnt vmcnt(0)" ::: "memory");
        }
    }
    __syncthreads();
}
typedef float f32x2 __attribute__((ext_vector_type(2)));
typedef unsigned u32x2 __attribute__((ext_vector_type(2)));
struct Frame {
    LAS unsigned char* lds;
    volatile LAS unsigned* MISC;
    gu32* ctl;
    int wave;
    int vcu, G;
    unsigned char* ws; float* out;
};
struct Args { const void* in[33]; float* out; unsigned char* ws; int ph_lo, ph_hi, li, pad; };
struct InProxy { __device__ __forceinline__ const void* operator[](int k) const { unsigned long long v; const unsigned long long kp = (unsigned long long)__builtin_amdgcn_kernarg_segment_ptr();
    asm volatile("s_load_dwordx2 %0, %1, %2\n\ts_waitcnt lgkmcnt(0)" : "=s"(v) : "s"(kp), "s"(8 * k) : "memory"); return (const void*)(const GAS unsigned char*)v; } };
struct ArgsD { InProxy in; };

__device__ __forceinline__ float wave_sum(float v) {
#pragma unroll
    for (int o = 1; o < 64; o <<= 1) v += __shfl_xor(v, o);
    return v;
}
__device__ __forceinline__ float bf2f(unsigned short u) { return __uint_as_float((unsigned)u << 16); }
__device__ __forceinline__ float bflo(unsigned u) { return __uint_as_float(u << 16); }
__device__ __forceinline__ float bfhi(unsigned u) { return __uint_as_float(u & 0xffff0000u); }
typedef float f32x2_t __attribute__((ext_vector_type(2))); typedef __bf16 bf16x2_t __attribute__((ext_vector_type(2)));
__device__ __forceinline__ unsigned pkbf(float lo, float hi) { f32x2_t v = {lo, hi}; bf16x2_t b = __builtin_convertvector(v, bf16x2_t); return __builtin_bit_cast(unsigned, b); }
#define DPP_ADD(x, ctrl) ((x) + __builtin_bit_cast(float, __builtin_amdgcn_update_dpp(0, __builtin_bit_cast(int, (x)), (ctrl), 0xF, 0xF, true)))
__device__ __forceinline__ float allsum16(float x) {
    x = DPP_ADD(x, 0xB1); x = DPP_ADD(x, 0x4E); x = DPP_ADD(x, 0x124); x = DPP_ADD(x, 0x128); return x; }

struct P0Item { const float* src; bf16* dst; int N, K, n0; bool permq, fp8; };
__device__ __forceinline__ bool p0_decode(const Frame& F, int it, P0Item& d, const float* w_in, const float* w_out, const float* w1, const float* w2m) {
    constexpr int I_IN = (D / 64) * (IN_COLS / 32), I_OUT = (D / 64) * (D / 32), I_W1 = (D / 64) * (2048 / 32), I_W2 = (D / 64) * (D / 32);
    constexpr int NITEMS = I_IN + I_OUT + NEXP * I_W1 + NEXP * I_W2;
    if (it >= NITEMS) return false;
    const float* W; bf16* WT; int N, r = it; d.permq = false; d.fp8 = false; d.K = D;
    if (r < I_IN) { W = w_in; WT = (bf16*)(F.ws + WS_WIN); N = IN_COLS; d.permq = true; }
    else { r -= I_IN; if (r < I_OUT) { W = w_out; WT = (bf16*)(F.ws + WS_WOUT); N = D; }
        else { r -= I_OUT; if (r < NEXP * I_W1) { const int e = r / I_W1; r -= e * I_W1; W = w1 + (size_t)e * D * 2048; WT = (bf16*)(F.ws + WS_W1 + (size_t)e * 2048 * D); N = 2048; d.fp8 = true; }
            else { r -= NEXP * I_W1; const int e = r / I_W2; r -= e * I_W2; W = w2m + (size_t)e * D * D; WT = (bf16*)(F.ws + WS_W2 + (size_t)e * D * D); N = D; d.fp8 = true; } } }
    const int nblk = N / 32, kb = r / nblk, nb = r - kb * nblk; d.N = N; d.n0 = 32 * nb; d.src = W + (size_t)(64 * kb) * N + d.n0; d.dst = d.fp8 ? (bf16*)((unsigned char*)WT + 64 * kb) : WT + 64 * kb; return true;
}
__device__ __forceinline__ void p0_item_store(const P0Item& d, const float (&v)[32], LAS float* scr, int lane) {
#pragma unroll
    for (int i = 0; i < 32; ++i) scr[(2 * i + (lane >> 5)) * 33 + (lane & 31)] = v[i];
    LDS_WAIT(); asm volatile("" ::: "memory");
    const int c = lane & 7;
#pragma unroll
    for (int j = 0; j < 4; ++j) { const int n = (lane >> 3) + 8 * j; const LAS float* s = scr + (8 * c) * 33 + n;
        int nn = d.n0 + n;
        if (d.fp8) { const u32x2 o8 = (u32x2){pg8::pk4_fp8(s[0 * 33] * pg8::W8_SCALE, s[1 * 33] * pg8::W8_SCALE, s[2 * 33] * pg8::W8_SCALE, s[3 * 33] * pg8::W8_SCALE), pg8::pk4_fp8(s[4 * 33] * pg8::W8_SCALE, s[5 * 33] * pg8::W8_SCALE, s[6 * 33] * pg8::W8_SCALE, s[7 * 33] * pg8::W8_SCALE)};
            *(GAS u32x2*)((unsigned char*)d.dst + (size_t)nn * d.K + 8 * c) = o8; }
        else { v4u o; o.x = pkbf(s[0 * 33], s[1 * 33]); o.y = pkbf(s[2 * 33], s[3 * 33]); o.z = pkbf(s[4 * 33], s[5 * 33]); o.w = pkbf(s[6 * 33], s[7 * 33]);
            if (d.permq && nn < 1024) { const int dd = nn & 63; if (dd < 16) nn = (nn & ~63) + ((dd < 8) ? 2 * dd : 2 * (dd - 8) + 1); }
            *(GAS v4u*)(d.dst + (size_t)nn * d.K + 8 * c) = o; } }
    LDS_WAIT(); asm volatile("" ::: "memory");
}
__device__ __forceinline__ void sincos_d(float af, float& s, float& c) {
    const double a = (double)af; const double n = __builtin_rint(a * 0.63661977236758134308);
    double r = __builtin_fma(-n, 1.57079632679489655800e+00, a); r = __builtin_fma(-n, 6.12323399573676603587e-17, r);
    const double r2 = r * r;
    double sp = 1.0 / 6227020800.0; sp = sp * r2 * -1.0 + 1.0 / 39916800.0; sp = -sp * r2 + 1.0 / 362880.0; sp = -sp * r2 + 1.0 / 5040.0; sp = -sp * r2 + 1.0 / 120.0; sp = -sp * r2 + 1.0 / 6.0; sp = r - r * r2 * sp;
    double cp = 1.0 / 87178291200.0; cp = -cp * r2 + 1.0 / 479001600.0; cp = -cp * r2 + 1.0 / 3628800.0; cp = -cp * r2 + 1.0 / 40320.0; cp = -cp * r2 + 1.0 / 720.0; cp = -cp * r2 + 1.0 / 24.0; cp = -cp * r2 + 0.5; cp = 1.0 - r2 * cp;
    const int q = ((int)n) & 3;
    const double sv = (q == 0) ? sp : (q == 1) ? cp : (q == 2) ? -sp : -cp, cv = (q == 0) ? cp : (q == 1) ? -sp : (q == 2) ? -cp : sp;
    s = (float)sv; c = (float)cv;
}
__device__ __forceinline__ void p0_prologue(Frame& F, const ArgsD& A) {
    const int lane = lane_id_v(), tid = F.wave * 64 + lane; (void)tid;
    const int gw = F.vcu * NWAVES + F.wave, NGW = F.G * NWAVES, gt = F.vcu * 512 + tid, NGT = F.G * 512;
    LAS float* scr = (LAS float*)(F.lds + RING_OFF + F.wave * 12288);
    LAS float* sl = (LAS float*)(F.lds + RING_OFF + 98304);
    const float* c = (const float*)A.in[1];
    for (int i = tid; i < 8 * 1024; i += 512) { const float v = c[i]; sl[i] = v / (1.f + __expf(-v)); }
    __syncthreads();
    { const float* aw = (const float*)A.in[3]; float* modp = (float*)(F.ws + WS_MODP);
      for (int it = gw; it < 96 * MOD_KS; it += NGW) { const int cc = it % 96, ks = it / 96, col = cc * 64 + lane;
          float acc[8];
#pragma unroll
          for (int b = 0; b < 8; ++b) acc[b] = 0.f;
          for (int k = ks * 128; k < ks * 128 + 128; ++k) { const float w = aw[(size_t)k * NMOD + col];
#pragma unroll
              for (int b = 0; b < 8; ++b) acc[b] += sl[b * 1024 + k] * w; }
#pragma unroll
          for (int b = 0; b < 8; ++b) modp[(size_t)(ks * 8 + b) * NMOD + col] = acc[b]; } }
    { const int* pos = (const int*)A.in[2]; float* rope = (float*)(F.ws + WS_ROPE);
      for (int idx = gt; idx < M * 8; idx += NGT) { const int m = idx >> 3, i = idx & 7;
          const float invf = (i == 0) ? 1.0f : (i == 1) ? 0.1939227432012558f : (i == 2) ? 0.03760603070259094f : (i == 3) ? 0.007292664609849453f : (i == 4) ? 0.0014142135623842478f : (i == 5) ? 0.00027424818836152554f : (i == 6) ? 5.318296098266728e-05f : 1.0313386155758053e-05f;
          const float ang = (float)pos[m] * invf; float s, cc; sincos_d(ang, s, cc); rope[(size_t)m * 16 + i] = cc; rope[(size_t)m * 16 + 8 + i] = s; } }
    { const float* w2 = (const float*)A.in[18]; const float* a2 = (const float*)A.in[20]; const float* g2 = (const float*)A.in[21]; bf16* bl = (bf16*)(F.ws + WS_BLORA);
      for (int idx = gt; idx < 1536 * 256; idx += NGT) { const int n = idx >> 8, k = idx & 255, blk = n >> 9, nn = n & 511; float v = 0.f;
          if (blk == 0 && k < 64) v = w2[k * 512 + nn]; else if (blk == 1 && k >= 64 && k < 128) v = a2[(k - 64) * 512 + nn]; else if (blk == 2 && k >= 128) v = g2[(k - 128) * 512 + nn];
          bl[idx] = (bf16)(pkbf(v, 0.f) & 0xffffu); } }
    { const float* w_in = (const float*)A.in[9]; const float* w_out = (const float*)A.in[10]; const float* w1 = (const float*)A.in[29]; const float* w2m = (const float*)A.in[31];
      P0Item cur, nxt; float v[32], vn[32];
      bool have = p0_decode(F, gw, cur, w_in, w_out, w1, w2m);
      if (have) {
#pragma unroll
          for (int i = 0; i < 32; ++i) v[i] = cur.src[(size_t)(2 * i + (lane >> 5)) * cur.N + (lane & 31)]; }
      for (int it = gw; have; it += NGW) {
          const bool hn = p0_decode(F, it + NGW, nxt, w_in, w_out, w1, w2m);
          if (hn) {
#pragma unroll
              for (int i = 0; i < 32; ++i) vn[i] = nxt.src[(size_t)(2 * i + (lane >> 5)) * nxt.N + (lane & 31)]; }
          p0_item_store(cur, v, scr, lane);
          cur = nxt; have = hn;
#pragma unroll
          for (int i = 0; i < 32; ++i) v[i] = vn[i];
      } }
}

__device__ __forceinline__ void p1_premix(Frame& F, const ArgsD& A) {
    const int lane = lane_id_v(), tid = F.wave * 64 + lane; (void)tid;
    const float* modp = (const float*)(F.ws + WS_MODP); const float* ada_b = (const float*)A.in[4]; float* mod = (float*)(F.ws + WS_MOD);
    const int rows_per = M / F.G, mbeg = F.vcu * rows_per, b = mbeg >> 12;
    LAS float* ms = (LAS float*)(F.lds + RING_OFF);
    for (int col = tid; col < 2048; col += 512) { float s = ada_b[col];
#pragma unroll
        for (int ks = 0; ks < MOD_KS; ++ks) s += modp[(size_t)(ks * 8 + b) * NMOD + col];
        ms[col] = s; }
    for (int i = F.vcu * 512 + tid; i < 8 * 4096; i += F.G * 512) { const int bb = i >> 12, col = 2048 + (i & 4095); float s = ada_b[col];
#pragma unroll
        for (int ks = 0; ks < MOD_KS; ++ks) s += modp[(size_t)(ks * 8 + bb) * NMOD + col];
        mod[(size_t)bb * NMOD + col] = s; }
    __syncthreads();
    const float* x = (const float*)A.in[0]; const float* nw = (const float*)A.in[5]; bf16* H = (bf16*)(F.ws + WS_H);
    f32x4 wsc[4], sh[4];
#pragma unroll
    for (int j = 0; j < 4; ++j) { const int col = 4 * lane + 256 * j; wsc[j] = *((const f32x4*)nw + lane + 64 * j) * (*(const LAS f32x4*)(ms + 1024 + col) + 1.f); sh[j] = *(const LAS f32x4*)(ms + col); }
    const int nr = rows_per / NWAVES, m0 = mbeg + F.wave * nr;
    f32x4 pv[4];
#pragma unroll
    for (int j = 0; j < 4; ++j) pv[j] = *((const GAS f32x4*)(x + (size_t)m0 * D) + lane + 64 * j);
    for (int i = 0; i < nr; ++i) { const int m = m0 + i;
        f32x4 v[4]; float s2 = 0.f;
#pragma unroll
        for (int j = 0; j < 4; ++j) { v[j] = pv[j]; s2 += (v[j].x * v[j].x + v[j].y * v[j].y) + (v[j].z * v[j].z + v[j].w * v[j].w); }
        if (i + 1 < nr) {
#pragma unroll
            for (int j = 0; j < 4; ++j) pv[j] = *((const GAS f32x4*)(x + (size_t)(m + 1) * D) + lane + 64 * j); }
        const float rs = __builtin_amdgcn_rsqf(wave_sum(s2) * (1.f / D) + 1e-6f);
        GAS u32x2* o8 = (GAS u32x2*)(H + (size_t)m * D) + lane;
#pragma unroll
        for (int j = 0; j < 4; ++j) { const f32x4 y = v[j] * rs * wsc[j] + sh[j]; o8[64 * j] = (u32x2){pkbf(y.x, y.y), pkbf(y.z, y.w)}; } }
}

__device__ __forceinline__ void p3_lact(Frame& F, const ArgsD& A) {
    const int lane = lane_id_v(), tid = F.wave * 64 + lane; (void)tid;
    const bf16* RW = (const bf16*)(F.ws + WS_RW); bf16* L = (bf16*)(F.ws + WS_LACT); const float* mu = (const float*)A.in[16] + 1536;
    const int gw = F.vcu * NWAVES + F.wave, NGW = F.G * NWAVES, c0 = 4 * lane;
    const f32x4 mu4 = *(const f32x4*)(mu + c0);
    for (int m = gw; m < M; m += NGW) { const int t = m & (T - 1);
        const u32x2 p = *(const GAS u32x2*)(RW + (size_t)m * RWC + 1536 + c0); u32x2 q = (u32x2){0u, 0u}; if (t > 0) q = *(const GAS u32x2*)(RW + (size_t)(m - 1) * RWC + 1536 + c0);
        f32x4 pv = (f32x4){bflo(p.x), bfhi(p.x), bflo(p.y), bfhi(p.y)}, qv = (f32x4){bflo(q.x), bfhi(q.x), bflo(q.y), bfhi(q.y)};
        f32x4 s = pv + (qv - pv) * mu4;
        if (c0 < 64) { s.x = tanhf(s.x); s.y = tanhf(s.y); s.z = tanhf(s.z); s.w = tanhf(s.w); }
        else if (c0 >= 128) { s.x = 1.f / (1.f + __expf(-s.x)); s.y = 1.f / (1.f + __expf(-s.y)); s.z = 1.f / (1.f + __expf(-s.z)); s.w = 1.f / (1.f + __expf(-s.w)); }
        *(GAS u32x2*)(L + (size_t)m * 256 + c0) = (u32x2){pkbf(s.x, s.y), pkbf(s.z, s.w)}; }
}

namespace rwk {
typedef short bf16x8 __attribute__((ext_vector_type(8)));
constexpr int MB = 8192;
__device__ __forceinline__ int moff(int r, int c) { return r * 128 + ((((c >> 3) ^ (r >> 1)) & 7) << 4) + ((c & 7) << 1); }
__device__ __forceinline__ bf16x8 frag(const LAS unsigned char* buf, int row, int chunk) { return *(const LAS bf16x8*)(buf + row * 128 + (((chunk ^ (row >> 1)) & 7) << 4)); }
struct LaneOff { int f[2], sb, mb[2]; };
__device__ __forceinline__ LaneOff lane_off(int l) { LaneOff o; const int r16 = l & 15, q = l >> 4, key = (l >> 1) & 7;
    o.f[0] = r16 * 128 + (((q) ^ key) << 4); o.f[1] = r16 * 128 + (((4 + q) ^ key) << 4);
    o.sb = r16 * 128 + ((((q >> 1) ^ key) & 7) << 4) + (q & 1) * 8;
#pragma unroll
    for (int p = 0; p < 2; ++p) { const int keyr = (2 * q + p) & 7; o.mb[p] = (4 * q + 2 * p) * 128 + ((((r16 >> 3) ^ keyr) & 7) << 4) + (r16 & 7) * 2; }
    return o; }
__device__ __forceinline__ void mm(f32x4& acc, const LAS unsigned char* A, int tm, const LAS unsigned char* B, int tn, const LaneOff& o) {
#pragma unroll
    for (int ks = 0; ks < 2; ++ks) { const bf16x8 a = *(const LAS bf16x8*)(A + tm * 2048 + o.f[ks]), b = *(const LAS bf16x8*)(B + tn * 2048 + o.f[ks]); acc = __builtin_amdgcn_mfma_f32_16x16x32_bf16(a, b, acc, 0, 0, 0); }
}
__device__ __forceinline__ void st_nm(LAS unsigned char* buf, int tm, int tn, const LaneOff& o, f32x4 v) {
    *(LAS u32x2*)(buf + tn * 2048 + (o.sb ^ (tm << 5))) = (u32x2){pkbf(v[0], v[1]), pkbf(v[2], v[3])}; }
__device__ __forceinline__ void st_mn(LAS unsigned char* buf, int tm, int tn, const LaneOff& o, f32x4 v) {
    const unsigned p0 = pkbf(v[0], v[1]), p1 = pkbf(v[2], v[3]); LAS unsigned char* b0 = buf + tm * 2048 + (o.mb[0] ^ (tn << 5)); LAS unsigned char* b1 = buf + tm * 2048 + (o.mb[1] ^ (tn << 5));
    *(LAS unsigned short*)(b0) = (unsigned short)(p0 & 0xffffu); *(LAS unsigned short*)(b0 + 128) = (unsigned short)(p0 >> 16);
    *(LAS unsigned short*)(b1) = (unsigned short)(p1 & 0xffffu); *(LAS unsigned short*)(b1 + 128) = (unsigned short)(p1 >> 16); }
__device__ __forceinline__ f32x4 ld_nm(const LAS unsigned char* buf, int tm, int tn, const LaneOff& o) {
    const u32x2 p = *(const LAS u32x2*)(buf + tn * 2048 + (o.sb ^ (tm << 5))); return (f32x4){bflo(p.x), bfhi(p.x), bflo(p.y), bfhi(p.y)}; }
__device__ __forceinline__ float wsum64(float x) {
    x = DPP_ADD(x, 0xB1); x = DPP_ADD(x, 0x4E); x = DPP_ADD(x, 0x124); x = DPP_ADD(x, 0x128);
    x += __shfl_xor(x, 16); x += __shfl_xor(x, 32); return x; }
__device__ __forceinline__ float sum8(float x) { x = DPP_ADD(x, 0xB1); x = DPP_ADD(x, 0x4E); x = DPP_ADD(x, 0x141); return x; }
}

__device__ __forceinline__ void rwkv_pre(Frame& F, const ArgsD& A, const int bh, const int c_lo, const int c_hi) {
    using namespace rwk;
    const int b = bh >> 3, h = bh & 7, lane0 = lane_id_v(), w0 = F.wave;
    const LaneOff LO = lane_off(lane0);
    LAS unsigned char* L = F.lds + RING_OFF;
    LAS unsigned char* bA = L + 0 * MB; LAS unsigned char* bR = L + 1 * MB; LAS unsigned char* bB = L + 2 * MB; LAS unsigned char* bK = L + 3 * MB;
    LAS unsigned char* bBH = L + 4 * MB; LAS unsigned char* bKH = L + 5 * MB; LAS unsigned char* bVT = L + 6 * MB;
    LAS unsigned char* bAT = L + 7 * MB;
    LAS unsigned char* bAak = L + 9 * MB; LAS unsigned char* bArb = L + 10 * MB; LAS unsigned char* bArk = L + 11 * MB;
    LAS unsigned char* bQ0 = L + 12 * MB; LAS unsigned char* bQT0 = L + 13 * MB;
    LAS unsigned char* bT = L + 14 * MB;
    LAS unsigned char* bTF = L + 15 * MB;
    LAS float* part = (LAS float*)(F.lds + MISC_OFF + 128);
    LAS float* bon = part + 512;
    const bf16* RW = (const bf16*)(F.ws + WS_RW); const bf16* LW = (const bf16*)(F.ws + WS_LW); const bf16* AS = (const bf16*)(F.ws + WS_AS);
    unsigned char* IMG = F.ws + WS_RIMG; float* BON = (float*)(F.ws + WS_RBON);
    const size_t mb = (size_t)b * T;
    const float* mu = (const float*)A.in[16];
    float mu_r, mu_k, mu_v, kkc, kac, rkc;
    { const int hj = h * 64 + lane0; mu_r = mu[hj]; mu_k = mu[512 + hj]; mu_v = mu[1024 + hj]; kkc = ((const float*)A.in[22])[hj]; kac = ((const float*)A.in[23])[hj]; rkc = ((const float*)A.in[24])[hj]; }
    unsigned short pr[9], pk_[9], pv[9], plw[8], pas[8];
#define RWC_LOAD(c) do { const int w = w0, hj = h * 64 + lane0; const size_t m0_ = mb + (size_t)(c) * 64 + 8 * w; \
        _Pragma("unroll") for (int i_ = 0; i_ < 9; ++i_) { const bool ok_ = (i_ > 0) || ((c) > 0) || (w > 0); const bf16* row_ = RW + (m0_ + i_ - 1) * RWC + hj; \
            pr[i_] = ok_ ? row_[0] : (unsigned short)0; pk_[i_] = ok_ ? row_[512] : (unsigned short)0; pv[i_] = ok_ ? row_[1024] : (unsigned short)0; } \
        _Pragma("unroll") for (int i_ = 0; i_ < 8; ++i_) { plw[i_] = LW[(m0_ + i_) * 512 + hj]; pas[i_] = AS[(m0_ + i_) * 512 + hj]; } } while (0)
    RWC_LOAD(c_lo);
    for (int c = c_lo; c < c_hi; ++c) {
        int w = w0, lane = lane0; asm volatile("" : "+s"(w), "+v"(lane));
        const int tn_ = w & 3, tm0_ = 2 * (w >> 2);
        { float run = 0.f;
#pragma unroll
          for (int i = 0; i < 8; ++i) run += bf2f(plw[i]);
          part[w * 64 + lane] = run; }
        __syncthreads();
        float off = 0.f, ctot = 0.f;
#pragma unroll
        for (int o = 0; o < 8; ++o) { const float p = part[o * 64 + lane]; ctot += p; if (o < w) off += p; }
        {   unsigned bh_[4], kh_[4], vt_[4], at_[4]; float cm = off; float* bon_g = BON + ((size_t)bh * 64 + c) * 64;
#pragma unroll
            for (int i = 0; i < 8; ++i) { const int t = 8 * w + i;
                const float p0 = bf2f(pr[i + 1]), p1 = bf2f(pk_[i + 1]), p2 = bf2f(pv[i + 1]);
                const float rv = p0 + (bf2f(pr[i]) - p0) * mu_r, kv = p1 + (bf2f(pk_[i]) - p1) * mu_k, vv = p2 + (bf2f(pv[i]) - p2) * mu_v, asg = bf2f(pas[i]);
                const float ce = cm; cm += bf2f(plw[i]);
                float kkv = kv * kkc; const float n2 = wsum64(kkv * kkv); kkv = kkv * __builtin_amdgcn_rsqf(fmaxf(n2, 1e-24f));
                const float km = kv * (1.f + (asg - 1.f) * kac); const float bn = wsum64(rv * km * rkc); if (lane == 0) bon_g[t] = bn;
                const float av = -kkv, bv = kkv * asg;
                const float e_ce = __expf(ce), e_cm = __expf(cm), e_ncm = __expf(-cm), e_rem = __expf(ctot - cm);
                const unsigned ha = pkbf(av * e_ce, 0.f) & 0xffffu; *(LAS unsigned short*)(bA + moff(t, lane)) = (unsigned short)ha; *(LAS unsigned short*)(bR + moff(t, lane)) = (unsigned short)(pkbf(rv * e_cm, 0.f) & 0xffffu);
                *(LAS unsigned short*)(bB + moff(t, lane)) = (unsigned short)(pkbf(bv * e_ncm, 0.f) & 0xffffu); *(LAS unsigned short*)(bK + moff(t, lane)) = (unsigned short)(pkbf(km * e_ncm, 0.f) & 0xffffu);
                const unsigned hb = pkbf(bv * e_rem, 0.f) & 0xffffu, hk = pkbf(km * e_rem, 0.f) & 0xffffu, hv = pkbf(vv, 0.f) & 0xffffu;
                if (i & 1) { bh_[i >> 1] |= hb << 16; kh_[i >> 1] |= hk << 16; vt_[i >> 1] |= hv << 16; at_[i >> 1] |= ha << 16; } else { bh_[i >> 1] = hb; kh_[i >> 1] = hk; vt_[i >> 1] = hv; at_[i >> 1] = ha; } }
            *(LAS v4u*)(bBH + moff(lane, 8 * w)) = (v4u){bh_[0], bh_[1], bh_[2], bh_[3]};
            *(LAS v4u*)(bKH + moff(lane, 8 * w)) = (v4u){kh_[0], kh_[1], kh_[2], kh_[3]};
            *(LAS v4u*)(bVT + moff(lane, 8 * w)) = (v4u){vt_[0], vt_[1], vt_[2], vt_[3]};
            *(LAS v4u*)(bAT + moff(lane, 8 * w)) = (v4u){at_[0], at_[1], at_[2], at_[3]};
        }
        const float dec0 = __expf(ctot);
        if (c + 1 < c_hi) RWC_LOAD(c + 1);
        __syncthreads();
        {   const int p = w >> 1; const LAS unsigned char* Am = (p < 2) ? bA : bR; const LAS unsigned char* Bm = (p == 0 || p == 2) ? bB : bK;
#pragma unroll
            for (int x = 0; x < 2; ++x) { const int tm = 2 * (w & 1) + x;
#pragma unroll
                for (int tn = 0; tn < 4; ++tn) { f32x4 acc = (f32x4){0.f, 0.f, 0.f, 0.f}; mm(acc, Am, tm, Bm, tn, LO);
                    const int n = 16 * tn + (lane & 15), m0 = 16 * tm + 4 * (lane >> 4);
#pragma unroll
                    for (int r = 0; r < 4; ++r) { const bool keep = (p < 2) ? (n < m0 + r) : (n <= m0 + r); if (!keep) acc[r] = 0.f; }
                    if (p == 0) { st_mn(bQ0, tm, tn, LO, acc); st_nm(bQT0, tm, tn, LO, acc);
#pragma unroll
                        for (int r = 0; r < 4; ++r) if (n == m0 + r) acc[r] += 1.f;
                        st_nm(bT, tm, tn, LO, acc); }
                    else st_mn((p == 1) ? bAak : (p == 2) ? bArb : bArk, tm, tn, LO, acc); } }
        }
        __syncthreads();
#pragma unroll
        for (int x = 0; x < 2; ++x) { const int tm = tm0_ + x; f32x4 acc = (f32x4){0.f, 0.f, 0.f, 0.f}; mm(acc, bQ0, tm, bQT0, tn_, LO); st_mn(bB, tm, tn_, LO, acc); st_nm(bK, tm, tn_, LO, acc); }
        __syncthreads();
#pragma unroll
        for (int s = 2; s <= 5; ++s) {
            const LAS unsigned char* Qc = (s & 1) ? bQ0 : bB; const LAS unsigned char* QTc = (s & 1) ? bQT0 : bK;
            LAS unsigned char* Qn = (s & 1) ? bB : bQ0; LAS unsigned char* QTn = (s & 1) ? bK : bQT0;
            const int tn = w & 3;
            if (w >= 4) { f32x4 acc[4];
#pragma unroll
                for (int tm = 0; tm < 4; ++tm) acc[tm] = ld_nm(bT, tm, tn, LO);
#pragma unroll
                for (int tm = 0; tm < 4; ++tm) mm(acc[tm], Qc, tm, bT, tn, LO);
#pragma unroll
                for (int tm = 0; tm < 4; ++tm) st_nm(bT, tm, tn, LO, acc[tm]);
            } else {
#pragma unroll
                for (int tm = 0; tm < 4; ++tm) { f32x4 acc = (f32x4){0.f, 0.f, 0.f, 0.f}; mm(acc, Qc, tm, QTc, tn, LO); st_mn(Qn, tm, tn, LO, acc); st_nm(QTn, tm, tn, LO, acc); }
            }
            __syncthreads();
        }
        {
#pragma unroll
            for (int x = 0; x < 2; ++x) { const int tm = tm0_ + x; f32x4 acc = ld_nm(bT, tm, tn_, LO); mm(acc, bB, tm, bT, tn_, LO); st_mn(bTF, tm, tn_, LO, acc); }
        }
        LAS unsigned char* bX = bB; LAS unsigned char* bW = bK; LAS unsigned char* bU = bQ0;
        __syncthreads();
#pragma unroll
        for (int x = 0; x < 2; ++x) { const int tm = tm0_ + x;
            { f32x4 acc = (f32x4){0.f, 0.f, 0.f, 0.f}; mm(acc, bAak, tm, bVT, tn_, LO); st_nm(bX, tm, tn_, LO, acc); }
            { f32x4 acc = (f32x4){0.f, 0.f, 0.f, 0.f}; mm(acc, bTF, tm, bAT, tn_, LO); st_nm(bW, tm, tn_, LO, acc); } }
        __syncthreads();
#pragma unroll
        for (int x = 0; x < 2; ++x) { const int tm = tm0_ + x; f32x4 acc = (f32x4){0.f, 0.f, 0.f, 0.f}; mm(acc, bTF, tm, bX, tn_, LO); st_nm(bU, tm, tn_, LO, acc); }
        __syncthreads();
        {   unsigned char* img = IMG + ((size_t)bh * 64 + c) * (4 * MB);
            const int n_ = 16 * tn_ + (lane & 15); const float decn = __shfl(dec0, n_);
#pragma unroll
            for (int x = 0; x < 2; ++x) { const int tm = tm0_ + x; const int m0 = 16 * tm + 4 * (lane >> 4); const int go = moff(n_, m0);
                { f32x4 acc = (f32x4){0.f, 0.f, 0.f, 0.f}; mm(acc, bW, tm, bBH, tn_, LO);
#pragma unroll
                  for (int r = 0; r < 4; ++r) if (m0 + r == n_) acc[r] += decn;
                  *(GAS u32x2*)(img + 0 * MB + go) = (u32x2){pkbf(acc[0], acc[1]), pkbf(acc[2], acc[3])}; }
                { f32x4 acc = (f32x4){0.f, 0.f, 0.f, 0.f}; mm(acc, bBH, tm, bU, tn_, LO); mm(acc, bKH, tm, bVT, tn_, LO);
                  *(GAS u32x2*)(img + 1 * MB + go) = (u32x2){pkbf(acc[0], acc[1]), pkbf(acc[2], acc[3])}; }
                { f32x4 acc = ld_nm(bR, tm, tn_, LO); mm(acc, bW, tm, bArb, tn_, LO);
                  *(GAS u32x2*)(img + 2 * MB + go) = (u32x2){pkbf(acc[0], acc[1]), pkbf(acc[2], acc[3])}; }
                { f32x4 acc = (f32x4){0.f, 0.f, 0.f, 0.f}; mm(acc, bArb, tm, bU, tn_, LO); mm(acc, bArk, tm, bVT, tn_, LO);
                  *(GAS u32x2*)(img + 3 * MB + go) = (u32x2){pkbf(acc[0], acc[1]), pkbf(acc[2], acc[3])}; } }
        }
        __syncthreads();
    }
#undef RWC_LOAD
}

__device__ __forceinline__ void rwkv_seq(Frame& F, const ArgsD& A, const int bh) {
    using namespace rwk;
    const int b = bh >> 3, h = bh & 7, lane0 = lane_id_v(), w0 = F.wave;
    const LaneOff LO = lane_off(lane0);
    LAS unsigned char* L = F.lds + RING_OFF;
    LAS unsigned char* bS0 = L + 8 * MB;
    LAS float* ybuf = (LAS float*)(L + 10 * MB);
    const bf16* RW = (const bf16*)(F.ws + WS_RW); const bf16* G = (const bf16*)(F.ws + WS_G); bf16* YC = (bf16*)(F.ws + WS_YCAT);
    const unsigned char* IMG = F.ws + WS_RIMG + (size_t)bh * 64 * (4 * MB); const float* BON = (const float*)(F.ws + WS_RBON) + (size_t)bh * 64 * 64;
    const float* mu = (const float*)A.in[16]; const float* lnw_g = (const float*)A.in[25]; const float* lnb_g = (const float*)A.in[26];
    const size_t mb = (size_t)b * T;
    const int tid0 = w0 * 64 + lane0, lt0 = tid0 >> 3, hlc0 = h * 64 + (tid0 & 7) * 8;
    for (int i = tid0; i < MB / 16; i += 512) ((LAS v4u*)bS0)[i] = (v4u){0u, 0u, 0u, 0u};
    const f32x4 lw0 = *(const f32x4*)(lnw_g + hlc0), lw1 = *(const f32x4*)(lnw_g + hlc0 + 4), lb0 = *(const f32x4*)(lnb_g + hlc0), lb1 = *(const f32x4*)(lnb_g + hlc0 + 4), mv0 = *(const f32x4*)(mu + 1024 + hlc0), mv1 = *(const f32x4*)(mu + 1024 + hlc0 + 4);
    v4u pf[4][4], lvp[4], lvq[4], lgg[4]; float lbn[4];
#define RWS_LOAD(u, c) do { _Pragma("unroll") for (int k_ = 0; k_ < 4; ++k_) pf[u][k_] = *(const GAS v4u*)(IMG + (size_t)(c) * (4 * MB) + k_ * MB + tid0 * 16); \
        const size_t ml_ = mb + (size_t)(c) * 64 + lt0; lvp[u] = *(const GAS v4u*)(RW + ml_ * RWC + 1024 + hlc0); lvq[u] = *(const GAS v4u*)(RW + (ml_ - (((c) > 0 || lt0 > 0) ? 1 : 0)) * RWC + 1024 + hlc0); \
        lgg[u] = *(const GAS v4u*)(G + ml_ * 512 + hlc0); lbn[u] = BON[(c) * 64 + lt0]; } while (0)
#pragma unroll
    for (int u = 0; u < 4; ++u) RWS_LOAD(u, u);
    int scur = 0;
    for (int c4 = 0; c4 < T / 64; c4 += 4) {
#pragma unroll
      for (int u = 0; u < 4; ++u) { const int c = c4 + u;
        int w = w0, lane = lane0; asm volatile("" : "+s"(w), "+v"(lane));
        const int tid = w * 64 + lane, tn_ = w & 3, tm0_ = 2 * (w >> 2), lt = tid >> 3, lc = (tid & 7) * 8, hlc = h * 64 + lc;
        LAS unsigned char* set = L + (c & 1) * (4 * MB);
#pragma unroll
        for (int k = 0; k < 4; ++k) *(LAS v4u*)(set + k * MB + tid * 16) = pf[u][k];
        const v4u lv_p = lvp[u], lv_q = (c > 0 || lt > 0) ? lvq[u] : (v4u){0u, 0u, 0u, 0u}; const f32x4 lg0 = (f32x4){bflo(lgg[u].x), bfhi(lgg[u].x), bflo(lgg[u].y), bfhi(lgg[u].y)}, lg1 = (f32x4){bflo(lgg[u].z), bfhi(lgg[u].z), bflo(lgg[u].w), bfhi(lgg[u].w)}; const float bn = lbn[u];
        __syncthreads();
        if (c + 4 < T / 64) RWS_LOAD(u, c + 4);
        const LAS unsigned char* Sc = bS0 + scur * MB; LAS unsigned char* Sn = bS0 + (scur ^ 1) * MB;
#pragma unroll
        for (int x = 0; x < 2; ++x) { const int tm = tm0_ + x;
            { f32x4 acc = ld_nm(set + 1 * MB, tm, tn_, LO); mm(acc, set + 0 * MB, tm, Sc, tn_, LO); st_nm(Sn, tm, tn_, LO, acc); }
            { f32x4 acc = ld_nm(set + 3 * MB, tm, tn_, LO); mm(acc, set + 2 * MB, tm, Sc, tn_, LO);
              const int i = 16 * tn_ + (lane & 15), t0 = 16 * tm + 4 * (lane >> 4);
#pragma unroll
              for (int r = 0; r < 4; ++r) ybuf[(t0 + r) * 64 + i] = acc[r]; } }
        scur ^= 1;
        __syncthreads();
        {   const f32x4 y0 = *(const LAS f32x4*)(ybuf + lt * 64 + lc), y1 = *(const LAS f32x4*)(ybuf + lt * 64 + lc + 4);
            const float mean = sum8((y0.x + y0.y) + (y0.z + y0.w) + (y1.x + y1.y) + (y1.z + y1.w)) * (1.f / 64.f); const f32x4 d0 = y0 - mean, d1 = y1 - mean;
            const float var = sum8((d0.x * d0.x + d0.y * d0.y) + (d0.z * d0.z + d0.w * d0.w) + (d1.x * d1.x + d1.y * d1.y) + (d1.z * d1.z + d1.w * d1.w)) * (1.f / 64.f); const float rs = __builtin_amdgcn_rsqf(var + 64e-5f);
            f32x4 va = (f32x4){bflo(lv_p.x), bfhi(lv_p.x), bflo(lv_p.y), bfhi(lv_p.y)}, vb = (f32x4){bflo(lv_p.z), bfhi(lv_p.z), bflo(lv_p.w), bfhi(lv_p.w)};
            { const f32x4 qa = (f32x4){bflo(lv_q.x), bfhi(lv_q.x), bflo(lv_q.y), bfhi(lv_q.y)}, qb = (f32x4){bflo(lv_q.z), bfhi(lv_q.z), bflo(lv_q.w), bfhi(lv_q.w)}; va = va + (qa - va) * mv0; vb = vb + (qb - vb) * mv1; }
            const f32x4 o0 = ((d0 * rs) * lw0 + lb0 + va * bn) * lg0, o1 = ((d1 * rs) * lw1 + lb1 + vb * bn) * lg1;
            *(GAS v4u*)(YC + (mb + (size_t)c * 64 + lt) * 1024 + 512 + hlc) = (v4u){pkbf(o0.x, o0.y), pkbf(o0.z, o0.w), pkbf(o1.x, o1.y), pkbf(o1.z, o1.w)};
        }
      }
    }
#undef RWS_LOAD
}

__device__ __forceinline__ void p6_dacombine(Frame& F, const ArgsD& A) {
    const int lane = lane_id_v(), tid = F.wave * 64 + lane; (void)tid;
    const float* q1 = (const float*)A.in[11]; const float* k1 = (const float*)A.in[12]; const float* q2 = (const float*)A.in[13]; const float* k2 = (const float*)A.in[14];
    const float lam = __expf(wave_sum(q1[lane] * k1[lane])) - __expf(wave_sum(q2[lane] * k2[lane])) + 0.2f;
    const bf16* O = (const bf16*)(F.ws + WS_O); bf16* YC = (bf16*)(F.ws + WS_YCAT);
    const int gw = F.vcu * NWAVES + F.wave, NGW = F.G * NWAVES, dh = lane >> 4, d0 = 8 * (lane & 15);
    const float* sw = (const float*)A.in[15] + d0; const f32x4 swa = *(const f32x4*)sw * 0.8f, swb = *(const f32x4*)(sw + 4) * 0.8f;
    for (int m = gw; m < M; m += NGW) {
        const v4u a = *(const GAS v4u*)(O + (size_t)m * 1024 + dh * 256 + d0), c = *(const GAS v4u*)(O + (size_t)m * 1024 + dh * 256 + 128 + d0);
        f32x4 y0 = (f32x4){bflo(a.x) - lam * bflo(c.x), bfhi(a.x) - lam * bfhi(c.x), bflo(a.y) - lam * bflo(c.y), bfhi(a.y) - lam * bfhi(c.y)};
        f32x4 y1 = (f32x4){bflo(a.z) - lam * bflo(c.z), bfhi(a.z) - lam * bfhi(c.z), bflo(a.w) - lam * bflo(c.w), bfhi(a.w) - lam * bfhi(c.w)};
        float s2 = (y0.x * y0.x + y0.y * y0.y) + (y0.z * y0.z + y0.w * y0.w) + (y1.x * y1.x + y1.y * y1.y) + (y1.z * y1.z + y1.w * y1.w);
        s2 = allsum16(s2); const float rs = 1.f / sqrtf(s2 * (1.f / 128.f) + 1e-5f);
        y0 = y0 * rs * swa; y1 = y1 * rs * swb;
        *(GAS v4u*)(YC + (size_t)m * 1024 + dh * 128 + d0) = (v4u){pkbf(y0.x, y0.y), pkbf(y0.z, y0.w), pkbf(y1.x, y1.y), pkbf(y1.z, y1.w)}; }
}

#define P9_SWAP32(a, b) do { const auto r_ = __builtin_amdgcn_permlane32_swap(__float_as_uint(a), __float_as_uint(b), false, false); (a) = __uint_as_float(r_[0]) + __uint_as_float(r_[1]); } while (0)
#define P9_SWAP16(a, b) do { const auto r_ = __builtin_amdgcn_permlane16_swap(__float_as_uint(a), __float_as_uint(b), false, false); (a) = __uint_as_float(r_[0]) + __uint_as_float(r_[1]); } while (0)
#define P9_DPPF(x, ctrl) __builtin_bit_cast(float, __builtin_amdgcn_update_dpp(0, __builtin_bit_cast(int, (x)), (ctrl), 0xF, 0xF, true))
#define P9_DPPU(x, ctrl) ((unsigned)__builtin_amdgcn_update_dpp(0, (int)(x), (ctrl), 0xF, 0xF, true))
__device__ __forceinline__ float p9_reduce32(float (&a)[32], const int lane) {
#pragma unroll
    for (int e = 0; e < 16; ++e) P9_SWAP32(a[e], a[e + 16]);
#pragma unroll
    for (int e = 0; e < 8; ++e) P9_SWAP16(a[e], a[e + 8]);
    const bool b3 = (lane & 8) != 0, b2 = (lane & 4) != 0, b0 = (lane & 1) != 0;
#pragma unroll
    for (int e = 0; e < 4; ++e) { const float keep = b3 ? a[e + 4] : a[e], send = b3 ? a[e] : a[e + 4]; a[e] = keep + P9_DPPF(send, 0x128); }
#pragma unroll
    for (int e = 0; e < 2; ++e) { const float keep = b2 ? a[e + 2] : a[e], send = b2 ? a[e] : a[e + 2]; a[e] = keep + P9_DPPF(send, 0x141); }
    { const float keep = b0 ? a[1] : a[0], send = b0 ? a[0] : a[1]; a[0] = keep + P9_DPPF(send, 0xB1); }
    return a[0] + P9_DPPF(a[0], 0x4E);
}
__device__ __forceinline__ unsigned p9_wmax(unsigned v) {
    v = max(v, P9_DPPU(v, 0xB1)); v = max(v, P9_DPPU(v, 0x4E)); v = max(v, P9_DPPU(v, 0x124)); v = max(v, P9_DPPU(v, 0x128));
    const unsigned s0 = __builtin_amdgcn_readlane(v, 0), s1 = __builtin_amdgcn_readlane(v, 16), s2 = __builtin_amdgcn_readlane(v, 32), s3 = __builtin_amdgcn_readlane(v, 48);
    return max(max(s0, s1), max(s2, s3)); }
__device__ __forceinline__ void p8_postmix_router(Frame& F, const ArgsD& A, const int cset) {
    const int lane = lane_id_v(), tid = F.wave * 64 + lane; (void)tid;
    LAS float* rw = (LAS float*)(F.lds + RING_OFF);
    volatile LAS int* lcnt = (volatile LAS int*)(F.lds + LDSCTL_OFF);
    { const float* r = (const float*)A.in[27]; for (int i = tid; i < 1024 * 32; i += 512) { const int k = i >> 5, e = i & 31; rw[e * 1024 + k] = r[i]; } }
    if (tid < 32) lcnt[tid] = 0;
    __syncthreads();
    const float* x = (const float*)A.in[0]; const bf16* Y = (const bf16*)(F.ws + WS_Y); const float* mod = (const float*)(F.ws + WS_MOD);
    const float* pmn = (const float*)A.in[6]; const float* pfn = (const float*)A.in[7]; const float* rb = (const float*)A.in[28];
    unsigned char* H2 = F.ws + WS_H2; int* tokE = (int*)(F.ws + WS_TOKE); float* tokG = (float*)(F.ws + WS_TOKG);
    const int rows_per = M / F.G, mbeg = F.vcu * rows_per, b = mbeg >> 12; const float* mb_ = mod + (size_t)b * NMOD;
    f32x4 a1[4], a2[4], sh[4];
#pragma unroll
    for (int j = 0; j < 4; ++j) { const int col = 4 * lane + 256 * j; a1[j] = *(const f32x4*)(pmn + col) * *(const f32x4*)(mb_ + 2048 + col); a2[j] = *(const f32x4*)(pfn + col) * (*(const f32x4*)(mb_ + 4096 + col) + 1.f); sh[j] = *(const f32x4*)(mb_ + 3072 + col); }
    const int myexp = 8 * (lane >> 4) + 4 * ((lane >> 3) & 1) + 2 * ((lane >> 2) & 1) + (lane & 1); const float rbias = rb[myexp];
    const int nr = rows_per / NWAVES, m0 = mbeg + F.wave * nr;
    u32x2 yp[2][4]; f32x4 xp[2][4];
#define P9_LOAD(m_) do { _Pragma("unroll") for (int t_ = 0; t_ < 2; ++t_) _Pragma("unroll") for (int j_ = 0; j_ < 4; ++j_) { \
        yp[t_][j_] = *((const GAS u32x2*)(Y + (size_t)((m_) + t_) * D) + lane + 64 * j_); xp[t_][j_] = *((const GAS f32x4*)(x + (size_t)((m_) + t_) * D) + lane + 64 * j_); } } while (0)
    P9_LOAD(m0);
    for (int i = 0; i < nr; i += 2) { const int m = m0 + i;
        f32x4 xv[2][4];
#pragma unroll
        for (int t = 0; t < 2; ++t) { f32x4 yv[4]; float s2 = 0.f;
#pragma unroll
            for (int j = 0; j < 4; ++j) { const u32x2 p = yp[t][j]; yv[j] = (f32x4){bflo(p.x), bfhi(p.x), bflo(p.y), bfhi(p.y)}; s2 += (yv[j].x * yv[j].x + yv[j].y * yv[j].y) + (yv[j].z * yv[j].z + yv[j].w * yv[j].w); }
            const float rs = __builtin_amdgcn_rsqf(wave_sum(s2) * (1.f / D) + 1e-6f); float t2 = 0.f;
#pragma unroll
            for (int j = 0; j < 4; ++j) { xv[t][j] = xp[t][j] + a1[j] * (yv[j] * rs); *((GAS f32x4*)(F.out + (size_t)(m + t) * D) + lane + 64 * j) = xv[t][j];
                t2 += (xv[t][j].x * xv[t][j].x + xv[t][j].y * xv[t][j].y) + (xv[t][j].z * xv[t][j].z + xv[t][j].w * xv[t][j].w); }
            const float rs2 = __builtin_amdgcn_rsqf(wave_sum(t2) * (1.f / D) + 1e-6f);
#pragma unroll
            for (int j = 0; j < 4; ++j) { xv[t][j] = xv[t][j] * rs2 * a2[j] + sh[j]; *((GAS unsigned*)(H2 + (size_t)(m + t) * D) + lane + 64 * j) = pg8::pk4_fp8(xv[t][j].x, xv[t][j].y, xv[t][j].z, xv[t][j].w); } }
        if (i + 2 < nr) P9_LOAD(m + 2);
        float ac0[32], ac1[32];
#pragma unroll
        for (int e = 0; e < 32; ++e) { float s0 = 0.f, s1 = 0.f;
#pragma unroll
            for (int j = 0; j < 4; ++j) { const f32x4 w = *(const LAS f32x4*)(rw + e * 1024 + 4 * lane + 256 * j);
                s0 += (xv[0][j].x * w.x + xv[0][j].y * w.y) + (xv[0][j].z * w.z + xv[0][j].w * w.w); s1 += (xv[1][j].x * w.x + xv[1][j].y * w.y) + (xv[1][j].z * w.z + xv[1][j].w * w.w); }
            ac0[e] = s0; ac1[e] = s1; }
        const float lg[2] = {p9_reduce32(ac0, lane) + rbias, p9_reduce32(ac1, lane) + rbias};
#pragma unroll
        for (int t = 0; t < 2; ++t) { const unsigned u = __float_as_uint(lg[t]); unsigned key = (((u >> 31) ? ~u : (u | 0x80000000u)) & ~31u) | (unsigned)(31 - myexp);
            float tv[4]; int ti[4];
#pragma unroll
            for (int k = 0; k < 4; ++k) { const unsigned mx = p9_wmax(key); ti[k] = 31 - (int)(mx & 31u); const unsigned kv = mx & ~31u; tv[k] = __uint_as_float((kv >> 31) ? (kv & 0x7fffffffu) : ~kv); if (key == mx) key = 0u; }
            float ew[4], es = 0.f;
#pragma unroll
            for (int k = 0; k < 4; ++k) { ew[k] = __expf(tv[k] - tv[0]); es += ew[k]; }
            if (lane < 4) { const int e = (lane == 0) ? ti[0] : (lane == 1) ? ti[1] : (lane == 2) ? ti[2] : ti[3]; const float g = ((lane == 0) ? ew[0] : (lane == 1) ? ew[1] : (lane == 2) ? ew[2] : ew[3]) / es;
                const int pos = __hip_atomic_fetch_add((LAS int*)lcnt + e, 1, __ATOMIC_RELAXED, __HIP_MEMORY_SCOPE_WORKGROUP);
                tokE[(size_t)(m + t) * 4 + lane] = e | (pos << 8); tokG[(size_t)(m + t) * 4 + lane] = g; } }
    }
#undef P9_LOAD
    __syncthreads();
    if (tid < 32) { const int n = lcnt[tid]; int base = 0; if (n > 0) base = (int)__hip_atomic_fetch_add(F.ctl + CW_ECNT + cset * 64 * NEXP + 64 * tid, (unsigned)n, __ATOMIC_RELAXED, __HIP_MEMORY_SCOPE_AGENT);
        ((int*)(F.ws + WS_BLKBASE))[F.vcu * 32 + tid] = base; }
}

__device__ __forceinline__ void moe_tables(Frame& F) {
    const int lane = lane_id_v(), tid = F.wave * 64 + lane; (void)tid;
    volatile LAS int* ts = (volatile LAS int*)(F.lds + LDSCTL_OFF);
    if (tid < 32) ts[40 + tid] = (int)__hip_atomic_load(F.ctl + CW_ECNT + 64 * tid, __ATOMIC_RELAXED, __HIP_MEMORY_SCOPE_AGENT);
    __syncthreads();
    if (tid == 0) { int acc = 0; for (int e = 0; e < 32; ++e) { ts[e] = acc; acc += (ts[40 + e] + 255) >> 8; } ts[32] = acc; }
    __syncthreads();
}
__device__ __forceinline__ void p9_rows(Frame& F) {
    const int lane = lane_id_v(), tid = F.wave * 64 + lane; (void)tid;
    moe_tables(F);
    volatile LAS int* ts = (volatile LAS int*)(F.lds + LDSCTL_OFF);
    const int* tokE = (const int*)(F.ws + WS_TOKE); const float* tokG = (const float*)(F.ws + WS_TOKG); const int* blkbase = (const int*)(F.ws + WS_BLKBASE) + F.vcu * 32;
    int* tokrow = (int*)(F.ws + WS_TOKROW); int* rowtok = (int*)(F.ws + WS_ROWTOK); float* rowgate = (float*)(F.ws + WS_ROWGATE);
    const int rows_per = M / F.G, mbeg = F.vcu * rows_per;
    for (int i = tid; i < rows_per * 4; i += 512) { const int idx = mbeg * 4 + i; const int pe = tokE[idx], e = pe & 255, pos = pe >> 8; const int row = ts[e] * 256 + blkbase[e] + pos;
        tokrow[idx] = row; rowtok[row] = idx >> 2; rowgate[row] = tokG[idx]; }
    for (int e = F.vcu; e < 32; e += F.G) { const int n = ts[40 + e]; const int r0 = ts[e] * 256 + n, r1 = ts[e + 1] * 256;
        for (int r = r0 + tid; r < r1; r += 512) { rowtok[r] = 0; rowgate[r] = 0.f; } }
}

__device__ __forceinline__ void p12_final(Frame& F, const ArgsD& A, float* dst) {
    const int lane = lane_id_v(), tid = F.wave * 64 + lane; (void)tid;
    const unsigned char* Y2 = F.ws + WS_Y2; const int* tokrow = (const int*)(F.ws + WS_TOKROW); const float* mod = (const float*)(F.ws + WS_MOD); const float* pn = (const float*)A.in[8];
    const int rows_per = M / F.G, mbeg = F.vcu * rows_per, b = mbeg >> 12, nr = rows_per / NWAVES, m0 = mbeg + F.wave * nr;
    const float* mb_ = mod + (size_t)b * NMOD + 5120;
    f32x4 gw[4];
#pragma unroll
    for (int j = 0; j < 4; ++j) { const int col = 4 * lane + 256 * j; gw[j] = *(const f32x4*)(pn + col) * *(const f32x4*)(mb_ + col); }
    const int myrow = tokrow[(size_t)m0 * 4 + (lane < nr * 4 ? lane : 0)];
    unsigned yp[4][4]; f32x4 xp[4];
#define P13_LOAD(i_) do { _Pragma("unroll") for (int k_ = 0; k_ < 4; ++k_) { const int row_ = __builtin_amdgcn_readlane(myrow, 4 * (i_) + k_); \
        _Pragma("unroll") for (int j_ = 0; j_ < 4; ++j_) yp[k_][j_] = *((const GAS unsigned*)(Y2 + (size_t)row_ * D) + lane + 64 * j_); } \
        _Pragma("unroll") for (int j_ = 0; j_ < 4; ++j_) xp[j_] = *((const GAS f32x4*)(F.out + (size_t)(m0 + (i_)) * D) + lane + 64 * j_); } while (0)
    P13_LOAD(0);
#pragma unroll 1
    for (int i = 0; i < nr; ++i) { const int m = m0 + i;
        f32x4 a[4], xv[4]; float s2 = 0.f;
#pragma unroll
        for (int j = 0; j < 4; ++j) { a[j] = (f32x4){0.f, 0.f, 0.f, 0.f};
#pragma unroll
            for (int k = 0; k < 4; ++k) { const unsigned p = yp[k][j]; const f32x2 lo = __builtin_amdgcn_cvt_pk_f32_fp8((int)p, false), hi = __builtin_amdgcn_cvt_pk_f32_fp8((int)p, true); a[j] = a[j] + (f32x4){lo.x, lo.y, hi.x, hi.y}; }
            a[j] = a[j] * pg8::Y8_INV;
            s2 += (a[j].x * a[j].x + a[j].y * a[j].y) + (a[j].z * a[j].z + a[j].w * a[j].w); xv[j] = xp[j]; }
        if (i + 1 < nr) { const int in_ = __builtin_amdgcn_readfirstlane(i + 1);
#pragma unroll
            for (int k_ = 0; k_ < 4; ++k_) { const int row_ = __shfl(myrow, 4 * in_ + k_);
#pragma unroll
                for (int j_ = 0; j_ < 4; ++j_) yp[k_][j_] = *((const GAS unsigned*)(Y2 + (size_t)row_ * D) + lane + 64 * j_); }
#pragma unroll
            for (int j_ = 0; j_ < 4; ++j_) xp[j_] = *((const GAS f32x4*)(F.out + (size_t)(m + 1) * D) + lane + 64 * j_); }
        const float rs = __builtin_amdgcn_rsqf(wave_sum(s2) * (1.f / D) + 1e-6f);
#pragma unroll
        for (int j = 0; j < 4; ++j) *((GAS f32x4*)(dst + (size_t)m * D) + lane + 64 * j) = xv[j] + gw[j] * (a[j] * rs); }
#undef P13_LOAD
}
__global__ void __launch_bounds__(NWAVES * 64, 2) hybrid_fwd(Args kargs) {
    const ArgsD args{};
    extern __shared__ __attribute__((aligned(16))) unsigned char lds[];
    Frame F;
    F.lds = (LAS unsigned char*)lds;
    F.MISC = (volatile LAS unsigned*)(F.lds + MISC_OFF);
    F.wave = __builtin_amdgcn_readfirstlane((int)threadIdx.x >> 6);
    F.G = gridDim.x; { const int bx = blockIdx.x; F.vcu = (F.G % 8 == 0) ? (bx % 8) * (F.G / 8) + bx / 8 : bx; }
    F.ws = kargs.ws; F.out = kargs.out;
    unsigned char* ws = kargs.ws;
    F.ctl = (gu32*)(ws + WS_CTL);
#define GRID_BAR(seam) do { if (N_LAUNCHES != 1) { if (F.wave == 0 && lane_id_v() == 0) __hip_atomic_store(F.ctl + CW_TMO, 0xBADBA0u | (unsigned)(seam), RLX_AGENT); } else { xcd_barrier(bar); } } while (0)
    for (int u = threadIdx.x; u < (LDS_BYTES - LDSCTL_OFF) / 4; u += NWAVES * 64) ((LAS unsigned*)(F.lds + LDSCTL_OFF))[u] = 0u;
    __syncthreads();
    XcdBarrier bar; bar.bar = (unsigned*)(F.ctl + CW_BAR); bar.x = 0; bar.st = nullptr; bar.wid = F.wave;
    if (N_LAUNCHES == 1) bar = xcd_barrier_post((unsigned*)(F.ctl + CW_BAR), F.MISC + 8, F.wave);
    const int lo = kargs.ph_lo, hi = kargs.ph_hi;
#define IN(k) (lo <= (k) && (k) < hi)
#define PREP(k) (((PROBE_MASK) >> (k)) & 1)
#define BOTH(k) (IN(k) && IN((k) + 1))
    bf16* const H = (bf16*)(ws + WS_H); bf16* const H2 = (bf16*)(ws + WS_H2);

    if (IN(0)) { _Pragma("unroll 1") for (int r_ = 0; r_ <= PREP(0); ++r_) { p0_prologue(F, args); } if (BOTH(0)) GRID_BAR(0); }
    if (IN(1)) { _Pragma("unroll 1") for (int r_ = 0; r_ <= PREP(1); ++r_) { p1_premix(F, args); } if (BOTH(1)) GRID_BAR(1); }
    if (IN(2)) {
        pg8::Gemm g{H, (const bf16*)(ws + WS_WIN), M, IN_COLS, D, 0, nullptr, ws}; pg8::StaticOrder S; S.init(M, IN_COLS, F.G, (int)blockIdx.x);
        pg8::EpiProj E{(bf16*)(ws + WS_Q), (bf16*)(ws + WS_K), (bf16*)(ws + WS_V), (bf16*)(ws + WS_RW), (const float*)(ws + WS_ROPE), attn_body::C2};
        if (PREP(2)) { pg8::gemm_phase<pg8::EpiProj, pg8::StaticOrder, true, true, false>(F.lds + RING_OFF, g, S, E, F.wave); GRID_BAR(102); }
        pg8::gemm_phase<pg8::EpiProj, pg8::StaticOrder, true, true, false>(F.lds + RING_OFF, g, S, E, F.wave);
        if (BOTH(2)) GRID_BAR(2);
    }
    if (IN(3)) { _Pragma("unroll 1") for (int r_ = 0; r_ <= PREP(3); ++r_) { p3_lact(F, args); } if (BOTH(3)) GRID_BAR(3); }
    if (IN(4)) {
        pg8::Gemm g{(const bf16*)(ws + WS_LACT), (const bf16*)(ws + WS_BLORA), M, 1536, 256, 0, nullptr, ws}; pg8::StaticOrder S; S.init(M, 1536, F.G, (int)blockIdx.x);
        pg8::EpiLora E{(bf16*)(ws + WS_LW), (size_t)(WS_AS - WS_LW) / 2, (const float*)args.in[17], (const float*)args.in[19]}; static_assert(WS_G - WS_AS == WS_AS - WS_LW, "LW | AS | G equally spaced");
        if (PREP(4)) { pg8::gemm_phase<pg8::EpiLora, pg8::StaticOrder, true, true, false>(F.lds + RING_OFF, g, S, E, F.wave); GRID_BAR(104); }
        pg8::gemm_phase<pg8::EpiLora, pg8::StaticOrder, true, true, false>(F.lds + RING_OFF, g, S, E, F.wave);
        if (BOTH(4)) GRID_BAR(4);
    }
    if (IN(5)) {
        _Pragma("unroll 1") for (int r_ = 0; r_ <= PREP(5); ++r_)
            for (int u = F.vcu; u < BATCH * 8 * 4; u += F.G) rwkv_pre(F, args, u >> 2, (u & 3) * 16, (u & 3) * 16 + 16);
        if (BOTH(5)) GRID_BAR(5);
    }
    if (IN(6)) {
        _Pragma("unroll 1") for (int r_ = 0; r_ <= PREP(14); ++r_)
            for (int bh = blockIdx.x; bh < BATCH * 8; bh += F.G) rwkv_seq(F, args, bh);
        static_assert(attn_body::ATTN_LDS_BYTES <= RING_BYTES, "attention body geometry vs frame");
        const attn_body::AttnTensors AT{(const attn_body::bf16*)(ws + WS_Q), (const attn_body::bf16*)(ws + WS_K), (const attn_body::bf16*)(ws + WS_V), (attn_body::bf16*)(ws + WS_O)};
        if (PREP(15)) { const attn_body::QueueOrder S0{(unsigned*)(F.ctl + CW_ATTQ + 64), F.MISC + 12, F.wave}; attn_body::attn_phase<attn_body::QueueOrder>((char*)lds + RING_OFF, AT, S0, F.wave); GRID_BAR(106); }
        const attn_body::QueueOrder S{(unsigned*)(F.ctl + CW_ATTQ), F.MISC + 12, F.wave};
        attn_body::attn_phase<attn_body::QueueOrder>((char*)lds + RING_OFF, AT, S, F.wave);
        if (BOTH(6)) GRID_BAR(6);
    }
    if (IN(7)) { _Pragma("unroll 1") for (int r_ = 0; r_ <= PREP(7); ++r_) { p6_dacombine(F, args); } if (BOTH(7)) GRID_BAR(7); }
    if (IN(8)) {
        pg8::Gemm g{(const bf16*)(ws + WS_YCAT), (const bf16*)(ws + WS_WOUT), M, D, D, 0, nullptr, ws}; pg8::StaticOrder S; S.init(M, D, F.G, (int)blockIdx.x);
        pg8::EpiPlain E{(bf16*)(ws + WS_Y), D};
        if (PREP(8)) { pg8::gemm_phase<pg8::EpiPlain, pg8::StaticOrder, true, true, false>(F.lds + RING_OFF, g, S, E, F.wave); GRID_BAR(108); }
        pg8::gemm_phase<pg8::EpiPlain, pg8::StaticOrder, true, true, false>(F.lds + RING_OFF, g, S, E, F.wave);
        if (BOTH(8)) GRID_BAR(8);
    }
    if (IN(9)) { _Pragma("unroll 1") for (int r_ = PREP(9); r_ >= 0; --r_) { p8_postmix_router(F, args, r_); } if (BOTH(9)) GRID_BAR(9); }
    if (IN(10)) { _Pragma("unroll 1") for (int r_ = 0; r_ <= PREP(10); ++r_) { p9_rows(F); } if (BOTH(10)) GRID_BAR(10); }
    if (IN(11)) {
        moe_tables(F);
        const LAS int* ts = (const LAS int*)(F.lds + LDSCTL_OFF);
        pg8::Gemm g{H2, (const bf16*)(ws + WS_W1), MAXROWS, 2048, D / 2, (size_t)2048 * D, (const int*)(ws + WS_ROWTOK), ws};
        pg8::MoeOrder S{__builtin_amdgcn_readfirstlane(ts[32]), 8, 4, F.G, F.vcu, ts};
        pg8::EpiSwiglu E{ws + WS_ACT, (const float*)args.in[30]};
        if (PREP(11)) { pg8::gemm_phase<pg8::EpiSwiglu, pg8::MoeOrder, true, true, true, true>(F.lds + RING_OFF, g, S, E, F.wave); GRID_BAR(111); }
        pg8::gemm_phase<pg8::EpiSwiglu, pg8::MoeOrder, true, true, true, true>(F.lds + RING_OFF, g, S, E, F.wave);
        if (BOTH(11)) GRID_BAR(11);
    }
    if (IN(12)) {
        moe_tables(F);
        const LAS int* ts = (const LAS int*)(F.lds + LDSCTL_OFF);
        pg8::Gemm g{(const bf16*)(ws + WS_ACT), (const bf16*)(ws + WS_W2), MAXROWS, D, D / 2, (size_t)D * D, nullptr, ws};
        pg8::MoeOrder S{__builtin_amdgcn_readfirstlane(ts[32]), 4, 8, F.G, F.vcu, ts};
        pg8::EpiMoe2 E{ws + WS_Y2, (const float*)args.in[32], (const float*)(ws + WS_ROWGATE)};
        if (PREP(12)) { pg8::gemm_phase<pg8::EpiMoe2, pg8::MoeOrder, true, true, false, true>(F.lds + RING_OFF, g, S, E, F.wave); GRID_BAR(112); }
        pg8::gemm_phase<pg8::EpiMoe2, pg8::MoeOrder, true, true, false, true>(F.lds + RING_OFF, g, S, E, F.wave);
        if (BOTH(12)) GRID_BAR(12);
    }
    if (IN(13)) { _Pragma("unroll 1") for (int r_ = PREP(13); r_ >= 0; --r_) { p12_final(F, args, r_ ? (float*)(ws + WS_G) : F.out); } }
#undef IN
#undef PREP
#undef BOTH
}

extern "C" void kernel_launch(void* const* d_in, const int* in_sizes, int n_in, void* d_out, int out_size, void* d_ws, size_t ws_size, hipStream_t stream) {
    static int grid = 0;
    if (grid == 0) {
        if (n_in != 33 || in_sizes[0] != M * D || out_size != M * D || ws_size < WS_END) { fprintf(stderr, "kernel_launch: built for 33 inputs, x and out of %d floats, >= %zu bytes of workspace; got n_in %d, in0 %d, out %d, ws %zu; nothing launched\n", M * D, (size_t)WS_END, n_in, n_in > 0 ? in_sizes[0] : -1, out_size, ws_size); grid = -1; return; }
        int dev = 0, cus = 0, per_cu = 0;
        if (hipGetDevice(&dev) != hipSuccess || hipDeviceGetAttribute(&cus, hipDeviceAttributeMultiprocessorCount, dev) != hipSuccess) { fprintf(stderr, "kernel_launch: hipGetDevice / hipDeviceGetAttribute failed; nothing launched\n"); grid = -1; return; }
        if (hipFuncSetAttribute((const void*)hybrid_fwd, hipFuncAttributeMaxDynamicSharedMemorySize, LDS_BYTES) != hipSuccess) { fprintf(stderr, "kernel_launch: hipFuncSetAttribute failed; nothing launched\n"); grid = -1; return; }
        if (hipOccupancyMaxActiveBlocksPerMultiprocessor(&per_cu, (const void*)hybrid_fwd, NWAVES * 64, LDS_BYTES) != hipSuccess || per_cu < 1)
            fprintf(stderr, "kernel_launch: note: the occupancy query reports %d workgroups per CU\n", per_cu);
        (void)hipGetLastError();
        grid = (cus >= 256) ? 256 : (cus / 32) * 32;
        if (grid != 256) fprintf(stderr, "kernel_launch: launching %d workgroups (built and checked for 256)\n", grid);
    }
    if (grid <= 0) return;
    if (hipMemsetAsync((char*)d_ws + WS_CTL, 0, CTL_ZERO_BYTES, stream) != hipSuccess) { fprintf(stderr, "kernel_launch: hipMemsetAsync of the control words failed; nothing launched\n"); return; }
    Args a{};
    for (int i = 0; i < 33; ++i) a.in[i] = d_in[i];
    a.out = (float*)d_out; a.ws = (unsigned char*)d_ws;
    for (int li = 0; li < N_LAUNCHES; ++li) {
        a.ph_lo = (N_LAUNCHES == 1) ? 0 : li; a.ph_hi = (N_LAUNCHES == 1) ? N_PHASES : li + 1; a.li = li; a.pad = 0;
        hipLaunchKernelGGL(hybrid_fwd, dim3(grid), dim3(NWAVES * 64), LDS_BYTES, stream, a);
        const hipError_t le = hipPeekAtLastError();
        if (le != hipSuccess) { fprintf(stderr, "kernel_launch: launch %d failed: %s\n", li, hipGetErrorName(le)); break; }
    }
}
```

```cpp
#include <hip/hip_runtime.h>
#include <cstdio>
#include <cstdint>
__device__ __forceinline__ int lane_id_v() { int l; asm volatile("v_mbcnt_lo_u32_b32 %0, -1, 0\n\tv_mbcnt_hi_u32_b32 %0, -1, %0" : "=v"(l)); return l; }
namespace pg8 {
#define PG8_LAS __attribute__((address_space(3)))
typedef unsigned short bf16_t;
typedef short bf16x8 __attribute__((ext_vector_type(8)));
typedef float f32x4 __attribute__((ext_vector_type(4)));
typedef unsigned u32x4 __attribute__((ext_vector_type(4)));
typedef int v4i_t __attribute__((ext_vector_type(4)));
typedef int v8i_t __attribute__((ext_vector_type(8)));
typedef v8i_t v8i_a16 __attribute__((aligned(16)));
union frag2_t { bf16x8 pc[2]; v8i_t w; };
constexpr int BM = 256, BK = 64, HALF = 128, HTB = HALF * BK * 2  , STAGE_BYTES = 8 * HTB, NXCD = 8, WGM = 8;

__host__ __device__ __forceinline__ int lds_byte(int r, int c) { const int st = (r >> 4) * 2 + (c >> 5), rr = r & 15, cc = c & 31, ob = rr * 64 + cc * 2; return st * 1024 + (ob ^ (((ob >> 9) & 1) << 5)); }
__host__ __device__ __forceinline__ void stage_rc(int b, int& R, int& C) { const int st = b / 1024, sb = b % 1024, swz = sb ^ (((sb >> 9) & 1) << 5); R = (st >> 1) * 16 + swz / 64; C = (st & 1) * 32 + (swz % 64) / 2; }
__host__ __device__ __forceinline__ int perm32(int rho) { const int n = rho >> 4, i = rho & 15; return 8 * (i >> 2) + 4 * n + (i & 3); }

struct Unit { int pm, pn, e; };
struct Gemm { const bf16_t* A; const bf16_t* Bt; int M, N, K; size_t bstride; const int* rowidx; const void* base; };

struct StaticOrder {
    int nM, nN, nwg, G, c;
    __host__ __device__ void init(int M, int N, int G_, int c_) { nM = M / BM; nN = N / BM; nwg = nM * nN; G = G_; c = c_; }
    __host__ __device__ bool next(int i, Unit& u) const {
        const long L = (long)i * G + c; if (L >= nwg) return false;
        int wgid = (int)L; { const int q = nwg / NXCD, r = nwg % NXCD, xcd = wgid % NXCD, off = wgid / NXCD; wgid = (xcd < r ? xcd * (q + 1) : r * (q + 1) + (xcd - r) * q) + off; }
        const int nig = WGM * nN, gid = wgid / nig, fm = gid * WGM, gsz = (nM - fm) < WGM ? (nM - fm) : WGM;
        u.pm = fm + ((wgid % nig) % gsz); u.pn = (wgid % nig) / gsz; u.e = 0; return true;
    }
    __device__ __forceinline__ void a_ready(const Unit&) const {}
    __device__ __forceinline__ void done(const Unit&) const {}
};

__device__ __forceinline__ unsigned cvt_pk_bf16(float lo, float hi) { unsigned r; asm volatile("v_cvt_pk_bf16_f32 %0, %1, %2" : "=v"(r) : "v"(lo), "v"(hi)); return r; }
typedef float f32x2 __attribute__((ext_vector_type(2)));
typedef unsigned u32x2 __attribute__((ext_vector_type(2)));
__device__ __forceinline__ float sigmoidf_(float x) { return __builtin_amdgcn_rcpf(1.f + __expf(-x)); }

struct MoeOrder {
    int ntiles, nN, RG, G, c; const PG8_LAS int* tstart;
    __device__ __forceinline__ bool next(int i, Unit& u) const {
        const int L = i * G + c, grp = L >> 5, idx = L & 31; u.pn = idx / RG; u.pm = grp * RG + idx % RG; u.e = 0;
        if (u.pm >= ntiles) return false;
        int e = 0;
#pragma unroll
        for (int k = 16; k >= 1; k >>= 1) { if (tstart[e + k] <= u.pm) e += k; }
        u.e = __builtin_amdgcn_readfirstlane(e); return true;
    }
    __device__ __forceinline__ void a_ready(const Unit&) const {}
    __device__ __forceinline__ void done(const Unit&) const {}
};

#define PG8_PACK8(v0, v1) (u32x4){cvt_pk_bf16((v0)[0], (v0)[1]), cvt_pk_bf16((v0)[2], (v0)[3]), cvt_pk_bf16((v1)[0], (v1)[1]), cvt_pk_bf16((v1)[2], (v1)[3])}

struct EpiPlain {
    static constexpr bool PERM = true, AFTER_DRAIN = false;
    bf16_t* O; int ldc;
    __device__ __forceinline__ void operator()(const f32x4 (&acc)[2][2][4][2], const Unit& u, int wr, int wc, int fr, int fq) const {
        const int row0 = u.pm * BM + wr * 64 + fr, col0 = u.pn * BM + wc * 32 + 8 * fq;
#pragma unroll
        for (int ai = 0; ai < 2; ++ai)
#pragma unroll
            for (int m = 0; m < 4; ++m) { bf16_t* rowp = O + (size_t)(row0 + ai * HALF + m * 16) * ldc + col0;
#pragma unroll
                for (int bj = 0; bj < 2; ++bj) { const f32x4 v0 = acc[ai][bj][m][0], v1 = acc[ai][bj][m][1]; *(u32x4*)(rowp + bj * HALF) = PG8_PACK8(v0, v1); } }
    }
};

struct EpiProj {
    static constexpr bool PERM = true, AFTER_DRAIN = false;
    bf16_t *Q, *K, *V, *RW; const float* rope; float qscale;
    __device__ __forceinline__ void operator()(const f32x4 (&acc)[2][2][4][2], const Unit& u, int wr, int wc, int fr, int fq) const {
        const int row0 = u.pm * BM + wr * 64 + fr, cl = wc * 32 + 8 * fq, pn = u.pn;
        if (pn < 4) {
            bf16_t* base = (pn < 2) ? Q : K; const int colt = (pn & 1) * 256; const float sc = (pn < 2) ? qscale : 1.f;
            const bool rp = ((wc & 1) == 0) && (fq < 2);
#pragma unroll
            for (int ai = 0; ai < 2; ++ai)
#pragma unroll
                for (int m = 0; m < 4; ++m) { const int row = row0 + ai * HALF + m * 16;
                    f32x4 cs = (f32x4){1.f, 1.f, 1.f, 1.f}, sn = (f32x4){0.f, 0.f, 0.f, 0.f};
                    if (rp) { cs = *(const f32x4*)(rope + (size_t)row * 16 + 4 * fq); sn = *(const f32x4*)(rope + (size_t)row * 16 + 8 + 4 * fq); }
#pragma unroll
                    for (int bj = 0; bj < 2; ++bj) { f32x4 v0 = acc[ai][bj][m][0], v1 = acc[ai][bj][m][1];
                        { const float a0 = v0[0], b0 = v0[1], a1 = v0[2], b1 = v0[3], a2 = v1[0], b2 = v1[1], a3 = v1[2], b3 = v1[3];
                          v0[0] = a0 * cs[0] - b0 * sn[0]; v0[1] = b0 * cs[0] + a0 * sn[0]; v0[2] = a1 * cs[1] - b1 * sn[1]; v0[3] = b1 * cs[1] + a1 * sn[1];
                          v1[0] = a2 * cs[2] - b2 * sn[2]; v1[1] = b2 * cs[2] + a2 * sn[2]; v1[2] = a3 * cs[3] - b3 * sn[3]; v1[3] = b3 * cs[3] + a3 * sn[3]; }
                        v0 = v0 * sc; v1 = v1 * sc;
                        *(u32x4*)(base + (size_t)row * 512 + colt + bj * HALF + cl) = PG8_PACK8(v0, v1); } }
        } else {
            bf16_t* base; int ld, colt;
            if (pn < 6) { base = V; ld = 512; colt = (pn - 4) * 256; } else { base = RW; ld = 1792; colt = (pn - 6) * 256; }
#pragma unroll
            for (int ai = 0; ai < 2; ++ai)
#pragma unroll
                for (int m = 0; m < 4; ++m) { bf16_t* rowp = base + (size_t)(row0 + ai * HALF + m * 16) * ld + colt + cl;
#pragma unroll
                    for (int bj = 0; bj < 2; ++bj) { const f32x4 v0 = acc[ai][bj][m][0], v1 = acc[ai][bj][m][1]; *(u32x4*)(rowp + bj * HALF) = PG8_PACK8(v0, v1); } }
        }
    }
};

struct EpiLora {
    static constexpr bool PERM = true, AFTER_DRAIN = false;
    bf16_t* LW; size_t kstride; const float *w0, *a0;
    __device__ __forceinline__ void operator()(const f32x4 (&acc)[2][2][4][2], const Unit& u, int wr, int wc, int fr, int fq) const {
        const int row0 = u.pm * BM + wr * 64 + fr, kind = u.pn >> 1, col0 = (u.pn & 1) * 256 + wc * 32 + 8 * fq;
        bf16_t* dst = LW + (size_t)kind * kstride; const float* bias = (kind == 1) ? a0 : w0;
        f32x4 bv[2][2];
#pragma unroll
        for (int bj = 0; bj < 2; ++bj)
#pragma unroll
            for (int n = 0; n < 2; ++n) bv[bj][n] = (kind < 2) ? *(const f32x4*)(bias + col0 + bj * HALF + 4 * n) : (f32x4){0.f, 0.f, 0.f, 0.f};
#pragma unroll
        for (int ai = 0; ai < 2; ++ai)
#pragma unroll
            for (int m = 0; m < 4; ++m) { bf16_t* rowp = dst + (size_t)(row0 + ai * HALF + m * 16) * 512 + col0;
#pragma unroll
                for (int bj = 0; bj < 2; ++bj) { f32x4 vv[2];
#pragma unroll
                    for (int n = 0; n < 2; ++n) { f32x4 v = acc[ai][bj][m][n] + bv[bj][n];
                        if (kind == 0) {
#pragma unroll
                            for (int q = 0; q < 4; ++q) v[q] = -0.60653066f * sigmoidf_(v[q]);
                        } else if (kind == 1) {
#pragma unroll
                            for (int q = 0; q < 4; ++q) v[q] = sigmoidf_(v[q]);
                        }
                        vv[n] = v; }
                    *(u32x4*)(rowp + bj * HALF) = PG8_PACK8(vv[0], vv[1]); } }
    }
};

__device__ __forceinline__ unsigned pk4_fp8(float a, float b, float c_, float d) { int r = __builtin_amdgcn_cvt_pk_fp8_f32(a, b, 0, false); r = __builtin_amdgcn_cvt_pk_fp8_f32(c_, d, r, true); return (unsigned)r; }
constexpr float W8_SCALE = 32.f, W8_INV = 1.f / 32.f;
struct EpiSwiglu {
    static constexpr bool PERM = true, AFTER_DRAIN = false;
    unsigned char* ACT; const float* b1;
    __device__ __forceinline__ void operator()(const f32x4 (&acc)[2][2][4][2], const Unit& u, int wr, int wc, int fr, int fq) const {
        const int row0 = u.pm * BM + wr * 64 + fr, col0 = u.pn * BM + wc * 32 + 8 * fq;
        f32x4 bv[2][2];
#pragma unroll
        for (int bj = 0; bj < 2; ++bj)
#pragma unroll
            for (int n = 0; n < 2; ++n) bv[bj][n] = *(const f32x4*)(b1 + (size_t)u.e * 2048 + col0 + bj * HALF + 4 * n);
#pragma unroll
        for (int ai = 0; ai < 2; ++ai)
#pragma unroll
            for (int m = 0; m < 4; ++m) { unsigned char* rowp = ACT + (size_t)(row0 + ai * HALF + m * 16) * 1024 + (col0 >> 1);
#pragma unroll
                for (int bj = 0; bj < 2; ++bj) { const f32x4 v0 = acc[ai][bj][m][0] * W8_INV + bv[bj][0], v1 = acc[ai][bj][m][1] * W8_INV + bv[bj][1];
                    float o[4];
#pragma unroll
                    for (int q = 0; q < 4; ++q) { const float glu = (q < 2) ? v0[2 * q] : v1[2 * q - 4], lin = (q < 2) ? v0[2 * q + 1] : v1[2 * q - 3];
                        const float gg = fminf(glu, 7.f), ll = fminf(fmaxf(lin, -7.f), 7.f); o[q] = gg * sigmoidf_(1.702f * gg) * (ll + 1.f); }
                    *(unsigned*)(rowp + bj * (HALF / 2)) = pk4_fp8(o[0], o[1], o[2], o[3]); } }
    }
};

constexpr float Y8_SCALE = 32.f, Y8_INV = 1.f / 32.f;
struct EpiMoe2 {
    static constexpr bool PERM = true, AFTER_DRAIN = false;
    unsigned char* Y2; const float* b2; const float* gate;
    __device__ __forceinline__ void operator()(const f32x4 (&acc)[2][2][4][2], const Unit& u, int wr, int wc, int fr, int fq) const {
        const int row0 = u.pm * BM + wr * 64 + fr, col0 = u.pn * BM + wc * 32 + 8 * fq;
#pragma unroll
        for (int bj = 0; bj < 2; ++bj) { const f32x4 b0 = *(const f32x4*)(b2 + (size_t)u.e * 1024 + col0 + bj * HALF), b1 = *(const f32x4*)(b2 + (size_t)u.e * 1024 + col0 + bj * HALF + 4);
#pragma unroll
            for (int ai = 0; ai < 2; ++ai)
#pragma unroll
                for (int m = 0; m < 4; ++m) { const int row = row0 + ai * HALF + m * 16; const float gt = gate[row] * Y8_SCALE;
                    const f32x4 v0 = (acc[ai][bj][m][0] * W8_INV + b0) * gt, v1 = (acc[ai][bj][m][1] * W8_INV + b1) * gt;
                    *(u32x2*)(Y2 + (size_t)row * 1024 + col0 + bj * HALF) = (u32x2){pk4_fp8(v0[0], v0[1], v0[2], v0[3]), pk4_fp8(v1[0], v1[1], v1[2], v1[3])}; } }
    }
};

template <class Epi, class Sched, bool ALIGN_EPI = false, bool SP2 = false, bool GATHER = false, bool FP8 = false>
__device__ __forceinline__ void gemm_phase(PG8_LAS unsigned char* lds, const Gemm g, const Sched& S, const Epi& E, const int wid) {
    const int lane = lane_id_v(), tid = wid * 64 + lane, wr = wid >> 2, wc = wid & 3, fr = lane & 15, fq = lane >> 4;
    const int K = g.K, nt = K / BK;
    const __amdgpu_buffer_rsrc_t rsrc = __builtin_amdgcn_make_buffer_rsrc((void*)g.base, 0, 0x7fffffff, 0x00020000);
    unsigned voffA[2], voffB[2];
#pragma unroll
    for (int i = 0; i < 2; ++i) { int R, C; stage_rc(tid * 16 + i * 8192, R, C); const int Rb = Epi::PERM ? ((R & ~31) + perm32(R & 31)) : R;
        voffA[i] = (unsigned)(R * K + C) * 2u; voffB[i] = (unsigned)(Rb * K + C) * 2u; }
    const size_t kstep = (size_t)(BK * 2);
    const size_t hstep = (size_t)HALF * K * 2;
    const size_t tstep = 2 * hstep;
    const unsigned ldsw = (unsigned)wid * 1024u;
    const int aoff = FP8 ? lds_byte(wr * 64 + fr, fq * 16) : lds_byte(wr * 64 + fr, fq * 8), boff = FP8 ? lds_byte(wc * 32 + fr, fq * 16) : lds_byte(wc * 32 + fr, fq * 8);
    const PG8_LAS unsigned char* ldsA; const PG8_LAS unsigned char* ldsB;
    { unsigned a_ = (unsigned)(size_t)(lds + aoff), b_ = (unsigned)(size_t)(lds + 4 * HTB + boff); asm volatile("" : "+v"(a_), "+v"(b_)); ldsA = (const PG8_LAS unsigned char*)(size_t)a_; ldsB = (const PG8_LAS unsigned char*)(size_t)b_; }
#define PG8_SA(b, h) (((b) * 2 + (h)) * HTB)
#define PG8_SB(b, h) ((4 + (b) * 2 + (h)) * HTB)
#define PG8_STAGE(bufoff, gbase, voff) do { const unsigned so_ = (unsigned)((const char*)(gbase) - (const char*)g.base); _Pragma("unroll") for (int _i = 0; _i < 2; ++_i) \
        __builtin_amdgcn_raw_ptr_buffer_load_lds(rsrc, (PG8_LAS unsigned*)(lds + (bufoff) + ldsw + _i * 8192), 16, (voff)[_i], so_, 0, 0); } while (0)
#define PG8_STAGE_A(bufoff, ptr, h, nx) do { if constexpr (GATHER) { unsigned vo_[2]; vo_[0] = (nx) ? gn[h][0] : gc[h][0]; vo_[1] = (nx) ? gn[h][1] : gc[h][1]; PG8_STAGE(bufoff, ptr, vo_); } \
        else { PG8_STAGE(bufoff, (ptr) + (h) * hstep, voffA); } } while (0)
#define PG8_LDA(dst, b, h) do { _Pragma("unroll") for (int m = 0; m < 4; ++m) _Pragma("unroll") for (int k = 0; k < 2; ++k) dst[m].pc[k] = *(const PG8_LAS bf16x8*)(ldsA + ((b) * 2 + (h)) * HTB + m * 2048 + k * (FP8 ? 16 : 1024)); } while (0)
#define PG8_LDB(dst, b, h) do { _Pragma("unroll") for (int n = 0; n < 2; ++n) _Pragma("unroll") for (int k = 0; k < 2; ++k) dst[n].pc[k] = *(const PG8_LAS bf16x8*)(ldsB + ((b) * 2 + (h)) * HTB + n * 2048 + k * (FP8 ? 16 : 1024)); } while (0)
#define PG8_MMA(ai, bj, At, Bt) do { __builtin_amdgcn_s_setprio(1); _Pragma("unroll") for (int m = 0; m < 4; ++m) _Pragma("unroll") for (int n = 0; n < 2; ++n) { \
        if constexpr (FP8) { acc[ai][bj][m][n] = __builtin_amdgcn_mfma_scale_f32_16x16x128_f8f6f4(Bt[n].w, At[m].w, acc[ai][bj][m][n], 0, 0, 0, 0, 0, 0); } \
        else { _Pragma("unroll") for (int k = 0; k < 2; ++k) acc[ai][bj][m][n] = __builtin_amdgcn_mfma_f32_16x16x32_bf16(Bt[n].pc[k], At[m].pc[k], acc[ai][bj][m][n], 0, 0, 0); } } \
        __builtin_amdgcn_s_setprio(0); } while (0)
#define PG8_WAIT_V(n) asm volatile("s_waitcnt vmcnt(" #n ")" ::: "memory")
#define PG8_WAIT_L(n) asm volatile("s_waitcnt lgkmcnt(" #n ")" ::: "memory")
#define PG8_BAR __builtin_amdgcn_s_barrier()
#define PG8_SCHED __builtin_amdgcn_sched_barrier(0)
    Unit cur, nxt; int ui = 0;
    if (!S.next(0, cur)) return;
    f32x4 acc[2][2][4][2];
#pragma unroll
    for (int a = 0; a < 2; ++a)
#pragma unroll
        for (int b = 0; b < 2; ++b)
#pragma unroll
            for (int m = 0; m < 4; ++m)
#pragma unroll
                for (int n = 0; n < 2; ++n) acc[a][b][m][n] = (f32x4){0.f, 0.f, 0.f, 0.f};
    frag2_t At[4], B0[2], B1[2];
    const char* cA = GATHER ? (const char*)g.A : (const char*)g.A + (size_t)cur.pm * tstep; const char* cB = (const char*)g.Bt + (size_t)cur.e * g.bstride + (size_t)cur.pn * tstep;
    unsigned gc[2][2] = {{0u, 0u}, {0u, 0u}}, gn[2][2] = {{0u, 0u}, {0u, 0u}}; Unit nx2; bool has_nx2 = false;
#define PG8_GOFF(dst, pm_, ok_, alt_) do { const int t_ = lane_id_v() + wid * 64; _Pragma("unroll") for (int i_ = 0; i_ < 2; ++i_) { int R_, C_; stage_rc(t_ * 16 + i_ * 8192, R_, C_); \
        _Pragma("unroll") for (int h_ = 0; h_ < 2; ++h_) dst[h_][i_] = (ok_) ? (unsigned)g.rowidx[(pm_) * BM + h_ * HALF + R_] * (unsigned)(K * 2) + (unsigned)C_ * 2u : alt_[h_][i_]; } } while (0)
    if constexpr (GATHER) {
        PG8_GOFF(gc, cur.pm, true, gc);
        const bool hn = S.next(1, nxt);
        PG8_GOFF(gn, nxt.pm, hn, gc);
    }
    S.a_ready(cur);
    if constexpr (SP2) {
        PG8_STAGE(PG8_SB(0, 0), cB, voffB); PG8_STAGE(PG8_SB(0, 1), cB + hstep, voffB); PG8_STAGE_A(PG8_SA(0, 0), cA, 0, false); PG8_STAGE_A(PG8_SA(0, 1), cA, 1, false);
        if (wr == 1) PG8_BAR;
        PG8_WAIT_V(2); PG8_BAR;
        PG8_STAGE(PG8_SB(1, 0), cB + kstep, voffB); PG8_STAGE_A(PG8_SA(1, 0), cA + kstep, 0, false); PG8_STAGE(PG8_SB(1, 1), cB + hstep + kstep, voffB);
        PG8_WAIT_V(6); PG8_BAR;
    } else {
        PG8_STAGE(PG8_SB(0, 0), cB, voffB); PG8_STAGE_A(PG8_SA(0, 0), cA, 0, false); PG8_STAGE(PG8_SB(0, 1), cB + hstep, voffB); PG8_STAGE_A(PG8_SA(0, 1), cA, 1, false);
        if (wr == 1) PG8_BAR;
        PG8_WAIT_V(4); PG8_BAR;
        PG8_STAGE(PG8_SB(1, 0), cB + kstep, voffB); PG8_STAGE_A(PG8_SA(1, 0), cA + kstep, 0, false); PG8_STAGE(PG8_SB(1, 1), cB + hstep + kstep, voffB);
        PG8_WAIT_V(6); PG8_BAR;
    }
    for (;;) {
        const bool has_next = S.next(ui + 1, nxt);
        const char* nA = GATHER ? (const char*)g.A : (has_next ? (const char*)g.A + (size_t)nxt.pm * tstep : cA); const char* nB = has_next ? (const char*)g.Bt + (size_t)nxt.e * g.bstride + (size_t)nxt.pn * tstep : cB;
        for (int t = 0; t < nt; t += 2) {
            const bool last = (t == nt - 2);
            asm volatile("" : "+v"(voffA[0]), "+v"(voffA[1]), "+v"(voffB[0]), "+v"(voffB[1]));
            if constexpr (GATHER) asm volatile("" : "+v"(gc[0][0]), "+v"(gc[0][1]), "+v"(gc[1][0]), "+v"(gc[1][1]), "+v"(gn[0][0]), "+v"(gn[0][1]), "+v"(gn[1][0]), "+v"(gn[1][1]));
            const char* a1 = cA + (size_t)(t + 1) * kstep;
            const char* a2 = last ? nA : cA + (size_t)(t + 2) * kstep; const char* b2 = last ? nB : cB + (size_t)(t + 2) * kstep;
            const char* a3 = a2 + kstep; const char* b3 = b2 + kstep;
            if (last && has_next) S.a_ready(nxt);
            if constexpr (SP2) {
            PG8_LDB(B0, 0, 0); PG8_LDB(B1, 0, 1); PG8_SCHED; PG8_LDA(At, 0, 0); PG8_STAGE_A(PG8_SA(1, 1), a1, 1, false);
            PG8_WAIT_V(8); PG8_WAIT_L(0); PG8_BAR; PG8_MMA(0, 0, At, B0); PG8_MMA(0, 1, At, B1); PG8_BAR; PG8_SCHED;
            PG8_LDA(At, 0, 1); PG8_STAGE(PG8_SB(0, 0), b2, voffB); PG8_STAGE(PG8_SB(0, 1), b2 + hstep, voffB); PG8_STAGE_A(PG8_SA(0, 0), a2, 0, last);
            PG8_WAIT_V(8); PG8_WAIT_L(0); PG8_BAR; PG8_MMA(1, 0, At, B0); PG8_MMA(1, 1, At, B1); PG8_BAR; PG8_SCHED;
            PG8_LDB(B0, 1, 0); PG8_LDB(B1, 1, 1); PG8_SCHED; PG8_LDA(At, 1, 0); PG8_STAGE_A(PG8_SA(0, 1), a2, 1, last);
            PG8_WAIT_V(8); PG8_WAIT_L(0); PG8_BAR; PG8_MMA(0, 0, At, B0); PG8_MMA(0, 1, At, B1); PG8_BAR; PG8_SCHED;
            PG8_LDA(At, 1, 1); PG8_STAGE(PG8_SB(1, 0), b3, voffB); PG8_STAGE(PG8_SB(1, 1), b3 + hstep, voffB); PG8_STAGE_A(PG8_SA(1, 0), a3, 0, last);
            PG8_WAIT_V(8); PG8_WAIT_L(0); PG8_BAR; PG8_MMA(1, 0, At, B0); PG8_MMA(1, 1, At, B1); PG8_BAR; PG8_SCHED;
            } else {
            PG8_LDB(B0, 0, 0); PG8_SCHED; PG8_LDA(At, 0, 0); PG8_STAGE_A(PG8_SA(1, 1), a1, 1, false);
            PG8_WAIT_L(8); PG8_BAR; PG8_WAIT_L(0); PG8_MMA(0, 0, At, B0); PG8_BAR; PG8_SCHED;
            PG8_LDB(B1, 0, 1); PG8_STAGE(PG8_SB(0, 0), b2, voffB);
            PG8_BAR; PG8_WAIT_L(0); PG8_MMA(0, 1, At, B1); PG8_BAR;
            PG8_LDA(At, 0, 1); PG8_STAGE_A(PG8_SA(0, 0), a2, 0, last);
            PG8_BAR; PG8_WAIT_L(0); PG8_MMA(1, 0, At, B0); PG8_BAR; PG8_SCHED;
            PG8_STAGE(PG8_SB(0, 1), b2 + hstep, voffB);
            PG8_WAIT_V(6); PG8_BAR; PG8_MMA(1, 1, At, B1); PG8_BAR;
            PG8_LDB(B0, 1, 0); PG8_SCHED; PG8_LDA(At, 1, 0); PG8_STAGE_A(PG8_SA(0, 1), a2, 1, last);
            PG8_WAIT_L(8); PG8_BAR; PG8_WAIT_L(0); PG8_MMA(0, 0, At, B0); PG8_BAR; PG8_SCHED;
            PG8_LDB(B1, 1, 1); PG8_STAGE(PG8_SB(1, 0), b3, voffB);
            PG8_BAR; PG8_WAIT_L(0); PG8_MMA(0, 1, At, B1); PG8_BAR;
            PG8_LDA(At, 1, 1); PG8_STAGE_A(PG8_SA(1, 0), a3, 0, last);
            PG8_BAR; PG8_WAIT_L(0); PG8_MMA(1, 0, At, B0); PG8_BAR; PG8_SCHED;
            PG8_STAGE(PG8_SB(1, 1), b3 + hstep, voffB);
            PG8_WAIT_V(6); PG8_BAR; PG8_MMA(1, 1, At, B1); PG8_BAR;
            }
        }
        if constexpr (GATHER) { has_nx2 = has_next && S.next(ui + 2, nx2);
            _Pragma("unroll") for (int h = 0; h < 2; ++h) _Pragma("unroll") for (int i = 0; i < 2; ++i) gc[h][i] = gn[h][i];
            PG8_GOFF(gn, nx2.pm, has_nx2, gc); }
        if constexpr (ALIGN_EPI) { if (wr == 0) PG8_BAR; }
        if constexpr (!Epi::AFTER_DRAIN) { const int l_ = lane_id_v(); const int fr_ = l_ & 15, fq_ = l_ >> 4;
            E(acc, cur, wr, wc, fr_, fq_); S.done(cur); }
        if (!has_next) break;
#pragma unroll
        for (int a = 0; a < 2; ++a)
#pragma unroll
            for (int b = 0; b < 2; ++b)
#pragma unroll
                for (int m = 0; m < 4; ++m)
#pragma unroll
                    for (int n = 0; n < 2; ++n) acc[a][b][m][n] = (f32x4){0.f, 0.f, 0.f, 0.f};
        if constexpr (GATHER) { asm volatile("" : "+v"(gn[0][0]), "+v"(gn[0][1]), "+v"(gn[1][0]), "+v"(gn[1][1])); }
        cur = nxt; cA = nA; cB = nB; ++ui;
        if constexpr (ALIGN_EPI) { if (wr == 1) PG8_BAR; }
    }
    PG8_WAIT_V(0);
    if constexpr (!ALIGN_EPI) { if (wr == 0) PG8_BAR; }
    PG8_BAR;
    if constexpr (Epi::AFTER_DRAIN) { E.fused(acc, cur, wr, wc, fr, fq, lds, wid, lane); S.done(cur); }
#undef PG8_SA
#undef PG8_SB
#undef PG8_STAGE
#undef PG8_STAGE_A
#undef PG8_GOFF
#undef PG8_LDA
#undef PG8_LDB
#undef PG8_MMA
#undef PG8_WAIT_V
#undef PG8_WAIT_L
#undef PG8_BAR
#undef PG8_SCHED
}
}
#include <hip/hip_bf16.h>
#include <cmath>
namespace attn_body {
using bf16=__hip_bfloat16;
using bf16x8=__attribute__((ext_vector_type(8)))short;
using s16x4=__attribute__((ext_vector_type(4)))short;
using f32x16=__attribute__((ext_vector_type(16)))float;
using u32x4=__attribute__((ext_vector_type(4)))unsigned;
constexpr int BATCH=8,NHEAD=8,SEQ=4096,D=64;
constexpr int QP=512,KP=512,VP=512,OP=1024;
constexpr int NW=8,QBLK=32,QB=QBLK*NW,KVBLK=64,NQB=SEQ/QB;
constexpr int ATTN_UNIT_ROWS=QB;
__device__ __forceinline__ int crow(int r,int hi){return (r&3)+8*(r>>2)+4*hi;}
#define SBAR() __builtin_amdgcn_sched_barrier(0)
__device__ __forceinline__ void cmask(f32x16&p0,f32x16&p1,int jb,int qrel,int hi){
  const float NEG=-INFINITY; int kb=64*jb+4*hi;
  #pragma unroll
  for(int r=0;r<16;++r){int kv=kb+(r&3)+8*(r>>2); if(kv>qrel)p0[r]=NEG; if(kv+32>qrel)p1[r]=NEG;}
}

constexpr int NSLOT=3, SLOTB=8192;
constexpr int LDS_K=0, LDS_V=NSLOT*SLOTB, LDS_WS=3*NSLOT*SLOTB, LDS_Q=LDS_WS+NW*64*4, LDS_OST=LDS_Q, LDS_BYTES=LDS_Q+NW*4096;
constexpr float C2=0.125f*1.4426950408889634f;
__device__ __forceinline__ void glds16(const void*gsrc,unsigned lds_dst){unsigned keep;
  asm volatile("s_mov_b32 %0, m0\n\ts_mov_b32 m0, %2\n\ts_nop 0\n\tglobal_load_lds_dwordx4 %1, off\n\ts_mov_b32 m0, %0":"=&s"(keep):"v"(gsrc),"s"(lds_dst):"memory");}
__device__ __forceinline__ float max3f(float a,float b,float c){float r;asm("v_max3_f32 %0, %1, %2, %3":"=v"(r):"v"(a),"v"(b),"v"(c));return r;}
__device__ __forceinline__ float max2f(float a,float b){float r;asm("v_max_f32_e32 %0, %1, %2":"=v"(r):"v"(a),"v"(b));return r;}
__device__ __forceinline__ float fadd_s(float a,float b){float r;asm("v_add_f32_e32 %0, %1, %2":"=v"(r):"v"(a),"v"(b));return r;}
__device__ __forceinline__ float fsub_s(float a,float b){float r;asm("v_sub_f32_e32 %0, %1, %2":"=v"(r):"v"(a),"v"(b));return r;}
typedef float f32x2_t __attribute__((ext_vector_type(2))); typedef __bf16 bf16x2_t __attribute__((ext_vector_type(2)));
__device__ __forceinline__ unsigned cvtpk_s(float lo,float hi){f32x2_t v={lo,hi};bf16x2_t b=__builtin_convertvector(v,bf16x2_t);return __builtin_bit_cast(unsigned,b);}
#define WAIT_BAR(N) asm volatile("s_waitcnt vmcnt(" #N ") lgkmcnt(0)\n\ts_barrier":::"memory")

__device__ __forceinline__ void qkt(f32x16&p0,f32x16&p1,const char*Kslot,const __attribute__((address_space(3))) char*qf,int r32,int hi){
  const char*kb=Kslot+hi*1024+r32*16;
  #pragma unroll
  for(int d0=0;d0<4;++d0){
    const bf16x8 b0=*reinterpret_cast<const bf16x8*>(kb+d0*2048);
    const bf16x8 b1=*reinterpret_cast<const bf16x8*>(kb+d0*2048+512);
    const bf16x8 q_=*(const __attribute__((address_space(3))) bf16x8*)(qf+d0*1024);
    if(d0==0){p0=__builtin_amdgcn_mfma_f32_32x32x16_bf16(b0,q_,f32x16{},0,0,0);p1=__builtin_amdgcn_mfma_f32_32x32x16_bf16(b1,q_,f32x16{},0,0,0);}
    else{p0=__builtin_amdgcn_mfma_f32_32x32x16_bf16(b0,q_,p0,0,0,0);p1=__builtin_amdgcn_mfma_f32_32x32x16_bf16(b1,q_,p1,0,0,0);}}
}
typedef __attribute__((address_space(3))) const char* lds_cptr;
typedef short v4i16_t __attribute__((ext_vector_type(4)));
__device__ __forceinline__ void kload8(bf16x8*kf,lds_cptr kp){
  kf[0]=*(const __attribute__((address_space(3))) bf16x8*)(kp);      kf[1]=*(const __attribute__((address_space(3))) bf16x8*)(kp+512);
  kf[2]=*(const __attribute__((address_space(3))) bf16x8*)(kp+2048); kf[3]=*(const __attribute__((address_space(3))) bf16x8*)(kp+2560);
  kf[4]=*(const __attribute__((address_space(3))) bf16x8*)(kp+4096); kf[5]=*(const __attribute__((address_space(3))) bf16x8*)(kp+4608);
  kf[6]=*(const __attribute__((address_space(3))) bf16x8*)(kp+6144); kf[7]=*(const __attribute__((address_space(3))) bf16x8*)(kp+6656);
}
__device__ __forceinline__ void kload2(bf16x8*kf,lds_cptr kp,int j){ kf[2*j]=*(const __attribute__((address_space(3))) bf16x8*)(kp+j*2048); kf[2*j+1]=*(const __attribute__((address_space(3))) bf16x8*)(kp+j*2048+512); }
__device__ __forceinline__ s16x4 vtr(lds_cptr p){ return __builtin_bit_cast(s16x4,__builtin_amdgcn_ds_read_tr16_b64_v4i16((__attribute__((address_space(3))) v4i16_t*)p)); }
__device__ __forceinline__ float rowmax(const f32x16&p0,const f32x16&p1){
  float a=max3f(p0[0],p0[1],p1[0]),b=max3f(p0[2],p0[3],p1[1]);a=max3f(a,p1[2],p1[3]);
  #pragma unroll
  for(int r=4;r<16;r+=4){a=max3f(a,p0[r],p0[r+1]);b=max3f(b,p0[r+2],p0[r+3]);a=max3f(a,p1[r],p1[r+1]);b=max3f(b,p1[r+2],p1[r+3]);}
  const float m=max2f(a,b);
  auto rr=__builtin_amdgcn_permlane32_swap(__float_as_uint(m),__float_as_uint(m),false,false);
  return max2f(__uint_as_float(rr[0]),__uint_as_float(rr[1]));
}
__device__ __forceinline__ void pv(f32x16*o,int vb,bf16x8 pa0,bf16x8 pa1,bf16x8 pa2,bf16x8 pa3){
  #pragma unroll
  for(int d0=0;d0<2;++d0){s16x4 lo[4],hi[4];
    #pragma unroll
    for(int ks=0;ks<4;++ks){
      asm volatile("ds_read_b64_tr_b16 %0,%1 offset:%c2":"=&v"(lo[ks]):"v"(vb),"i"(d0*4096+ks*1024):"memory");
      asm volatile("ds_read_b64_tr_b16 %0,%1 offset:%c2":"=&v"(hi[ks]):"v"(vb),"i"(d0*4096+ks*1024+512):"memory");}
    asm volatile("s_waitcnt lgkmcnt(0)":::"memory");SBAR();
    #define PK(k) (bf16x8){lo[k][0],lo[k][1],lo[k][2],lo[k][3],hi[k][0],hi[k][1],hi[k][2],hi[k][3]}
    o[d0]=__builtin_amdgcn_mfma_f32_32x32x16_bf16(pa0,PK(0),o[d0],0,0,0);
    o[d0]=__builtin_amdgcn_mfma_f32_32x32x16_bf16(pa1,PK(1),o[d0],0,0,0);
    o[d0]=__builtin_amdgcn_mfma_f32_32x32x16_bf16(pa2,PK(2),o[d0],0,0,0);
    o[d0]=__builtin_amdgcn_mfma_f32_32x32x16_bf16(pa3,PK(3),o[d0],0,0,0);
    #undef PK
  }
}

#ifndef ATTN_STORE16
#define ATTN_STORE16(p,v) (*(u32x4*)(p)=(v))
#endif
template<int THRL> __device__ __forceinline__ void attn_unit(int b,int h,int qb,const bf16*Q,const bf16*__restrict__ K,const bf16*__restrict__ V,bf16*O,char*shm,const int wid){
  const int qcol=h*64, kcol=h*64, vcol=(h>>1)*128, ocol=h*128;
  const int lane=lane_id_v(),r32=lane&31,hi=lane>>5;
  const long rowbase=(long)b*SEQ; const int q0=qb*QB;
  const bf16*Qw=Q+(rowbase+q0+wid*QBLK)*QP+qcol;
  const bf16*Kh=K+rowbase*KP+kcol,*Vh=V+rowbase*VP+vcol;
  const unsigned lds0=(unsigned)(uintptr_t)shm;
  __attribute__((address_space(3))) float*const wsf=(__attribute__((address_space(3))) float*)((__attribute__((address_space(3))) char*)shm+LDS_WS)+wid*64;
  const int koff=lane*KP+wid*8, voff=(16*(wid&3)+(lane>>2))*VP+(wid>>2)*32+(lane&3)*8;
  const unsigned kdst=lds0+LDS_K+wid*1024, vdst=lds0+LDS_V+wid*1024;
  #define DMA_K(t,slot) glds16(Kh+(long)(t)*KVBLK*KP+koff,(unsigned)__builtin_amdgcn_readfirstlane(kdst+(slot)))
  #define DMA_V(t,slot) do{ glds16(Vh+(long)(t)*KVBLK*VP+voff,(unsigned)__builtin_amdgcn_readfirstlane(vdst+2*(slot))); glds16(Vh+(long)(t)*KVBLK*VP+64+voff,(unsigned)__builtin_amdgcn_readfirstlane(vdst+2*(slot)+8192)); }while(0)
  const char*Kbase=shm+LDS_K; bf16x8 kf[8];
  const lds_cptr shm3=(lds_cptr)shm; const lds_cptr kp0=shm3+LDS_K+hi*1024+r32*16; const lds_cptr vp0=shm3+LDS_V+((lane>>4)&1)*32+(lane&3)*8+(4*hi+((lane&15)>>2))*64;
  const int NT=(q0+QB)/KVBLK;
  DMA_K(0,0);DMA_V(0,0);DMA_K(1,SLOTB);
  __attribute__((address_space(3))) char*const qf=(__attribute__((address_space(3))) char*)shm+LDS_Q+wid*4096+lane*16;
  { bf16x8 qt[4];
    #pragma unroll
    for(int d0=0;d0<4;++d0)qt[d0]=*reinterpret_cast<const bf16x8*>(&Qw[(long)r32*QP+d0*16+hi*8]);
    #pragma unroll
    for(int d0=0;d0<4;++d0)*(__attribute__((address_space(3))) bf16x8*)(qf+d0*1024)=qt[d0]; }
  #define QF(d0) (*(const __attribute__((address_space(3))) bf16x8*)(qf+(d0)*1024))
  float mhat=0.f,l_reg=0.f;f32x16 o[4];o[0]=f32x16{};o[1]=f32x16{};o[2]=f32x16{};o[3]=f32x16{};
  #define CMASK(P0,P1,t) do{int jb_=(t)-(NT-4); if(jb_>=0){ const int l_=lane_id_v(); cmask(P0,P1,jb_,wid*QBLK+(l_&31),l_>>5); } }while(0)
  bool resc=false;
  #define START(P0,P1) do{ const float rm=rowmax(P0,P1); resc=false; \
    { const float dl=rm; mhat=fadd_s(mhat,dl); \
      _Pragma("unroll") for(int r=0;r<16;++r){P0[r]=fsub_s(P0[r],dl);P1[r]=fsub_s(P1[r],dl);} } \
    _Pragma("unroll") for(int r=0;r<16;++r)P0[r]=__builtin_amdgcn_exp2f(P0[r]); }while(0)
  #define RESC() do{ if(resc){ asm volatile("s_waitcnt lgkmcnt(0)":::"memory"); \
      _Pragma("unroll") for(int d_=0;d_<4;++d_) _Pragma("unroll") for(int r=0;r<16;++r)o[d_][r]*=wsf[crow(r,hi)]; } }while(0)
  f32x16 pA0,pA1,pB0,pB1;
  int sl_prev=0,sl_cur=0,sl_next=SLOTB;
  #define ROT() do{sl_prev=sl_cur;sl_cur=sl_next;sl_next=(sl_next==(NSLOT-1)*SLOTB)?0:sl_next+SLOTB;}while(0)
  DMA_K(2,2*SLOTB);
  WAIT_BAR(4);
  qkt(pA0,pA1,Kbase,qf,r32,hi);asm volatile("s_nop 15\n\ts_nop 7":"+v"(pA0),"+v"(pA1));CMASK(pA0,pA1,0);
  START(pA0,pA1);
  _Pragma("unroll") for(int r=0;r<16;++r)pA1[r]=__builtin_amdgcn_exp2f(pA1[r]);
  WAIT_BAR(0);
  DMA_K(3,0);DMA_V(1,SLOTB);
  ROT();
  kload8(kf,kp0+sl_cur);
  WAIT_BAR(3);
  s16x4 vlo[8],vhi[8]; u32x4 pw0,pw1,pw2,pw3;
  #define PKW(P,B) cvtpk_s(P[B],P[B+1])
  #define PAF(k) __builtin_bit_cast(bf16x8,pw##k)
  #define VFR(i) (bf16x8){vlo[i][0],vlo[i][1],vlo[i][2],vlo[i][3],vhi[i][0],vhi[i][1],vhi[i][2],vhi[i][3]}
  #define PIN(x) asm volatile("":"+v"(x))
  #define MX3(a,b,c) __builtin_fmaxf(__builtin_fmaxf((a),(b)),(c))
  #define GAPA(MF,A0,A1,A2,A3,W0,W1,PW) do{ MF; sacc+=A0; sacc+=A1; sacc+=A2; sacc+=A3; PIN(sacc); W0; W1; PIN(PW); SBAR(); }while(0)
  #define EX(v) __builtin_amdgcn_exp2f(v)
  #define GAPB(MF,X,B) do{ MF; X[B]=EX(X[B]); X[B+1]=EX(X[B+1]); X[B+2]=EX(X[B+2]); X[B+3]=EX(X[B+3]); PIN(X); SBAR(); }while(0)
  #define GAPB2(MF,X,B,RD) do{ MF; RD; X[B]=EX(X[B]); X[(B)+1]=EX(X[(B)+1]); PIN(X); SBAR(); }while(0)
  #define VRD2(i) do{ vlo[i]=vtr(vp_+8192+(((i)>>2)*4096+((i)&3)*1024)); vhi[i]=vtr(vp_+8192+(((i)>>2)*4096+((i)&3)*1024+512)); }while(0)
  #define VRD(i) do{ vlo[i]=vtr(vp_+(((i)>>2)*4096+((i)&3)*1024)); vhi[i]=vtr(vp_+(((i)>>2)*4096+((i)&3)*1024+512)); }while(0)
  #define KRD(G,j) do{ if(G){ kload2(kf,kp0+sl_next,j); SBAR(); } }while(0)
  #define STEP(C0,C1,P0,P1,t,GK,GV,GL) do{ SBAR(); \
    const lds_cptr vp_=vp0+2*sl_prev; \
    VRD(0); SBAR(); float sacc=(P0[0]+P0[1]); \
    bf16x8 q_=QF(0); \
    GAPA(C0=__builtin_amdgcn_mfma_f32_32x32x16_bf16(kf[0],q_,f32x16{},0,0,0), P0[2],P0[3],P0[4],P0[5],     pw0[0]=PKW(P0,0), pw0[1]=PKW(P0,2), pw0); \
    VRD(4); SBAR(); GAPA(C1=__builtin_amdgcn_mfma_f32_32x32x16_bf16(kf[1],q_,f32x16{},0,0,0), P0[6],P0[7],P0[8],P0[9],     pw0[2]=PKW(P0,4), pw0[3]=PKW(P0,6), pw0); \
    q_=QF(1); \
    VRD(1); SBAR(); GAPA(C0=__builtin_amdgcn_mfma_f32_32x32x16_bf16(kf[2],q_,C0,0,0,0),   P0[10],P0[11],P0[12],P0[13], pw1[0]=PKW(P0,8), pw1[1]=PKW(P0,10), pw1); \
    VRD(5); SBAR(); GAPA(C1=__builtin_amdgcn_mfma_f32_32x32x16_bf16(kf[3],q_,C1,0,0,0),   P0[14],P0[15],P1[0],P1[1],   pw1[2]=PKW(P0,12),pw1[3]=PKW(P0,14), pw1); \
    q_=QF(2); \
    VRD(2); SBAR(); GAPA(C0=__builtin_amdgcn_mfma_f32_32x32x16_bf16(kf[4],q_,C0,0,0,0),   P1[2],P1[3],P1[4],P1[5],     pw2[0]=PKW(P1,0), pw2[1]=PKW(P1,2), pw2); \
    VRD(6); SBAR(); GAPA(C1=__builtin_amdgcn_mfma_f32_32x32x16_bf16(kf[5],q_,C1,0,0,0),   P1[6],P1[7],P1[8],P1[9],     pw2[2]=PKW(P1,4), pw2[3]=PKW(P1,6), pw2); \
    q_=QF(3); \
    VRD(3); SBAR(); GAPA(C0=__builtin_amdgcn_mfma_f32_32x32x16_bf16(kf[6],q_,C0,0,0,0),   P1[10],P1[11],P1[12],P1[13], pw3[0]=PKW(P1,8), pw3[1]=PKW(P1,10), pw3); \
    VRD(7); SBAR(); GAPA(C1=__builtin_amdgcn_mfma_f32_32x32x16_bf16(kf[7],q_,C1,0,0,0),   P1[14],P1[15],0.f,0.f,       pw3[2]=PKW(P1,12),pw3[3]=PKW(P1,14), pw3); \
    l_reg+=sacc; \
    if(GK){DMA_K((t)+3,sl_cur);} if(GV){DMA_V((t)+1,sl_next);} \
    _Pragma("unroll") for(int r=0;r<16;++r){C0[r]-=mhat;C1[r]-=mhat;} \
    CMASK(C0,C1,t); \
    { float a=MX3(C0[0],C0[1],C1[0]),b=MX3(C0[2],C0[3],C1[1]); a=MX3(a,C1[2],C1[3]); \
      _Pragma("unroll") for(int r=4;r<16;r+=4){a=MX3(a,C0[r],C0[r+1]);b=MX3(b,C0[r+2],C0[r+3]);a=MX3(a,C1[r],C1[r+1]);b=MX3(b,C1[r+2],C1[r+3]);} \
      float rm=__builtin_fmaxf(a,b); { auto rr=__builtin_amdgcn_permlane32_swap(__float_as_uint(rm),__float_as_uint(rm),false,false); rm=__builtin_fmaxf(__uint_as_float(rr[0]),__uint_as_float(rr[1])); } \
      resc=false; \
      if(__builtin_expect(__any(rm>(float)THRL),0)){ const float dl=__builtin_fmaxf(rm,0.f); mhat+=dl; \
        _Pragma("unroll") for(int r=0;r<16;++r){C0[r]-=dl;C1[r]-=dl;} \
        const float f=__builtin_amdgcn_exp2f(-dl); l_reg*=f; if(hi==0)wsf[r32]=f; resc=true; } } \
    SBAR(); \
    GAPB2(o[0]=__builtin_amdgcn_mfma_f32_32x32x16_bf16(PAF(0),VFR(0),o[0],0,0,0), C0,0,  VRD2(0)); \
    GAPB2(o[1]=__builtin_amdgcn_mfma_f32_32x32x16_bf16(PAF(0),VFR(4),o[1],0,0,0), C0,2,  VRD2(4)); \
    KRD(GL,0); GAPB2(o[0]=__builtin_amdgcn_mfma_f32_32x32x16_bf16(PAF(1),VFR(1),o[0],0,0,0), C0,4,  VRD2(1)); \
    KRD(GL,1); GAPB2(o[1]=__builtin_amdgcn_mfma_f32_32x32x16_bf16(PAF(1),VFR(5),o[1],0,0,0), C0,6,  VRD2(5)); \
    KRD(GL,2); GAPB2(o[0]=__builtin_amdgcn_mfma_f32_32x32x16_bf16(PAF(2),VFR(2),o[0],0,0,0), C0,8,  VRD2(2)); \
    KRD(GL,3); GAPB2(o[1]=__builtin_amdgcn_mfma_f32_32x32x16_bf16(PAF(2),VFR(6),o[1],0,0,0), C0,10, VRD2(6)); \
    GAPB2(o[0]=__builtin_amdgcn_mfma_f32_32x32x16_bf16(PAF(3),VFR(3),o[0],0,0,0), C0,12, VRD2(3)); \
    GAPB2(o[1]=__builtin_amdgcn_mfma_f32_32x32x16_bf16(PAF(3),VFR(7),o[1],0,0,0), C0,14, VRD2(7)); \
      \
    GAPB2(o[2]=__builtin_amdgcn_mfma_f32_32x32x16_bf16(PAF(0),VFR(0),o[2],0,0,0), C1,0,  (void)0); \
    GAPB2(o[3]=__builtin_amdgcn_mfma_f32_32x32x16_bf16(PAF(0),VFR(4),o[3],0,0,0), C1,2,  (void)0); \
    GAPB2(o[2]=__builtin_amdgcn_mfma_f32_32x32x16_bf16(PAF(1),VFR(1),o[2],0,0,0), C1,4,  (void)0); \
    GAPB2(o[3]=__builtin_amdgcn_mfma_f32_32x32x16_bf16(PAF(1),VFR(5),o[3],0,0,0), C1,6,  (void)0); \
    GAPB2(o[2]=__builtin_amdgcn_mfma_f32_32x32x16_bf16(PAF(2),VFR(2),o[2],0,0,0), C1,8,  (void)0); \
    GAPB2(o[3]=__builtin_amdgcn_mfma_f32_32x32x16_bf16(PAF(2),VFR(6),o[3],0,0,0), C1,10, (void)0); \
    GAPB2(o[2]=__builtin_amdgcn_mfma_f32_32x32x16_bf16(PAF(3),VFR(3),o[2],0,0,0), C1,12, (void)0); \
    GAPB2(o[3]=__builtin_amdgcn_mfma_f32_32x32x16_bf16(PAF(3),VFR(7),o[3],0,0,0), C1,14, (void)0); \
    }while(0)
  int t=1;
  #undef CMASK
  #define CMASK(P0,P1,t) do{}while(0)
  for(;t+5<NT;t+=2){
    STEP(pB0,pB1,pA0,pA1,t,true,true,true);     WAIT_BAR(3); RESC(); ROT();
    STEP(pA0,pA1,pB0,pB1,t+1,true,true,true);   WAIT_BAR(3); RESC(); ROT();
  }
  #undef CMASK
  #define CMASK(P0,P1,t) do{int jb_=(t)-(NT-4); if(jb_>=0){ const int l_=lane_id_v(); cmask(P0,P1,jb_,wid*QBLK+(l_&31),l_>>5); } }while(0)
  #define ENDW(tt) do{ if((tt)+3<NT){WAIT_BAR(3);} else if((tt)+2<NT){WAIT_BAR(2);} else {WAIT_BAR(0);} }while(0)
  for(;t+1<NT;t+=2){
    STEP(pB0,pB1,pA0,pA1,t,(t+3<NT),(t+1<NT),(t+1<NT));       ENDW(t);   RESC(); ROT();
    STEP(pA0,pA1,pB0,pB1,t+1,(t+4<NT),(t+2<NT),(t+2<NT));     ENDW(t+1); RESC(); ROT();
  }
  STEP(pB0,pB1,pA0,pA1,NT-1,false,false,false); RESC();
  { float sacc=pB0[0]+pB0[1]; _Pragma("unroll") for(int r=2;r<16;++r)sacc+=pB0[r]; _Pragma("unroll") for(int r=0;r<16;++r)sacc+=pB1[r]; l_reg+=sacc;
    pw0=(u32x4){PKW(pB0,0),PKW(pB0,2),PKW(pB0,4),PKW(pB0,6)};pw1=(u32x4){PKW(pB0,8),PKW(pB0,10),PKW(pB0,12),PKW(pB0,14)};pw2=(u32x4){PKW(pB1,0),PKW(pB1,2),PKW(pB1,4),PKW(pB1,6)};pw3=(u32x4){PKW(pB1,8),PKW(pB1,10),PKW(pB1,12),PKW(pB1,14)};
    const int vb0=(int)(lds0+LDS_V)+((lane>>4)&1)*32+(lane&3)*8+(4*hi+((lane&15)>>2))*64;
    SBAR(); pv(o,vb0+2*sl_cur,PAF(0),PAF(1),PAF(2),PAF(3)); pv(o+2,vb0+2*sl_cur+8192,PAF(0),PAF(1),PAF(2),PAF(3)); }
  #undef PKW
  #undef PAF
  #undef VFR
  #undef PIN
  #undef MX3
  #undef GAPA
  #undef GAPB
  #undef GAPB2
  #undef VRD2
  #undef EX
  #undef VRD
  #undef KRD
  #undef STEP
  #undef ENDW
  {auto rr=__builtin_amdgcn_permlane32_swap(__float_as_uint(l_reg),__float_as_uint(l_reg),false,false);l_reg=__uint_as_float(rr[0])+__uint_as_float(rr[1]);}
  if(hi==0)wsf[32+r32]=l_reg;asm volatile("s_waitcnt lgkmcnt(0)":::"memory");
  float rli[16];
  #pragma unroll
  for(int r=0;r<16;++r)rli[r]=__builtin_amdgcn_rcpf(wsf[32+crow(r,hi)]);
  bf16*Ow=O+(rowbase+q0+wid*QBLK)*OP+ocol;
  { bf16*stg=(bf16*)(shm+LDS_OST)+wid*2048;
    #pragma unroll
    for(int hf=0;hf<2;++hf){
      #pragma unroll
      for(int r=0;r<16;++r){const int orow=crow(r,hi);
        #pragma unroll
        for(int d0=0;d0<2;++d0)stg[orow*64+d0*32+r32]=__float2bfloat16(o[2*hf+d0][r]*rli[r]);}
      asm volatile("s_waitcnt lgkmcnt(0)":::"memory");
      #pragma unroll
      for(int i=0;i<4;++i){const int row=i*8+(lane>>3),ch=lane&7; const u32x4 v=*(const u32x4*)(stg+row*64+ch*8); ATTN_STORE16(Ow+(long)row*OP+hf*64+ch*8,v);}
      asm volatile("s_waitcnt lgkmcnt(0)":::"memory"); } }
  asm volatile("s_waitcnt lgkmcnt(0)\n\ts_barrier":::"memory");
  #undef DMA_K
  #undef DMA_V
  #undef QF
  #undef CMASK
  #undef START
  #undef RESC
  #undef ROT
}
constexpr int ATTN_LDS_BYTES=LDS_BYTES;
struct AttnTensors { const bf16* Q; const bf16* K; const bf16* V; bf16* O; };
struct AttnUnit { int bh; int qb; };
struct QueueOrder {
  unsigned* ctr; volatile __attribute__((address_space(3))) unsigned* slot; int wid;
  __device__ __forceinline__ unsigned claim()const{ unsigned n=0u; if(wid==0&&lane_id_v()==0) n=__hip_atomic_fetch_add(ctr,1u,__ATOMIC_RELAXED,__HIP_MEMORY_SCOPE_AGENT); return n; }
  __device__ __forceinline__ unsigned publish(unsigned n,int par)const{
    if(wid==0&&lane_id_v()==0) slot[par]=n;
    asm volatile("s_waitcnt lgkmcnt(0)\n\ts_barrier":::"memory");
    const unsigned r=slot[par]; asm volatile("s_waitcnt lgkmcnt(0)":::"memory"); return r; }
  __device__ __forceinline__ void a_ready(const AttnUnit&)const{}
  __device__ __forceinline__ void done(const AttnUnit&)const{}
};
template<class Sched,int THRL=8> __device__ __forceinline__ void attn_phase(char*lds,const AttnTensors&T,const Sched&S,const int wid){
  unsigned nxt=S.claim(); int par=0;
  for(;;){ const unsigned n=S.publish(nxt,par); par^=1; if(n>=(unsigned)(BATCH*NHEAD*NQB))break;
    nxt=S.claim();
    const int qb=NQB-1-(int)(n/(BATCH*NHEAD)), bh=(int)(n%(BATCH*NHEAD));
    attn_unit<THRL>(bh/NHEAD,bh%NHEAD,qb,T.Q,T.K,T.V,T.O,lds,wid); }
}
#undef SBAR
#undef WAIT_BAR
}
constexpr int NWAVES = 8;
#ifndef MK_N_LAUNCHES
#define MK_N_LAUNCHES 1
#endif
constexpr int N_PHASES = 14;
#ifndef PROBE_MASK
#define PROBE_MASK 0
#endif
constexpr int N_LAUNCHES = MK_N_LAUNCHES;
static_assert(N_LAUNCHES == 1 || N_LAUNCHES == N_PHASES, "MK_N_LAUNCHES is 1 or 14");

constexpr int BATCH = 8, T = 4096, D = 1024, M = BATCH * T;
constexpr int IN_COLS = 3328, RWC = 1792, NEXP = 32, TOPK = 4, NMOD = 6 * D;
constexpr int MAXROWS = M * TOPK + NEXP * 256;
constexpr int MOD_KS = 8;

constexpr size_t MiB = 1u << 20, KiB = 1u << 10;
constexpr size_t WS_CTL = 0, CTL_ZERO_BYTES = 1 * MiB;
constexpr size_t WS_MODP = 1 * MiB;
constexpr size_t WS_MOD = 2 * MiB + 512 * KiB;
constexpr size_t WS_ROPE = 3 * MiB;
constexpr size_t WS_WIN = 5 * MiB;
constexpr size_t WS_WOUT = 12 * MiB;
constexpr size_t WS_BLORA = 14 * MiB;
constexpr size_t WS_TOKE = 15 * MiB, WS_TOKG = 15 * MiB + 512 * KiB;
constexpr size_t WS_TOKROW = 16 * MiB, WS_ROWTOK = 16 * MiB + 512 * KiB, WS_ROWGATE = 17 * MiB + 256 * KiB, WS_BLKBASE = 18 * MiB;
constexpr size_t WS_W1 = 20 * MiB, WS_W2 = 148 * MiB;
constexpr size_t WS_H2 = 212 * MiB;
constexpr size_t WS_H = 276 * MiB, WS_Q = 340 * MiB, WS_K = 372 * MiB, WS_V = 404 * MiB, WS_RW = 436 * MiB;
constexpr size_t WS_O = 548 * MiB, WS_YCAT = 612 * MiB, WS_LACT = 676 * MiB;
constexpr size_t WS_LW = 692 * MiB, WS_AS = 756 * MiB, WS_G = 820 * MiB, WS_Y = 884 * MiB;
constexpr size_t WS_RIMG = 884 * MiB, WS_RBON = 1012 * MiB;
constexpr size_t WS_ACT = 276 * MiB, WS_Y2 = 548 * MiB, WS_END = 1013 * MiB;
static_assert(WS_ROWTOK + (size_t)MAXROWS * 4 <= WS_ROWGATE && WS_ROWGATE + (size_t)MAXROWS * 4 <= WS_BLKBASE && WS_ACT + (size_t)MAXROWS * 2048 <= WS_Y2 && WS_Y2 + (size_t)MAXROWS * 2048 <= WS_Y, "d_ws map");
constexpr int CW_TMO = 0, CW_CODE = 1;
constexpr int CW_BAR = 4096;
constexpr int CW_ATTQ = 8192;
constexpr int CW_ECNT = 12288;
static_assert((CW_ECNT + 2 * 64 * NEXP) * 4 <= (int)CTL_ZERO_BYTES, "CTL words inside the memset region");

constexpr int RING_OFF = 0, RING_BYTES = 131072;
constexpr int LDSCTL_OFF = RING_BYTES, MISC_OFF = LDSCTL_OFF + 320;
constexpr int LDS_BYTES = 147456;
static_assert(MISC_OFF + 128 <= LDS_BYTES, "LDS map");
#define GAS __attribute__((address_space(1)))
#define LAS __attribute__((address_space(3)))
typedef unsigned short bf16;
typedef unsigned v4u __attribute__((ext_vector_type(4)));
typedef float f32x4 __attribute__((ext_vector_type(4)));
typedef short bf16x8 __attribute__((ext_vector_type(8)));
typedef GAS unsigned gu32;
typedef GAS unsigned long long gu64;
#define RLX_AGENT __ATOMIC_RELAXED, __HIP_MEMORY_SCOPE_AGENT
#define LDS_WAIT() asm volatile("s_waitcnt lgkmcnt(0)" ::: "memory")
#define VM_WAIT() asm volatile("s_waitcnt vmcnt(0)" ::: "memory")
__device__ __forceinline__ unsigned long long rt() { return __builtin_amdgcn_s_memrealtime(); }
__device__ __forceinline__ unsigned f2bf(float f) { unsigned u = __builtin_bit_cast(unsigned, f); return (u + 0x7fffu + ((u >> 16) & 1u)) >> 16; }
__device__ __forceinline__ unsigned pk2(float lo, float hi) { return f2bf(lo) | (f2bf(hi) << 16); }

#define XB_TMO      128
#define XB_XCNT(j)  (256  + 64 * (j))
#define XB_XSUB(j)  (1280 + 64 * (j))
#define XB_XGEN(j)  (2304 + 64 * (j))
#define XB_TOP      3328
#define XB_TOPGEN   3392
#define XCD_BAR_WORDS 3456
#define XB_SPIN_CAP (1u << 18)

__device__ __forceinline__ unsigned xb_ld(unsigned* p)              { return __hip_atomic_load(p, __ATOMIC_RELAXED, __HIP_MEMORY_SCOPE_AGENT); }
__device__ __forceinline__ unsigned xb_add(unsigned* p, unsigned v) { return __hip_atomic_fetch_add(p, v, __ATOMIC_RELAXED, __HIP_MEMORY_SCOPE_AGENT); }
__device__ __forceinline__ unsigned xb_xcc_id() { return (unsigned)__builtin_amdgcn_s_getreg((3 << 11) | 20) & 0xFu; }
#define XB_SPIN(cond, bar) do { unsigned _sp = 0; while (cond) { __builtin_amdgcn_s_sleep(1); \
    if ((++_sp & 255u) == 0u) { if (xb_ld(&(bar)[XB_TMO])) break; if (_sp > XB_SPIN_CAP) { atomicAdd(&(bar)[XB_TMO], 1u); break; } } } } while (0)

struct XcdBarrier {
    unsigned* bar; unsigned x; int wid;
    volatile LAS unsigned* st;
};

__device__ __forceinline__ XcdBarrier xcd_barrier_post(unsigned* bar, volatile LAS unsigned* st, int wid) {
    XcdBarrier b; b.bar = bar; b.x = xb_xcc_id(); b.st = st; b.wid = wid;
    if (threadIdx.x == 0) (void)xb_add(&bar[XB_XCNT(b.x)], 1u);
    return b;
}
__device__ __forceinline__ void xcd_barrier_complete(unsigned* bar, unsigned x, unsigned& nloc, unsigned& nx) {
    const unsigned G = gridDim.x * gridDim.y * gridDim.z;
    unsigned sum, cnt, mine, sp = 0u;
    for (;;) {
        sum = 0u; cnt = 0u; mine = 0u;
#pragma unroll
        for (unsigned j = 0; j < 16; ++j) { const unsigned c = xb_ld(&bar[XB_XCNT(j)]); sum += c; cnt += (c > 0u) ? 1u : 0u; mine = (j == x) ? c : mine; }
        if (sum == G) break;
        __builtin_amdgcn_s_sleep(1);
        if ((++sp & 255u) == 0u) { if (xb_ld(&bar[XB_TMO])) break; if (sp > XB_SPIN_CAP) { atomicAdd(&bar[XB_TMO], 1u); break; } }
    }
    nloc = mine > 0u ? mine : 1u; nx = cnt > 0u ? cnt : 1u;
}

__device__ __forceinline__ void xcd_barrier(const XcdBarrier& b) {
    asm volatile("s_waitcnt vmcnt(0)" ::: "memory");
    __syncthreads();
    if (b.wid == 0 && lane_id_v() == 0) {
        unsigned* bar = b.bar;
        __builtin_amdgcn_s_waitcnt(0);
        unsigned nloc = b.st[0], nx = b.st[1];
        if (nloc == 0u) { xcd_barrier_complete(bar, b.x, nloc, nx); b.st[0] = nloc; b.st[1] = nx; }
        const unsigned old = xb_add(&bar[XB_XSUB(b.x)], 1u);
        const unsigned gen = old / nloc;
        if (old + 1u == (gen + 1u) * nloc) {
            __builtin_amdgcn_fence(__ATOMIC_RELEASE, "agent");
            asm volatile("s_waitcnt vmcnt(0)" ::: "memory");
            const unsigned og = xb_add(&bar[XB_TOP], 1u);
            const unsigned tg = og / nx;
            if (og + 1u == (tg + 1u) * nx) xb_add(&bar[XB_TOPGEN], 1u);
            else XB_SPIN(xb_ld(&bar[XB_TOPGEN]) == tg, bar);
            __builtin_amdgcn_fence(__ATOMIC_ACQUIRE, "agent");
            xb_add(&bar[XB_XGEN(b.x)], 1u);
            asm volatile("s_waitcnt vmcnt(0)" ::: "memory");
        } else {
            XB_SPIN(xb_ld(&bar[XB_XGEN(b.x)]) == gen, bar);
            __builtin_amdgcn_fence(__ATOMIC_ACQUIRE, "agent");
            asm volatile("s_waitcnt vmcnt(0)" ::: "memory");
        }
    }
    __syncthreads();
}
typedef float f32x2 __attribute__((ext_vector_type(2)));
typedef unsigned u32x2 __attribute__((ext_vector_type(2)));
struct Frame {
    LAS unsigned char* lds;
    volatile LAS unsigned* MISC;
    gu32* ctl;
    int wave;
    int vcu, G;
    unsigned char* ws; float* out;
};
struct Args { const void* in[33]; float* out; unsigned char* ws; int ph_lo, ph_hi, li, pad; };
struct InProxy { __device__ __forceinline__ const void* operator[](int k) const { unsigned long long v; const unsigned long long kp = (unsigned long long)__builtin_amdgcn_kernarg_segment_ptr();
    asm volatile("s_load_dwordx2 %0, %1, %2\n\ts_waitcnt lgkmcnt(0)" : "=s"(v) : "s"(kp), "s"(8 * k) : "memory"); return (const void*)(const GAS unsigned char*)v; } };
struct ArgsD { InProxy in; };

__device__ __forceinline__ float wave_sum(float v) {
#pragma unroll
    for (int o = 1; o < 64; o <<= 1) v += __shfl_xor(v, o);
    return v;
}
__device__ __forceinline__ float bf2f(unsigned short u) { return __uint_as_float((unsigned)u << 16); }
__device__ __forceinline__ float bflo(unsigned u) { return __uint_as_float(u << 16); }
__device__ __forceinline__ float bfhi(unsigned u) { return __uint_as_float(u & 0xffff0000u); }
typedef float f32x2_t __attribute__((ext_vector_type(2))); typedef __bf16 bf16x2_t __attribute__((ext_vector_type(2)));
__device__ __forceinline__ unsigned pkbf(float lo, float hi) { f32x2_t v = {lo, hi}; bf16x2_t b = __builtin_convertvector(v, bf16x2_t); return __builtin_bit_cast(unsigned, b); }
#define DPP_ADD(x, ctrl) ((x) + __builtin_bit_cast(float, __builtin_amdgcn_update_dpp(0, __builtin_bit_cast(int, (x)), (ctrl), 0xF, 0xF, true)))
__device__ __forceinline__ float allsum16(float x) {
    x = DPP_ADD(x, 0xB1); x = DPP_ADD(x, 0x4E); x = DPP_ADD(x, 0x124); x = DPP_ADD(x, 0x128); return x; }

struct P0Item { const float* src; bf16* dst; int N, K, n0; bool permq, fp8; };
__device__ __forceinline__ bool p0_decode(const Frame& F, int it, P0Item& d, const float* w_in, const float* w_out, const float* w1, const float* w2m) {
    constexpr int I_IN = (D / 64) * (IN_COLS / 32), I_OUT = (D / 64) * (D / 32), I_W1 = (D / 64) * (2048 / 32), I_W2 = (D / 64) * (D / 32);
    constexpr int NITEMS = I_IN + I_OUT + NEXP * I_W1 + NEXP * I_W2;
    if (it >= NITEMS) return false;
    const float* W; bf16* WT; int N, r = it; d.permq = false; d.fp8 = false; d.K = D;
    if (r < I_IN) { W = w_in; WT = (bf16*)(F.ws + WS_WIN); N = IN_COLS; d.permq = true; }
    else { r -= I_IN; if (r < I_OUT) { W = w_out; WT = (bf16*)(F.ws + WS_WOUT); N = D; }
        else { r -= I_OUT; if (r < NEXP * I_W1) { const int e = r / I_W1; r -= e * I_W1; W = w1 + (size_t)e * D * 2048; WT = (bf16*)(F.ws + WS_W1 + (size_t)e * 2048 * D); N = 2048; d.fp8 = true; }
            else { r -= NEXP * I_W1; const int e = r / I_W2; r -= e * I_W2; W = w2m + (size_t)e * D * D; WT = (bf16*)(F.ws + WS_W2 + (size_t)e * D * D); N = D; d.fp8 = true; } } }
    const int nblk = N / 32, kb = r / nblk, nb = r - kb * nblk; d.N = N; d.n0 = 32 * nb; d.src = W + (size_t)(64 * kb) * N + d.n0; d.dst = d.fp8 ? (bf16*)((unsigned char*)WT + 64 * kb) : WT + 64 * kb; return true;
}
__device__ __forceinline__ void p0_item_store(const P0Item& d, const float (&v)[32], LAS float* scr, int lane) {
#pragma unroll
    for (int i = 0; i < 32; ++i) scr[(2 * i + (lane >> 5)) * 33 + (lane & 31)] = v[i];
    LDS_WAIT(); asm volatile("" ::: "memory");
    const int c = lane & 7;
#pragma unroll
    for (int j = 0; j < 4; ++j) { const int n = (lane >> 3) + 8 * j; const LAS float* s = scr + (8 * c) * 33 + n;
        int nn = d.n0 + n;
        if (d.fp8) { const u32x2 o8 = (u32x2){pg8::pk4_fp8(s[0 * 33] * pg8::W8_SCALE, s[1 * 33] * pg8::W8_SCALE, s[2 * 33] * pg8::W8_SCALE, s[3 * 33] * pg8::W8_SCALE), pg8::pk4_fp8(s[4 * 33] * pg8::W8_SCALE, s[5 * 33] * pg8::W8_SCALE, s[6 * 33] * pg8::W8_SCALE, s[7 * 33] * pg8::W8_SCALE)};
            *(GAS u32x2*)((unsigned char*)d.dst + (size_t)nn * d.K + 8 * c) = o8; }
        else { v4u o; o.x = pkbf(s[0 * 33], s[1 * 33]); o.y = pkbf(s[2 * 33], s[3 * 33]); o.z = pkbf(s[4 * 33], s[5 * 33]); o.w = pkbf(s[6 * 33], s[7 * 33]);
            if (d.permq && nn < 1024) { const int dd = nn & 63; if (dd < 16) nn = (nn & ~63) + ((dd < 8) ? 2 * dd : 2 * (dd - 8) + 1); }
            *(GAS v4u*)(d.dst + (size_t)nn * d.K + 8 * c) = o; } }
    LDS_WAIT(); asm volatile("" ::: "memory");
}
__device__ __forceinline__ void sincos_d(float af, float& s, float& c) {
    const double a = (double)af; const double n = __builtin_rint(a * 0.63661977236758134308);
    double r = __builtin_fma(-n, 1.57079632679489655800e+00, a); r = __builtin_fma(-n, 6.12323399573676603587e-17, r);
    const double r2 = r * r;
    double sp = 1.0 / 6227020800.0; sp = sp * r2 * -1.0 + 1.0 / 39916800.0; sp = -sp * r2 + 1.0 / 362880.0; sp = -sp * r2 + 1.0 / 5040.0; sp = -sp * r2 + 1.0 / 120.0; sp = -sp * r2 + 1.0 / 6.0; sp = r - r * r2 * sp;
    double cp = 1.0 / 87178291200.0; cp = -cp * r2 + 1.0 / 479001600.0; cp = -cp * r2 + 1.0 / 3628800.0; cp = -cp * r2 + 1.0 / 40320.0; cp = -cp * r2 + 1.0 / 720.0; cp = -cp * r2 + 1.0 / 24.0; cp = -cp * r2 + 0.5; cp = 1.0 - r2 * cp;
    const int q = ((int)n) & 3;
    const double sv = (q == 0) ? sp : (q == 1) ? cp : (q == 2) ? -sp : -cp, cv = (q == 0) ? cp : (q == 1) ? -sp : (q == 2) ? -cp : sp;
    s = (float)sv; c = (float)cv;
}
__device__ __forceinline__ void p0_prologue(Frame& F, const ArgsD& A) {
    const int lane = lane_id_v(), tid = F.wave * 64 + lane; (void)tid;
    const int gw = F.vcu * NWAVES + F.wave, NGW = F.G * NWAVES, gt = F.vcu * 512 + tid, NGT = F.G * 512;
    LAS float* scr = (LAS float*)(F.lds + RING_OFF + F.wave * 12288);
    LAS float* sl = (LAS float*)(F.lds + RING_OFF + 98304);
    const float* c = (const float*)A.in[1];
    for (int i = tid; i < 8 * 1024; i += 512) { const float v = c[i]; sl[i] = v / (1.f + __expf(-v)); }
    __syncthreads();
    { const float* aw = (const float*)A.in[3]; float* modp = (float*)(F.ws + WS_MODP);
      for (int it = gw; it < 96 * MOD_KS; it += NGW) { const int cc = it % 96, ks = it / 96, col = cc * 64 + lane;
          float acc[8];
#pragma unroll
          for (int b = 0; b < 8; ++b) acc[b] = 0.f;
          for (int k = ks * 128; k < ks * 128 + 128; ++k) { const float w = aw[(size_t)k * NMOD + col];
#pragma unroll
              for (int b = 0; b < 8; ++b) acc[b] += sl[b * 1024 + k] * w; }
#pragma unroll
          for (int b = 0; b < 8; ++b) modp[(size_t)(ks * 8 + b) * NMOD + col] = acc[b]; } }
    { const int* pos = (const int*)A.in[2]; float* rope = (float*)(F.ws + WS_ROPE);
      for (int idx = gt; idx < M * 8; idx += NGT) { const int m = idx >> 3, i = idx & 7;
          const float invf = (i == 0) ? 1.0f : (i == 1) ? 0.1939227432012558f : (i == 2) ? 0.03760603070259094f : (i == 3) ? 0.007292664609849453f : (i == 4) ? 0.0014142135623842478f : (i == 5) ? 0.00027424818836152554f : (i == 6) ? 5.318296098266728e-05f : 1.0313386155758053e-05f;
          const float ang = (float)pos[m] * invf; float s, cc; sincos_d(ang, s, cc); rope[(size_t)m * 16 + i] = cc; rope[(size_t)m * 16 + 8 + i] = s; } }
    { const float* w2 = (const float*)A.in[18]; const float* a2 = (const float*)A.in[20]; const float* g2 = (const float*)A.in[21]; bf16* bl = (bf16*)(F.ws + WS_BLORA);
      for (int idx = gt; idx < 1536 * 256; idx += NGT) { const int n = idx >> 8, k = idx & 255, blk = n >> 9, nn = n & 511; float v = 0.f;
          if (blk == 0 && k < 64) v = w2[k * 512 + nn]; else if (blk == 1 && k >= 64 && k < 128) v = a2[(k - 64) * 512 + nn]; else if (blk == 2 && k >= 128) v = g2[(k - 128) * 512 + nn];
          bl[idx] = (bf16)(pkbf(v, 0.f) & 0xffffu); } }
    { const float* w_in = (const float*)A.in[9]; const float* w_out = (const float*)A.in[10]; const float* w1 = (const float*)A.in[29]; const float* w2m = (const float*)A.in[31];
      P0Item cur, nxt; float v[32], vn[32];
      bool have = p0_decode(F, gw, cur, w_in, w_out, w1, w2m);
      if (have) {
#pragma unroll
          for (int i = 0; i < 32; ++i) v[i] = cur.src[(size_t)(2 * i + (lane >> 5)) * cur.N + (lane & 31)]; }
      for (int it = gw; have; it += NGW) {
          const bool hn = p0_decode(F, it + NGW, nxt, w_in, w_out, w1, w2m);
          if (hn) {
#pragma unroll
              for (int i = 0; i < 32; ++i) vn[i] = nxt.src[(size_t)(2 * i + (lane >> 5)) * nxt.N + (lane & 31)]; }
          p0_item_store(cur, v, scr, lane);
          cur = nxt; have = hn;
#pragma unroll
          for (int i = 0; i < 32; ++i) v[i] = vn[i];
      } }
}

__device__ __forceinline__ void p1_premix(Frame& F, const ArgsD& A) {
    const int lane = lane_id_v(), tid = F.wave * 64 + lane; (void)tid;
    const float* modp = (const float*)(F.ws + WS_MODP); const float* ada_b = (const float*)A.in[4]; float* mod = (float*)(F.ws + WS_MOD);
    const int rows_per = M / F.G, mbeg = F.vcu * rows_per, b = mbeg >> 12;
    LAS float* ms = (LAS float*)(F.lds + RING_OFF);
    for (int col = tid; col < 2048; col += 512) { float s = ada_b[col];
#pragma unroll
        for (int ks = 0; ks < MOD_KS; ++ks) s += modp[(size_t)(ks * 8 + b) * NMOD + col];
        ms[col] = s; }
    for (int i = F.vcu * 512 + tid; i < 8 * 4096; i += F.G * 512) { const int bb = i >> 12, col = 2048 + (i & 4095); float s = ada_b[col];
#pragma unroll
        for (int ks = 0; ks < MOD_KS; ++ks) s += modp[(size_t)(ks * 8 + bb) * NMOD + col];
        mod[(size_t)bb * NMOD + col] = s; }
    __syncthreads();
    const float* x = (const float*)A.in[0]; const float* nw = (const float*)A.in[5]; bf16* H = (bf16*)(F.ws + WS_H);
    f32x4 wsc[4], sh[4];
#pragma unroll
    for (int j = 0; j < 4; ++j) { const int col = 4 * lane + 256 * j; wsc[j] = *((const f32x4*)nw + lane + 64 * j) * (*(const LAS f32x4*)(ms + 1024 + col) + 1.f); sh[j] = *(const LAS f32x4*)(ms + col); }
    const int nr = rows_per / NWAVES, m0 = mbeg + F.wave * nr;
    f32x4 pv[4];
#pragma unroll
    for (int j = 0; j < 4; ++j) pv[j] = *((const GAS f32x4*)(x + (size_t)m0 * D) + lane + 64 * j);
    for (int i = 0; i < nr; ++i) { const int m = m0 + i;
        f32x4 v[4]; float s2 = 0.f;
#pragma unroll
        for (int j = 0; j < 4; ++j) { v[j] = pv[j]; s2 += (v[j].x * v[j].x + v[j].y * v[j].y) + (v[j].z * v[j].z + v[j].w * v[j].w); }
        if (i + 1 < nr) {
#pragma unroll
            for (int j = 0; j < 4; ++j) pv[j] = *((const GAS f32x4*)(x + (size_t)(m + 1) * D) + lane + 64 * j); }
        const float rs = __builtin_amdgcn_rsqf(wave_sum(s2) * (1.f / D) + 1e-6f);
        GAS u32x2* o8 = (GAS u32x2*)(H + (size_t)m * D) + lane;
#pragma unroll
        for (int j = 0; j < 4; ++j) { const f32x4 y = v[j] * rs * wsc[j] + sh[j]; o8[64 * j] = (u32x2){pkbf(y.x, y.y), pkbf(y.z, y.w)}; } }
}

__device__ __forceinline__ void p3_lact(Frame& F, const ArgsD& A) {
    const int lane = lane_id_v(), tid = F.wave * 64 + lane; (void)tid;
    const bf16* RW = (const bf16*)(F.ws + WS_RW); bf16* L = (bf16*)(F.ws + WS_LACT); const float* mu = (const float*)A.in[16] + 1536;
    const int gw = F.vcu * NWAVES + F.wave, NGW = F.G * NWAVES, c0 = 4 * lane;
    const f32x4 mu4 = *(const f32x4*)(mu + c0);
    for (int m = gw; m < M; m += NGW) { const int t = m & (T - 1);
        const u32x2 p = *(const GAS u32x2*)(RW + (size_t)m * RWC + 1536 + c0); u32x2 q = (u32x2){0u, 0u}; if (t > 0) q = *(const GAS u32x2*)(RW + (size_t)(m - 1) * RWC + 1536 + c0);
        f32x4 pv = (f32x4){bflo(p.x), bfhi(p.x), bflo(p.y), bfhi(p.y)}, qv = (f32x4){bflo(q.x), bfhi(q.x), bflo(q.y), bfhi(q.y)};
        f32x4 s = pv + (qv - pv) * mu4;
        if (c0 < 64) { s.x = tanhf(s.x); s.y = tanhf(s.y); s.z = tanhf(s.z); s.w = tanhf(s.w); }
        else if (c0 >= 128) { s.x = 1.f / (1.f + __expf(-s.x)); s.y = 1.f / (1.f + __expf(-s.y)); s.z = 1.f / (1.f + __expf(-s.z)); s.w = 1.f / (1.f + __expf(-s.w)); }
        *(GAS u32x2*)(L + (size_t)m * 256 + c0) = (u32x2){pkbf(s.x, s.y), pkbf(s.z, s.w)}; }
}

namespace rwk {
typedef short bf16x8 __attribute__((ext_vector_type(8)));
constexpr int MB = 8192;
__device__ __forceinline__ int moff(int r, int c) { return r * 128 + ((((c >> 3) ^ (r >> 1)) & 7) << 4) + ((c & 7) << 1); }
__device__ __forceinline__ bf16x8 frag(const LAS unsigned char* buf, int row, int chunk) { return *(const LAS bf16x8*)(buf + row * 128 + (((chunk ^ (row >> 1)) & 7) << 4)); }
struct LaneOff { int f[2], sb, mb[2]; };
__device__ __forceinline__ LaneOff lane_off(int l) { LaneOff o; const int r16 = l & 15, q = l >> 4, key = (l >> 1) & 7;
    o.f[0] = r16 * 128 + (((q) ^ key) << 4); o.f[1] = r16 * 128 + (((4 + q) ^ key) << 4);
    o.sb = r16 * 128 + ((((q >> 1) ^ key) & 7) << 4) + (q & 1) * 8;
#pragma unroll
    for (int p = 0; p < 2; ++p) { const int keyr = (2 * q + p) & 7; o.mb[p] = (4 * q + 2 * p) * 128 + ((((r16 >> 3) ^ keyr) & 7) << 4) + (r16 & 7) * 2; }
    return o; }
__device__ __forceinline__ void mm(f32x4& acc, const LAS unsigned char* A, int tm, const LAS unsigned char* B, int tn, const LaneOff& o) {
#pragma unroll
    for (int ks = 0; ks < 2; ++ks) { const bf16x8 a = *(const LAS bf16x8*)(A + tm * 2048 + o.f[ks]), b = *(const LAS bf16x8*)(B + tn * 2048 + o.f[ks]); acc = __builtin_amdgcn_mfma_f32_16x16x32_bf16(a, b, acc, 0, 0, 0); }
}
struct Fr { bf16x8 k0, k1; };
__device__ __forceinline__ Fr ldfr(const LAS unsigned char* A, int t, const LaneOff& o) { Fr f; f.k0 = *(const LAS bf16x8*)(A + t * 2048 + o.f[0]); f.k1 = *(const LAS bf16x8*)(A + t * 2048 + o.f[1]); return f; }
__device__ __forceinline__ void mmf(f32x4& acc, const Fr& a, const Fr& b) { acc = __builtin_amdgcn_mfma_f32_16x16x32_bf16(a.k0, b.k0, acc, 0, 0, 0); acc = __builtin_amdgcn_mfma_f32_16x16x32_bf16(a.k1, b.k1, acc, 0, 0, 0); }
__device__ __forceinline__ void st_nm(LAS unsigned char* buf, int tm, int tn, const LaneOff& o, f32x4 v) {
    *(LAS u32x2*)(buf + tn * 2048 + (o.sb ^ (tm << 5))) = (u32x2){pkbf(v[0], v[1]), pkbf(v[2], v[3])}; }
__device__ __forceinline__ void st_mn(LAS unsigned char* buf, int tm, int tn, const LaneOff& o, f32x4 v) {
    const unsigned p0 = pkbf(v[0], v[1]), p1 = pkbf(v[2], v[3]); LAS unsigned char* b0 = buf + tm * 2048 + (o.mb[0] ^ (tn << 5)); LAS unsigned char* b1 = buf + tm * 2048 + (o.mb[1] ^ (tn << 5));
    *(LAS unsigned short*)(b0) = (unsigned short)(p0 & 0xffffu); *(LAS unsigned short*)(b0 + 128) = (unsigned short)(p0 >> 16);
    *(LAS unsigned short*)(b1) = (unsigned short)(p1 & 0xffffu); *(LAS unsigned short*)(b1 + 128) = (unsigned short)(p1 >> 16); }
__device__ __forceinline__ f32x4 ld_nm(const LAS unsigned char* buf, int tm, int tn, const LaneOff& o) {
    const u32x2 p = *(const LAS u32x2*)(buf + tn * 2048 + (o.sb ^ (tm << 5))); return (f32x4){bflo(p.x), bfhi(p.x), bflo(p.y), bfhi(p.y)}; }
__device__ __forceinline__ float wsum64(float x) {
    x = DPP_ADD(x, 0xB1); x = DPP_ADD(x, 0x4E); x = DPP_ADD(x, 0x124); x = DPP_ADD(x, 0x128);
    { const auto r_ = __builtin_amdgcn_permlane16_swap(__float_as_uint(x), __float_as_uint(x), false, false); x = __uint_as_float(r_[0]) + __uint_as_float(r_[1]); }
    { const auto r_ = __builtin_amdgcn_permlane32_swap(__float_as_uint(x), __float_as_uint(x), false, false); x = __uint_as_float(r_[0]) + __uint_as_float(r_[1]); }
    return x; }
__device__ __forceinline__ float sum8(float x) { x = DPP_ADD(x, 0xB1); x = DPP_ADD(x, 0x4E); x = DPP_ADD(x, 0x141); return x; }
}

__device__ __forceinline__ void rwkv_pre(Frame& F, const ArgsD& A, const int bh, const int c_lo, const int c_hi) {
    using namespace rwk;
    const int b = bh >> 3, h = bh & 7, lane0 = lane_id_v(), w0 = F.wave;
    const LaneOff LO = lane_off(lane0);
    LAS unsigned char* L = F.lds + RING_OFF;
    LAS unsigned char* bA = L + 0 * MB; LAS unsigned char* bR = L + 1 * MB; LAS unsigned char* bB = L + 2 * MB; LAS unsigned char* bK = L + 3 * MB;
    LAS unsigned char* bBH = L + 4 * MB; LAS unsigned char* bKH = L + 5 * MB; LAS unsigned char* bVT = L + 6 * MB;
    LAS unsigned char* bAT = L + 7 * MB;
    LAS unsigned char* bAak = L + 9 * MB; LAS unsigned char* bArb = L + 10 * MB; LAS unsigned char* bArk = L + 11 * MB;
    LAS unsigned char* bQ0 = L + 12 * MB; LAS unsigned char* bQT0 = L + 13 * MB;
    LAS unsigned char* bT = L + 14 * MB;
    LAS unsigned char* bTF = L + 15 * MB;
    LAS float* part = (LAS float*)(F.lds + MISC_OFF + 128);
    LAS float* bon = part + 512;
    const bf16* RW = (const bf16*)(F.ws + WS_RW); const bf16* LW = (const bf16*)(F.ws + WS_LW); const bf16* AS = (const bf16*)(F.ws + WS_AS);
    unsigned char* IMG = F.ws + WS_RIMG; float* BON = (float*)(F.ws + WS_RBON);
    const size_t mb = (size_t)b * T;
    const float* mu = (const float*)A.in[16];
    float mu_r, mu_k, mu_v, kkc, kac, rkc;
    { const int hj = h * 64 + lane0; mu_r = mu[hj]; mu_k = mu[512 + hj]; mu_v = mu[1024 + hj]; kkc = ((const float*)A.in[22])[hj]; kac = ((const float*)A.in[23])[hj]; rkc = ((const float*)A.in[24])[hj]; }
    unsigned short pr[9], pk_[9], pv[9], plw[8], pas[8];
#define RWC_LOAD(c) do { const int w = w0, hj = h * 64 + lane0; const size_t m0_ = mb + (size_t)(c) * 64 + 8 * w; \
        _Pragma("unroll") for (int i_ = 0; i_ < 9; ++i_) { const bool ok_ = (i_ > 0) || ((c) > 0) || (w > 0); const bf16* row_ = RW + (m0_ + i_ - 1) * RWC + hj; \
            pr[i_] = ok_ ? row_[0] : (unsigned short)0; pk_[i_] = ok_ ? row_[512] : (unsigned short)0; pv[i_] = ok_ ? row_[1024] : (unsigned short)0; } \
        _Pragma("unroll") for (int i_ = 0; i_ < 8; ++i_) { plw[i_] = LW[(m0_ + i_) * 512 + hj]; pas[i_] = AS[(m0_ + i_) * 512 + hj]; } } while (0)
    RWC_LOAD(c_lo);
    { float run = 0.f;
#pragma unroll
      for (int i = 0; i < 8; ++i) run += bf2f(plw[i]);
      part[w0 * 64 + lane0] = run; }
    __syncthreads();
    for (int c = c_lo; c < c_hi; ++c) {
        int w = w0, lane = lane0; asm volatile("" : "+s"(w), "+v"(lane));
        const int tn_ = w & 3, tm0_ = 2 * (w >> 2);
        float off = 0.f, ctot = 0.f;
#pragma unroll
        for (int o = 0; o < 8; ++o) { const float p = part[o * 64 + lane]; ctot += p; if (o < w) off += p; }
        {   unsigned bh_[4], kh_[4], vt_[4], at_[4]; float cm = off; float* bon_g = BON + ((size_t)bh * 64 + c) * 64;
#pragma unroll
            for (int i = 0; i < 8; ++i) { const int t = 8 * w + i;
                const float p0 = bf2f(pr[i + 1]), p1 = bf2f(pk_[i + 1]), p2 = bf2f(pv[i + 1]);
                const float rv = p0 + (bf2f(pr[i]) - p0) * mu_r, kv = p1 + (bf2f(pk_[i]) - p1) * mu_k, vv = p2 + (bf2f(pv[i]) - p2) * mu_v, asg = bf2f(pas[i]);
                const float ce = cm; cm += bf2f(plw[i]);
                float kkv = kv * kkc; const float n2 = wsum64(kkv * kkv); kkv = kkv * __builtin_amdgcn_rsqf(fmaxf(n2, 1e-24f));
                const float km = kv * (1.f + (asg - 1.f) * kac); const float bn = wsum64(rv * km * rkc); if (lane == 0) bon_g[t] = bn;
                const float av = -kkv, bv = kkv * asg;
                const float e_ce = __expf(ce), e_cm = __expf(cm), e_ncm = __expf(-cm), e_rem = __expf(ctot - cm);
                const unsigned ha = pkbf(av * e_ce, 0.f) & 0xffffu; *(LAS unsigned short*)(bA + moff(t, lane)) = (unsigned short)ha; *(LAS unsigned short*)(bR + moff(t, lane)) = (unsigned short)(pkbf(rv * e_cm, 0.f) & 0xffffu);
                *(LAS unsigned short*)(bB + moff(t, lane)) = (unsigned short)(pkbf(bv * e_ncm, 0.f) & 0xffffu); *(LAS unsigned short*)(bK + moff(t, lane)) = (unsigned short)(pkbf(km * e_ncm, 0.f) & 0xffffu);
                const unsigned hb = pkbf(bv * e_rem, 0.f) & 0xffffu, hk = pkbf(km * e_rem, 0.f) & 0xffffu, hv = pkbf(vv, 0.f) & 0xffffu;
                if (i & 1) { bh_[i >> 1] |= hb << 16; kh_[i >> 1] |= hk << 16; vt_[i >> 1] |= hv << 16; at_[i >> 1] |= ha << 16; } else { bh_[i >> 1] = hb; kh_[i >> 1] = hk; vt_[i >> 1] = hv; at_[i >> 1] = ha; } }
            *(LAS v4u*)(bBH + moff(lane, 8 * w)) = (v4u){bh_[0], bh_[1], bh_[2], bh_[3]};
            *(LAS v4u*)(bKH + moff(lane, 8 * w)) = (v4u){kh_[0], kh_[1], kh_[2], kh_[3]};
            *(LAS v4u*)(bVT + moff(lane, 8 * w)) = (v4u){vt_[0], vt_[1], vt_[2], vt_[3]};
            *(LAS v4u*)(bAT + moff(lane, 8 * w)) = (v4u){at_[0], at_[1], at_[2], at_[3]};
        }
        const float dec0 = __expf(ctot);
        if (c + 1 < c_hi) RWC_LOAD(c + 1);
        __syncthreads();
        {   const int p = w >> 1; const LAS unsigned char* Am = (p < 2) ? bA : bR; const LAS unsigned char* Bm = (p == 0 || p == 2) ? bB : bK;
            const int tmb = 2 * (w & 1);
            Fr fa[2], fb[4]; f32x4 acc[2][4];
#pragma unroll
            for (int x = 0; x < 2; ++x) fa[x] = ldfr(Am, tmb + x, LO);
#pragma unroll
            for (int tn = 0; tn < 4; ++tn) fb[tn] = ldfr(Bm, tn, LO);
#pragma unroll
            for (int x = 0; x < 2; ++x)
#pragma unroll
                for (int tn = 0; tn < 4; ++tn) { acc[x][tn] = (f32x4){0.f, 0.f, 0.f, 0.f}; mmf(acc[x][tn], fa[x], fb[tn]); }
#pragma unroll
            for (int x = 0; x < 2; ++x) { const int tm = tmb + x;
#pragma unroll
                for (int tn = 0; tn < 4; ++tn) { f32x4 a = acc[x][tn];
                    const int n = 16 * tn + (lane & 15), m0 = 16 * tm + 4 * (lane >> 4);
#pragma unroll
                    for (int r = 0; r < 4; ++r) { const bool keep = (p < 2) ? (n < m0 + r) : (n <= m0 + r); if (!keep) a[r] = 0.f; }
                    if (p == 0) { st_mn(bQ0, tm, tn, LO, a); st_nm(bQT0, tm, tn, LO, a);
#pragma unroll
                        for (int r = 0; r < 4; ++r) if (n == m0 + r) a[r] += 1.f;
                        st_nm(bT, tm, tn, LO, a); }
                    else st_mn((p == 1) ? bAak : (p == 2) ? bArb : bArk, tm, tn, LO, a); } }
        }
        __syncthreads();
#pragma unroll
        for (int x = 0; x < 1; ++x) { const Fr fb = ldfr(bQT0, tn_, LO), fa0 = ldfr(bQ0, tm0_, LO), fa1 = ldfr(bQ0, tm0_ + 1, LO); f32x4 a0 = (f32x4){0.f, 0.f, 0.f, 0.f}, a1 = a0; mmf(a0, fa0, fb); mmf(a1, fa1, fb);
            st_mn(bB, tm0_, tn_, LO, a0); st_nm(bK, tm0_, tn_, LO, a0); st_mn(bB, tm0_ + 1, tn_, LO, a1); st_nm(bK, tm0_ + 1, tn_, LO, a1); }
        __syncthreads();
#pragma unroll
        for (int s = 2; s <= 5; ++s) {
            const LAS unsigned char* Qc = (s & 1) ? bQ0 : bB; const LAS unsigned char* QTc = (s & 1) ? bQT0 : bK;
            LAS unsigned char* Qn = (s & 1) ? bB : bQ0; LAS unsigned char* QTn = (s & 1) ? bK : bQT0;
            const int tn = w & 3;
            if (w >= 4) { f32x4 acc[4]; Fr fa[4]; const Fr fb = ldfr(bT, tn, LO);
#pragma unroll
                for (int tm = 0; tm < 4; ++tm) fa[tm] = ldfr(Qc, tm, LO);
#pragma unroll
                for (int tm = 0; tm < 4; ++tm) acc[tm] = ld_nm(bT, tm, tn, LO);
#pragma unroll
                for (int tm = 0; tm < 4; ++tm) mmf(acc[tm], fa[tm], fb);
#pragma unroll
                for (int tm = 0; tm < 4; ++tm) st_nm(bT, tm, tn, LO, acc[tm]);
            } else { f32x4 acc[4]; Fr fa[4]; const Fr fb = ldfr(QTc, tn, LO);
#pragma unroll
                for (int tm = 0; tm < 4; ++tm) fa[tm] = ldfr(Qc, tm, LO);
#pragma unroll
                for (int tm = 0; tm < 4; ++tm) { acc[tm] = (f32x4){0.f, 0.f, 0.f, 0.f}; mmf(acc[tm], fa[tm], fb); }
#pragma unroll
                for (int tm = 0; tm < 4; ++tm) { st_mn(Qn, tm, tn, LO, acc[tm]); st_nm(QTn, tm, tn, LO, acc[tm]); }
            }
            __syncthreads();
        }
        {
#pragma unroll
            for (int x = 0; x < 1; ++x) { const Fr fb = ldfr(bT, tn_, LO), fa0 = ldfr(bB, tm0_, LO), fa1 = ldfr(bB, tm0_ + 1, LO); f32x4 a0 = ld_nm(bT, tm0_, tn_, LO), a1 = ld_nm(bT, tm0_ + 1, tn_, LO);
                mmf(a0, fa0, fb); mmf(a1, fa1, fb); st_mn(bTF, tm0_, tn_, LO, a0); st_mn(bTF, tm0_ + 1, tn_, LO, a1); }
        }
        LAS unsigned char* bX = bB; LAS unsigned char* bW = bK; LAS unsigned char* bU = bQ0;
        __syncthreads();
#pragma unroll
        for (int x = 0; x < 1; ++x) { const Fr fv = ldfr(bVT, tn_, LO), ft = ldfr(bAT, tn_, LO), fk0 = ldfr(bAak, tm0_, LO), fk1 = ldfr(bAak, tm0_ + 1, LO), ff0 = ldfr(bTF, tm0_, LO), ff1 = ldfr(bTF, tm0_ + 1, LO);
            f32x4 x0 = (f32x4){0.f, 0.f, 0.f, 0.f}, x1 = x0, w0_ = x0, w1_ = x0; mmf(x0, fk0, fv); mmf(x1, fk1, fv); mmf(w0_, ff0, ft); mmf(w1_, ff1, ft);
            st_nm(bX, tm0_, tn_, LO, x0); st_nm(bX, tm0_ + 1, tn_, LO, x1); st_nm(bW, tm0_, tn_, LO, w0_); st_nm(bW, tm0_ + 1, tn_, LO, w1_); }
        __syncthreads();
#pragma unroll
        for (int x = 0; x < 1; ++x) { const Fr fb = ldfr(bX, tn_, LO), fa0 = ldfr(bTF, tm0_, LO), fa1 = ldfr(bTF, tm0_ + 1, LO); f32x4 a0 = (f32x4){0.f, 0.f, 0.f, 0.f}, a1 = a0; mmf(a0, fa0, fb); mmf(a1, fa1, fb);
            st_nm(bU, tm0_, tn_, LO, a0); st_nm(bU, tm0_ + 1, tn_, LO, a1); }
        __syncthreads();
        if (c + 1 < c_hi) { float run = 0.f;
#pragma unroll
          for (int i = 0; i < 8; ++i) run += bf2f(plw[i]);
          part[w * 64 + lane] = run; }
        {   unsigned char* img = IMG + ((size_t)bh * 64 + c) * (4 * MB);
            const int n_ = 16 * tn_ + (lane & 15); const float decn = __shfl(dec0, n_);
#pragma unroll
            for (int x = 0; x < 2; ++x) { const int tm = tm0_ + x; const int m0 = 16 * tm + 4 * (lane >> 4); const int go = moff(n_, m0);
                { f32x4 acc = (f32x4){0.f, 0.f, 0.f, 0.f}; mm(acc, bW, tm, bBH, tn_, LO);
#pragma unroll
                  for (int r = 0; r < 4; ++r) if (m0 + r == n_) acc[r] += decn;
                  *(GAS u32x2*)(img + 0 * MB + go) = (u32x2){pkbf(acc[0], acc[1]), pkbf(acc[2], acc[3])}; }
                { f32x4 acc = (f32x4){0.f, 0.f, 0.f, 0.f}; mm(acc, bBH, tm, bU, tn_, LO); mm(acc, bKH, tm, bVT, tn_, LO);
                  *(GAS u32x2*)(img + 1 * MB + go) = (u32x2){pkbf(acc[0], acc[1]), pkbf(acc[2], acc[3])}; }
                { f32x4 acc = ld_nm(bR, tm, tn_, LO); mm(acc, bW, tm, bArb, tn_, LO);
                  *(GAS u32x2*)(img + 2 * MB + go) = (u32x2){pkbf(acc[0], acc[1]), pkbf(acc[2], acc[3])}; }
                { f32x4 acc = (f32x4){0.f, 0.f, 0.f, 0.f}; mm(acc, bArb, tm, bU, tn_, LO); mm(acc, bArk, tm, bVT, tn_, LO);
                  *(GAS u32x2*)(img + 3 * MB + go) = (u32x2){pkbf(acc[0], acc[1]), pkbf(acc[2], acc[3])}; } }
        }
        __syncthreads();
    }
#undef RWC_LOAD
}

__device__ __forceinline__ void rwkv_seq(Frame& F, const ArgsD& A, const int bh) {
    using namespace rwk;
    const int b = bh >> 3, h = bh & 7, lane0 = lane_id_v(), w0 = F.wave;
    const LaneOff LO = lane_off(lane0);
    LAS unsigned char* L = F.lds + RING_OFF;
    LAS unsigned char* bS0 = L + 8 * MB;
    LAS float* ybuf = (LAS float*)(L + 10 * MB);
    const bf16* RW = (const bf16*)(F.ws + WS_RW); const bf16* G = (const bf16*)(F.ws + WS_G); bf16* YC = (bf16*)(F.ws + WS_YCAT);
    const unsigned char* IMG = F.ws + WS_RIMG + (size_t)bh * 64 * (4 * MB); const float* BON = (const float*)(F.ws + WS_RBON) + (size_t)bh * 64 * 64;
    const float* mu = (const float*)A.in[16]; const float* lnw_g = (const float*)A.in[25]; const float* lnb_g = (const float*)A.in[26];
    const size_t mb = (size_t)b * T;
    const int tid0 = w0 * 64 + lane0, lt0 = tid0 >> 3, hlc0 = h * 64 + (tid0 & 7) * 8;
    for (int i = tid0; i < MB / 16; i += 512) ((LAS v4u*)bS0)[i] = (v4u){0u, 0u, 0u, 0u};
    const f32x4 lw0 = *(const f32x4*)(lnw_g + hlc0), lw1 = *(const f32x4*)(lnw_g + hlc0 + 4), lb0 = *(const f32x4*)(lnb_g + hlc0), lb1 = *(const f32x4*)(lnb_g + hlc0 + 4), mv0 = *(const f32x4*)(mu + 1024 + hlc0), mv1 = *(const f32x4*)(mu + 1024 + hlc0 + 4);
    v4u pf[4][4], lvp[4], lvq[4], lgg[4]; float lbn[4];
#define RWS_LOAD(u, c) do { _Pragma("unroll") for (int k_ = 0; k_ < 4; ++k_) pf[u][k_] = *(const GAS v4u*)(IMG + (size_t)(c) * (4 * MB) + k_ * MB + tid0 * 16); \
        const size_t ml_ = mb + (size_t)(c) * 64 + lt0; lvp[u] = *(const GAS v4u*)(RW + ml_ * RWC + 1024 + hlc0); lvq[u] = *(const GAS v4u*)(RW + (ml_ - (((c) > 0 || lt0 > 0) ? 1 : 0)) * RWC + 1024 + hlc0); \
        lgg[u] = *(const GAS v4u*)(G + ml_ * 512 + hlc0); lbn[u] = BON[(c) * 64 + lt0]; } while (0)
#pragma unroll
    for (int u = 0; u < 4; ++u) RWS_LOAD(u, u);
    int scur = 0;
    for (int c4 = 0; c4 < T / 64; c4 += 4) {
#pragma unroll
      for (int u = 0; u < 4; ++u) { const int c = c4 + u;
        int w = w0, lane = lane0; asm volatile("" : "+s"(w), "+v"(lane));
        const int tid = w * 64 + lane, tn_ = w & 3, tm0_ = 2 * (w >> 2), lt = tid >> 3, lc = (tid & 7) * 8, hlc = h * 64 + lc;
        LAS unsigned char* set = L + (c & 1) * (4 * MB);
#pragma unroll
        for (int k = 0; k < 4; ++k) *(LAS v4u*)(set + k * MB + tid * 16) = pf[u][k];
        const v4u lv_p = lvp[u], lv_q = (c > 0 || lt > 0) ? lvq[u] : (v4u){0u, 0u, 0u, 0u}; const f32x4 lg0 = (f32x4){bflo(lgg[u].x), bfhi(lgg[u].x), bflo(lgg[u].y), bfhi(lgg[u].y)}, lg1 = (f32x4){bflo(lgg[u].z), bfhi(lgg[u].z), bflo(lgg[u].w), bfhi(lgg[u].w)}; const float bn = lbn[u];
        __syncthreads();
        if (c + 4 < T / 64) RWS_LOAD(u, c + 4);
        const LAS unsigned char* Sc = bS0 + scur * MB; LAS unsigned char* Sn = bS0 + (scur ^ 1) * MB;
#pragma unroll
        for (int x = 0; x < 2; ++x) { const int tm = tm0_ + x;
            { f32x4 acc = ld_nm(set + 1 * MB, tm, tn_, LO); mm(acc, set + 0 * MB, tm, Sc, tn_, LO); st_nm(Sn, tm, tn_, LO, acc); }
            { f32x4 acc = ld_nm(set + 3 * MB, tm, tn_, LO); mm(acc, set + 2 * MB, tm, Sc, tn_, LO);
              const int i = 16 * tn_ + (lane & 15), t0 = 16 * tm + 4 * (lane >> 4);
#pragma unroll
              for (int r = 0; r < 4; ++r) ybuf[(t0 + r) * 64 + i] = acc[r]; } }
        scur ^= 1;
        __syncthreads();
        {   const f32x4 y0 = *(const LAS f32x4*)(ybuf + lt * 64 + lc), y1 = *(const LAS f32x4*)(ybuf + lt * 64 + lc + 4);
            const float mean = sum8((y0.x + y0.y) + (y0.z + y0.w) + (y1.x + y1.y) + (y1.z + y1.w)) * (1.f / 64.f); const f32x4 d0 = y0 - mean, d1 = y1 - mean;
            const float var = sum8((d0.x * d0.x + d0.y * d0.y) + (d0.z * d0.z + d0.w * d0.w) + (d1.x * d1.x + d1.y * d1.y) + (d1.z * d1.z + d1.w * d1.w)) * (1.f / 64.f); const float rs = __builtin_amdgcn_rsqf(var + 64e-5f);
            f32x4 va = (f32x4){bflo(lv_p.x), bfhi(lv_p.x), bflo(lv_p.y), bfhi(lv_p.y)}, vb = (f32x4){bflo(lv_p.z), bfhi(lv_p.z), bflo(lv_p.w), bfhi(lv_p.w)};
            { const f32x4 qa = (f32x4){bflo(lv_q.x), bfhi(lv_q.x), bflo(lv_q.y), bfhi(lv_q.y)}, qb = (f32x4){bflo(lv_q.z), bfhi(lv_q.z), bflo(lv_q.w), bfhi(lv_q.w)}; va = va + (qa - va) * mv0; vb = vb + (qb - vb) * mv1; }
            const f32x4 o0 = ((d0 * rs) * lw0 + lb0 + va * bn) * lg0, o1 = ((d1 * rs) * lw1 + lb1 + vb * bn) * lg1;
            *(GAS v4u*)(YC + (mb + (size_t)c * 64 + lt) * 1024 + 512 + hlc) = (v4u){pkbf(o0.x, o0.y), pkbf(o0.z, o0.w), pkbf(o1.x, o1.y), pkbf(o1.z, o1.w)};
        }
      }
    }
#undef RWS_LOAD
}

__device__ __forceinline__ void p6_dacombine(Frame& F, const ArgsD& A) {
    const int lane = lane_id_v(), tid = F.wave * 64 + lane; (void)tid;
    const float* q1 = (const float*)A.in[11]; const float* k1 = (const float*)A.in[12]; const float* q2 = (const float*)A.in[13]; const float* k2 = (const float*)A.in[14];
    const float lam = __expf(wave_sum(q1[lane] * k1[lane])) - __expf(wave_sum(q2[lane] * k2[lane])) + 0.2f;
    const bf16* O = (const bf16*)(F.ws + WS_O); bf16* YC = (bf16*)(F.ws + WS_YCAT);
    const int gw = F.vcu * NWAVES + F.wave, NGW = F.G * NWAVES, dh = lane >> 4, d0 = 8 * (lane & 15);
    const float* sw = (const float*)A.in[15] + d0; const f32x4 swa = *(const f32x4*)sw * 0.8f, swb = *(const f32x4*)(sw + 4) * 0.8f;
    for (int m = gw; m < M; m += NGW) {
        const v4u a = *(const GAS v4u*)(O + (size_t)m * 1024 + dh * 256 + d0), c = *(const GAS v4u*)(O + (size_t)m * 1024 + dh * 256 + 128 + d0);
        f32x4 y0 = (f32x4){bflo(a.x) - lam * bflo(c.x), bfhi(a.x) - lam * bfhi(c.x), bflo(a.y) - lam * bflo(c.y), bfhi(a.y) - lam * bfhi(c.y)};
        f32x4 y1 = (f32x4){bflo(a.z) - lam * bflo(c.z), bfhi(a.z) - lam * bfhi(c.z), bflo(a.w) - lam * bflo(c.w), bfhi(a.w) - lam * bfhi(c.w)};
        float s2 = (y0.x * y0.x + y0.y * y0.y) + (y0.z * y0.z + y0.w * y0.w) + (y1.x * y1.x + y1.y * y1.y) + (y1.z * y1.z + y1.w * y1.w);
        s2 = allsum16(s2); const float rs = 1.f / sqrtf(s2 * (1.f / 128.f) + 1e-5f);
        y0 = y0 * rs * swa; y1 = y1 * rs * swb;
        *(GAS v4u*)(YC + (size_t)m * 1024 + dh * 128 + d0) = (v4u){pkbf(y0.x, y0.y), pkbf(y0.z, y0.w), pkbf(y1.x, y1.y), pkbf(y1.z, y1.w)}; }
}

#define P9_SWAP32(a, b) do { const auto r_ = __builtin_amdgcn_permlane32_swap(__float_as_uint(a), __float_as_uint(b), false, false); (a) = __uint_as_float(r_[0]) + __uint_as_float(r_[1]); } while (0)
#define P9_SWAP16(a, b) do { const auto r_ = __builtin_amdgcn_permlane16_swap(__float_as_uint(a), __float_as_uint(b), false, false); (a) = __uint_as_float(r_[0]) + __uint_as_float(r_[1]); } while (0)
#define P9_DPPF(x, ctrl) __builtin_bit_cast(float, __builtin_amdgcn_update_dpp(0, __builtin_bit_cast(int, (x)), (ctrl), 0xF, 0xF, true))
#define P9_DPPU(x, ctrl) ((unsigned)__builtin_amdgcn_update_dpp(0, (int)(x), (ctrl), 0xF, 0xF, true))
__device__ __forceinline__ float p9_reduce32(float (&a)[32], const int lane) {
#pragma unroll
    for (int e = 0; e < 16; ++e) P9_SWAP32(a[e], a[e + 16]);
#pragma unroll
    for (int e = 0; e < 8; ++e) P9_SWAP16(a[e], a[e + 8]);
    const bool b3 = (lane & 8) != 0, b2 = (lane & 4) != 0, b0 = (lane & 1) != 0;
#pragma unroll
    for (int e = 0; e < 4; ++e) { const float keep = b3 ? a[e + 4] : a[e], send = b3 ? a[e] : a[e + 4]; a[e] = keep + P9_DPPF(send, 0x128); }
#pragma unroll
    for (int e = 0; e < 2; ++e) { const float keep = b2 ? a[e + 2] : a[e], send = b2 ? a[e] : a[e + 2]; a[e] = keep + P9_DPPF(send, 0x141); }
    { const float keep = b0 ? a[1] : a[0], send = b0 ? a[0] : a[1]; a[0] = keep + P9_DPPF(send, 0xB1); }
    return a[0] + P9_DPPF(a[0], 0x4E);
}
__device__ __forceinline__ unsigned p9_wmax(unsigned v) {
    v = max(v, P9_DPPU(v, 0xB1)); v = max(v, P9_DPPU(v, 0x4E)); v = max(v, P9_DPPU(v, 0x124)); v = max(v, P9_DPPU(v, 0x128));
    const unsigned s0 = __builtin_amdgcn_readlane(v, 0), s1 = __builtin_amdgcn_readlane(v, 16), s2 = __builtin_amdgcn_readlane(v, 32), s3 = __builtin_amdgcn_readlane(v, 48);
    return max(max(s0, s1), max(s2, s3)); }
__device__ __forceinline__ unsigned p9_hmax32(unsigned v) {
    v = max(v, P9_DPPU(v, 0xB1)); v = max(v, P9_DPPU(v, 0x4E)); v = max(v, P9_DPPU(v, 0x124)); v = max(v, P9_DPPU(v, 0x128));
    const auto r_ = __builtin_amdgcn_permlane16_swap(v, v, false, false); return max(r_[0], r_[1]); }
__device__ __forceinline__ void p8_postmix_router(Frame& F, const ArgsD& A, const int cset) {
    typedef rwk::bf16x8 bf16x8;
    const int lane = lane_id_v(), wv = F.wave, tid = wv * 64 + lane;
    LAS unsigned char* tileH = F.lds + RING_OFF;
    LAS float* red = (LAS float*)(F.lds + RING_OFF + 65536);
    volatile LAS int* lcnt = (volatile LAS int*)(F.lds + LDSCTL_OFF);
    if (tid < 32) lcnt[tid] = 0;
    bf16x8 bh[2][4], bl[2][4];
    { const float* r = (const float*)A.in[27];
#pragma unroll
      for (int nt = 0; nt < 2; ++nt)
#pragma unroll
        for (int ks = 0; ks < 4; ++ks) { const float* rp = r + (size_t)(128 * wv + 32 * ks + 8 * (lane >> 4)) * 32 + 16 * nt + (lane & 15);
            float w_[8];
#pragma unroll
            for (int q = 0; q < 8; ++q) w_[q] = rp[q * 32];
            v4u h, l;
            h.x = pkbf(w_[0], w_[1]); h.y = pkbf(w_[2], w_[3]); h.z = pkbf(w_[4], w_[5]); h.w = pkbf(w_[6], w_[7]);
            l.x = pkbf(w_[0] - bflo(h.x), w_[1] - bfhi(h.x)); l.y = pkbf(w_[2] - bflo(h.y), w_[3] - bfhi(h.y)); l.z = pkbf(w_[4] - bflo(h.z), w_[5] - bfhi(h.z)); l.w = pkbf(w_[6] - bflo(h.w), w_[7] - bfhi(h.w));
            bh[nt][ks] = __builtin_bit_cast(bf16x8, h); bl[nt][ks] = __builtin_bit_cast(bf16x8, l); } }
    __syncthreads();
    const float* x = (const float*)A.in[0]; const bf16* Y = (const bf16*)(F.ws + WS_Y); const float* mod = (const float*)(F.ws + WS_MOD);
    const float* pmn = (const float*)A.in[6]; const float* pfn = (const float*)A.in[7]; const float* rb = (const float*)A.in[28];
    unsigned char* H2 = F.ws + WS_H2; int* tokE = (int*)(F.ws + WS_TOKE); float* tokG = (float*)(F.ws + WS_TOKG);
    const int rows_per = M / F.G, mbeg = F.vcu * rows_per, b = mbeg >> 12; const float* mb_ = mod + (size_t)b * NMOD;
    f32x4 a1[4], a2[4], sh[4];
#pragma unroll
    for (int j = 0; j < 4; ++j) { const int col = 4 * lane + 256 * j; a1[j] = *(const f32x4*)(pmn + col) * *(const f32x4*)(mb_ + 2048 + col); a2[j] = *(const f32x4*)(pfn + col) * (*(const f32x4*)(mb_ + 4096 + col) + 1.f); sh[j] = *(const f32x4*)(mb_ + 3072 + col); }
    const float rbias = rb[lane & 31];
    const int nr = rows_per / NWAVES, m0 = mbeg + wv * nr;
    u32x2 yp[2][4]; f32x4 xp[2][4];
#define P9_LOAD(m_) do { _Pragma("unroll") for (int t_ = 0; t_ < 2; ++t_) _Pragma("unroll") for (int j_ = 0; j_ < 4; ++j_) { \
        yp[t_][j_] = *((const GAS u32x2*)(Y + (size_t)((m_) + t_) * D) + lane + 64 * j_); xp[t_][j_] = *((const GAS f32x4*)(x + (size_t)((m_) + t_) * D) + lane + 64 * j_); } } while (0)
    P9_LOAD(m0);
    for (int i = 0; i < nr; i += 2) { const int m = m0 + i;
#pragma unroll
        for (int t = 0; t < 2; ++t) { f32x4 yv[4], xv[4]; float s2 = 0.f;
#pragma unroll
            for (int j = 0; j < 4; ++j) { const u32x2 p = yp[t][j]; yv[j] = (f32x4){bflo(p.x), bfhi(p.x), bflo(p.y), bfhi(p.y)}; s2 += (yv[j].x * yv[j].x + yv[j].y * yv[j].y) + (yv[j].z * yv[j].z + yv[j].w * yv[j].w); }
            const float rs = __builtin_amdgcn_rsqf(rwk::wsum64(s2) * (1.f / D) + 1e-6f); float t2 = 0.f;
#pragma unroll
            for (int j = 0; j < 4; ++j) { xv[j] = xp[t][j] + a1[j] * (yv[j] * rs); *((GAS f32x4*)(F.out + (size_t)(m + t) * D) + lane + 64 * j) = xv[j];
                t2 += (xv[j].x * xv[j].x + xv[j].y * xv[j].y) + (xv[j].z * xv[j].z + xv[j].w * xv[j].w); }
            const float rs2 = __builtin_amdgcn_rsqf(rwk::wsum64(t2) * (1.f / D) + 1e-6f);
            const int r = 2 * wv + t;
#pragma unroll
            for (int j = 0; j < 4; ++j) { const f32x4 v = xv[j] * rs2 * a2[j] + sh[j]; *((GAS unsigned*)(H2 + (size_t)(m + t) * D) + lane + 64 * j) = pg8::pk4_fp8(v.x, v.y, v.z, v.w);
                const unsigned h0 = pkbf(v.x, v.y), h1 = pkbf(v.z, v.w), l0 = pkbf(v.x - bflo(h0), v.y - bfhi(h0)), l1 = pkbf(v.z - bflo(h1), v.w - bfhi(h1));
                const int off = r * 2048 + ((((lane >> 1) + 32 * j) ^ r) << 4) + (lane & 1) * 8;
                *(LAS u32x2*)(tileH + off) = (u32x2){h0, h1}; *(LAS u32x2*)(tileH + 32768 + off) = (u32x2){l0, l1}; } }
        if (i + 2 < nr) P9_LOAD(m + 2);
        __syncthreads();
        {   f32x4 acc[2] = {(f32x4){0.f, 0.f, 0.f, 0.f}, (f32x4){0.f, 0.f, 0.f, 0.f}};
#pragma unroll
            for (int ks = 0; ks < 4; ++ks) { const int r = lane & 15, off = r * 2048 + (((16 * wv + 4 * ks + (lane >> 4)) ^ r) << 4);
                const bf16x8 ah = *(const LAS bf16x8*)(tileH + off), al = *(const LAS bf16x8*)(tileH + 32768 + off);
#pragma unroll
                for (int nt = 0; nt < 2; ++nt) { acc[nt] = __builtin_amdgcn_mfma_f32_16x16x32_bf16(al, bl[nt][ks], acc[nt], 0, 0, 0); acc[nt] = __builtin_amdgcn_mfma_f32_16x16x32_bf16(al, bh[nt][ks], acc[nt], 0, 0, 0);
                    acc[nt] = __builtin_amdgcn_mfma_f32_16x16x32_bf16(ah, bl[nt][ks], acc[nt], 0, 0, 0); acc[nt] = __builtin_amdgcn_mfma_f32_16x16x32_bf16(ah, bh[nt][ks], acc[nt], 0, 0, 0); } }
#pragma unroll
            for (int nt = 0; nt < 2; ++nt)
#pragma unroll
                for (int rr = 0; rr < 4; ++rr) red[(wv * 16 + 4 * (lane >> 4) + rr) * 32 + 16 * nt + (lane & 15)] = acc[nt][rr]; }
        __syncthreads();
        {   const int t = lane >> 5, e = lane & 31; float lg = rbias;
#pragma unroll
            for (int w8 = 0; w8 < 8; ++w8) lg += red[(w8 * 16 + 2 * wv + t) * 32 + e];
            const unsigned u = __float_as_uint(lg); unsigned key = (((u >> 31) ? ~u : (u | 0x80000000u)) & ~31u) | (unsigned)(31 - e);
            float tv[4]; int ti[4];
#pragma unroll
            for (int k = 0; k < 4; ++k) { const unsigned mx = p9_hmax32(key); ti[k] = 31 - (int)(mx & 31u); const unsigned kv = mx & ~31u; tv[k] = __uint_as_float((kv >> 31) ? (kv & 0x7fffffffu) : ~kv); if (key == mx) key = 0u; }
            float ew[4], es = 0.f;
#pragma unroll
            for (int k = 0; k < 4; ++k) { ew[k] = __expf(tv[k] - tv[0]); es += ew[k]; }
            if (e < 4) { const int ex = (e == 0) ? ti[0] : (e == 1) ? ti[1] : (e == 2) ? ti[2] : ti[3]; const float g = ((e == 0) ? ew[0] : (e == 1) ? ew[1] : (e == 2) ? ew[2] : ew[3]) / es;
                const int pos = __hip_atomic_fetch_add((LAS int*)lcnt + ex, 1, __ATOMIC_RELAXED, __HIP_MEMORY_SCOPE_WORKGROUP);
                tokE[(size_t)(m + t) * 4 + e] = ex | (pos << 8); tokG[(size_t)(m + t) * 4 + e] = g; } }
    }
#undef P9_LOAD
    __syncthreads();
    if (tid < 32) { const int n = lcnt[tid]; int base = 0; if (n > 0) base = (int)__hip_atomic_fetch_add(F.ctl + CW_ECNT + cset * 64 * NEXP + 64 * tid, (unsigned)n, __ATOMIC_RELAXED, __HIP_MEMORY_SCOPE_AGENT);
        ((int*)(F.ws + WS_BLKBASE))[F.vcu * 32 + tid] = base; }
}

__device__ __forceinline__ void moe_tables(Frame& F) {
    const int lane = lane_id_v(), tid = F.wave * 64 + lane; (void)tid;
    volatile LAS int* ts = (volatile LAS int*)(F.lds + LDSCTL_OFF);
    if (tid < 32) ts[40 + tid] = (int)__hip_atomic_load(F.ctl + CW_ECNT + 64 * tid, __ATOMIC_RELAXED, __HIP_MEMORY_SCOPE_AGENT);
    __syncthreads();
    if (tid == 0) { int acc = 0; for (int e = 0; e < 32; ++e) { ts[e] = acc; acc += (ts[40 + e] + 255) >> 8; } ts[32] = acc; }
    __syncthreads();
}
__device__ __forceinline__ void p9_rows(Frame& F) {
    const int lane = lane_id_v(), tid = F.wave * 64 + lane; (void)tid;
    moe_tables(F);
    volatile LAS int* ts = (volatile LAS int*)(F.lds + LDSCTL_OFF);
    const int* tokE = (const int*)(F.ws + WS_TOKE); const float* tokG = (const float*)(F.ws + WS_TOKG); const int* blkbase = (const int*)(F.ws + WS_BLKBASE) + F.vcu * 32;
    int* tokrow = (int*)(F.ws + WS_TOKROW); int* rowtok = (int*)(F.ws + WS_ROWTOK); float* rowgate = (float*)(F.ws + WS_ROWGATE);
    const int rows_per = M / F.G, mbeg = F.vcu * rows_per;
    for (int i = tid; i < rows_per * 4; i += 512) { const int idx = mbeg * 4 + i; const int pe = tokE[idx], e = pe & 255, pos = pe >> 8; const int row = ts[e] * 256 + blkbase[e] + pos;
        tokrow[idx] = row; rowtok[row] = idx >> 2; rowgate[row] = tokG[idx]; }
    for (int e = F.vcu; e < 32; e += F.G) { const int n = ts[40 + e]; const int r0 = ts[e] * 256 + n, r1 = ts[e + 1] * 256;
        for (int r = r0 + tid; r < r1; r += 512) { rowtok[r] = 0; rowgate[r] = 0.f; } }
}

__device__ __forceinline__ void p12_final(Frame& F, const ArgsD& A, float* dst) {
    const int lane = lane_id_v(), tid = F.wave * 64 + lane; (void)tid;
    const unsigned char* Y2 = F.ws + WS_Y2; const int* tokrow = (const int*)(F.ws + WS_TOKROW); const float* mod = (const float*)(F.ws + WS_MOD); const float* pn = (const float*)A.in[8];
    const int rows_per = M / F.G, mbeg = F.vcu * rows_per, b = mbeg >> 12, nr = rows_per / NWAVES, m0 = mbeg + F.wave * nr;
    const float* mb_ = mod + (size_t)b * NMOD + 5120;
    f32x4 gw[4];
#pragma unroll
    for (int j = 0; j < 4; ++j) { const int col = 4 * lane + 256 * j; gw[j] = *(const f32x4*)(pn + col) * *(const f32x4*)(mb_ + col); }
    const int myrow = tokrow[(size_t)m0 * 4 + (lane < nr * 4 ? lane : 0)];
    unsigned yp[4][4]; f32x4 xp[4];
#define P13_LOAD(i_) do { _Pragma("unroll") for (int k_ = 0; k_ < 4; ++k_) { const int row_ = __builtin_amdgcn_readlane(myrow, 4 * (i_) + k_); \
        _Pragma("unroll") for (int j_ = 0; j_ < 4; ++j_) yp[k_][j_] = *((const GAS unsigned*)(Y2 + (size_t)row_ * D) + lane + 64 * j_); } \
        _Pragma("unroll") for (int j_ = 0; j_ < 4; ++j_) xp[j_] = *((const GAS f32x4*)(F.out + (size_t)(m0 + (i_)) * D) + lane + 64 * j_); } while (0)
    P13_LOAD(0);
#pragma unroll 1
    for (int i = 0; i < nr; ++i) { const int m = m0 + i;
        f32x4 a[4], xv[4]; float s2 = 0.f;
#pragma unroll
        for (int j = 0; j < 4; ++j) { a[j] = (f32x4){0.f, 0.f, 0.f, 0.f};
#pragma unroll
            for (int k = 0; k < 4; ++k) { const unsigned p = yp[k][j]; const f32x2 lo = __builtin_amdgcn_cvt_pk_f32_fp8((int)p, false), hi = __builtin_amdgcn_cvt_pk_f32_fp8((int)p, true); a[j] = a[j] + (f32x4){lo.x, lo.y, hi.x, hi.y}; }
            a[j] = a[j] * pg8::Y8_INV;
            s2 += (a[j].x * a[j].x + a[j].y * a[j].y) + (a[j].z * a[j].z + a[j].w * a[j].w); xv[j] = xp[j]; }
        if (i + 1 < nr) { const int in_ = __builtin_amdgcn_readfirstlane(i + 1);
#pragma unroll
            for (int k_ = 0; k_ < 4; ++k_) { const int row_ = __shfl(myrow, 4 * in_ + k_);
#pragma unroll
                for (int j_ = 0; j_ < 4; ++j_) yp[k_][j_] = *((const GAS unsigned*)(Y2 + (size_t)row_ * D) + lane + 64 * j_); }
#pragma unroll
            for (int j_ = 0; j_ < 4; ++j_) xp[j_] = *((const GAS f32x4*)(F.out + (size_t)(m + 1) * D) + lane + 64 * j_); }
        const float rs = __builtin_amdgcn_rsqf(wave_sum(s2) * (1.f / D) + 1e-6f);
#pragma unroll
        for (int j = 0; j < 4; ++j) *((GAS f32x4*)(dst + (size_t)m * D) + lane + 64 * j) = xv[j] + gw[j] * (a[j] * rs); }
#undef P13_LOAD
}
__global__ void __launch_bounds__(NWAVES * 64, 2) hybrid_fwd(Args kargs) {
    const ArgsD args{};
    extern __shared__ __attribute__((aligned(16))) unsigned char lds[];
    Frame F;
    F.lds = (LAS unsigned char*)lds;
    F.MISC = (volatile LAS unsigned*)(F.lds + MISC_OFF);
    F.wave = __builtin_amdgcn_readfirstlane((int)threadIdx.x >> 6);
    F.G = gridDim.x; { const int bx = blockIdx.x; F.vcu = (F.G % 8 == 0) ? (bx % 8) * (F.G / 8) + bx / 8 : bx; }
    F.ws = kargs.ws; F.out = kargs.out;
    unsigned char* ws = kargs.ws;
    F.ctl = (gu32*)(ws + WS_CTL);
#define GRID_BAR(seam) do { if (N_LAUNCHES != 1) { if (F.wave == 0 && lane_id_v() == 0) __hip_atomic_store(F.ctl + CW_TMO, 0xBADBA0u | (unsigned)(seam), RLX_AGENT); } else { xcd_barrier(bar); } } while (0)
    for (int u = threadIdx.x; u < (LDS_BYTES - LDSCTL_OFF) / 4; u += NWAVES * 64) ((LAS unsigned*)(F.lds + LDSCTL_OFF))[u] = 0u;
    __syncthreads();
    XcdBarrier bar; bar.bar = (unsigned*)(F.ctl + CW_BAR); bar.x = 0; bar.st = nullptr; bar.wid = F.wave;
    if (N_LAUNCHES == 1) bar = xcd_barrier_post((unsigned*)(F.ctl + CW_BAR), F.MISC + 8, F.wave);
    const int lo = kargs.ph_lo, hi = kargs.ph_hi;
#define IN(k) (lo <= (k) && (k) < hi)
#define PREP(k) (((PROBE_MASK) >> (k)) & 1)
#define BOTH(k) (IN(k) && IN((k) + 1))
    bf16* const H = (bf16*)(ws + WS_H); bf16* const H2 = (bf16*)(ws + WS_H2);

    if (IN(0)) { _Pragma("unroll 1") for (int r_ = 0; r_ <= PREP(0); ++r_) { p0_prologue(F, args); } if (BOTH(0)) GRID_BAR(0); }
    if (IN(1)) { _Pragma("unroll 1") for (int r_ = 0; r_ <= PREP(1); ++r_) { p1_premix(F, args); } if (BOTH(1)) GRID_BAR(1); }
    if (IN(2)) {
        pg8::Gemm g{H, (const bf16*)(ws + WS_WIN), M, IN_COLS, D, 0, nullptr, ws}; pg8::StaticOrder S; S.init(M, IN_COLS, F.G, (int)blockIdx.x);
        pg8::EpiProj E{(bf16*)(ws + WS_Q), (bf16*)(ws + WS_K), (bf16*)(ws + WS_V), (bf16*)(ws + WS_RW), (const float*)(ws + WS_ROPE), attn_body::C2};
        if (PREP(2)) { pg8::gemm_phase<pg8::EpiProj, pg8::StaticOrder, true, true, false>(F.lds + RING_OFF, g, S, E, F.wave); GRID_BAR(102); }
        pg8::gemm_phase<pg8::EpiProj, pg8::StaticOrder, true, true, false>(F.lds + RING_OFF, g, S, E, F.wave);
        if (BOTH(2)) GRID_BAR(2);
    }
    if (IN(3)) { _Pragma("unroll 1") for (int r_ = 0; r_ <= PREP(3); ++r_) { p3_lact(F, args); } if (BOTH(3)) GRID_BAR(3); }
    if (IN(4)) {
        pg8::Gemm g{(const bf16*)(ws + WS_LACT), (const bf16*)(ws + WS_BLORA), M, 1536, 256, 0, nullptr, ws}; pg8::StaticOrder S; S.init(M, 1536, F.G, (int)blockIdx.x);
        pg8::EpiLora E{(bf16*)(ws + WS_LW), (size_t)(WS_AS - WS_LW) / 2, (const float*)args.in[17], (const float*)args.in[19]}; static_assert(WS_G - WS_AS == WS_AS - WS_LW, "LW | AS | G equally spaced");
        if (PREP(4)) { pg8::gemm_phase<pg8::EpiLora, pg8::StaticOrder, true, true, false>(F.lds + RING_OFF, g, S, E, F.wave); GRID_BAR(104); }
        pg8::gemm_phase<pg8::EpiLora, pg8::StaticOrder, true, true, false>(F.lds + RING_OFF, g, S, E, F.wave);
        if (BOTH(4)) GRID_BAR(4);
    }
    if (IN(5)) {
        _Pragma("unroll 1") for (int r_ = 0; r_ <= PREP(5); ++r_)
            for (int u = F.vcu; u < BATCH * 8 * 4; u += F.G) rwkv_pre(F, args, u >> 2, (u & 3) * 16, (u & 3) * 16 + 16);
        if (BOTH(5)) GRID_BAR(5);
    }
    if (IN(6)) {
        _Pragma("unroll 1") for (int r_ = 0; r_ <= PREP(14); ++r_)
            for (int bh = blockIdx.x; bh < BATCH * 8; bh += F.G) rwkv_seq(F, args, bh);
        static_assert(attn_body::ATTN_LDS_BYTES <= RING_BYTES, "attention body geometry vs frame");
        const attn_body::AttnTensors AT{(const attn_body::bf16*)(ws + WS_Q), (const attn_body::bf16*)(ws + WS_K), (const attn_body::bf16*)(ws + WS_V), (attn_body::bf16*)(ws + WS_O)};
        if (PREP(15)) { const attn_body::QueueOrder S0{(unsigned*)(F.ctl + CW_ATTQ + 64), F.MISC + 12, F.wave}; attn_body::attn_phase<attn_body::QueueOrder>((char*)lds + RING_OFF, AT, S0, F.wave); GRID_BAR(106); }
        const attn_body::QueueOrder S{(unsigned*)(F.ctl + CW_ATTQ), F.MISC + 12, F.wave};
        attn_body::attn_phase<attn_body::QueueOrder>((char*)lds + RING_OFF, AT, S, F.wave);
        if (BOTH(6)) GRID_BAR(6);
    }
    if (IN(7)) { _Pragma("unroll 1") for (int r_ = 0; r_ <= PREP(7); ++r_) { p6_dacombine(F, args); } if (BOTH(7)) GRID_BAR(7); }
    if (IN(8)) {
        pg8::Gemm g{(const bf16*)(ws + WS_YCAT), (const bf16*)(ws + WS_WOUT), M, D, D, 0, nullptr, ws}; pg8::StaticOrder S; S.init(M, D, F.G, (int)blockIdx.x);
        pg8::EpiPlain E{(bf16*)(ws + WS_Y), D};
        if (PREP(8)) { pg8::gemm_phase<pg8::EpiPlain, pg8::StaticOrder, true, true, false>(F.lds + RING_OFF, g, S, E, F.wave); GRID_BAR(108); }
        pg8::gemm_phase<pg8::EpiPlain, pg8::StaticOrder, true, true, false>(F.lds + RING_OFF, g, S, E, F.wave);
        if (BOTH(8)) GRID_BAR(8);
    }
    if (IN(9)) { _Pragma("unroll 1") for (int r_ = PREP(9); r_ >= 0; --r_) { p8_postmix_router(F, args, r_); } if (BOTH(9)) GRID_BAR(9); }
    if (IN(10)) { _Pragma("unroll 1") for (int r_ = 0; r_ <= PREP(10); ++r_) { p9_rows(F); } if (BOTH(10)) GRID_BAR(10); }
    if (IN(11)) {
        moe_tables(F);
        const LAS int* ts = (const LAS int*)(F.lds + LDSCTL_OFF);
        pg8::Gemm g{H2, (const bf16*)(ws + WS_W1), MAXROWS, 2048, D / 2, (size_t)2048 * D, (const int*)(ws + WS_ROWTOK), ws};
        pg8::MoeOrder S{__builtin_amdgcn_readfirstlane(ts[32]), 8, 4, F.G, F.vcu, ts};
        pg8::EpiSwiglu E{ws + WS_ACT, (const float*)args.in[30]};
        if (PREP(11)) { pg8::gemm_phase<pg8::EpiSwiglu, pg8::MoeOrder, true, true, true, true>(F.lds + RING_OFF, g, S, E, F.wave); GRID_BAR(111); }
        pg8::gemm_phase<pg8::EpiSwiglu, pg8::MoeOrder, true, true, true, true>(F.lds + RING_OFF, g, S, E, F.wave);
        if (BOTH(11)) GRID_BAR(11);
    }
    if (IN(12)) {
        moe_tables(F);
        const LAS int* ts = (const LAS int*)(F.lds + LDSCTL_OFF);
        pg8::Gemm g{(const bf16*)(ws + WS_ACT), (const bf16*)(ws + WS_W2), MAXROWS, D, D / 2, (size_t)D * D, nullptr, ws};
        pg8::MoeOrder S{__builtin_amdgcn_readfirstlane(ts[32]), 4, 8, F.G, F.vcu, ts};
        pg8::EpiMoe2 E{ws + WS_Y2, (const float*)args.in[32], (const float*)(ws + WS_ROWGATE)};
        if (PREP(12)) { pg8::gemm_phase<pg8::EpiMoe2, pg8::MoeOrder, true, true, false, true>(F.lds + RING_OFF, g, S, E, F.wave); GRID_BAR(112); }
        pg8::gemm_phase<pg8::EpiMoe2, pg8::MoeOrder, true, true, false, true>(F.lds + RING_OFF, g, S, E, F.wave);
        if (BOTH(12)) GRID_BAR(12);
    }
    if (IN(13)) { _Pragma("unroll 1") for (int r_ = PREP(13); r_ >= 0; --r_) { p12_final(F, args, r_ ? (float*)(ws + WS_G) : F.out); } }
#undef IN
#undef PREP
#undef BOTH
}

extern "C" void kernel_launch(void* const* d_in, const int* in_sizes, int n_in, void* d_out, int out_size, void* d_ws, size_t ws_size, hipStream_t stream) {
    static int grid = 0;
    if (grid == 0) {
        if (n_in != 33 || in_sizes[0] != M * D || out_size != M * D || ws_size < WS_END) { fprintf(stderr, "kernel_launch: built for 33 inputs, x and out of %d floats, >= %zu bytes of workspace; got n_in %d, in0 %d, out %d, ws %zu; nothing launched\n", M * D, (size_t)WS_END, n_in, n_in > 0 ? in_sizes[0] : -1, out_size, ws_size); grid = -1; return; }
        int dev = 0, cus = 0, per_cu = 0;
        if (hipGetDevice(&dev) != hipSuccess || hipDeviceGetAttribute(&cus, hipDeviceAttributeMultiprocessorCount, dev) != hipSuccess) { fprintf(stderr, "kernel_launch: hipGetDevice / hipDeviceGetAttribute failed; nothing launched\n"); grid = -1; return; }
        if (hipFuncSetAttribute((const void*)hybrid_fwd, hipFuncAttributeMaxDynamicSharedMemorySize, LDS_BYTES) != hipSuccess) { fprintf(stderr, "kernel_launch: hipFuncSetAttribute failed; nothing launched\n"); grid = -1; return; }
        if (hipOccupancyMaxActiveBlocksPerMultiprocessor(&per_cu, (const void*)hybrid_fwd, NWAVES * 64, LDS_BYTES) != hipSuccess || per_cu < 1)
            fprintf(stderr, "kernel_launch: note: the occupancy query reports %d workgroups per CU\n", per_cu);
        (void)hipGetLastError();
        grid = (cus >= 256) ? 256 : (cus / 32) * 32;
        if (grid != 256) fprintf(stderr, "kernel_launch: launching %d workgroups (built and checked for 256)\n", grid);
    }
    if (grid <= 0) return;
    if (hipMemsetAsync((char*)d_ws + WS_CTL, 0, CTL_ZERO_BYTES, stream) != hipSuccess) { fprintf(stderr, "kernel_launch: hipMemsetAsync of the control words failed; nothing launched\n"); return; }
    Args a{};
    for (int i = 0; i < 33; ++i) a.in[i] = d_in[i];
    a.out = (float*)d_out; a.ws = (unsigned char*)d_ws;
    for (int li = 0; li < N_LAUNCHES; ++li) {
        a.ph_lo = (N_LAUNCHES == 1) ? 0 : li; a.ph_hi = (N_LAUNCHES == 1) ? N_PHASES : li + 1; a.li = li; a.pad = 0;
        hipLaunchKernelGGL(hybrid_fwd, dim3(grid), dim3(NWAVES * 64), LDS_BYTES, stream, a);
        const hipError_t le = hipPeekAtLastError();
        if (le != hipSuccess) { fprintf(stderr, "kernel_launch: launch %d failed: %s\n", li, hipGetErrorName(le)); break; }
    }
}
```

```cpp
#include <hip/hip_runtime.h>
#include <cstdio>
#include <cstdint>
__device__ __forceinline__ int lane_id_v() { int l; asm volatile("v_mbcnt_lo_u32_b32 %0, -1, 0\n\tv_mbcnt_hi_u32_b32 %0, -1, %0" : "=v"(l)); return l; }
namespace pg8 {
#define PG8_LAS __attribute__((address_space(3)))
typedef unsigned short bf16_t;
typedef short bf16x8 __attribute__((ext_vector_type(8)));
typedef float f32x4 __attribute__((ext_vector_type(4)));
typedef unsigned u32x4 __attribute__((ext_vector_type(4)));
typedef int v4i_t __attribute__((ext_vector_type(4)));
typedef int v8i_t __attribute__((ext_vector_type(8)));
typedef v8i_t v8i_a16 __attribute__((aligned(16)));
union frag2_t { bf16x8 pc[2]; v8i_t w; };
constexpr int BM = 256, BK = 64, HALF = 128, HTB = HALF * BK * 2  , STAGE_BYTES = 8 * HTB, NXCD = 8, WGM = 8;

__host__ __device__ __forceinline__ int lds_byte(int r, int c) { const int st = (r >> 4) * 2 + (c >> 5), rr = r & 15, cc = c & 31, ob = rr * 64 + cc * 2; return st * 1024 + (ob ^ (((ob >> 9) & 1) << 5)); }
__host__ __device__ __forceinline__ void stage_rc(int b, int& R, int& C) { const int st = b / 1024, sb = b % 1024, swz = sb ^ (((sb >> 9) & 1) << 5); R = (st >> 1) * 16 + swz / 64; C = (st & 1) * 32 + (swz % 64) / 2; }
__host__ __device__ __forceinline__ int perm32(int rho) { const int n = rho >> 4, i = rho & 15; return 8 * (i >> 2) + 4 * n + (i & 3); }

struct Unit { int pm, pn, e; };
struct Gemm { const bf16_t* A; const bf16_t* Bt; int M, N, K; size_t bstride; const int* rowidx; const void* base; };

struct StaticOrder {
    int nM, nN, nwg, G, c;
    __host__ __device__ void init(int M, int N, int G_, int c_) { nM = M / BM; nN = N / BM; nwg = nM * nN; G = G_; c = c_; }
    __host__ __device__ bool next(int i, Unit& u) const {
        const long L = (long)i * G + c; if (L >= nwg) return false;
        int wgid = (int)L; { const int q = nwg / NXCD, r = nwg % NXCD, xcd = wgid % NXCD, off = wgid / NXCD; wgid = (xcd < r ? xcd * (q + 1) : r * (q + 1) + (xcd - r) * q) + off; }
        const int nig = WGM * nN, gid = wgid / nig, fm = gid * WGM, gsz = (nM - fm) < WGM ? (nM - fm) : WGM;
        u.pm = fm + ((wgid % nig) % gsz); u.pn = (wgid % nig) / gsz; u.e = 0; return true;
    }
    __device__ __forceinline__ void a_ready(const Unit&) const {}
    __device__ __forceinline__ void done(const Unit&) const {}
};

__device__ __forceinline__ unsigned cvt_pk_bf16(float lo, float hi) { unsigned r; asm volatile("v_cvt_pk_bf16_f32 %0, %1, %2" : "=v"(r) : "v"(lo), "v"(hi)); return r; }
typedef float f32x2 __attribute__((ext_vector_type(2)));
typedef unsigned u32x2 __attribute__((ext_vector_type(2)));
__device__ __forceinline__ float sigmoidf_(float x) { return __builtin_amdgcn_rcpf(1.f + __expf(-x)); }

struct MoeOrder {
    int ntiles, nN, RG, G, c; const PG8_LAS int* tstart;
    __device__ __forceinline__ bool next(int i, Unit& u) const {
        const int L = i * G + c, grp = L >> 5, idx = L & 31; u.pn = idx / RG; u.pm = grp * RG + idx % RG; u.e = 0;
        if (u.pm >= ntiles) return false;
        int e = 0;
#pragma unroll
        for (int k = 16; k >= 1; k >>= 1) { if (tstart[e + k] <= u.pm) e += k; }
        u.e = __builtin_amdgcn_readfirstlane(e); return true;
    }
    __device__ __forceinline__ void a_ready(const Unit&) const {}
    __device__ __forceinline__ void done(const Unit&) const {}
};

#define PG8_PACK8(v0, v1) (u32x4){cvt_pk_bf16((v0)[0], (v0)[1]), cvt_pk_bf16((v0)[2], (v0)[3]), cvt_pk_bf16((v1)[0], (v1)[1]), cvt_pk_bf16((v1)[2], (v1)[3])}

struct EpiPlain {
    static constexpr bool PERM = true, AFTER_DRAIN = false;
    bf16_t* O; int ldc;
    __device__ __forceinline__ void operator()(const f32x4 (&acc)[2][2][4][2], const Unit& u, int wr, int wc, int fr, int fq) const {
        const int row0 = u.pm * BM + wr * 64 + fr, col0 = u.pn * BM + wc * 32 + 8 * fq;
#pragma unroll
        for (int ai = 0; ai < 2; ++ai)
#pragma unroll
            for (int m = 0; m < 4; ++m) { bf16_t* rowp = O + (size_t)(row0 + ai * HALF + m * 16) * ldc + col0;
#pragma unroll
                for (int bj = 0; bj < 2; ++bj) { const f32x4 v0 = acc[ai][bj][m][0], v1 = acc[ai][bj][m][1]; *(u32x4*)(rowp + bj * HALF) = PG8_PACK8(v0, v1); } }
    }
};

struct EpiProj {
    static constexpr bool PERM = true, AFTER_DRAIN = false;
    bf16_t *Q, *K, *V, *RW; const float* rope; float qscale;
    __device__ __forceinline__ void operator()(const f32x4 (&acc)[2][2][4][2], const Unit& u, int wr, int wc, int fr, int fq) const {
        const int row0 = u.pm * BM + wr * 64 + fr, cl = wc * 32 + 8 * fq, pn = u.pn;
        if (pn < 4) {
            bf16_t* base = (pn < 2) ? Q : K; const int colt = (pn & 1) * 256; const float sc = (pn < 2) ? qscale : 1.f;
            const bool rp = ((wc & 1) == 0) && (fq < 2);
#pragma unroll
            for (int ai = 0; ai < 2; ++ai)
#pragma unroll
                for (int m = 0; m < 4; ++m) { const int row = row0 + ai * HALF + m * 16;
                    f32x4 cs = (f32x4){1.f, 1.f, 1.f, 1.f}, sn = (f32x4){0.f, 0.f, 0.f, 0.f};
                    if (rp) { cs = *(const f32x4*)(rope + (size_t)row * 16 + 4 * fq); sn = *(const f32x4*)(rope + (size_t)row * 16 + 8 + 4 * fq); }
#pragma unroll
                    for (int bj = 0; bj < 2; ++bj) { f32x4 v0 = acc[ai][bj][m][0], v1 = acc[ai][bj][m][1];
                        { const float a0 = v0[0], b0 = v0[1], a1 = v0[2], b1 = v0[3], a2 = v1[0], b2 = v1[1], a3 = v1[2], b3 = v1[3];
                          v0[0] = a0 * cs[0] - b0 * sn[0]; v0[1] = b0 * cs[0] + a0 * sn[0]; v0[2] = a1 * cs[1] - b1 * sn[1]; v0[3] = b1 * cs[1] + a1 * sn[1];
                          v1[0] = a2 * cs[2] - b2 * sn[2]; v1[1] = b2 * cs[2] + a2 * sn[2]; v1[2] = a3 * cs[3] - b3 * sn[3]; v1[3] = b3 * cs[3] + a3 * sn[3]; }
                        v0 = v0 * sc; v1 = v1 * sc;
                        *(u32x4*)(base + (size_t)row * 512 + colt + bj * HALF + cl) = PG8_PACK8(v0, v1); } }
        } else {
            bf16_t* base; int ld, colt;
            if (pn < 6) { base = V; ld = 512; colt = (pn - 4) * 256; } else { base = RW; ld = 1792; colt = (pn - 6) * 256; }
#pragma unroll
            for (int ai = 0; ai < 2; ++ai)
#pragma unroll
                for (int m = 0; m < 4; ++m) { bf16_t* rowp = base + (size_t)(row0 + ai * HALF + m * 16) * ld + colt + cl;
#pragma unroll
                    for (int bj = 0; bj < 2; ++bj) { const f32x4 v0 = acc[ai][bj][m][0], v1 = acc[ai][bj][m][1]; *(u32x4*)(rowp + bj * HALF) = PG8_PACK8(v0, v1); } }
        }
    }
};

struct EpiLora {
    static constexpr bool PERM = true, AFTER_DRAIN = false;
    bf16_t* LW; size_t kstride; const float *w0, *a0;
    __device__ __forceinline__ void operator()(const f32x4 (&acc)[2][2][4][2], const Unit& u, int wr, int wc, int fr, int fq) const {
        const int row0 = u.pm * BM + wr * 64 + fr, kind = u.pn >> 1, col0 = (u.pn & 1) * 256 + wc * 32 + 8 * fq;
        bf16_t* dst = LW + (size_t)kind * kstride; const float* bias = (kind == 1) ? a0 : w0;
        f32x4 bv[2][2];
#pragma unroll
        for (int bj = 0; bj < 2; ++bj)
#pragma unroll
            for (int n = 0; n < 2; ++n) bv[bj][n] = (kind < 2) ? *(const f32x4*)(bias + col0 + bj * HALF + 4 * n) : (f32x4){0.f, 0.f, 0.f, 0.f};
#pragma unroll
        for (int ai = 0; ai < 2; ++ai)
#pragma unroll
            for (int m = 0; m < 4; ++m) { bf16_t* rowp = dst + (size_t)(row0 + ai * HALF + m * 16) * 512 + col0;
#pragma unroll
                for (int bj = 0; bj < 2; ++bj) { f32x4 vv[2];
#pragma unroll
                    for (int n = 0; n < 2; ++n) { f32x4 v = acc[ai][bj][m][n] + bv[bj][n];
                        if (kind == 0) {
#pragma unroll
                            for (int q = 0; q < 4; ++q) v[q] = -0.60653066f * sigmoidf_(v[q]);
                        } else if (kind == 1) {
#pragma unroll
                            for (int q = 0; q < 4; ++q) v[q] = sigmoidf_(v[q]);
                        }
                        vv[n] = v; }
                    *(u32x4*)(rowp + bj * HALF) = PG8_PACK8(vv[0], vv[1]); } }
    }
};

__device__ __forceinline__ unsigned pk4_fp8(float a, float b, float c_, float d) { int r = __builtin_amdgcn_cvt_pk_fp8_f32(a, b, 0, false); r = __builtin_amdgcn_cvt_pk_fp8_f32(c_, d, r, true); return (unsigned)r; }
constexpr float W8_SCALE = 32.f, W8_INV = 1.f / 32.f;
struct EpiSwiglu {
    static constexpr bool PERM = true, AFTER_DRAIN = false;
    unsigned char* ACT; const float* b1;
    __device__ __forceinline__ void operator()(const f32x4 (&acc)[2][2][4][2], const Unit& u, int wr, int wc, int fr, int fq) const {
        const int row0 = u.pm * BM + wr * 64 + fr, col0 = u.pn * BM + wc * 32 + 8 * fq;
        f32x4 bv[2][2];
#pragma unroll
        for (int bj = 0; bj < 2; ++bj)
#pragma unroll
            for (int n = 0; n < 2; ++n) bv[bj][n] = *(const f32x4*)(b1 + (size_t)u.e * 2048 + col0 + bj * HALF + 4 * n);
#pragma unroll
        for (int ai = 0; ai < 2; ++ai)
#pragma unroll
            for (int m = 0; m < 4; ++m) { unsigned char* rowp = ACT + (size_t)(row0 + ai * HALF + m * 16) * 1024 + (col0 >> 1);
#pragma unroll
                for (int bj = 0; bj < 2; ++bj) { const f32x4 v0 = acc[ai][bj][m][0] * W8_INV + bv[bj][0], v1 = acc[ai][bj][m][1] * W8_INV + bv[bj][1];
                    float o[4];
#pragma unroll
                    for (int q = 0; q < 4; ++q) { const float glu = (q < 2) ? v0[2 * q] : v1[2 * q - 4], lin = (q < 2) ? v0[2 * q + 1] : v1[2 * q - 3];
                        const float gg = fminf(glu, 7.f), ll = fminf(fmaxf(lin, -7.f), 7.f); o[q] = gg * sigmoidf_(1.702f * gg) * (ll + 1.f); }
                    *(unsigned*)(rowp + bj * (HALF / 2)) = pk4_fp8(o[0], o[1], o[2], o[3]); } }
    }
};

constexpr float Y8_SCALE = 32.f, Y8_INV = 1.f / 32.f;
struct EpiMoe2 {
    static constexpr bool PERM = true, AFTER_DRAIN = false;
    unsigned char* Y2; const float* b2; const float* gate;
    __device__ __forceinline__ void operator()(const f32x4 (&acc)[2][2][4][2], const Unit& u, int wr, int wc, int fr, int fq) const {
        const int row0 = u.pm * BM + wr * 64 + fr, col0 = u.pn * BM + wc * 32 + 8 * fq;
#pragma unroll
        for (int bj = 0; bj < 2; ++bj) { const f32x4 b0 = *(const f32x4*)(b2 + (size_t)u.e * 1024 + col0 + bj * HALF), b1 = *(const f32x4*)(b2 + (size_t)u.e * 1024 + col0 + bj * HALF + 4);
#pragma unroll
            for (int ai = 0; ai < 2; ++ai)
#pragma unroll
                for (int m = 0; m < 4; ++m) { const int row = row0 + ai * HALF + m * 16; const float gt = gate[row] * Y8_SCALE;
                    const f32x4 v0 = (acc[ai][bj][m][0] * W8_INV + b0) * gt, v1 = (acc[ai][bj][m][1] * W8_INV + b1) * gt;
                    *(u32x2*)(Y2 + (size_t)row * 1024 + col0 + bj * HALF) = (u32x2){pk4_fp8(v0[0], v0[1], v0[2], v0[3]), pk4_fp8(v1[0], v1[1], v1[2], v1[3])}; } }
    }
};

template <class Epi, class Sched, bool ALIGN_EPI = false, bool SP2 = false, bool GATHER = false, bool FP8 = false>
__device__ __forceinline__ void gemm_phase(PG8_LAS unsigned char* lds, const Gemm g, const Sched& S, const Epi& E, const int wid) {
    const int lane = lane_id_v(), tid = wid * 64 + lane, wr = wid >> 2, wc = wid & 3, fr = lane & 15, fq = lane >> 4;
    const int K = g.K, nt = K / BK;
    const __amdgpu_buffer_rsrc_t rsrc = __builtin_amdgcn_make_buffer_rsrc((void*)g.base, 0, 0x7fffffff, 0x00020000);
    unsigned voffA[2], voffB[2];
#pragma unroll
    for (int i = 0; i < 2; ++i) { int R, C; stage_rc(tid * 16 + i * 8192, R, C); const int Rb = Epi::PERM ? ((R & ~31) + perm32(R & 31)) : R;
        voffA[i] = (unsigned)(R * K + C) * 2u; voffB[i] = (unsigned)(Rb * K + C) * 2u; }
    const size_t kstep = (size_t)(BK * 2);
    const size_t hstep = (size_t)HALF * K * 2;
    const size_t tstep = 2 * hstep;
    const unsigned ldsw = (unsigned)wid * 1024u;
    const int aoff = FP8 ? lds_byte(wr * 64 + fr, fq * 16) : lds_byte(wr * 64 + fr, fq * 8), boff = FP8 ? lds_byte(wc * 32 + fr, fq * 16) : lds_byte(wc * 32 + fr, fq * 8);
    const PG8_LAS unsigned char* ldsA; const PG8_LAS unsigned char* ldsB;
    { unsigned a_ = (unsigned)(size_t)(lds + aoff), b_ = (unsigned)(size_t)(lds + 4 * HTB + boff); asm volatile("" : "+v"(a_), "+v"(b_)); ldsA = (const PG8_LAS unsigned char*)(size_t)a_; ldsB = (const PG8_LAS unsigned char*)(size_t)b_; }
#define PG8_SA(b, h) (((b) * 2 + (h)) * HTB)
#define PG8_SB(b, h) ((4 + (b) * 2 + (h)) * HTB)
#define PG8_STAGE(bufoff, gbase, voff) do { const unsigned so_ = (unsigned)((const char*)(gbase) - (const char*)g.base); _Pragma("unroll") for (int _i = 0; _i < 2; ++_i) \
        __builtin_amdgcn_raw_ptr_buffer_load_lds(rsrc, (PG8_LAS unsigned*)(lds + (bufoff) + ldsw + _i * 8192), 16, (voff)[_i], so_, 0, 0); } while (0)
#define PG8_STAGE_A(bufoff, ptr, h, nx) do { if constexpr (GATHER) { unsigned vo_[2]; vo_[0] = (nx) ? gn[h][0] : gc[h][0]; vo_[1] = (nx) ? gn[h][1] : gc[h][1]; PG8_STAGE(bufoff, ptr, vo_); } \
        else { PG8_STAGE(bufoff, (ptr) + (h) * hstep, voffA); } } while (0)
#define PG8_LDA(dst, b, h) do { _Pragma("unroll") for (int m = 0; m < 4; ++m) _Pragma("unroll") for (int k = 0; k < 2; ++k) dst[m].pc[k] = *(const PG8_LAS bf16x8*)(ldsA + ((b) * 2 + (h)) * HTB + m * 2048 + k * (FP8 ? 16 : 1024)); } while (0)
#define PG8_LDB(dst, b, h) do { _Pragma("unroll") for (int n = 0; n < 2; ++n) _Pragma("unroll") for (int k = 0; k < 2; ++k) dst[n].pc[k] = *(const PG8_LAS bf16x8*)(ldsB + ((b) * 2 + (h)) * HTB + n * 2048 + k * (FP8 ? 16 : 1024)); } while (0)
#define PG8_MMA(ai, bj, At, Bt) do { __builtin_amdgcn_s_setprio(1); _Pragma("unroll") for (int m = 0; m < 4; ++m) _Pragma("unroll") for (int n = 0; n < 2; ++n) { \
        if constexpr (FP8) { acc[ai][bj][m][n] = __builtin_amdgcn_mfma_scale_f32_16x16x128_f8f6f4(Bt[n].w, At[m].w, acc[ai][bj][m][n], 0, 0, 0, 0, 0, 0); } \
        else { _Pragma("unroll") for (int k = 0; k < 2; ++k) acc[ai][bj][m][n] = __builtin_amdgcn_mfma_f32_16x16x32_bf16(Bt[n].pc[k], At[m].pc[k], acc[ai][bj][m][n], 0, 0, 0); } } \
        __builtin_amdgcn_s_setprio(0); } while (0)
#define PG8_WAIT_V(n) asm volatile("s_waitcnt vmcnt(" #n ")" ::: "memory")
#define PG8_WAIT_L(n) asm volatile("s_waitcnt lgkmcnt(" #n ")" ::: "memory")
#define PG8_BAR __builtin_amdgcn_s_barrier()
#define PG8_SCHED __builtin_amdgcn_sched_barrier(0)
    Unit cur, nxt; int ui = 0;
    if (!S.next(0, cur)) return;
    f32x4 acc[2][2][4][2];
#pragma unroll
    for (int a = 0; a < 2; ++a)
#pragma unroll
        for (int b = 0; b < 2; ++b)
#pragma unroll
            for (int m = 0; m < 4; ++m)
#pragma unroll
                for (int n = 0; n < 2; ++n) acc[a][b][m][n] = (f32x4){0.f, 0.f, 0.f, 0.f};
    frag2_t At[4], B0[2], B1[2];
    const char* cA = GATHER ? (const char*)g.A : (const char*)g.A + (size_t)cur.pm * tstep; const char* cB = (const char*)g.Bt + (size_t)cur.e * g.bstride + (size_t)cur.pn * tstep;
    unsigned gc[2][2] = {{0u, 0u}, {0u, 0u}}, gn[2][2] = {{0u, 0u}, {0u, 0u}}; Unit nx2; bool has_nx2 = false;
#define PG8_GOFF(dst, pm_, ok_, alt_) do { const int t_ = lane_id_v() + wid * 64; _Pragma("unroll") for (int i_ = 0; i_ < 2; ++i_) { int R_, C_; stage_rc(t_ * 16 + i_ * 8192, R_, C_); \
        _Pragma("unroll") for (int h_ = 0; h_ < 2; ++h_) dst[h_][i_] = (ok_) ? (unsigned)g.rowidx[(pm_) * BM + h_ * HALF + R_] * (unsigned)(K * 2) + (unsigned)C_ * 2u : alt_[h_][i_]; } } while (0)
    if constexpr (GATHER) {
        PG8_GOFF(gc, cur.pm, true, gc);
        const bool hn = S.next(1, nxt);
        PG8_GOFF(gn, nxt.pm, hn, gc);
    }
    S.a_ready(cur);
    if constexpr (SP2) {
        PG8_STAGE(PG8_SB(0, 0), cB, voffB); PG8_STAGE(PG8_SB(0, 1), cB + hstep, voffB); PG8_STAGE_A(PG8_SA(0, 0), cA, 0, false); PG8_STAGE_A(PG8_SA(0, 1), cA, 1, false);
        if (wr == 1) PG8_BAR;
        PG8_WAIT_V(2); PG8_BAR;
        PG8_STAGE(PG8_SB(1, 0), cB + kstep, voffB); PG8_STAGE_A(PG8_SA(1, 0), cA + kstep, 0, false); PG8_STAGE(PG8_SB(1, 1), cB + hstep + kstep, voffB);
        PG8_WAIT_V(6); PG8_BAR;
    } else {
        PG8_STAGE(PG8_SB(0, 0), cB, voffB); PG8_STAGE_A(PG8_SA(0, 0), cA, 0, false); PG8_STAGE(PG8_SB(0, 1), cB + hstep, voffB); PG8_STAGE_A(PG8_SA(0, 1), cA, 1, false);
        if (wr == 1) PG8_BAR;
        PG8_WAIT_V(4); PG8_BAR;
        PG8_STAGE(PG8_SB(1, 0), cB + kstep, voffB); PG8_STAGE_A(PG8_SA(1, 0), cA + kstep, 0, false); PG8_STAGE(PG8_SB(1, 1), cB + hstep + kstep, voffB);
        PG8_WAIT_V(6); PG8_BAR;
    }
    for (;;) {
        const bool has_next = S.next(ui + 1, nxt);
        const char* nA = GATHER ? (const char*)g.A : (has_next ? (const char*)g.A + (size_t)nxt.pm * tstep : cA); const char* nB = has_next ? (const char*)g.Bt + (size_t)nxt.e * g.bstride + (size_t)nxt.pn * tstep : cB;
        for (int t = 0; t < nt; t += 2) {
            const bool last = (t == nt - 2);
            asm volatile("" : "+v"(voffA[0]), "+v"(voffA[1]), "+v"(voffB[0]), "+v"(voffB[1]));
            if constexpr (GATHER) asm volatile("" : "+v"(gc[0][0]), "+v"(gc[0][1]), "+v"(gc[1][0]), "+v"(gc[1][1]), "+v"(gn[0][0]), "+v"(gn[0][1]), "+v"(gn[1][0]), "+v"(gn[1][1]));
            const char* a1 = cA + (size_t)(t + 1) * kstep;
            const char* a2 = last ? nA : cA + (size_t)(t + 2) * kstep; const char* b2 = last ? nB : cB + (size_t)(t + 2) * kstep;
            const char* a3 = a2 + kstep; const char* b3 = b2 + kstep;
            if (last && has_next) S.a_ready(nxt);
            if constexpr (SP2) {
            PG8_LDB(B0, 0, 0); PG8_LDB(B1, 0, 1); PG8_SCHED; PG8_LDA(At, 0, 0); PG8_STAGE_A(PG8_SA(1, 1), a1, 1, false);
            PG8_WAIT_V(8); PG8_WAIT_L(0); PG8_BAR; PG8_MMA(0, 0, At, B0); PG8_MMA(0, 1, At, B1); PG8_BAR; PG8_SCHED;
            PG8_LDA(At, 0, 1); PG8_STAGE(PG8_SB(0, 0), b2, voffB); PG8_STAGE(PG8_SB(0, 1), b2 + hstep, voffB); PG8_STAGE_A(PG8_SA(0, 0), a2, 0, last);
            PG8_WAIT_V(8); PG8_WAIT_L(0); PG8_BAR; PG8_MMA(1, 0, At, B0); PG8_MMA(1, 1, At, B1); PG8_BAR; PG8_SCHED;
            PG8_LDB(B0, 1, 0); PG8_LDB(B1, 1, 1); PG8_SCHED; PG8_LDA(At, 1, 0); PG8_STAGE_A(PG8_SA(0, 1), a2, 1, last);
            PG8_WAIT_V(8); PG8_WAIT_L(0); PG8_BAR; PG8_MMA(0, 0, At, B0); PG8_MMA(0, 1, At, B1); PG8_BAR; PG8_SCHED;
            PG8_LDA(At, 1, 1); PG8_STAGE(PG8_SB(1, 0), b3, voffB); PG8_STAGE(PG8_SB(1, 1), b3 + hstep, voffB); PG8_STAGE_A(PG8_SA(1, 0), a3, 0, last);
            PG8_WAIT_V(8); PG8_WAIT_L(0); PG8_BAR; PG8_MMA(1, 0, At, B0); PG8_MMA(1, 1, At, B1); PG8_BAR; PG8_SCHED;
            } else {
            PG8_LDB(B0, 0, 0); PG8_SCHED; PG8_LDA(At, 0, 0); PG8_STAGE_A(PG8_SA(1, 1), a1, 1, false);
            PG8_WAIT_L(8); PG8_BAR; PG8_WAIT_L(0); PG8_MMA(0, 0, At, B0); PG8_BAR; PG8_SCHED;
            PG8_LDB(B1, 0, 1); PG8_STAGE(PG8_SB(0, 0), b2, voffB);
            PG8_BAR; PG8_WAIT_L(0); PG8_MMA(0, 1, At, B1); PG8_BAR;
            PG8_LDA(At, 0, 1); PG8_STAGE_A(PG8_SA(0, 0), a2, 0, last);
            PG8_BAR; PG8_WAIT_L(0); PG8_MMA(1, 0, At, B0); PG8_BAR; PG8_SCHED;
            PG8_STAGE(PG8_SB(0, 1), b2 + hstep, voffB);
            PG8_WAIT_V(6); PG8_BAR; PG8_MMA(1, 1, At, B1); PG8_BAR;
            PG8_LDB(B0, 1, 0); PG8_SCHED; PG8_LDA(At, 1, 0); PG8_STAGE_A(PG8_SA(0, 1), a2, 1, last);
            PG8_WAIT_L(8); PG8_BAR; PG8_WAIT_L(0); PG8_MMA(0, 0, At, B0); PG8_BAR; PG8_SCHED;
            PG8_LDB(B1, 1, 1); PG8_STAGE(PG8_SB(1, 0), b3, voffB);
            PG8_BAR; PG8_WAIT_L(0); PG8_MMA(0, 1, At, B1); PG8_BAR;
            PG8_LDA(At, 1, 1); PG8_STAGE_A(PG8_SA(1, 0), a3, 0, last);
            PG8_BAR; PG8_WAIT_L(0); PG8_MMA(1, 0, At, B0); PG8_BAR; PG8_SCHED;
            PG8_STAGE(PG8_SB(1, 1), b3 + hstep, voffB);
            PG8_WAIT_V(6); PG8_BAR; PG8_MMA(1, 1, At, B1); PG8_BAR;
            }
        }
        if constexpr (GATHER) { has_nx2 = has_next && S.next(ui + 2, nx2);
            _Pragma("unroll") for (int h = 0; h < 2; ++h) _Pragma("unroll") for (int i = 0; i < 2; ++i) gc[h][i] = gn[h][i];
            PG8_GOFF(gn, nx2.pm, has_nx2, gc); }
        if constexpr (ALIGN_EPI) { if (wr == 0) PG8_BAR; }
        if constexpr (!Epi::AFTER_DRAIN) { const int l_ = lane_id_v(); const int fr_ = l_ & 15, fq_ = l_ >> 4;
            E(acc, cur, wr, wc, fr_, fq_); S.done(cur); }
        if (!has_next) break;
#pragma unroll
        for (int a = 0; a < 2; ++a)
#pragma unroll
            for (int b = 0; b < 2; ++b)
#pragma unroll
                for (int m = 0; m < 4; ++m)
#pragma unroll
                    for (int n = 0; n < 2; ++n) acc[a][b][m][n] = (f32x4){0.f, 0.f, 0.f, 0.f};
        if constexpr (GATHER) { asm volatile("" : "+v"(gn[0][0]), "+v"(gn[0][1]), "+v"(gn[1][0]), "+v"(gn[1][1])); }
        cur = nxt; cA = nA; cB = nB; ++ui;
        if constexpr (ALIGN_EPI) { if (wr == 1) PG8_BAR; }
    }
    PG8_WAIT_V(0);
    if constexpr (!ALIGN_EPI) { if (wr == 0) PG8_BAR; }
    PG8_BAR;
    if constexpr (Epi::AFTER_DRAIN) { E.fused(acc, cur, wr, wc, fr, fq, lds, wid, lane); S.done(cur); }
#undef PG8_SA
#undef PG8_SB
#undef PG8_STAGE
#undef PG8_STAGE_A
#undef PG8_GOFF
#undef PG8_LDA
#undef PG8_LDB
#undef PG8_MMA
#undef PG8_WAIT_V
#undef PG8_WAIT_L
#undef PG8_BAR
#undef PG8_SCHED
}
}
#include <hip/hip_bf16.h>
#include <cmath>
namespace attn_body {
using bf16=__hip_bfloat16;
using bf16x8=__attribute__((ext_vector_type(8)))short;
using s16x4=__attribute__((ext_vector_type(4)))short;
using f32x16=__attribute__((ext_vector_type(16)))float;
using u32x4=__attribute__((ext_vector_type(4)))unsigned;
constexpr int BATCH=8,NHEAD=8,SEQ=4096,D=64;
constexpr int QP=512,KP=512,VP=512,OP=1024;
constexpr int NW=8,QBLK=32,QB=QBLK*NW,KVBLK=64,NQB=SEQ/QB;
constexpr int ATTN_UNIT_ROWS=QB;
__device__ __forceinline__ int crow(int r,int hi){return (r&3)+8*(r>>2)+4*hi;}
#define SBAR() __builtin_amdgcn_sched_barrier(0)
__device__ __forceinline__ void cmask(f32x16&p0,f32x16&p1,int jb,int qrel,int hi){
  const float NEG=-INFINITY; int kb=64*jb+4*hi;
  #pragma unroll
  for(int r=0;r<16;++r){int kv=kb+(r&3)+8*(r>>2); if(kv>qrel)p0[r]=NEG; if(kv+32>qrel)p1[r]=NEG;}
}

constexpr int NSLOT=3, SLOTB=8192;
constexpr int LDS_K=0, LDS_V=NSLOT*SLOTB, LDS_WS=3*NSLOT*SLOTB, LDS_Q=LDS_WS+NW*64*4, LDS_OST=LDS_Q, LDS_BYTES=LDS_Q+NW*4096;
constexpr float C2=0.125f*1.4426950408889634f;
__device__ __forceinline__ void glds16(const void*gsrc,unsigned lds_dst){unsigned keep;
  asm volatile("s_mov_b32 %0, m0\n\ts_mov_b32 m0, %2\n\ts_nop 0\n\tglobal_load_lds_dwordx4 %1, off\n\ts_mov_b32 m0, %0":"=&s"(keep):"v"(gsrc),"s"(lds_dst):"memory");}
__device__ __forceinline__ float max3f(float a,float b,float c){float r;asm("v_max3_f32 %0, %1, %2, %3":"=v"(r):"v"(a),"v"(b),"v"(c));return r;}
__device__ __forceinline__ float max2f(float a,float b){float r;asm("v_max_f32_e32 %0, %1, %2":"=v"(r):"v"(a),"v"(b));return r;}
__device__ __forceinline__ float fadd_s(float a,float b){float r;asm("v_add_f32_e32 %0, %1, %2":"=v"(r):"v"(a),"v"(b));return r;}
__device__ __forceinline__ float fsub_s(float a,float b){float r;asm("v_sub_f32_e32 %0, %1, %2":"=v"(r):"v"(a),"v"(b));return r;}
typedef float f32x2_t __attribute__((ext_vector_type(2))); typedef __bf16 bf16x2_t __attribute__((ext_vector_type(2)));
__device__ __forceinline__ unsigned cvtpk_s(float lo,float hi){f32x2_t v={lo,hi};bf16x2_t b=__builtin_convertvector(v,bf16x2_t);return __builtin_bit_cast(unsigned,b);}
#define WAIT_BAR(N) asm volatile("s_waitcnt vmcnt(" #N ") lgkmcnt(0)\n\ts_barrier":::"memory")

__device__ __forceinline__ void qkt(f32x16&p0,f32x16&p1,const char*Kslot,const __attribute__((address_space(3))) char*qf,int r32,int hi){
  const char*kb=Kslot+hi*1024+r32*16;
  #pragma unroll
  for(int d0=0;d0<4;++d0){
    const bf16x8 b0=*reinterpret_cast<const bf16x8*>(kb+d0*2048);
    const bf16x8 b1=*reinterpret_cast<const bf16x8*>(kb+d0*2048+512);
    const bf16x8 q_=*(const __attribute__((address_space(3))) bf16x8*)(qf+d0*1024);
    if(d0==0){p0=__builtin_amdgcn_mfma_f32_32x32x16_bf16(b0,q_,f32x16{},0,0,0);p1=__builtin_amdgcn_mfma_f32_32x32x16_bf16(b1,q_,f32x16{},0,0,0);}
    else{p0=__builtin_amdgcn_mfma_f32_32x32x16_bf16(b0,q_,p0,0,0,0);p1=__builtin_amdgcn_mfma_f32_32x32x16_bf16(b1,q_,p1,0,0,0);}}
}
typedef __attribute__((address_space(3))) const char* lds_cptr;
typedef short v4i16_t __attribute__((ext_vector_type(4)));
__device__ __forceinline__ void kload8(bf16x8*kf,lds_cptr kp){
  kf[0]=*(const __attribute__((address_space(3))) bf16x8*)(kp);      kf[1]=*(const __attribute__((address_space(3))) bf16x8*)(kp+512);
  kf[2]=*(const __attribute__((address_space(3))) bf16x8*)(kp+2048); kf[3]=*(const __attribute__((address_space(3))) bf16x8*)(kp+2560);
  kf[4]=*(const __attribute__((address_space(3))) bf16x8*)(kp+4096); kf[5]=*(const __attribute__((address_space(3))) bf16x8*)(kp+4608);
  kf[6]=*(const __attribute__((address_space(3))) bf16x8*)(kp+6144); kf[7]=*(const __attribute__((address_space(3))) bf16x8*)(kp+6656);
}
__device__ __forceinline__ void kload2(bf16x8*kf,lds_cptr kp,int j){ kf[2*j]=*(const __attribute__((address_space(3))) bf16x8*)(kp+j*2048); kf[2*j+1]=*(const __attribute__((address_space(3))) bf16x8*)(kp+j*2048+512); }
__device__ __forceinline__ s16x4 vtr(lds_cptr p){ return __builtin_bit_cast(s16x4,__builtin_amdgcn_ds_read_tr16_b64_v4i16((__attribute__((address_space(3))) v4i16_t*)p)); }
__device__ __forceinline__ float rowmax(const f32x16&p0,const f32x16&p1){
  float a=max3f(p0[0],p0[1],p1[0]),b=max3f(p0[2],p0[3],p1[1]);a=max3f(a,p1[2],p1[3]);
  #pragma unroll
  for(int r=4;r<16;r+=4){a=max3f(a,p0[r],p0[r+1]);b=max3f(b,p0[r+2],p0[r+3]);a=max3f(a,p1[r],p1[r+1]);b=max3f(b,p1[r+2],p1[r+3]);}
  const float m=max2f(a,b);
  auto rr=__builtin_amdgcn_permlane32_swap(__float_as_uint(m),__float_as_uint(m),false,false);
  return max2f(__uint_as_float(rr[0]),__uint_as_float(rr[1]));
}
__device__ __forceinline__ void pv(f32x16*o,int vb,bf16x8 pa0,bf16x8 pa1,bf16x8 pa2,bf16x8 pa3){
  #pragma unroll
  for(int d0=0;d0<2;++d0){s16x4 lo[4],hi[4];
    #pragma unroll
    for(int ks=0;ks<4;++ks){
      asm volatile("ds_read_b64_tr_b16 %0,%1 offset:%c2":"=&v"(lo[ks]):"v"(vb),"i"(d0*4096+ks*1024):"memory");
      asm volatile("ds_read_b64_tr_b16 %0,%1 offset:%c2":"=&v"(hi[ks]):"v"(vb),"i"(d0*4096+ks*1024+512):"memory");}
    asm volatile("s_waitcnt lgkmcnt(0)":::"memory");SBAR();
    #define PK(k) (bf16x8){lo[k][0],lo[k][1],lo[k][2],lo[k][3],hi[k][0],hi[k][1],hi[k][2],hi[k][3]}
    o[d0]=__builtin_amdgcn_mfma_f32_32x32x16_bf16(pa0,PK(0),o[d0],0,0,0);
    o[d0]=__builtin_amdgcn_mfma_f32_32x32x16_bf16(pa1,PK(1),o[d0],0,0,0);
    o[d0]=__builtin_amdgcn_mfma_f32_32x32x16_bf16(pa2,PK(2),o[d0],0,0,0);
    o[d0]=__builtin_amdgcn_mfma_f32_32x32x16_bf16(pa3,PK(3),o[d0],0,0,0);
    #undef PK
  }
}

#ifndef ATTN_STORE16
#define ATTN_STORE16(p,v) (*(u32x4*)(p)=(v))
#endif
template<int THRL> __device__ __forceinline__ void attn_unit(int b,int h,int qb,const bf16*Q,const bf16*__restrict__ K,const bf16*__restrict__ V,bf16*O,char*shm,const int wid){
  const int qcol=h*64, kcol=h*64, vcol=(h>>1)*128, ocol=h*128;
  const int lane=lane_id_v(),r32=lane&31,hi=lane>>5;
  const long rowbase=(long)b*SEQ; const int q0=qb*QB;
  const bf16*Qw=Q+(rowbase+q0+wid*QBLK)*QP+qcol;
  const bf16*Kh=K+rowbase*KP+kcol,*Vh=V+rowbase*VP+vcol;
  const unsigned lds0=(unsigned)(uintptr_t)shm;
  __attribute__((address_space(3))) float*const wsf=(__attribute__((address_space(3))) float*)((__attribute__((address_space(3))) char*)shm+LDS_WS)+wid*64;
  const int koff=lane*KP+wid*8, voff=(16*(wid&3)+(lane>>2))*VP+(wid>>2)*32+(lane&3)*8;
  const unsigned kdst=lds0+LDS_K+wid*1024, vdst=lds0+LDS_V+wid*1024;
  #define DMA_K(t,slot) glds16(Kh+(long)(t)*KVBLK*KP+koff,(unsigned)__builtin_amdgcn_readfirstlane(kdst+(slot)))
  #define DMA_V(t,slot) do{ glds16(Vh+(long)(t)*KVBLK*VP+voff,(unsigned)__builtin_amdgcn_readfirstlane(vdst+2*(slot))); glds16(Vh+(long)(t)*KVBLK*VP+64+voff,(unsigned)__builtin_amdgcn_readfirstlane(vdst+2*(slot)+8192)); }while(0)
  const char*Kbase=shm+LDS_K; bf16x8 kf[8];
  const lds_cptr shm3=(lds_cptr)shm; const lds_cptr kp0=shm3+LDS_K+hi*1024+r32*16; const lds_cptr vp0=shm3+LDS_V+((lane>>4)&1)*32+(lane&3)*8+(4*hi+((lane&15)>>2))*64;
  const int NT=(q0+QB)/KVBLK;
  DMA_K(0,0);DMA_V(0,0);DMA_K(1,SLOTB);
  __attribute__((address_space(3))) char*const qf=(__attribute__((address_space(3))) char*)shm+LDS_Q+wid*4096+lane*16;
  { bf16x8 qt[4];
    #pragma unroll
    for(int d0=0;d0<4;++d0)qt[d0]=*reinterpret_cast<const bf16x8*>(&Qw[(long)r32*QP+d0*16+hi*8]);
    #pragma unroll
    for(int d0=0;d0<4;++d0)*(__attribute__((address_space(3))) bf16x8*)(qf+d0*1024)=qt[d0]; }
  #define QF(d0) (*(const __attribute__((address_space(3))) bf16x8*)(qf+(d0)*1024))
  float mhat=0.f,l_reg=0.f;f32x16 o[4];o[0]=f32x16{};o[1]=f32x16{};o[2]=f32x16{};o[3]=f32x16{};
  #define CMASK(P0,P1,t) do{int jb_=(t)-(NT-4); if(jb_>=0){ const int l_=lane_id_v(); cmask(P0,P1,jb_,wid*QBLK+(l_&31),l_>>5); } }while(0)
  bool resc=false;
  #define START(P0,P1) do{ const float rm=rowmax(P0,P1); resc=false; \
    { const float dl=rm; mhat=fadd_s(mhat,dl); \
      _Pragma("unroll") for(int r=0;r<16;++r){P0[r]=fsub_s(P0[r],dl);P1[r]=fsub_s(P1[r],dl);} } \
    _Pragma("unroll") for(int r=0;r<16;++r)P0[r]=__builtin_amdgcn_exp2f(P0[r]); }while(0)
  #define RESC() do{ if(resc){ asm volatile("s_waitcnt lgkmcnt(0)":::"memory"); \
      _Pragma("unroll") for(int d_=0;d_<4;++d_) _Pragma("unroll") for(int r=0;r<16;++r)o[d_][r]*=wsf[crow(r,hi)]; } }while(0)
  f32x16 pA0,pA1,pB0,pB1;
  int sl_prev=0,sl_cur=0,sl_next=SLOTB;
  #define ROT() do{sl_prev=sl_cur;sl_cur=sl_next;sl_next=(sl_next==(NSLOT-1)*SLOTB)?0:sl_next+SLOTB;}while(0)
  DMA_K(2,2*SLOTB);
  WAIT_BAR(4);
  qkt(pA0,pA1,Kbase,qf,r32,hi);asm volatile("s_nop 15\n\ts_nop 7":"+v"(pA0),"+v"(pA1));CMASK(pA0,pA1,0);
  START(pA0,pA1);
  _Pragma("unroll") for(int r=0;r<16;++r)pA1[r]=__builtin_amdgcn_exp2f(pA1[r]);
  WAIT_BAR(0);
  DMA_K(3,0);DMA_V(1,SLOTB);
  ROT();
  kload8(kf,kp0+sl_cur);
  WAIT_BAR(3);
  s16x4 vlo[8],vhi[8]; u32x4 pw0,pw1,pw2,pw3;
  #define PKW(P,B) cvtpk_s(P[B],P[B+1])
  #define PAF(k) __builtin_bit_cast(bf16x8,pw##k)
  #define VFR(i) (bf16x8){vlo[i][0],vlo[i][1],vlo[i][2],vlo[i][3],vhi[i][0],vhi[i][1],vhi[i][2],vhi[i][3]}
  #define PIN(x) asm volatile("":"+v"(x))
  #define MX3(a,b,c) __builtin_fmaxf(__builtin_fmaxf((a),(b)),(c))
  #define GAPA(MF,A0,A1,A2,A3,W0,W1,PW) do{ MF; sacc+=A0; sacc+=A1; sacc+=A2; sacc+=A3; PIN(sacc); W0; W1; PIN(PW); SBAR(); }while(0)
  #define EX(v) __builtin_amdgcn_exp2f(v)
  #define GAPB(MF,X,B) do{ MF; X[B]=EX(X[B]); X[B+1]=EX(X[B+1]); X[B+2]=EX(X[B+2]); X[B+3]=EX(X[B+3]); PIN(X); SBAR(); }while(0)
  #define GAPB2(MF,X,B,RD) do{ MF; RD; X[B]=EX(X[B]); X[(B)+1]=EX(X[(B)+1]); PIN(X); SBAR(); }while(0)
  #define VRD2(i) do{ vlo[i]=vtr(vp_+8192+(((i)>>2)*4096+((i)&3)*1024)); vhi[i]=vtr(vp_+8192+(((i)>>2)*4096+((i)&3)*1024+512)); }while(0)
  #define VRD(i) do{ vlo[i]=vtr(vp_+(((i)>>2)*4096+((i)&3)*1024)); vhi[i]=vtr(vp_+(((i)>>2)*4096+((i)&3)*1024+512)); }while(0)
  #define KRD(G,j) do{ if(G){ kload2(kf,kp0+sl_next,j); SBAR(); } }while(0)
  #define STEP(C0,C1,P0,P1,t,GK,GV,GL) do{ SBAR(); \
    const lds_cptr vp_=vp0+2*sl_prev; \
    VRD(0); SBAR(); float sacc=(P0[0]+P0[1]); \
    bf16x8 q_=QF(0); \
    GAPA(C0=__builtin_amdgcn_mfma_f32_32x32x16_bf16(kf[0],q_,f32x16{},0,0,0), P0[2],P0[3],P0[4],P0[5],     pw0[0]=PKW(P0,0), pw0[1]=PKW(P0,2), pw0); \
    VRD(4); SBAR(); GAPA(C1=__builtin_amdgcn_mfma_f32_32x32x16_bf16(kf[1],q_,f32x16{},0,0,0), P0[6],P0[7],P0[8],P0[9],     pw0[2]=PKW(P0,4), pw0[3]=PKW(P0,6), pw0); \
    q_=QF(1); \
    VRD(1); SBAR(); GAPA(C0=__builtin_amdgcn_mfma_f32_32x32x16_bf16(kf[2],q_,C0,0,0,0),   P0[10],P0[11],P0[12],P0[13], pw1[0]=PKW(P0,8), pw1[1]=PKW(P0,10), pw1); \
    VRD(5); SBAR(); GAPA(C1=__builtin_amdgcn_mfma_f32_32x32x16_bf16(kf[3],q_,C1,0,0,0),   P0[14],P0[15],P1[0],P1[1],   pw1[2]=PKW(P0,12),pw1[3]=PKW(P0,14), pw1); \
    q_=QF(2); \
    VRD(2); SBAR(); GAPA(C0=__builtin_amdgcn_mfma_f32_32x32x16_bf16(kf[4],q_,C0,0,0,0),   P1[2],P1[3],P1[4],P1[5],     pw2[0]=PKW(P1,0), pw2[1]=PKW(P1,2), pw2); \
    VRD(6); SBAR(); GAPA(C1=__builtin_amdgcn_mfma_f32_32x32x16_bf16(kf[5],q_,C1,0,0,0),   P1[6],P1[7],P1[8],P1[9],     pw2[2]=PKW(P1,4), pw2[3]=PKW(P1,6), pw2); \
    q_=QF(3); \
    VRD(3); SBAR(); GAPA(C0=__builtin_amdgcn_mfma_f32_32x32x16_bf16(kf[6],q_,C0,0,0,0),   P1[10],P1[11],P1[12],P1[13], pw3[0]=PKW(P1,8), pw3[1]=PKW(P1,10), pw3); \
    VRD(7); SBAR(); GAPA(C1=__builtin_amdgcn_mfma_f32_32x32x16_bf16(kf[7],q_,C1,0,0,0),   P1[14],P1[15],0.f,0.f,       pw3[2]=PKW(P1,12),pw3[3]=PKW(P1,14), pw3); \
    l_reg+=sacc; \
    if(GK){DMA_K((t)+3,sl_cur);} if(GV){DMA_V((t)+1,sl_next);} \
    _Pragma("unroll") for(int r=0;r<16;++r){C0[r]-=mhat;C1[r]-=mhat;} \
    CMASK(C0,C1,t); \
    { float a=MX3(C0[0],C0[1],C1[0]),b=MX3(C0[2],C0[3],C1[1]); a=MX3(a,C1[2],C1[3]); \
      _Pragma("unroll") for(int r=4;r<16;r+=4){a=MX3(a,C0[r],C0[r+1]);b=MX3(b,C0[r+2],C0[r+3]);a=MX3(a,C1[r],C1[r+1]);b=MX3(b,C1[r+2],C1[r+3]);} \
      float rm=__builtin_fmaxf(a,b); { auto rr=__builtin_amdgcn_permlane32_swap(__float_as_uint(rm),__float_as_uint(rm),false,false); rm=__builtin_fmaxf(__uint_as_float(rr[0]),__uint_as_float(rr[1])); } \
      resc=false; \
      if(__builtin_expect(__any(rm>(float)THRL),0)){ const float dl=__builtin_fmaxf(rm,0.f); mhat+=dl; \
        _Pragma("unroll") for(int r=0;r<16;++r){C0[r]-=dl;C1[r]-=dl;} \
        const float f=__builtin_amdgcn_exp2f(-dl); l_reg*=f; if(hi==0)wsf[r32]=f; resc=true; } } \
    SBAR(); \
    GAPB2(o[0]=__builtin_amdgcn_mfma_f32_32x32x16_bf16(PAF(0),VFR(0),o[0],0,0,0), C0,0,  VRD2(0)); \
    GAPB2(o[1]=__builtin_amdgcn_mfma_f32_32x32x16_bf16(PAF(0),VFR(4),o[1],0,0,0), C0,2,  VRD2(4)); \
    KRD(GL,0); GAPB2(o[0]=__builtin_amdgcn_mfma_f32_32x32x16_bf16(PAF(1),VFR(1),o[0],0,0,0), C0,4,  VRD2(1)); \
    KRD(GL,1); GAPB2(o[1]=__builtin_amdgcn_mfma_f32_32x32x16_bf16(PAF(1),VFR(5),o[1],0,0,0), C0,6,  VRD2(5)); \
    KRD(GL,2); GAPB2(o[0]=__builtin_amdgcn_mfma_f32_32x32x16_bf16(PAF(2),VFR(2),o[0],0,0,0), C0,8,  VRD2(2)); \
    KRD(GL,3); GAPB2(o[1]=__builtin_amdgcn_mfma_f32_32x32x16_bf16(PAF(2),VFR(6),o[1],0,0,0), C0,10, VRD2(6)); \
    GAPB2(o[0]=__builtin_amdgcn_mfma_f32_32x32x16_bf16(PAF(3),VFR(3),o[0],0,0,0), C0,12, VRD2(3)); \
    GAPB2(o[1]=__builtin_amdgcn_mfma_f32_32x32x16_bf16(PAF(3),VFR(7),o[1],0,0,0), C0,14, VRD2(7)); \
      \
    GAPB2(o[2]=__builtin_amdgcn_mfma_f32_32x32x16_bf16(PAF(0),VFR(0),o[2],0,0,0), C1,0,  (void)0); \
    GAPB2(o[3]=__builtin_amdgcn_mfma_f32_32x32x16_bf16(PAF(0),VFR(4),o[3],0,0,0), C1,2,  (void)0); \
    GAPB2(o[2]=__builtin_amdgcn_mfma_f32_32x32x16_bf16(PAF(1),VFR(1),o[2],0,0,0), C1,4,  (void)0); \
    GAPB2(o[3]=__builtin_amdgcn_mfma_f32_32x32x16_bf16(PAF(1),VFR(5),o[3],0,0,0), C1,6,  (void)0); \
    GAPB2(o[2]=__builtin_amdgcn_mfma_f32_32x32x16_bf16(PAF(2),VFR(2),o[2],0,0,0), C1,8,  (void)0); \
    GAPB2(o[3]=__builtin_amdgcn_mfma_f32_32x32x16_bf16(PAF(2),VFR(6),o[3],0,0,0), C1,10, (void)0); \
    GAPB2(o[2]=__builtin_amdgcn_mfma_f32_32x32x16_bf16(PAF(3),VFR(3),o[2],0,0,0), C1,12, (void)0); \
    GAPB2(o[3]=__builtin_amdgcn_mfma_f32_32x32x16_bf16(PAF(3),VFR(7),o[3],0,0,0), C1,14, (void)0); \
    }while(0)
  int t=1;
  #undef CMASK
  #define CMASK(P0,P1,t) do{}while(0)
  for(;t+5<NT;t+=2){
    STEP(pB0,pB1,pA0,pA1,t,true,true,true);     WAIT_BAR(3); RESC(); ROT();
    STEP(pA0,pA1,pB0,pB1,t+1,true,true,true);   WAIT_BAR(3); RESC(); ROT();
  }
  #undef CMASK
  #define CMASK(P0,P1,t) do{int jb_=(t)-(NT-4); if(jb_>=0){ const int l_=lane_id_v(); cmask(P0,P1,jb_,wid*QBLK+(l_&31),l_>>5); } }while(0)
  #define ENDW(tt) do{ if((tt)+3<NT){WAIT_BAR(3);} else if((tt)+2<NT){WAIT_BAR(2);} else {WAIT_BAR(0);} }while(0)
  for(;t+1<NT;t+=2){
    STEP(pB0,pB1,pA0,pA1,t,(t+3<NT),(t+1<NT),(t+1<NT));       ENDW(t);   RESC(); ROT();
    STEP(pA0,pA1,pB0,pB1,t+1,(t+4<NT),(t+2<NT),(t+2<NT));     ENDW(t+1); RESC(); ROT();
  }
  STEP(pB0,pB1,pA0,pA1,NT-1,false,false,false); RESC();
  { float sacc=pB0[0]+pB0[1]; _Pragma("unroll") for(int r=2;r<16;++r)sacc+=pB0[r]; _Pragma("unroll") for(int r=0;r<16;++r)sacc+=pB1[r]; l_reg+=sacc;
    pw0=(u32x4){PKW(pB0,0),PKW(pB0,2),PKW(pB0,4),PKW(pB0,6)};pw1=(u32x4){PKW(pB0,8),PKW(pB0,10),PKW(pB0,12),PKW(pB0,14)};pw2=(u32x4){PKW(pB1,0),PKW(pB1,2),PKW(pB1,4),PKW(pB1,6)};pw3=(u32x4){PKW(pB1,8),PKW(pB1,10),PKW(pB1,12),PKW(pB1,14)};
    const int vb0=(int)(lds0+LDS_V)+((lane>>4)&1)*32+(lane&3)*8+(4*hi+((lane&15)>>2))*64;
    SBAR(); pv(o,vb0+2*sl_cur,PAF(0),PAF(1),PAF(2),PAF(3)); pv(o+2,vb0+2*sl_cur+8192,PAF(0),PAF(1),PAF(2),PAF(3)); }
  #undef PKW
  #undef PAF
  #undef VFR
  #undef PIN
  #undef MX3
  #undef GAPA
  #undef GAPB
  #undef GAPB2
  #undef VRD2
  #undef EX
  #undef VRD
  #undef KRD
  #undef STEP
  #undef ENDW
  {auto rr=__builtin_amdgcn_permlane32_swap(__float_as_uint(l_reg),__float_as_uint(l_reg),false,false);l_reg=__uint_as_float(rr[0])+__uint_as_float(rr[1]);}
  if(hi==0)wsf[32+r32]=l_reg;asm volatile("s_waitcnt lgkmcnt(0)":::"memory");
  float rli[16];
  #pragma unroll
  for(int r=0;r<16;++r)rli[r]=__builtin_amdgcn_rcpf(wsf[32+crow(r,hi)]);
  bf16*Ow=O+(rowbase+q0+wid*QBLK)*OP+ocol;
  { bf16*stg=(bf16*)(shm+LDS_OST)+wid*2048;
    #pragma unroll
    for(int hf=0;hf<2;++hf){
      #pragma unroll
      for(int r=0;r<16;++r){const int orow=crow(r,hi);
        #pragma unroll
        for(int d0=0;d0<2;++d0)stg[orow*64+d0*32+r32]=__float2bfloat16(o[2*hf+d0][r]*rli[r]);}
      asm volatile("s_waitcnt lgkmcnt(0)":::"memory");
      #pragma unroll
      for(int i=0;i<4;++i){const int row=i*8+(lane>>3),ch=lane&7; const u32x4 v=*(const u32x4*)(stg+row*64+ch*8); ATTN_STORE16(Ow+(long)row*OP+hf*64+ch*8,v);}
      asm volatile("s_waitcnt lgkmcnt(0)":::"memory"); } }
  asm volatile("s_waitcnt lgkmcnt(0)\n\ts_barrier":::"memory");
  #undef DMA_K
  #undef DMA_V
  #undef QF
  #undef CMASK
  #undef START
  #undef RESC
  #undef ROT
}
constexpr int ATTN_LDS_BYTES=LDS_BYTES;
struct AttnTensors { const bf16* Q; const bf16* K; const bf16* V; bf16* O; };
struct AttnUnit { int bh; int qb; };
struct QueueOrder {
  unsigned* ctr; volatile __attribute__((address_space(3))) unsigned* slot; int wid;
  __device__ __forceinline__ unsigned claim()const{ unsigned n=0u; if(wid==0&&lane_id_v()==0) n=__hip_atomic_fetch_add(ctr,1u,__ATOMIC_RELAXED,__HIP_MEMORY_SCOPE_AGENT); return n; }
  __device__ __forceinline__ unsigned publish(unsigned n,int par)const{
    if(wid==0&&lane_id_v()==0) slot[par]=n;
    asm volatile("s_waitcnt lgkmcnt(0)\n\ts_barrier":::"memory");
    const unsigned r=slot[par]; asm volatile("s_waitcnt lgkmcnt(0)":::"memory"); return r; }
  __device__ __forceinline__ void a_ready(const AttnUnit&)const{}
  __device__ __forceinline__ void done(const AttnUnit&)const{}
};
template<class Sched,int THRL=8> __device__ __forceinline__ void attn_phase(char*lds,const AttnTensors&T,const Sched&S,const int wid){
  unsigned nxt=S.claim(); int par=0;
  for(;;){ const unsigned n=S.publish(nxt,par); par^=1; if(n>=(unsigned)(BATCH*NHEAD*NQB))break;
    nxt=S.claim();
    const int qb=NQB-1-(int)(n/(BATCH*NHEAD)), bh=(int)(n%(BATCH*NHEAD));
    attn_unit<THRL>(bh/NHEAD,bh%NHEAD,qb,T.Q,T.K,T.V,T.O,lds,wid); }
}
#undef SBAR
#undef WAIT_BAR
}
constexpr int NWAVES = 8;
#ifndef MK_N_LAUNCHES
#define MK_N_LAUNCHES 1
#endif
constexpr int N_PHASES = 14;
#ifndef PROBE_MASK
#define PROBE_MASK 0
#endif
constexpr int N_LAUNCHES = MK_N_LAUNCHES;
static_assert(N_LAUNCHES == 1 || N_LAUNCHES == N_PHASES, "MK_N_LAUNCHES is 1 or 14");

constexpr int BATCH = 8, T = 4096, D = 1024, M = BATCH * T;
constexpr int IN_COLS = 3328, RWC = 1792, NEXP = 32, TOPK = 4, NMOD = 6 * D;
constexpr int MAXROWS = M * TOPK + NEXP * 256;
constexpr int MOD_KS = 8;

constexpr size_t MiB = 1u << 20, KiB = 1u << 10;
constexpr size_t WS_CTL = 0, CTL_ZERO_BYTES = 1 * MiB;
constexpr size_t WS_MODP = 1 * MiB;
constexpr size_t WS_MOD = 2 * MiB + 512 * KiB;
constexpr size_t WS_ROPE = 3 * MiB;
constexpr size_t WS_WIN = 5 * MiB;
constexpr size_t WS_WOUT = 12 * MiB;
constexpr size_t WS_BLORA = 14 * MiB;
constexpr size_t WS_TOKE = 15 * MiB, WS_TOKG = 15 * MiB + 512 * KiB;
constexpr size_t WS_TOKROW = 16 * MiB, WS_ROWTOK = 16 * MiB + 512 * KiB, WS_ROWGATE = 17 * MiB + 256 * KiB, WS_BLKBASE = 18 * MiB;
constexpr size_t WS_W1 = 20 * MiB, WS_W2 = 148 * MiB;
constexpr size_t WS_H2 = 212 * MiB;
constexpr size_t WS_H = 276 * MiB, WS_Q = 340 * MiB, WS_K = 372 * MiB, WS_V = 404 * MiB, WS_RW = 436 * MiB;
constexpr size_t WS_O = 548 * MiB, WS_YCAT = 612 * MiB, WS_LACT = 676 * MiB;
constexpr size_t WS_LW = 692 * MiB, WS_AS = 756 * MiB, WS_G = 820 * MiB, WS_Y = 884 * MiB;
constexpr size_t WS_RIMG = 884 * MiB, WS_RBON = 1012 * MiB;
constexpr size_t WS_X1 = 948 * MiB;
constexpr size_t WS_ACT = 276 * MiB, WS_Y2 = 548 * MiB, WS_END = 1013 * MiB;
static_assert(WS_ROWTOK + (size_t)MAXROWS * 4 <= WS_ROWGATE && WS_ROWGATE + (size_t)MAXROWS * 4 <= WS_BLKBASE && WS_ACT + (size_t)MAXROWS * 2048 <= WS_Y2 && WS_Y2 + (size_t)MAXROWS * 2048 <= WS_Y, "d_ws map");
constexpr int CW_TMO = 0, CW_CODE = 1;
constexpr int CW_BAR = 4096;
constexpr int CW_ATTQ = 8192;
constexpr int CW_ECNT = 12288;
static_assert((CW_ECNT + 2 * 64 * NEXP) * 4 <= (int)CTL_ZERO_BYTES, "CTL words inside the memset region");

constexpr int RING_OFF = 0, RING_BYTES = 131072;
constexpr int LDSCTL_OFF = RING_BYTES, MISC_OFF = LDSCTL_OFF + 320;
constexpr int LDS_BYTES = 147456;
static_assert(MISC_OFF + 128 <= LDS_BYTES, "LDS map");
#define GAS __attribute__((address_space(1)))
#define LAS __attribute__((address_space(3)))
typedef unsigned short bf16;
typedef unsigned v4u __attribute__((ext_vector_type(4)));
typedef float f32x4 __attribute__((ext_vector_type(4)));
typedef short bf16x8 __attribute__((ext_vector_type(8)));
typedef GAS unsigned gu32;
typedef GAS unsigned long long gu64;
#define RLX_AGENT __ATOMIC_RELAXED, __HIP_MEMORY_SCOPE_AGENT
#define LDS_WAIT() asm volatile("s_waitcnt lgkmcnt(0)" ::: "memory")
#define VM_WAIT() asm volatile("s_waitcnt vmcnt(0)" ::: "memory")
__device__ __forceinline__ unsigned long long rt() { return __builtin_amdgcn_s_memrealtime(); }
__device__ __forceinline__ unsigned f2bf(float f) { unsigned u = __builtin_bit_cast(unsigned, f); return (u + 0x7fffu + ((u >> 16) & 1u)) >> 16; }
__device__ __forceinline__ unsigned pk2(float lo, float hi) { return f2bf(lo) | (f2bf(hi) << 16); }

#define XB_TMO      128
#define XB_XCNT(j)  (256  + 64 * (j))
#define XB_XSUB(j)  (1280 + 64 * (j))
#define XB_XGEN(j)  (2304 + 64 * (j))
#define XB_TOP      3328
#define XB_TOPGEN   3392
#define XCD_BAR_WORDS 3456
#define XB_SPIN_CAP (1u << 18)

__device__ __forceinline__ unsigned xb_ld(unsigned* p)              { return __hip_atomic_load(p, __ATOMIC_RELAXED, __HIP_MEMORY_SCOPE_AGENT); }
__device__ __forceinline__ unsigned xb_add(unsigned* p, unsigned v) { return __hip_atomic_fetch_add(p, v, __ATOMIC_RELAXED, __HIP_MEMORY_SCOPE_AGENT); }
__device__ __forceinline__ unsigned xb_xcc_id() { return (unsigned)__builtin_amdgcn_s_getreg((3 << 11) | 20) & 0xFu; }
#define XB_SPIN(cond, bar) do { unsigned _sp = 0; while (cond) { __builtin_amdgcn_s_sleep(1); \
    if ((++_sp & 255u) == 0u) { if (xb_ld(&(bar)[XB_TMO])) break; if (_sp > XB_SPIN_CAP) { atomicAdd(&(bar)[XB_TMO], 1u); break; } } } } while (0)

struct XcdBarrier {
    unsigned* bar; unsigned x; int wid;
    volatile LAS unsigned* st;
};

__device__ __forceinline__ XcdBarrier xcd_barrier_post(unsigned* bar, volatile LAS unsigned* st, int wid) {
    XcdBarrier b; b.bar = bar; b.x = xb_xcc_id(); b.st = st; b.wid = wid;
    if (threadIdx.x == 0) (void)xb_add(&bar[XB_XCNT(b.x)], 1u);
    return b;
}
__device__ __forceinline__ void xcd_barrier_complete(unsigned* bar, unsigned x, unsigned& nloc, unsigned& nx) {
    const unsigned G = gridDim.x * gridDim.y * gridDim.z;
    unsigned sum, cnt, mine, sp = 0u;
    for (;;) {
        sum = 0u; cnt = 0u; mine = 0u;
#pragma unroll
        for (unsigned j = 0; j < 16; ++j) { const unsigned c = xb_ld(&bar[XB_XCNT(j)]); sum += c; cnt += (c > 0u) ? 1u : 0u; mine = (j == x) ? c : mine; }
        if (sum == G) break;
        __builtin_amdgcn_s_sleep(1);
        if ((++sp & 255u) == 0u) { if (xb_ld(&bar[XB_TMO])) break; if (sp > XB_SPIN_CAP) { atomicAdd(&bar[XB_TMO], 1u); break; } }
    }
    nloc = mine > 0u ? mine : 1u; nx = cnt > 0u ? cnt : 1u;
}

__device__ __forceinline__ void xcd_barrier(const XcdBarrier& b) {
    asm volatile("s_waitcnt vmcnt(0)" ::: "memory");
    __syncthreads();
    if (b.wid == 0 && lane_id_v() == 0) {
        unsigned* bar = b.bar;
        __builtin_amdgcn_s_waitcnt(0);
        unsigned nloc = b.st[0], nx = b.st[1];
        if (nloc == 0u) { xcd_barrier_complete(bar, b.x, nloc, nx); b.st[0] = nloc; b.st[1] = nx; }
        const unsigned old = xb_add(&bar[XB_XSUB(b.x)], 1u);
        const unsigned gen = old / nloc;
        if (old + 1u == (gen + 1u) * nloc) {
            __builtin_amdgcn_fence(__ATOMIC_RELEASE, "agent");
            asm volatile("s_waitcnt vmcnt(0)" ::: "memory");
            const unsigned og = xb_add(&bar[XB_TOP], 1u);
            const unsigned tg = og / nx;
            if (og + 1u == (tg + 1u) * nx) xb_add(&bar[XB_TOPGEN], 1u);
            else XB_SPIN(xb_ld(&bar[XB_TOPGEN]) == tg, bar);
            __builtin_amdgcn_fence(__ATOMIC_ACQUIRE, "agent");
            xb_add(&bar[XB_XGEN(b.x)], 1u);
            asm volatile("s_waitcnt vmcnt(0)" ::: "memory");
        } else {
            XB_SPIN(xb_ld(&bar[XB_XGEN(b.x)]) == gen, bar);
            __builtin_amdgcn_fence(__ATOMIC_ACQUIRE, "agent");
            asm volatile("s_waitcnt vmcnt(0)" ::: "memory");
        }
    }
    __syncthreads();
}
typedef float f32x2 __attribute__((ext_vector_type(2)));
typedef unsigned u32x2 __attribute__((ext_vector_type(2)));
struct Frame {
    LAS unsigned char* lds;
    volatile LAS unsigned* MISC;
    gu32* ctl;
    int wave;
    int vcu, G;
    unsigned char* ws; float* out;
};
struct Args { const void* in[33]; float* out; unsigned char* ws; int ph_lo, ph_hi, li, pad; };
struct InProxy { __device__ __forceinline__ const void* operator[](int k) const { unsigned long long v; const unsigned long long kp = (unsigned long long)__builtin_amdgcn_kernarg_segment_ptr();
    asm volatile("s_load_dwordx2 %0, %1, %2\n\ts_waitcnt lgkmcnt(0)" : "=s"(v) : "s"(kp), "s"(8 * k) : "memory"); return (const void*)(const GAS unsigned char*)v; } };
struct ArgsD { InProxy in; };

#define DPP_ADD(x, ctrl) ((x) + __builtin_bit_cast(float, __builtin_amdgcn_update_dpp(0, __builtin_bit_cast(int, (x)), (ctrl), 0xF, 0xF, true)))
__device__ __forceinline__ float wave_sum(float x) {
    x = DPP_ADD(x, 0xB1); x = DPP_ADD(x, 0x4E); x = DPP_ADD(x, 0x141); x = DPP_ADD(x, 0x140);
    { const auto r_ = __builtin_amdgcn_permlane16_swap(__float_as_uint(x), __float_as_uint(x), false, false); x = __uint_as_float(r_[0]) + __uint_as_float(r_[1]); }
    { const auto r_ = __builtin_amdgcn_permlane32_swap(__float_as_uint(x), __float_as_uint(x), false, false); x = __uint_as_float(r_[0]) + __uint_as_float(r_[1]); }
    return x; }
__device__ __forceinline__ float bf2f(unsigned short u) { return __uint_as_float((unsigned)u << 16); }
__device__ __forceinline__ float bflo(unsigned u) { return __uint_as_float(u << 16); }
__device__ __forceinline__ float bfhi(unsigned u) { return __uint_as_float(u & 0xffff0000u); }
typedef float f32x2_t __attribute__((ext_vector_type(2))); typedef __bf16 bf16x2_t __attribute__((ext_vector_type(2)));
__device__ __forceinline__ unsigned pkbf(float lo, float hi) { f32x2_t v = {lo, hi}; bf16x2_t b = __builtin_convertvector(v, bf16x2_t); return __builtin_bit_cast(unsigned, b); }
__device__ __forceinline__ float allsum16(float x) {
    x = DPP_ADD(x, 0xB1); x = DPP_ADD(x, 0x4E); x = DPP_ADD(x, 0x124); x = DPP_ADD(x, 0x128); return x; }

struct P0Item { const float* src; bf16* dst; int N, K, n0; bool permq, fp8; };
__device__ __forceinline__ bool p0_decode(const Frame& F, int it, P0Item& d, const float* w_in, const float* w_out, const float* w1, const float* w2m) {
    constexpr int I_IN = (D / 64) * (IN_COLS / 32), I_OUT = (D / 64) * (D / 32), I_W1 = (D / 64) * (2048 / 32), I_W2 = (D / 64) * (D / 32);
    constexpr int NITEMS = I_IN + I_OUT + NEXP * I_W1 + NEXP * I_W2;
    if (it >= NITEMS) return false;
    const float* W; bf16* WT; int N, r = it; d.permq = false; d.fp8 = false; d.K = D;
    if (r < I_IN) { W = w_in; WT = (bf16*)(F.ws + WS_WIN); N = IN_COLS; d.permq = true; }
    else { r -= I_IN; if (r < I_OUT) { W = w_out; WT = (bf16*)(F.ws + WS_WOUT); N = D; }
        else { r -= I_OUT; if (r < NEXP * I_W1) { const int e = r / I_W1; r -= e * I_W1; W = w1 + (size_t)e * D * 2048; WT = (bf16*)(F.ws + WS_W1 + (size_t)e * 2048 * D); N = 2048; d.fp8 = true; }
            else { r -= NEXP * I_W1; const int e = r / I_W2; r -= e * I_W2; W = w2m + (size_t)e * D * D; WT = (bf16*)(F.ws + WS_W2 + (size_t)e * D * D); N = D; d.fp8 = true; } } }
    const int nblk = N / 32, kb = r / nblk, nb = r - kb * nblk; d.N = N; d.n0 = 32 * nb; d.src = W + (size_t)(64 * kb) * N + d.n0; d.dst = d.fp8 ? (bf16*)((unsigned char*)WT + 64 * kb) : WT + 64 * kb; return true;
}
__device__ __forceinline__ void p0_item_store(const P0Item& d, const float (&v)[32], LAS float* scr, int lane) {
#pragma unroll
    for (int i = 0; i < 32; ++i) scr[(2 * i + (lane >> 5)) * 33 + (lane & 31)] = v[i];
    LDS_WAIT(); asm volatile("" ::: "memory");
    const int c = lane & 7;
#pragma unroll
    for (int j = 0; j < 4; ++j) { const int n = (lane >> 3) + 8 * j; const LAS float* s = scr + (8 * c) * 33 + n;
        int nn = d.n0 + n;
        if (d.fp8) { const u32x2 o8 = (u32x2){pg8::pk4_fp8(s[0 * 33] * pg8::W8_SCALE, s[1 * 33] * pg8::W8_SCALE, s[2 * 33] * pg8::W8_SCALE, s[3 * 33] * pg8::W8_SCALE), pg8::pk4_fp8(s[4 * 33] * pg8::W8_SCALE, s[5 * 33] * pg8::W8_SCALE, s[6 * 33] * pg8::W8_SCALE, s[7 * 33] * pg8::W8_SCALE)};
            *(GAS u32x2*)((unsigned char*)d.dst + (size_t)nn * d.K + 8 * c) = o8; }
        else { v4u o; o.x = pkbf(s[0 * 33], s[1 * 33]); o.y = pkbf(s[2 * 33], s[3 * 33]); o.z = pkbf(s[4 * 33], s[5 * 33]); o.w = pkbf(s[6 * 33], s[7 * 33]);
            if (d.permq && nn < 1024) { const int dd = nn & 63; if (dd < 16) nn = (nn & ~63) + ((dd < 8) ? 2 * dd : 2 * (dd - 8) + 1); }
            *(GAS v4u*)(d.dst + (size_t)nn * d.K + 8 * c) = o; } }
    LDS_WAIT(); asm volatile("" ::: "memory");
}
__device__ __forceinline__ void sincos_d(float af, float& s, float& c) {
    const double a = (double)af; const double n = __builtin_rint(a * 0.63661977236758134308);
    double r = __builtin_fma(-n, 1.57079632679489655800e+00, a); r = __builtin_fma(-n, 6.12323399573676603587e-17, r);
    const double r2 = r * r;
    double sp = 1.0 / 6227020800.0; sp = sp * r2 * -1.0 + 1.0 / 39916800.0; sp = -sp * r2 + 1.0 / 362880.0; sp = -sp * r2 + 1.0 / 5040.0; sp = -sp * r2 + 1.0 / 120.0; sp = -sp * r2 + 1.0 / 6.0; sp = r - r * r2 * sp;
    double cp = 1.0 / 87178291200.0; cp = -cp * r2 + 1.0 / 479001600.0; cp = -cp * r2 + 1.0 / 3628800.0; cp = -cp * r2 + 1.0 / 40320.0; cp = -cp * r2 + 1.0 / 720.0; cp = -cp * r2 + 1.0 / 24.0; cp = -cp * r2 + 0.5; cp = 1.0 - r2 * cp;
    const int q = ((int)n) & 3;
    const double sv = (q == 0) ? sp : (q == 1) ? cp : (q == 2) ? -sp : -cp, cv = (q == 0) ? cp : (q == 1) ? -sp : (q == 2) ? -cp : sp;
    s = (float)sv; c = (float)cv;
}
__device__ __forceinline__ void p0_prologue(Frame& F, const ArgsD& A) {
    const int lane = lane_id_v(), tid = F.wave * 64 + lane; (void)tid;
    const int gw = F.vcu * NWAVES + F.wave, NGW = F.G * NWAVES, gt = F.vcu * 512 + tid, NGT = F.G * 512;
    LAS float* scr = (LAS float*)(F.lds + RING_OFF + F.wave * 12288);
    LAS float* sl = (LAS float*)(F.lds + RING_OFF + 98304);
    const float* c = (const float*)A.in[1];
    for (int i = tid; i < 8 * 1024; i += 512) { const float v = c[i]; sl[i] = v / (1.f + __expf(-v)); }
    __syncthreads();
    { const float* aw = (const float*)A.in[3]; float* modp = (float*)(F.ws + WS_MODP);
      for (int it = gw; it < 96 * MOD_KS; it += NGW) { const int cc = it % 96, ks = it / 96, col = cc * 64 + lane;
          float acc[8];
#pragma unroll
          for (int b = 0; b < 8; ++b) acc[b] = 0.f;
          for (int k = ks * 128; k < ks * 128 + 128; ++k) { const float w = aw[(size_t)k * NMOD + col];
#pragma unroll
              for (int b = 0; b < 8; ++b) acc[b] += sl[b * 1024 + k] * w; }
#pragma unroll
          for (int b = 0; b < 8; ++b) modp[(size_t)(ks * 8 + b) * NMOD + col] = acc[b]; } }
    { const int* pos = (const int*)A.in[2]; float* rope = (float*)(F.ws + WS_ROPE);
      for (int idx = gt; idx < M * 8; idx += NGT) { const int m = idx >> 3, i = idx & 7;
          const float invf = (i == 0) ? 1.0f : (i == 1) ? 0.1939227432012558f : (i == 2) ? 0.03760603070259094f : (i == 3) ? 0.007292664609849453f : (i == 4) ? 0.0014142135623842478f : (i == 5) ? 0.00027424818836152554f : (i == 6) ? 5.318296098266728e-05f : 1.0313386155758053e-05f;
          const float ang = (float)pos[m] * invf; float s, cc; sincos_d(ang, s, cc); rope[(size_t)m * 16 + i] = cc; rope[(size_t)m * 16 + 8 + i] = s; } }
    { const float* w2 = (const float*)A.in[18]; const float* a2 = (const float*)A.in[20]; const float* g2 = (const float*)A.in[21]; bf16* bl = (bf16*)(F.ws + WS_BLORA);
      for (int idx = gt; idx < 1536 * 256; idx += NGT) { const int n = idx >> 8, k = idx & 255, blk = n >> 9, nn = n & 511; float v = 0.f;
          if (blk == 0 && k < 64) v = w2[k * 512 + nn]; else if (blk == 1 && k >= 64 && k < 128) v = a2[(k - 64) * 512 + nn]; else if (blk == 2 && k >= 128) v = g2[(k - 128) * 512 + nn];
          bl[idx] = (bf16)(pkbf(v, 0.f) & 0xffffu); } }
    { const float* w_in = (const float*)A.in[9]; const float* w_out = (const float*)A.in[10]; const float* w1 = (const float*)A.in[29]; const float* w2m = (const float*)A.in[31];
      P0Item cur, nxt; float v[32], vn[32];
      bool have = p0_decode(F, gw, cur, w_in, w_out, w1, w2m);
      if (have) {
#pragma unroll
          for (int i = 0; i < 32; ++i) v[i] = cur.src[(size_t)(2 * i + (lane >> 5)) * cur.N + (lane & 31)]; }
      for (int it = gw; have; it += NGW) {
          const bool hn = p0_decode(F, it + NGW, nxt, w_in, w_out, w1, w2m);
          if (hn) {
#pragma unroll
              for (int i = 0; i < 32; ++i) vn[i] = nxt.src[(size_t)(2 * i + (lane >> 5)) * nxt.N + (lane & 31)]; }
          p0_item_store(cur, v, scr, lane);
          cur = nxt; have = hn;
#pragma unroll
          for (int i = 0; i < 32; ++i) v[i] = vn[i];
      } }
}

__device__ __forceinline__ void p1_premix(Frame& F, const ArgsD& A) {
    const int lane = lane_id_v(), tid = F.wave * 64 + lane; (void)tid;
    const float* modp = (const float*)(F.ws + WS_MODP); const float* ada_b = (const float*)A.in[4]; float* mod = (float*)(F.ws + WS_MOD);
    const int rows_per = M / F.G, mbeg = F.vcu * rows_per, b = mbeg >> 12;
    LAS float* ms = (LAS float*)(F.lds + RING_OFF);
    for (int col = tid; col < 2048; col += 512) { float s = ada_b[col];
#pragma unroll
        for (int ks = 0; ks < MOD_KS; ++ks) s += modp[(size_t)(ks * 8 + b) * NMOD + col];
        ms[col] = s; }
    for (int i = F.vcu * 512 + tid; i < 8 * 4096; i += F.G * 512) { const int bb = i >> 12, col = 2048 + (i & 4095); float s = ada_b[col];
#pragma unroll
        for (int ks = 0; ks < MOD_KS; ++ks) s += modp[(size_t)(ks * 8 + bb) * NMOD + col];
        mod[(size_t)bb * NMOD + col] = s; }
    __syncthreads();
    const float* x = (const float*)A.in[0]; const float* nw = (const float*)A.in[5]; bf16* H = (bf16*)(F.ws + WS_H);
    f32x4 wsc[4], sh[4];
#pragma unroll
    for (int j = 0; j < 4; ++j) { const int col = 4 * lane + 256 * j; wsc[j] = *((const f32x4*)nw + lane + 64 * j) * (*(const LAS f32x4*)(ms + 1024 + col) + 1.f); sh[j] = *(const LAS f32x4*)(ms + col); }
    const int nr = rows_per / NWAVES, m0 = mbeg + F.wave * nr;
    f32x4 pv[4];
#pragma unroll
    for (int j = 0; j < 4; ++j) pv[j] = *((const GAS f32x4*)(x + (size_t)m0 * D) + lane + 64 * j);
    for (int i = 0; i < nr; ++i) { const int m = m0 + i;
        f32x4 v[4]; float s2 = 0.f;
#pragma unroll
        for (int j = 0; j < 4; ++j) { v[j] = pv[j]; s2 += (v[j].x * v[j].x + v[j].y * v[j].y) + (v[j].z * v[j].z + v[j].w * v[j].w); }
        if (i + 1 < nr) {
#pragma unroll
            for (int j = 0; j < 4; ++j) pv[j] = *((const GAS f32x4*)(x + (size_t)(m + 1) * D) + lane + 64 * j); }
        const float rs = __builtin_amdgcn_rsqf(wave_sum(s2) * (1.f / D) + 1e-6f);
        GAS u32x2* o8 = (GAS u32x2*)(H + (size_t)m * D) + lane;
#pragma unroll
        for (int j = 0; j < 4; ++j) { const f32x4 y = v[j] * rs * wsc[j] + sh[j]; o8[64 * j] = (u32x2){pkbf(y.x, y.y), pkbf(y.z, y.w)}; } }
}

__device__ __forceinline__ void p3_lact(Frame& F, const ArgsD& A) {
    const int lane = lane_id_v(), tid = F.wave * 64 + lane; (void)tid;
    const bf16* RW = (const bf16*)(F.ws + WS_RW); bf16* L = (bf16*)(F.ws + WS_LACT); const float* mu = (const float*)A.in[16] + 1536;
    const int gw = F.vcu * NWAVES + F.wave, NGW = F.G * NWAVES, c0 = 4 * lane;
    const f32x4 mu4 = *(const f32x4*)(mu + c0);
    for (int m = gw; m < M; m += NGW) { const int t = m & (T - 1);
        const u32x2 p = *(const GAS u32x2*)(RW + (size_t)m * RWC + 1536 + c0); u32x2 q = (u32x2){0u, 0u}; if (t > 0) q = *(const GAS u32x2*)(RW + (size_t)(m - 1) * RWC + 1536 + c0);
        f32x4 pv = (f32x4){bflo(p.x), bfhi(p.x), bflo(p.y), bfhi(p.y)}, qv = (f32x4){bflo(q.x), bfhi(q.x), bflo(q.y), bfhi(q.y)};
        f32x4 s = pv + (qv - pv) * mu4;
        if (c0 < 64) { s.x = tanhf(s.x); s.y = tanhf(s.y); s.z = tanhf(s.z); s.w = tanhf(s.w); }
        else if (c0 >= 128) { s.x = 1.f / (1.f + __expf(-s.x)); s.y = 1.f / (1.f + __expf(-s.y)); s.z = 1.f / (1.f + __expf(-s.z)); s.w = 1.f / (1.f + __expf(-s.w)); }
        *(GAS u32x2*)(L + (size_t)m * 256 + c0) = (u32x2){pkbf(s.x, s.y), pkbf(s.z, s.w)}; }
}

namespace rwk {
typedef short bf16x8 __attribute__((ext_vector_type(8)));
constexpr int MB = 8192;
__device__ __forceinline__ int moff(int r, int c) { return r * 128 + ((((c >> 3) ^ (r >> 1)) & 7) << 4) + ((c & 7) << 1); }
__device__ __forceinline__ bf16x8 frag(const LAS unsigned char* buf, int row, int chunk) { return *(const LAS bf16x8*)(buf + row * 128 + (((chunk ^ (row >> 1)) & 7) << 4)); }
struct LaneOff { int f[2], sb, mb[2]; };
__device__ __forceinline__ LaneOff lane_off(int l) { LaneOff o; const int r16 = l & 15, q = l >> 4, key = (l >> 1) & 7;
    o.f[0] = r16 * 128 + (((q) ^ key) << 4); o.f[1] = r16 * 128 + (((4 + q) ^ key) << 4);
    o.sb = r16 * 128 + ((((q >> 1) ^ key) & 7) << 4) + (q & 1) * 8;
#pragma unroll
    for (int p = 0; p < 2; ++p) { const int keyr = (2 * q + p) & 7; o.mb[p] = (4 * q + 2 * p) * 128 + ((((r16 >> 3) ^ keyr) & 7) << 4) + (r16 & 7) * 2; }
    return o; }
__device__ __forceinline__ void mm(f32x4& acc, const LAS unsigned char* A, int tm, const LAS unsigned char* B, int tn, const LaneOff& o) {
#pragma unroll
    for (int ks = 0; ks < 2; ++ks) { const bf16x8 a = *(const LAS bf16x8*)(A + tm * 2048 + o.f[ks]), b = *(const LAS bf16x8*)(B + tn * 2048 + o.f[ks]); acc = __builtin_amdgcn_mfma_f32_16x16x32_bf16(a, b, acc, 0, 0, 0); }
}
struct Fr { bf16x8 k0, k1; };
__device__ __forceinline__ Fr ldfr(const LAS unsigned char* A, int t, const LaneOff& o) { Fr f; f.k0 = *(const LAS bf16x8*)(A + t * 2048 + o.f[0]); f.k1 = *(const LAS bf16x8*)(A + t * 2048 + o.f[1]); return f; }
__device__ __forceinline__ void mmf(f32x4& acc, const Fr& a, const Fr& b) { acc = __builtin_amdgcn_mfma_f32_16x16x32_bf16(a.k0, b.k0, acc, 0, 0, 0); acc = __builtin_amdgcn_mfma_f32_16x16x32_bf16(a.k1, b.k1, acc, 0, 0, 0); }
__device__ __forceinline__ void st_nm(LAS unsigned char* buf, int tm, int tn, const LaneOff& o, f32x4 v) {
    *(LAS u32x2*)(buf + tn * 2048 + (o.sb ^ (tm << 5))) = (u32x2){pkbf(v[0], v[1]), pkbf(v[2], v[3])}; }
__device__ __forceinline__ void st_mn(LAS unsigned char* buf, int tm, int tn, const LaneOff& o, f32x4 v) {
    const unsigned p0 = pkbf(v[0], v[1]), p1 = pkbf(v[2], v[3]); LAS unsigned char* b0 = buf + tm * 2048 + (o.mb[0] ^ (tn << 5)); LAS unsigned char* b1 = buf + tm * 2048 + (o.mb[1] ^ (tn << 5));
    *(LAS unsigned short*)(b0) = (unsigned short)(p0 & 0xffffu); *(LAS unsigned short*)(b0 + 128) = (unsigned short)(p0 >> 16);
    *(LAS unsigned short*)(b1) = (unsigned short)(p1 & 0xffffu); *(LAS unsigned short*)(b1 + 128) = (unsigned short)(p1 >> 16); }
__device__ __forceinline__ f32x4 ld_nm(const LAS unsigned char* buf, int tm, int tn, const LaneOff& o) {
    const u32x2 p = *(const LAS u32x2*)(buf + tn * 2048 + (o.sb ^ (tm << 5))); return (f32x4){bflo(p.x), bfhi(p.x), bflo(p.y), bfhi(p.y)}; }
__device__ __forceinline__ float wsum64(float x) { return wave_sum(x); }
__device__ __forceinline__ float sum8(float x) { x = DPP_ADD(x, 0xB1); x = DPP_ADD(x, 0x4E); x = DPP_ADD(x, 0x141); return x; }
}

__device__ __forceinline__ void rwkv_pre(Frame& F, const ArgsD& A, const int bh, const int c_lo, const int c_hi) {
    using namespace rwk;
    const int b = bh >> 3, h = bh & 7, lane0 = lane_id_v(), w0 = F.wave;
    const LaneOff LO = lane_off(lane0);
    LAS unsigned char* L = F.lds + RING_OFF;
    LAS unsigned char* bA = L + 0 * MB; LAS unsigned char* bR = L + 1 * MB; LAS unsigned char* bB = L + 2 * MB; LAS unsigned char* bK = L + 3 * MB;
    LAS unsigned char* bBH = L + 4 * MB; LAS unsigned char* bKH = L + 5 * MB; LAS unsigned char* bVT = L + 6 * MB;
    LAS unsigned char* bAT = L + 7 * MB;
    LAS unsigned char* bAak = L + 9 * MB; LAS unsigned char* bArb = L + 10 * MB; LAS unsigned char* bArk = L + 11 * MB;
    LAS unsigned char* bQ0 = L + 12 * MB; LAS unsigned char* bQT0 = L + 13 * MB;
    LAS unsigned char* bT = L + 14 * MB;
    LAS unsigned char* bTF = L + 15 * MB;
    LAS float* part = (LAS float*)(F.lds + MISC_OFF + 128);
    LAS float* bon = part + 512;
    const bf16* RW = (const bf16*)(F.ws + WS_RW); const bf16* LW = (const bf16*)(F.ws + WS_LW); const bf16* AS = (const bf16*)(F.ws + WS_AS);
    unsigned char* IMG = F.ws + WS_RIMG; float* BON = (float*)(F.ws + WS_RBON);
    const size_t mb = (size_t)b * T;
    const float* mu = (const float*)A.in[16];
    float mu_r, mu_k, mu_v, kkc, kac, rkc;
    { const int hj = h * 64 + lane0; mu_r = mu[hj]; mu_k = mu[512 + hj]; mu_v = mu[1024 + hj]; kkc = ((const float*)A.in[22])[hj]; kac = ((const float*)A.in[23])[hj]; rkc = ((const float*)A.in[24])[hj]; }
    unsigned short pr[9], pk_[9], pv[9], plw[8], pas[8];
#define RWC_LOAD(c) do { const int w = w0, hj = h * 64 + lane0; const size_t m0_ = mb + (size_t)(c) * 64 + 8 * w; \
        _Pragma("unroll") for (int i_ = 0; i_ < 9; ++i_) { const bool ok_ = (i_ > 0) || ((c) > 0) || (w > 0); const bf16* row_ = RW + (m0_ + i_ - 1) * RWC + hj; \
            pr[i_] = ok_ ? row_[0] : (unsigned short)0; pk_[i_] = ok_ ? row_[512] : (unsigned short)0; pv[i_] = ok_ ? row_[1024] : (unsigned short)0; } \
        _Pragma("unroll") for (int i_ = 0; i_ < 8; ++i_) { plw[i_] = LW[(m0_ + i_) * 512 + hj]; pas[i_] = AS[(m0_ + i_) * 512 + hj]; } } while (0)
    RWC_LOAD(c_lo);
    { float run = 0.f;
#pragma unroll
      for (int i = 0; i < 8; ++i) run += bf2f(plw[i]);
      part[w0 * 64 + lane0] = run; }
    __syncthreads();
    for (int c = c_lo; c < c_hi; ++c) {
        int w = w0, lane = lane0; asm volatile("" : "+s"(w), "+v"(lane));
        const int tn_ = w & 3, tm0_ = 2 * (w >> 2);
        float off = 0.f, ctot = 0.f;
#pragma unroll
        for (int o = 0; o < 8; ++o) { const float p = part[o * 64 + lane]; ctot += p; if (o < w) off += p; }
        {   unsigned bh_[4], kh_[4], vt_[4], at_[4]; float cm = off; float* bon_g = BON + ((size_t)bh * 64 + c) * 64;
#pragma unroll
            for (int i = 0; i < 8; ++i) { const int t = 8 * w + i;
                const float p0 = bf2f(pr[i + 1]), p1 = bf2f(pk_[i + 1]), p2 = bf2f(pv[i + 1]);
                const float rv = p0 + (bf2f(pr[i]) - p0) * mu_r, kv = p1 + (bf2f(pk_[i]) - p1) * mu_k, vv = p2 + (bf2f(pv[i]) - p2) * mu_v, asg = bf2f(pas[i]);
                const float ce = cm; cm += bf2f(plw[i]);
                float kkv = kv * kkc; const float n2 = wsum64(kkv * kkv); kkv = kkv * __builtin_amdgcn_rsqf(fmaxf(n2, 1e-24f));
                const float km = kv * (1.f + (asg - 1.f) * kac); const float bn = wsum64(rv * km * rkc); if (lane == 0) bon_g[t] = bn;
                const float av = -kkv, bv = kkv * asg;
                const float e_ce = __expf(ce), e_cm = __expf(cm), e_ncm = __expf(-cm), e_rem = __expf(ctot - cm);
                const unsigned ha = pkbf(av * e_ce, 0.f) & 0xffffu; *(LAS unsigned short*)(bA + moff(t, lane)) = (unsigned short)ha; *(LAS unsigned short*)(bR + moff(t, lane)) = (unsigned short)(pkbf(rv * e_cm, 0.f) & 0xffffu);
                *(LAS unsigned short*)(bB + moff(t, lane)) = (unsigned short)(pkbf(bv * e_ncm, 0.f) & 0xffffu); *(LAS unsigned short*)(bK + moff(t, lane)) = (unsigned short)(pkbf(km * e_ncm, 0.f) & 0xffffu);
                const unsigned hb = pkbf(bv * e_rem, 0.f) & 0xffffu, hk = pkbf(km * e_rem, 0.f) & 0xffffu, hv = pkbf(vv, 0.f) & 0xffffu;
                if (i & 1) { bh_[i >> 1] |= hb << 16; kh_[i >> 1] |= hk << 16; vt_[i >> 1] |= hv << 16; at_[i >> 1] |= ha << 16; } else { bh_[i >> 1] = hb; kh_[i >> 1] = hk; vt_[i >> 1] = hv; at_[i >> 1] = ha; } }
            *(LAS v4u*)(bBH + moff(lane, 8 * w)) = (v4u){bh_[0], bh_[1], bh_[2], bh_[3]};
            *(LAS v4u*)(bKH + moff(lane, 8 * w)) = (v4u){kh_[0], kh_[1], kh_[2], kh_[3]};
            *(LAS v4u*)(bVT + moff(lane, 8 * w)) = (v4u){vt_[0], vt_[1], vt_[2], vt_[3]};
            *(LAS v4u*)(bAT + moff(lane, 8 * w)) = (v4u){at_[0], at_[1], at_[2], at_[3]};
        }
        const float dec0 = __expf(ctot);
        if (c + 1 < c_hi) RWC_LOAD(c + 1);
        __syncthreads();
        {   const int p = w >> 1; const LAS unsigned char* Am = (p < 2) ? bA : bR; const LAS unsigned char* Bm = (p == 0 || p == 2) ? bB : bK;
            const int tmb = 2 * (w & 1);
            Fr fa[2], fb[4]; f32x4 acc[2][4];
#pragma unroll
            for (int x = 0; x < 2; ++x) fa[x] = ldfr(Am, tmb + x, LO);
#pragma unroll
            for (int tn = 0; tn < 4; ++tn) fb[tn] = ldfr(Bm, tn, LO);
#pragma unroll
            for (int x = 0; x < 2; ++x)
#pragma unroll
                for (int tn = 0; tn < 4; ++tn) { acc[x][tn] = (f32x4){0.f, 0.f, 0.f, 0.f}; mmf(acc[x][tn], fa[x], fb[tn]); }
#pragma unroll
            for (int x = 0; x < 2; ++x) { const int tm = tmb + x;
#pragma unroll
                for (int tn = 0; tn < 4; ++tn) { f32x4 a = acc[x][tn];
                    const int n = 16 * tn + (lane & 15), m0 = 16 * tm + 4 * (lane >> 4);
#pragma unroll
                    for (int r = 0; r < 4; ++r) { const bool keep = (p < 2) ? (n < m0 + r) : (n <= m0 + r); if (!keep) a[r] = 0.f; }
                    if (p == 0) { st_mn(bQ0, tm, tn, LO, a); st_nm(bQT0, tm, tn, LO, a);
#pragma unroll
                        for (int r = 0; r < 4; ++r) if (n == m0 + r) a[r] += 1.f;
                        st_nm(bT, tm, tn, LO, a); }
                    else st_mn((p == 1) ? bAak : (p == 2) ? bArb : bArk, tm, tn, LO, a); } }
        }
        __syncthreads();
#pragma unroll
        for (int x = 0; x < 1; ++x) { const Fr fb = ldfr(bQT0, tn_, LO), fa0 = ldfr(bQ0, tm0_, LO), fa1 = ldfr(bQ0, tm0_ + 1, LO); f32x4 a0 = (f32x4){0.f, 0.f, 0.f, 0.f}, a1 = a0; mmf(a0, fa0, fb); mmf(a1, fa1, fb);
            st_mn(bB, tm0_, tn_, LO, a0); st_nm(bK, tm0_, tn_, LO, a0); st_mn(bB, tm0_ + 1, tn_, LO, a1); st_nm(bK, tm0_ + 1, tn_, LO, a1); }
        __syncthreads();
#pragma unroll
        for (int s = 2; s <= 5; ++s) {
            const LAS unsigned char* Qc = (s & 1) ? bQ0 : bB; const LAS unsigned char* QTc = (s & 1) ? bQT0 : bK;
            LAS unsigned char* Qn = (s & 1) ? bB : bQ0; LAS unsigned char* QTn = (s & 1) ? bK : bQT0;
            const int tn = w & 3;
            if (w >= 4) { f32x4 acc[4]; Fr fa[4]; const Fr fb = ldfr(bT, tn, LO);
#pragma unroll
                for (int tm = 0; tm < 4; ++tm) fa[tm] = ldfr(Qc, tm, LO);
#pragma unroll
                for (int tm = 0; tm < 4; ++tm) acc[tm] = ld_nm(bT, tm, tn, LO);
#pragma unroll
                for (int tm = 0; tm < 4; ++tm) mmf(acc[tm], fa[tm], fb);
#pragma unroll
                for (int tm = 0; tm < 4; ++tm) st_nm(bT, tm, tn, LO, acc[tm]);
            } else { f32x4 acc[4]; Fr fa[4]; const Fr fb = ldfr(QTc, tn, LO);
#pragma unroll
                for (int tm = 0; tm < 4; ++tm) fa[tm] = ldfr(Qc, tm, LO);
#pragma unroll
                for (int tm = 0; tm < 4; ++tm) { acc[tm] = (f32x4){0.f, 0.f, 0.f, 0.f}; mmf(acc[tm], fa[tm], fb); }
#pragma unroll
                for (int tm = 0; tm < 4; ++tm) { st_mn(Qn, tm, tn, LO, acc[tm]); st_nm(QTn, tm, tn, LO, acc[tm]); }
            }
            __syncthreads();
        }
        {
#pragma unroll
            for (int x = 0; x < 1; ++x) { const Fr fb = ldfr(bT, tn_, LO), fa0 = ldfr(bB, tm0_, LO), fa1 = ldfr(bB, tm0_ + 1, LO); f32x4 a0 = ld_nm(bT, tm0_, tn_, LO), a1 = ld_nm(bT, tm0_ + 1, tn_, LO);
                mmf(a0, fa0, fb); mmf(a1, fa1, fb); st_mn(bTF, tm0_, tn_, LO, a0); st_mn(bTF, tm0_ + 1, tn_, LO, a1); }
        }
        LAS unsigned char* bX = bB; LAS unsigned char* bW = bK; LAS unsigned char* bU = bQ0;
        __syncthreads();
#pragma unroll
        for (int x = 0; x < 1; ++x) { const Fr fv = ldfr(bVT, tn_, LO), ft = ldfr(bAT, tn_, LO), fk0 = ldfr(bAak, tm0_, LO), fk1 = ldfr(bAak, tm0_ + 1, LO), ff0 = ldfr(bTF, tm0_, LO), ff1 = ldfr(bTF, tm0_ + 1, LO);
            f32x4 x0 = (f32x4){0.f, 0.f, 0.f, 0.f}, x1 = x0, w0_ = x0, w1_ = x0; mmf(x0, fk0, fv); mmf(x1, fk1, fv); mmf(w0_, ff0, ft); mmf(w1_, ff1, ft);
            st_nm(bX, tm0_, tn_, LO, x0); st_nm(bX, tm0_ + 1, tn_, LO, x1); st_nm(bW, tm0_, tn_, LO, w0_); st_nm(bW, tm0_ + 1, tn_, LO, w1_); }
        __syncthreads();
#pragma unroll
        for (int x = 0; x < 1; ++x) { const Fr fb = ldfr(bX, tn_, LO), fa0 = ldfr(bTF, tm0_, LO), fa1 = ldfr(bTF, tm0_ + 1, LO); f32x4 a0 = (f32x4){0.f, 0.f, 0.f, 0.f}, a1 = a0; mmf(a0, fa0, fb); mmf(a1, fa1, fb);
            st_nm(bU, tm0_, tn_, LO, a0); st_nm(bU, tm0_ + 1, tn_, LO, a1); }
        __syncthreads();
        if (c + 1 < c_hi) { float run = 0.f;
#pragma unroll
          for (int i = 0; i < 8; ++i) run += bf2f(plw[i]);
          part[w * 64 + lane] = run; }
        {   unsigned char* img = IMG + ((size_t)bh * 64 + c) * (4 * MB);
            const int n_ = 16 * tn_ + (lane & 15); const float decn = __shfl(dec0, n_);
#pragma unroll
            for (int x = 0; x < 2; ++x) { const int tm = tm0_ + x; const int m0 = 16 * tm + 4 * (lane >> 4); const int go = moff(n_, m0);
                { f32x4 acc = (f32x4){0.f, 0.f, 0.f, 0.f}; mm(acc, bW, tm, bBH, tn_, LO);
#pragma unroll
                  for (int r = 0; r < 4; ++r) if (m0 + r == n_) acc[r] += decn;
                  *(GAS u32x2*)(img + 0 * MB + go) = (u32x2){pkbf(acc[0], acc[1]), pkbf(acc[2], acc[3])}; }
                { f32x4 acc = (f32x4){0.f, 0.f, 0.f, 0.f}; mm(acc, bBH, tm, bU, tn_, LO); mm(acc, bKH, tm, bVT, tn_, LO);
                  *(GAS u32x2*)(img + 1 * MB + go) = (u32x2){pkbf(acc[0], acc[1]), pkbf(acc[2], acc[3])}; }
                { f32x4 acc = ld_nm(bR, tm, tn_, LO); mm(acc, bW, tm, bArb, tn_, LO);
                  *(GAS u32x2*)(img + 2 * MB + go) = (u32x2){pkbf(acc[0], acc[1]), pkbf(acc[2], acc[3])}; }
                { f32x4 acc = (f32x4){0.f, 0.f, 0.f, 0.f}; mm(acc, bArb, tm, bU, tn_, LO); mm(acc, bArk, tm, bVT, tn_, LO);
                  *(GAS u32x2*)(img + 3 * MB + go) = (u32x2){pkbf(acc[0], acc[1]), pkbf(acc[2], acc[3])}; } }
        }
        __syncthreads();
    }
#undef RWC_LOAD
}

__device__ __forceinline__ void rwkv_seq(Frame& F, const ArgsD& A, const int bh) {
    using namespace rwk;
    const int b = bh >> 3, h = bh & 7, lane0 = lane_id_v(), w0 = F.wave;
    const LaneOff LO = lane_off(lane0);
    LAS unsigned char* L = F.lds + RING_OFF;
    LAS unsigned char* bS0 = L + 8 * MB;
    LAS float* ybuf = (LAS float*)(L + 10 * MB);
    const bf16* RW = (const bf16*)(F.ws + WS_RW); const bf16* G = (const bf16*)(F.ws + WS_G); bf16* YC = (bf16*)(F.ws + WS_YCAT);
    const unsigned char* IMG = F.ws + WS_RIMG + (size_t)bh * 64 * (4 * MB); const float* BON = (const float*)(F.ws + WS_RBON) + (size_t)bh * 64 * 64;
    const float* mu = (const float*)A.in[16]; const float* lnw_g = (const float*)A.in[25]; const float* lnb_g = (const float*)A.in[26];
    const size_t mb = (size_t)b * T;
    const int tid0 = w0 * 64 + lane0, lt0 = tid0 >> 3, hlc0 = h * 64 + (tid0 & 7) * 8;
    for (int i = tid0; i < MB / 16; i += 512) ((LAS v4u*)bS0)[i] = (v4u){0u, 0u, 0u, 0u};
    const f32x4 lw0 = *(const f32x4*)(lnw_g + hlc0), lw1 = *(const f32x4*)(lnw_g + hlc0 + 4), lb0 = *(const f32x4*)(lnb_g + hlc0), lb1 = *(const f32x4*)(lnb_g + hlc0 + 4), mv0 = *(const f32x4*)(mu + 1024 + hlc0), mv1 = *(const f32x4*)(mu + 1024 + hlc0 + 4);
    v4u pf[4][4], lvp[4], lvq[4], lgg[4]; float lbn[4];
#define RWS_LOAD(u, c) do { _Pragma("unroll") for (int k_ = 0; k_ < 4; ++k_) pf[u][k_] = *(const GAS v4u*)(IMG + (size_t)(c) * (4 * MB) + k_ * MB + tid0 * 16); \
        const size_t ml_ = mb + (size_t)(c) * 64 + lt0; lvp[u] = *(const GAS v4u*)(RW + ml_ * RWC + 1024 + hlc0); lvq[u] = *(const GAS v4u*)(RW + (ml_ - (((c) > 0 || lt0 > 0) ? 1 : 0)) * RWC + 1024 + hlc0); \
        lgg[u] = *(const GAS v4u*)(G + ml_ * 512 + hlc0); lbn[u] = BON[(c) * 64 + lt0]; } while (0)
#pragma unroll
    for (int u = 0; u < 4; ++u) RWS_LOAD(u, u);
    int scur = 0;
    for (int c4 = 0; c4 < T / 64; c4 += 4) {
#pragma unroll
      for (int u = 0; u < 4; ++u) { const int c = c4 + u;
        int w = w0, lane = lane0; asm volatile("" : "+s"(w), "+v"(lane));
        const int tid = w * 64 + lane, tn_ = w & 3, tm0_ = 2 * (w >> 2), lt = tid >> 3, lc = (tid & 7) * 8, hlc = h * 64 + lc;
        LAS unsigned char* set = L + (c & 1) * (4 * MB);
#pragma unroll
        for (int k = 0; k < 4; ++k) *(LAS v4u*)(set + k * MB + tid * 16) = pf[u][k];
        const v4u lv_p = lvp[u], lv_q = (c > 0 || lt > 0) ? lvq[u] : (v4u){0u, 0u, 0u, 0u}; const f32x4 lg0 = (f32x4){bflo(lgg[u].x), bfhi(lgg[u].x), bflo(lgg[u].y), bfhi(lgg[u].y)}, lg1 = (f32x4){bflo(lgg[u].z), bfhi(lgg[u].z), bflo(lgg[u].w), bfhi(lgg[u].w)}; const float bn = lbn[u];
        __syncthreads();
        if (c + 4 < T / 64) RWS_LOAD(u, c + 4);
        const LAS unsigned char* Sc = bS0 + scur * MB; LAS unsigned char* Sn = bS0 + (scur ^ 1) * MB;
#pragma unroll
        for (int x = 0; x < 2; ++x) { const int tm = tm0_ + x;
            { f32x4 acc = ld_nm(set + 1 * MB, tm, tn_, LO); mm(acc, set + 0 * MB, tm, Sc, tn_, LO); st_nm(Sn, tm, tn_, LO, acc); }
            { f32x4 acc = ld_nm(set + 3 * MB, tm, tn_, LO); mm(acc, set + 2 * MB, tm, Sc, tn_, LO);
              const int i = 16 * tn_ + (lane & 15), t0 = 16 * tm + 4 * (lane >> 4);
#pragma unroll
              for (int r = 0; r < 4; ++r) ybuf[(t0 + r) * 64 + i] = acc[r]; } }
        scur ^= 1;
        __syncthreads();
        {   const f32x4 y0 = *(const LAS f32x4*)(ybuf + lt * 64 + lc), y1 = *(const LAS f32x4*)(ybuf + lt * 64 + lc + 4);
            const float mean = sum8((y0.x + y0.y) + (y0.z + y0.w) + (y1.x + y1.y) + (y1.z + y1.w)) * (1.f / 64.f); const f32x4 d0 = y0 - mean, d1 = y1 - mean;
            const float var = sum8((d0.x * d0.x + d0.y * d0.y) + (d0.z * d0.z + d0.w * d0.w) + (d1.x * d1.x + d1.y * d1.y) + (d1.z * d1.z + d1.w * d1.w)) * (1.f / 64.f); const float rs = __builtin_amdgcn_rsqf(var + 64e-5f);
            f32x4 va = (f32x4){bflo(lv_p.x), bfhi(lv_p.x), bflo(lv_p.y), bfhi(lv_p.y)}, vb = (f32x4){bflo(lv_p.z), bfhi(lv_p.z), bflo(lv_p.w), bfhi(lv_p.w)};
            { const f32x4 qa = (f32x4){bflo(lv_q.x), bfhi(lv_q.x), bflo(lv_q.y), bfhi(lv_q.y)}, qb = (f32x4){bflo(lv_q.z), bfhi(lv_q.z), bflo(lv_q.w), bfhi(lv_q.w)}; va = va + (qa - va) * mv0; vb = vb + (qb - vb) * mv1; }
            const f32x4 o0 = ((d0 * rs) * lw0 + lb0 + va * bn) * lg0, o1 = ((d1 * rs) * lw1 + lb1 + vb * bn) * lg1;
            *(GAS v4u*)(YC + (mb + (size_t)c * 64 + lt) * 1024 + 512 + hlc) = (v4u){pkbf(o0.x, o0.y), pkbf(o0.z, o0.w), pkbf(o1.x, o1.y), pkbf(o1.z, o1.w)};
        }
      }
    }
#undef RWS_LOAD
}

__device__ __forceinline__ void p6_dacombine(Frame& F, const ArgsD& A) {
    const int lane = lane_id_v(), tid = F.wave * 64 + lane; (void)tid;
    const float* q1 = (const float*)A.in[11]; const float* k1 = (const float*)A.in[12]; const float* q2 = (const float*)A.in[13]; const float* k2 = (const float*)A.in[14];
    const float lam = __expf(wave_sum(q1[lane] * k1[lane])) - __expf(wave_sum(q2[lane] * k2[lane])) + 0.2f;
    const bf16* O = (const bf16*)(F.ws + WS_O); bf16* YC = (bf16*)(F.ws + WS_YCAT);
    const int gw = F.vcu * NWAVES + F.wave, NGW = F.G * NWAVES, dh = lane >> 4, d0 = 8 * (lane & 15);
    const float* sw = (const float*)A.in[15] + d0; const f32x4 swa = *(const f32x4*)sw * 0.8f, swb = *(const f32x4*)(sw + 4) * 0.8f;
    for (int m = gw; m < M; m += NGW) {
        const v4u a = *(const GAS v4u*)(O + (size_t)m * 1024 + dh * 256 + d0), c = *(const GAS v4u*)(O + (size_t)m * 1024 + dh * 256 + 128 + d0);
        f32x4 y0 = (f32x4){bflo(a.x) - lam * bflo(c.x), bfhi(a.x) - lam * bfhi(c.x), bflo(a.y) - lam * bflo(c.y), bfhi(a.y) - lam * bfhi(c.y)};
        f32x4 y1 = (f32x4){bflo(a.z) - lam * bflo(c.z), bfhi(a.z) - lam * bfhi(c.z), bflo(a.w) - lam * bflo(c.w), bfhi(a.w) - lam * bfhi(c.w)};
        float s2 = (y0.x * y0.x + y0.y * y0.y) + (y0.z * y0.z + y0.w * y0.w) + (y1.x * y1.x + y1.y * y1.y) + (y1.z * y1.z + y1.w * y1.w);
        s2 = allsum16(s2); const float rs = 1.f / sqrtf(s2 * (1.f / 128.f) + 1e-5f);
        y0 = y0 * rs * swa; y1 = y1 * rs * swb;
        *(GAS v4u*)(YC + (size_t)m * 1024 + dh * 128 + d0) = (v4u){pkbf(y0.x, y0.y), pkbf(y0.z, y0.w), pkbf(y1.x, y1.y), pkbf(y1.z, y1.w)}; }
}

#define P9_SWAP32(a, b) do { const auto r_ = __builtin_amdgcn_permlane32_swap(__float_as_uint(a), __float_as_uint(b), false, false); (a) = __uint_as_float(r_[0]) + __uint_as_float(r_[1]); } while (0)
#define P9_SWAP16(a, b) do { const auto r_ = __builtin_amdgcn_permlane16_swap(__float_as_uint(a), __float_as_uint(b), false, false); (a) = __uint_as_float(r_[0]) + __uint_as_float(r_[1]); } while (0)
#define P9_DPPF(x, ctrl) __builtin_bit_cast(float, __builtin_amdgcn_update_dpp(0, __builtin_bit_cast(int, (x)), (ctrl), 0xF, 0xF, true))
#define P9_DPPU(x, ctrl) ((unsigned)__builtin_amdgcn_update_dpp(0, (int)(x), (ctrl), 0xF, 0xF, true))
__device__ __forceinline__ float p9_reduce32(float (&a)[32], const int lane) {
#pragma unroll
    for (int e = 0; e < 16; ++e) P9_SWAP32(a[e], a[e + 16]);
#pragma unroll
    for (int e = 0; e < 8; ++e) P9_SWAP16(a[e], a[e + 8]);
    const bool b3 = (lane & 8) != 0, b2 = (lane & 4) != 0, b0 = (lane & 1) != 0;
#pragma unroll
    for (int e = 0; e < 4; ++e) { const float keep = b3 ? a[e + 4] : a[e], send = b3 ? a[e] : a[e + 4]; a[e] = keep + P9_DPPF(send, 0x128); }
#pragma unroll
    for (int e = 0; e < 2; ++e) { const float keep = b2 ? a[e + 2] : a[e], send = b2 ? a[e] : a[e + 2]; a[e] = keep + P9_DPPF(send, 0x141); }
    { const float keep = b0 ? a[1] : a[0], send = b0 ? a[0] : a[1]; a[0] = keep + P9_DPPF(send, 0xB1); }
    return a[0] + P9_DPPF(a[0], 0x4E);
}
__device__ __forceinline__ unsigned p9_wmax(unsigned v) {
    v = max(v, P9_DPPU(v, 0xB1)); v = max(v, P9_DPPU(v, 0x4E)); v = max(v, P9_DPPU(v, 0x124)); v = max(v, P9_DPPU(v, 0x128));
    const unsigned s0 = __builtin_amdgcn_readlane(v, 0), s1 = __builtin_amdgcn_readlane(v, 16), s2 = __builtin_amdgcn_readlane(v, 32), s3 = __builtin_amdgcn_readlane(v, 48);
    return max(max(s0, s1), max(s2, s3)); }
__device__ __forceinline__ unsigned p9_hmax32(unsigned v) {
    v = max(v, P9_DPPU(v, 0xB1)); v = max(v, P9_DPPU(v, 0x4E)); v = max(v, P9_DPPU(v, 0x124)); v = max(v, P9_DPPU(v, 0x128));
    const auto r_ = __builtin_amdgcn_permlane16_swap(v, v, false, false); return max(r_[0], r_[1]); }
__device__ __forceinline__ void p8_postmix_router(Frame& F, const ArgsD& A, const int cset) {
    typedef rwk::bf16x8 bf16x8;
    const int lane = lane_id_v(), wv = F.wave, tid = wv * 64 + lane;
    LAS unsigned char* tileH = F.lds + RING_OFF;
    LAS float* red = (LAS float*)(F.lds + RING_OFF + 65536);
    volatile LAS int* lcnt = (volatile LAS int*)(F.lds + LDSCTL_OFF);
    if (tid < 32) lcnt[tid] = 0;
    bf16x8 bh[2][4], bl[2][4];
    { const float* r = (const float*)A.in[27];
#pragma unroll
      for (int nt = 0; nt < 2; ++nt)
#pragma unroll
        for (int ks = 0; ks < 4; ++ks) { const float* rp = r + (size_t)(128 * wv + 32 * ks + 8 * (lane >> 4)) * 32 + 16 * nt + (lane & 15);
            float w_[8];
#pragma unroll
            for (int q = 0; q < 8; ++q) w_[q] = rp[q * 32];
            v4u h, l;
            h.x = pkbf(w_[0], w_[1]); h.y = pkbf(w_[2], w_[3]); h.z = pkbf(w_[4], w_[5]); h.w = pkbf(w_[6], w_[7]);
            l.x = pkbf(w_[0] - bflo(h.x), w_[1] - bfhi(h.x)); l.y = pkbf(w_[2] - bflo(h.y), w_[3] - bfhi(h.y)); l.z = pkbf(w_[4] - bflo(h.z), w_[5] - bfhi(h.z)); l.w = pkbf(w_[6] - bflo(h.w), w_[7] - bfhi(h.w));
            bh[nt][ks] = __builtin_bit_cast(bf16x8, h); bl[nt][ks] = __builtin_bit_cast(bf16x8, l); } }
    __syncthreads();
    const float* x = (const float*)A.in[0]; const bf16* Y = (const bf16*)(F.ws + WS_Y); const float* mod = (const float*)(F.ws + WS_MOD);
    const float* pmn = (const float*)A.in[6]; const float* pfn = (const float*)A.in[7]; const float* rb = (const float*)A.in[28];
    unsigned char* H2 = F.ws + WS_H2; int* tokE = (int*)(F.ws + WS_TOKE); float* tokG = (float*)(F.ws + WS_TOKG);
    bf16* X1 = (bf16*)(F.ws + WS_X1);
    const int rows_per = M / F.G, mbeg = F.vcu * rows_per, b = mbeg >> 12; const float* mb_ = mod + (size_t)b * NMOD;
    f32x4 a1[4], a2[4], sh[4];
#pragma unroll
    for (int j = 0; j < 4; ++j) { const int col = 4 * lane + 256 * j; a1[j] = *(const f32x4*)(pmn + col) * *(const f32x4*)(mb_ + 2048 + col); a2[j] = *(const f32x4*)(pfn + col) * (*(const f32x4*)(mb_ + 4096 + col) + 1.f); sh[j] = *(const f32x4*)(mb_ + 3072 + col); }
    const float rbias = rb[lane & 31];
    const int nr = rows_per / NWAVES, m0 = mbeg + wv * nr;
    u32x2 yp[2][4]; f32x4 xp[2][4];
#define P9_LOAD(m_) do { _Pragma("unroll") for (int t_ = 0; t_ < 2; ++t_) _Pragma("unroll") for (int j_ = 0; j_ < 4; ++j_) { \
        yp[t_][j_] = *((const GAS u32x2*)(Y + (size_t)((m_) + t_) * D) + lane + 64 * j_); xp[t_][j_] = *((const GAS f32x4*)(x + (size_t)((m_) + t_) * D) + lane + 64 * j_); } } while (0)
    P9_LOAD(m0);
    for (int i = 0; i < nr; i += 2) { const int m = m0 + i;
#pragma unroll
        for (int t = 0; t < 2; ++t) { f32x4 yv[4], xv[4]; float s2 = 0.f;
#pragma unroll
            for (int j = 0; j < 4; ++j) { const u32x2 p = yp[t][j]; yv[j] = (f32x4){bflo(p.x), bfhi(p.x), bflo(p.y), bfhi(p.y)}; s2 += (yv[j].x * yv[j].x + yv[j].y * yv[j].y) + (yv[j].z * yv[j].z + yv[j].w * yv[j].w); }
            const float rs = __builtin_amdgcn_rsqf(rwk::wsum64(s2) * (1.f / D) + 1e-6f); float t2 = 0.f;
#pragma unroll
            for (int j = 0; j < 4; ++j) { xv[j] = xp[t][j] + a1[j] * (yv[j] * rs); *((GAS u32x2*)(X1 + (size_t)(m + t) * D) + lane + 64 * j) = (u32x2){pkbf(xv[j].x, xv[j].y), pkbf(xv[j].z, xv[j].w)};
                t2 += (xv[j].x * xv[j].x + xv[j].y * xv[j].y) + (xv[j].z * xv[j].z + xv[j].w * xv[j].w); }
            const float rs2 = __builtin_amdgcn_rsqf(rwk::wsum64(t2) * (1.f / D) + 1e-6f);
            const int r = 2 * wv + t;
#pragma unroll
            for (int j = 0; j < 4; ++j) { const f32x4 v = xv[j] * rs2 * a2[j] + sh[j]; *((GAS unsigned*)(H2 + (size_t)(m + t) * D) + lane + 64 * j) = pg8::pk4_fp8(v.x, v.y, v.z, v.w);
                const unsigned h0 = pkbf(v.x, v.y), h1 = pkbf(v.z, v.w), l0 = pkbf(v.x - bflo(h0), v.y - bfhi(h0)), l1 = pkbf(v.z - bflo(h1), v.w - bfhi(h1));
                const int off = r * 2048 + ((((lane >> 1) + 32 * j) ^ r) << 4) + (lane & 1) * 8;
                *(LAS u32x2*)(tileH + off) = (u32x2){h0, h1}; *(LAS u32x2*)(tileH + 32768 + off) = (u32x2){l0, l1}; } }
        if (i + 2 < nr) P9_LOAD(m + 2);
        __syncthreads();
        {   f32x4 acc[2] = {(f32x4){0.f, 0.f, 0.f, 0.f}, (f32x4){0.f, 0.f, 0.f, 0.f}};
#pragma unroll
            for (int ks = 0; ks < 4; ++ks) { const int r = lane & 15, off = r * 2048 + (((16 * wv + 4 * ks + (lane >> 4)) ^ r) << 4);
                const bf16x8 ah = *(const LAS bf16x8*)(tileH + off), al = *(const LAS bf16x8*)(tileH + 32768 + off);
#pragma unroll
                for (int nt = 0; nt < 2; ++nt) { acc[nt] = __builtin_amdgcn_mfma_f32_16x16x32_bf16(al, bl[nt][ks], acc[nt], 0, 0, 0); acc[nt] = __builtin_amdgcn_mfma_f32_16x16x32_bf16(al, bh[nt][ks], acc[nt], 0, 0, 0);
                    acc[nt] = __builtin_amdgcn_mfma_f32_16x16x32_bf16(ah, bl[nt][ks], acc[nt], 0, 0, 0); acc[nt] = __builtin_amdgcn_mfma_f32_16x16x32_bf16(ah, bh[nt][ks], acc[nt], 0, 0, 0); } }
#pragma unroll
            for (int nt = 0; nt < 2; ++nt)
#pragma unroll
                for (int rr = 0; rr < 4; ++rr) red[(wv * 16 + 4 * (lane >> 4) + rr) * 32 + 16 * nt + (lane & 15)] = acc[nt][rr]; }
        __syncthreads();
        {   const int t = lane >> 5, e = lane & 31; float lg = rbias;
#pragma unroll
            for (int w8 = 0; w8 < 8; ++w8) lg += red[(w8 * 16 + 2 * wv + t) * 32 + e];
            const unsigned u = __float_as_uint(lg); unsigned key = (((u >> 31) ? ~u : (u | 0x80000000u)) & ~31u) | (unsigned)(31 - e);
            float tv[4]; int ti[4];
#pragma unroll
            for (int k = 0; k < 4; ++k) { const unsigned mx = p9_hmax32(key); ti[k] = 31 - (int)(mx & 31u); const unsigned kv = mx & ~31u; tv[k] = __uint_as_float((kv >> 31) ? (kv & 0x7fffffffu) : ~kv); if (key == mx) key = 0u; }
            float ew[4], es = 0.f;
#pragma unroll
            for (int k = 0; k < 4; ++k) { ew[k] = __expf(tv[k] - tv[0]); es += ew[k]; }
            if (e < 4) { const int ex = (e == 0) ? ti[0] : (e == 1) ? ti[1] : (e == 2) ? ti[2] : ti[3]; const float g = ((e == 0) ? ew[0] : (e == 1) ? ew[1] : (e == 2) ? ew[2] : ew[3]) / es;
                const int pos = __hip_atomic_fetch_add((LAS int*)lcnt + ex, 1, __ATOMIC_RELAXED, __HIP_MEMORY_SCOPE_WORKGROUP);
                tokE[(size_t)(m + t) * 4 + e] = ex | (pos << 8); tokG[(size_t)(m + t) * 4 + e] = g; } }
    }
#undef P9_LOAD
    __syncthreads();
    if (tid < 32) { const int n = lcnt[tid]; int base = 0; if (n > 0) base = (int)__hip_atomic_fetch_add(F.ctl + CW_ECNT + cset * 64 * NEXP + 64 * tid, (unsigned)n, __ATOMIC_RELAXED, __HIP_MEMORY_SCOPE_AGENT);
        ((int*)(F.ws + WS_BLKBASE))[F.vcu * 32 + tid] = base; }
}

__device__ __forceinline__ void moe_tables(Frame& F) {
    const int lane = lane_id_v(), tid = F.wave * 64 + lane; (void)tid;
    volatile LAS int* ts = (volatile LAS int*)(F.lds + LDSCTL_OFF);
    if (tid < 32) ts[40 + tid] = (int)__hip_atomic_load(F.ctl + CW_ECNT + 64 * tid, __ATOMIC_RELAXED, __HIP_MEMORY_SCOPE_AGENT);
    __syncthreads();
    if (tid == 0) { int acc = 0; for (int e = 0; e < 32; ++e) { ts[e] = acc; acc += (ts[40 + e] + 255) >> 8; } ts[32] = acc; }
    __syncthreads();
}
__device__ __forceinline__ void p9_rows(Frame& F) {
    const int lane = lane_id_v(), tid = F.wave * 64 + lane; (void)tid;
    moe_tables(F);
    volatile LAS int* ts = (volatile LAS int*)(F.lds + LDSCTL_OFF);
    const int* tokE = (const int*)(F.ws + WS_TOKE); const float* tokG = (const float*)(F.ws + WS_TOKG); const int* blkbase = (const int*)(F.ws + WS_BLKBASE) + F.vcu * 32;
    int* tokrow = (int*)(F.ws + WS_TOKROW); int* rowtok = (int*)(F.ws + WS_ROWTOK); float* rowgate = (float*)(F.ws + WS_ROWGATE);
    const int rows_per = M / F.G, mbeg = F.vcu * rows_per;
    for (int i = tid; i < rows_per * 4; i += 512) { const int idx = mbeg * 4 + i; const int pe = tokE[idx], e = pe & 255, pos = pe >> 8; const int row = ts[e] * 256 + blkbase[e] + pos;
        tokrow[idx] = row; rowtok[row] = idx >> 2; rowgate[row] = tokG[idx]; }
    for (int e = F.vcu; e < 32; e += F.G) { const int n = ts[40 + e]; const int r0 = ts[e] * 256 + n, r1 = ts[e + 1] * 256;
        for (int r = r0 + tid; r < r1; r += 512) { rowtok[r] = 0; rowgate[r] = 0.f; } }
}

__device__ __forceinline__ void p12_final(Frame& F, const ArgsD& A, float* dst) {
    const int lane = lane_id_v(), tid = F.wave * 64 + lane; (void)tid;
    const unsigned char* Y2 = F.ws + WS_Y2; const int* tokrow = (const int*)(F.ws + WS_TOKROW); const float* mod = (const float*)(F.ws + WS_MOD); const float* pn = (const float*)A.in[8];
    const int rows_per = M / F.G, mbeg = F.vcu * rows_per, b = mbeg >> 12, nr = rows_per / NWAVES, m0 = mbeg + F.wave * nr;
    const float* mb_ = mod + (size_t)b * NMOD + 5120;
    f32x4 gw[4];
#pragma unroll
    for (int j = 0; j < 4; ++j) { const int col = 4 * lane + 256 * j; gw[j] = *(const f32x4*)(pn + col) * *(const f32x4*)(mb_ + col); }
    const int myrow = tokrow[(size_t)m0 * 4 + (lane < nr * 4 ? lane : 0)];
    const bf16* X1 = (const bf16*)(F.ws + WS_X1);
    unsigned yp[4][4]; u32x2 xp[4];
#define P13_LOAD(i_) do { _Pragma("unroll") for (int k_ = 0; k_ < 4; ++k_) { const int row_ = __builtin_amdgcn_readlane(myrow, 4 * (i_) + k_); \
        _Pragma("unroll") for (int j_ = 0; j_ < 4; ++j_) yp[k_][j_] = *((const GAS unsigned*)(Y2 + (size_t)row_ * D) + lane + 64 * j_); } \
        _Pragma("unroll") for (int j_ = 0; j_ < 4; ++j_) xp[j_] = *((const GAS u32x2*)(X1 + (size_t)(m0 + (i_)) * D) + lane + 64 * j_); } while (0)
    P13_LOAD(0);
#pragma unroll 1
    for (int i = 0; i < nr; ++i) { const int m = m0 + i;
        f32x4 a[4], xv[4]; float s2 = 0.f;
#pragma unroll
        for (int j = 0; j < 4; ++j) { a[j] = (f32x4){0.f, 0.f, 0.f, 0.f};
#pragma unroll
            for (int k = 0; k < 4; ++k) { const unsigned p = yp[k][j]; const f32x2 lo = __builtin_amdgcn_cvt_pk_f32_fp8((int)p, false), hi = __builtin_amdgcn_cvt_pk_f32_fp8((int)p, true); a[j] = a[j] + (f32x4){lo.x, lo.y, hi.x, hi.y}; }
            a[j] = a[j] * pg8::Y8_INV;
            s2 += (a[j].x * a[j].x + a[j].y * a[j].y) + (a[j].z * a[j].z + a[j].w * a[j].w); xv[j] = (f32x4){bflo(xp[j].x), bfhi(xp[j].x), bflo(xp[j].y), bfhi(xp[j].y)}; }
        if (i + 1 < nr) { const int in_ = __builtin_amdgcn_readfirstlane(i + 1);
#pragma unroll
            for (int k_ = 0; k_ < 4; ++k_) { const int row_ = __builtin_amdgcn_readlane(myrow, 4 * in_ + k_);
#pragma unroll
                for (int j_ = 0; j_ < 4; ++j_) yp[k_][j_] = *((const GAS unsigned*)(Y2 + (size_t)row_ * D) + lane + 64 * j_); }
#pragma unroll
            for (int j_ = 0; j_ < 4; ++j_) xp[j_] = *((const GAS u32x2*)(X1 + (size_t)(m + 1) * D) + lane + 64 * j_); }
        const float rs = __builtin_amdgcn_rsqf(wave_sum(s2) * (1.f / D) + 1e-6f);
#pragma unroll
        for (int j = 0; j < 4; ++j) *((GAS f32x4*)(dst + (size_t)m * D) + lane + 64 * j) = xv[j] + gw[j] * (a[j] * rs); }
#undef P13_LOAD
}
__global__ void __launch_bounds__(NWAVES * 64, 2) hybrid_fwd(Args kargs) {
    const ArgsD args{};
    extern __shared__ __attribute__((aligned(16))) unsigned char lds[];
    Frame F;
    F.lds = (LAS unsigned char*)lds;
    F.MISC = (volatile LAS unsigned*)(F.lds + MISC_OFF);
    F.wave = __builtin_amdgcn_readfirstlane((int)threadIdx.x >> 6);
    F.G = gridDim.x; { const int bx = blockIdx.x; F.vcu = (F.G % 8 == 0) ? (bx % 8) * (F.G / 8) + bx / 8 : bx; }
    F.ws = kargs.ws; F.out = kargs.out;
    unsigned char* ws = kargs.ws;
    F.ctl = (gu32*)(ws + WS_CTL);
#define GRID_BAR(seam) do { if (N_LAUNCHES != 1) { if (F.wave == 0 && lane_id_v() == 0) __hip_atomic_store(F.ctl + CW_TMO, 0xBADBA0u | (unsigned)(seam), RLX_AGENT); } else { xcd_barrier(bar); } } while (0)
    for (int u = threadIdx.x; u < (LDS_BYTES - LDSCTL_OFF) / 4; u += NWAVES * 64) ((LAS unsigned*)(F.lds + LDSCTL_OFF))[u] = 0u;
    __syncthreads();
    XcdBarrier bar; bar.bar = (unsigned*)(F.ctl + CW_BAR); bar.x = 0; bar.st = nullptr; bar.wid = F.wave;
    if (N_LAUNCHES == 1) bar = xcd_barrier_post((unsigned*)(F.ctl + CW_BAR), F.MISC + 8, F.wave);
    const int lo = kargs.ph_lo, hi = kargs.ph_hi;
#define IN(k) (lo <= (k) && (k) < hi)
#define PREP(k) (((PROBE_MASK) >> (k)) & 1)
#define BOTH(k) (IN(k) && IN((k) + 1))
    bf16* const H = (bf16*)(ws + WS_H); bf16* const H2 = (bf16*)(ws + WS_H2);

    if (IN(0)) { _Pragma("unroll 1") for (int r_ = 0; r_ <= PREP(0); ++r_) { p0_prologue(F, args); } if (BOTH(0)) GRID_BAR(0); }
    if (IN(1)) { _Pragma("unroll 1") for (int r_ = 0; r_ <= PREP(1); ++r_) { p1_premix(F, args); } if (BOTH(1)) GRID_BAR(1); }
    if (IN(2)) {
        pg8::Gemm g{H, (const bf16*)(ws + WS_WIN), M, IN_COLS, D, 0, nullptr, ws}; pg8::StaticOrder S; S.init(M, IN_COLS, F.G, (int)blockIdx.x);
        pg8::EpiProj E{(bf16*)(ws + WS_Q), (bf16*)(ws + WS_K), (bf16*)(ws + WS_V), (bf16*)(ws + WS_RW), (const float*)(ws + WS_ROPE), attn_body::C2};
        if (PREP(2)) { pg8::gemm_phase<pg8::EpiProj, pg8::StaticOrder, true, true, false>(F.lds + RING_OFF, g, S, E, F.wave); GRID_BAR(102); }
        pg8::gemm_phase<pg8::EpiProj, pg8::StaticOrder, true, true, false>(F.lds + RING_OFF, g, S, E, F.wave);
        if (BOTH(2)) GRID_BAR(2);
    }
    if (IN(3)) { _Pragma("unroll 1") for (int r_ = 0; r_ <= PREP(3); ++r_) { p3_lact(F, args); } if (BOTH(3)) GRID_BAR(3); }
    if (IN(4)) {
        pg8::Gemm g{(const bf16*)(ws + WS_LACT), (const bf16*)(ws + WS_BLORA), M, 1536, 256, 0, nullptr, ws}; pg8::StaticOrder S; S.init(M, 1536, F.G, (int)blockIdx.x);
        pg8::EpiLora E{(bf16*)(ws + WS_LW), (size_t)(WS_AS - WS_LW) / 2, (const float*)args.in[17], (const float*)args.in[19]}; static_assert(WS_G - WS_AS == WS_AS - WS_LW, "LW | AS | G equally spaced");
        if (PREP(4)) { pg8::gemm_phase<pg8::EpiLora, pg8::StaticOrder, true, true, false>(F.lds + RING_OFF, g, S, E, F.wave); GRID_BAR(104); }
        pg8::gemm_phase<pg8::EpiLora, pg8::StaticOrder, true, true, false>(F.lds + RING_OFF, g, S, E, F.wave);
        if (BOTH(4)) GRID_BAR(4);
    }
    if (IN(5)) {
        _Pragma("unroll 1") for (int r_ = 0; r_ <= PREP(5); ++r_)
            for (int u = F.vcu; u < BATCH * 8 * 4; u += F.G) rwkv_pre(F, args, u >> 2, (u & 3) * 16, (u & 3) * 16 + 16);
        if (BOTH(5)) GRID_BAR(5);
    }
    if (IN(6)) {
        _Pragma("unroll 1") for (int r_ = 0; r_ <= PREP(14); ++r_)
            for (int bh = blockIdx.x; bh < BATCH * 8; bh += F.G) rwkv_seq(F, args, bh);
        static_assert(attn_body::ATTN_LDS_BYTES <= RING_BYTES, "attention body geometry vs frame");
        const attn_body::AttnTensors AT{(const attn_body::bf16*)(ws + WS_Q), (const attn_body::bf16*)(ws + WS_K), (const attn_body::bf16*)(ws + WS_V), (attn_body::bf16*)(ws + WS_O)};
        if (PREP(15)) { const attn_body::QueueOrder S0{(unsigned*)(F.ctl + CW_ATTQ + 64), F.MISC + 12, F.wave}; attn_body::attn_phase<attn_body::QueueOrder>((char*)lds + RING_OFF, AT, S0, F.wave); GRID_BAR(106); }
        const attn_body::QueueOrder S{(unsigned*)(F.ctl + CW_ATTQ), F.MISC + 12, F.wave};
        attn_body::attn_phase<attn_body::QueueOrder>((char*)lds + RING_OFF, AT, S, F.wave);
        if (BOTH(6)) GRID_BAR(6);
    }
    if (IN(7)) { _Pragma("unroll 1") for (int r_ = 0; r_ <= PREP(7); ++r_) { p6_dacombine(F, args); } if (BOTH(7)) GRID_BAR(7); }
    if (IN(8)) {
        pg8::Gemm g{(const bf16*)(ws + WS_YCAT), (const bf16*)(ws + WS_WOUT), M, D, D, 0, nullptr, ws}; pg8::StaticOrder S; S.init(M, D, F.G, (int)blockIdx.x);
        pg8::EpiPlain E{(bf16*)(ws + WS_Y), D};
        if (PREP(8)) { pg8::gemm_phase<pg8::EpiPlain, pg8::StaticOrder, true, true, false>(F.lds + RING_OFF, g, S, E, F.wave); GRID_BAR(108); }
        pg8::gemm_phase<pg8::EpiPlain, pg8::StaticOrder, true, true, false>(F.lds + RING_OFF, g, S, E, F.wave);
        if (BOTH(8)) GRID_BAR(8);
    }
    if (IN(9)) { _Pragma("unroll 1") for (int r_ = PREP(9); r_ >= 0; --r_) { p8_postmix_router(F, args, r_); } if (BOTH(9)) GRID_BAR(9); }
    if (IN(10)) { _Pragma("unroll 1") for (int r_ = 0; r_ <= PREP(10); ++r_) { p9_rows(F); } if (BOTH(10)) GRID_BAR(10); }
    if (IN(11)) {
        moe_tables(F);
        const LAS int* ts = (const LAS int*)(F.lds + LDSCTL_OFF);
        pg8::Gemm g{H2, (const bf16*)(ws + WS_W1), MAXROWS, 2048, D / 2, (size_t)2048 * D, (const int*)(ws + WS_ROWTOK), ws};
        pg8::MoeOrder S{__builtin_amdgcn_readfirstlane(ts[32]), 8, 4, F.G, F.vcu, ts};
        pg8::EpiSwiglu E{ws + WS_ACT, (const float*)args.in[30]};
        if (PREP(11)) { pg8::gemm_phase<pg8::EpiSwiglu, pg8::MoeOrder, true, true, true, true>(F.lds + RING_OFF, g, S, E, F.wave); GRID_BAR(111); }
        pg8::gemm_phase<pg8::EpiSwiglu, pg8::MoeOrder, true, true, true, true>(F.lds + RING_OFF, g, S, E, F.wave);
        if (BOTH(11)) GRID_BAR(11);
    }
    if (IN(12)) {
        moe_tables(F);
        const LAS int* ts = (const LAS int*)(F.lds + LDSCTL_OFF);
        pg8::Gemm g{(const bf16*)(ws + WS_ACT), (const bf16*)(ws + WS_W2), MAXROWS, D, D / 2, (size_t)D * D, nullptr, ws};
        pg8::MoeOrder S{__builtin_amdgcn_readfirstlane(ts[32]), 4, 8, F.G, F.vcu, ts};
        pg8::EpiMoe2 E{ws + WS_Y2, (const float*)args.in[32], (const float*)(ws + WS_ROWGATE)};
        if (PREP(12)) { pg8::gemm_phase<pg8::EpiMoe2, pg8::MoeOrder, true, true, false, true>(F.lds + RING_OFF, g, S, E, F.wave); GRID_BAR(112); }
        pg8::gemm_phase<pg8::EpiMoe2, pg8::MoeOrder, true, true, false, true>(F.lds + RING_OFF, g, S, E, F.wave);
        if (BOTH(12)) GRID_BAR(12);
    }
    if (IN(13)) { _Pragma("unroll 1") for (int r_ = PREP(13); r_ >= 0; --r_) { p12_final(F, args, r_ ? (float*)(ws + WS_G) : F.out); } }
#undef IN
#undef PREP
#undef BOTH
}

extern "C" void kernel_launch(void* const* d_in, const int* in_sizes, int n_in, void* d_out, int out_size, void* d_ws, size_t ws_size, hipStream_t stream) {
    static int grid = 0;
    if (grid == 0) {
        if (n_in != 33 || in_sizes[0] != M * D || out_size != M * D || ws_size < WS_END) { fprintf(stderr, "kernel_launch: built for 33 inputs, x and out of %d floats, >= %zu bytes of workspace; got n_in %d, in0 %d, out %d, ws %zu; nothing launched\n", M * D, (size_t)WS_END, n_in, n_in > 0 ? in_sizes[0] : -1, out_size, ws_size); grid = -1; return; }
        int dev = 0, cus = 0, per_cu = 0;
        if (hipGetDevice(&dev) != hipSuccess || hipDeviceGetAttribute(&cus, hipDeviceAttributeMultiprocessorCount, dev) != hipSuccess) { fprintf(stderr, "kernel_launch: hipGetDevice / hipDeviceGetAttribute failed; nothing launched\n"); grid = -1; return; }
        if (hipFuncSetAttribute((const void*)hybrid_fwd, hipFuncAttributeMaxDynamicSharedMemorySize, LDS_BYTES) != hipSuccess) { fprintf(stderr, "kernel_launch: hipFuncSetAttribute failed; nothing launched\n"); grid = -1; return; }
        if (hipOccupancyMaxActiveBlocksPerMultiprocessor(&per_cu, (const void*)hybrid_fwd, NWAVES * 64, LDS_BYTES) != hipSuccess || per_cu < 1)
            fprintf(stderr, "kernel_launch: note: the occupancy query reports %d workgroups per CU\n", per_cu);
        (void)hipGetLastError();
        grid = (cus >= 256) ? 256 : (cus / 32) * 32;
        if (grid != 256) fprintf(stderr, "kernel_launch: launching %d workgroups (built and checked for 256)\n", grid);
    }
    if (grid <= 0) return;
    if (hipMemsetAsync((char*)d_ws + WS_CTL, 0, CTL_ZERO_BYTES, stream) != hipSuccess) { fprintf(stderr, "kernel_launch: hipMemsetAsync of the control words failed; nothing launched\n"); return; }
    Args a{};
    for (int i = 0; i < 33; ++i) a.in[i] = d_in[i];
    a.out = (float*)d_out; a.ws = (unsigned char*)d_ws;
    for (int li = 0; li < N_LAUNCHES; ++li) {
        a.ph_lo = (N_LAUNCHES == 1) ? 0 : li; a.ph_hi = (N_LAUNCHES == 1) ? N_PHASES : li + 1; a.li = li; a.pad = 0;
        hipLaunchKernelGGL(hybrid_fwd, dim3(grid), dim3(NWAVES * 64), LDS_BYTES, stream, a);
        const hipError_t le = hipPeekAtLastError();
        if (le != hipSuccess) { fprintf(stderr, "kernel_launch: launch %d failed: %s\n", li, hipGetErrorName(le)); break; }
    }
}
```

```cpp
#include <hip/hip_runtime.h>
#include <cstdio>
#include <cstdint>
__device__ __forceinline__ int lane_id_v() { int l; asm volatile("v_mbcnt_lo_u32_b32 %0, -1, 0\n\tv_mbcnt_hi_u32_b32 %0, -1, %0" : "=v"(l)); return l; }
namespace pg8 {
#define PG8_LAS __attribute__((address_space(3)))
typedef unsigned short bf16_t;
typedef short bf16x8 __attribute__((ext_vector_type(8)));
typedef float f32x4 __attribute__((ext_vector_type(4)));
typedef unsigned u32x4 __attribute__((ext_vector_type(4)));
typedef int v4i_t __attribute__((ext_vector_type(4)));
typedef int v8i_t __attribute__((ext_vector_type(8)));
typedef v8i_t v8i_a16 __attribute__((aligned(16)));
union frag2_t { bf16x8 pc[2]; v8i_t w; };
constexpr int BM = 256, BK = 64, HALF = 128, HTB = HALF * BK * 2  , STAGE_BYTES = 8 * HTB, NXCD = 8, WGM = 8;

__host__ __device__ __forceinline__ int lds_byte(int r, int c) { const int st = (r >> 4) * 2 + (c >> 5), rr = r & 15, cc = c & 31, ob = rr * 64 + cc * 2; return st * 1024 + (ob ^ (((ob >> 9) & 1) << 5)); }
__host__ __device__ __forceinline__ void stage_rc(int b, int& R, int& C) { const int st = b / 1024, sb = b % 1024, swz = sb ^ (((sb >> 9) & 1) << 5); R = (st >> 1) * 16 + swz / 64; C = (st & 1) * 32 + (swz % 64) / 2; }
__host__ __device__ __forceinline__ int perm32(int rho) { const int n = rho >> 4, i = rho & 15; return 8 * (i >> 2) + 4 * n + (i & 3); }

struct Unit { int pm, pn, e; };
struct Gemm { const bf16_t* A; const bf16_t* Bt; int M, N, K; size_t bstride; const int* rowidx; const void* base; };

struct StaticOrder {
    int nM, nN, nwg, G, c;
    __host__ __device__ void init(int M, int N, int G_, int c_) { nM = M / BM; nN = N / BM; nwg = nM * nN; G = G_; c = c_; }
    __host__ __device__ bool next(int i, Unit& u) const {
        const long L = (long)i * G + c; if (L >= nwg) return false;
        int wgid = (int)L; { const int q = nwg / NXCD, r = nwg % NXCD, xcd = wgid % NXCD, off = wgid / NXCD; wgid = (xcd < r ? xcd * (q + 1) : r * (q + 1) + (xcd - r) * q) + off; }
        const int nig = WGM * nN, gid = wgid / nig, fm = gid * WGM, gsz = (nM - fm) < WGM ? (nM - fm) : WGM;
        u.pm = fm + ((wgid % nig) % gsz); u.pn = (wgid % nig) / gsz; u.e = 0; return true;
    }
    __device__ __forceinline__ void a_ready(const Unit&) const {}
    __device__ __forceinline__ void done(const Unit&) const {}
};

__device__ __forceinline__ unsigned cvt_pk_bf16(float lo, float hi) { unsigned r; asm volatile("v_cvt_pk_bf16_f32 %0, %1, %2" : "=v"(r) : "v"(lo), "v"(hi)); return r; }
typedef float f32x2 __attribute__((ext_vector_type(2)));
typedef unsigned u32x2 __attribute__((ext_vector_type(2)));
__device__ __forceinline__ float sigmoidf_(float x) { return __builtin_amdgcn_rcpf(1.f + __expf(-x)); }

struct MoeOrder {
    int ntiles, nN, RG, G, c; const PG8_LAS int* tstart;
    __device__ __forceinline__ bool next(int i, Unit& u) const {
        const int L = i * G + c, grp = L >> 5, idx = L & 31; u.pn = idx / RG; u.pm = grp * RG + idx % RG; u.e = 0;
        if (u.pm >= ntiles) return false;
        int e = 0;
#pragma unroll
        for (int k = 16; k >= 1; k >>= 1) { if (tstart[e + k] <= u.pm) e += k; }
        u.e = __builtin_amdgcn_readfirstlane(e); return true;
    }
    __device__ __forceinline__ void a_ready(const Unit&) const {}
    __device__ __forceinline__ void done(const Unit&) const {}
};

#define PG8_PACK8(v0, v1) (u32x4){cvt_pk_bf16((v0)[0], (v0)[1]), cvt_pk_bf16((v0)[2], (v0)[3]), cvt_pk_bf16((v1)[0], (v1)[1]), cvt_pk_bf16((v1)[2], (v1)[3])}

struct EpiPlain {
    static constexpr bool PERM = true, AFTER_DRAIN = false;
    bf16_t* O; int ldc;
    __device__ __forceinline__ void operator()(const f32x4 (&acc)[2][2][4][2], const Unit& u, int wr, int wc, int fr, int fq) const {
        const int row0 = u.pm * BM + wr * 64 + fr, col0 = u.pn * BM + wc * 32 + 8 * fq;
#pragma unroll
        for (int ai = 0; ai < 2; ++ai)
#pragma unroll
            for (int m = 0; m < 4; ++m) { bf16_t* rowp = O + (size_t)(row0 + ai * HALF + m * 16) * ldc + col0;
#pragma unroll
                for (int bj = 0; bj < 2; ++bj) { const f32x4 v0 = acc[ai][bj][m][0], v1 = acc[ai][bj][m][1]; *(u32x4*)(rowp + bj * HALF) = PG8_PACK8(v0, v1); } }
    }
};

struct EpiProj {
    static constexpr bool PERM = true, AFTER_DRAIN = false;
    bf16_t *Q, *K, *V, *RW; const float* rope; float qscale;
    __device__ __forceinline__ void operator()(const f32x4 (&acc)[2][2][4][2], const Unit& u, int wr, int wc, int fr, int fq) const {
        const int row0 = u.pm * BM + wr * 64 + fr, cl = wc * 32 + 8 * fq, pn = u.pn;
        if (pn < 4) {
            bf16_t* base = (pn < 2) ? Q : K; const int colt = (pn & 1) * 256; const float sc = (pn < 2) ? qscale : 1.f;
            const bool rp = ((wc & 1) == 0) && (fq < 2);
#pragma unroll
            for (int ai = 0; ai < 2; ++ai)
#pragma unroll
                for (int m = 0; m < 4; ++m) { const int row = row0 + ai * HALF + m * 16;
                    f32x4 cs = (f32x4){1.f, 1.f, 1.f, 1.f}, sn = (f32x4){0.f, 0.f, 0.f, 0.f};
                    if (rp) { cs = *(const f32x4*)(rope + (size_t)row * 16 + 4 * fq); sn = *(const f32x4*)(rope + (size_t)row * 16 + 8 + 4 * fq); }
#pragma unroll
                    for (int bj = 0; bj < 2; ++bj) { f32x4 v0 = acc[ai][bj][m][0], v1 = acc[ai][bj][m][1];
                        { const float a0 = v0[0], b0 = v0[1], a1 = v0[2], b1 = v0[3], a2 = v1[0], b2 = v1[1], a3 = v1[2], b3 = v1[3];
                          v0[0] = a0 * cs[0] - b0 * sn[0]; v0[1] = b0 * cs[0] + a0 * sn[0]; v0[2] = a1 * cs[1] - b1 * sn[1]; v0[3] = b1 * cs[1] + a1 * sn[1];
                          v1[0] = a2 * cs[2] - b2 * sn[2]; v1[1] = b2 * cs[2] + a2 * sn[2]; v1[2] = a3 * cs[3] - b3 * sn[3]; v1[3] = b3 * cs[3] + a3 * sn[3]; }
                        v0 = v0 * sc; v1 = v1 * sc;
                        *(u32x4*)(base + (size_t)row * 512 + colt + bj * HALF + cl) = PG8_PACK8(v0, v1); } }
        } else {
            bf16_t* base; int ld, colt;
            if (pn < 6) { base = V; ld = 512; colt = (pn - 4) * 256; } else { base = RW; ld = 1792; colt = (pn - 6) * 256; }
#pragma unroll
            for (int ai = 0; ai < 2; ++ai)
#pragma unroll
                for (int m = 0; m < 4; ++m) { bf16_t* rowp = base + (size_t)(row0 + ai * HALF + m * 16) * ld + colt + cl;
#pragma unroll
                    for (int bj = 0; bj < 2; ++bj) { const f32x4 v0 = acc[ai][bj][m][0], v1 = acc[ai][bj][m][1]; *(u32x4*)(rowp + bj * HALF) = PG8_PACK8(v0, v1); } }
        }
    }
};

struct EpiLora {
    static constexpr bool PERM = true, AFTER_DRAIN = false;
    bf16_t* LW; size_t kstride; const float *w0, *a0;
    __device__ __forceinline__ void operator()(const f32x4 (&acc)[2][2][4][2], const Unit& u, int wr, int wc, int fr, int fq) const {
        const int row0 = u.pm * BM + wr * 64 + fr, kind = u.pn >> 1, col0 = (u.pn & 1) * 256 + wc * 32 + 8 * fq;
        bf16_t* dst = LW + (size_t)kind * kstride; const float* bias = (kind == 1) ? a0 : w0;
        f32x4 bv[2][2];
#pragma unroll
        for (int bj = 0; bj < 2; ++bj)
#pragma unroll
            for (int n = 0; n < 2; ++n) bv[bj][n] = (kind < 2) ? *(const f32x4*)(bias + col0 + bj * HALF + 4 * n) : (f32x4){0.f, 0.f, 0.f, 0.f};
#pragma unroll
        for (int ai = 0; ai < 2; ++ai)
#pragma unroll
            for (int m = 0; m < 4; ++m) { bf16_t* rowp = dst + (size_t)(row0 + ai * HALF + m * 16) * 512 + col0;
#pragma unroll
                for (int bj = 0; bj < 2; ++bj) { f32x4 vv[2];
#pragma unroll
                    for (int n = 0; n < 2; ++n) { f32x4 v = acc[ai][bj][m][n] + bv[bj][n];
                        if (kind == 0) {
#pragma unroll
                            for (int q = 0; q < 4; ++q) v[q] = -0.60653066f * sigmoidf_(v[q]);
                        } else if (kind == 1) {
#pragma unroll
                            for (int q = 0; q < 4; ++q) v[q] = sigmoidf_(v[q]);
                        }
                        vv[n] = v; }
                    *(u32x4*)(rowp + bj * HALF) = PG8_PACK8(vv[0], vv[1]); } }
    }
};

__device__ __forceinline__ unsigned pk4_fp8(float a, float b, float c_, float d) { int r = __builtin_amdgcn_cvt_pk_fp8_f32(a, b, 0, false); r = __builtin_amdgcn_cvt_pk_fp8_f32(c_, d, r, true); return (unsigned)r; }
constexpr float W8_SCALE = 32.f, W8_INV = 1.f / 32.f;
struct EpiSwiglu {
    static constexpr bool PERM = true, AFTER_DRAIN = false;
    unsigned char* ACT; const float* b1;
    __device__ __forceinline__ void operator()(const f32x4 (&acc)[2][2][4][2], const Unit& u, int wr, int wc, int fr, int fq) const {
        const int row0 = u.pm * BM + wr * 64 + fr, col0 = u.pn * BM + wc * 32 + 8 * fq;
        f32x4 bv[2][2];
#pragma unroll
        for (int bj = 0; bj < 2; ++bj)
#pragma unroll
            for (int n = 0; n < 2; ++n) bv[bj][n] = *(const f32x4*)(b1 + (size_t)u.e * 2048 + col0 + bj * HALF + 4 * n);
#pragma unroll
        for (int ai = 0; ai < 2; ++ai)
#pragma unroll
            for (int m = 0; m < 4; ++m) { unsigned char* rowp = ACT + (size_t)(row0 + ai * HALF + m * 16) * 1024 + (col0 >> 1);
#pragma unroll
                for (int bj = 0; bj < 2; ++bj) { const f32x4 v0 = acc[ai][bj][m][0] * W8_INV + bv[bj][0], v1 = acc[ai][bj][m][1] * W8_INV + bv[bj][1];
                    float o[4];
#pragma unroll
                    for (int q = 0; q < 4; ++q) { const float glu = (q < 2) ? v0[2 * q] : v1[2 * q - 4], lin = (q < 2) ? v0[2 * q + 1] : v1[2 * q - 3];
                        const float gg = fminf(glu, 7.f), ll = fminf(fmaxf(lin, -7.f), 7.f); o[q] = gg * sigmoidf_(1.702f * gg) * (ll + 1.f); }
                    *(unsigned*)(rowp + bj * (HALF / 2)) = pk4_fp8(o[0], o[1], o[2], o[3]); } }
    }
};

constexpr float Y8_SCALE = 32.f, Y8_INV = 1.f / 32.f;
struct EpiMoe2 {
    static constexpr bool PERM = true, AFTER_DRAIN = false;
    unsigned char* Y2; const float* b2; const float* gate;
    __device__ __forceinline__ void operator()(const f32x4 (&acc)[2][2][4][2], const Unit& u, int wr, int wc, int fr, int fq) const {
        const int row0 = u.pm * BM + wr * 64 + fr, col0 = u.pn * BM + wc * 32 + 8 * fq;
#pragma unroll
        for (int bj = 0; bj < 2; ++bj) { const f32x4 b0 = *(const f32x4*)(b2 + (size_t)u.e * 1024 + col0 + bj * HALF), b1 = *(const f32x4*)(b2 + (size_t)u.e * 1024 + col0 + bj * HALF + 4);
#pragma unroll
            for (int ai = 0; ai < 2; ++ai)
#pragma unroll
                for (int m = 0; m < 4; ++m) { const int row = row0 + ai * HALF + m * 16; const float gt = gate[row] * Y8_SCALE;
                    const f32x4 v0 = (acc[ai][bj][m][0] * W8_INV + b0) * gt, v1 = (acc[ai][bj][m][1] * W8_INV + b1) * gt;
                    *(u32x2*)(Y2 + (size_t)row * 1024 + col0 + bj * HALF) = (u32x2){pk4_fp8(v0[0], v0[1], v0[2], v0[3]), pk4_fp8(v1[0], v1[1], v1[2], v1[3])}; } }
    }
};

template <class Epi, class Sched, bool ALIGN_EPI = false, bool SP2 = false, bool GATHER = false, bool FP8 = false>
__device__ __forceinline__ void gemm_phase(PG8_LAS unsigned char* lds, const Gemm g, const Sched& S, const Epi& E, const int wid) {
    const int lane = lane_id_v(), tid = wid * 64 + lane, wr = wid >> 2, wc = wid & 3, fr = lane & 15, fq = lane >> 4;
    const int K = g.K, nt = K / BK;
    const __amdgpu_buffer_rsrc_t rsrc = __builtin_amdgcn_make_buffer_rsrc((void*)g.base, 0, 0x7fffffff, 0x00020000);
    unsigned voffA[2], voffB[2];
#pragma unroll
    for (int i = 0; i < 2; ++i) { int R, C; stage_rc(tid * 16 + i * 8192, R, C); const int Rb = Epi::PERM ? ((R & ~31) + perm32(R & 31)) : R;
        voffA[i] = (unsigned)(R * K + C) * 2u; voffB[i] = (unsigned)(Rb * K + C) * 2u; }
    const size_t kstep = (size_t)(BK * 2);
    const size_t hstep = (size_t)HALF * K * 2;
    const size_t tstep = 2 * hstep;
    const unsigned ldsw = (unsigned)wid * 1024u;
    const int aoff = FP8 ? lds_byte(wr * 64 + fr, fq * 16) : lds_byte(wr * 64 + fr, fq * 8), boff = FP8 ? lds_byte(wc * 32 + fr, fq * 16) : lds_byte(wc * 32 + fr, fq * 8);
    const PG8_LAS unsigned char* ldsA; const PG8_LAS unsigned char* ldsB;
    { unsigned a_ = (unsigned)(size_t)(lds + aoff), b_ = (unsigned)(size_t)(lds + 4 * HTB + boff); asm volatile("" : "+v"(a_), "+v"(b_)); ldsA = (const PG8_LAS unsigned char*)(size_t)a_; ldsB = (const PG8_LAS unsigned char*)(size_t)b_; }
#define PG8_SA(b, h) (((b) * 2 + (h)) * HTB)
#define PG8_SB(b, h) ((4 + (b) * 2 + (h)) * HTB)
#define PG8_STAGE(bufoff, gbase, voff) do { const unsigned so_ = (unsigned)((const char*)(gbase) - (const char*)g.base); _Pragma("unroll") for (int _i = 0; _i < 2; ++_i) \
        __builtin_amdgcn_raw_ptr_buffer_load_lds(rsrc, (PG8_LAS unsigned*)(lds + (bufoff) + ldsw + _i * 8192), 16, (voff)[_i], so_, 0, 0); } while (0)
#define PG8_STAGE_A(bufoff, ptr, h, nx) do { if constexpr (GATHER) { unsigned vo_[2]; vo_[0] = (nx) ? gn[h][0] : gc[h][0]; vo_[1] = (nx) ? gn[h][1] : gc[h][1]; PG8_STAGE(bufoff, ptr, vo_); } \
        else { PG8_STAGE(bufoff, (ptr) + (h) * hstep, voffA); } } while (0)
#define PG8_LDA(dst, b, h) do { _Pragma("unroll") for (int m = 0; m < 4; ++m) _Pragma("unroll") for (int k = 0; k < 2; ++k) dst[m].pc[k] = *(const PG8_LAS bf16x8*)(ldsA + ((b) * 2 + (h)) * HTB + m * 2048 + k * (FP8 ? 16 : 1024)); } while (0)
#define PG8_LDB(dst, b, h) do { _Pragma("unroll") for (int n = 0; n < 2; ++n) _Pragma("unroll") for (int k = 0; k < 2; ++k) dst[n].pc[k] = *(const PG8_LAS bf16x8*)(ldsB + ((b) * 2 + (h)) * HTB + n * 2048 + k * (FP8 ? 16 : 1024)); } while (0)
#define PG8_MMA(ai, bj, At, Bt) do { __builtin_amdgcn_s_setprio(1); _Pragma("unroll") for (int m = 0; m < 4; ++m) _Pragma("unroll") for (int n = 0; n < 2; ++n) { \
        if constexpr (FP8) { acc[ai][bj][m][n] = __builtin_amdgcn_mfma_scale_f32_16x16x128_f8f6f4(Bt[n].w, At[m].w, acc[ai][bj][m][n], 0, 0, 0, 0, 0, 0); } \
        else { _Pragma("unroll") for (int k = 0; k < 2; ++k) acc[ai][bj][m][n] = __builtin_amdgcn_mfma_f32_16x16x32_bf16(Bt[n].pc[k], At[m].pc[k], acc[ai][bj][m][n], 0, 0, 0); } } \
        __builtin_amdgcn_s_setprio(0); } while (0)
#define PG8_WAIT_V(n) asm volatile("s_waitcnt vmcnt(" #n ")" ::: "memory")
#define PG8_WAIT_L(n) asm volatile("s_waitcnt lgkmcnt(" #n ")" ::: "memory")
#define PG8_BAR __builtin_amdgcn_s_barrier()
#define PG8_SCHED __builtin_amdgcn_sched_barrier(0)
    Unit cur, nxt; int ui = 0;
    if (!S.next(0, cur)) return;
    f32x4 acc[2][2][4][2];
#pragma unroll
    for (int a = 0; a < 2; ++a)
#pragma unroll
        for (int b = 0; b < 2; ++b)
#pragma unroll
            for (int m = 0; m < 4; ++m)
#pragma unroll
                for (int n = 0; n < 2; ++n) acc[a][b][m][n] = (f32x4){0.f, 0.f, 0.f, 0.f};
    frag2_t At[4], B0[2], B1[2];
    const char* cA = GATHER ? (const char*)g.A : (const char*)g.A + (size_t)cur.pm * tstep; const char* cB = (const char*)g.Bt + (size_t)cur.e * g.bstride + (size_t)cur.pn * tstep;
    unsigned gc[2][2] = {{0u, 0u}, {0u, 0u}}, gn[2][2] = {{0u, 0u}, {0u, 0u}}; Unit nx2; bool has_nx2 = false;
#define PG8_GOFF(dst, pm_, ok_, alt_) do { const int t_ = lane_id_v() + wid * 64; _Pragma("unroll") for (int i_ = 0; i_ < 2; ++i_) { int R_, C_; stage_rc(t_ * 16 + i_ * 8192, R_, C_); \
        _Pragma("unroll") for (int h_ = 0; h_ < 2; ++h_) dst[h_][i_] = (ok_) ? (unsigned)g.rowidx[(pm_) * BM + h_ * HALF + R_] * (unsigned)(K * 2) + (unsigned)C_ * 2u : alt_[h_][i_]; } } while (0)
    if constexpr (GATHER) {
        PG8_GOFF(gc, cur.pm, true, gc);
        const bool hn = S.next(1, nxt);
        PG8_GOFF(gn, nxt.pm, hn, gc);
    }
    S.a_ready(cur);
    if constexpr (SP2) {
        PG8_STAGE(PG8_SB(0, 0), cB, voffB); PG8_STAGE(PG8_SB(0, 1), cB + hstep, voffB); PG8_STAGE_A(PG8_SA(0, 0), cA, 0, false); PG8_STAGE_A(PG8_SA(0, 1), cA, 1, false);
        if (wr == 1) PG8_BAR;
        PG8_WAIT_V(2); PG8_BAR;
        PG8_STAGE(PG8_SB(1, 0), cB + kstep, voffB); PG8_STAGE_A(PG8_SA(1, 0), cA + kstep, 0, false); PG8_STAGE(PG8_SB(1, 1), cB + hstep + kstep, voffB);
        PG8_WAIT_V(6); PG8_BAR;
    } else {
        PG8_STAGE(PG8_SB(0, 0), cB, voffB); PG8_STAGE_A(PG8_SA(0, 0), cA, 0, false); PG8_STAGE(PG8_SB(0, 1), cB + hstep, voffB); PG8_STAGE_A(PG8_SA(0, 1), cA, 1, false);
        if (wr == 1) PG8_BAR;
        PG8_WAIT_V(4); PG8_BAR;
        PG8_STAGE(PG8_SB(1, 0), cB + kstep, voffB); PG8_STAGE_A(PG8_SA(1, 0), cA + kstep, 0, false); PG8_STAGE(PG8_SB(1, 1), cB + hstep + kstep, voffB);
        PG8_WAIT_V(6); PG8_BAR;
    }
    for (;;) {
        const bool has_next = S.next(ui + 1, nxt);
        const char* nA = GATHER ? (const char*)g.A : (has_next ? (const char*)g.A + (size_t)nxt.pm * tstep : cA); const char* nB = has_next ? (const char*)g.Bt + (size_t)nxt.e * g.bstride + (size_t)nxt.pn * tstep : cB;
        for (int t = 0; t < nt; t += 2) {
            const bool last = (t == nt - 2);
            asm volatile("" : "+v"(voffA[0]), "+v"(voffA[1]), "+v"(voffB[0]), "+v"(voffB[1]));
            if constexpr (GATHER) asm volatile("" : "+v"(gc[0][0]), "+v"(gc[0][1]), "+v"(gc[1][0]), "+v"(gc[1][1]), "+v"(gn[0][0]), "+v"(gn[0][1]), "+v"(gn[1][0]), "+v"(gn[1][1]));
            const char* a1 = cA + (size_t)(t + 1) * kstep;
            const char* a2 = last ? nA : cA + (size_t)(t + 2) * kstep; const char* b2 = last ? nB : cB + (size_t)(t + 2) * kstep;
            const char* a3 = a2 + kstep; const char* b3 = b2 + kstep;
            if (last && has_next) S.a_ready(nxt);
            if constexpr (SP2) {
            PG8_LDB(B0, 0, 0); PG8_LDB(B1, 0, 1); PG8_SCHED; PG8_LDA(At, 0, 0); PG8_STAGE_A(PG8_SA(1, 1), a1, 1, false);
            PG8_WAIT_V(8); PG8_WAIT_L(0); PG8_BAR; PG8_MMA(0, 0, At, B0); PG8_MMA(0, 1, At, B1); PG8_BAR; PG8_SCHED;
            PG8_LDA(At, 0, 1); PG8_STAGE(PG8_SB(0, 0), b2, voffB); PG8_STAGE(PG8_SB(0, 1), b2 + hstep, voffB); PG8_STAGE_A(PG8_SA(0, 0), a2, 0, last);
            PG8_WAIT_V(8); PG8_WAIT_L(0); PG8_BAR; PG8_MMA(1, 0, At, B0); PG8_MMA(1, 1, At, B1); PG8_BAR; PG8_SCHED;
            PG8_LDB(B0, 1, 0); PG8_LDB(B1, 1, 1); PG8_SCHED; PG8_LDA(At, 1, 0); PG8_STAGE_A(PG8_SA(0, 1), a2, 1, last);
            PG8_WAIT_V(8); PG8_WAIT_L(0); PG8_BAR; PG8_MMA(0, 0, At, B0); PG8_MMA(0, 1, At, B1); PG8_BAR; PG8_SCHED;
            PG8_LDA(At, 1, 1); PG8_STAGE(PG8_SB(1, 0), b3, voffB); PG8_STAGE(PG8_SB(1, 1), b3 + hstep, voffB); PG8_STAGE_A(PG8_SA(1, 0), a3, 0, last);
            PG8_WAIT_V(8); PG8_WAIT_L(0); PG8_BAR; PG8_MMA(1, 0, At, B0); PG8_MMA(1, 1, At, B1); PG8_BAR; PG8_SCHED;
            } else {
            PG8_LDB(B0, 0, 0); PG8_SCHED; PG8_LDA(At, 0, 0); PG8_STAGE_A(PG8_SA(1, 1), a1, 1, false);
            PG8_WAIT_L(8); PG8_BAR; PG8_WAIT_L(0); PG8_MMA(0, 0, At, B0); PG8_BAR; PG8_SCHED;
            PG8_LDB(B1, 0, 1); PG8_STAGE(PG8_SB(0, 0), b2, voffB);
            PG8_BAR; PG8_WAIT_L(0); PG8_MMA(0, 1, At, B1); PG8_BAR;
            PG8_LDA(At, 0, 1); PG8_STAGE_A(PG8_SA(0, 0), a2, 0, last);
            PG8_BAR; PG8_WAIT_L(0); PG8_MMA(1, 0, At, B0); PG8_BAR; PG8_SCHED;
            PG8_STAGE(PG8_SB(0, 1), b2 + hstep, voffB);
            PG8_WAIT_V(6); PG8_BAR; PG8_MMA(1, 1, At, B1); PG8_BAR;
            PG8_LDB(B0, 1, 0); PG8_SCHED; PG8_LDA(At, 1, 0); PG8_STAGE_A(PG8_SA(0, 1), a2, 1, last);
            PG8_WAIT_L(8); PG8_BAR; PG8_WAIT_L(0); PG8_MMA(0, 0, At, B0); PG8_BAR; PG8_SCHED;
            PG8_LDB(B1, 1, 1); PG8_STAGE(PG8_SB(1, 0), b3, voffB);
            PG8_BAR; PG8_WAIT_L(0); PG8_MMA(0, 1, At, B1); PG8_BAR;
            PG8_LDA(At, 1, 1); PG8_STAGE_A(PG8_SA(1, 0), a3, 0, last);
            PG8_BAR; PG8_WAIT_L(0); PG8_MMA(1, 0, At, B0); PG8_BAR; PG8_SCHED;
            PG8_STAGE(PG8_SB(1, 1), b3 + hstep, voffB);
            PG8_WAIT_V(6); PG8_BAR; PG8_MMA(1, 1, At, B1); PG8_BAR;
            }
        }
        if constexpr (GATHER) { has_nx2 = has_next && S.next(ui + 2, nx2);
            _Pragma("unroll") for (int h = 0; h < 2; ++h) _Pragma("unroll") for (int i = 0; i < 2; ++i) gc[h][i] = gn[h][i];
            PG8_GOFF(gn, nx2.pm, has_nx2, gc); }
        if constexpr (ALIGN_EPI) { if (wr == 0) PG8_BAR; }
        if constexpr (!Epi::AFTER_DRAIN) { const int l_ = lane_id_v(); const int fr_ = l_ & 15, fq_ = l_ >> 4;
            E(acc, cur, wr, wc, fr_, fq_); S.done(cur); }
        if (!has_next) break;
#pragma unroll
        for (int a = 0; a < 2; ++a)
#pragma unroll
            for (int b = 0; b < 2; ++b)
#pragma unroll
                for (int m = 0; m < 4; ++m)
#pragma unroll
                    for (int n = 0; n < 2; ++n) acc[a][b][m][n] = (f32x4){0.f, 0.f, 0.f, 0.f};
        if constexpr (GATHER) { asm volatile("" : "+v"(gn[0][0]), "+v"(gn[0][1]), "+v"(gn[1][0]), "+v"(gn[1][1])); }
        cur = nxt; cA = nA; cB = nB; ++ui;
        if constexpr (ALIGN_EPI) { if (wr == 1) PG8_BAR; }
    }
    PG8_WAIT_V(0);
    if constexpr (!ALIGN_EPI) { if (wr == 0) PG8_BAR; }
    PG8_BAR;
    if constexpr (Epi::AFTER_DRAIN) { E.fused(acc, cur, wr, wc, fr, fq, lds, wid, lane); S.done(cur); }
#undef PG8_SA
#undef PG8_SB
#undef PG8_STAGE
#undef PG8_STAGE_A
#undef PG8_GOFF
#undef PG8_LDA
#undef PG8_LDB
#undef PG8_MMA
#undef PG8_WAIT_V
#undef PG8_WAIT_L
#undef PG8_BAR
#undef PG8_SCHED
}
}
#include <hip/hip_bf16.h>
#include <cmath>
namespace attn_body {
using bf16=__hip_bfloat16;
using bf16x8=__attribute__((ext_vector_type(8)))short;
using s16x4=__attribute__((ext_vector_type(4)))short;
using f32x16=__attribute__((ext_vector_type(16)))float;
using u32x4=__attribute__((ext_vector_type(4)))unsigned;
constexpr int BATCH=8,NHEAD=8,SEQ=4096,D=64;
constexpr int QP=512,KP=512,VP=512,OP=1024;
constexpr int NW=8,QBLK=32,QB=QBLK*NW,KVBLK=64,NQB=SEQ/QB;
constexpr int ATTN_UNIT_ROWS=QB;
__device__ __forceinline__ int crow(int r,int hi){return (r&3)+8*(r>>2)+4*hi;}
#define SBAR() __builtin_amdgcn_sched_barrier(0)
__device__ __forceinline__ void cmask(f32x16&p0,f32x16&p1,int jb,int qrel,int hi){
  const float NEG=-INFINITY; int kb=64*jb+4*hi;
  #pragma unroll
  for(int r=0;r<16;++r){int kv=kb+(r&3)+8*(r>>2); if(kv>qrel)p0[r]=NEG; if(kv+32>qrel)p1[r]=NEG;}
}

constexpr int NSLOT=3, SLOTB=8192;
constexpr int LDS_K=0, LDS_V=NSLOT*SLOTB, LDS_WS=3*NSLOT*SLOTB, LDS_Q=LDS_WS+NW*64*4, LDS_OST=LDS_Q, LDS_BYTES=LDS_Q+NW*4096;
constexpr float C2=0.125f*1.4426950408889634f;
__device__ __forceinline__ void glds16(const void*gsrc,unsigned lds_dst){unsigned keep;
  asm volatile("s_mov_b32 %0, m0\n\ts_mov_b32 m0, %2\n\ts_nop 0\n\tglobal_load_lds_dwordx4 %1, off\n\ts_mov_b32 m0, %0":"=&s"(keep):"v"(gsrc),"s"(lds_dst):"memory");}
__device__ __forceinline__ float max3f(float a,float b,float c){float r;asm("v_max3_f32 %0, %1, %2, %3":"=v"(r):"v"(a),"v"(b),"v"(c));return r;}
__device__ __forceinline__ float max2f(float a,float b){float r;asm("v_max_f32_e32 %0, %1, %2":"=v"(r):"v"(a),"v"(b));return r;}
__device__ __forceinline__ float fadd_s(float a,float b){float r;asm("v_add_f32_e32 %0, %1, %2":"=v"(r):"v"(a),"v"(b));return r;}
__device__ __forceinline__ float fsub_s(float a,float b){float r;asm("v_sub_f32_e32 %0, %1, %2":"=v"(r):"v"(a),"v"(b));return r;}
typedef float f32x2_t __attribute__((ext_vector_type(2))); typedef __bf16 bf16x2_t __attribute__((ext_vector_type(2)));
__device__ __forceinline__ unsigned cvtpk_s(float lo,float hi){f32x2_t v={lo,hi};bf16x2_t b=__builtin_convertvector(v,bf16x2_t);return __builtin_bit_cast(unsigned,b);}
#define WAIT_BAR(N) asm volatile("s_waitcnt vmcnt(" #N ") lgkmcnt(0)\n\ts_barrier":::"memory")

__device__ __forceinline__ void qkt(f32x16&p0,f32x16&p1,const char*Kslot,const __attribute__((address_space(3))) char*qf,int r32,int hi){
  const char*kb=Kslot+hi*1024+r32*16;
  #pragma unroll
  for(int d0=0;d0<4;++d0){
    const bf16x8 b0=*reinterpret_cast<const bf16x8*>(kb+d0*2048);
    const bf16x8 b1=*reinterpret_cast<const bf16x8*>(kb+d0*2048+512);
    const bf16x8 q_=*(const __attribute__((address_space(3))) bf16x8*)(qf+d0*1024);
    if(d0==0){p0=__builtin_amdgcn_mfma_f32_32x32x16_bf16(b0,q_,f32x16{},0,0,0);p1=__builtin_amdgcn_mfma_f32_32x32x16_bf16(b1,q_,f32x16{},0,0,0);}
    else{p0=__builtin_amdgcn_mfma_f32_32x32x16_bf16(b0,q_,p0,0,0,0);p1=__builtin_amdgcn_mfma_f32_32x32x16_bf16(b1,q_,p1,0,0,0);}}
}
typedef __attribute__((address_space(3))) const char* lds_cptr;
typedef short v4i16_t __attribute__((ext_vector_type(4)));
__device__ __forceinline__ void kload8(bf16x8*kf,lds_cptr kp){
  kf[0]=*(const __attribute__((address_space(3))) bf16x8*)(kp);      kf[1]=*(const __attribute__((address_space(3))) bf16x8*)(kp+512);
  kf[2]=*(const __attribute__((address_space(3))) bf16x8*)(kp+2048); kf[3]=*(const __attribute__((address_space(3))) bf16x8*)(kp+2560);
  kf[4]=*(const __attribute__((address_space(3))) bf16x8*)(kp+4096); kf[5]=*(const __attribute__((address_space(3))) bf16x8*)(kp+4608);
  kf[6]=*(const __attribute__((address_space(3))) bf16x8*)(kp+6144); kf[7]=*(const __attribute__((address_space(3))) bf16x8*)(kp+6656);
}
__device__ __forceinline__ void kload2(bf16x8*kf,lds_cptr kp,int j){ kf[2*j]=*(const __attribute__((address_space(3))) bf16x8*)(kp+j*2048); kf[2*j+1]=*(const __attribute__((address_space(3))) bf16x8*)(kp+j*2048+512); }
__device__ __forceinline__ s16x4 vtr(lds_cptr p){ return __builtin_bit_cast(s16x4,__builtin_amdgcn_ds_read_tr16_b64_v4i16((__attribute__((address_space(3))) v4i16_t*)p)); }
__device__ __forceinline__ float rowmax(const f32x16&p0,const f32x16&p1){
  float a=max3f(p0[0],p0[1],p1[0]),b=max3f(p0[2],p0[3],p1[1]);a=max3f(a,p1[2],p1[3]);
  #pragma unroll
  for(int r=4;r<16;r+=4){a=max3f(a,p0[r],p0[r+1]);b=max3f(b,p0[r+2],p0[r+3]);a=max3f(a,p1[r],p1[r+1]);b=max3f(b,p1[r+2],p1[r+3]);}
  const float m=max2f(a,b);
  auto rr=__builtin_amdgcn_permlane32_swap(__float_as_uint(m),__float_as_uint(m),false,false);
  return max2f(__uint_as_float(rr[0]),__uint_as_float(rr[1]));
}
__device__ __forceinline__ void pv(f32x16*o,int vb,bf16x8 pa0,bf16x8 pa1,bf16x8 pa2,bf16x8 pa3){
  #pragma unroll
  for(int d0=0;d0<2;++d0){s16x4 lo[4],hi[4];
    #pragma unroll
    for(int ks=0;ks<4;++ks){
      asm volatile("ds_read_b64_tr_b16 %0,%1 offset:%c2":"=&v"(lo[ks]):"v"(vb),"i"(d0*4096+ks*1024):"memory");
      asm volatile("ds_read_b64_tr_b16 %0,%1 offset:%c2":"=&v"(hi[ks]):"v"(vb),"i"(d0*4096+ks*1024+512):"memory");}
    asm volatile("s_waitcnt lgkmcnt(0)":::"memory");SBAR();
    #define PK(k) (bf16x8){lo[k][0],lo[k][1],lo[k][2],lo[k][3],hi[k][0],hi[k][1],hi[k][2],hi[k][3]}
    o[d0]=__builtin_amdgcn_mfma_f32_32x32x16_bf16(pa0,PK(0),o[d0],0,0,0);
    o[d0]=__builtin_amdgcn_mfma_f32_32x32x16_bf16(pa1,PK(1),o[d0],0,0,0);
    o[d0]=__builtin_amdgcn_mfma_f32_32x32x16_bf16(pa2,PK(2),o[d0],0,0,0);
    o[d0]=__builtin_amdgcn_mfma_f32_32x32x16_bf16(pa3,PK(3),o[d0],0,0,0);
    #undef PK
  }
}

#ifndef ATTN_STORE16
#define ATTN_STORE16(p,v) (*(u32x4*)(p)=(v))
#endif
template<int THRL> __device__ __forceinline__ void attn_unit(int b,int h,int qb,const bf16*Q,const bf16*__restrict__ K,const bf16*__restrict__ V,bf16*O,char*shm,const int wid){
  const int qcol=h*64, kcol=h*64, vcol=(h>>1)*128, ocol=h*128;
  const int lane=lane_id_v(),r32=lane&31,hi=lane>>5;
  const long rowbase=(long)b*SEQ; const int q0=qb*QB;
  const bf16*Qw=Q+(rowbase+q0+wid*QBLK)*QP+qcol;
  const bf16*Kh=K+rowbase*KP+kcol,*Vh=V+rowbase*VP+vcol;
  const unsigned lds0=(unsigned)(uintptr_t)shm;
  __attribute__((address_space(3))) float*const wsf=(__attribute__((address_space(3))) float*)((__attribute__((address_space(3))) char*)shm+LDS_WS)+wid*64;
  const int koff=lane*KP+wid*8, voff=(16*(wid&3)+(lane>>2))*VP+(wid>>2)*32+(lane&3)*8;
  const unsigned kdst=lds0+LDS_K+wid*1024, vdst=lds0+LDS_V+wid*1024;
  #define DMA_K(t,slot) glds16(Kh+(long)(t)*KVBLK*KP+koff,(unsigned)__builtin_amdgcn_readfirstlane(kdst+(slot)))
  #define DMA_V(t,slot) do{ glds16(Vh+(long)(t)*KVBLK*VP+voff,(unsigned)__builtin_amdgcn_readfirstlane(vdst+2*(slot))); glds16(Vh+(long)(t)*KVBLK*VP+64+voff,(unsigned)__builtin_amdgcn_readfirstlane(vdst+2*(slot)+8192)); }while(0)
  const char*Kbase=shm+LDS_K; bf16x8 kf[8];
  const lds_cptr shm3=(lds_cptr)shm; const lds_cptr kp0=shm3+LDS_K+hi*1024+r32*16; const lds_cptr vp0=shm3+LDS_V+((lane>>4)&1)*32+(lane&3)*8+(4*hi+((lane&15)>>2))*64;
  const int NT=(q0+QB)/KVBLK;
  DMA_K(0,0);DMA_V(0,0);DMA_K(1,SLOTB);
  __attribute__((address_space(3))) char*const qf=(__attribute__((address_space(3))) char*)shm+LDS_Q+wid*4096+lane*16;
  { bf16x8 qt[4];
    #pragma unroll
    for(int d0=0;d0<4;++d0)qt[d0]=*reinterpret_cast<const bf16x8*>(&Qw[(long)r32*QP+d0*16+hi*8]);
    #pragma unroll
    for(int d0=0;d0<4;++d0)*(__attribute__((address_space(3))) bf16x8*)(qf+d0*1024)=qt[d0]; }
  #define QF(d0) (*(const __attribute__((address_space(3))) bf16x8*)(qf+(d0)*1024))
  float mhat=0.f,l_reg=0.f;f32x16 o[4];o[0]=f32x16{};o[1]=f32x16{};o[2]=f32x16{};o[3]=f32x16{};
  #define CMASK(P0,P1,t) do{int jb_=(t)-(NT-4); if(jb_>=0){ const int l_=lane_id_v(); cmask(P0,P1,jb_,wid*QBLK+(l_&31),l_>>5); } }while(0)
  bool resc=false;
  #define START(P0,P1) do{ const float rm=rowmax(P0,P1); resc=false; \
    { const float dl=rm; mhat=fadd_s(mhat,dl); \
      _Pragma("unroll") for(int r=0;r<16;++r){P0[r]=fsub_s(P0[r],dl);P1[r]=fsub_s(P1[r],dl);} } \
    _Pragma("unroll") for(int r=0;r<16;++r)P0[r]=__builtin_amdgcn_exp2f(P0[r]); }while(0)
  #define RESC() do{ if(resc){ asm volatile("s_waitcnt lgkmcnt(0)":::"memory"); \
      _Pragma("unroll") for(int d_=0;d_<4;++d_) _Pragma("unroll") for(int r=0;r<16;++r)o[d_][r]*=wsf[crow(r,hi)]; } }while(0)
  f32x16 pA0,pA1,pB0,pB1;
  int sl_prev=0,sl_cur=0,sl_next=SLOTB;
  #define ROT() do{sl_prev=sl_cur;sl_cur=sl_next;sl_next=(sl_next==(NSLOT-1)*SLOTB)?0:sl_next+SLOTB;}while(0)
  DMA_K(2,2*SLOTB);
  WAIT_BAR(4);
  qkt(pA0,pA1,Kbase,qf,r32,hi);asm volatile("s_nop 15\n\ts_nop 7":"+v"(pA0),"+v"(pA1));CMASK(pA0,pA1,0);
  START(pA0,pA1);
  _Pragma("unroll") for(int r=0;r<16;++r)pA1[r]=__builtin_amdgcn_exp2f(pA1[r]);
  WAIT_BAR(0);
  DMA_K(3,0);DMA_V(1,SLOTB);
  ROT();
  kload8(kf,kp0+sl_cur);
  WAIT_BAR(3);
  s16x4 vlo[8],vhi[8]; u32x4 pw0,pw1,pw2,pw3;
  #define PKW(P,B) cvtpk_s(P[B],P[B+1])
  #define PAF(k) __builtin_bit_cast(bf16x8,pw##k)
  #define VFR(i) (bf16x8){vlo[i][0],vlo[i][1],vlo[i][2],vlo[i][3],vhi[i][0],vhi[i][1],vhi[i][2],vhi[i][3]}
  #define PIN(x) asm volatile("":"+v"(x))
  #define MX3(a,b,c) __builtin_fmaxf(__builtin_fmaxf((a),(b)),(c))
  #define GAPA(MF,A0,A1,A2,A3,W0,W1,PW) do{ MF; sacc+=A0; sacc+=A1; sacc+=A2; sacc+=A3; PIN(sacc); W0; W1; PIN(PW); SBAR(); }while(0)
  #define EX(v) __builtin_amdgcn_exp2f(v)
  #define GAPB(MF,X,B) do{ MF; X[B]=EX(X[B]); X[B+1]=EX(X[B+1]); X[B+2]=EX(X[B+2]); X[B+3]=EX(X[B+3]); PIN(X); SBAR(); }while(0)
  #define GAPB2(MF,X,B,RD) do{ MF; RD; X[B]=EX(X[B]); X[(B)+1]=EX(X[(B)+1]); PIN(X); SBAR(); }while(0)
  #define VRD2(i) do{ vlo[i]=vtr(vp_+8192+(((i)>>2)*4096+((i)&3)*1024)); vhi[i]=vtr(vp_+8192+(((i)>>2)*4096+((i)&3)*1024+512)); }while(0)
  #define VRD(i) do{ vlo[i]=vtr(vp_+(((i)>>2)*4096+((i)&3)*1024)); vhi[i]=vtr(vp_+(((i)>>2)*4096+((i)&3)*1024+512)); }while(0)
  #define KRD(G,j) do{ if(G){ kload2(kf,kp0+sl_next,j); SBAR(); } }while(0)
  #define STEP(C0,C1,P0,P1,t,GK,GV,GL) do{ SBAR(); \
    const lds_cptr vp_=vp0+2*sl_prev; \
    VRD(0); SBAR(); float sacc=(P0[0]+P0[1]); \
    bf16x8 q_=QF(0); \
    GAPA(C0=__builtin_amdgcn_mfma_f32_32x32x16_bf16(kf[0],q_,f32x16{},0,0,0), P0[2],P0[3],P0[4],P0[5],     pw0[0]=PKW(P0,0), pw0[1]=PKW(P0,2), pw0); \
    VRD(4); SBAR(); GAPA(C1=__builtin_amdgcn_mfma_f32_32x32x16_bf16(kf[1],q_,f32x16{},0,0,0), P0[6],P0[7],P0[8],P0[9],     pw0[2]=PKW(P0,4), pw0[3]=PKW(P0,6), pw0); \
    q_=QF(1); \
    VRD(1); SBAR(); GAPA(C0=__builtin_amdgcn_mfma_f32_32x32x16_bf16(kf[2],q_,C0,0,0,0),   P0[10],P0[11],P0[12],P0[13], pw1[0]=PKW(P0,8), pw1[1]=PKW(P0,10), pw1); \
    VRD(5); SBAR(); GAPA(C1=__builtin_amdgcn_mfma_f32_32x32x16_bf16(kf[3],q_,C1,0,0,0),   P0[14],P0[15],P1[0],P1[1],   pw1[2]=PKW(P0,12),pw1[3]=PKW(P0,14), pw1); \
    q_=QF(2); \
    VRD(2); SBAR(); GAPA(C0=__builtin_amdgcn_mfma_f32_32x32x16_bf16(kf[4],q_,C0,0,0,0),   P1[2],P1[3],P1[4],P1[5],     pw2[0]=PKW(P1,0), pw2[1]=PKW(P1,2), pw2); \
    VRD(6); SBAR(); GAPA(C1=__builtin_amdgcn_mfma_f32_32x32x16_bf16(kf[5],q_,C1,0,0,0),   P1[6],P1[7],P1[8],P1[9],     pw2[2]=PKW(P1,4), pw2[3]=PKW(P1,6), pw2); \
    q_=QF(3); \
    VRD(3); SBAR(); GAPA(C0=__builtin_amdgcn_mfma_f32_32x32x16_bf16(kf[6],q_,C0,0,0,0),   P1[10],P1[11],P1[12],P1[13], pw3[0]=PKW(P1,8), pw3[1]=PKW(P1,10), pw3); \
    VRD(7); SBAR(); GAPA(C1=__builtin_amdgcn_mfma_f32_32x32x16_bf16(kf[7],q_,C1,0,0,0),   P1[14],P1[15],0.f,0.f,       pw3[2]=PKW(P1,12),pw3[3]=PKW(P1,14), pw3); \
    l_reg+=sacc; \
    if(GK){DMA_K((t)+3,sl_cur);} if(GV){DMA_V((t)+1,sl_next);} \
    _Pragma("unroll") for(int r=0;r<16;++r){C0[r]-=mhat;C1[r]-=mhat;} \
    CMASK(C0,C1,t); \
    { float a=MX3(C0[0],C0[1],C1[0]),b=MX3(C0[2],C0[3],C1[1]); a=MX3(a,C1[2],C1[3]); \
      _Pragma("unroll") for(int r=4;r<16;r+=4){a=MX3(a,C0[r],C0[r+1]);b=MX3(b,C0[r+2],C0[r+3]);a=MX3(a,C1[r],C1[r+1]);b=MX3(b,C1[r+2],C1[r+3]);} \
      float rm=__builtin_fmaxf(a,b); { auto rr=__builtin_amdgcn_permlane32_swap(__float_as_uint(rm),__float_as_uint(rm),false,false); rm=__builtin_fmaxf(__uint_as_float(rr[0]),__uint_as_float(rr[1])); } \
      resc=false; \
      if(__builtin_expect(__any(rm>(float)THRL),0)){ const float dl=__builtin_fmaxf(rm,0.f); mhat+=dl; \
        _Pragma("unroll") for(int r=0;r<16;++r){C0[r]-=dl;C1[r]-=dl;} \
        const float f=__builtin_amdgcn_exp2f(-dl); l_reg*=f; if(hi==0)wsf[r32]=f; resc=true; } } \
    SBAR(); \
    GAPB2(o[0]=__builtin_amdgcn_mfma_f32_32x32x16_bf16(PAF(0),VFR(0),o[0],0,0,0), C0,0,  VRD2(0)); \
    GAPB2(o[1]=__builtin_amdgcn_mfma_f32_32x32x16_bf16(PAF(0),VFR(4),o[1],0,0,0), C0,2,  VRD2(4)); \
    KRD(GL,0); GAPB2(o[0]=__builtin_amdgcn_mfma_f32_32x32x16_bf16(PAF(1),VFR(1),o[0],0,0,0), C0,4,  VRD2(1)); \
    KRD(GL,1); GAPB2(o[1]=__builtin_amdgcn_mfma_f32_32x32x16_bf16(PAF(1),VFR(5),o[1],0,0,0), C0,6,  VRD2(5)); \
    KRD(GL,2); GAPB2(o[0]=__builtin_amdgcn_mfma_f32_32x32x16_bf16(PAF(2),VFR(2),o[0],0,0,0), C0,8,  VRD2(2)); \
    KRD(GL,3); GAPB2(o[1]=__builtin_amdgcn_mfma_f32_32x32x16_bf16(PAF(2),VFR(6),o[1],0,0,0), C0,10, VRD2(6)); \
    GAPB2(o[0]=__builtin_amdgcn_mfma_f32_32x32x16_bf16(PAF(3),VFR(3),o[0],0,0,0), C0,12, VRD2(3)); \
    GAPB2(o[1]=__builtin_amdgcn_mfma_f32_32x32x16_bf16(PAF(3),VFR(7),o[1],0,0,0), C0,14, VRD2(7)); \
      \
    GAPB2(o[2]=__builtin_amdgcn_mfma_f32_32x32x16_bf16(PAF(0),VFR(0),o[2],0,0,0), C1,0,  (void)0); \
    GAPB2(o[3]=__builtin_amdgcn_mfma_f32_32x32x16_bf16(PAF(0),VFR(4),o[3],0,0,0), C1,2,  (void)0); \
    GAPB2(o[2]=__builtin_amdgcn_mfma_f32_32x32x16_bf16(PAF(1),VFR(1),o[2],0,0,0), C1,4,  (void)0); \
    GAPB2(o[3]=__builtin_amdgcn_mfma_f32_32x32x16_bf16(PAF(1),VFR(5),o[3],0,0,0), C1,6,  (void)0); \
    GAPB2(o[2]=__builtin_amdgcn_mfma_f32_32x32x16_bf16(PAF(2),VFR(2),o[2],0,0,0), C1,8,  (void)0); \
    GAPB2(o[3]=__builtin_amdgcn_mfma_f32_32x32x16_bf16(PAF(2),VFR(6),o[3],0,0,0), C1,10, (void)0); \
    GAPB2(o[2]=__builtin_amdgcn_mfma_f32_32x32x16_bf16(PAF(3),VFR(3),o[2],0,0,0), C1,12, (void)0); \
    GAPB2(o[3]=__builtin_amdgcn_mfma_f32_32x32x16_bf16(PAF(3),VFR(7),o[3],0,0,0), C1,14, (void)0); \
    }while(0)
  int t=1;
  #undef CMASK
  #define CMASK(P0,P1,t) do{}while(0)
  for(;t+5<NT;t+=2){
    STEP(pB0,pB1,pA0,pA1,t,true,true,true);     WAIT_BAR(3); RESC(); ROT();
    STEP(pA0,pA1,pB0,pB1,t+1,true,true,true);   WAIT_BAR(3); RESC(); ROT();
  }
  #undef CMASK
  #define CMASK(P0,P1,t) do{int jb_=(t)-(NT-4); if(jb_>=0){ const int l_=lane_id_v(); cmask(P0,P1,jb_,wid*QBLK+(l_&31),l_>>5); } }while(0)
  #define ENDW(tt) do{ if((tt)+3<NT){WAIT_BAR(3);} else if((tt)+2<NT){WAIT_BAR(2);} else {WAIT_BAR(0);} }while(0)
  for(;t+1<NT;t+=2){
    STEP(pB0,pB1,pA0,pA1,t,(t+3<NT),(t+1<NT),(t+1<NT));       ENDW(t);   RESC(); ROT();
    STEP(pA0,pA1,pB0,pB1,t+1,(t+4<NT),(t+2<NT),(t+2<NT));     ENDW(t+1); RESC(); ROT();
  }
  STEP(pB0,pB1,pA0,pA1,NT-1,false,false,false); RESC();
  { float sacc=pB0[0]+pB0[1]; _Pragma("unroll") for(int r=2;r<16;++r)sacc+=pB0[r]; _Pragma("unroll") for(int r=0;r<16;++r)sacc+=pB1[r]; l_reg+=sacc;
    pw0=(u32x4){PKW(pB0,0),PKW(pB0,2),PKW(pB0,4),PKW(pB0,6)};pw1=(u32x4){PKW(pB0,8),PKW(pB0,10),PKW(pB0,12),PKW(pB0,14)};pw2=(u32x4){PKW(pB1,0),PKW(pB1,2),PKW(pB1,4),PKW(pB1,6)};pw3=(u32x4){PKW(pB1,8),PKW(pB1,10),PKW(pB1,12),PKW(pB1,14)};
    const int vb0=(int)(lds0+LDS_V)+((lane>>4)&1)*32+(lane&3)*8+(4*hi+((lane&15)>>2))*64;
    SBAR(); pv(o,vb0+2*sl_cur,PAF(0),PAF(1),PAF(2),PAF(3)); pv(o+2,vb0+2*sl_cur+8192,PAF(0),PAF(1),PAF(2),PAF(3)); }
  #undef PKW
  #undef PAF
  #undef VFR
  #undef PIN
  #undef MX3
  #undef GAPA
  #undef GAPB
  #undef GAPB2
  #undef VRD2
  #undef EX
  #undef VRD
  #undef KRD
  #undef STEP
  #undef ENDW
  {auto rr=__builtin_amdgcn_permlane32_swap(__float_as_uint(l_reg),__float_as_uint(l_reg),false,false);l_reg=__uint_as_float(rr[0])+__uint_as_float(rr[1]);}
  if(hi==0)wsf[32+r32]=l_reg;asm volatile("s_waitcnt lgkmcnt(0)":::"memory");
  float rli[16];
  #pragma unroll
  for(int r=0;r<16;++r)rli[r]=__builtin_amdgcn_rcpf(wsf[32+crow(r,hi)]);
  bf16*Ow=O+(rowbase+q0+wid*QBLK)*OP+ocol;
  { bf16*stg=(bf16*)(shm+LDS_OST)+wid*2048;
    #pragma unroll
    for(int hf=0;hf<2;++hf){
      #pragma unroll
      for(int r=0;r<16;++r){const int orow=crow(r,hi);
        #pragma unroll
        for(int d0=0;d0<2;++d0)stg[orow*64+d0*32+r32]=__float2bfloat16(o[2*hf+d0][r]*rli[r]);}
      asm volatile("s_waitcnt lgkmcnt(0)":::"memory");
      #pragma unroll
      for(int i=0;i<4;++i){const int row=i*8+(lane>>3),ch=lane&7; const u32x4 v=*(const u32x4*)(stg+row*64+ch*8); ATTN_STORE16(Ow+(long)row*OP+hf*64+ch*8,v);}
      asm volatile("s_waitcnt lgkmcnt(0)":::"memory"); } }
  asm volatile("s_waitcnt lgkmcnt(0)\n\ts_barrier":::"memory");
  #undef DMA_K
  #undef DMA_V
  #undef QF
  #undef CMASK
  #undef START
  #undef RESC
  #undef ROT
}
constexpr int ATTN_LDS_BYTES=LDS_BYTES;
struct AttnTensors { const bf16* Q; const bf16* K; const bf16* V; bf16* O; };
struct AttnUnit { int bh; int qb; };
struct QueueOrder {
  unsigned* ctr; volatile __attribute__((address_space(3))) unsigned* slot; int wid;
  __device__ __forceinline__ unsigned claim()const{ unsigned n=0u; if(wid==0&&lane_id_v()==0) n=__hip_atomic_fetch_add(ctr,1u,__ATOMIC_RELAXED,__HIP_MEMORY_SCOPE_AGENT); return n; }
  __device__ __forceinline__ unsigned publish(unsigned n,int par)const{
    if(wid==0&&lane_id_v()==0) slot[par]=n;
    asm volatile("s_waitcnt lgkmcnt(0)\n\ts_barrier":::"memory");
    const unsigned r=slot[par]; asm volatile("s_waitcnt lgkmcnt(0)":::"memory"); return r; }
  __device__ __forceinline__ void a_ready(const AttnUnit&)const{}
  __device__ __forceinline__ void done(const AttnUnit&)const{}
};
template<class Sched,int THRL=8> __device__ __forceinline__ void attn_phase(char*lds,const AttnTensors&T,const Sched&S,const int wid){
  unsigned nxt=S.claim(); int par=0;
  for(;;){ const unsigned n=S.publish(nxt,par); par^=1; if(n>=(unsigned)(BATCH*NHEAD*NQB))break;
    nxt=S.claim();
    const int qb=NQB-1-(int)(n/(BATCH*NHEAD)), bh=(int)(n%(BATCH*NHEAD));
    attn_unit<THRL>(bh/NHEAD,bh%NHEAD,qb,T.Q,T.K,T.V,T.O,lds,wid); }
}
#undef SBAR
#undef WAIT_BAR
}
constexpr int NWAVES = 8;
#ifndef MK_N_LAUNCHES
#define MK_N_LAUNCHES 1
#endif
constexpr int N_PHASES = 14;
#ifndef PROBE_MASK
#define PROBE_MASK 0
#endif
constexpr int N_LAUNCHES = MK_N_LAUNCHES;
static_assert(N_LAUNCHES == 1 || N_LAUNCHES == N_PHASES, "MK_N_LAUNCHES is 1 or 14");

constexpr int BATCH = 8, T = 4096, D = 1024, M = BATCH * T;
constexpr int IN_COLS = 3328, RWC = 1792, NEXP = 32, TOPK = 4, NMOD = 6 * D;
constexpr int MAXROWS = M * TOPK + NEXP * 256;
constexpr int MOD_KS = 8;

constexpr size_t MiB = 1u << 20, KiB = 1u << 10;
constexpr size_t WS_CTL = 0, CTL_ZERO_BYTES = 1 * MiB;
constexpr size_t WS_MODP = 1 * MiB;
constexpr size_t WS_MOD = 2 * MiB + 512 * KiB;
constexpr size_t WS_ROPE = 3 * MiB;
constexpr size_t WS_WIN = 5 * MiB;
constexpr size_t WS_WOUT = 12 * MiB;
constexpr size_t WS_BLORA = 14 * MiB;
constexpr size_t WS_TOKE = 15 * MiB, WS_TOKG = 15 * MiB + 512 * KiB;
constexpr size_t WS_TOKROW = 16 * MiB, WS_ROWTOK = 16 * MiB + 512 * KiB, WS_ROWGATE = 17 * MiB + 256 * KiB, WS_BLKBASE = 18 * MiB;
constexpr size_t WS_W1 = 20 * MiB, WS_W2 = 148 * MiB;
constexpr size_t WS_H2 = 212 * MiB;
constexpr size_t WS_H = 276 * MiB, WS_Q = 340 * MiB, WS_K = 372 * MiB, WS_V = 404 * MiB, WS_RW = 436 * MiB;
constexpr size_t WS_O = 548 * MiB, WS_YCAT = 612 * MiB, WS_LACT = 676 * MiB;
constexpr size_t WS_LW = 692 * MiB, WS_AS = 756 * MiB, WS_G = 820 * MiB, WS_Y = 884 * MiB;
constexpr size_t WS_RIMG = 884 * MiB, WS_RBON = 1012 * MiB;
constexpr size_t WS_X1 = 948 * MiB;
constexpr size_t WS_ACT = 276 * MiB, WS_Y2 = 548 * MiB, WS_END = 1013 * MiB;
static_assert(WS_ROWTOK + (size_t)MAXROWS * 4 <= WS_ROWGATE && WS_ROWGATE + (size_t)MAXROWS * 4 <= WS_BLKBASE && WS_ACT + (size_t)MAXROWS * 2048 <= WS_Y2 && WS_Y2 + (size_t)MAXROWS * 2048 <= WS_Y, "d_ws map");
constexpr int CW_TMO = 0, CW_CODE = 1;
constexpr int CW_BAR = 4096;
constexpr int CW_ATTQ = 8192;
constexpr int CW_ECNT = 12288;
static_assert((CW_ECNT + 2 * 64 * NEXP) * 4 <= (int)CTL_ZERO_BYTES, "CTL words inside the memset region");

constexpr int RING_OFF = 0, RING_BYTES = 131072;
constexpr int LDSCTL_OFF = RING_BYTES, MISC_OFF = LDSCTL_OFF + 320;
constexpr int LDS_BYTES = 147456;
static_assert(MISC_OFF + 128 <= LDS_BYTES, "LDS map");
#define GAS __attribute__((address_space(1)))
#define LAS __attribute__((address_space(3)))
typedef unsigned short bf16;
typedef unsigned v4u __attribute__((ext_vector_type(4)));
typedef float f32x4 __attribute__((ext_vector_type(4)));
typedef short bf16x8 __attribute__((ext_vector_type(8)));
typedef GAS unsigned gu32;
typedef GAS unsigned long long gu64;
#define RLX_AGENT __ATOMIC_RELAXED, __HIP_MEMORY_SCOPE_AGENT
#define LDS_WAIT() asm volatile("s_waitcnt lgkmcnt(0)" ::: "memory")
#define VM_WAIT() asm volatile("s_waitcnt vmcnt(0)" ::: "memory")
__device__ __forceinline__ unsigned long long rt() { return __builtin_amdgcn_s_memrealtime(); }
__device__ __forceinline__ unsigned f2bf(float f) { unsigned u = __builtin_bit_cast(unsigned, f); return (u + 0x7fffu + ((u >> 16) & 1u)) >> 16; }
__device__ __forceinline__ unsigned pk2(float lo, float hi) { return f2bf(lo) | (f2bf(hi) << 16); }

#define XB_TMO      128
#define XB_XCNT(j)  (256  + 64 * (j))
#define XB_XSUB(j)  (1280 + 64 * (j))
#define XB_XGEN(j)  (2304 + 64 * (j))
#define XB_TOP      3328
#define XB_TOPGEN   3392
#define XCD_BAR_WORDS 3456
#define XB_SPIN_CAP (1u << 18)

__device__ __forceinline__ unsigned xb_ld(unsigned* p)              { return __hip_atomic_load(p, __ATOMIC_RELAXED, __HIP_MEMORY_SCOPE_AGENT); }
__device__ __forceinline__ unsigned xb_add(unsigned* p, unsigned v) { return __hip_atomic_fetch_add(p, v, __ATOMIC_RELAXED, __HIP_MEMORY_SCOPE_AGENT); }
__device__ __forceinline__ unsigned xb_xcc_id() { return (unsigned)__builtin_amdgcn_s_getreg((3 << 11) | 20) & 0xFu; }
#define XB_SPIN(cond, bar) do { unsigned _sp = 0; while (cond) { __builtin_amdgcn_s_sleep(1); \
    if ((++_sp & 255u) == 0u) { if (xb_ld(&(bar)[XB_TMO])) break; if (_sp > XB_SPIN_CAP) { atomicAdd(&(bar)[XB_TMO], 1u); break; } } } } while (0)

struct XcdBarrier {
    unsigned* bar; unsigned x; int wid;
    volatile LAS unsigned* st;
};

__device__ __forceinline__ XcdBarrier xcd_barrier_post(unsigned* bar, volatile LAS unsigned* st, int wid) {
    XcdBarrier b; b.bar = bar; b.x = xb_xcc_id(); b.st = st; b.wid = wid;
    if (threadIdx.x == 0) (void)xb_add(&bar[XB_XCNT(b.x)], 1u);
    return b;
}
__device__ __forceinline__ void xcd_barrier_complete(unsigned* bar, unsigned x, unsigned& nloc, unsigned& nx) {
    const unsigned G = gridDim.x * gridDim.y * gridDim.z;
    unsigned sum, cnt, mine, sp = 0u;
    for (;;) {
        sum = 0u; cnt = 0u; mine = 0u;
#pragma unroll
        for (unsigned j = 0; j < 16; ++j) { const unsigned c = xb_ld(&bar[XB_XCNT(j)]); sum += c; cnt += (c > 0u) ? 1u : 0u; mine = (j == x) ? c : mine; }
        if (sum == G) break;
        __builtin_amdgcn_s_sleep(1);
        if ((++sp & 255u) == 0u) { if (xb_ld(&bar[XB_TMO])) break; if (sp > XB_SPIN_CAP) { atomicAdd(&bar[XB_TMO], 1u); break; } }
    }
    nloc = mine > 0u ? mine : 1u; nx = cnt > 0u ? cnt : 1u;
}

__device__ __forceinline__ void xcd_barrier(const XcdBarrier& b) {
    asm volatile("s_waitcnt vmcnt(0)" ::: "memory");
    __syncthreads();
    if (b.wid == 0 && lane_id_v() == 0) {
        unsigned* bar = b.bar;
        __builtin_amdgcn_s_waitcnt(0);
        unsigned nloc = b.st[0], nx = b.st[1];
        if (nloc == 0u) { xcd_barrier_complete(bar, b.x, nloc, nx); b.st[0] = nloc; b.st[1] = nx; }
        const unsigned old = xb_add(&bar[XB_XSUB(b.x)], 1u);
        const unsigned gen = old / nloc;
        if (old + 1u == (gen + 1u) * nloc) {
            __builtin_amdgcn_fence(__ATOMIC_RELEASE, "agent");
            asm volatile("s_waitcnt vmcnt(0)" ::: "memory");
            const unsigned og = xb_add(&bar[XB_TOP], 1u);
            const unsigned tg = og / nx;
            if (og + 1u == (tg + 1u) * nx) xb_add(&bar[XB_TOPGEN], 1u);
            else XB_SPIN(xb_ld(&bar[XB_TOPGEN]) == tg, bar);
            __builtin_amdgcn_fence(__ATOMIC_ACQUIRE, "agent");
            xb_add(&bar[XB_XGEN(b.x)], 1u);
            asm volatile("s_waitcnt vmcnt(0)" ::: "memory");
        } else {
            XB_SPIN(xb_ld(&bar[XB_XGEN(b.x)]) == gen, bar);
            __builtin_amdgcn_fence(__ATOMIC_ACQUIRE, "agent");
            asm volatile("s_waitcnt vmcnt(0)" ::: "memory");
        }
    }
    __syncthreads();
}
typedef float f32x2 __attribute__((ext_vector_type(2)));
typedef unsigned u32x2 __attribute__((ext_vector_type(2)));
struct Frame {
    LAS unsigned char* lds;
    volatile LAS unsigned* MISC;
    gu32* ctl;
    int wave;
    int vcu, G;
    unsigned char* ws; float* out;
};
struct Args { const void* in[33]; float* out; unsigned char* ws; int ph_lo, ph_hi, li, pad; };
struct InProxy { __device__ __forceinline__ const void* operator[](int k) const { unsigned long long v; const unsigned long long kp = (unsigned long long)__builtin_amdgcn_kernarg_segment_ptr();
    asm volatile("s_load_dwordx2 %0, %1, %2\n\ts_waitcnt lgkmcnt(0)" : "=s"(v) : "s"(kp), "s"(8 * k) : "memory"); return (const void*)(const GAS unsigned char*)v; } };
struct ArgsD { InProxy in; };

#define DPP_ADD(x, ctrl) ((x) + __builtin_bit_cast(float, __builtin_amdgcn_update_dpp(0, __builtin_bit_cast(int, (x)), (ctrl), 0xF, 0xF, true)))
__device__ __forceinline__ float wave_sum(float x) {
    x = DPP_ADD(x, 0xB1); x = DPP_ADD(x, 0x4E); x = DPP_ADD(x, 0x141); x = DPP_ADD(x, 0x140);
    { const auto r_ = __builtin_amdgcn_permlane16_swap(__float_as_uint(x), __float_as_uint(x), false, false); x = __uint_as_float(r_[0]) + __uint_as_float(r_[1]); }
    { const auto r_ = __builtin_amdgcn_permlane32_swap(__float_as_uint(x), __float_as_uint(x), false, false); x = __uint_as_float(r_[0]) + __uint_as_float(r_[1]); }
    return x; }
__device__ __forceinline__ float bf2f(unsigned short u) { return __uint_as_float((unsigned)u << 16); }
__device__ __forceinline__ float bflo(unsigned u) { return __uint_as_float(u << 16); }
__device__ __forceinline__ float bfhi(unsigned u) { return __uint_as_float(u & 0xffff0000u); }
typedef float f32x2_t __attribute__((ext_vector_type(2))); typedef __bf16 bf16x2_t __attribute__((ext_vector_type(2)));
__device__ __forceinline__ unsigned pkbf(float lo, float hi) { f32x2_t v = {lo, hi}; bf16x2_t b = __builtin_convertvector(v, bf16x2_t); return __builtin_bit_cast(unsigned, b); }
__device__ __forceinline__ float allsum16(float x) {
    x = DPP_ADD(x, 0xB1); x = DPP_ADD(x, 0x4E); x = DPP_ADD(x, 0x124); x = DPP_ADD(x, 0x128); return x; }

struct P0Item { const float* src; bf16* dst; int N, K, n0; bool permq, fp8; };
__device__ __forceinline__ bool p0_decode(const Frame& F, int it, P0Item& d, const float* w_in, const float* w_out, const float* w1, const float* w2m) {
    constexpr int I_IN = (D / 64) * (IN_COLS / 32), I_OUT = (D / 64) * (D / 32), I_W1 = (D / 64) * (2048 / 32), I_W2 = (D / 64) * (D / 32);
    constexpr int NITEMS = I_IN + I_OUT + NEXP * I_W1 + NEXP * I_W2;
    if (it >= NITEMS) return false;
    const float* W; bf16* WT; int N, r = it; d.permq = false; d.fp8 = false; d.K = D;
    if (r < I_IN) { W = w_in; WT = (bf16*)(F.ws + WS_WIN); N = IN_COLS; d.permq = true; }
    else { r -= I_IN; if (r < I_OUT) { W = w_out; WT = (bf16*)(F.ws + WS_WOUT); N = D; }
        else { r -= I_OUT; if (r < NEXP * I_W1) { const int e = r / I_W1; r -= e * I_W1; W = w1 + (size_t)e * D * 2048; WT = (bf16*)(F.ws + WS_W1 + (size_t)e * 2048 * D); N = 2048; d.fp8 = true; }
            else { r -= NEXP * I_W1; const int e = r / I_W2; r -= e * I_W2; W = w2m + (size_t)e * D * D; WT = (bf16*)(F.ws + WS_W2 + (size_t)e * D * D); N = D; d.fp8 = true; } } }
    const int nblk = N / 32, kb = r / nblk, nb = r - kb * nblk; d.N = N; d.n0 = 32 * nb; d.src = W + (size_t)(64 * kb) * N + d.n0; d.dst = d.fp8 ? (bf16*)((unsigned char*)WT + 64 * kb) : WT + 64 * kb; return true;
}
__device__ __forceinline__ void p0_item_store(const P0Item& d, const float (&v)[32], LAS float* scr, int lane) {
#pragma unroll
    for (int i = 0; i < 32; ++i) scr[(2 * i + (lane >> 5)) * 33 + (lane & 31)] = v[i];
    LDS_WAIT(); asm volatile("" ::: "memory");
    const int c = lane & 7;
#pragma unroll
    for (int j = 0; j < 4; ++j) { const int n = (lane >> 3) + 8 * j; const LAS float* s = scr + (8 * c) * 33 + n;
        int nn = d.n0 + n;
        if (d.fp8) { const u32x2 o8 = (u32x2){pg8::pk4_fp8(s[0 * 33] * pg8::W8_SCALE, s[1 * 33] * pg8::W8_SCALE, s[2 * 33] * pg8::W8_SCALE, s[3 * 33] * pg8::W8_SCALE), pg8::pk4_fp8(s[4 * 33] * pg8::W8_SCALE, s[5 * 33] * pg8::W8_SCALE, s[6 * 33] * pg8::W8_SCALE, s[7 * 33] * pg8::W8_SCALE)};
            *(GAS u32x2*)((unsigned char*)d.dst + (size_t)nn * d.K + 8 * c) = o8; }
        else { v4u o; o.x = pkbf(s[0 * 33], s[1 * 33]); o.y = pkbf(s[2 * 33], s[3 * 33]); o.z = pkbf(s[4 * 33], s[5 * 33]); o.w = pkbf(s[6 * 33], s[7 * 33]);
            if (d.permq && nn < 1024) { const int dd = nn & 63; if (dd < 16) nn = (nn & ~63) + ((dd < 8) ? 2 * dd : 2 * (dd - 8) + 1); }
            *(GAS v4u*)(d.dst + (size_t)nn * d.K + 8 * c) = o; } }
    LDS_WAIT(); asm volatile("" ::: "memory");
}
__device__ __forceinline__ void sincos_d(float af, float& s, float& c) {
    const double a = (double)af; const double n = __builtin_rint(a * 0.63661977236758134308);
    double r = __builtin_fma(-n, 1.57079632679489655800e+00, a); r = __builtin_fma(-n, 6.12323399573676603587e-17, r);
    const double r2 = r * r;
    double sp = 1.0 / 6227020800.0; sp = sp * r2 * -1.0 + 1.0 / 39916800.0; sp = -sp * r2 + 1.0 / 362880.0; sp = -sp * r2 + 1.0 / 5040.0; sp = -sp * r2 + 1.0 / 120.0; sp = -sp * r2 + 1.0 / 6.0; sp = r - r * r2 * sp;
    double cp = 1.0 / 87178291200.0; cp = -cp * r2 + 1.0 / 479001600.0; cp = -cp * r2 + 1.0 / 3628800.0; cp = -cp * r2 + 1.0 / 40320.0; cp = -cp * r2 + 1.0 / 720.0; cp = -cp * r2 + 1.0 / 24.0; cp = -cp * r2 + 0.5; cp = 1.0 - r2 * cp;
    const int q = ((int)n) & 3;
    const double sv = (q == 0) ? sp : (q == 1) ? cp : (q == 2) ? -sp : -cp, cv = (q == 0) ? cp : (q == 1) ? -sp : (q == 2) ? -cp : sp;
    s = (float)sv; c = (float)cv;
}
constexpr int P0_I0 = (D / 64) * (IN_COLS / 32) + (D / 64) * (D / 32);
constexpr int P0_XU_ITEMS = 96, P0_XUNITS = (NEXP * (D / 64) * (2048 / 32) + NEXP * (D / 64) * (D / 32)) / P0_XU_ITEMS;
static_assert(P0_XUNITS * P0_XU_ITEMS == NEXP * (D / 64) * (2048 / 32) + NEXP * (D / 64) * (D / 32) && P0_XUNITS == 512, "expert conversion units");
__device__ __forceinline__ void p0_expert_unit(Frame& F, const ArgsD& A, const int cu) {
    const int lane = lane_id_v();
    LAS float* scr = (LAS float*)(F.lds + RING_OFF + F.wave * 12288);
    const float* w1 = (const float*)A.in[29]; const float* w2m = (const float*)A.in[31];
    P0Item cur, nxt; float v[32], vn[32];
    int it = P0_I0 + cu * P0_XU_ITEMS + F.wave;
    (void)p0_decode(F, it, cur, nullptr, nullptr, w1, w2m);
#pragma unroll
    for (int i = 0; i < 32; ++i) v[i] = __builtin_nontemporal_load(&cur.src[(size_t)(2 * i + (lane >> 5)) * cur.N + (lane & 31)]);
#pragma unroll 1
    for (int j = 0; j < P0_XU_ITEMS / NWAVES; ++j) { it += NWAVES;
        const bool hn = j + 1 < P0_XU_ITEMS / NWAVES;
        if (hn) { (void)p0_decode(F, it, nxt, nullptr, nullptr, w1, w2m);
#pragma unroll
            for (int i = 0; i < 32; ++i) vn[i] = __builtin_nontemporal_load(&nxt.src[(size_t)(2 * i + (lane >> 5)) * nxt.N + (lane & 31)]); }
        p0_item_store(cur, v, scr, lane);
        cur = nxt;
#pragma unroll
        for (int i = 0; i < 32; ++i) v[i] = vn[i]; }
    __syncthreads();
}
__device__ __forceinline__ void p0_prologue(Frame& F, const ArgsD& A) {
    const int lane = lane_id_v(), tid = F.wave * 64 + lane; (void)tid;
    const int gw = F.vcu * NWAVES + F.wave, NGW = F.G * NWAVES, gt = F.vcu * 512 + tid, NGT = F.G * 512;
    LAS float* scr = (LAS float*)(F.lds + RING_OFF + F.wave * 12288);
    LAS float* sl = (LAS float*)(F.lds + RING_OFF + 98304);
    const float* c = (const float*)A.in[1];
    for (int i = tid; i < 8 * 1024; i += 512) { const float v = c[i]; sl[i] = v / (1.f + __expf(-v)); }
    __syncthreads();
    { const float* aw = (const float*)A.in[3]; float* modp = (float*)(F.ws + WS_MODP);
      for (int it = gw; it < 96 * MOD_KS; it += NGW) { const int cc = it % 96, ks = it / 96, col = cc * 64 + lane;
          float acc[8];
#pragma unroll
          for (int b = 0; b < 8; ++b) acc[b] = 0.f;
          for (int k = ks * 128; k < ks * 128 + 128; ++k) { const float w = aw[(size_t)k * NMOD + col];
#pragma unroll
              for (int b = 0; b < 8; ++b) acc[b] += sl[b * 1024 + k] * w; }
#pragma unroll
          for (int b = 0; b < 8; ++b) modp[(size_t)(ks * 8 + b) * NMOD + col] = acc[b]; } }
    { const int* pos = (const int*)A.in[2]; float* rope = (float*)(F.ws + WS_ROPE);
      for (int idx = gt; idx < M * 8; idx += NGT) { const int m = idx >> 3, i = idx & 7;
          const float invf = (i == 0) ? 1.0f : (i == 1) ? 0.1939227432012558f : (i == 2) ? 0.03760603070259094f : (i == 3) ? 0.007292664609849453f : (i == 4) ? 0.0014142135623842478f : (i == 5) ? 0.00027424818836152554f : (i == 6) ? 5.318296098266728e-05f : 1.0313386155758053e-05f;
          const float ang = (float)pos[m] * invf; float s, cc; sincos_d(ang, s, cc); rope[(size_t)m * 16 + i] = cc; rope[(size_t)m * 16 + 8 + i] = s; } }
    { const float* w2 = (const float*)A.in[18]; const float* a2 = (const float*)A.in[20]; const float* g2 = (const float*)A.in[21]; bf16* bl = (bf16*)(F.ws + WS_BLORA);
      for (int idx = gt; idx < 1536 * 256; idx += NGT) { const int n = idx >> 8, k = idx & 255, blk = n >> 9, nn = n & 511; float v = 0.f;
          if (blk == 0 && k < 64) v = w2[k * 512 + nn]; else if (blk == 1 && k >= 64 && k < 128) v = a2[(k - 64) * 512 + nn]; else if (blk == 2 && k >= 128) v = g2[(k - 128) * 512 + nn];
          bl[idx] = (bf16)(pkbf(v, 0.f) & 0xffffu); } }
    { const float* w_in = (const float*)A.in[9]; const float* w_out = (const float*)A.in[10]; const float* w1 = (const float*)A.in[29]; const float* w2m = (const float*)A.in[31];
      P0Item cur, nxt; float v[32], vn[32];
      bool have = gw < P0_I0 && p0_decode(F, gw, cur, w_in, w_out, w1, w2m);
      if (have) {
#pragma unroll
          for (int i = 0; i < 32; ++i) v[i] = cur.src[(size_t)(2 * i + (lane >> 5)) * cur.N + (lane & 31)]; }
      for (int it = gw; have; it += NGW) {
          const bool hn = it + NGW < P0_I0 && p0_decode(F, it + NGW, nxt, w_in, w_out, w1, w2m);
          if (hn) {
#pragma unroll
              for (int i = 0; i < 32; ++i) vn[i] = nxt.src[(size_t)(2 * i + (lane >> 5)) * nxt.N + (lane & 31)]; }
          p0_item_store(cur, v, scr, lane);
          cur = nxt; have = hn;
#pragma unroll
          for (int i = 0; i < 32; ++i) v[i] = vn[i];
      } }
}

__device__ __forceinline__ void p1_premix(Frame& F, const ArgsD& A) {
    const int lane = lane_id_v(), tid = F.wave * 64 + lane; (void)tid;
    const float* modp = (const float*)(F.ws + WS_MODP); const float* ada_b = (const float*)A.in[4]; float* mod = (float*)(F.ws + WS_MOD);
    const int rows_per = M / F.G, mbeg = F.vcu * rows_per, b = mbeg >> 12;
    LAS float* ms = (LAS float*)(F.lds + RING_OFF);
    for (int col = tid; col < 2048; col += 512) { float s = ada_b[col];
#pragma unroll
        for (int ks = 0; ks < MOD_KS; ++ks) s += modp[(size_t)(ks * 8 + b) * NMOD + col];
        ms[col] = s; }
    for (int i = F.vcu * 512 + tid; i < 8 * 4096; i += F.G * 512) { const int bb = i >> 12, col = 2048 + (i & 4095); float s = ada_b[col];
#pragma unroll
        for (int ks = 0; ks < MOD_KS; ++ks) s += modp[(size_t)(ks * 8 + bb) * NMOD + col];
        mod[(size_t)bb * NMOD + col] = s; }
    __syncthreads();
    const float* x = (const float*)A.in[0]; const float* nw = (const float*)A.in[5]; bf16* H = (bf16*)(F.ws + WS_H);
    f32x4 wsc[4], sh[4];
#pragma unroll
    for (int j = 0; j < 4; ++j) { const int col = 4 * lane + 256 * j; wsc[j] = *((const f32x4*)nw + lane + 64 * j) * (*(const LAS f32x4*)(ms + 1024 + col) + 1.f); sh[j] = *(const LAS f32x4*)(ms + col); }
    const int nr = rows_per / NWAVES, m0 = mbeg + F.wave * nr;
    f32x4 pv[4];
#pragma unroll
    for (int j = 0; j < 4; ++j) pv[j] = *((const GAS f32x4*)(x + (size_t)m0 * D) + lane + 64 * j);
    for (int i = 0; i < nr; ++i) { const int m = m0 + i;
        f32x4 v[4]; float s2 = 0.f;
#pragma unroll
        for (int j = 0; j < 4; ++j) { v[j] = pv[j]; s2 += (v[j].x * v[j].x + v[j].y * v[j].y) + (v[j].z * v[j].z + v[j].w * v[j].w); }
        if (i + 1 < nr) {
#pragma unroll
            for (int j = 0; j < 4; ++j) pv[j] = *((const GAS f32x4*)(x + (size_t)(m + 1) * D) + lane + 64 * j); }
        const float rs = __builtin_amdgcn_rsqf(wave_sum(s2) * (1.f / D) + 1e-6f);
        GAS u32x2* o8 = (GAS u32x2*)(H + (size_t)m * D) + lane;
#pragma unroll
        for (int j = 0; j < 4; ++j) { const f32x4 y = v[j] * rs * wsc[j] + sh[j]; o8[64 * j] = (u32x2){pkbf(y.x, y.y), pkbf(y.z, y.w)}; } }
}

__device__ __forceinline__ void p3_lact(Frame& F, const ArgsD& A) {
    const int lane = lane_id_v(), tid = F.wave * 64 + lane; (void)tid;
    const bf16* RW = (const bf16*)(F.ws + WS_RW); bf16* L = (bf16*)(F.ws + WS_LACT); const float* mu = (const float*)A.in[16] + 1536;
    const int gw = F.vcu * NWAVES + F.wave, NGW = F.G * NWAVES, c0 = 4 * lane;
    const f32x4 mu4 = *(const f32x4*)(mu + c0);
    for (int m = gw; m < M; m += NGW) { const int t = m & (T - 1);
        const u32x2 p = *(const GAS u32x2*)(RW + (size_t)m * RWC + 1536 + c0); u32x2 q = (u32x2){0u, 0u}; if (t > 0) q = *(const GAS u32x2*)(RW + (size_t)(m - 1) * RWC + 1536 + c0);
        f32x4 pv = (f32x4){bflo(p.x), bfhi(p.x), bflo(p.y), bfhi(p.y)}, qv = (f32x4){bflo(q.x), bfhi(q.x), bflo(q.y), bfhi(q.y)};
        f32x4 s = pv + (qv - pv) * mu4;
        if (c0 < 64) { s.x = tanhf(s.x); s.y = tanhf(s.y); s.z = tanhf(s.z); s.w = tanhf(s.w); }
        else if (c0 >= 128) { s.x = 1.f / (1.f + __expf(-s.x)); s.y = 1.f / (1.f + __expf(-s.y)); s.z = 1.f / (1.f + __expf(-s.z)); s.w = 1.f / (1.f + __expf(-s.w)); }
        *(GAS u32x2*)(L + (size_t)m * 256 + c0) = (u32x2){pkbf(s.x, s.y), pkbf(s.z, s.w)}; }
}

namespace rwk {
typedef short bf16x8 __attribute__((ext_vector_type(8)));
constexpr int MB = 8192;
__device__ __forceinline__ int moff(int r, int c) { return r * 128 + ((((c >> 3) ^ (r >> 1)) & 7) << 4) + ((c & 7) << 1); }
__device__ __forceinline__ bf16x8 frag(const LAS unsigned char* buf, int row, int chunk) { return *(const LAS bf16x8*)(buf + row * 128 + (((chunk ^ (row >> 1)) & 7) << 4)); }
struct LaneOff { int f[2], sb, mb[2]; };
__device__ __forceinline__ LaneOff lane_off(int l) { LaneOff o; const int r16 = l & 15, q = l >> 4, key = (l >> 1) & 7;
    o.f[0] = r16 * 128 + (((q) ^ key) << 4); o.f[1] = r16 * 128 + (((4 + q) ^ key) << 4);
    o.sb = r16 * 128 + ((((q >> 1) ^ key) & 7) << 4) + (q & 1) * 8;
#pragma unroll
    for (int p = 0; p < 2; ++p) { const int keyr = (2 * q + p) & 7; o.mb[p] = (4 * q + 2 * p) * 128 + ((((r16 >> 3) ^ keyr) & 7) << 4) + (r16 & 7) * 2; }
    return o; }
__device__ __forceinline__ void mm(f32x4& acc, const LAS unsigned char* A, int tm, const LAS unsigned char* B, int tn, const LaneOff& o) {
#pragma unroll
    for (int ks = 0; ks < 2; ++ks) { const bf16x8 a = *(const LAS bf16x8*)(A + tm * 2048 + o.f[ks]), b = *(const LAS bf16x8*)(B + tn * 2048 + o.f[ks]); acc = __builtin_amdgcn_mfma_f32_16x16x32_bf16(a, b, acc, 0, 0, 0); }
}
struct Fr { bf16x8 k0, k1; };
__device__ __forceinline__ Fr ldfr(const LAS unsigned char* A, int t, const LaneOff& o) { Fr f; f.k0 = *(const LAS bf16x8*)(A + t * 2048 + o.f[0]); f.k1 = *(const LAS bf16x8*)(A + t * 2048 + o.f[1]); return f; }
__device__ __forceinline__ void mmf(f32x4& acc, const Fr& a, const Fr& b) { acc = __builtin_amdgcn_mfma_f32_16x16x32_bf16(a.k0, b.k0, acc, 0, 0, 0); acc = __builtin_amdgcn_mfma_f32_16x16x32_bf16(a.k1, b.k1, acc, 0, 0, 0); }
__device__ __forceinline__ void st_nm(LAS unsigned char* buf, int tm, int tn, const LaneOff& o, f32x4 v) {
    *(LAS u32x2*)(buf + tn * 2048 + (o.sb ^ (tm << 5))) = (u32x2){pkbf(v[0], v[1]), pkbf(v[2], v[3])}; }
__device__ __forceinline__ void st_mn(LAS unsigned char* buf, int tm, int tn, const LaneOff& o, f32x4 v) {
    const unsigned p0 = pkbf(v[0], v[1]), p1 = pkbf(v[2], v[3]); LAS unsigned char* b0 = buf + tm * 2048 + (o.mb[0] ^ (tn << 5)); LAS unsigned char* b1 = buf + tm * 2048 + (o.mb[1] ^ (tn << 5));
    *(LAS unsigned short*)(b0) = (unsigned short)(p0 & 0xffffu); *(LAS unsigned short*)(b0 + 128) = (unsigned short)(p0 >> 16);
    *(LAS unsigned short*)(b1) = (unsigned short)(p1 & 0xffffu); *(LAS unsigned short*)(b1 + 128) = (unsigned short)(p1 >> 16); }
__device__ __forceinline__ f32x4 ld_nm(const LAS unsigned char* buf, int tm, int tn, const LaneOff& o) {
    const u32x2 p = *(const LAS u32x2*)(buf + tn * 2048 + (o.sb ^ (tm << 5))); return (f32x4){bflo(p.x), bfhi(p.x), bflo(p.y), bfhi(p.y)}; }
__device__ __forceinline__ float wsum64(float x) { return wave_sum(x); }
__device__ __forceinline__ float sum8(float x) { x = DPP_ADD(x, 0xB1); x = DPP_ADD(x, 0x4E); x = DPP_ADD(x, 0x141); return x; }
}

__device__ __forceinline__ void rwkv_pre(Frame& F, const ArgsD& A, const int bh, const int c_lo, const int c_hi) {
    using namespace rwk;
    const int b = bh >> 3, h = bh & 7, lane0 = lane_id_v(), w0 = F.wave;
    const LaneOff LO = lane_off(lane0);
    LAS unsigned char* L = F.lds + RING_OFF;
    LAS unsigned char* bA = L + 0 * MB; LAS unsigned char* bR = L + 1 * MB; LAS unsigned char* bB = L + 2 * MB; LAS unsigned char* bK = L + 3 * MB;
    LAS unsigned char* bBH = L + 4 * MB; LAS unsigned char* bKH = L + 5 * MB; LAS unsigned char* bVT = L + 6 * MB;
    LAS unsigned char* bAT = L + 7 * MB;
    LAS unsigned char* bAak = L + 9 * MB; LAS unsigned char* bArb = L + 10 * MB; LAS unsigned char* bArk = L + 11 * MB;
    LAS unsigned char* bQ0 = L + 12 * MB; LAS unsigned char* bQT0 = L + 13 * MB;
    LAS unsigned char* bT = L + 14 * MB;
    LAS unsigned char* bTF = L + 15 * MB;
    LAS float* part = (LAS float*)(F.lds + MISC_OFF + 128);
    LAS float* bon = part + 512;
    const bf16* RW = (const bf16*)(F.ws + WS_RW); const bf16* LW = (const bf16*)(F.ws + WS_LW); const bf16* AS = (const bf16*)(F.ws + WS_AS);
    unsigned char* IMG = F.ws + WS_RIMG; float* BON = (float*)(F.ws + WS_RBON);
    const size_t mb = (size_t)b * T;
    const float* mu = (const float*)A.in[16];
    float mu_r, mu_k, mu_v, kkc, kac, rkc;
    { const int hj = h * 64 + lane0; mu_r = mu[hj]; mu_k = mu[512 + hj]; mu_v = mu[1024 + hj]; kkc = ((const float*)A.in[22])[hj]; kac = ((const float*)A.in[23])[hj]; rkc = ((const float*)A.in[24])[hj]; }
    unsigned short pr[9], pk_[9], pv[9], plw[8], pas[8];
#define RWC_LOAD(c) do { const int w = w0, hj = h * 64 + lane0; const size_t m0_ = mb + (size_t)(c) * 64 + 8 * w; \
        _Pragma("unroll") for (int i_ = 0; i_ < 9; ++i_) { const bool ok_ = (i_ > 0) || ((c) > 0) || (w > 0); const bf16* row_ = RW + (m0_ + i_ - 1) * RWC + hj; \
            pr[i_] = ok_ ? row_[0] : (unsigned short)0; pk_[i_] = ok_ ? row_[512] : (unsigned short)0; pv[i_] = ok_ ? row_[1024] : (unsigned short)0; } \
        _Pragma("unroll") for (int i_ = 0; i_ < 8; ++i_) { plw[i_] = LW[(m0_ + i_) * 512 + hj]; pas[i_] = AS[(m0_ + i_) * 512 + hj]; } } while (0)
    RWC_LOAD(c_lo);
    { float run = 0.f;
#pragma unroll
      for (int i = 0; i < 8; ++i) run += bf2f(plw[i]);
      part[w0 * 64 + lane0] = run; }
    __syncthreads();
    for (int c = c_lo; c < c_hi; ++c) {
        int w = w0, lane = lane0; asm volatile("" : "+s"(w), "+v"(lane));
        const int tn_ = w & 3, tm0_ = 2 * (w >> 2);
        float off = 0.f, ctot = 0.f;
#pragma unroll
        for (int o = 0; o < 8; ++o) { const float p = part[o * 64 + lane]; ctot += p; if (o < w) off += p; }
        {   unsigned bh_[4], kh_[4], vt_[4], at_[4]; float cm = off; float* bon_g = BON + ((size_t)bh * 64 + c) * 64;
#pragma unroll
            for (int i = 0; i < 8; ++i) { const int t = 8 * w + i;
                const float p0 = bf2f(pr[i + 1]), p1 = bf2f(pk_[i + 1]), p2 = bf2f(pv[i + 1]);
                const float rv = p0 + (bf2f(pr[i]) - p0) * mu_r, kv = p1 + (bf2f(pk_[i]) - p1) * mu_k, vv = p2 + (bf2f(pv[i]) - p2) * mu_v, asg = bf2f(pas[i]);
                const float ce = cm; cm += bf2f(plw[i]);
                float kkv = kv * kkc; const float n2 = wsum64(kkv * kkv); kkv = kkv * __builtin_amdgcn_rsqf(fmaxf(n2, 1e-24f));
                const float km = kv * (1.f + (asg - 1.f) * kac); const float bn = wsum64(rv * km * rkc); if (lane == 0) bon_g[t] = bn;
                const float av = -kkv, bv = kkv * asg;
                const float e_ce = __expf(ce), e_cm = __expf(cm), e_ncm = __expf(-cm), e_rem = __expf(ctot - cm);
                const unsigned ha = pkbf(av * e_ce, 0.f) & 0xffffu; *(LAS unsigned short*)(bA + moff(t, lane)) = (unsigned short)ha; *(LAS unsigned short*)(bR + moff(t, lane)) = (unsigned short)(pkbf(rv * e_cm, 0.f) & 0xffffu);
                *(LAS unsigned short*)(bB + moff(t, lane)) = (unsigned short)(pkbf(bv * e_ncm, 0.f) & 0xffffu); *(LAS unsigned short*)(bK + moff(t, lane)) = (unsigned short)(pkbf(km * e_ncm, 0.f) & 0xffffu);
                const unsigned hb = pkbf(bv * e_rem, 0.f) & 0xffffu, hk = pkbf(km * e_rem, 0.f) & 0xffffu, hv = pkbf(vv, 0.f) & 0xffffu;
                if (i & 1) { bh_[i >> 1] |= hb << 16; kh_[i >> 1] |= hk << 16; vt_[i >> 1] |= hv << 16; at_[i >> 1] |= ha << 16; } else { bh_[i >> 1] = hb; kh_[i >> 1] = hk; vt_[i >> 1] = hv; at_[i >> 1] = ha; } }
            *(LAS v4u*)(bBH + moff(lane, 8 * w)) = (v4u){bh_[0], bh_[1], bh_[2], bh_[3]};
            *(LAS v4u*)(bKH + moff(lane, 8 * w)) = (v4u){kh_[0], kh_[1], kh_[2], kh_[3]};
            *(LAS v4u*)(bVT + moff(lane, 8 * w)) = (v4u){vt_[0], vt_[1], vt_[2], vt_[3]};
            *(LAS v4u*)(bAT + moff(lane, 8 * w)) = (v4u){at_[0], at_[1], at_[2], at_[3]};
        }
        const float dec0 = __expf(ctot);
        if (c + 1 < c_hi) RWC_LOAD(c + 1);
        __syncthreads();
        {   const int p = w >> 1; const LAS unsigned char* Am = (p < 2) ? bA : bR; const LAS unsigned char* Bm = (p == 0 || p == 2) ? bB : bK;
            const int tmb = 2 * (w & 1);
            Fr fa[2], fb[4]; f32x4 acc[2][4];
#pragma unroll
            for (int x = 0; x < 2; ++x) fa[x] = ldfr(Am, tmb + x, LO);
#pragma unroll
            for (int tn = 0; tn < 4; ++tn) fb[tn] = ldfr(Bm, tn, LO);
#pragma unroll
            for (int x = 0; x < 2; ++x)
#pragma unroll
                for (int tn = 0; tn < 4; ++tn) { acc[x][tn] = (f32x4){0.f, 0.f, 0.f, 0.f}; mmf(acc[x][tn], fa[x], fb[tn]); }
#pragma unroll
            for (int x = 0; x < 2; ++x) { const int tm = tmb + x;
#pragma unroll
                for (int tn = 0; tn < 4; ++tn) { f32x4 a = acc[x][tn];
                    const int n = 16 * tn + (lane & 15), m0 = 16 * tm + 4 * (lane >> 4);
#pragma unroll
                    for (int r = 0; r < 4; ++r) { const bool keep = (p < 2) ? (n < m0 + r) : (n <= m0 + r); if (!keep) a[r] = 0.f; }
                    if (p == 0) { st_mn(bQ0, tm, tn, LO, a); st_nm(bQT0, tm, tn, LO, a);
#pragma unroll
                        for (int r = 0; r < 4; ++r) if (n == m0 + r) a[r] += 1.f;
                        st_nm(bT, tm, tn, LO, a); }
                    else st_mn((p == 1) ? bAak : (p == 2) ? bArb : bArk, tm, tn, LO, a); } }
        }
        __syncthreads();
#pragma unroll
        for (int x = 0; x < 1; ++x) { const Fr fb = ldfr(bQT0, tn_, LO), fa0 = ldfr(bQ0, tm0_, LO), fa1 = ldfr(bQ0, tm0_ + 1, LO); f32x4 a0 = (f32x4){0.f, 0.f, 0.f, 0.f}, a1 = a0; mmf(a0, fa0, fb); mmf(a1, fa1, fb);
            st_mn(bB, tm0_, tn_, LO, a0); st_nm(bK, tm0_, tn_, LO, a0); st_mn(bB, tm0_ + 1, tn_, LO, a1); st_nm(bK, tm0_ + 1, tn_, LO, a1); }
        __syncthreads();
#pragma unroll
        for (int s = 2; s <= 5; ++s) {
            const LAS unsigned char* Qc = (s & 1) ? bQ0 : bB; const LAS unsigned char* QTc = (s & 1) ? bQT0 : bK;
            LAS unsigned char* Qn = (s & 1) ? bB : bQ0; LAS unsigned char* QTn = (s & 1) ? bK : bQT0;
            const int tn = w & 3;
            if (w >= 4) { f32x4 acc[4]; Fr fa[4]; const Fr fb = ldfr(bT, tn, LO);
#pragma unroll
                for (int tm = 0; tm < 4; ++tm) fa[tm] = ldfr(Qc, tm, LO);
#pragma unroll
                for (int tm = 0; tm < 4; ++tm) acc[tm] = ld_nm(bT, tm, tn, LO);
#pragma unroll
                for (int tm = 0; tm < 4; ++tm) mmf(acc[tm], fa[tm], fb);
#pragma unroll
                for (int tm = 0; tm < 4; ++tm) st_nm(bT, tm, tn, LO, acc[tm]);
            } else { f32x4 acc[4]; Fr fa[4]; const Fr fb = ldfr(QTc, tn, LO);
#pragma unroll
                for (int tm = 0; tm < 4; ++tm) fa[tm] = ldfr(Qc, tm, LO);
#pragma unroll
                for (int tm = 0; tm < 4; ++tm) { acc[tm] = (f32x4){0.f, 0.f, 0.f, 0.f}; mmf(acc[tm], fa[tm], fb); }
#pragma unroll
                for (int tm = 0; tm < 4; ++tm) { st_mn(Qn, tm, tn, LO, acc[tm]); st_nm(QTn, tm, tn, LO, acc[tm]); }
            }
            __syncthreads();
        }
        {
#pragma unroll
            for (int x = 0; x < 1; ++x) { const Fr fb = ldfr(bT, tn_, LO), fa0 = ldfr(bB, tm0_, LO), fa1 = ldfr(bB, tm0_ + 1, LO); f32x4 a0 = ld_nm(bT, tm0_, tn_, LO), a1 = ld_nm(bT, tm0_ + 1, tn_, LO);
                mmf(a0, fa0, fb); mmf(a1, fa1, fb); st_mn(bTF, tm0_, tn_, LO, a0); st_mn(bTF, tm0_ + 1, tn_, LO, a1); }
        }
        LAS unsigned char* bX = bB; LAS unsigned char* bW = bK; LAS unsigned char* bU = bQ0;
        __syncthreads();
#pragma unroll
        for (int x = 0; x < 1; ++x) { const Fr fv = ldfr(bVT, tn_, LO), ft = ldfr(bAT, tn_, LO), fk0 = ldfr(bAak, tm0_, LO), fk1 = ldfr(bAak, tm0_ + 1, LO), ff0 = ldfr(bTF, tm0_, LO), ff1 = ldfr(bTF, tm0_ + 1, LO);
            f32x4 x0 = (f32x4){0.f, 0.f, 0.f, 0.f}, x1 = x0, w0_ = x0, w1_ = x0; mmf(x0, fk0, fv); mmf(x1, fk1, fv); mmf(w0_, ff0, ft); mmf(w1_, ff1, ft);
            st_nm(bX, tm0_, tn_, LO, x0); st_nm(bX, tm0_ + 1, tn_, LO, x1); st_nm(bW, tm0_, tn_, LO, w0_); st_nm(bW, tm0_ + 1, tn_, LO, w1_); }
        __syncthreads();
#pragma unroll
        for (int x = 0; x < 1; ++x) { const Fr fb = ldfr(bX, tn_, LO), fa0 = ldfr(bTF, tm0_, LO), fa1 = ldfr(bTF, tm0_ + 1, LO); f32x4 a0 = (f32x4){0.f, 0.f, 0.f, 0.f}, a1 = a0; mmf(a0, fa0, fb); mmf(a1, fa1, fb);
            st_nm(bU, tm0_, tn_, LO, a0); st_nm(bU, tm0_ + 1, tn_, LO, a1); }
        __syncthreads();
        if (c + 1 < c_hi) { float run = 0.f;
#pragma unroll
          for (int i = 0; i < 8; ++i) run += bf2f(plw[i]);
          part[w * 64 + lane] = run; }
        {   unsigned char* img = IMG + ((size_t)bh * 64 + c) * (4 * MB);
            const int n_ = 16 * tn_ + (lane & 15); const float decn = __shfl(dec0, n_);
#pragma unroll
            for (int x = 0; x < 2; ++x) { const int tm = tm0_ + x; const int m0 = 16 * tm + 4 * (lane >> 4); const int go = moff(n_, m0);
                { f32x4 acc = (f32x4){0.f, 0.f, 0.f, 0.f}; mm(acc, bW, tm, bBH, tn_, LO);
#pragma unroll
                  for (int r = 0; r < 4; ++r) if (m0 + r == n_) acc[r] += decn;
                  *(GAS u32x2*)(img + 0 * MB + go) = (u32x2){pkbf(acc[0], acc[1]), pkbf(acc[2], acc[3])}; }
                { f32x4 acc = (f32x4){0.f, 0.f, 0.f, 0.f}; mm(acc, bBH, tm, bU, tn_, LO); mm(acc, bKH, tm, bVT, tn_, LO);
                  *(GAS u32x2*)(img + 1 * MB + go) = (u32x2){pkbf(acc[0], acc[1]), pkbf(acc[2], acc[3])}; }
                { f32x4 acc = ld_nm(bR, tm, tn_, LO); mm(acc, bW, tm, bArb, tn_, LO);
                  *(GAS u32x2*)(img + 2 * MB + go) = (u32x2){pkbf(acc[0], acc[1]), pkbf(acc[2], acc[3])}; }
                { f32x4 acc = (f32x4){0.f, 0.f, 0.f, 0.f}; mm(acc, bArb, tm, bU, tn_, LO); mm(acc, bArk, tm, bVT, tn_, LO);
                  *(GAS u32x2*)(img + 3 * MB + go) = (u32x2){pkbf(acc[0], acc[1]), pkbf(acc[2], acc[3])}; } }
        }
        __syncthreads();
    }
#undef RWC_LOAD
}

__device__ __forceinline__ void rwkv_seq(Frame& F, const ArgsD& A, const int bh) {
    using namespace rwk;
    const int b = bh >> 3, h = bh & 7, lane0 = lane_id_v(), w0 = F.wave;
    const LaneOff LO = lane_off(lane0);
    LAS unsigned char* L = F.lds + RING_OFF;
    LAS unsigned char* bS0 = L + 8 * MB;
    LAS float* ybuf = (LAS float*)(L + 10 * MB);
    const bf16* RW = (const bf16*)(F.ws + WS_RW); const bf16* G = (const bf16*)(F.ws + WS_G); bf16* YC = (bf16*)(F.ws + WS_YCAT);
    const unsigned char* IMG = F.ws + WS_RIMG + (size_t)bh * 64 * (4 * MB); const float* BON = (const float*)(F.ws + WS_RBON) + (size_t)bh * 64 * 64;
    const float* mu = (const float*)A.in[16]; const float* lnw_g = (const float*)A.in[25]; const float* lnb_g = (const float*)A.in[26];
    const size_t mb = (size_t)b * T;
    const int tid0 = w0 * 64 + lane0, lt0 = tid0 >> 3, hlc0 = h * 64 + (tid0 & 7) * 8;
    for (int i = tid0; i < MB / 16; i += 512) ((LAS v4u*)bS0)[i] = (v4u){0u, 0u, 0u, 0u};
    const f32x4 lw0 = *(const f32x4*)(lnw_g + hlc0), lw1 = *(const f32x4*)(lnw_g + hlc0 + 4), lb0 = *(const f32x4*)(lnb_g + hlc0), lb1 = *(const f32x4*)(lnb_g + hlc0 + 4), mv0 = *(const f32x4*)(mu + 1024 + hlc0), mv1 = *(const f32x4*)(mu + 1024 + hlc0 + 4);
    v4u pf[4][4], lvp[4], lvq[4], lgg[4]; float lbn[4];
#define RWS_LOAD(u, c) do { _Pragma("unroll") for (int k_ = 0; k_ < 4; ++k_) pf[u][k_] = *(const GAS v4u*)(IMG + (size_t)(c) * (4 * MB) + k_ * MB + tid0 * 16); \
        const size_t ml_ = mb + (size_t)(c) * 64 + lt0; lvp[u] = *(const GAS v4u*)(RW + ml_ * RWC + 1024 + hlc0); lvq[u] = *(const GAS v4u*)(RW + (ml_ - (((c) > 0 || lt0 > 0) ? 1 : 0)) * RWC + 1024 + hlc0); \
        lgg[u] = *(const GAS v4u*)(G + ml_ * 512 + hlc0); lbn[u] = BON[(c) * 64 + lt0]; } while (0)
#pragma unroll
    for (int u = 0; u < 4; ++u) RWS_LOAD(u, u);
    int scur = 0;
    for (int c4 = 0; c4 < T / 64; c4 += 4) {
#pragma unroll
      for (int u = 0; u < 4; ++u) { const int c = c4 + u;
        int w = w0, lane = lane0; asm volatile("" : "+s"(w), "+v"(lane));
        const int tid = w * 64 + lane, tn_ = w & 3, tm0_ = 2 * (w >> 2), lt = tid >> 3, lc = (tid & 7) * 8, hlc = h * 64 + lc;
        LAS unsigned char* set = L + (c & 1) * (4 * MB);
#pragma unroll
        for (int k = 0; k < 4; ++k) *(LAS v4u*)(set + k * MB + tid * 16) = pf[u][k];
        const v4u lv_p = lvp[u], lv_q = (c > 0 || lt > 0) ? lvq[u] : (v4u){0u, 0u, 0u, 0u}; const f32x4 lg0 = (f32x4){bflo(lgg[u].x), bfhi(lgg[u].x), bflo(lgg[u].y), bfhi(lgg[u].y)}, lg1 = (f32x4){bflo(lgg[u].z), bfhi(lgg[u].z), bflo(lgg[u].w), bfhi(lgg[u].w)}; const float bn = lbn[u];
        __syncthreads();
        if (c + 4 < T / 64) RWS_LOAD(u, c + 4);
        const LAS unsigned char* Sc = bS0 + scur * MB; LAS unsigned char* Sn = bS0 + (scur ^ 1) * MB;
#pragma unroll
        for (int x = 0; x < 2; ++x) { const int tm = tm0_ + x;
            { f32x4 acc = ld_nm(set + 1 * MB, tm, tn_, LO); mm(acc, set + 0 * MB, tm, Sc, tn_, LO); st_nm(Sn, tm, tn_, LO, acc); }
            { f32x4 acc = ld_nm(set + 3 * MB, tm, tn_, LO); mm(acc, set + 2 * MB, tm, Sc, tn_, LO);
              const int i = 16 * tn_ + (lane & 15), t0 = 16 * tm + 4 * (lane >> 4);
#pragma unroll
              for (int r = 0; r < 4; ++r) ybuf[(t0 + r) * 64 + i] = acc[r]; } }
        scur ^= 1;
        __syncthreads();
        {   const f32x4 y0 = *(const LAS f32x4*)(ybuf + lt * 64 + lc), y1 = *(const LAS f32x4*)(ybuf + lt * 64 + lc + 4);
            const float mean = sum8((y0.x + y0.y) + (y0.z + y0.w) + (y1.x + y1.y) + (y1.z + y1.w)) * (1.f / 64.f); const f32x4 d0 = y0 - mean, d1 = y1 - mean;
            const float var = sum8((d0.x * d0.x + d0.y * d0.y) + (d0.z * d0.z + d0.w * d0.w) + (d1.x * d1.x + d1.y * d1.y) + (d1.z * d1.z + d1.w * d1.w)) * (1.f / 64.f); const float rs = __builtin_amdgcn_rsqf(var + 64e-5f);
            f32x4 va = (f32x4){bflo(lv_p.x), bfhi(lv_p.x), bflo(lv_p.y), bfhi(lv_p.y)}, vb = (f32x4){bflo(lv_p.z), bfhi(lv_p.z), bflo(lv_p.w), bfhi(lv_p.w)};
            { const f32x4 qa = (f32x4){bflo(lv_q.x), bfhi(lv_q.x), bflo(lv_q.y), bfhi(lv_q.y)}, qb = (f32x4){bflo(lv_q.z), bfhi(lv_q.z), bflo(lv_q.w), bfhi(lv_q.w)}; va = va + (qa - va) * mv0; vb = vb + (qb - vb) * mv1; }
            const f32x4 o0 = ((d0 * rs) * lw0 + lb0 + va * bn) * lg0, o1 = ((d1 * rs) * lw1 + lb1 + vb * bn) * lg1;
            *(GAS v4u*)(YC + (mb + (size_t)c * 64 + lt) * 1024 + 512 + hlc) = (v4u){pkbf(o0.x, o0.y), pkbf(o0.z, o0.w), pkbf(o1.x, o1.y), pkbf(o1.z, o1.w)};
        }
      }
    }
#undef RWS_LOAD
}

__device__ __forceinline__ void p6_dacombine(Frame& F, const ArgsD& A) {
    const int lane = lane_id_v(), tid = F.wave * 64 + lane; (void)tid;
    const float* q1 = (const float*)A.in[11]; const float* k1 = (const float*)A.in[12]; const float* q2 = (const float*)A.in[13]; const float* k2 = (const float*)A.in[14];
    const float lam = __expf(wave_sum(q1[lane] * k1[lane])) - __expf(wave_sum(q2[lane] * k2[lane])) + 0.2f;
    const bf16* O = (const bf16*)(F.ws + WS_O); bf16* YC = (bf16*)(F.ws + WS_YCAT);
    const int gw = F.vcu * NWAVES + F.wave, NGW = F.G * NWAVES, dh = lane >> 4, d0 = 8 * (lane & 15);
    const float* sw = (const float*)A.in[15] + d0; const f32x4 swa = *(const f32x4*)sw * 0.8f, swb = *(const f32x4*)(sw + 4) * 0.8f;
    for (int m = gw; m < M; m += NGW) {
        const v4u a = *(const GAS v4u*)(O + (size_t)m * 1024 + dh * 256 + d0), c = *(const GAS v4u*)(O + (size_t)m * 1024 + dh * 256 + 128 + d0);
        f32x4 y0 = (f32x4){bflo(a.x) - lam * bflo(c.x), bfhi(a.x) - lam * bfhi(c.x), bflo(a.y) - lam * bflo(c.y), bfhi(a.y) - lam * bfhi(c.y)};
        f32x4 y1 = (f32x4){bflo(a.z) - lam * bflo(c.z), bfhi(a.z) - lam * bfhi(c.z), bflo(a.w) - lam * bflo(c.w), bfhi(a.w) - lam * bfhi(c.w)};
        float s2 = (y0.x * y0.x + y0.y * y0.y) + (y0.z * y0.z + y0.w * y0.w) + (y1.x * y1.x + y1.y * y1.y) + (y1.z * y1.z + y1.w * y1.w);
        s2 = allsum16(s2); const float rs = 1.f / sqrtf(s2 * (1.f / 128.f) + 1e-5f);
        y0 = y0 * rs * swa; y1 = y1 * rs * swb;
        *(GAS v4u*)(YC + (size_t)m * 1024 + dh * 128 + d0) = (v4u){pkbf(y0.x, y0.y), pkbf(y0.z, y0.w), pkbf(y1.x, y1.y), pkbf(y1.z, y1.w)}; }
}

#define P9_SWAP32(a, b) do { const auto r_ = __builtin_amdgcn_permlane32_swap(__float_as_uint(a), __float_as_uint(b), false, false); (a) = __uint_as_float(r_[0]) + __uint_as_float(r_[1]); } while (0)
#define P9_SWAP16(a, b) do { const auto r_ = __builtin_amdgcn_permlane16_swap(__float_as_uint(a), __float_as_uint(b), false, false); (a) = __uint_as_float(r_[0]) + __uint_as_float(r_[1]); } while (0)
#define P9_DPPF(x, ctrl) __builtin_bit_cast(float, __builtin_amdgcn_update_dpp(0, __builtin_bit_cast(int, (x)), (ctrl), 0xF, 0xF, true))
#define P9_DPPU(x, ctrl) ((unsigned)__builtin_amdgcn_update_dpp(0, (int)(x), (ctrl), 0xF, 0xF, true))
__device__ __forceinline__ float p9_reduce32(float (&a)[32], const int lane) {
#pragma unroll
    for (int e = 0; e < 16; ++e) P9_SWAP32(a[e], a[e + 16]);
#pragma unroll
    for (int e = 0; e < 8; ++e) P9_SWAP16(a[e], a[e + 8]);
    const bool b3 = (lane & 8) != 0, b2 = (lane & 4) != 0, b0 = (lane & 1) != 0;
#pragma unroll
    for (int e = 0; e < 4; ++e) { const float keep = b3 ? a[e + 4] : a[e], send = b3 ? a[e] : a[e + 4]; a[e] = keep + P9_DPPF(send, 0x128); }
#pragma unroll
    for (int e = 0; e < 2; ++e) { const float keep = b2 ? a[e + 2] : a[e], send = b2 ? a[e] : a[e + 2]; a[e] = keep + P9_DPPF(send, 0x141); }
    { const float keep = b0 ? a[1] : a[0], send = b0 ? a[0] : a[1]; a[0] = keep + P9_DPPF(send, 0xB1); }
    return a[0] + P9_DPPF(a[0], 0x4E);
}
__device__ __forceinline__ unsigned p9_wmax(unsigned v) {
    v = max(v, P9_DPPU(v, 0xB1)); v = max(v, P9_DPPU(v, 0x4E)); v = max(v, P9_DPPU(v, 0x124)); v = max(v, P9_DPPU(v, 0x128));
    const unsigned s0 = __builtin_amdgcn_readlane(v, 0), s1 = __builtin_amdgcn_readlane(v, 16), s2 = __builtin_amdgcn_readlane(v, 32), s3 = __builtin_amdgcn_readlane(v, 48);
    return max(max(s0, s1), max(s2, s3)); }
__device__ __forceinline__ unsigned p9_hmax32(unsigned v) {
    v = max(v, P9_DPPU(v, 0xB1)); v = max(v, P9_DPPU(v, 0x4E)); v = max(v, P9_DPPU(v, 0x124)); v = max(v, P9_DPPU(v, 0x128));
    const auto r_ = __builtin_amdgcn_permlane16_swap(v, v, false, false); return max(r_[0], r_[1]); }
__device__ __forceinline__ void p8_postmix_router(Frame& F, const ArgsD& A, const int cset) {
    typedef rwk::bf16x8 bf16x8;
    const int lane = lane_id_v(), wv = F.wave, tid = wv * 64 + lane;
    LAS unsigned char* tileH = F.lds + RING_OFF;
    LAS float* red = (LAS float*)(F.lds + RING_OFF + 65536);
    volatile LAS int* lcnt = (volatile LAS int*)(F.lds + LDSCTL_OFF);
    if (tid < 32) lcnt[tid] = 0;
    bf16x8 bh[2][4], bl[2][4];
    { const float* r = (const float*)A.in[27];
#pragma unroll
      for (int nt = 0; nt < 2; ++nt)
#pragma unroll
        for (int ks = 0; ks < 4; ++ks) { const float* rp = r + (size_t)(128 * wv + 32 * ks + 8 * (lane >> 4)) * 32 + 16 * nt + (lane & 15);
            float w_[8];
#pragma unroll
            for (int q = 0; q < 8; ++q) w_[q] = rp[q * 32];
            v4u h, l;
            h.x = pkbf(w_[0], w_[1]); h.y = pkbf(w_[2], w_[3]); h.z = pkbf(w_[4], w_[5]); h.w = pkbf(w_[6], w_[7]);
            l.x = pkbf(w_[0] - bflo(h.x), w_[1] - bfhi(h.x)); l.y = pkbf(w_[2] - bflo(h.y), w_[3] - bfhi(h.y)); l.z = pkbf(w_[4] - bflo(h.z), w_[5] - bfhi(h.z)); l.w = pkbf(w_[6] - bflo(h.w), w_[7] - bfhi(h.w));
            bh[nt][ks] = __builtin_bit_cast(bf16x8, h); bl[nt][ks] = __builtin_bit_cast(bf16x8, l); } }
    __syncthreads();
    const float* x = (const float*)A.in[0]; const bf16* Y = (const bf16*)(F.ws + WS_Y); const float* mod = (const float*)(F.ws + WS_MOD);
    const float* pmn = (const float*)A.in[6]; const float* pfn = (const float*)A.in[7]; const float* rb = (const float*)A.in[28];
    unsigned char* H2 = F.ws + WS_H2; int* tokE = (int*)(F.ws + WS_TOKE); float* tokG = (float*)(F.ws + WS_TOKG);
    bf16* X1 = (bf16*)(F.ws + WS_X1);
    const int rows_per = M / F.G, mbeg = F.vcu * rows_per, b = mbeg >> 12; const float* mb_ = mod + (size_t)b * NMOD;
    f32x4 a1[4], a2[4], sh[4];
#pragma unroll
    for (int j = 0; j < 4; ++j) { const int col = 4 * lane + 256 * j; a1[j] = *(const f32x4*)(pmn + col) * *(const f32x4*)(mb_ + 2048 + col); a2[j] = *(const f32x4*)(pfn + col) * (*(const f32x4*)(mb_ + 4096 + col) + 1.f); sh[j] = *(const f32x4*)(mb_ + 3072 + col); }
    const float rbias = rb[lane & 31];
    const int nr = rows_per / NWAVES, m0 = mbeg + wv * nr;
    u32x2 yp[2][4]; f32x4 xp[2][4];
#define P9_LOAD(m_) do { _Pragma("unroll") for (int t_ = 0; t_ < 2; ++t_) _Pragma("unroll") for (int j_ = 0; j_ < 4; ++j_) { \
        yp[t_][j_] = *((const GAS u32x2*)(Y + (size_t)((m_) + t_) * D) + lane + 64 * j_); xp[t_][j_] = *((const GAS f32x4*)(x + (size_t)((m_) + t_) * D) + lane + 64 * j_); } } while (0)
    P9_LOAD(m0);
    for (int i = 0; i < nr; i += 2) { const int m = m0 + i;
#pragma unroll
        for (int t = 0; t < 2; ++t) { f32x4 yv[4], xv[4]; float s2 = 0.f;
#pragma unroll
            for (int j = 0; j < 4; ++j) { const u32x2 p = yp[t][j]; yv[j] = (f32x4){bflo(p.x), bfhi(p.x), bflo(p.y), bfhi(p.y)}; s2 += (yv[j].x * yv[j].x + yv[j].y * yv[j].y) + (yv[j].z * yv[j].z + yv[j].w * yv[j].w); }
            const float rs = __builtin_amdgcn_rsqf(rwk::wsum64(s2) * (1.f / D) + 1e-6f); float t2 = 0.f;
#pragma unroll
            for (int j = 0; j < 4; ++j) { xv[j] = xp[t][j] + a1[j] * (yv[j] * rs); *((GAS u32x2*)(X1 + (size_t)(m + t) * D) + lane + 64 * j) = (u32x2){pkbf(xv[j].x, xv[j].y), pkbf(xv[j].z, xv[j].w)};
                t2 += (xv[j].x * xv[j].x + xv[j].y * xv[j].y) + (xv[j].z * xv[j].z + xv[j].w * xv[j].w); }
            const float rs2 = __builtin_amdgcn_rsqf(rwk::wsum64(t2) * (1.f / D) + 1e-6f);
            const int r = 2 * wv + t;
#pragma unroll
            for (int j = 0; j < 4; ++j) { const f32x4 v = xv[j] * rs2 * a2[j] + sh[j]; *((GAS unsigned*)(H2 + (size_t)(m + t) * D) + lane + 64 * j) = pg8::pk4_fp8(v.x, v.y, v.z, v.w);
                const unsigned h0 = pkbf(v.x, v.y), h1 = pkbf(v.z, v.w), l0 = pkbf(v.x - bflo(h0), v.y - bfhi(h0)), l1 = pkbf(v.z - bflo(h1), v.w - bfhi(h1));
                const int off = r * 2048 + ((((lane >> 1) + 32 * j) ^ r) << 4) + (lane & 1) * 8;
                *(LAS u32x2*)(tileH + off) = (u32x2){h0, h1}; *(LAS u32x2*)(tileH + 32768 + off) = (u32x2){l0, l1}; } }
        if (i + 2 < nr) P9_LOAD(m + 2);
        __syncthreads();
        {   f32x4 acc[2] = {(f32x4){0.f, 0.f, 0.f, 0.f}, (f32x4){0.f, 0.f, 0.f, 0.f}};
#pragma unroll
            for (int ks = 0; ks < 4; ++ks) { const int r = lane & 15, off = r * 2048 + (((16 * wv + 4 * ks + (lane >> 4)) ^ r) << 4);
                const bf16x8 ah = *(const LAS bf16x8*)(tileH + off), al = *(const LAS bf16x8*)(tileH + 32768 + off);
#pragma unroll
                for (int nt = 0; nt < 2; ++nt) { acc[nt] = __builtin_amdgcn_mfma_f32_16x16x32_bf16(al, bl[nt][ks], acc[nt], 0, 0, 0); acc[nt] = __builtin_amdgcn_mfma_f32_16x16x32_bf16(al, bh[nt][ks], acc[nt], 0, 0, 0);
                    acc[nt] = __builtin_amdgcn_mfma_f32_16x16x32_bf16(ah, bl[nt][ks], acc[nt], 0, 0, 0); acc[nt] = __builtin_amdgcn_mfma_f32_16x16x32_bf16(ah, bh[nt][ks], acc[nt], 0, 0, 0); } }
#pragma unroll
            for (int nt = 0; nt < 2; ++nt)
#pragma unroll
                for (int rr = 0; rr < 4; ++rr) red[(wv * 16 + 4 * (lane >> 4) + rr) * 32 + 16 * nt + (lane & 15)] = acc[nt][rr]; }
        __syncthreads();
        {   const int t = lane >> 5, e = lane & 31; float lg = rbias;
#pragma unroll
            for (int w8 = 0; w8 < 8; ++w8) lg += red[(w8 * 16 + 2 * wv + t) * 32 + e];
            const unsigned u = __float_as_uint(lg); unsigned key = (((u >> 31) ? ~u : (u | 0x80000000u)) & ~31u) | (unsigned)(31 - e);
            float tv[4]; int ti[4];
#pragma unroll
            for (int k = 0; k < 4; ++k) { const unsigned mx = p9_hmax32(key); ti[k] = 31 - (int)(mx & 31u); const unsigned kv = mx & ~31u; tv[k] = __uint_as_float((kv >> 31) ? (kv & 0x7fffffffu) : ~kv); if (key == mx) key = 0u; }
            float ew[4], es = 0.f;
#pragma unroll
            for (int k = 0; k < 4; ++k) { ew[k] = __expf(tv[k] - tv[0]); es += ew[k]; }
            if (e < 4) { const int ex = (e == 0) ? ti[0] : (e == 1) ? ti[1] : (e == 2) ? ti[2] : ti[3]; const float g = ((e == 0) ? ew[0] : (e == 1) ? ew[1] : (e == 2) ? ew[2] : ew[3]) / es;
                const int pos = __hip_atomic_fetch_add((LAS int*)lcnt + ex, 1, __ATOMIC_RELAXED, __HIP_MEMORY_SCOPE_WORKGROUP);
                tokE[(size_t)(m + t) * 4 + e] = ex | (pos << 8); tokG[(size_t)(m + t) * 4 + e] = g; } }
    }
#undef P9_LOAD
    __syncthreads();
    if (tid < 32) { const int n = lcnt[tid]; int base = 0; if (n > 0) base = (int)__hip_atomic_fetch_add(F.ctl + CW_ECNT + cset * 64 * NEXP + 64 * tid, (unsigned)n, __ATOMIC_RELAXED, __HIP_MEMORY_SCOPE_AGENT);
        ((int*)(F.ws + WS_BLKBASE))[F.vcu * 32 + tid] = base; }
}

__device__ __forceinline__ void moe_tables(Frame& F) {
    const int lane = lane_id_v(), tid = F.wave * 64 + lane; (void)tid;
    volatile LAS int* ts = (volatile LAS int*)(F.lds + LDSCTL_OFF);
    if (tid < 32) ts[40 + tid] = (int)__hip_atomic_load(F.ctl + CW_ECNT + 64 * tid, __ATOMIC_RELAXED, __HIP_MEMORY_SCOPE_AGENT);
    __syncthreads();
    if (tid == 0) { int acc = 0; for (int e = 0; e < 32; ++e) { ts[e] = acc; acc += (ts[40 + e] + 255) >> 8; } ts[32] = acc; }
    __syncthreads();
}
__device__ __forceinline__ void p9_rows(Frame& F) {
    const int lane = lane_id_v(), tid = F.wave * 64 + lane; (void)tid;
    moe_tables(F);
    volatile LAS int* ts = (volatile LAS int*)(F.lds + LDSCTL_OFF);
    const int* tokE = (const int*)(F.ws + WS_TOKE); const float* tokG = (const float*)(F.ws + WS_TOKG); const int* blkbase = (const int*)(F.ws + WS_BLKBASE) + F.vcu * 32;
    int* tokrow = (int*)(F.ws + WS_TOKROW); int* rowtok = (int*)(F.ws + WS_ROWTOK); float* rowgate = (float*)(F.ws + WS_ROWGATE);
    const int rows_per = M / F.G, mbeg = F.vcu * rows_per;
    for (int i = tid; i < rows_per * 4; i += 512) { const int idx = mbeg * 4 + i; const int pe = tokE[idx], e = pe & 255, pos = pe >> 8; const int row = ts[e] * 256 + blkbase[e] + pos;
        tokrow[idx] = row; rowtok[row] = idx >> 2; rowgate[row] = tokG[idx]; }
    for (int e = F.vcu; e < 32; e += F.G) { const int n = ts[40 + e]; const int r0 = ts[e] * 256 + n, r1 = ts[e + 1] * 256;
        for (int r = r0 + tid; r < r1; r += 512) { rowtok[r] = 0; rowgate[r] = 0.f; } }
}

__device__ __forceinline__ void p12_final(Frame& F, const ArgsD& A, float* dst) {
    const int lane = lane_id_v(), tid = F.wave * 64 + lane; (void)tid;
    const unsigned char* Y2 = F.ws + WS_Y2; const int* tokrow = (const int*)(F.ws + WS_TOKROW); const float* mod = (const float*)(F.ws + WS_MOD); const float* pn = (const float*)A.in[8];
    const int rows_per = M / F.G, mbeg = F.vcu * rows_per, b = mbeg >> 12, nr = rows_per / NWAVES, m0 = mbeg + F.wave * nr;
    const float* mb_ = mod + (size_t)b * NMOD + 5120;
    f32x4 gw[4];
#pragma unroll
    for (int j = 0; j < 4; ++j) { const int col = 4 * lane + 256 * j; gw[j] = *(const f32x4*)(pn + col) * *(const f32x4*)(mb_ + col); }
    const int myrow = tokrow[(size_t)m0 * 4 + (lane < nr * 4 ? lane : 0)];
    const bf16* X1 = (const bf16*)(F.ws + WS_X1);
    unsigned yp[4][4]; u32x2 xp[4];
#define P13_LOAD(i_) do { _Pragma("unroll") for (int k_ = 0; k_ < 4; ++k_) { const int row_ = __builtin_amdgcn_readlane(myrow, 4 * (i_) + k_); \
        _Pragma("unroll") for (int j_ = 0; j_ < 4; ++j_) yp[k_][j_] = *((const GAS unsigned*)(Y2 + (size_t)row_ * D) + lane + 64 * j_); } \
        _Pragma("unroll") for (int j_ = 0; j_ < 4; ++j_) xp[j_] = *((const GAS u32x2*)(X1 + (size_t)(m0 + (i_)) * D) + lane + 64 * j_); } while (0)
    P13_LOAD(0);
#pragma unroll 1
    for (int i = 0; i < nr; ++i) { const int m = m0 + i;
        f32x4 a[4], xv[4]; float s2 = 0.f;
#pragma unroll
        for (int j = 0; j < 4; ++j) { a[j] = (f32x4){0.f, 0.f, 0.f, 0.f};
#pragma unroll
            for (int k = 0; k < 4; ++k) { const unsigned p = yp[k][j]; const f32x2 lo = __builtin_amdgcn_cvt_pk_f32_fp8((int)p, false), hi = __builtin_amdgcn_cvt_pk_f32_fp8((int)p, true); a[j] = a[j] + (f32x4){lo.x, lo.y, hi.x, hi.y}; }
            a[j] = a[j] * pg8::Y8_INV;
            s2 += (a[j].x * a[j].x + a[j].y * a[j].y) + (a[j].z * a[j].z + a[j].w * a[j].w); xv[j] = (f32x4){bflo(xp[j].x), bfhi(xp[j].x), bflo(xp[j].y), bfhi(xp[j].y)}; }
        if (i + 1 < nr) { const int in_ = __builtin_amdgcn_readfirstlane(i + 1);
#pragma unroll
            for (int k_ = 0; k_ < 4; ++k_) { const int row_ = __builtin_amdgcn_readlane(myrow, 4 * in_ + k_);
#pragma unroll
                for (int j_ = 0; j_ < 4; ++j_) yp[k_][j_] = *((const GAS unsigned*)(Y2 + (size_t)row_ * D) + lane + 64 * j_); }
#pragma unroll
            for (int j_ = 0; j_ < 4; ++j_) xp[j_] = *((const GAS u32x2*)(X1 + (size_t)(m + 1) * D) + lane + 64 * j_); }
        const float rs = __builtin_amdgcn_rsqf(wave_sum(s2) * (1.f / D) + 1e-6f);
#pragma unroll
        for (int j = 0; j < 4; ++j) *((GAS f32x4*)(dst + (size_t)m * D) + lane + 64 * j) = xv[j] + gw[j] * (a[j] * rs); }
#undef P13_LOAD
}
__global__ void __launch_bounds__(NWAVES * 64, 2) hybrid_fwd(Args kargs) {
    const ArgsD args{};
    extern __shared__ __attribute__((aligned(16))) unsigned char lds[];
    Frame F;
    F.lds = (LAS unsigned char*)lds;
    F.MISC = (volatile LAS unsigned*)(F.lds + MISC_OFF);
    F.wave = __builtin_amdgcn_readfirstlane((int)threadIdx.x >> 6);
    F.G = gridDim.x; { const int bx = blockIdx.x; F.vcu = (F.G % 8 == 0) ? (bx % 8) * (F.G / 8) + bx / 8 : bx; }
    F.ws = kargs.ws; F.out = kargs.out;
    unsigned char* ws = kargs.ws;
    F.ctl = (gu32*)(ws + WS_CTL);
#define GRID_BAR(seam) do { if (N_LAUNCHES != 1) { if (F.wave == 0 && lane_id_v() == 0) __hip_atomic_store(F.ctl + CW_TMO, 0xBADBA0u | (unsigned)(seam), RLX_AGENT); } else { xcd_barrier(bar); } } while (0)
    for (int u = threadIdx.x; u < (LDS_BYTES - LDSCTL_OFF) / 4; u += NWAVES * 64) ((LAS unsigned*)(F.lds + LDSCTL_OFF))[u] = 0u;
    __syncthreads();
    XcdBarrier bar; bar.bar = (unsigned*)(F.ctl + CW_BAR); bar.x = 0; bar.st = nullptr; bar.wid = F.wave;
    if (N_LAUNCHES == 1) bar = xcd_barrier_post((unsigned*)(F.ctl + CW_BAR), F.MISC + 8, F.wave);
    const int lo = kargs.ph_lo, hi = kargs.ph_hi;
#define IN(k) (lo <= (k) && (k) < hi)
#define PREP(k) (((PROBE_MASK) >> (k)) & 1)
#define BOTH(k) (IN(k) && IN((k) + 1))
    bf16* const H = (bf16*)(ws + WS_H); bf16* const H2 = (bf16*)(ws + WS_H2);

    if (IN(0)) { _Pragma("unroll 1") for (int r_ = 0; r_ <= PREP(0); ++r_) { p0_prologue(F, args); } if (BOTH(0)) GRID_BAR(0); }
    if (IN(1)) { _Pragma("unroll 1") for (int r_ = 0; r_ <= PREP(1); ++r_) { p1_premix(F, args); } if (BOTH(1)) GRID_BAR(1); }
    if (IN(2)) {
        pg8::Gemm g{H, (const bf16*)(ws + WS_WIN), M, IN_COLS, D, 0, nullptr, ws}; pg8::StaticOrder S; S.init(M, IN_COLS, F.G, (int)blockIdx.x);
        pg8::EpiProj E{(bf16*)(ws + WS_Q), (bf16*)(ws + WS_K), (bf16*)(ws + WS_V), (bf16*)(ws + WS_RW), (const float*)(ws + WS_ROPE), attn_body::C2};
        if (PREP(2)) { pg8::gemm_phase<pg8::EpiProj, pg8::StaticOrder, true, true, false>(F.lds + RING_OFF, g, S, E, F.wave); GRID_BAR(102); }
        pg8::gemm_phase<pg8::EpiProj, pg8::StaticOrder, true, true, false>(F.lds + RING_OFF, g, S, E, F.wave);
        if (BOTH(2)) GRID_BAR(2);
    }
    if (IN(3)) { _Pragma("unroll 1") for (int r_ = 0; r_ <= PREP(3); ++r_) { p3_lact(F, args); } if (BOTH(3)) GRID_BAR(3); }
    if (IN(4)) {
        pg8::Gemm g{(const bf16*)(ws + WS_LACT), (const bf16*)(ws + WS_BLORA), M, 1536, 256, 0, nullptr, ws}; pg8::StaticOrder S; S.init(M, 1536, F.G, (int)blockIdx.x);
        pg8::EpiLora E{(bf16*)(ws + WS_LW), (size_t)(WS_AS - WS_LW) / 2, (const float*)args.in[17], (const float*)args.in[19]}; static_assert(WS_G - WS_AS == WS_AS - WS_LW, "LW | AS | G equally spaced");
        if (PREP(4)) { pg8::gemm_phase<pg8::EpiLora, pg8::StaticOrder, true, true, false>(F.lds + RING_OFF, g, S, E, F.wave); GRID_BAR(104); }
        pg8::gemm_phase<pg8::EpiLora, pg8::StaticOrder, true, true, false>(F.lds + RING_OFF, g, S, E, F.wave);
        if (BOTH(4)) GRID_BAR(4);
    }
    if (IN(5)) {
        _Pragma("unroll 1") for (int r_ = 0; r_ <= PREP(5); ++r_)
            for (int u = F.vcu; u < BATCH * 8 * 4; u += F.G) rwkv_pre(F, args, u >> 2, (u & 3) * 16, (u & 3) * 16 + 16);
        if (BOTH(5)) GRID_BAR(5);
    }
    if (IN(6)) {
        _Pragma("unroll 1") for (int r_ = 0; r_ <= PREP(14); ++r_)
            for (int bh = blockIdx.x; bh < BATCH * 8; bh += F.G) rwkv_seq(F, args, bh);
        static_assert(attn_body::ATTN_LDS_BYTES <= RING_BYTES, "attention body geometry vs frame");
        const attn_body::AttnTensors AT{(const attn_body::bf16*)(ws + WS_Q), (const attn_body::bf16*)(ws + WS_K), (const attn_body::bf16*)(ws + WS_V), (attn_body::bf16*)(ws + WS_O)};
        _Pragma("unroll 1") for (int r_ = PREP(15); r_ >= 0; --r_) {
            const attn_body::QueueOrder S{(unsigned*)(F.ctl + CW_ATTQ + 64 * r_), F.MISC + 12, F.wave};
            unsigned nxt = S.claim(); int par = 0;
            for (;;) { const unsigned n = S.publish(nxt, par); par ^= 1; if (n >= 3u * P0_XUNITS) break;
                nxt = S.claim();
                const unsigned g3 = n / 3u, r3 = n - 3u * g3;
                if (r3 == 2u) p0_expert_unit(F, args, (int)g3);
                else { const int a = (int)(2u * g3 + r3), qb = attn_body::NQB - 1 - a / 64, bh = a % 64;
                    attn_body::attn_unit<8>(bh / 8, bh % 8, qb, AT.Q, AT.K, AT.V, AT.O, (char*)lds + RING_OFF, F.wave); } }
            if (r_) GRID_BAR(106);
        }
        if (BOTH(6)) GRID_BAR(6);
    }
    if (IN(7)) { _Pragma("unroll 1") for (int r_ = 0; r_ <= PREP(7); ++r_) { p6_dacombine(F, args); } if (BOTH(7)) GRID_BAR(7); }
    if (IN(8)) {
        pg8::Gemm g{(const bf16*)(ws + WS_YCAT), (const bf16*)(ws + WS_WOUT), M, D, D, 0, nullptr, ws}; pg8::StaticOrder S; S.init(M, D, F.G, (int)blockIdx.x);
        pg8::EpiPlain E{(bf16*)(ws + WS_Y), D};
        if (PREP(8)) { pg8::gemm_phase<pg8::EpiPlain, pg8::StaticOrder, true, true, false>(F.lds + RING_OFF, g, S, E, F.wave); GRID_BAR(108); }
        pg8::gemm_phase<pg8::EpiPlain, pg8::StaticOrder, true, true, false>(F.lds + RING_OFF, g, S, E, F.wave);
        if (BOTH(8)) GRID_BAR(8);
    }
    if (IN(9)) { _Pragma("unroll 1") for (int r_ = PREP(9); r_ >= 0; --r_) { p8_postmix_router(F, args, r_); } if (BOTH(9)) GRID_BAR(9); }
    if (IN(10)) { _Pragma("unroll 1") for (int r_ = 0; r_ <= PREP(10); ++r_) { p9_rows(F); } if (BOTH(10)) GRID_BAR(10); }
    if (IN(11)) {
        moe_tables(F);
        const LAS int* ts = (const LAS int*)(F.lds + LDSCTL_OFF);
        pg8::Gemm g{H2, (const bf16*)(ws + WS_W1), MAXROWS, 2048, D / 2, (size_t)2048 * D, (const int*)(ws + WS_ROWTOK), ws};
        pg8::MoeOrder S{__builtin_amdgcn_readfirstlane(ts[32]), 8, 4, F.G, F.vcu, ts};
        pg8::EpiSwiglu E{ws + WS_ACT, (const float*)args.in[30]};
        if (PREP(11)) { pg8::gemm_phase<pg8::EpiSwiglu, pg8::MoeOrder, true, true, true, true>(F.lds + RING_OFF, g, S, E, F.wave); GRID_BAR(111); }
        pg8::gemm_phase<pg8::EpiSwiglu, pg8::MoeOrder, true, true, true, true>(F.lds + RING_OFF, g, S, E, F.wave);
        if (BOTH(11)) GRID_BAR(11);
    }
    if (IN(12)) {
        moe_tables(F);
        const LAS int* ts = (const LAS int*)(F.lds + LDSCTL_OFF);
        pg8::Gemm g{(const bf16*)(ws + WS_ACT), (const bf16*)(ws + WS_W2), MAXROWS, D, D / 2, (size_t)D * D, nullptr, ws};
        pg8::MoeOrder S{__builtin_amdgcn_readfirstlane(ts[32]), 4, 8, F.G, F.vcu, ts};
        pg8::EpiMoe2 E{ws + WS_Y2, (const float*)args.in[32], (const float*)(ws + WS_ROWGATE)};
        if (PREP(12)) { pg8::gemm_phase<pg8::EpiMoe2, pg8::MoeOrder, true, true, false, true>(F.lds + RING_OFF, g, S, E, F.wave); GRID_BAR(112); }
        pg8::gemm_phase<pg8::EpiMoe2, pg8::MoeOrder, true, true, false, true>(F.lds + RING_OFF, g, S, E, F.wave);
        if (BOTH(12)) GRID_BAR(12);
    }
    if (IN(13)) { _Pragma("unroll 1") for (int r_ = PREP(13); r_ >= 0; --r_) { p12_final(F, args, r_ ? (float*)(ws + WS_G) : F.out); } }
    if (PREP(16)) { _Pragma("unroll 1") for (int r_ = 0; r_ < 16; ++r_) GRID_BAR(200); }
#undef IN
#undef PREP
#undef BOTH
}

extern "C" void kernel_launch(void* const* d_in, const int* in_sizes, int n_in, void* d_out, int out_size, void* d_ws, size_t ws_size, hipStream_t stream) {
    static int grid = 0;
    if (grid == 0) {
        if (n_in != 33 || in_sizes[0] != M * D || out_size != M * D || ws_size < WS_END) { fprintf(stderr, "kernel_launch: built for 33 inputs, x and out of %d floats, >= %zu bytes of workspace; got n_in %d, in0 %d, out %d, ws %zu; nothing launched\n", M * D, (size_t)WS_END, n_in, n_in > 0 ? in_sizes[0] : -1, out_size, ws_size); grid = -1; return; }
        int dev = 0, cus = 0, per_cu = 0;
        if (hipGetDevice(&dev) != hipSuccess || hipDeviceGetAttribute(&cus, hipDeviceAttributeMultiprocessorCount, dev) != hipSuccess) { fprintf(stderr, "kernel_launch: hipGetDevice / hipDeviceGetAttribute failed; nothing launched\n"); grid = -1; return; }
        if (hipFuncSetAttribute((const void*)hybrid_fwd, hipFuncAttributeMaxDynamicSharedMemorySize, LDS_BYTES) != hipSuccess) { fprintf(stderr, "kernel_launch: hipFuncSetAttribute failed; nothing launched\n"); grid = -1; return; }
        if (hipOccupancyMaxActiveBlocksPerMultiprocessor(&per_cu, (const void*)hybrid_fwd, NWAVES * 64, LDS_BYTES) != hipSuccess || per_cu < 1)
            fprintf(stderr, "kernel_launch: note: the occupancy query reports %d workgroups per CU\n", per_cu);
        (void)hipGetLastError();
        grid = (cus >= 256) ? 256 : (cus / 32) * 32;
        if (grid != 256) fprintf(stderr, "kernel_launch: launching %d workgroups (built and checked for 256)\n", grid);
    }
    if (grid <= 0) return;
    if (hipMemsetAsync((char*)d_ws + WS_CTL, 0, CTL_ZERO_BYTES, stream) != hipSuccess) { fprintf(stderr, "kernel_launch: hipMemsetAsync of the control words failed; nothing launched\n"); return; }
    Args a{};
    for (int i = 0; i < 33; ++i) a.in[i] = d_in[i];
    a.out = (float*)d_out; a.ws = (unsigned char*)d_ws;
    for (int li = 0; li < N_LAUNCHES; ++li) {
        a.ph_lo = (N_LAUNCHES == 1) ? 0 : li; a.ph_hi = (N_LAUNCHES == 1) ? N_PHASES : li + 1; a.li = li; a.pad = 0;
        hipLaunchKernelGGL(hybrid_fwd, dim3(grid), dim3(NWAVES * 64), LDS_BYTES, stream, a);
        const hipError_t le = hipPeekAtLastError();
        if (le != hipSuccess) { fprintf(stderr, "kernel_launch: launch %d failed: %s\n", li, hipGetErrorName(le)); break; }
    }
}
```
